# Optimizing an MI355X kernel written in HIP

```python
import numpy as np
import jax
import jax.numpy as jnp
from jax import lax

D_MODEL = 2048
BATCH = 4
SEQ = 4096
DEPTH = 4

F32 = jnp.float32
HEAD_DIM = 64
D_MIX = D_MODEL
D_RWKV = (3 * D_MIX) // 8
D_POOL = D_MIX // 4
D_NSA = D_MIX - D_RWKV - D_POOL
RW_HEADS = D_RWKV // HEAD_DIM
RW_DECAY_LORA = 64
RW_A_LORA = 64
RW_GATE_LORA = 128
RW_GN_EPS = 64e-5
RW_COLS = 3 * D_RWKV + RW_DECAY_LORA + RW_A_LORA + RW_GATE_LORA
RW_SPLITS = (D_RWKV, 2 * D_RWKV, 3 * D_RWKV, 3 * D_RWKV + RW_DECAY_LORA,
             3 * D_RWKV + RW_DECAY_LORA + RW_A_LORA)
POOL_WINDOWS = (2, 4, 8, 16)
POOL_GROUP = D_POOL // 4
NSA_HEADS = D_NSA // HEAD_DIM
NSA_KV_HEADS = 3
NSA_GQA = NSA_HEADS // NSA_KV_HEADS
NSA_KV = NSA_KV_HEADS * HEAD_DIM
NSA_COLS = D_NSA + 6 * NSA_KV + 3 * NSA_HEADS
NSA_SPLITS = (D_NSA, D_NSA + NSA_KV, D_NSA + 2 * NSA_KV, D_NSA + 3 * NSA_KV,
              D_NSA + 4 * NSA_KV, D_NSA + 5 * NSA_KV, D_NSA + 6 * NSA_KV)
CMP_BLOCK = 32
CMP_STRIDE = 16
CMP_HIDDEN = 256
SEL_BLOCK = 64
SEL_TOPK = 16
FORCE_SCORE = 1e9
WINDOW = 512
Q_BLOCK = 128
SEL_Q_CHUNK = 64
ROPE_THETA = 500000.0
ROPE_DIM = HEAD_DIM // 4
D_FF = ((8 * D_MODEL // 3 + 127) // 128) * 128
IN_COLS = RW_COLS + D_POOL + NSA_COLS
ALPHA = (2 * DEPTH) ** 0.25
BETA = (8 * DEPTH) ** -0.25
LN_EPS = 1e-5

kernel_name = "hymba_rwkv7_pool_nsa_macaron_deepnorm"


def layer_norm(x, g, b):
    xf = x.astype(F32)
    mu = xf.mean(-1, keepdims=True)
    var = jnp.square(xf - mu).mean(-1, keepdims=True)
    return ((xf - mu) * lax.rsqrt(var + LN_EPS) * g + b).astype(x.dtype)


def swiglu(x, w_up, w_down):
    a, b = jnp.split(x @ w_up, 2, axis=-1)
    return (jax.nn.silu(a) * b) @ w_down


def token_shift(t):
    return jnp.pad(t[:, :-1], ((0, 0), (1, 0), (0, 0)))


def partial_rope(x, pos):
    half = ROPE_DIM // 2
    inv_freq = ROPE_THETA ** (-jnp.arange(half, dtype=F32) / half)
    ang = pos.astype(F32)[:, None] * inv_freq
    cos, sin = jnp.cos(ang)[:, None, :], jnp.sin(ang)[:, None, :]
    x1, x2, xp = x[..., :half], x[..., half:ROPE_DIM], x[..., ROPE_DIM:]
    rot = jnp.concatenate([x1 * cos - x2 * sin, x2 * cos + x1 * sin], axis=-1)
    return jnp.concatenate([rot.astype(x.dtype), xp], axis=-1)


def masked_softmax(s, mask):
    s = jnp.where(mask, s.astype(F32), -jnp.inf)
    m = jnp.max(s, axis=-1, keepdims=True)
    m = jnp.where(jnp.isfinite(m), m, 0.0)
    e = jnp.where(mask, jnp.exp(s - m), 0.0)
    return e / jnp.maximum(e.sum(-1, keepdims=True), jnp.finfo(F32).tiny)


def rwkv7_mix(p, mu, w0, w2, a0, a2, g2, k_k, k_a, r_k, gn_g, gn_b):
    B, S, _ = p.shape
    dt = p.dtype
    p = p + (token_shift(p) - p) * mu
    r, k, v, wl, al, gl = jnp.split(p, RW_SPLITS, axis=-1)
    w = -jax.nn.softplus(-(w0 + jnp.tanh(wl) @ w2).astype(F32)) - 0.5
    decay = jnp.exp(-jnp.exp(w))
    a = jax.nn.sigmoid((a0 + al @ a2).astype(F32))
    g = jax.nn.sigmoid(gl) @ g2

    def heads(t):
        return t.astype(F32).reshape(B, S, RW_HEADS, HEAD_DIM)

    kk = heads(k * k_k)
    kk = kk / jnp.maximum(jnp.linalg.norm(kk, axis=-1, keepdims=True), 1e-12)
    k_mod = k.astype(F32) * (1.0 + (a - 1.0) * k_a)
    r_h, k_h, v_h, w_h, a_h = heads(r), heads(k_mod), heads(v), heads(decay), heads(a)

    def step(state, inp):
        r_t, w_t, k_t, v_t, kk_t, a_t = inp
        sa = jnp.einsum('bhvk,bhk->bhv', state, kk_t)
        state = (state * w_t[:, :, None, :]
                 - sa[..., None] * (kk_t * a_t)[:, :, None, :]
                 + v_t[..., :, None] * k_t[..., None, :])
        return state, jnp.einsum('bhvk,bhk->bhv', state, r_t)

    xs = tuple(jnp.moveaxis(t, 1, 0) for t in (r_h, w_h, k_h, v_h, kk, a_h))
    state0 = jnp.zeros((B, RW_HEADS, HEAD_DIM, HEAD_DIM), F32)
    _, y = lax.scan(step, state0, xs)
    y = jnp.moveaxis(y, 0, 1)
    ym = y.mean(-1, keepdims=True)
    yv = jnp.square(y - ym).mean(-1, keepdims=True)
    y = ((y - ym) * lax.rsqrt(yv + RW_GN_EPS)).reshape(B, S, D_RWKV) * gn_g + gn_b
    bonus = (jnp.sum(r_h * k_h * r_k, axis=-1, keepdims=True) * v_h).reshape(B, S, D_RWKV)
    return ((y + bonus) * g).astype(dt)


def pool_mix(p, pool_w, pool_b, pool_scale):
    B, S, _ = p.shape
    n_g = len(POOL_WINDOWS)
    pf = p.astype(F32).reshape(B, S, n_g, POOL_GROUP)
    cs = jnp.cumsum(pf, axis=1)
    t1 = jnp.arange(1, S + 1, dtype=F32)
    pooled = []
    for gi, win in enumerate(POOL_WINDOWS):
        c = cs[:, :, gi]
        lagged = jnp.pad(c, ((0, 0), (win, 0), (0, 0)))[:, :S]
        count = jnp.minimum(t1, float(win))[None, :, None]
        pooled.append((c - lagged) / count - pf[:, :, gi])
    z = jnp.stack(pooled, axis=2)
    z = jnp.einsum('bsgc,gcd->bsgd', z, pool_w) + pool_b.reshape(n_g, POOL_GROUP)
    z = z * pool_scale.reshape(n_g, POOL_GROUP)
    return z.reshape(B, S, D_POOL).astype(p.dtype)


def compress(blocks, pe, w1, w2):
    h = jnp.einsum('bnlhd,ldf->bnhf', blocks + pe[:, None, :], w1)
    return jax.nn.gelu(h) @ w2


def nsa_mix(p, pos, cmp_pe_k, cmp_pe_v, cmp_k_w1, cmp_k_w2, cmp_v_w1, cmp_v_w2, gate_b):
    B, S, _ = p.shape
    dt = p.dtype
    q, kc, vc, ks, vs, kw, vw, gl = jnp.split(p, NSA_SPLITS, axis=-1)
    kv_shape = (B, S, NSA_KV_HEADS, HEAD_DIM)
    q = partial_rope(q.reshape(B, S, NSA_HEADS, HEAD_DIM), pos)
    q = q.reshape(B, S, NSA_KV_HEADS, NSA_GQA, HEAD_DIM) * (HEAD_DIM ** -0.5)
    kc, vc, vs, vw = (t.reshape(kv_shape) for t in (kc, vc, vs, vw))
    ks = partial_rope(ks.reshape(kv_shape), pos)
    kw = partial_rope(kw.reshape(kv_shape), pos)
    gates = jax.nn.sigmoid((gl + gate_b).astype(F32)).reshape(B, S, NSA_KV_HEADS, NSA_GQA, 3)

    n_cmp = (S - CMP_BLOCK) // CMP_STRIDE + 1
    cmp_start = np.arange(n_cmp) * CMP_STRIDE
    cmp_idx = cmp_start[:, None] + np.arange(CMP_BLOCK)[None, :]
    cmp_end = cmp_start + CMP_BLOCK - 1
    k_cmp = compress(kc[:, cmp_idx], cmp_pe_k, cmp_k_w1, cmp_k_w2)
    v_cmp = compress(vc[:, cmp_idx], cmp_pe_v, cmp_v_w1, cmp_v_w2)
    k_cmp = partial_rope(k_cmp, jnp.asarray(cmp_end))
    s_cmp = jnp.einsum('bshgd,bnhd->bshgn', q, k_cmp)
    mask_cmp = (jnp.asarray(cmp_end)[None, :] <= pos[:, None])[None, :, None, None, :]
    p_cmp = masked_softmax(s_cmp, mask_cmp)
    o_cmp = jnp.einsum('bshgn,bnhd->bshgd', p_cmp.astype(dt), v_cmp)

    n_sel = S // SEL_BLOCK
    k_sel = min(SEL_TOPK, n_sel)
    sel_start = np.arange(n_sel) * SEL_BLOCK
    overlap = np.clip(np.minimum(cmp_start[:, None] + CMP_BLOCK, sel_start[None, :] + SEL_BLOCK)
                      - np.maximum(cmp_start[:, None], sel_start[None, :]), 0, None) / CMP_BLOCK
    imp = jnp.einsum('bshgn,nj->bshj', p_cmp, jnp.asarray(overlap, F32))
    blk = jnp.arange(n_sel)[None, :]
    cur = (pos // SEL_BLOCK)[:, None]
    forced = (blk == 0) | (blk == cur) | (blk == cur - 1)
    score = jnp.where(forced[None, :, None, :], FORCE_SCORE, imp)
    score = jnp.where((blk <= cur)[None, :, None, :], score, -jnp.inf)
    top_val, top_idx = lax.top_k(score, k_sel)
    top_ok = top_val > -jnp.inf
    ks_blk = ks.reshape(B, n_sel, SEL_BLOCK, NSA_KV_HEADS, HEAD_DIM).transpose(0, 3, 1, 2, 4)
    vs_blk = vs.reshape(B, n_sel, SEL_BLOCK, NSA_KV_HEADS, HEAD_DIM).transpose(0, 3, 1, 2, 4)
    nc = S // SEL_Q_CHUNK
    b_ix = jnp.arange(B)[:, None, None, None]
    h_ix = jnp.arange(NSA_KV_HEADS)[None, None, :, None]
    tok = jnp.arange(SEL_BLOCK)

    def chunk_first(t):
        return jnp.moveaxis(t.reshape(B, nc, SEL_Q_CHUNK, *t.shape[2:]), 1, 0)

    def sel_chunk(args):
        qc, idx, ok, qpos = args
        kg = ks_blk[b_ix, h_ix, idx]
        vg = vs_blk[b_ix, h_ix, idx]
        kpos = idx[..., None] * SEL_BLOCK + tok
        mask = ok[..., None] & (kpos <= qpos[None, :, None, None, None])
        s = jnp.einsum('bchgd,bchkld->bchgkl', qc, kg)
        pr = masked_softmax(s.reshape(*s.shape[:4], -1), mask.reshape(*mask.shape[:3], 1, -1))
        return jnp.einsum('bchgn,bchnd->bchgd', pr.astype(dt),
                          vg.reshape(*vg.shape[:3], -1, HEAD_DIM))

    o_sel = lax.map(sel_chunk, (chunk_first(q), chunk_first(top_idx), chunk_first(top_ok),
                                pos.reshape(nc, SEL_Q_CHUNK)))
    o_sel = jnp.moveaxis(o_sel, 0, 1).reshape(B, S, NSA_KV_HEADS, NSA_GQA, HEAD_DIM)

    n_qb = S // Q_BLOCK
    span = WINDOW + Q_BLOCK
    win_idx = np.arange(n_qb)[:, None] * Q_BLOCK + np.arange(span)[None, :]
    pad = ((0, 0), (WINDOW, 0), (0, 0), (0, 0))
    kb = jnp.pad(kw, pad)[:, win_idx]
    vb = jnp.pad(vw, pad)[:, win_idx]
    kpos = (win_idx - WINDOW)[:, None, :]
    qpos = np.arange(S).reshape(n_qb, Q_BLOCK)[:, :, None]
    mask_w = (kpos >= 0) & (kpos <= qpos) & (kpos > qpos - WINDOW)
    qb = q.reshape(B, n_qb, Q_BLOCK, NSA_KV_HEADS, NSA_GQA, HEAD_DIM)
    s_w = jnp.einsum('bnqhgd,bnkhd->bnhgqk', qb, kb)
    p_w = masked_softmax(s_w, jnp.asarray(mask_w)[None, :, None, None])
    o_win = jnp.einsum('bnhgqk,bnkhd->bnqhgd', p_w.astype(dt), vb)
    o_win = o_win.reshape(B, S, NSA_KV_HEADS, NSA_GQA, HEAD_DIM)

    o = gates[..., 0:1] * o_cmp + gates[..., 1:2] * o_sel + gates[..., 2:3] * o_win
    return o.reshape(B, S, D_NSA).astype(dt)


def setup_inputs(seed: int = 0) -> dict:
    key = jax.random.key(seed)
    keys = iter(jax.random.split(key, 48))
    L = DEPTH

    def nrm(shape, scale):
        return scale * jax.random.normal(next(keys), shape, F32)

    def unif(shape, lo, hi):
        return jax.random.uniform(next(keys), shape, F32, lo, hi)

    return {
        "x": nrm((BATCH, SEQ, D_MODEL), 1.0),
        "ffn1_w_up": nrm((L, D_MODEL, 2 * D_FF), D_MODEL ** -0.5),
        "ffn1_w_down": nrm((L, D_FF, D_MODEL), BETA * D_FF ** -0.5),
        "ln1_g": 1.0 + nrm((L, D_MODEL), 0.02),
        "ln1_b": nrm((L, D_MODEL), 0.02),
        "w_in": nrm((L, D_MODEL, IN_COLS), D_MODEL ** -0.5),
        "rw_mu": unif((L, RW_COLS), 0.0, 1.0),
        "rw_w0": unif((L, D_RWKV), -6.0, -1.0),
        "rw_w2": nrm((L, RW_DECAY_LORA, D_RWKV), RW_DECAY_LORA ** -0.5),
        "rw_a0": nrm((L, D_RWKV), 0.1),
        "rw_a2": nrm((L, RW_A_LORA, D_RWKV), RW_A_LORA ** -0.5),
        "rw_g2": nrm((L, RW_GATE_LORA, D_RWKV), RW_GATE_LORA ** -0.5),
        "rw_k_k": 0.85 + nrm((L, D_RWKV), 0.02),
        "rw_k_a": 1.0 + nrm((L, D_RWKV), 0.02),
        "rw_r_k": nrm((L, RW_HEADS, HEAD_DIM), 0.1),
        "rw_gn_g": 1.0 + nrm((L, D_RWKV), 0.02),
        "rw_gn_b": nrm((L, D_RWKV), 0.02),
        "pool_w": nrm((L, len(POOL_WINDOWS), POOL_GROUP, POOL_GROUP), POOL_GROUP ** -0.5),
        "pool_b": nrm((L, D_POOL), 0.02),
        "pool_scale": 1.0 + nrm((L, D_POOL), 0.1),
        "nsa_cmp_pe_k": nrm((L, CMP_BLOCK, HEAD_DIM), 0.02),
        "nsa_cmp_pe_v": nrm((L, CMP_BLOCK, HEAD_DIM), 0.02),
        "nsa_cmp_k_w1": nrm((L, CMP_BLOCK, HEAD_DIM, CMP_HIDDEN), (CMP_BLOCK * HEAD_DIM) ** -0.5),
        "nsa_cmp_k_w2": nrm((L, CMP_HIDDEN, HEAD_DIM), CMP_HIDDEN ** -0.5),
        "nsa_cmp_v_w1": nrm((L, CMP_BLOCK, HEAD_DIM, CMP_HIDDEN), (CMP_BLOCK * HEAD_DIM) ** -0.5),
        "nsa_cmp_v_w2": nrm((L, CMP_HIDDEN, HEAD_DIM), CMP_HIDDEN ** -0.5),
        "nsa_gate_b": nrm((L, 3 * NSA_HEADS), 0.1),
        "w_out": nrm((L, D_MIX, D_MODEL), BETA * D_MIX ** -0.5),
        "ln2_g": 1.0 + nrm((L, D_MODEL), 0.02),
        "ln2_b": nrm((L, D_MODEL), 0.02),
        "ffn2_w_up": nrm((L, D_MODEL, 2 * D_FF), D_MODEL ** -0.5),
        "ffn2_w_down": nrm((L, D_FF, D_MODEL), BETA * D_FF ** -0.5),
        "ln3_g": 1.0 + nrm((L, D_MODEL), 0.02),
        "ln3_b": nrm((L, D_MODEL), 0.02),
    }


def reference(x, ffn1_w_up, ffn1_w_down, ln1_g, ln1_b, w_in, rw_mu, rw_w0, rw_w2, rw_a0,
              rw_a2, rw_g2, rw_k_k, rw_k_a, rw_r_k, rw_gn_g, rw_gn_b, pool_w, pool_b,
              pool_scale, nsa_cmp_pe_k, nsa_cmp_pe_v, nsa_cmp_k_w1, nsa_cmp_k_w2,
              nsa_cmp_v_w1, nsa_cmp_v_w2, nsa_gate_b, w_out, ln2_g, ln2_b, ffn2_w_up,
              ffn2_w_down, ln3_g, ln3_b):
    pos = jnp.arange(x.shape[1])
    for l in range(DEPTH):
        x = layer_norm(ALPHA * x + 0.5 * swiglu(x, ffn1_w_up[l], ffn1_w_down[l]), ln1_g[l], ln1_b[l])
        p = x @ w_in[l]
        p_rw, p_pool, p_nsa = jnp.split(p, (RW_COLS, RW_COLS + D_POOL), axis=-1)
        y_rw = rwkv7_mix(p_rw, rw_mu[l], rw_w0[l], rw_w2[l], rw_a0[l], rw_a2[l], rw_g2[l],
                         rw_k_k[l], rw_k_a[l], rw_r_k[l], rw_gn_g[l], rw_gn_b[l])
        y_pool = pool_mix(p_pool, pool_w[l], pool_b[l], pool_scale[l])
        y_nsa = nsa_mix(p_nsa, pos, nsa_cmp_pe_k[l], nsa_cmp_pe_v[l], nsa_cmp_k_w1[l],
                        nsa_cmp_k_w2[l], nsa_cmp_v_w1[l], nsa_cmp_v_w2[l], nsa_gate_b[l])
        y = jnp.concatenate([y_rw, y_pool, y_nsa], axis=-1) @ w_out[l]
        x = layer_norm(ALPHA * x + y, ln2_g[l], ln2_b[l])
        x = layer_norm(ALPHA * x + 0.5 * swiglu(x, ffn2_w_up[l], ffn2_w_down[l]), ln3_g[l], ln3_b[l])
    return x
```

```cpp
#include <hip/hip_runtime.h>
#include <cstdio>
#include <cstdint>
namespace pg8 {
#define PG8_LAS __attribute__((address_space(3)))
typedef unsigned short bf16_t;
typedef short bf16x8 __attribute__((ext_vector_type(8)));
typedef float f32x4 __attribute__((ext_vector_type(4)));
typedef unsigned u32x4 __attribute__((ext_vector_type(4)));
constexpr int BM = 256, BK = 64, HALF = 128, HTB = HALF * BK * 2  , STAGE_BYTES = 8 * HTB, NXCD = 8, WGM = 8;

__host__ __device__ __forceinline__ int lds_byte(int r, int c) { const int st = (r >> 4) * 2 + (c >> 5), rr = r & 15, cc = c & 31, ob = rr * 64 + cc * 2; return st * 1024 + (ob ^ (((ob >> 9) & 1) << 5)); }
__host__ __device__ __forceinline__ void stage_rc(int b, int& R, int& C) { const int st = b / 1024, sb = b % 1024, swz = sb ^ (((sb >> 9) & 1) << 5); R = (st >> 1) * 16 + swz / 64; C = (st & 1) * 32 + (swz % 64) / 2; }
__host__ __device__ __forceinline__ int perm32(int rho) { const int n = rho >> 4, i = rho & 15; return 8 * (i >> 2) + 4 * n + (i & 3); }

struct Unit { int pm, pn; };
struct Gemm { const bf16_t* A; const bf16_t* Bt; int M, N, K; };

struct StaticOrder {
    int nM, nN, nwg, G, c;
    __host__ __device__ void init(int M, int N, int G_, int c_) { nM = M / BM; nN = N / BM; nwg = nM * nN; G = G_; c = c_; }
    __host__ __device__ bool next(int i, Unit& u) const {
        const long L = (long)i * G + c; if (L >= nwg) return false;
        int wgid = (int)L; { const int q = nwg / NXCD, r = nwg % NXCD, xcd = wgid % NXCD, off = wgid / NXCD; wgid = (xcd < r ? xcd * (q + 1) : r * (q + 1) + (xcd - r) * q) + off; }
        const int nig = WGM * nN, gid = wgid / nig, fm = gid * WGM, gsz = (nM - fm) < WGM ? (nM - fm) : WGM;
        u.pm = fm + ((wgid % nig) % gsz); u.pn = (wgid % nig) / gsz; return true;
    }
    __device__ __forceinline__ void a_ready(const Unit&) const {}
    __device__ __forceinline__ void done(const Unit&) const {}
};

__device__ __forceinline__ unsigned cvt_pk_bf16(float lo, float hi) { unsigned r; asm volatile("v_cvt_pk_bf16_f32 %0, %1, %2" : "=v"(r) : "v"(lo), "v"(hi)); return r; }
typedef float f32x2 __attribute__((ext_vector_type(2)));
struct EpiSwiGLU {
    static constexpr bool PERM = true, AFTER_DRAIN = false;
    bf16_t* H; int ldh;
    __device__ __forceinline__ void operator()(const f32x4 (&acc)[2][2][4][2], const Unit& u, int wr, int wc, int fr, int fq) const {
        const int row0 = u.pm * BM + wr * 64 + fr, col0 = u.pn * HALF + wc * 32 + 8 * fq;
#pragma unroll
        for (int ai = 0; ai < 2; ++ai)
#pragma unroll
            for (int m = 0; m < 4; ++m) { bf16_t* rowp = H + (size_t)(row0 + ai * HALF + m * 16) * ldh + col0;
                float hv[8];
#pragma unroll
                for (int n = 0; n < 2; ++n)
#pragma unroll
                    for (int i = 0; i < 4; ++i) { const float a = acc[ai][0][m][n][i], b = acc[ai][1][m][n][i];
                        const float e = __builtin_amdgcn_exp2f(a * -1.44269504089f); hv[n * 4 + i] = a * __builtin_amdgcn_rcpf(1.0f + e) * b; }
                u32x4 w; w.x = cvt_pk_bf16(hv[0], hv[1]); w.y = cvt_pk_bf16(hv[2], hv[3]); w.z = cvt_pk_bf16(hv[4], hv[5]); w.w = cvt_pk_bf16(hv[6], hv[7]);
                *(u32x4*)rowp = w; }
    }
};
struct EpiResid {
    static constexpr bool PERM = false, AFTER_DRAIN = false;
    const float* X; float* Y; int ldc; float alpha, s;
    __device__ __forceinline__ void operator()(const f32x4 (&acc)[2][2][4][2], const Unit& u, int wr, int wc, int fr, int fq) const {
        const int row0 = u.pm * BM + wr * 64 + fr, col0 = u.pn * BM + wc * 32 + 4 * fq;
#pragma unroll
        for (int ai = 0; ai < 2; ++ai)
#pragma unroll
            for (int m = 0; m < 4; ++m) { const size_t off = (size_t)(row0 + ai * HALF + m * 16) * ldc + col0;
#pragma unroll
                for (int bj = 0; bj < 2; ++bj)
#pragma unroll
                    for (int n = 0; n < 2; ++n) { const f32x4 xv = *(const f32x4*)(X + off + bj * HALF + n * 16); *(f32x4*)(Y + off + bj * HALF + n * 16) = xv * alpha + acc[ai][bj][m][n] * s; }
                asm volatile("" ::: "memory"); }
    }
};
struct EpiF32 {
    static constexpr bool PERM = false, AFTER_DRAIN = false;
    float* C; int ldc;
    __device__ __forceinline__ void operator()(const f32x4 (&acc)[2][2][4][2], const Unit& u, int wr, int wc, int fr, int fq) const {
        const int row0 = u.pm * BM + wr * 64 + fr, col0 = u.pn * BM + wc * 32 + 4 * fq;
#pragma unroll
        for (int ai = 0; ai < 2; ++ai)
#pragma unroll
            for (int m = 0; m < 4; ++m) { float* rowp = C + (size_t)(row0 + ai * HALF + m * 16) * ldc + col0;
#pragma unroll
                for (int bj = 0; bj < 2; ++bj)
#pragma unroll
                    for (int n = 0; n < 2; ++n) *(f32x4*)(rowp + bj * HALF + n * 16) = acc[ai][bj][m][n]; }
    }
};

template <class Epi, class Sched, bool ALIGN_EPI = false, bool SP2 = false>
__device__ __forceinline__ void gemm_phase(PG8_LAS unsigned char* lds, const Gemm g, const Sched& S, const Epi& E) {
    const int tid = threadIdx.x, wid = __builtin_amdgcn_readfirstlane(tid >> 6), lane = tid & 63, wr = wid >> 2, wc = wid & 3, fr = lane & 15, fq = lane >> 4;
    const int K = g.K, nt = K / BK;
    unsigned voffA[2], voffB[2];
#pragma unroll
    for (int i = 0; i < 2; ++i) { int R, C; stage_rc(tid * 16 + i * 8192, R, C); const int Rb = Epi::PERM ? ((R & ~31) + perm32(R & 31)) : R;
        voffA[i] = (unsigned)(R * K + C) * 2u; voffB[i] = (unsigned)(Rb * K + C) * 2u; }
    const size_t kstep = (size_t)(BK * 2);
    const size_t hstep = (size_t)HALF * K * 2;
    const size_t tstep = 2 * hstep;
    const unsigned ldsw = (unsigned)wid * 1024u;
    const int aoff = lds_byte(wr * 64 + fr, fq * 8), boff = lds_byte(wc * 32 + fr, fq * 8);
#define PG8_SA(b, h) (((b) * 2 + (h)) * HTB)
#define PG8_SB(b, h) ((4 + (b) * 2 + (h)) * HTB)
#define PG8_STAGE(bufoff, gbase, voff) do { _Pragma("unroll") for (int _i = 0; _i < 2; ++_i) \
        __builtin_amdgcn_global_load_lds((const unsigned*)((const char*)(gbase) + (voff)[_i]), (PG8_LAS unsigned*)(lds + (bufoff) + ldsw + _i * 8192), 16, 0, 0); } while (0)
#define PG8_LDA(dst, b, h) do { _Pragma("unroll") for (int m = 0; m < 4; ++m) _Pragma("unroll") for (int k = 0; k < 2; ++k) dst[m][k] = *(const PG8_LAS bf16x8*)(lds + PG8_SA(b, h) + aoff + m * 2048 + k * 1024); } while (0)
#define PG8_LDB(dst, b, h) do { _Pragma("unroll") for (int n = 0; n < 2; ++n) _Pragma("unroll") for (int k = 0; k < 2; ++k) dst[n][k] = *(const PG8_LAS bf16x8*)(lds + PG8_SB(b, h) + boff + n * 2048 + k * 1024); } while (0)
#define PG8_MMA(ai, bj, At, Bt) do { __builtin_amdgcn_s_setprio(1); _Pragma("unroll") for (int m = 0; m < 4; ++m) _Pragma("unroll") for (int n = 0; n < 2; ++n) _Pragma("unroll") for (int k = 0; k < 2; ++k) \
        acc[ai][bj][m][n] = __builtin_amdgcn_mfma_f32_16x16x32_bf16(Bt[n][k], At[m][k], acc[ai][bj][m][n], 0, 0, 0); __builtin_amdgcn_s_setprio(0); } while (0)
#define PG8_WAIT_V(n) asm volatile("s_waitcnt vmcnt(" #n ")" ::: "memory")
#define PG8_WAIT_L(n) asm volatile("s_waitcnt lgkmcnt(" #n ")" ::: "memory")
#define PG8_BAR __builtin_amdgcn_s_barrier()
#define PG8_SCHED __builtin_amdgcn_sched_barrier(0)
    Unit cur, nxt; int ui = 0;
    if (!S.next(0, cur)) return;
    f32x4 acc[2][2][4][2];
#pragma unroll
    for (int a = 0; a < 2; ++a)
#pragma unroll
        for (int b = 0; b < 2; ++b)
#pragma unroll
            for (int m = 0; m < 4; ++m)
#pragma unroll
                for (int n = 0; n < 2; ++n) acc[a][b][m][n] = (f32x4){0.f, 0.f, 0.f, 0.f};
    bf16x8 At[4][2], B0[2][2], B1[2][2];
    const char* cA = (const char*)g.A + (size_t)cur.pm * tstep; const char* cB = (const char*)g.Bt + (size_t)cur.pn * tstep;
    S.a_ready(cur);
    if constexpr (SP2) {
        PG8_STAGE(PG8_SB(0, 0), cB, voffB); PG8_STAGE(PG8_SB(0, 1), cB + hstep, voffB); PG8_STAGE(PG8_SA(0, 0), cA, voffA); PG8_STAGE(PG8_SA(0, 1), cA + hstep, voffA);
        if (wr == 1) PG8_BAR;
        PG8_WAIT_V(2); PG8_BAR;
        PG8_STAGE(PG8_SB(1, 0), cB + kstep, voffB); PG8_STAGE(PG8_SA(1, 0), cA + kstep, voffA); PG8_STAGE(PG8_SB(1, 1), cB + hstep + kstep, voffB);
        PG8_WAIT_V(6); PG8_BAR;
    } else {
        PG8_STAGE(PG8_SB(0, 0), cB, voffB); PG8_STAGE(PG8_SA(0, 0), cA, voffA); PG8_STAGE(PG8_SB(0, 1), cB + hstep, voffB); PG8_STAGE(PG8_SA(0, 1), cA + hstep, voffA);
        if (wr == 1) PG8_BAR;
        PG8_WAIT_V(4); PG8_BAR;
        PG8_STAGE(PG8_SB(1, 0), cB + kstep, voffB); PG8_STAGE(PG8_SA(1, 0), cA + kstep, voffA); PG8_STAGE(PG8_SB(1, 1), cB + hstep + kstep, voffB);
        PG8_WAIT_V(6); PG8_BAR;
    }
    for (;;) {
        const bool has_next = S.next(ui + 1, nxt);
        const char* nA = has_next ? (const char*)g.A + (size_t)nxt.pm * tstep : cA; const char* nB = has_next ? (const char*)g.Bt + (size_t)nxt.pn * tstep : cB;
        for (int t = 0; t < nt; t += 2) {
            const bool last = (t == nt - 2);
            const char* a1 = cA + (size_t)(t + 1) * kstep;
            const char* a2 = last ? nA : cA + (size_t)(t + 2) * kstep; const char* b2 = last ? nB : cB + (size_t)(t + 2) * kstep;
            const char* a3 = a2 + kstep; const char* b3 = b2 + kstep;
            if (last && has_next) S.a_ready(nxt);
            if constexpr (SP2) {
            PG8_LDB(B0, 0, 0); PG8_LDB(B1, 0, 1); PG8_SCHED; PG8_LDA(At, 0, 0); PG8_STAGE(PG8_SA(1, 1), a1 + hstep, voffA);
            PG8_WAIT_V(8); PG8_WAIT_L(0); PG8_BAR; PG8_MMA(0, 0, At, B0); PG8_MMA(0, 1, At, B1); PG8_BAR; PG8_SCHED;
            PG8_LDA(At, 0, 1); PG8_STAGE(PG8_SB(0, 0), b2, voffB); PG8_STAGE(PG8_SB(0, 1), b2 + hstep, voffB); PG8_STAGE(PG8_SA(0, 0), a2, voffA);
            PG8_WAIT_V(8); PG8_WAIT_L(0); PG8_BAR; PG8_MMA(1, 0, At, B0); PG8_MMA(1, 1, At, B1); PG8_BAR; PG8_SCHED;
            PG8_LDB(B0, 1, 0); PG8_LDB(B1, 1, 1); PG8_SCHED; PG8_LDA(At, 1, 0); PG8_STAGE(PG8_SA(0, 1), a2 + hstep, voffA);
            PG8_WAIT_V(8); PG8_WAIT_L(0); PG8_BAR; PG8_MMA(0, 0, At, B0); PG8_MMA(0, 1, At, B1); PG8_BAR; PG8_SCHED;
            PG8_LDA(At, 1, 1); PG8_STAGE(PG8_SB(1, 0), b3, voffB); PG8_STAGE(PG8_SB(1, 1), b3 + hstep, voffB); PG8_STAGE(PG8_SA(1, 0), a3, voffA);
            PG8_WAIT_V(8); PG8_WAIT_L(0); PG8_BAR; PG8_MMA(1, 0, At, B0); PG8_MMA(1, 1, At, B1); PG8_BAR; PG8_SCHED;
            } else {
            PG8_LDB(B0, 0, 0); PG8_SCHED; PG8_LDA(At, 0, 0); PG8_STAGE(PG8_SA(1, 1), a1 + hstep, voffA);
            PG8_WAIT_L(8); PG8_BAR; PG8_WAIT_L(0); PG8_MMA(0, 0, At, B0); PG8_BAR; PG8_SCHED;
            PG8_LDB(B1, 0, 1); PG8_STAGE(PG8_SB(0, 0), b2, voffB);
            PG8_BAR; PG8_WAIT_L(0); PG8_MMA(0, 1, At, B1); PG8_BAR;
            PG8_LDA(At, 0, 1); PG8_STAGE(PG8_SA(0, 0), a2, voffA);
            PG8_BAR; PG8_WAIT_L(0); PG8_MMA(1, 0, At, B0); PG8_BAR; PG8_SCHED;
            PG8_STAGE(PG8_SB(0, 1), b2 + hstep, voffB);
            PG8_WAIT_V(6); PG8_BAR; PG8_MMA(1, 1, At, B1); PG8_BAR;
            PG8_LDB(B0, 1, 0); PG8_SCHED; PG8_LDA(At, 1, 0); PG8_STAGE(PG8_SA(0, 1), a2 + hstep, voffA);
            PG8_WAIT_L(8); PG8_BAR; PG8_WAIT_L(0); PG8_MMA(0, 0, At, B0); PG8_BAR; PG8_SCHED;
            PG8_LDB(B1, 1, 1); PG8_STAGE(PG8_SB(1, 0), b3, voffB);
            PG8_BAR; PG8_WAIT_L(0); PG8_MMA(0, 1, At, B1); PG8_BAR;
            PG8_LDA(At, 1, 1); PG8_STAGE(PG8_SA(1, 0), a3, voffA);
            PG8_BAR; PG8_WAIT_L(0); PG8_MMA(1, 0, At, B0); PG8_BAR; PG8_SCHED;
            PG8_STAGE(PG8_SB(1, 1), b3 + hstep, voffB);
            PG8_WAIT_V(6); PG8_BAR; PG8_MMA(1, 1, At, B1); PG8_BAR;
            }
        }
        if constexpr (ALIGN_EPI) { if (wr == 0) PG8_BAR; }
        if constexpr (!Epi::AFTER_DRAIN) { E(acc, cur, wr, wc, fr, fq); S.done(cur); }
        if (!has_next) break;
#pragma unroll
        for (int a = 0; a < 2; ++a)
#pragma unroll
            for (int b = 0; b < 2; ++b)
#pragma unroll
                for (int m = 0; m < 4; ++m)
#pragma unroll
                    for (int n = 0; n < 2; ++n) acc[a][b][m][n] = (f32x4){0.f, 0.f, 0.f, 0.f};
        cur = nxt; cA = nA; cB = nB; ++ui;
        if constexpr (ALIGN_EPI) { if (wr == 1) PG8_BAR; }
    }
    PG8_WAIT_V(0);
    if constexpr (!ALIGN_EPI) { if (wr == 0) PG8_BAR; }
    PG8_BAR;
    if constexpr (Epi::AFTER_DRAIN) { E.fused(acc, cur, wr, wc, fr, fq, lds, wid, lane); S.done(cur); }
#undef PG8_SA
#undef PG8_SB
#undef PG8_STAGE
#undef PG8_LDA
#undef PG8_LDB
#undef PG8_MMA
#undef PG8_WAIT_V
#undef PG8_WAIT_L
#undef PG8_BAR
#undef PG8_SCHED
}
}

constexpr int NWAVES = 8, NTHR = 512;
constexpr int NB = 4, SEQ = 4096, DM = 2048, MTOK = NB * SEQ, NLAYER = 4;
constexpr int DFF = 5504, NUP = 2 * DFF;
constexpr int INC = 5028, INP = 5120;
constexpr int DRW = 768, RWC = 2560, PO_POOL = 2560, DPOOL = 512, PO_NSA = 3072;
constexpr int PO_Q = PO_NSA, PO_KC = PO_NSA + 768, PO_VC = PO_KC + 192, PO_KS = PO_VC + 192, PO_VS = PO_KS + 192, PO_KW = PO_VS + 192, PO_VW = PO_KW + 192, PO_GL = PO_VW + 192;
static_assert(PO_GL + 36 == INC, "W_in column map");
constexpr int NCMP = 255, NCMPP = 256;
constexpr float ALPHA = 1.6817928305074290f;
constexpr float LN_EPS = 1e-5f, GN_EPS = 64e-5f;
constexpr int NPH = 1 + 13 * NLAYER;

constexpr size_t MiB = 1u << 20;
constexpr size_t WS_CTL = 0, CTL_ZERO_BYTES = 1 * MiB;
constexpr size_t WS_ROPE = 1 * MiB;
constexpr size_t WS_KC = 2 * MiB, WS_VC = 2 * MiB + 512 * 1024;
constexpr size_t WS_SC = 3 * MiB;
constexpr size_t WS_WUP1 = 8 * MiB, WS_WDN1 = 51 * MiB, WS_WIN = WS_WDN1 + 21 * MiB + 512 * 1024, WS_WOUT = WS_WIN + 20 * MiB, WS_WUP2 = WS_WOUT + 8 * MiB, WS_WDN2 = WS_WUP2 + 43 * MiB;
constexpr size_t WS_XB = 165 * MiB;
static_assert(WS_WDN2 + (size_t)DM * DFF * 2 <= WS_XB, "weights map");
constexpr size_t WS_CAT = 229 * MiB;
constexpr size_t WS_QR = 293 * MiB;
constexpr size_t WS_KS = 317 * MiB, WS_KW = 323 * MiB, WS_VS = 329 * MiB, WS_VW = 335 * MiB;
constexpr size_t WS_P = 341 * MiB;
constexpr size_t WS_H = 661 * MiB;
constexpr size_t WS_Y = 833 * MiB;
constexpr size_t WS_SV = WS_H;
constexpr size_t SV_STRIDE = 48 * MiB;
static_assert(WS_SV + 6 * SV_STRIDE <= WS_Y + 128 * MiB, "scan overlay");
constexpr size_t WS_G = 961 * MiB, WS_YS = 1009 * MiB, WS_END = 1057 * MiB;

constexpr int LDS_BYTES = 147456, MISC_OFF = 131072 + 320;

#define GAS __attribute__((address_space(1)))
#define LAS __attribute__((address_space(3)))
typedef unsigned short bf16;
typedef float f32x4 __attribute__((ext_vector_type(4)));
typedef float f32x2 __attribute__((ext_vector_type(2)));
typedef unsigned u32x4 __attribute__((ext_vector_type(4)));
typedef unsigned u32x2 __attribute__((ext_vector_type(2)));
#define LDS_WAIT() asm volatile("s_waitcnt lgkmcnt(0)" ::: "memory")
__device__ __forceinline__ unsigned f2bf(float f) { unsigned u = __builtin_bit_cast(unsigned, f); return (u + 0x7fffu + ((u >> 16) & 1u)) >> 16; }
__device__ __forceinline__ unsigned pk2(float lo, float hi) { return f2bf(lo) | (f2bf(hi) << 16); }
__device__ __forceinline__ float bf2f(unsigned short b) { return __builtin_bit_cast(float, ((unsigned)b) << 16); }
__device__ __forceinline__ float wave_sum(float v) {
#pragma unroll
    for (int o = 1; o < 64; o <<= 1) v += __shfl_xor(v, o);
    return v;
}
__device__ __forceinline__ float wave_max(float v) {
#pragma unroll
    for (int o = 1; o < 64; o <<= 1) v = fmaxf(v, __shfl_xor(v, o));
    return v;
}
__device__ __forceinline__ float sigmoidf_(float x) { return 1.0f / (1.0f + expf(-x)); }
template <int CTRL> __device__ __forceinline__ float dpp_f(float v) { return __builtin_bit_cast(float, __builtin_amdgcn_update_dpp(0, __builtin_bit_cast(int, v), CTRL, 0xF, 0xF, true)); }
__device__ __forceinline__ float row16_sum(float v) {
    v += dpp_f<0xB1>(v); v += dpp_f<0x4E>(v); v += dpp_f<0x141>(v); v += dpp_f<0x140>(v); return v;
}

#define XB_TMO      128
#define XB_XCNT(j)  (256  + 64 * (j))
#define XB_XSUB(j)  (1280 + 64 * (j))
#define XB_XGEN(j)  (2304 + 64 * (j))
#define XB_TOP      3328
#define XB_TOPGEN   3392
#define XCD_BAR_WORDS 3456
#define XB_SPIN_CAP (1u << 18)

__device__ __forceinline__ unsigned xb_ld(unsigned* p)              { return __hip_atomic_load(p, __ATOMIC_RELAXED, __HIP_MEMORY_SCOPE_AGENT); }
__device__ __forceinline__ unsigned xb_add(unsigned* p, unsigned v) { return __hip_atomic_fetch_add(p, v, __ATOMIC_RELAXED, __HIP_MEMORY_SCOPE_AGENT); }
__device__ __forceinline__ unsigned xb_xcc_id() { return (unsigned)__builtin_amdgcn_s_getreg((3 << 11) | 20) & 0xFu; }
#define XB_SPIN(cond, bar) do { unsigned _sp = 0; while (cond) { __builtin_amdgcn_s_sleep(1); \
    if ((++_sp & 255u) == 0u) { if (xb_ld(&(bar)[XB_TMO])) break; if (_sp > XB_SPIN_CAP) { atomicAdd(&(bar)[XB_TMO], 1u); break; } } } } while (0)

struct XcdBarrier {
    unsigned* bar; unsigned x;
    volatile LAS unsigned* st;
};

__device__ __forceinline__ XcdBarrier xcd_barrier_post(unsigned* bar, volatile LAS unsigned* st) {
    XcdBarrier b; b.bar = bar; b.x = xb_xcc_id(); b.st = st;
    if (threadIdx.x == 0) (void)xb_add(&bar[XB_XCNT(b.x)], 1u);
    return b;
}
__device__ __forceinline__ void xcd_barrier_complete(unsigned* bar, unsigned x, unsigned& nloc, unsigned& nx) {
    const unsigned G = gridDim.x * gridDim.y * gridDim.z;
    unsigned sum, cnt, mine, sp = 0u;
    for (;;) {
        sum = 0u; cnt = 0u; mine = 0u;
#pragma unroll
        for (unsigned j = 0; j < 16; ++j) { const unsigned c = xb_ld(&bar[XB_XCNT(j)]); sum += c; cnt += (c > 0u) ? 1u : 0u; mine = (j == x) ? c : mine; }
        if (sum == G) break;
        __builtin_amdgcn_s_sleep(1);
        if ((++sp & 255u) == 0u) { if (xb_ld(&bar[XB_TMO])) break; if (sp > XB_SPIN_CAP) { atomicAdd(&bar[XB_TMO], 1u); break; } }
    }
    nloc = mine > 0u ? mine : 1u; nx = cnt > 0u ? cnt : 1u;
}

__device__ __forceinline__ void xcd_barrier(const XcdBarrier& b) {
    asm volatile("s_waitcnt vmcnt(0)" ::: "memory");
    __syncthreads();
    if (threadIdx.x == 0) {
        unsigned* bar = b.bar;
        __builtin_amdgcn_s_waitcnt(0);
        unsigned nloc = b.st[0], nx = b.st[1];
        if (nloc == 0u) { xcd_barrier_complete(bar, b.x, nloc, nx); b.st[0] = nloc; b.st[1] = nx; }
        const unsigned old = xb_add(&bar[XB_XSUB(b.x)], 1u);
        const unsigned gen = old / nloc;
        if (old + 1u == (gen + 1u) * nloc) {
            __builtin_amdgcn_fence(__ATOMIC_RELEASE, "agent");
            asm volatile("s_waitcnt vmcnt(0)" ::: "memory");
            const unsigned og = xb_add(&bar[XB_TOP], 1u);
            const unsigned tg = og / nx;
            if (og + 1u == (tg + 1u) * nx) xb_add(&bar[XB_TOPGEN], 1u);
            else XB_SPIN(xb_ld(&bar[XB_TOPGEN]) == tg, bar);
            __builtin_amdgcn_fence(__ATOMIC_ACQUIRE, "agent");
            xb_add(&bar[XB_XGEN(b.x)], 1u);
            asm volatile("s_waitcnt vmcnt(0)" ::: "memory");
        } else {
            XB_SPIN(xb_ld(&bar[XB_XGEN(b.x)]) == gen, bar);
            __builtin_amdgcn_fence(__ATOMIC_ACQUIRE, "agent");
            asm volatile("s_waitcnt vmcnt(0)" ::: "memory");
        }
    }
    __syncthreads();
}

struct Args { const float* in[34]; float* out; unsigned char* ws; int ph_lo, ph_hi; };
enum { I_X = 0, I_UP1, I_DN1, I_LN1G, I_LN1B, I_WIN, I_MU, I_W0, I_W2, I_A0, I_A2, I_G2, I_KK, I_KA, I_RK, I_GNG, I_GNB, I_PW, I_PB, I_PS, I_PEK, I_PEV, I_CK1, I_CK2, I_CV1, I_CV2, I_GB, I_WOUT, I_LN2G, I_LN2B, I_UP2, I_DN2, I_LN3G, I_LN3B };

__device__ __forceinline__ void transpose_item(const float* W, int K, int Nsrc, bf16* WT, int dst0, LAS float* scr, int k0, int n0, int lane) {
    const int n = n0 + (lane & 31); const bool ok = n < Nsrc;
#pragma unroll 8
    for (int i = 0; i < 32; ++i) { const int kk = 2 * i + (lane >> 5); scr[kk * 33 + (lane & 31)] = ok ? W[(size_t)(k0 + kk) * Nsrc + n] : 0.f; }
    LDS_WAIT();
    const int c = lane & 7;
#pragma unroll
    for (int j = 0; j < 4; ++j) { const int nn = (lane >> 3) + 8 * j; const LAS float* s = scr + (8 * c) * 33 + nn;
        u32x4 o; o.x = pk2(s[0 * 33], s[1 * 33]); o.y = pk2(s[2 * 33], s[3 * 33]); o.z = pk2(s[4 * 33], s[5 * 33]); o.w = pk2(s[6 * 33], s[7 * 33]);
        *(u32x4*)(WT + (size_t)(dst0 + nn) * K + k0 + 8 * c) = o; }
    LDS_WAIT();
}
__device__ __forceinline__ int up_dst_row(int n0) { return n0 < DFF ? 256 * (n0 / 128) + (n0 % 128) : 256 * ((n0 - DFF) / 128) + 128 + ((n0 - DFF) % 128); }

__device__ __forceinline__ void phase_wconv(const Args& a, int l, LAS unsigned char* lds, int gw, int NGW, int wave, int lane) {
    LAS float* scr = (LAS float*)(lds + wave * 16384);
    unsigned char* ws = a.ws;
    constexpr int I_UP = (DM / 64) * (NUP / 32), I_DN = (DFF / 64) * (DM / 32), I_IN = (DM / 64) * (INP / 32), I_OUT = (DM / 64) * (DM / 32);
    constexpr int NIT = 2 * I_UP + 2 * I_DN + I_IN + I_OUT;
    for (int it = gw; it < NIT; it += NGW) {
        int r = it;
        if (r < 2 * I_UP) { const int which = r / I_UP; r -= which * I_UP; const int nblk = NUP / 32, kb = r / nblk, nb = r % nblk;
            const float* W = a.in[which ? I_UP2 : I_UP1] + (size_t)l * DM * NUP; bf16* WT = (bf16*)(ws + (which ? WS_WUP2 : WS_WUP1));
            transpose_item(W, DM, NUP, WT, up_dst_row(32 * nb), scr, 64 * kb, 32 * nb, lane); continue; }
        r -= 2 * I_UP;
        if (r < 2 * I_DN) { const int which = r / I_DN; r -= which * I_DN; const int nblk = DM / 32, kb = r / nblk, nb = r % nblk;
            const float* W = a.in[which ? I_DN2 : I_DN1] + (size_t)l * DFF * DM; bf16* WT = (bf16*)(ws + (which ? WS_WDN2 : WS_WDN1));
            transpose_item(W, DFF, DM, WT, 32 * nb, scr, 64 * kb, 32 * nb, lane); continue; }
        r -= 2 * I_DN;
        if (r < I_IN) { const int nblk = INP / 32, kb = r / nblk, nb = r % nblk;
            transpose_item(a.in[I_WIN] + (size_t)l * DM * INC, DM, INC, (bf16*)(ws + WS_WIN), 32 * nb, scr, 64 * kb, 32 * nb, lane); continue; }
        r -= I_IN;
        { const int nblk = DM / 32, kb = r / nblk, nb = r % nblk;
            transpose_item(a.in[I_WOUT] + (size_t)l * DM * DM, DM, DM, (bf16*)(ws + WS_WOUT), 32 * nb, scr, 64 * kb, 32 * nb, lane); }
    }
}

__device__ __forceinline__ void phase_prologue(const Args& a, int gtid, int NGT) {
    const f32x4* x4 = (const f32x4*)a.in[I_X]; u32x2* xb = (u32x2*)(a.ws + WS_XB);
    for (size_t i = gtid; i < (size_t)MTOK * DM / 4; i += NGT) { const f32x4 v = x4[i]; u32x2 o; o.x = pk2(v.x, v.y); o.y = pk2(v.z, v.w); xb[i] = o; }
    f32x2* rope = (f32x2*)(a.ws + WS_ROPE);
    for (int i = gtid; i < SEQ * 8; i += NGT) { const int s = i >> 3, k = i & 7;
        const float inv = powf(500000.0f, -(float)k * 0.125f); const float ang = (float)s * inv;
        const double ad = (double)ang; const double q = __builtin_rint(ad * 0.15915494309189535); const double rr = ad - q * 6.283185307179586;
        const float rf = (float)rr; rope[i] = (f32x2){cosf(rf), sinf(rf)}; }
}

__device__ __forceinline__ void phase_ln(const float* Y, const float* g, const float* b, float* X, bf16* XB, int gw, int NGW, int lane) {
    f32x4 gv[8], bv[8];
#pragma unroll
    for (int j = 0; j < 8; ++j) { gv[j] = ((const f32x4*)g)[64 * j + lane]; bv[j] = ((const f32x4*)b)[64 * j + lane]; }
    for (int m = gw; m < MTOK; m += NGW) {
        const f32x4* yr = (const f32x4*)(Y + (size_t)m * DM) + lane; f32x4 v[8]; float s = 0.f;
#pragma unroll
        for (int j = 0; j < 8; ++j) { v[j] = yr[64 * j]; s += (v[j].x + v[j].y) + (v[j].z + v[j].w); }
        const float mean = wave_sum(s) * (1.f / DM); float s2 = 0.f;
#pragma unroll
        for (int j = 0; j < 8; ++j) { v[j] = v[j] - mean; s2 += (v[j].x * v[j].x + v[j].y * v[j].y) + (v[j].z * v[j].z + v[j].w * v[j].w); }
        const float rstd = 1.f / sqrtf(wave_sum(s2) * (1.f / DM) + LN_EPS);
        f32x4* xr = (f32x4*)(X + (size_t)m * DM) + lane; u32x2* xb = (u32x2*)(XB + (size_t)m * DM) + lane;
#pragma unroll
        for (int j = 0; j < 8; ++j) { const f32x4 o = v[j] * rstd * gv[j] + bv[j]; xr[64 * j] = o; u32x2 w; w.x = pk2(o.x, o.y); w.y = pk2(o.z, o.w); xb[64 * j] = w; }
    }
}

__device__ __forceinline__ void phase_m1(const Args& a, int l, LAS unsigned char* lds, int bid, int G, int tid, int wave, int lane) {
    unsigned char* ws = a.ws; const float* P = (const float*)(ws + WS_P);
    {
        LAS float* sps = (LAS float*)lds;
        LAS float* tl = sps + 4 * RWC;
        LAS float* sg = tl + 4 * 64;
        const float* mu = a.in[I_MU] + (size_t)l * RWC; const float* w0 = a.in[I_W0] + (size_t)l * DRW; const float* w2 = a.in[I_W2] + (size_t)l * 64 * DRW;
        const float* a0 = a.in[I_A0] + (size_t)l * DRW; const float* a2 = a.in[I_A2] + (size_t)l * 64 * DRW; const float* g2 = a.in[I_G2] + (size_t)l * 128 * DRW;
        const float* k_k = a.in[I_KK] + (size_t)l * DRW; const float* k_a = a.in[I_KA] + (size_t)l * DRW; const float* r_k = a.in[I_RK] + (size_t)l * DRW;
        float* vKK = (float*)(ws + WS_SV); float* vWR = (float*)(ws + WS_SV + SV_STRIDE); float* vW = (float*)(ws + WS_SV + 2 * SV_STRIDE);
        float* vKM = (float*)(ws + WS_SV + 3 * SV_STRIDE); float* vBB = (float*)(ws + WS_SV + 4 * SV_STRIDE); float* vV = (float*)(ws + WS_SV + 5 * SV_STRIDE);
        float* vG = (float*)(ws + WS_G); float* SC = (float*)(ws + WS_SC);
        for (int unit = bid; unit < MTOK / 4; unit += G) {
            const int t0 = unit * 4;
            for (int i = tid; i < 4 * RWC; i += NTHR) { const int tt = i / RWC, c = i - tt * RWC; const int m = t0 + tt; const int s = m & (SEQ - 1);
                const float pc = P[(size_t)m * INP + c]; const float pp = s > 0 ? P[(size_t)(m - 1) * INP + c] : 0.f; sps[i] = pc + (pp - pc) * mu[c]; }
            __syncthreads();
            for (int i = tid; i < 4 * 192; i += NTHR) { const int tt = i / 192, j = i - tt * 192;
                if (j < 64) tl[tt * 64 + j] = tanhf(sps[tt * RWC + 2304 + j]); else sg[tt * 128 + (j - 64)] = sigmoidf_(sps[tt * RWC + 2432 + (j - 64)]); }
            __syncthreads();
            for (int c = tid; c < DRW; c += NTHR) {
                float u[4] = {0.f, 0.f, 0.f, 0.f}, aa[4] = {0.f, 0.f, 0.f, 0.f}, gg[4] = {0.f, 0.f, 0.f, 0.f};
                for (int j = 0; j < 64; ++j) { const float w2v = w2[j * DRW + c], a2v = a2[j * DRW + c];
#pragma unroll
                    for (int tt = 0; tt < 4; ++tt) { u[tt] += tl[tt * 64 + j] * w2v; aa[tt] += sps[tt * RWC + 2368 + j] * a2v; } }
                for (int j = 0; j < 128; ++j) { const float g2v = g2[j * DRW + c];
#pragma unroll
                    for (int tt = 0; tt < 4; ++tt) gg[tt] += sg[tt * 128 + j] * g2v; }
                const float w0c = w0[c], a0c = a0[c], kkc = k_k[c], kac = k_a[c], rkc = r_k[c]; const int h = c >> 6;
#pragma unroll
                for (int tt = 0; tt < 4; ++tt) {
                    const size_t o = (size_t)(t0 + tt) * DRW + c;
                    const float uu = w0c + u[tt]; const float z = -uu; const float sp = z > 20.f ? z : log1pf(expf(z)); const float wlog = -sp - 0.5f; const float decay = expf(-expf(wlog));
                    const float av = sigmoidf_(a0c + aa[tt]);
                    const float r = sps[tt * RWC + c], k = sps[tt * RWC + 768 + c], v = sps[tt * RWC + 1536 + c];
                    const float kr = k * kkc; const float nrm = sqrtf(wave_sum(kr * kr)); const float kk = kr / fmaxf(nrm, 1e-12f);
                    const float km = k * (1.0f + (av - 1.0f) * kac); const float bb = kk * av;
                    vKK[o] = kk; vWR[o] = decay * r; vW[o] = decay; vKM[o] = km; vBB[o] = bb; vV[o] = v; vG[o] = gg[tt];
                    const float c1 = wave_sum(bb * r), c2 = wave_sum(km * r), bc = wave_sum(r * km * rkc);
                    if (lane == 0) *(f32x4*)(SC + ((size_t)(t0 + tt) * 12 + h) * 4) = (f32x4){c1, c2, bc, 0.f};
                }
            }
            __syncthreads();
        }
    }
    {
        LAS float* z = (LAS float*)lds;
        const float* pw = a.in[I_PW] + (size_t)l * 4 * 128 * 128; const float* pb = a.in[I_PB] + (size_t)l * DPOOL; const float* psc = a.in[I_PS] + (size_t)l * DPOOL;
        bf16* CAT = (bf16*)(ws + WS_CAT);
        for (int unit = bid; unit < MTOK / 4; unit += G) {
            const int t0 = unit * 4;
            for (int i = tid; i < 4 * DPOOL; i += NTHR) { const int tt = i >> 9, ch = i & 511, gi = ch >> 7; const int m = t0 + tt, s = m & (SEQ - 1); const int win = 2 << gi; const int cnt = (s + 1) < win ? (s + 1) : win;
                float sum = 0.f; for (int j = 0; j < cnt; ++j) sum += P[(size_t)(m - j) * INP + PO_POOL + ch];
                z[i] = sum / (float)cnt - P[(size_t)m * INP + PO_POOL + ch]; }
            __syncthreads();
            { const int gi = tid >> 7, d = tid & 127; float acc[4] = {0.f, 0.f, 0.f, 0.f};
                for (int c = 0; c < 128; ++c) { const float wv = pw[(size_t)(gi * 128 + c) * 128 + d];
#pragma unroll
                    for (int tt = 0; tt < 4; ++tt) acc[tt] += z[tt * 512 + gi * 128 + c] * wv; }
                const float bv = pb[gi * 128 + d], sv = psc[gi * 128 + d];
#pragma unroll
                for (int tt = 0; tt < 4; ++tt) CAT[(size_t)(t0 + tt) * DM + DRW + gi * 128 + d] = (bf16)f2bf((acc[tt] + bv) * sv); }
            __syncthreads();
        }
    }
    {
        const f32x2* rope = (const f32x2*)(ws + WS_ROPE);
        bf16* QR = (bf16*)(ws + WS_QR); bf16* KS = (bf16*)(ws + WS_KS); bf16* KW = (bf16*)(ws + WS_KW); bf16* VS = (bf16*)(ws + WS_VS); bf16* VW = (bf16*)(ws + WS_VW);
        const int NGT = G * NTHR;
        for (int i = bid * NTHR + tid; i < MTOK * 1536; i += NGT) {
            const int m = i / 1536, c = i - m * 1536; const int s = m & (SEQ - 1); const float* pr = P + (size_t)m * INP;
            int src; bf16* dst; float scale = 1.f; bool rot;
            if (c < 768) { src = PO_Q + c; dst = QR + (size_t)m * 768 + c; scale = 0.125f; rot = true; }
            else if (c < 960) { src = PO_KS + (c - 768); dst = KS + (size_t)m * 192 + (c - 768); rot = true; }
            else if (c < 1152) { src = PO_KW + (c - 960); dst = KW + (size_t)m * 192 + (c - 960); rot = true; }
            else if (c < 1344) { src = PO_VS + (c - 1152); dst = VS + (size_t)m * 192 + (c - 1152); rot = false; }
            else { src = PO_VW + (c - 1344); dst = VW + (size_t)m * 192 + (c - 1344); rot = false; }
            const int d = c & 63; float v = pr[src];
            if (rot && d < 16) { const f32x2 cs = rope[s * 8 + (d & 7)];
                if (d < 8) v = v * cs.x - pr[src + 8] * cs.y; else v = v * cs.x + pr[src - 8] * cs.y; }
            *dst = (bf16)f2bf(v * scale);
        }
    }
    {
        LAS float* cs = (LAS float*)lds;
        LAS float* hid = cs + 2 * 80 * 64;
        const float* pe[2] = {a.in[I_PEK] + (size_t)l * 2048, a.in[I_PEV] + (size_t)l * 2048};
        const float* w1[2] = {a.in[I_CK1] + (size_t)l * 2048 * 256, a.in[I_CV1] + (size_t)l * 2048 * 256};
        const float* w2[2] = {a.in[I_CK2] + (size_t)l * 256 * 64, a.in[I_CV2] + (size_t)l * 256 * 64};
        const f32x2* rope = (const f32x2*)(ws + WS_ROPE);
        bf16* KC = (bf16*)(ws + WS_KC); bf16* VC = (bf16*)(ws + WS_VC);
        for (int unit = bid; unit < NB * 3 * 64; unit += G) {
            const int b = unit / 192, r = unit - b * 192, h = r >> 6, ng = r & 63, n0 = ng * 4;
            for (int i = tid; i < 2 * 80 * 64; i += NTHR) { const int ten = i / 5120, j = i - ten * 5120, tk = j >> 6, d = j & 63; const int s = 16 * n0 + tk;
                cs[i] = s < SEQ ? P[(size_t)(b * SEQ + s) * INP + (ten ? PO_VC : PO_KC) + h * 64 + d] : 0.f; }
            __syncthreads();
            { const int ten = tid >> 8, f = tid & 255; const float* w1p = (ten ? w1[1] : w1[0]) + f; const float* pep = ten ? pe[1] : pe[0]; const LAS float* csp = cs + ten * 5120;
                float acc[4] = {0.f, 0.f, 0.f, 0.f};
                for (int k = 0; k < 2048; ++k) { const float wv = w1p[(size_t)k * 256]; const float pv = pep[k]; const int ll = k >> 6, d = k & 63;
#pragma unroll
                    for (int nn = 0; nn < 4; ++nn) acc[nn] += (csp[(16 * nn + ll) * 64 + d] + pv) * wv; }
#pragma unroll
                for (int nn = 0; nn < 4; ++nn) { const float x = acc[nn]; hid[(ten * 4 + nn) * 256 + f] = 0.5f * x * (1.0f + tanhf(0.7978845608028654f * (x + 0.044715f * x * x * x))); } }
            __syncthreads();
            { const int ten = tid >> 8, nn = (tid >> 6) & 3, d = tid & 63; const float* w2p = (ten ? w2[1] : w2[0]) + d; const LAS float* hp = hid + (ten * 4 + nn) * 256;
                float o = 0.f; for (int f = 0; f < 256; ++f) o += hp[f] * w2p[f * 64];
                const int n = n0 + nn; const float other = __shfl_xor(o, 8);
                if (ten == 0 && d < 16) { const int pos = 16 * n + 31; const f32x2 c2 = rope[(pos & (SEQ - 1)) * 8 + (d & 7)]; o = d < 8 ? o * c2.x - other * c2.y : o * c2.x + other * c2.y; }
                if (n < NCMP) { bf16* dst = (ten ? VC : KC) + ((size_t)(b * NCMPP + n) * 3 + h) * 64 + d; *dst = (bf16)f2bf(o); } }
            __syncthreads();
        }
    }
}

constexpr int SCH = 16, SSTR = 360;
__device__ __forceinline__ void phase_scan(const Args& a, LAS unsigned char* lds, int bid, int tid, int wave, int lane) {
    unsigned char* ws = a.ws;
    const int hd = bid >> 1, half = bid & 1, b = hd / 12, h = hd - b * 12;
    const int rowl = wave * 4 + (lane >> 4), j = lane & 15;
    const float* SC = (const float*)(ws + WS_SC); float* YS = (float*)(ws + WS_YS);
    LAS float* buf = (LAS float*)lds;
    const size_t m0 = (size_t)b * SEQ;
    const float* src[3]; int dsto[3]; bool act[3];
#pragma unroll
    for (int q = 0; q < 3; ++q) { const int i = tid + q * NTHR; act[q] = i < SCH * 88; const int st = i / 88, r = i - st * 88;
        if (r < 80) { const int vec = r >> 4, part = r & 15; src[q] = (const float*)(ws + WS_SV + (size_t)vec * SV_STRIDE) + (m0 + st) * DRW + h * 64 + part * 4; dsto[q] = st * SSTR + vec * 64 + part * 4; }
        else { const int part = r - 80; src[q] = (const float*)(ws + WS_SV + 5 * SV_STRIDE) + (m0 + st) * DRW + h * 64 + half * 32 + part * 4; dsto[q] = st * SSTR + 320 + part * 4; } }
    const float* srcc = SC + ((m0 + (tid & 15)) * 12 + h) * 4; const int dstc = (tid & 15) * SSTR + 352;
    f32x4 pre[3]; f32x2 prec;
#define SCAN_LOAD(ck) do { _Pragma("unroll") for (int q = 0; q < 3; ++q) if (act[q]) pre[q] = *(const f32x4*)(src[q] + (size_t)(ck) * SCH * DRW); if (tid < 16) prec = *(const f32x2*)(srcc + (size_t)(ck) * SCH * 48); } while (0)
#define SCAN_STORE(bb) do { _Pragma("unroll") for (int q = 0; q < 3; ++q) if (act[q]) *(LAS f32x4*)(buf + (bb) * SCH * SSTR + dsto[q]) = pre[q]; if (tid < 16) *(LAS f32x2*)(buf + (bb) * SCH * SSTR + dstc) = prec; } while (0)
    SCAN_LOAD(0); SCAN_STORE(0); __syncthreads();
    float S0 = 0.f, S1 = 0.f, S2 = 0.f, S3 = 0.f;
    constexpr int NCH = SEQ / SCH;
    for (int ck = 0; ck < NCH; ++ck) {
        if (ck + 1 < NCH) SCAN_LOAD(ck + 1);
        const LAS float* cb = buf + (ck & 1) * SCH * SSTR;
#pragma unroll 4
        for (int st = 0; st < SCH; ++st) {
            const LAS float* sb = cb + st * SSTR;
            const f32x4 kk = *(const LAS f32x4*)(sb + 4 * j), wr = *(const LAS f32x4*)(sb + 64 + 4 * j), w = *(const LAS f32x4*)(sb + 128 + 4 * j), km = *(const LAS f32x4*)(sb + 192 + 4 * j), bb = *(const LAS f32x4*)(sb + 256 + 4 * j);
            const float v = sb[320 + rowl]; const f32x2 c = *(const LAS f32x2*)(sb + 352);
            float p1 = S0 * kk.x; p1 = fmaf(S1, kk.y, p1); p1 = fmaf(S2, kk.z, p1); p1 = fmaf(S3, kk.w, p1);
            float p2 = S0 * wr.x; p2 = fmaf(S1, wr.y, p2); p2 = fmaf(S2, wr.z, p2); p2 = fmaf(S3, wr.w, p2);
            const float sa = row16_sum(p1), y0 = row16_sum(p2);
            const float t0 = fmaf(S0, w.x, v * km.x), t1 = fmaf(S1, w.y, v * km.y), t2 = fmaf(S2, w.z, v * km.z), t3 = fmaf(S3, w.w, v * km.w);
            S0 = fmaf(-sa, bb.x, t0); S1 = fmaf(-sa, bb.y, t1); S2 = fmaf(-sa, bb.z, t2); S3 = fmaf(-sa, bb.w, t3);
            const float y = y0 - sa * c.x + v * c.y;
            if (j == 0) YS[(m0 + (size_t)ck * SCH + st) * DRW + h * 64 + half * 32 + rowl] = y;
        }
        if (ck + 1 < NCH) SCAN_STORE((ck + 1) & 1);
        __syncthreads();
    }
#undef SCAN_LOAD
#undef SCAN_STORE
}

#define WSYNC() asm volatile("s_waitcnt lgkmcnt(0)" ::: "memory")
__device__ __forceinline__ void dot4(const bf16* krow, const LAS float* qT, float (&s)[4]) {
    const u32x4* kp = (const u32x4*)krow; s[0] = s[1] = s[2] = s[3] = 0.f;
#pragma unroll
    for (int c8 = 0; c8 < 8; ++c8) { const u32x4 kv = kp[c8]; const unsigned w[4] = {kv.x, kv.y, kv.z, kv.w};
#pragma unroll
        for (int e = 0; e < 4; ++e) { const float klo = __builtin_bit_cast(float, w[e] << 16), khi = __builtin_bit_cast(float, w[e] & 0xffff0000u); const int d = c8 * 8 + 2 * e;
            const f32x4 qa = *(const LAS f32x4*)(qT + d * 4), qb = *(const LAS f32x4*)(qT + d * 4 + 4);
            s[0] = fmaf(qa.x, klo, s[0]); s[1] = fmaf(qa.y, klo, s[1]); s[2] = fmaf(qa.z, klo, s[2]); s[3] = fmaf(qa.w, klo, s[3]);
            s[0] = fmaf(qb.x, khi, s[0]); s[1] = fmaf(qb.y, khi, s[1]); s[2] = fmaf(qb.z, khi, s[2]); s[3] = fmaf(qb.w, khi, s[3]); } }
}
__device__ __forceinline__ void attend_block(const bf16* K, const bf16* V, int kbase, int lo, int hi, const LAS float* qT, LAS float* pb, int lane, float (&mx)[4], float (&ls)[4], float (&o)[4]) {
    const int kpos = kbase + lane; const bool valid = kpos >= lo && kpos <= hi;
    float s[4]; dot4(K + (size_t)kpos * 192, qT, s);
    float p[4];
#pragma unroll
    for (int g = 0; g < 4; ++g) { const float sv = valid ? s[g] : -INFINITY; const float bm = wave_max(sv); const float mn = fmaxf(mx[g], bm);
        const float sc = expf(mx[g] - mn); p[g] = valid ? expf(sv - mn) : 0.f; ls[g] = ls[g] * sc + wave_sum(p[g]); o[g] *= sc; mx[g] = mn; }
    *(LAS f32x4*)(pb + lane * 4) = (f32x4){p[0], p[1], p[2], p[3]};
    WSYNC();
    const bf16* vp = V + (size_t)kbase * 192 + lane;
#pragma unroll 8
    for (int jj = 0; jj < 64; ++jj) { const f32x4 p4 = *(const LAS f32x4*)(pb + jj * 4); const float vv = bf2f(vp[(size_t)jj * 192]);
        o[0] = fmaf(p4.x, vv, o[0]); o[1] = fmaf(p4.y, vv, o[1]); o[2] = fmaf(p4.z, vv, o[2]); o[3] = fmaf(p4.w, vv, o[3]); }
    WSYNC();
}
__device__ __forceinline__ void phase_nsa(const Args& a, int l, LAS unsigned char* lds, int gw, int NGW, int wave, int lane) {
    unsigned char* ws = a.ws;
    LAS float* qT = (LAS float*)(lds + wave * 3072);
    LAS float* pb = qT + 256;
    LAS float* psum = pb + 256;
    const bf16* QR = (const bf16*)(ws + WS_QR); const bf16* KSb = (const bf16*)(ws + WS_KS); const bf16* KWb = (const bf16*)(ws + WS_KW); const bf16* VSb = (const bf16*)(ws + WS_VS); const bf16* VWb = (const bf16*)(ws + WS_VW);
    const bf16* KC = (const bf16*)(ws + WS_KC); const bf16* VC = (const bf16*)(ws + WS_VC);
    const float* P = (const float*)(ws + WS_P); const float* gate_b = a.in[I_GB] + (size_t)l * 36; bf16* CAT = (bf16*)(ws + WS_CAT);
    for (int id = gw; id < MTOK * 3; id += NGW) {
        const int s = id & (SEQ - 1), bh = id >> 12, b = bh / 3, kvh = bh - b * 3; const size_t m = (size_t)b * SEQ + s;
#pragma unroll
        for (int g = 0; g < 4; ++g) qT[lane * 4 + g] = bf2f(QR[m * 768 + (kvh * 4 + g) * 64 + lane]);
        WSYNC();
        const int nv = s >= 31 ? ((s - 31) >> 4) + 1 : 0;
        float sc[4][4];
#pragma unroll
        for (int kt = 0; kt < 4; ++kt) {
            if (kt * 64 < nv) { float t[4]; dot4(KC + ((size_t)(b * NCMPP + kt * 64 + lane) * 3 + kvh) * 64, qT, t); const bool ok = kt * 64 + lane < nv;
#pragma unroll
                for (int g = 0; g < 4; ++g) sc[kt][g] = ok ? t[g] : -INFINITY; }
            else {
#pragma unroll
                for (int g = 0; g < 4; ++g) sc[kt][g] = -INFINITY; }
        }
        float pc[4][4];
#pragma unroll
        for (int g = 0; g < 4; ++g) { float mxv = wave_max(fmaxf(fmaxf(sc[0][g], sc[1][g]), fmaxf(sc[2][g], sc[3][g]))); if (!(mxv > -INFINITY)) mxv = 0.f; float es = 0.f;
#pragma unroll
            for (int kt = 0; kt < 4; ++kt) { pc[kt][g] = sc[kt][g] > -INFINITY ? expf(sc[kt][g] - mxv) : 0.f; es += pc[kt][g]; }
            const float inv = 1.0f / fmaxf(wave_sum(es), 1.17549435e-38f);
#pragma unroll
            for (int kt = 0; kt < 4; ++kt) pc[kt][g] *= inv; }
#pragma unroll
        for (int kt = 0; kt < 4; ++kt) psum[kt * 64 + lane] = (pc[kt][0] + pc[kt][1]) + (pc[kt][2] + pc[kt][3]);
        float oc[4] = {0.f, 0.f, 0.f, 0.f};
#pragma unroll
        for (int kt = 0; kt < 4; ++kt) {
            if (kt * 64 < nv) {
                *(LAS f32x4*)(pb + lane * 4) = (f32x4){pc[kt][0], pc[kt][1], pc[kt][2], pc[kt][3]};
                WSYNC();
                const int cnt = (nv - kt * 64) < 64 ? (nv - kt * 64) : 64; const bf16* vp = VC + ((size_t)(b * NCMPP + kt * 64) * 3 + kvh) * 64 + lane;
                for (int jj = 0; jj < cnt; ++jj) { const f32x4 p4 = *(const LAS f32x4*)(pb + jj * 4); const float vv = bf2f(vp[(size_t)jj * 192]);
                    oc[0] = fmaf(p4.x, vv, oc[0]); oc[1] = fmaf(p4.y, vv, oc[1]); oc[2] = fmaf(p4.z, vv, oc[2]); oc[3] = fmaf(p4.w, vv, oc[3]); }
                WSYNC();
            }
        }
        WSYNC();
        const int cur = s >> 6;
        float imp = psum[4 * lane] + psum[4 * lane + 1] + psum[4 * lane + 2] + 0.5f * psum[4 * lane + 3] + (lane > 0 ? 0.5f * psum[4 * lane - 1] : 0.f);
        const bool forced = (lane == 0) || (lane == cur) || (lane == cur - 1);
        float score = forced ? 1e9f : imp; if (lane > cur) score = -INFINITY;
        int rank = 0;
        for (int i = 0; i < 64; ++i) { const float si = __shfl(score, i); rank += (si > score || (si == score && i < lane)) ? 1 : 0; }
        unsigned long long selmask = __ballot(lane <= cur && rank < 16);
        float mx[4] = {-INFINITY, -INFINITY, -INFINITY, -INFINITY}, ls[4] = {0.f, 0.f, 0.f, 0.f}, os[4] = {0.f, 0.f, 0.f, 0.f};
        const bf16* Kb = KSb + ((size_t)b * SEQ * 3 + kvh) * 64; const bf16* Vb = VSb + ((size_t)b * SEQ * 3 + kvh) * 64;
        while (selmask) { const int jb = __builtin_ctzll(selmask); selmask &= selmask - 1; attend_block(Kb, Vb, jb * 64, 0, s, qT, pb, lane, mx, ls, os); }
#pragma unroll
        for (int g = 0; g < 4; ++g) os[g] = os[g] / fmaxf(ls[g], 1.17549435e-38f);
        float mw[4] = {-INFINITY, -INFINITY, -INFINITY, -INFINITY}, lw[4] = {0.f, 0.f, 0.f, 0.f}, ow[4] = {0.f, 0.f, 0.f, 0.f};
        const int lo = s - 511 > 0 ? s - 511 : 0;
        Kb = KWb + ((size_t)b * SEQ * 3 + kvh) * 64; Vb = VWb + ((size_t)b * SEQ * 3 + kvh) * 64;
        for (int jb = lo >> 6; jb <= cur; ++jb) attend_block(Kb, Vb, jb * 64, lo, s, qT, pb, lane, mw, lw, ow);
#pragma unroll
        for (int g = 0; g < 4; ++g) ow[g] = ow[g] / fmaxf(lw[g], 1.17549435e-38f);
#pragma unroll
        for (int g = 0; g < 4; ++g) { const int hq = kvh * 4 + g; const float* gl = P + m * INP + PO_GL + hq * 3; const float* gb = gate_b + hq * 3;
            const float g0 = sigmoidf_(gl[0] + gb[0]), g1 = sigmoidf_(gl[1] + gb[1]), g2 = sigmoidf_(gl[2] + gb[2]);
            CAT[m * DM + DRW + DPOOL + hq * 64 + lane] = (bf16)f2bf(g0 * oc[g] + g1 * os[g] + g2 * ow[g]); }
        WSYNC();
    }
}

__device__ __forceinline__ void phase_rwkv_out(const Args& a, int l, int gw, int NGW, int lane) {
    unsigned char* ws = a.ws; const float* YS = (const float*)(ws + WS_YS); const float* vV = (const float*)(ws + WS_SV + 5 * SV_STRIDE); const float* vG = (const float*)(ws + WS_G); const float* SC = (const float*)(ws + WS_SC);
    const float* gng = a.in[I_GNG] + (size_t)l * DRW; const float* gnb = a.in[I_GNB] + (size_t)l * DRW; bf16* CAT = (bf16*)(ws + WS_CAT);
    for (int id = gw; id < MTOK * 12; id += NGW) { const int m = id / 12, h = id - m * 12, c = h * 64 + lane; const size_t o = (size_t)m * DRW + c;
        const float y = YS[o]; const float mean = wave_sum(y) * (1.f / 64.f); const float d = y - mean; const float var = wave_sum(d * d) * (1.f / 64.f);
        const float yn = d * (1.f / sqrtf(var + GN_EPS)) * gng[c] + gnb[c]; const float bonus = SC[((size_t)m * 12 + h) * 4 + 2] * vV[o];
        CAT[(size_t)m * DM + c] = (bf16)f2bf((yn + bonus) * vG[o]); }
}

template <int PHMASK> __global__ void __launch_bounds__(NTHR, 2) fwd(Args args) {
    extern __shared__ __attribute__((aligned(16))) unsigned char lds_raw[];
    LAS unsigned char* lds = (LAS unsigned char*)lds_raw;
    const int tid = threadIdx.x, lane = tid & 63, wave = __builtin_amdgcn_readfirstlane(tid >> 6);
    const int G = gridDim.x, bid = blockIdx.x; const int gw = bid * NWAVES + wave, NGW = G * NWAVES;
    unsigned char* ws = args.ws;
    for (int u = tid; u < (LDS_BYTES - 131072) / 4; u += NTHR) ((LAS unsigned*)(lds + 131072))[u] = 0u;
    __syncthreads();
    const int lo = args.ph_lo, hi = args.ph_hi;
    XcdBarrier bar; bar.bar = (unsigned*)(ws + WS_CTL) + 4096; bar.x = 0; bar.st = nullptr;
    if (hi - lo > 1) bar = xcd_barrier_post((unsigned*)(ws + WS_CTL) + 4096, (volatile LAS unsigned*)(lds + MISC_OFF) + 8);
#define IN(k) (lo <= (k) && (k) < hi)
#define PHEN(j) (((PHMASK) >> (j)) & 1)
#define SEAM(k) do { if ((k) + 1 < hi) xcd_barrier(bar); } while (0)
    bf16* XB = (bf16*)(ws + WS_XB); bf16* Hb = (bf16*)(ws + WS_H); float* Y = (float*)(ws + WS_Y); float* Pm = (float*)(ws + WS_P); bf16* CAT = (bf16*)(ws + WS_CAT);

    if (PHEN(0) && IN(0)) { phase_prologue(args, bid * NTHR + tid, G * NTHR); SEAM(0); }
    for (int l = 0; l < NLAYER; ++l) {
        const int pb = 1 + 13 * l;
        if (PHEN(1) && IN(pb + 0)) { phase_wconv(args, l, lds, gw, NGW, wave, lane); SEAM(pb + 0); }
        if (PHEN(2) && IN(pb + 1)) {
            pg8::Gemm g{XB, (const bf16*)(ws + WS_WUP1), MTOK, NUP, DM}; pg8::StaticOrder S; S.init(MTOK, NUP, G, bid); pg8::EpiSwiGLU E{Hb, DFF};
            pg8::gemm_phase<pg8::EpiSwiGLU, pg8::StaticOrder, true, true>(lds, g, S, E); SEAM(pb + 1); }
        if (PHEN(3) && IN(pb + 2)) {
            pg8::Gemm g{Hb, (const bf16*)(ws + WS_WDN1), MTOK, DM, DFF}; pg8::StaticOrder S; S.init(MTOK, DM, G, bid); pg8::EpiResid E{l == 0 ? args.in[I_X] : args.out, Y, DM, ALPHA, 0.5f};
            pg8::gemm_phase<pg8::EpiResid, pg8::StaticOrder, true, true>(lds, g, S, E); SEAM(pb + 2); }
        if (PHEN(4) && IN(pb + 3)) { phase_ln(Y, args.in[I_LN1G] + (size_t)l * DM, args.in[I_LN1B] + (size_t)l * DM, args.out, XB, gw, NGW, lane); SEAM(pb + 3); }
        if (PHEN(5) && IN(pb + 4)) {
            pg8::Gemm g{XB, (const bf16*)(ws + WS_WIN), MTOK, INP, DM}; pg8::StaticOrder S; S.init(MTOK, INP, G, bid); pg8::EpiF32 E{Pm, INP};
            pg8::gemm_phase<pg8::EpiF32, pg8::StaticOrder, true, true>(lds, g, S, E); SEAM(pb + 4); }
        if (PHEN(6) && IN(pb + 5)) { phase_m1(args, l, lds, bid, G, tid, wave, lane); SEAM(pb + 5); }
        if (PHEN(7) && IN(pb + 6)) { if (bid < 96) phase_scan(args, lds, bid, tid, wave, lane); __syncthreads(); phase_nsa(args, l, lds, gw, NGW, wave, lane); SEAM(pb + 6); }
        if (PHEN(8) && IN(pb + 7)) { phase_rwkv_out(args, l, gw, NGW, lane); SEAM(pb + 7); }
        if (PHEN(9) && IN(pb + 8)) {
            pg8::Gemm g{CAT, (const bf16*)(ws + WS_WOUT), MTOK, DM, DM}; pg8::StaticOrder S; S.init(MTOK, DM, G, bid); pg8::EpiResid E{args.out, Y, DM, ALPHA, 1.0f};
            pg8::gemm_phase<pg8::EpiResid, pg8::StaticOrder, true, true>(lds, g, S, E); SEAM(pb + 8); }
        if (PHEN(10) && IN(pb + 9)) { phase_ln(Y, args.in[I_LN2G] + (size_t)l * DM, args.in[I_LN2B] + (size_t)l * DM, args.out, XB, gw, NGW, lane); SEAM(pb + 9); }
        if (PHEN(11) && IN(pb + 10)) {
            pg8::Gemm g{XB, (const bf16*)(ws + WS_WUP2), MTOK, NUP, DM}; pg8::StaticOrder S; S.init(MTOK, NUP, G, bid); pg8::EpiSwiGLU E{Hb, DFF};
            pg8::gemm_phase<pg8::EpiSwiGLU, pg8::StaticOrder, true, true>(lds, g, S, E); SEAM(pb + 10); }
        if (PHEN(12) && IN(pb + 11)) {
            pg8::Gemm g{Hb, (const bf16*)(ws + WS_WDN2), MTOK, DM, DFF}; pg8::StaticOrder S; S.init(MTOK, DM, G, bid); pg8::EpiResid E{args.out, Y, DM, ALPHA, 0.5f};
            pg8::gemm_phase<pg8::EpiResid, pg8::StaticOrder, true, true>(lds, g, S, E); SEAM(pb + 11); }
        if (PHEN(13) && IN(pb + 12)) { phase_ln(Y, args.in[I_LN3G] + (size_t)l * DM, args.in[I_LN3B] + (size_t)l * DM, args.out, XB, gw, NGW, lane); SEAM(pb + 12); }
    }
#undef IN
#undef SEAM
}

#ifndef MK_ONE_LAUNCH
#define MK_ONE_LAUNCH 0
#endif
typedef void (*kern_t)(Args);
extern "C" void kernel_launch(void* const* d_in, const int* in_sizes, int n_in, void* d_out, int out_size, void* d_ws, size_t ws_size, hipStream_t stream) {
    static int grid = 0;
#if MK_ONE_LAUNCH
    static const kern_t kerns[1] = {fwd<0xFFFFF>};
    constexpr int NK = 1;
#else
    static const kern_t kerns[14] = {fwd<1 << 0>, fwd<1 << 1>, fwd<1 << 2>, fwd<1 << 3>, fwd<1 << 4>, fwd<1 << 5>, fwd<1 << 6>, fwd<1 << 7>, fwd<1 << 8>, fwd<1 << 9>, fwd<1 << 10>, fwd<1 << 11>, fwd<1 << 12>, fwd<1 << 13>};
    constexpr int NK = 14;
#endif
    if (grid == 0) {
        if (n_in != 34 || out_size != MTOK * DM || ws_size < WS_END) { fprintf(stderr, "kernel_launch: unexpected shapes (n_in %d, out %d, ws %zu; need ws >= %zu)\n", n_in, out_size, ws_size, (size_t)WS_END); grid = -1; return; }
        int dev = 0, cus = 0;
        if (hipGetDevice(&dev) != hipSuccess || hipDeviceGetAttribute(&cus, hipDeviceAttributeMultiprocessorCount, dev) != hipSuccess) { grid = -1; return; }
        for (int i = 0; i < NK; ++i) if (hipFuncSetAttribute((const void*)kerns[i], hipFuncAttributeMaxDynamicSharedMemorySize, LDS_BYTES) != hipSuccess) { fprintf(stderr, "kernel_launch: hipFuncSetAttribute failed\n"); grid = -1; return; }
        int per_cu = 0;
        if (hipOccupancyMaxActiveBlocksPerMultiprocessor(&per_cu, (const void*)kerns[0], NTHR, LDS_BYTES) != hipSuccess || per_cu < 1) fprintf(stderr, "kernel_launch: occupancy query says %d blocks per CU\n", per_cu);
        (void)hipGetLastError();
        grid = cus;
    }
    if (grid < 0) return;
    (void)hipMemsetAsync((char*)d_ws + WS_CTL, 0, CTL_ZERO_BYTES, stream);
    Args a{};
    for (int i = 0; i < 34; ++i) a.in[i] = (const float*)d_in[i];
    a.out = (float*)d_out; a.ws = (unsigned char*)d_ws;
#if MK_ONE_LAUNCH
    a.ph_lo = 0; a.ph_hi = NPH;
    hipLaunchKernelGGL(kerns[0], dim3(grid), dim3(NTHR), LDS_BYTES, stream, a);
#else
    for (int k = 0; k < NPH; ++k) { a.ph_lo = k; a.ph_hi = k + 1; const int j = k == 0 ? 0 : (k - 1) % 13 + 1; hipLaunchKernelGGL(kerns[j], dim3(grid), dim3(NTHR), LDS_BYTES, stream, a); }
#endif
}
```

```cpp
#include <hip/hip_runtime.h>
#include <cstdio>
#include <cstdint>
namespace pg8 {
#define PG8_LAS __attribute__((address_space(3)))
typedef unsigned short bf16_t;
typedef short bf16x8 __attribute__((ext_vector_type(8)));
typedef float f32x4 __attribute__((ext_vector_type(4)));
typedef unsigned u32x4 __attribute__((ext_vector_type(4)));
constexpr int BM = 256, BK = 64, HALF = 128, HTB = HALF * BK * 2  , STAGE_BYTES = 8 * HTB, NXCD = 8, WGM = 8;

__host__ __device__ __forceinline__ int lds_byte(int r, int c) { const int st = (r >> 4) * 2 + (c >> 5), rr = r & 15, cc = c & 31, ob = rr * 64 + cc * 2; return st * 1024 + (ob ^ (((ob >> 9) & 1) << 5)); }
__host__ __device__ __forceinline__ void stage_rc(int b, int& R, int& C) { const int st = b / 1024, sb = b % 1024, swz = sb ^ (((sb >> 9) & 1) << 5); R = (st >> 1) * 16 + swz / 64; C = (st & 1) * 32 + (swz % 64) / 2; }
__host__ __device__ __forceinline__ int perm32(int rho) { const int n = rho >> 4, i = rho & 15; return 8 * (i >> 2) + 4 * n + (i & 3); }

struct Unit { int pm, pn; };
struct Gemm { const bf16_t* A; const bf16_t* Bt; int M, N, K; };

struct StaticOrder {
    int nM, nN, nwg, G, c;
    __host__ __device__ void init(int M, int N, int G_, int c_) { nM = M / BM; nN = N / BM; nwg = nM * nN; G = G_; c = c_; }
    __host__ __device__ bool next(int i, Unit& u) const {
        const long L = (long)i * G + c; if (L >= nwg) return false;
        int wgid = (int)L; { const int q = nwg / NXCD, r = nwg % NXCD, xcd = wgid % NXCD, off = wgid / NXCD; wgid = (xcd < r ? xcd * (q + 1) : r * (q + 1) + (xcd - r) * q) + off; }
        const int nig = WGM * nN, gid = wgid / nig, fm = gid * WGM, gsz = (nM - fm) < WGM ? (nM - fm) : WGM;
        u.pm = fm + ((wgid % nig) % gsz); u.pn = (wgid % nig) / gsz; return true;
    }
    __device__ __forceinline__ void a_ready(const Unit&) const {}
    __device__ __forceinline__ void done(const Unit&) const {}
};

__device__ __forceinline__ unsigned cvt_pk_bf16(float lo, float hi) { unsigned r; asm volatile("v_cvt_pk_bf16_f32 %0, %1, %2" : "=v"(r) : "v"(lo), "v"(hi)); return r; }
typedef float f32x2 __attribute__((ext_vector_type(2)));
struct EpiSwiGLU {
    static constexpr bool PERM = true, AFTER_DRAIN = false;
    bf16_t* H; int ldh;
    __device__ __forceinline__ void operator()(const f32x4 (&acc)[2][2][4][2], const Unit& u, int wr, int wc, int fr, int fq) const {
        const int row0 = u.pm * BM + wr * 64 + fr, col0 = u.pn * HALF + wc * 32 + 8 * fq;
#pragma unroll
        for (int ai = 0; ai < 2; ++ai)
#pragma unroll
            for (int m = 0; m < 4; ++m) { bf16_t* rowp = H + (size_t)(row0 + ai * HALF + m * 16) * ldh + col0;
                float hv[8];
#pragma unroll
                for (int n = 0; n < 2; ++n)
#pragma unroll
                    for (int i = 0; i < 4; ++i) { const float a = acc[ai][0][m][n][i], b = acc[ai][1][m][n][i];
                        const float e = __builtin_amdgcn_exp2f(a * -1.44269504089f); hv[n * 4 + i] = a * __builtin_amdgcn_rcpf(1.0f + e) * b; }
                u32x4 w; w.x = cvt_pk_bf16(hv[0], hv[1]); w.y = cvt_pk_bf16(hv[2], hv[3]); w.z = cvt_pk_bf16(hv[4], hv[5]); w.w = cvt_pk_bf16(hv[6], hv[7]);
                *(u32x4*)rowp = w; }
    }
};
struct EpiResid {
    static constexpr bool PERM = false, AFTER_DRAIN = false;
    const float* X; float* Y; int ldc; float alpha, s;
    __device__ __forceinline__ void operator()(const f32x4 (&acc)[2][2][4][2], const Unit& u, int wr, int wc, int fr, int fq) const {
        const int row0 = u.pm * BM + wr * 64 + fr, col0 = u.pn * BM + wc * 32 + 4 * fq;
#pragma unroll
        for (int ai = 0; ai < 2; ++ai)
#pragma unroll
            for (int m = 0; m < 4; ++m) { const size_t off = (size_t)(row0 + ai * HALF + m * 16) * ldc + col0;
#pragma unroll
                for (int bj = 0; bj < 2; ++bj)
#pragma unroll
                    for (int n = 0; n < 2; ++n) { const f32x4 xv = *(const f32x4*)(X + off + bj * HALF + n * 16); *(f32x4*)(Y + off + bj * HALF + n * 16) = xv * alpha + acc[ai][bj][m][n] * s; }
                asm volatile("" ::: "memory"); }
    }
};
struct EpiF32 {
    static constexpr bool PERM = false, AFTER_DRAIN = false;
    float* C; int ldc;
    __device__ __forceinline__ void operator()(const f32x4 (&acc)[2][2][4][2], const Unit& u, int wr, int wc, int fr, int fq) const {
        const int row0 = u.pm * BM + wr * 64 + fr, col0 = u.pn * BM + wc * 32 + 4 * fq;
#pragma unroll
        for (int ai = 0; ai < 2; ++ai)
#pragma unroll
            for (int m = 0; m < 4; ++m) { float* rowp = C + (size_t)(row0 + ai * HALF + m * 16) * ldc + col0;
#pragma unroll
                for (int bj = 0; bj < 2; ++bj)
#pragma unroll
                    for (int n = 0; n < 2; ++n) *(f32x4*)(rowp + bj * HALF + n * 16) = acc[ai][bj][m][n]; }
    }
};

template <class Epi, class Sched, bool ALIGN_EPI = false, bool SP2 = false>
__device__ __forceinline__ void gemm_phase(PG8_LAS unsigned char* lds, const Gemm g, const Sched& S, const Epi& E) {
    int tid_ = threadIdx.x; asm volatile("" : "+v"(tid_));
    const int tid = tid_, wid = __builtin_amdgcn_readfirstlane(tid >> 6), lane = tid & 63, wr = wid >> 2, wc = wid & 3, fr = lane & 15, fq = lane >> 4;
    const int K = g.K, nt = K / BK;
    unsigned voffA[2], voffB[2];
#pragma unroll
    for (int i = 0; i < 2; ++i) { int R, C; stage_rc(tid * 16 + i * 8192, R, C); const int Rb = Epi::PERM ? ((R & ~31) + perm32(R & 31)) : R;
        voffA[i] = (unsigned)(R * K + C) * 2u; voffB[i] = (unsigned)(Rb * K + C) * 2u; }
    const size_t kstep = (size_t)(BK * 2);
    const size_t hstep = (size_t)HALF * K * 2;
    const size_t tstep = 2 * hstep;
    const unsigned ldsw = (unsigned)wid * 1024u;
    const int aoff = lds_byte(wr * 64 + fr, fq * 8), boff = lds_byte(wc * 32 + fr, fq * 8);
#define PG8_SA(b, h) (((b) * 2 + (h)) * HTB)
#define PG8_SB(b, h) ((4 + (b) * 2 + (h)) * HTB)
#define PG8_STAGE(bufoff, gbase, voff) do { _Pragma("unroll") for (int _i = 0; _i < 2; ++_i) \
        __builtin_amdgcn_global_load_lds((const unsigned*)((const char*)(gbase) + (voff)[_i]), (PG8_LAS unsigned*)(lds + (bufoff) + ldsw + _i * 8192), 16, 0, 0); } while (0)
#define PG8_LDA(dst, b, h) do { _Pragma("unroll") for (int m = 0; m < 4; ++m) _Pragma("unroll") for (int k = 0; k < 2; ++k) dst[m][k] = *(const PG8_LAS bf16x8*)(lds + PG8_SA(b, h) + aoff + m * 2048 + k * 1024); } while (0)
#define PG8_LDB(dst, b, h) do { _Pragma("unroll") for (int n = 0; n < 2; ++n) _Pragma("unroll") for (int k = 0; k < 2; ++k) dst[n][k] = *(const PG8_LAS bf16x8*)(lds + PG8_SB(b, h) + boff + n * 2048 + k * 1024); } while (0)
#define PG8_MMA(ai, bj, At, Bt) do { __builtin_amdgcn_s_setprio(1); _Pragma("unroll") for (int m = 0; m < 4; ++m) _Pragma("unroll") for (int n = 0; n < 2; ++n) _Pragma("unroll") for (int k = 0; k < 2; ++k) \
        acc[ai][bj][m][n] = __builtin_amdgcn_mfma_f32_16x16x32_bf16(Bt[n][k], At[m][k], acc[ai][bj][m][n], 0, 0, 0); __builtin_amdgcn_s_setprio(0); } while (0)
#define PG8_WAIT_V(n) asm volatile("s_waitcnt vmcnt(" #n ")" ::: "memory")
#define PG8_WAIT_L(n) asm volatile("s_waitcnt lgkmcnt(" #n ")" ::: "memory")
#define PG8_BAR __builtin_amdgcn_s_barrier()
#define PG8_SCHED __builtin_amdgcn_sched_barrier(0)
    Unit cur, nxt; int ui = 0;
    if (!S.next(0, cur)) return;
    f32x4 acc[2][2][4][2];
#pragma unroll
    for (int a = 0; a < 2; ++a)
#pragma unroll
        for (int b = 0; b < 2; ++b)
#pragma unroll
            for (int m = 0; m < 4; ++m)
#pragma unroll
                for (int n = 0; n < 2; ++n) acc[a][b][m][n] = (f32x4){0.f, 0.f, 0.f, 0.f};
    bf16x8 At[4][2], B0[2][2], B1[2][2];
    const char* cA = (const char*)g.A + (size_t)cur.pm * tstep; const char* cB = (const char*)g.Bt + (size_t)cur.pn * tstep;
    S.a_ready(cur);
    if constexpr (SP2) {
        PG8_STAGE(PG8_SB(0, 0), cB, voffB); PG8_STAGE(PG8_SB(0, 1), cB + hstep, voffB); PG8_STAGE(PG8_SA(0, 0), cA, voffA); PG8_STAGE(PG8_SA(0, 1), cA + hstep, voffA);
        if (wr == 1) PG8_BAR;
        PG8_WAIT_V(2); PG8_BAR;
        PG8_STAGE(PG8_SB(1, 0), cB + kstep, voffB); PG8_STAGE(PG8_SA(1, 0), cA + kstep, voffA); PG8_STAGE(PG8_SB(1, 1), cB + hstep + kstep, voffB);
        PG8_WAIT_V(6); PG8_BAR;
    } else {
        PG8_STAGE(PG8_SB(0, 0), cB, voffB); PG8_STAGE(PG8_SA(0, 0), cA, voffA); PG8_STAGE(PG8_SB(0, 1), cB + hstep, voffB); PG8_STAGE(PG8_SA(0, 1), cA + hstep, voffA);
        if (wr == 1) PG8_BAR;
        PG8_WAIT_V(4); PG8_BAR;
        PG8_STAGE(PG8_SB(1, 0), cB + kstep, voffB); PG8_STAGE(PG8_SA(1, 0), cA + kstep, voffA); PG8_STAGE(PG8_SB(1, 1), cB + hstep + kstep, voffB);
        PG8_WAIT_V(6); PG8_BAR;
    }
    for (;;) {
        const bool has_next = S.next(ui + 1, nxt);
        const char* nA = has_next ? (const char*)g.A + (size_t)nxt.pm * tstep : cA; const char* nB = has_next ? (const char*)g.Bt + (size_t)nxt.pn * tstep : cB;
        for (int t = 0; t < nt; t += 2) {
            const bool last = (t == nt - 2);
            const char* a1 = cA + (size_t)(t + 1) * kstep;
            const char* a2 = last ? nA : cA + (size_t)(t + 2) * kstep; const char* b2 = last ? nB : cB + (size_t)(t + 2) * kstep;
            const char* a3 = a2 + kstep; const char* b3 = b2 + kstep;
            if (last && has_next) S.a_ready(nxt);
            if constexpr (SP2) {
            PG8_LDB(B0, 0, 0); PG8_LDB(B1, 0, 1); PG8_SCHED; PG8_LDA(At, 0, 0); PG8_STAGE(PG8_SA(1, 1), a1 + hstep, voffA);
            PG8_WAIT_V(8); PG8_WAIT_L(0); PG8_BAR; PG8_MMA(0, 0, At, B0); PG8_MMA(0, 1, At, B1); PG8_BAR; PG8_SCHED;
            PG8_LDA(At, 0, 1); PG8_STAGE(PG8_SB(0, 0), b2, voffB); PG8_STAGE(PG8_SB(0, 1), b2 + hstep, voffB); PG8_STAGE(PG8_SA(0, 0), a2, voffA);
            PG8_WAIT_V(8); PG8_WAIT_L(0); PG8_BAR; PG8_MMA(1, 0, At, B0); PG8_MMA(1, 1, At, B1); PG8_BAR; PG8_SCHED;
            PG8_LDB(B0, 1, 0); PG8_LDB(B1, 1, 1); PG8_SCHED; PG8_LDA(At, 1, 0); PG8_STAGE(PG8_SA(0, 1), a2 + hstep, voffA);
            PG8_WAIT_V(8); PG8_WAIT_L(0); PG8_BAR; PG8_MMA(0, 0, At, B0); PG8_MMA(0, 1, At, B1); PG8_BAR; PG8_SCHED;
            PG8_LDA(At, 1, 1); PG8_STAGE(PG8_SB(1, 0), b3, voffB); PG8_STAGE(PG8_SB(1, 1), b3 + hstep, voffB); PG8_STAGE(PG8_SA(1, 0), a3, voffA);
            PG8_WAIT_V(8); PG8_WAIT_L(0); PG8_BAR; PG8_MMA(1, 0, At, B0); PG8_MMA(1, 1, At, B1); PG8_BAR; PG8_SCHED;
            } else {
            PG8_LDB(B0, 0, 0); PG8_SCHED; PG8_LDA(At, 0, 0); PG8_STAGE(PG8_SA(1, 1), a1 + hstep, voffA);
            PG8_WAIT_L(8); PG8_BAR; PG8_WAIT_L(0); PG8_MMA(0, 0, At, B0); PG8_BAR; PG8_SCHED;
            PG8_LDB(B1, 0, 1); PG8_STAGE(PG8_SB(0, 0), b2, voffB);
            PG8_BAR; PG8_WAIT_L(0); PG8_MMA(0, 1, At, B1); PG8_BAR;
            PG8_LDA(At, 0, 1); PG8_STAGE(PG8_SA(0, 0), a2, voffA);
            PG8_BAR; PG8_WAIT_L(0); PG8_MMA(1, 0, At, B0); PG8_BAR; PG8_SCHED;
            PG8_STAGE(PG8_SB(0, 1), b2 + hstep, voffB);
            PG8_WAIT_V(6); PG8_BAR; PG8_MMA(1, 1, At, B1); PG8_BAR;
            PG8_LDB(B0, 1, 0); PG8_SCHED; PG8_LDA(At, 1, 0); PG8_STAGE(PG8_SA(0, 1), a2 + hstep, voffA);
            PG8_WAIT_L(8); PG8_BAR; PG8_WAIT_L(0); PG8_MMA(0, 0, At, B0); PG8_BAR; PG8_SCHED;
            PG8_LDB(B1, 1, 1); PG8_STAGE(PG8_SB(1, 0), b3, voffB);
            PG8_BAR; PG8_WAIT_L(0); PG8_MMA(0, 1, At, B1); PG8_BAR;
            PG8_LDA(At, 1, 1); PG8_STAGE(PG8_SA(1, 0), a3, voffA);
            PG8_BAR; PG8_WAIT_L(0); PG8_MMA(1, 0, At, B0); PG8_BAR; PG8_SCHED;
            PG8_STAGE(PG8_SB(1, 1), b3 + hstep, voffB);
            PG8_WAIT_V(6); PG8_BAR; PG8_MMA(1, 1, At, B1); PG8_BAR;
            }
        }
        if constexpr (ALIGN_EPI) { if (wr == 0) PG8_BAR; }
        if constexpr (!Epi::AFTER_DRAIN) { E(acc, cur, wr, wc, fr, fq); S.done(cur); }
        if (!has_next) break;
#pragma unroll
        for (int a = 0; a < 2; ++a)
#pragma unroll
            for (int b = 0; b < 2; ++b)
#pragma unroll
                for (int m = 0; m < 4; ++m)
#pragma unroll
                    for (int n = 0; n < 2; ++n) acc[a][b][m][n] = (f32x4){0.f, 0.f, 0.f, 0.f};
        cur = nxt; cA = nA; cB = nB; ++ui;
        if constexpr (ALIGN_EPI) { if (wr == 1) PG8_BAR; }
    }
    PG8_WAIT_V(0);
    if constexpr (!ALIGN_EPI) { if (wr == 0) PG8_BAR; }
    PG8_BAR;
    if constexpr (Epi::AFTER_DRAIN) { E.fused(acc, cur, wr, wc, fr, fq, lds, wid, lane); S.done(cur); }
#undef PG8_SA
#undef PG8_SB
#undef PG8_STAGE
#undef PG8_LDA
#undef PG8_LDB
#undef PG8_MMA
#undef PG8_WAIT_V
#undef PG8_WAIT_L
#undef PG8_BAR
#undef PG8_SCHED
}
}

constexpr int NWAVES = 8, NTHR = 512;
constexpr int NB = 4, SEQ = 4096, DM = 2048, MTOK = NB * SEQ, NLAYER = 4;
constexpr int DFF = 5504, NUP = 2 * DFF;
constexpr int INC = 5028, INP = 5120;
constexpr int DRW = 768, RWC = 2560, PO_POOL = 2560, DPOOL = 512, PO_NSA = 3072;
constexpr int PO_Q = PO_NSA, PO_KC = PO_NSA + 768, PO_VC = PO_KC + 192, PO_KS = PO_VC + 192, PO_VS = PO_KS + 192, PO_KW = PO_VS + 192, PO_VW = PO_KW + 192, PO_GL = PO_VW + 192;
static_assert(PO_GL + 36 == INC, "W_in column map");
constexpr int NCMP = 255, NCMPP = 256;
constexpr float ALPHA = 1.6817928305074290f;
constexpr float LN_EPS = 1e-5f, GN_EPS = 64e-5f;
constexpr int NPH = 1 + 13 * NLAYER;

constexpr size_t MiB = 1u << 20;
constexpr size_t WS_CTL = 0, CTL_ZERO_BYTES = 1 * MiB;
constexpr size_t WS_ROPE = 1 * MiB;
constexpr size_t WS_KC = 2 * MiB, WS_VC = 2 * MiB + 512 * 1024;
constexpr size_t WS_SC = 3 * MiB;
constexpr size_t WS_WUP1 = 8 * MiB, WS_WDN1 = 51 * MiB, WS_WIN = WS_WDN1 + 21 * MiB + 512 * 1024, WS_WOUT = WS_WIN + 20 * MiB, WS_WUP2 = WS_WOUT + 8 * MiB, WS_WDN2 = WS_WUP2 + 43 * MiB;
constexpr size_t WS_XB = 165 * MiB;
static_assert(WS_WDN2 + (size_t)DM * DFF * 2 <= WS_XB, "weights map");
constexpr size_t WS_CAT = 229 * MiB;
constexpr size_t WS_QR = 293 * MiB;
constexpr size_t WS_KS = 317 * MiB, WS_KW = 323 * MiB, WS_VS = 329 * MiB, WS_VW = 335 * MiB;
constexpr size_t WS_P = 341 * MiB;
constexpr size_t WS_H = 661 * MiB;
constexpr size_t WS_Y = 833 * MiB;
constexpr size_t WS_SV = WS_H;
constexpr size_t SV_STRIDE = 48 * MiB;
static_assert(WS_SV + 6 * SV_STRIDE <= WS_Y + 128 * MiB, "scan overlay");
constexpr size_t WS_G = 961 * MiB, WS_YS = 1009 * MiB, WS_END = 1057 * MiB;

constexpr int LDS_BYTES = 147456, MISC_OFF = 131072 + 320;

#define GAS __attribute__((address_space(1)))
#define LAS __attribute__((address_space(3)))
typedef unsigned short bf16;
typedef float f32x4 __attribute__((ext_vector_type(4)));
typedef float f32x2 __attribute__((ext_vector_type(2)));
typedef unsigned u32x4 __attribute__((ext_vector_type(4)));
typedef unsigned u32x2 __attribute__((ext_vector_type(2)));
#define LDS_WAIT() asm volatile("s_waitcnt lgkmcnt(0)" ::: "memory")
__device__ __forceinline__ unsigned f2bf(float f) { unsigned u = __builtin_bit_cast(unsigned, f); return (u + 0x7fffu + ((u >> 16) & 1u)) >> 16; }
__device__ __forceinline__ unsigned pk2(float lo, float hi) { return f2bf(lo) | (f2bf(hi) << 16); }
__device__ __forceinline__ float bf2f(unsigned short b) { return __builtin_bit_cast(float, ((unsigned)b) << 16); }
__device__ __forceinline__ float wave_sum(float v) {
#pragma unroll
    for (int o = 1; o < 64; o <<= 1) v += __shfl_xor(v, o);
    return v;
}
__device__ __forceinline__ float wave_max(float v) {
#pragma unroll
    for (int o = 1; o < 64; o <<= 1) v = fmaxf(v, __shfl_xor(v, o));
    return v;
}
__device__ __forceinline__ float sigmoidf_(float x) { return 1.0f / (1.0f + expf(-x)); }
template <int CTRL> __device__ __forceinline__ float dpp_f(float v) { return __builtin_bit_cast(float, __builtin_amdgcn_update_dpp(0, __builtin_bit_cast(int, v), CTRL, 0xF, 0xF, true)); }
__device__ __forceinline__ float row16_sum(float v) {
    v += dpp_f<0xB1>(v); v += dpp_f<0x4E>(v); v += dpp_f<0x141>(v); v += dpp_f<0x140>(v); return v;
}

#define XB_TMO      128
#define XB_XCNT(j)  (256  + 64 * (j))
#define XB_XSUB(j)  (1280 + 64 * (j))
#define XB_XGEN(j)  (2304 + 64 * (j))
#define XB_TOP      3328
#define XB_TOPGEN   3392
#define XCD_BAR_WORDS 3456
#define XB_SPIN_CAP (1u << 18)

__device__ __forceinline__ unsigned xb_ld(unsigned* p)              { return __hip_atomic_load(p, __ATOMIC_RELAXED, __HIP_MEMORY_SCOPE_AGENT); }
__device__ __forceinline__ unsigned xb_add(unsigned* p, unsigned v) { return __hip_atomic_fetch_add(p, v, __ATOMIC_RELAXED, __HIP_MEMORY_SCOPE_AGENT); }
__device__ __forceinline__ unsigned xb_xcc_id() { return (unsigned)__builtin_amdgcn_s_getreg((3 << 11) | 20) & 0xFu; }
#define XB_SPIN(cond, bar) do { unsigned _sp = 0; while (cond) { __builtin_amdgcn_s_sleep(1); \
    if ((++_sp & 255u) == 0u) { if (xb_ld(&(bar)[XB_TMO])) break; if (_sp > XB_SPIN_CAP) { atomicAdd(&(bar)[XB_TMO], 1u); break; } } } } while (0)

struct XcdBarrier {
    unsigned* bar; unsigned x;
    volatile LAS unsigned* st;
};

__device__ __forceinline__ XcdBarrier xcd_barrier_post(unsigned* bar, volatile LAS unsigned* st) {
    XcdBarrier b; b.bar = bar; b.x = xb_xcc_id(); b.st = st;
    if (threadIdx.x == 0) (void)xb_add(&bar[XB_XCNT(b.x)], 1u);
    return b;
}
__device__ __forceinline__ void xcd_barrier_complete(unsigned* bar, unsigned x, unsigned& nloc, unsigned& nx) {
    const unsigned G = gridDim.x * gridDim.y * gridDim.z;
    unsigned sum, cnt, mine, sp = 0u;
    for (;;) {
        sum = 0u; cnt = 0u; mine = 0u;
#pragma unroll
        for (unsigned j = 0; j < 16; ++j) { const unsigned c = xb_ld(&bar[XB_XCNT(j)]); sum += c; cnt += (c > 0u) ? 1u : 0u; mine = (j == x) ? c : mine; }
        if (sum == G) break;
        __builtin_amdgcn_s_sleep(1);
        if ((++sp & 255u) == 0u) { if (xb_ld(&bar[XB_TMO])) break; if (sp > XB_SPIN_CAP) { atomicAdd(&bar[XB_TMO], 1u); break; } }
    }
    nloc = mine > 0u ? mine : 1u; nx = cnt > 0u ? cnt : 1u;
}

__device__ __forceinline__ void xcd_barrier(const XcdBarrier& b) {
    asm volatile("s_waitcnt vmcnt(0)" ::: "memory");
    __syncthreads();
    if (threadIdx.x == 0) {
        unsigned* bar = b.bar;
        __builtin_amdgcn_s_waitcnt(0);
        unsigned nloc = b.st[0], nx = b.st[1];
        if (nloc == 0u) { xcd_barrier_complete(bar, b.x, nloc, nx); b.st[0] = nloc; b.st[1] = nx; }
        const unsigned old = xb_add(&bar[XB_XSUB(b.x)], 1u);
        const unsigned gen = old / nloc;
        if (old + 1u == (gen + 1u) * nloc) {
            __builtin_amdgcn_fence(__ATOMIC_RELEASE, "agent");
            asm volatile("s_waitcnt vmcnt(0)" ::: "memory");
            const unsigned og = xb_add(&bar[XB_TOP], 1u);
            const unsigned tg = og / nx;
            if (og + 1u == (tg + 1u) * nx) xb_add(&bar[XB_TOPGEN], 1u);
            else XB_SPIN(xb_ld(&bar[XB_TOPGEN]) == tg, bar);
            __builtin_amdgcn_fence(__ATOMIC_ACQUIRE, "agent");
            xb_add(&bar[XB_XGEN(b.x)], 1u);
            asm volatile("s_waitcnt vmcnt(0)" ::: "memory");
        } else {
            XB_SPIN(xb_ld(&bar[XB_XGEN(b.x)]) == gen, bar);
            __builtin_amdgcn_fence(__ATOMIC_ACQUIRE, "agent");
            asm volatile("s_waitcnt vmcnt(0)" ::: "memory");
        }
    }
    __syncthreads();
}

struct Args { const float* in[34]; float* out; unsigned char* ws; int ph_lo, ph_hi; };
__device__ __forceinline__ int opaque0() { int z = 0; asm volatile("" : "+s"(z)); return z; }
#define OPQ_S(x) asm volatile("" : "+s"(x))
#define OPQ_SI(x) do { (x) = __builtin_amdgcn_readfirstlane(x); asm volatile("" : "+s"(x)); } while (0)
#define OPQ_V(x) asm volatile("" : "+v"(x))
#define INPTR(a, idx) ((a).in[(idx) + opaque0()])
enum { I_X = 0, I_UP1, I_DN1, I_LN1G, I_LN1B, I_WIN, I_MU, I_W0, I_W2, I_A0, I_A2, I_G2, I_KK, I_KA, I_RK, I_GNG, I_GNB, I_PW, I_PB, I_PS, I_PEK, I_PEV, I_CK1, I_CK2, I_CV1, I_CV2, I_GB, I_WOUT, I_LN2G, I_LN2B, I_UP2, I_DN2, I_LN3G, I_LN3B };

__device__ __forceinline__ void transpose_item(const float* W, int K, int Nsrc, bf16* WT, int dst0, LAS float* scr, int k0, int n0, int lane) {
    const int n = n0 + (lane & 31); const bool ok = n < Nsrc;
#pragma unroll 8
    for (int i = 0; i < 32; ++i) { const int kk = 2 * i + (lane >> 5); scr[kk * 33 + (lane & 31)] = ok ? W[(size_t)(k0 + kk) * Nsrc + n] : 0.f; }
    LDS_WAIT();
    const int c = lane & 7;
#pragma unroll
    for (int j = 0; j < 4; ++j) { const int nn = (lane >> 3) + 8 * j; const LAS float* s = scr + (8 * c) * 33 + nn;
        u32x4 o; o.x = pk2(s[0 * 33], s[1 * 33]); o.y = pk2(s[2 * 33], s[3 * 33]); o.z = pk2(s[4 * 33], s[5 * 33]); o.w = pk2(s[6 * 33], s[7 * 33]);
        *(u32x4*)(WT + (size_t)(dst0 + nn) * K + k0 + 8 * c) = o; }
    LDS_WAIT();
}
__device__ __forceinline__ int up_dst_row(int n0) { return n0 < DFF ? 256 * (n0 / 128) + (n0 % 128) : 256 * ((n0 - DFF) / 128) + 128 + ((n0 - DFF) % 128); }

__device__ __forceinline__ void phase_wconv(const Args& a, int l, LAS unsigned char* lds, int gw, int NGW, int wave, int lane) {
    OPQ_SI(gw); OPQ_SI(wave); OPQ_V(lane);
    LAS float* scr = (LAS float*)(lds + wave * 16384);
    unsigned char* ws = a.ws + opaque0();
    constexpr int I_UP = (DM / 64) * (NUP / 32), I_DN = (DFF / 64) * (DM / 32), I_IN = (DM / 64) * (INP / 32), I_OUT = (DM / 64) * (DM / 32);
    constexpr int NIT = 2 * I_UP + 2 * I_DN + I_IN + I_OUT;
    for (int it = gw; it < NIT; it += NGW) {
        int r = it;
        if (r < 2 * I_UP) { const int which = r / I_UP; r -= which * I_UP; const int nblk = NUP / 32, kb = r / nblk, nb = r % nblk;
            const float* W = a.in[which ? I_UP2 : I_UP1] + (size_t)l * DM * NUP; bf16* WT = (bf16*)(ws + (which ? WS_WUP2 : WS_WUP1));
            transpose_item(W, DM, NUP, WT, up_dst_row(32 * nb), scr, 64 * kb, 32 * nb, lane); continue; }
        r -= 2 * I_UP;
        if (r < 2 * I_DN) { const int which = r / I_DN; r -= which * I_DN; const int nblk = DM / 32, kb = r / nblk, nb = r % nblk;
            const float* W = a.in[which ? I_DN2 : I_DN1] + (size_t)l * DFF * DM; bf16* WT = (bf16*)(ws + (which ? WS_WDN2 : WS_WDN1));
            transpose_item(W, DFF, DM, WT, 32 * nb, scr, 64 * kb, 32 * nb, lane); continue; }
        r -= 2 * I_DN;
        if (r < I_IN) { const int nblk = INP / 32, kb = r / nblk, nb = r % nblk;
            transpose_item(INPTR(a, I_WIN) + (size_t)l * DM * INC, DM, INC, (bf16*)(ws + WS_WIN), 32 * nb, scr, 64 * kb, 32 * nb, lane); continue; }
        r -= I_IN;
        { const int nblk = DM / 32, kb = r / nblk, nb = r % nblk;
            transpose_item(INPTR(a, I_WOUT) + (size_t)l * DM * DM, DM, DM, (bf16*)(ws + WS_WOUT), 32 * nb, scr, 64 * kb, 32 * nb, lane); }
    }
}

__device__ __forceinline__ void phase_prologue(const Args& a, int gtid, int NGT) {
    OPQ_V(gtid);
    const f32x4* x4 = (const f32x4*)INPTR(a, I_X); u32x2* xb = (u32x2*)(a.ws + WS_XB);
    for (size_t i = gtid; i < (size_t)MTOK * DM / 4; i += NGT) { const f32x4 v = x4[i]; u32x2 o; o.x = pk2(v.x, v.y); o.y = pk2(v.z, v.w); xb[i] = o; }
    f32x2* rope = (f32x2*)(a.ws + WS_ROPE);
    for (int i = gtid; i < SEQ * 8; i += NGT) { const int s = i >> 3, k = i & 7;
        const float inv = powf(500000.0f, -(float)k * 0.125f); const float ang = (float)s * inv;
        const double ad = (double)ang; const double q = __builtin_rint(ad * 0.15915494309189535); const double rr = ad - q * 6.283185307179586;
        const float rf = (float)rr; rope[i] = (f32x2){cosf(rf), sinf(rf)}; }
}

__device__ __forceinline__ void phase_ln(const float* Y, const float* g, const float* b, float* X, bf16* XB, int gw, int NGW, int lane) {
    OPQ_SI(gw); OPQ_V(lane);
    f32x4 gv[8], bv[8];
#pragma unroll
    for (int j = 0; j < 8; ++j) { gv[j] = ((const f32x4*)g)[64 * j + lane]; bv[j] = ((const f32x4*)b)[64 * j + lane]; }
    for (int m = gw; m < MTOK; m += NGW) {
        const f32x4* yr = (const f32x4*)(Y + (size_t)m * DM) + lane; f32x4 v[8]; float s = 0.f;
#pragma unroll
        for (int j = 0; j < 8; ++j) { v[j] = yr[64 * j]; s += (v[j].x + v[j].y) + (v[j].z + v[j].w); }
        const float mean = wave_sum(s) * (1.f / DM); float s2 = 0.f;
#pragma unroll
        for (int j = 0; j < 8; ++j) { v[j] = v[j] - mean; s2 += (v[j].x * v[j].x + v[j].y * v[j].y) + (v[j].z * v[j].z + v[j].w * v[j].w); }
        const float rstd = 1.f / sqrtf(wave_sum(s2) * (1.f / DM) + LN_EPS);
        f32x4* xr = (f32x4*)(X + (size_t)m * DM) + lane; u32x2* xb = (u32x2*)(XB + (size_t)m * DM) + lane;
#pragma unroll
        for (int j = 0; j < 8; ++j) { const f32x4 o = v[j] * rstd * gv[j] + bv[j]; xr[64 * j] = o; u32x2 w; w.x = pk2(o.x, o.y); w.y = pk2(o.z, o.w); xb[64 * j] = w; }
    }
}

__device__ __forceinline__ void phase_m1(const Args& a, int l, LAS unsigned char* lds, int bid, int G, int tid, int wave, int lane) {
    OPQ_SI(bid); OPQ_V(tid); OPQ_SI(wave); lane = tid & 63;
    unsigned char* ws = a.ws + opaque0(); const float* P = (const float*)(ws + WS_P);
    {
        LAS float* sps = (LAS float*)lds;
        LAS float* tl = sps + 4 * RWC;
        LAS float* sg = tl + 4 * 64;
        const float* mu = INPTR(a, I_MU) + (size_t)l * RWC; const float* w0 = INPTR(a, I_W0) + (size_t)l * DRW; const float* w2 = INPTR(a, I_W2) + (size_t)l * 64 * DRW;
        const float* a0 = INPTR(a, I_A0) + (size_t)l * DRW; const float* a2 = INPTR(a, I_A2) + (size_t)l * 64 * DRW; const float* g2 = INPTR(a, I_G2) + (size_t)l * 128 * DRW;
        const float* k_k = INPTR(a, I_KK) + (size_t)l * DRW; const float* k_a = INPTR(a, I_KA) + (size_t)l * DRW; const float* r_k = INPTR(a, I_RK) + (size_t)l * DRW;
        float* vKK = (float*)(ws + WS_SV); float* vWR = (float*)(ws + WS_SV + SV_STRIDE); float* vW = (float*)(ws + WS_SV + 2 * SV_STRIDE);
        float* vKM = (float*)(ws + WS_SV + 3 * SV_STRIDE); float* vBB = (float*)(ws + WS_SV + 4 * SV_STRIDE); float* vV = (float*)(ws + WS_SV + 5 * SV_STRIDE);
        float* vG = (float*)(ws + WS_G); float* SC = (float*)(ws + WS_SC);
        for (int unit = bid; unit < MTOK / 4; unit += G) {
            const int t0 = unit * 4;
            for (int i = tid; i < 4 * RWC; i += NTHR) { const int tt = i / RWC, c = i - tt * RWC; const int m = t0 + tt; const int s = m & (SEQ - 1);
                const float pc = P[(size_t)m * INP + c]; const float pp = s > 0 ? P[(size_t)(m - 1) * INP + c] : 0.f; sps[i] = pc + (pp - pc) * mu[c]; }
            __syncthreads();
            for (int i = tid; i < 4 * 192; i += NTHR) { const int tt = i / 192, j = i - tt * 192;
                if (j < 64) tl[tt * 64 + j] = tanhf(sps[tt * RWC + 2304 + j]); else sg[tt * 128 + (j - 64)] = sigmoidf_(sps[tt * RWC + 2432 + (j - 64)]); }
            __syncthreads();
            for (int c = tid; c < DRW; c += NTHR) {
                float u[4] = {0.f, 0.f, 0.f, 0.f}, aa[4] = {0.f, 0.f, 0.f, 0.f}, gg[4] = {0.f, 0.f, 0.f, 0.f};
                for (int j = 0; j < 64; ++j) { const float w2v = w2[j * DRW + c], a2v = a2[j * DRW + c];
#pragma unroll
                    for (int tt = 0; tt < 4; ++tt) { u[tt] += tl[tt * 64 + j] * w2v; aa[tt] += sps[tt * RWC + 2368 + j] * a2v; } }
                for (int j = 0; j < 128; ++j) { const float g2v = g2[j * DRW + c];
#pragma unroll
                    for (int tt = 0; tt < 4; ++tt) gg[tt] += sg[tt * 128 + j] * g2v; }
                const float w0c = w0[c], a0c = a0[c], kkc = k_k[c], kac = k_a[c], rkc = r_k[c]; const int h = c >> 6;
#pragma unroll
                for (int tt = 0; tt < 4; ++tt) {
                    const size_t o = (size_t)(t0 + tt) * DRW + c;
                    const float uu = w0c + u[tt]; const float z = -uu; const float sp = z > 20.f ? z : log1pf(expf(z)); const float wlog = -sp - 0.5f; const float decay = expf(-expf(wlog));
                    const float av = sigmoidf_(a0c + aa[tt]);
                    const float r = sps[tt * RWC + c], k = sps[tt * RWC + 768 + c], v = sps[tt * RWC + 1536 + c];
                    const float kr = k * kkc; const float nrm = sqrtf(wave_sum(kr * kr)); const float kk = kr / fmaxf(nrm, 1e-12f);
                    const float km = k * (1.0f + (av - 1.0f) * kac); const float bb = kk * av;
                    vKK[o] = kk; vWR[o] = decay * r; vW[o] = decay; vKM[o] = km; vBB[o] = bb; vV[o] = v; vG[o] = gg[tt];
                    const float c1 = wave_sum(bb * r), c2 = wave_sum(km * r), bc = wave_sum(r * km * rkc);
                    if (lane == 0) *(f32x4*)(SC + ((size_t)(t0 + tt) * 12 + h) * 4) = (f32x4){c1, c2, bc, 0.f};
                }
            }
            __syncthreads();
        }
    }
    {
        LAS float* z = (LAS float*)lds;
        const float* pw = INPTR(a, I_PW) + (size_t)l * 4 * 128 * 128; const float* pb = INPTR(a, I_PB) + (size_t)l * DPOOL; const float* psc = INPTR(a, I_PS) + (size_t)l * DPOOL;
        bf16* CAT = (bf16*)(ws + WS_CAT);
        for (int unit = bid; unit < MTOK / 4; unit += G) {
            const int t0 = unit * 4;
            for (int i = tid; i < 4 * DPOOL; i += NTHR) { const int tt = i >> 9, ch = i & 511, gi = ch >> 7; const int m = t0 + tt, s = m & (SEQ - 1); const int win = 2 << gi; const int cnt = (s + 1) < win ? (s + 1) : win;
                float sum = 0.f; for (int j = 0; j < cnt; ++j) sum += P[(size_t)(m - j) * INP + PO_POOL + ch];
                z[i] = sum / (float)cnt - P[(size_t)m * INP + PO_POOL + ch]; }
            __syncthreads();
            { const int gi = tid >> 7, d = tid & 127; float acc[4] = {0.f, 0.f, 0.f, 0.f};
                for (int c = 0; c < 128; ++c) { const float wv = pw[(size_t)(gi * 128 + c) * 128 + d];
#pragma unroll
                    for (int tt = 0; tt < 4; ++tt) acc[tt] += z[tt * 512 + gi * 128 + c] * wv; }
                const float bv = pb[gi * 128 + d], sv = psc[gi * 128 + d];
#pragma unroll
                for (int tt = 0; tt < 4; ++tt) CAT[(size_t)(t0 + tt) * DM + DRW + gi * 128 + d] = (bf16)f2bf((acc[tt] + bv) * sv); }
            __syncthreads();
        }
    }
    {
        const f32x2* rope = (const f32x2*)(ws + WS_ROPE);
        bf16* QR = (bf16*)(ws + WS_QR); bf16* KS = (bf16*)(ws + WS_KS); bf16* KW = (bf16*)(ws + WS_KW); bf16* VS = (bf16*)(ws + WS_VS); bf16* VW = (bf16*)(ws + WS_VW);
        const int NGT = G * NTHR;
        for (int i = bid * NTHR + tid; i < MTOK * 1536; i += NGT) {
            const int m = i / 1536, c = i - m * 1536; const int s = m & (SEQ - 1); const float* pr = P + (size_t)m * INP;
            int src; bf16* dst; float scale = 1.f; bool rot;
            if (c < 768) { src = PO_Q + c; dst = QR + (size_t)m * 768 + c; scale = 0.125f; rot = true; }
            else if (c < 960) { src = PO_KS + (c - 768); dst = KS + (size_t)m * 192 + (c - 768); rot = true; }
            else if (c < 1152) { src = PO_KW + (c - 960); dst = KW + (size_t)m * 192 + (c - 960); rot = true; }
            else if (c < 1344) { src = PO_VS + (c - 1152); dst = VS + (size_t)m * 192 + (c - 1152); rot = false; }
            else { src = PO_VW + (c - 1344); dst = VW + (size_t)m * 192 + (c - 1344); rot = false; }
            const int d = c & 63; float v = pr[src];
            if (rot && d < 16) { const f32x2 cs = rope[s * 8 + (d & 7)];
                if (d < 8) v = v * cs.x - pr[src + 8] * cs.y; else v = v * cs.x + pr[src - 8] * cs.y; }
            *dst = (bf16)f2bf(v * scale);
        }
    }
    {
        LAS float* cs = (LAS float*)lds;
        LAS float* hid = cs + 2 * 80 * 64;
        const float* pe[2] = {INPTR(a, I_PEK) + (size_t)l * 2048, INPTR(a, I_PEV) + (size_t)l * 2048};
        const float* w1[2] = {INPTR(a, I_CK1) + (size_t)l * 2048 * 256, INPTR(a, I_CV1) + (size_t)l * 2048 * 256};
        const float* w2[2] = {INPTR(a, I_CK2) + (size_t)l * 256 * 64, INPTR(a, I_CV2) + (size_t)l * 256 * 64};
        const f32x2* rope = (const f32x2*)(ws + WS_ROPE);
        bf16* KC = (bf16*)(ws + WS_KC); bf16* VC = (bf16*)(ws + WS_VC);
        for (int unit = bid; unit < NB * 3 * 64; unit += G) {
            const int b = unit / 192, r = unit - b * 192, h = r >> 6, ng = r & 63, n0 = ng * 4;
            for (int i = tid; i < 2 * 80 * 64; i += NTHR) { const int ten = i / 5120, j = i - ten * 5120, tk = j >> 6, d = j & 63; const int s = 16 * n0 + tk;
                cs[i] = s < SEQ ? P[(size_t)(b * SEQ + s) * INP + (ten ? PO_VC : PO_KC) + h * 64 + d] : 0.f; }
            __syncthreads();
            { const int ten = tid >> 8, f = tid & 255; const float* w1p = (ten ? w1[1] : w1[0]) + f; const float* pep = ten ? pe[1] : pe[0]; const LAS float* csp = cs + ten * 5120;
                float acc[4] = {0.f, 0.f, 0.f, 0.f};
                for (int k = 0; k < 2048; ++k) { const float wv = w1p[(size_t)k * 256]; const float pv = pep[k]; const int ll = k >> 6, d = k & 63;
#pragma unroll
                    for (int nn = 0; nn < 4; ++nn) acc[nn] += (csp[(16 * nn + ll) * 64 + d] + pv) * wv; }
#pragma unroll
                for (int nn = 0; nn < 4; ++nn) { const float x = acc[nn]; hid[(ten * 4 + nn) * 256 + f] = 0.5f * x * (1.0f + tanhf(0.7978845608028654f * (x + 0.044715f * x * x * x))); } }
            __syncthreads();
            { const int ten = tid >> 8, nn = (tid >> 6) & 3, d = tid & 63; const float* w2p = (ten ? w2[1] : w2[0]) + d; const LAS float* hp = hid + (ten * 4 + nn) * 256;
                float o = 0.f; for (int f = 0; f < 256; ++f) o += hp[f] * w2p[f * 64];
                const int n = n0 + nn; const float other = __shfl_xor(o, 8);
                if (ten == 0 && d < 16) { const int pos = 16 * n + 31; const f32x2 c2 = rope[(pos & (SEQ - 1)) * 8 + (d & 7)]; o = d < 8 ? o * c2.x - other * c2.y : o * c2.x + other * c2.y; }
                if (n < NCMP) { bf16* dst = (ten ? VC : KC) + ((size_t)(b * NCMPP + n) * 3 + h) * 64 + d; *dst = (bf16)f2bf(o); } }
            __syncthreads();
        }
    }
}

constexpr int SCH = 16, SSTR = 360;
__device__ __forceinline__ void phase_scan(const Args& a, LAS unsigned char* lds, int bid, int tid, int wave, int lane) {
    OPQ_SI(bid); OPQ_V(tid); OPQ_SI(wave); lane = tid & 63;
    unsigned char* ws = a.ws + opaque0();
    const int hd = bid >> 1, half = bid & 1, b = hd / 12, h = hd - b * 12;
    const int rowl = wave * 4 + (lane >> 4), j = lane & 15;
    const float* SC = (const float*)(ws + WS_SC); float* YS = (float*)(ws + WS_YS);
    LAS float* buf = (LAS float*)lds;
    const size_t m0 = (size_t)b * SEQ;
    const float* src[3]; int dsto[3]; bool act[3];
#pragma unroll
    for (int q = 0; q < 3; ++q) { const int i = tid + q * NTHR; act[q] = i < SCH * 88; const int st = i / 88, r = i - st * 88;
        if (r < 80) { const int vec = r >> 4, part = r & 15; src[q] = (const float*)(ws + WS_SV + (size_t)vec * SV_STRIDE) + (m0 + st) * DRW + h * 64 + part * 4; dsto[q] = st * SSTR + vec * 64 + part * 4; }
        else { const int part = r - 80; src[q] = (const float*)(ws + WS_SV + 5 * SV_STRIDE) + (m0 + st) * DRW + h * 64 + half * 32 + part * 4; dsto[q] = st * SSTR + 320 + part * 4; } }
    const float* srcc = SC + ((m0 + (tid & 15)) * 12 + h) * 4; const int dstc = (tid & 15) * SSTR + 352;
    f32x4 pre[3]; f32x2 prec;
#define SCAN_LOAD(ck) do { _Pragma("unroll") for (int q = 0; q < 3; ++q) if (act[q]) pre[q] = *(const f32x4*)(src[q] + (size_t)(ck) * SCH * DRW); if (tid < 16) prec = *(const f32x2*)(srcc + (size_t)(ck) * SCH * 48); } while (0)
#define SCAN_STORE(bb) do { _Pragma("unroll") for (int q = 0; q < 3; ++q) if (act[q]) *(LAS f32x4*)(buf + (bb) * SCH * SSTR + dsto[q]) = pre[q]; if (tid < 16) *(LAS f32x2*)(buf + (bb) * SCH * SSTR + dstc) = prec; } while (0)
    SCAN_LOAD(0); SCAN_STORE(0); __syncthreads();
    float S0 = 0.f, S1 = 0.f, S2 = 0.f, S3 = 0.f;
    constexpr int NCH = SEQ / SCH;
    for (int ck = 0; ck < NCH; ++ck) {
        if (ck + 1 < NCH) SCAN_LOAD(ck + 1);
        const LAS float* cb = buf + (ck & 1) * SCH * SSTR;
#pragma unroll 4
        for (int st = 0; st < SCH; ++st) {
            const LAS float* sb = cb + st * SSTR;
            const f32x4 kk = *(const LAS f32x4*)(sb + 4 * j), wr = *(const LAS f32x4*)(sb + 64 + 4 * j), w = *(const LAS f32x4*)(sb + 128 + 4 * j), km = *(const LAS f32x4*)(sb + 192 + 4 * j), bb = *(const LAS f32x4*)(sb + 256 + 4 * j);
            const float v = sb[320 + rowl]; const f32x2 c = *(const LAS f32x2*)(sb + 352);
            float p1 = S0 * kk.x; p1 = fmaf(S1, kk.y, p1); p1 = fmaf(S2, kk.z, p1); p1 = fmaf(S3, kk.w, p1);
            float p2 = S0 * wr.x; p2 = fmaf(S1, wr.y, p2); p2 = fmaf(S2, wr.z, p2); p2 = fmaf(S3, wr.w, p2);
            const float sa = row16_sum(p1), y0 = row16_sum(p2);
            const float t0 = fmaf(S0, w.x, v * km.x), t1 = fmaf(S1, w.y, v * km.y), t2 = fmaf(S2, w.z, v * km.z), t3 = fmaf(S3, w.w, v * km.w);
            S0 = fmaf(-sa, bb.x, t0); S1 = fmaf(-sa, bb.y, t1); S2 = fmaf(-sa, bb.z, t2); S3 = fmaf(-sa, bb.w, t3);
            const float y = y0 - sa * c.x + v * c.y;
            if (j == 0) YS[(m0 + (size_t)ck * SCH + st) * DRW + h * 64 + half * 32 + rowl] = y;
        }
        if (ck + 1 < NCH) SCAN_STORE((ck + 1) & 1);
        __syncthreads();
    }
#undef SCAN_LOAD
#undef SCAN_STORE
}

#define WSYNC() asm volatile("s_waitcnt lgkmcnt(0)" ::: "memory")
__device__ __forceinline__ void dot4(const bf16* krow, const LAS float* qT, float (&s)[4]) {
    const u32x4* kp = (const u32x4*)krow; s[0] = s[1] = s[2] = s[3] = 0.f;
#pragma unroll
    for (int c8 = 0; c8 < 8; ++c8) { const u32x4 kv = kp[c8]; const unsigned w[4] = {kv.x, kv.y, kv.z, kv.w};
#pragma unroll
        for (int e = 0; e < 4; ++e) { const float klo = __builtin_bit_cast(float, w[e] << 16), khi = __builtin_bit_cast(float, w[e] & 0xffff0000u); const int d = c8 * 8 + 2 * e;
            const f32x4 qa = *(const LAS f32x4*)(qT + d * 4), qb = *(const LAS f32x4*)(qT + d * 4 + 4);
            s[0] = fmaf(qa.x, klo, s[0]); s[1] = fmaf(qa.y, klo, s[1]); s[2] = fmaf(qa.z, klo, s[2]); s[3] = fmaf(qa.w, klo, s[3]);
            s[0] = fmaf(qb.x, khi, s[0]); s[1] = fmaf(qb.y, khi, s[1]); s[2] = fmaf(qb.z, khi, s[2]); s[3] = fmaf(qb.w, khi, s[3]); } }
}
__device__ __forceinline__ void attend_block(const bf16* K, const bf16* V, int kbase, int lo, int hi, const LAS float* qT, LAS float* pb, int lane, float (&mx)[4], float (&ls)[4], float (&o)[4]) {
    const int kpos = kbase + lane; const bool valid = kpos >= lo && kpos <= hi;
    float s[4]; dot4(K + (size_t)kpos * 192, qT, s);
    float p[4];
#pragma unroll
    for (int g = 0; g < 4; ++g) { const float sv = valid ? s[g] : -INFINITY; const float bm = wave_max(sv); const float mn = fmaxf(mx[g], bm);
        const float sc = expf(mx[g] - mn); p[g] = valid ? expf(sv - mn) : 0.f; ls[g] = ls[g] * sc + wave_sum(p[g]); o[g] *= sc; mx[g] = mn; }
    *(LAS f32x4*)(pb + lane * 4) = (f32x4){p[0], p[1], p[2], p[3]};
    WSYNC();
    const bf16* vp = V + (size_t)kbase * 192 + lane;
#pragma unroll 8
    for (int jj = 0; jj < 64; ++jj) { const f32x4 p4 = *(const LAS f32x4*)(pb + jj * 4); const float vv = bf2f(vp[(size_t)jj * 192]);
        o[0] = fmaf(p4.x, vv, o[0]); o[1] = fmaf(p4.y, vv, o[1]); o[2] = fmaf(p4.z, vv, o[2]); o[3] = fmaf(p4.w, vv, o[3]); }
    WSYNC();
}
__device__ __forceinline__ void phase_nsa(const Args& a, int l, LAS unsigned char* lds, int gw, int NGW, int wave, int lane) {
    OPQ_SI(gw); OPQ_SI(wave); OPQ_V(lane);
    unsigned char* ws = a.ws + opaque0();
    LAS float* qT = (LAS float*)(lds + wave * 3072);
    LAS float* pb = qT + 256;
    LAS float* psum = pb + 256;
    const bf16* QR = (const bf16*)(ws + WS_QR); const bf16* KSb = (const bf16*)(ws + WS_KS); const bf16* KWb = (const bf16*)(ws + WS_KW); const bf16* VSb = (const bf16*)(ws + WS_VS); const bf16* VWb = (const bf16*)(ws + WS_VW);
    const bf16* KC = (const bf16*)(ws + WS_KC); const bf16* VC = (const bf16*)(ws + WS_VC);
    const float* P = (const float*)(ws + WS_P); const float* gate_b = INPTR(a, I_GB) + (size_t)l * 36; bf16* CAT = (bf16*)(ws + WS_CAT);
    for (int id = gw; id < MTOK * 3; id += NGW) {
        const int s = id & (SEQ - 1), bh = id >> 12, b = bh / 3, kvh = bh - b * 3; const size_t m = (size_t)b * SEQ + s;
#pragma unroll
        for (int g = 0; g < 4; ++g) qT[lane * 4 + g] = bf2f(QR[m * 768 + (kvh * 4 + g) * 64 + lane]);
        WSYNC();
        const int nv = s >= 31 ? ((s - 31) >> 4) + 1 : 0;
        float sc[4][4];
#pragma unroll
        for (int kt = 0; kt < 4; ++kt) {
            if (kt * 64 < nv) { float t[4]; dot4(KC + ((size_t)(b * NCMPP + kt * 64 + lane) * 3 + kvh) * 64, qT, t); const bool ok = kt * 64 + lane < nv;
#pragma unroll
                for (int g = 0; g < 4; ++g) sc[kt][g] = ok ? t[g] : -INFINITY; }
            else {
#pragma unroll
                for (int g = 0; g < 4; ++g) sc[kt][g] = -INFINITY; }
        }
        float pc[4][4];
#pragma unroll
        for (int g = 0; g < 4; ++g) { float mxv = wave_max(fmaxf(fmaxf(sc[0][g], sc[1][g]), fmaxf(sc[2][g], sc[3][g]))); if (!(mxv > -INFINITY)) mxv = 0.f; float es = 0.f;
#pragma unroll
            for (int kt = 0; kt < 4; ++kt) { pc[kt][g] = sc[kt][g] > -INFINITY ? expf(sc[kt][g] - mxv) : 0.f; es += pc[kt][g]; }
            const float inv = 1.0f / fmaxf(wave_sum(es), 1.17549435e-38f);
#pragma unroll
            for (int kt = 0; kt < 4; ++kt) pc[kt][g] *= inv; }
#pragma unroll
        for (int kt = 0; kt < 4; ++kt) psum[kt * 64 + lane] = (pc[kt][0] + pc[kt][1]) + (pc[kt][2] + pc[kt][3]);
        float oc[4] = {0.f, 0.f, 0.f, 0.f};
#pragma unroll
        for (int kt = 0; kt < 4; ++kt) {
            if (kt * 64 < nv) {
                *(LAS f32x4*)(pb + lane * 4) = (f32x4){pc[kt][0], pc[kt][1], pc[kt][2], pc[kt][3]};
                WSYNC();
                const int cnt = (nv - kt * 64) < 64 ? (nv - kt * 64) : 64; const bf16* vp = VC + ((size_t)(b * NCMPP + kt * 64) * 3 + kvh) * 64 + lane;
                for (int jj = 0; jj < cnt; ++jj) { const f32x4 p4 = *(const LAS f32x4*)(pb + jj * 4); const float vv = bf2f(vp[(size_t)jj * 192]);
                    oc[0] = fmaf(p4.x, vv, oc[0]); oc[1] = fmaf(p4.y, vv, oc[1]); oc[2] = fmaf(p4.z, vv, oc[2]); oc[3] = fmaf(p4.w, vv, oc[3]); }
                WSYNC();
            }
        }
        WSYNC();
        const int cur = s >> 6;
        float imp = psum[4 * lane] + psum[4 * lane + 1] + psum[4 * lane + 2] + 0.5f * psum[4 * lane + 3] + (lane > 0 ? 0.5f * psum[4 * lane - 1] : 0.f);
        const bool forced = (lane == 0) || (lane == cur) || (lane == cur - 1);
        float score = forced ? 1e9f : imp; if (lane > cur) score = -INFINITY;
        int rank = 0;
        for (int i = 0; i < 64; ++i) { const float si = __shfl(score, i); rank += (si > score || (si == score && i < lane)) ? 1 : 0; }
        unsigned long long selmask = __ballot(lane <= cur && rank < 16);
        float mx[4] = {-INFINITY, -INFINITY, -INFINITY, -INFINITY}, ls[4] = {0.f, 0.f, 0.f, 0.f}, os[4] = {0.f, 0.f, 0.f, 0.f};
        const bf16* Kb = KSb + ((size_t)b * SEQ * 3 + kvh) * 64; const bf16* Vb = VSb + ((size_t)b * SEQ * 3 + kvh) * 64;
        while (selmask) { const int jb = __builtin_ctzll(selmask); selmask &= selmask - 1; attend_block(Kb, Vb, jb * 64, 0, s, qT, pb, lane, mx, ls, os); }
#pragma unroll
        for (int g = 0; g < 4; ++g) os[g] = os[g] / fmaxf(ls[g], 1.17549435e-38f);
        float mw[4] = {-INFINITY, -INFINITY, -INFINITY, -INFINITY}, lw[4] = {0.f, 0.f, 0.f, 0.f}, ow[4] = {0.f, 0.f, 0.f, 0.f};
        const int lo = s - 511 > 0 ? s - 511 : 0;
        Kb = KWb + ((size_t)b * SEQ * 3 + kvh) * 64; Vb = VWb + ((size_t)b * SEQ * 3 + kvh) * 64;
        for (int jb = lo >> 6; jb <= cur; ++jb) attend_block(Kb, Vb, jb * 64, lo, s, qT, pb, lane, mw, lw, ow);
#pragma unroll
        for (int g = 0; g < 4; ++g) ow[g] = ow[g] / fmaxf(lw[g], 1.17549435e-38f);
#pragma unroll
        for (int g = 0; g < 4; ++g) { const int hq = kvh * 4 + g; const float* gl = P + m * INP + PO_GL + hq * 3; const float* gb = gate_b + hq * 3;
            const float g0 = sigmoidf_(gl[0] + gb[0]), g1 = sigmoidf_(gl[1] + gb[1]), g2 = sigmoidf_(gl[2] + gb[2]);
            CAT[m * DM + DRW + DPOOL + hq * 64 + lane] = (bf16)f2bf(g0 * oc[g] + g1 * os[g] + g2 * ow[g]); }
        WSYNC();
    }
}

__device__ __forceinline__ void phase_rwkv_out(const Args& a, int l, int gw, int NGW, int lane) {
    OPQ_SI(gw); OPQ_V(lane);
    unsigned char* ws = a.ws + opaque0(); const float* YS = (const float*)(ws + WS_YS); const float* vV = (const float*)(ws + WS_SV + 5 * SV_STRIDE); const float* vG = (const float*)(ws + WS_G); const float* SC = (const float*)(ws + WS_SC);
    const float* gng = INPTR(a, I_GNG) + (size_t)l * DRW; const float* gnb = INPTR(a, I_GNB) + (size_t)l * DRW; bf16* CAT = (bf16*)(ws + WS_CAT);
    for (int id = gw; id < MTOK * 12; id += NGW) { const int m = id / 12, h = id - m * 12, c = h * 64 + lane; const size_t o = (size_t)m * DRW + c;
        const float y = YS[o]; const float mean = wave_sum(y) * (1.f / 64.f); const float d = y - mean; const float var = wave_sum(d * d) * (1.f / 64.f);
        const float yn = d * (1.f / sqrtf(var + GN_EPS)) * gng[c] + gnb[c]; const float bonus = SC[((size_t)m * 12 + h) * 4 + 2] * vV[o];
        CAT[(size_t)m * DM + c] = (bf16)f2bf((yn + bonus) * vG[o]); }
}

template <int PHMASK> __global__ void __launch_bounds__(NTHR, 2) fwd(Args args) {
    extern __shared__ __attribute__((aligned(16))) unsigned char lds_raw[];
    LAS unsigned char* lds = (LAS unsigned char*)lds_raw;
    const int tid = threadIdx.x, lane = tid & 63, wave = __builtin_amdgcn_readfirstlane(tid >> 6);
    const int G = gridDim.x, bid = blockIdx.x; const int gw = bid * NWAVES + wave, NGW = G * NWAVES;
    unsigned char* ws = args.ws;
    for (int u = tid; u < (LDS_BYTES - 131072) / 4; u += NTHR) ((LAS unsigned*)(lds + 131072))[u] = 0u;
    __syncthreads();
    const int lo = args.ph_lo, hi = args.ph_hi;
    XcdBarrier bar; bar.bar = (unsigned*)(ws + WS_CTL) + 4096; bar.x = 0; bar.st = nullptr;
    if (hi - lo > 1) bar = xcd_barrier_post((unsigned*)(ws + WS_CTL) + 4096, (volatile LAS unsigned*)(lds + MISC_OFF) + 8);
#define IN(k) (lo <= (k) && (k) < hi)
#define PHEN(j) (((PHMASK) >> (j)) & 1)
#define SEAM(k) do { if ((k) + 1 < hi) xcd_barrier(bar); } while (0)
    bf16* XB = (bf16*)(ws + WS_XB); bf16* Hb = (bf16*)(ws + WS_H); float* Y = (float*)(ws + WS_Y); float* Pm = (float*)(ws + WS_P); bf16* CAT = (bf16*)(ws + WS_CAT);

    if (PHEN(0) && IN(0)) { phase_prologue(args, bid * NTHR + tid, G * NTHR); SEAM(0); }
    for (int l = 0; l < NLAYER; ++l) {
        const int pb = 1 + 13 * l;
        if (PHEN(1) && IN(pb + 0)) { phase_wconv(args, l, lds, gw, NGW, wave, lane); SEAM(pb + 0); }
        if (PHEN(2) && IN(pb + 1)) {
            pg8::Gemm g{XB, (const bf16*)(ws + WS_WUP1), MTOK, NUP, DM}; pg8::StaticOrder S; S.init(MTOK, NUP, G, bid); pg8::EpiSwiGLU E{Hb, DFF};
            pg8::gemm_phase<pg8::EpiSwiGLU, pg8::StaticOrder, true, true>(lds, g, S, E); SEAM(pb + 1); }
        if (PHEN(3) && IN(pb + 2)) {
            pg8::Gemm g{Hb, (const bf16*)(ws + WS_WDN1), MTOK, DM, DFF}; pg8::StaticOrder S; S.init(MTOK, DM, G, bid); pg8::EpiResid E{l == 0 ? INPTR(args, I_X) : args.out, Y, DM, ALPHA, 0.5f};
            pg8::gemm_phase<pg8::EpiResid, pg8::StaticOrder, true, true>(lds, g, S, E); SEAM(pb + 2); }
        if (PHEN(4) && IN(pb + 3)) { phase_ln(Y, INPTR(args, I_LN1G) + (size_t)l * DM, INPTR(args, I_LN1B) + (size_t)l * DM, args.out, XB, gw, NGW, lane); SEAM(pb + 3); }
        if (PHEN(5) && IN(pb + 4)) {
            pg8::Gemm g{XB, (const bf16*)(ws + WS_WIN), MTOK, INP, DM}; pg8::StaticOrder S; S.init(MTOK, INP, G, bid); pg8::EpiF32 E{Pm, INP};
            pg8::gemm_phase<pg8::EpiF32, pg8::StaticOrder, true, true>(lds, g, S, E); SEAM(pb + 4); }
        if (PHEN(6) && IN(pb + 5)) { phase_m1(args, l, lds, bid, G, tid, wave, lane); SEAM(pb + 5); }
        if (PHEN(7) && IN(pb + 6)) { if (bid < 96) phase_scan(args, lds, bid, tid, wave, lane); __syncthreads(); phase_nsa(args, l, lds, gw, NGW, wave, lane); SEAM(pb + 6); }
        if (PHEN(8) && IN(pb + 7)) { phase_rwkv_out(args, l, gw, NGW, lane); SEAM(pb + 7); }
        if (PHEN(9) && IN(pb + 8)) {
            pg8::Gemm g{CAT, (const bf16*)(ws + WS_WOUT), MTOK, DM, DM}; pg8::StaticOrder S; S.init(MTOK, DM, G, bid); pg8::EpiResid E{args.out, Y, DM, ALPHA, 1.0f};
            pg8::gemm_phase<pg8::EpiResid, pg8::StaticOrder, true, true>(lds, g, S, E); SEAM(pb + 8); }
        if (PHEN(10) && IN(pb + 9)) { phase_ln(Y, INPTR(args, I_LN2G) + (size_t)l * DM, INPTR(args, I_LN2B) + (size_t)l * DM, args.out, XB, gw, NGW, lane); SEAM(pb + 9); }
        if (PHEN(11) && IN(pb + 10)) {
            pg8::Gemm g{XB, (const bf16*)(ws + WS_WUP2), MTOK, NUP, DM}; pg8::StaticOrder S; S.init(MTOK, NUP, G, bid); pg8::EpiSwiGLU E{Hb, DFF};
            pg8::gemm_phase<pg8::EpiSwiGLU, pg8::StaticOrder, true, true>(lds, g, S, E); SEAM(pb + 10); }
        if (PHEN(12) && IN(pb + 11)) {
            pg8::Gemm g{Hb, (const bf16*)(ws + WS_WDN2), MTOK, DM, DFF}; pg8::StaticOrder S; S.init(MTOK, DM, G, bid); pg8::EpiResid E{args.out, Y, DM, ALPHA, 0.5f};
            pg8::gemm_phase<pg8::EpiResid, pg8::StaticOrder, true, true>(lds, g, S, E); SEAM(pb + 11); }
        if (PHEN(13) && IN(pb + 12)) { phase_ln(Y, INPTR(args, I_LN3G) + (size_t)l * DM, INPTR(args, I_LN3B) + (size_t)l * DM, args.out, XB, gw, NGW, lane); SEAM(pb + 12); }
    }
#undef IN
#undef SEAM
}

#ifndef ONE_MASK
#define ONE_MASK 0xFFFFF
#endif
#ifndef MK_ONE_LAUNCH
#define MK_ONE_LAUNCH 1
#endif
typedef void (*kern_t)(Args);
extern "C" void kernel_launch(void* const* d_in, const int* in_sizes, int n_in, void* d_out, int out_size, void* d_ws, size_t ws_size, hipStream_t stream) {
    static int grid = 0;
#if MK_ONE_LAUNCH
    static const kern_t kerns[1] = {fwd<ONE_MASK>};
    constexpr int NK = 1;
#else
    static const kern_t kerns[14] = {fwd<1 << 0>, fwd<1 << 1>, fwd<1 << 2>, fwd<1 << 3>, fwd<1 << 4>, fwd<1 << 5>, fwd<1 << 6>, fwd<1 << 7>, fwd<1 << 8>, fwd<1 << 9>, fwd<1 << 10>, fwd<1 << 11>, fwd<1 << 12>, fwd<1 << 13>};
    constexpr int NK = 14;
#endif
    if (grid == 0) {
        if (n_in != 34 || out_size != MTOK * DM || ws_size < WS_END) { fprintf(stderr, "kernel_launch: unexpected shapes (n_in %d, out %d, ws %zu; need ws >= %zu)\n", n_in, out_size, ws_size, (size_t)WS_END); grid = -1; return; }
        int dev = 0, cus = 0;
        if (hipGetDevice(&dev) != hipSuccess || hipDeviceGetAttribute(&cus, hipDeviceAttributeMultiprocessorCount, dev) != hipSuccess) { grid = -1; return; }
        for (int i = 0; i < NK; ++i) if (hipFuncSetAttribute((const void*)kerns[i], hipFuncAttributeMaxDynamicSharedMemorySize, LDS_BYTES) != hipSuccess) { fprintf(stderr, "kernel_launch: hipFuncSetAttribute failed\n"); grid = -1; return; }
        int per_cu = 0;
        if (hipOccupancyMaxActiveBlocksPerMultiprocessor(&per_cu, (const void*)kerns[0], NTHR, LDS_BYTES) != hipSuccess || per_cu < 1) fprintf(stderr, "kernel_launch: occupancy query says %d blocks per CU\n", per_cu);
        (void)hipGetLastError();
        grid = cus;
    }
    if (grid < 0) return;
    (void)hipMemsetAsync((char*)d_ws + WS_CTL, 0, CTL_ZERO_BYTES, stream);
    Args a{};
    for (int i = 0; i < 34; ++i) a.in[i] = (const float*)d_in[i];
    a.out = (float*)d_out; a.ws = (unsigned char*)d_ws;
#if MK_ONE_LAUNCH
    a.ph_lo = 0; a.ph_hi = NPH;
    hipLaunchKernelGGL(kerns[0], dim3(grid), dim3(NTHR), LDS_BYTES, stream, a);
#else
    for (int k = 0; k < NPH; ++k) { a.ph_lo = k; a.ph_hi = k + 1; const int j = k == 0 ? 0 : (k - 1) % 13 + 1; hipLaunchKernelGGL(kerns[j], dim3(grid), dim3(NTHR), LDS_BYTES, stream, a); }
#endif
}
```

```cpp
#include <hip/hip_runtime.h>
#include <cstdio>
#include <cstdint>
namespace pg8 {
#define PG8_LAS __attribute__((address_space(3)))
typedef unsigned short bf16_t;
typedef short bf16x8 __attribute__((ext_vector_type(8)));
typedef float f32x4 __attribute__((ext_vector_type(4)));
typedef unsigned u32x4 __attribute__((ext_vector_type(4)));
constexpr int BM = 256, BK = 64, HALF = 128, HTB = HALF * BK * 2  , STAGE_BYTES = 8 * HTB, NXCD = 8, WGM = 8;

__host__ __device__ __forceinline__ int lds_byte(int r, int c) { const int st = (r >> 4) * 2 + (c >> 5), rr = r & 15, cc = c & 31, ob = rr * 64 + cc * 2; return st * 1024 + (ob ^ (((ob >> 9) & 1) << 5)); }
__host__ __device__ __forceinline__ void stage_rc(int b, int& R, int& C) { const int st = b / 1024, sb = b % 1024, swz = sb ^ (((sb >> 9) & 1) << 5); R = (st >> 1) * 16 + swz / 64; C = (st & 1) * 32 + (swz % 64) / 2; }
__host__ __device__ __forceinline__ int perm32(int rho) { const int n = rho >> 4, i = rho & 15; return 8 * (i >> 2) + 4 * n + (i & 3); }

struct Unit { int pm, pn; };
struct Gemm { const bf16_t* A; const bf16_t* Bt; int M, N, K; };

struct StaticOrder {
    int nM, nN, nwg, G, c;
    __host__ __device__ void init(int M, int N, int G_, int c_) { nM = M / BM; nN = N / BM; nwg = nM * nN; G = G_; c = c_; }
    __host__ __device__ bool next(int i, Unit& u) const {
        const long L = (long)i * G + c; if (L >= nwg) return false;
        int wgid = (int)L; { const int q = nwg / NXCD, r = nwg % NXCD, xcd = wgid % NXCD, off = wgid / NXCD; wgid = (xcd < r ? xcd * (q + 1) : r * (q + 1) + (xcd - r) * q) + off; }
        const int nig = WGM * nN, gid = wgid / nig, fm = gid * WGM, gsz = (nM - fm) < WGM ? (nM - fm) : WGM;
        u.pm = fm + ((wgid % nig) % gsz); u.pn = (wgid % nig) / gsz; return true;
    }
    __device__ __forceinline__ void a_ready(const Unit&) const {}
    __device__ __forceinline__ void done(const Unit&) const {}
};

__device__ __forceinline__ unsigned cvt_pk_bf16(float lo, float hi) { unsigned r; asm volatile("v_cvt_pk_bf16_f32 %0, %1, %2" : "=v"(r) : "v"(lo), "v"(hi)); return r; }
typedef float f32x2 __attribute__((ext_vector_type(2)));
struct EpiSwiGLU {
    static constexpr bool PERM = true, AFTER_DRAIN = false;
    bf16_t* H; int ldh;
    __device__ __forceinline__ void operator()(const f32x4 (&acc)[2][2][4][2], const Unit& u, int wr, int wc, int fr, int fq) const {
        const int row0 = u.pm * BM + wr * 64 + fr, col0 = u.pn * HALF + wc * 32 + 8 * fq;
#pragma unroll
        for (int ai = 0; ai < 2; ++ai)
#pragma unroll
            for (int m = 0; m < 4; ++m) { bf16_t* rowp = H + (size_t)(row0 + ai * HALF + m * 16) * ldh + col0;
                float hv[8];
#pragma unroll
                for (int n = 0; n < 2; ++n)
#pragma unroll
                    for (int i = 0; i < 4; ++i) { const float a = acc[ai][0][m][n][i], b = acc[ai][1][m][n][i];
                        const float e = __builtin_amdgcn_exp2f(a * -1.44269504089f); hv[n * 4 + i] = a * __builtin_amdgcn_rcpf(1.0f + e) * b; }
                u32x4 w; w.x = cvt_pk_bf16(hv[0], hv[1]); w.y = cvt_pk_bf16(hv[2], hv[3]); w.z = cvt_pk_bf16(hv[4], hv[5]); w.w = cvt_pk_bf16(hv[6], hv[7]);
                *(u32x4*)rowp = w; }
    }
};
struct EpiResid {
    static constexpr bool PERM = false, AFTER_DRAIN = false;
    const float* X; float* Y; int ldc; float alpha, s;
    __device__ __forceinline__ void operator()(const f32x4 (&acc)[2][2][4][2], const Unit& u, int wr, int wc, int fr, int fq) const {
        const int row0 = u.pm * BM + wr * 64 + fr, col0 = u.pn * BM + wc * 32 + 4 * fq;
#pragma unroll
        for (int ai = 0; ai < 2; ++ai)
#pragma unroll
            for (int m = 0; m < 4; ++m) { const size_t off = (size_t)(row0 + ai * HALF + m * 16) * ldc + col0;
#pragma unroll
                for (int bj = 0; bj < 2; ++bj)
#pragma unroll
                    for (int n = 0; n < 2; ++n) { const f32x4 xv = *(const f32x4*)(X + off + bj * HALF + n * 16); *(f32x4*)(Y + off + bj * HALF + n * 16) = xv * alpha + acc[ai][bj][m][n] * s; }
                asm volatile("" ::: "memory"); }
    }
};
struct EpiF32 {
    static constexpr bool PERM = false, AFTER_DRAIN = false;
    float* C; int ldc;
    __device__ __forceinline__ void operator()(const f32x4 (&acc)[2][2][4][2], const Unit& u, int wr, int wc, int fr, int fq) const {
        const int row0 = u.pm * BM + wr * 64 + fr, col0 = u.pn * BM + wc * 32 + 4 * fq;
#pragma unroll
        for (int ai = 0; ai < 2; ++ai)
#pragma unroll
            for (int m = 0; m < 4; ++m) { float* rowp = C + (size_t)(row0 + ai * HALF + m * 16) * ldc + col0;
#pragma unroll
                for (int bj = 0; bj < 2; ++bj)
#pragma unroll
                    for (int n = 0; n < 2; ++n) *(f32x4*)(rowp + bj * HALF + n * 16) = acc[ai][bj][m][n]; }
    }
};

template <class Epi, class Sched, bool ALIGN_EPI = false, bool SP2 = false>
__device__ __forceinline__ void gemm_phase(PG8_LAS unsigned char* lds, const Gemm g, const Sched& S, const Epi& E) {
    int tid_ = threadIdx.x; asm volatile("" : "+v"(tid_));
    const int tid = tid_, wid = __builtin_amdgcn_readfirstlane(tid >> 6), lane = tid & 63, wr = wid >> 2, wc = wid & 3, fr = lane & 15, fq = lane >> 4;
    const int K = g.K, nt = K / BK;
    unsigned voffA[2], voffB[2];
#pragma unroll
    for (int i = 0; i < 2; ++i) { int R, C; stage_rc(tid * 16 + i * 8192, R, C); const int Rb = Epi::PERM ? ((R & ~31) + perm32(R & 31)) : R;
        voffA[i] = (unsigned)(R * K + C) * 2u; voffB[i] = (unsigned)(Rb * K + C) * 2u; }
    const size_t kstep = (size_t)(BK * 2);
    const size_t hstep = (size_t)HALF * K * 2;
    const size_t tstep = 2 * hstep;
    const unsigned ldsw = (unsigned)wid * 1024u;
    const int aoff = lds_byte(wr * 64 + fr, fq * 8), boff = lds_byte(wc * 32 + fr, fq * 8);
#define PG8_SA(b, h) (((b) * 2 + (h)) * HTB)
#define PG8_SB(b, h) ((4 + (b) * 2 + (h)) * HTB)
#define PG8_STAGE(bufoff, gbase, voff) do { _Pragma("unroll") for (int _i = 0; _i < 2; ++_i) \
        __builtin_amdgcn_global_load_lds((const unsigned*)((const char*)(gbase) + (voff)[_i]), (PG8_LAS unsigned*)(lds + (bufoff) + ldsw + _i * 8192), 16, 0, 0); } while (0)
#define PG8_LDA(dst, b, h) do { _Pragma("unroll") for (int m = 0; m < 4; ++m) _Pragma("unroll") for (int k = 0; k < 2; ++k) dst[m][k] = *(const PG8_LAS bf16x8*)(lds + PG8_SA(b, h) + aoff + m * 2048 + k * 1024); } while (0)
#define PG8_LDB(dst, b, h) do { _Pragma("unroll") for (int n = 0; n < 2; ++n) _Pragma("unroll") for (int k = 0; k < 2; ++k) dst[n][k] = *(const PG8_LAS bf16x8*)(lds + PG8_SB(b, h) + boff + n * 2048 + k * 1024); } while (0)
#define PG8_MMA(ai, bj, At, Bt) do { __builtin_amdgcn_s_setprio(1); _Pragma("unroll") for (int m = 0; m < 4; ++m) _Pragma("unroll") for (int n = 0; n < 2; ++n) _Pragma("unroll") for (int k = 0; k < 2; ++k) \
        acc[ai][bj][m][n] = __builtin_amdgcn_mfma_f32_16x16x32_bf16(Bt[n][k], At[m][k], acc[ai][bj][m][n], 0, 0, 0); __builtin_amdgcn_s_setprio(0); } while (0)
#define PG8_WAIT_V(n) asm volatile("s_waitcnt vmcnt(" #n ")" ::: "memory")
#define PG8_WAIT_L(n) asm volatile("s_waitcnt lgkmcnt(" #n ")" ::: "memory")
#define PG8_BAR __builtin_amdgcn_s_barrier()
#define PG8_SCHED __builtin_amdgcn_sched_barrier(0)
    Unit cur, nxt; int ui = 0;
    if (!S.next(0, cur)) return;
    f32x4 acc[2][2][4][2];
#pragma unroll
    for (int a = 0; a < 2; ++a)
#pragma unroll
        for (int b = 0; b < 2; ++b)
#pragma unroll
            for (int m = 0; m < 4; ++m)
#pragma unroll
                for (int n = 0; n < 2; ++n) acc[a][b][m][n] = (f32x4){0.f, 0.f, 0.f, 0.f};
    bf16x8 At[4][2], B0[2][2], B1[2][2];
    const char* cA = (const char*)g.A + (size_t)cur.pm * tstep; const char* cB = (const char*)g.Bt + (size_t)cur.pn * tstep;
    S.a_ready(cur);
    if constexpr (SP2) {
        PG8_STAGE(PG8_SB(0, 0), cB, voffB); PG8_STAGE(PG8_SB(0, 1), cB + hstep, voffB); PG8_STAGE(PG8_SA(0, 0), cA, voffA); PG8_STAGE(PG8_SA(0, 1), cA + hstep, voffA);
        if (wr == 1) PG8_BAR;
        PG8_WAIT_V(2); PG8_BAR;
        PG8_STAGE(PG8_SB(1, 0), cB + kstep, voffB); PG8_STAGE(PG8_SA(1, 0), cA + kstep, voffA); PG8_STAGE(PG8_SB(1, 1), cB + hstep + kstep, voffB);
        PG8_WAIT_V(6); PG8_BAR;
    } else {
        PG8_STAGE(PG8_SB(0, 0), cB, voffB); PG8_STAGE(PG8_SA(0, 0), cA, voffA); PG8_STAGE(PG8_SB(0, 1), cB + hstep, voffB); PG8_STAGE(PG8_SA(0, 1), cA + hstep, voffA);
        if (wr == 1) PG8_BAR;
        PG8_WAIT_V(4); PG8_BAR;
        PG8_STAGE(PG8_SB(1, 0), cB + kstep, voffB); PG8_STAGE(PG8_SA(1, 0), cA + kstep, voffA); PG8_STAGE(PG8_SB(1, 1), cB + hstep + kstep, voffB);
        PG8_WAIT_V(6); PG8_BAR;
    }
    for (;;) {
        const bool has_next = S.next(ui + 1, nxt);
        const char* nA = has_next ? (const char*)g.A + (size_t)nxt.pm * tstep : cA; const char* nB = has_next ? (const char*)g.Bt + (size_t)nxt.pn * tstep : cB;
        for (int t = 0; t < nt; t += 2) {
            const bool last = (t == nt - 2);
            const char* a1 = cA + (size_t)(t + 1) * kstep;
            const char* a2 = last ? nA : cA + (size_t)(t + 2) * kstep; const char* b2 = last ? nB : cB + (size_t)(t + 2) * kstep;
            const char* a3 = a2 + kstep; const char* b3 = b2 + kstep;
            if (last && has_next) S.a_ready(nxt);
            if constexpr (SP2) {
            PG8_LDB(B0, 0, 0); PG8_LDB(B1, 0, 1); PG8_SCHED; PG8_LDA(At, 0, 0); PG8_STAGE(PG8_SA(1, 1), a1 + hstep, voffA);
            PG8_WAIT_V(8); PG8_WAIT_L(0); PG8_BAR; PG8_MMA(0, 0, At, B0); PG8_MMA(0, 1, At, B1); PG8_BAR; PG8_SCHED;
            PG8_LDA(At, 0, 1); PG8_STAGE(PG8_SB(0, 0), b2, voffB); PG8_STAGE(PG8_SB(0, 1), b2 + hstep, voffB); PG8_STAGE(PG8_SA(0, 0), a2, voffA);
            PG8_WAIT_V(8); PG8_WAIT_L(0); PG8_BAR; PG8_MMA(1, 0, At, B0); PG8_MMA(1, 1, At, B1); PG8_BAR; PG8_SCHED;
            PG8_LDB(B0, 1, 0); PG8_LDB(B1, 1, 1); PG8_SCHED; PG8_LDA(At, 1, 0); PG8_STAGE(PG8_SA(0, 1), a2 + hstep, voffA);
            PG8_WAIT_V(8); PG8_WAIT_L(0); PG8_BAR; PG8_MMA(0, 0, At, B0); PG8_MMA(0, 1, At, B1); PG8_BAR; PG8_SCHED;
            PG8_LDA(At, 1, 1); PG8_STAGE(PG8_SB(1, 0), b3, voffB); PG8_STAGE(PG8_SB(1, 1), b3 + hstep, voffB); PG8_STAGE(PG8_SA(1, 0), a3, voffA);
            PG8_WAIT_V(8); PG8_WAIT_L(0); PG8_BAR; PG8_MMA(1, 0, At, B0); PG8_MMA(1, 1, At, B1); PG8_BAR; PG8_SCHED;
            } else {
            PG8_LDB(B0, 0, 0); PG8_SCHED; PG8_LDA(At, 0, 0); PG8_STAGE(PG8_SA(1, 1), a1 + hstep, voffA);
            PG8_WAIT_L(8); PG8_BAR; PG8_WAIT_L(0); PG8_MMA(0, 0, At, B0); PG8_BAR; PG8_SCHED;
            PG8_LDB(B1, 0, 1); PG8_STAGE(PG8_SB(0, 0), b2, voffB);
            PG8_BAR; PG8_WAIT_L(0); PG8_MMA(0, 1, At, B1); PG8_BAR;
            PG8_LDA(At, 0, 1); PG8_STAGE(PG8_SA(0, 0), a2, voffA);
            PG8_BAR; PG8_WAIT_L(0); PG8_MMA(1, 0, At, B0); PG8_BAR; PG8_SCHED;
            PG8_STAGE(PG8_SB(0, 1), b2 + hstep, voffB);
            PG8_WAIT_V(6); PG8_BAR; PG8_MMA(1, 1, At, B1); PG8_BAR;
            PG8_LDB(B0, 1, 0); PG8_SCHED; PG8_LDA(At, 1, 0); PG8_STAGE(PG8_SA(0, 1), a2 + hstep, voffA);
            PG8_WAIT_L(8); PG8_BAR; PG8_WAIT_L(0); PG8_MMA(0, 0, At, B0); PG8_BAR; PG8_SCHED;
            PG8_LDB(B1, 1, 1); PG8_STAGE(PG8_SB(1, 0), b3, voffB);
            PG8_BAR; PG8_WAIT_L(0); PG8_MMA(0, 1, At, B1); PG8_BAR;
            PG8_LDA(At, 1, 1); PG8_STAGE(PG8_SA(1, 0), a3, voffA);
            PG8_BAR; PG8_WAIT_L(0); PG8_MMA(1, 0, At, B0); PG8_BAR; PG8_SCHED;
            PG8_STAGE(PG8_SB(1, 1), b3 + hstep, voffB);
            PG8_WAIT_V(6); PG8_BAR; PG8_MMA(1, 1, At, B1); PG8_BAR;
            }
        }
        if constexpr (ALIGN_EPI) { if (wr == 0) PG8_BAR; }
        if constexpr (!Epi::AFTER_DRAIN) { E(acc, cur, wr, wc, fr, fq); S.done(cur); }
        if (!has_next) break;
#pragma unroll
        for (int a = 0; a < 2; ++a)
#pragma unroll
            for (int b = 0; b < 2; ++b)
#pragma unroll
                for (int m = 0; m < 4; ++m)
#pragma unroll
                    for (int n = 0; n < 2; ++n) acc[a][b][m][n] = (f32x4){0.f, 0.f, 0.f, 0.f};
        cur = nxt; cA = nA; cB = nB; ++ui;
        if constexpr (ALIGN_EPI) { if (wr == 1) PG8_BAR; }
    }
    PG8_WAIT_V(0);
    if constexpr (!ALIGN_EPI) { if (wr == 0) PG8_BAR; }
    PG8_BAR;
    if constexpr (Epi::AFTER_DRAIN) { E.fused(acc, cur, wr, wc, fr, fq, lds, wid, lane); S.done(cur); }
#undef PG8_SA
#undef PG8_SB
#undef PG8_STAGE
#undef PG8_LDA
#undef PG8_LDB
#undef PG8_MMA
#undef PG8_WAIT_V
#undef PG8_WAIT_L
#undef PG8_BAR
#undef PG8_SCHED
}
}

constexpr int NWAVES = 8, NTHR = 512;
constexpr int NB = 4, SEQ = 4096, DM = 2048, MTOK = NB * SEQ, NLAYER = 4;
constexpr int DFF = 5504, NUP = 2 * DFF;
constexpr int INC = 5028, INP = 5120;
constexpr int DRW = 768, RWC = 2560, PO_POOL = 2560, DPOOL = 512, PO_NSA = 3072;
constexpr int PO_Q = PO_NSA, PO_KC = PO_NSA + 768, PO_VC = PO_KC + 192, PO_KS = PO_VC + 192, PO_VS = PO_KS + 192, PO_KW = PO_VS + 192, PO_VW = PO_KW + 192, PO_GL = PO_VW + 192;
static_assert(PO_GL + 36 == INC, "W_in column map");
constexpr int NCMP = 255, NCMPP = 256;
constexpr float ALPHA = 1.6817928305074290f;
constexpr float LN_EPS = 1e-5f, GN_EPS = 64e-5f;
constexpr int NPH = 1 + 13 * NLAYER;

constexpr size_t MiB = 1u << 20;
constexpr size_t WS_CTL = 0, CTL_ZERO_BYTES = 1 * MiB;
constexpr size_t WS_ROPE = 1 * MiB;
constexpr size_t WS_KC = 2 * MiB, WS_VC = 2 * MiB + 512 * 1024;
constexpr size_t WS_SC = 3 * MiB;
constexpr size_t WS_WUP1 = 8 * MiB, WS_WDN1 = 51 * MiB, WS_WIN = WS_WDN1 + 21 * MiB + 512 * 1024, WS_WOUT = WS_WIN + 20 * MiB, WS_WUP2 = WS_WOUT + 8 * MiB, WS_WDN2 = WS_WUP2 + 43 * MiB;
constexpr size_t WS_XB = 165 * MiB;
static_assert(WS_WDN2 + (size_t)DM * DFF * 2 <= WS_XB, "weights map");
constexpr size_t WS_CAT = 229 * MiB;
constexpr size_t WS_QR = 293 * MiB;
constexpr size_t WS_KS = 317 * MiB, WS_KW = 323 * MiB, WS_VS = 329 * MiB, WS_VW = 335 * MiB;
constexpr size_t WS_P = 341 * MiB;
constexpr size_t WS_H = 661 * MiB;
constexpr size_t WS_Y = 833 * MiB;
constexpr size_t WS_SV = WS_H;
constexpr size_t SV_STRIDE = 48 * MiB;
static_assert(WS_SV + 6 * SV_STRIDE <= WS_Y + 128 * MiB, "scan overlay");
constexpr size_t WS_G = 961 * MiB, WS_YS = 1009 * MiB;
constexpr size_t WS_VST = 1057 * MiB, WS_VWT = 1063 * MiB, WS_END = 1069 * MiB;
constexpr size_t WS_VCT = 6 * MiB;

constexpr int LDS_BYTES = 147456, MISC_OFF = 131072 + 320;

#define GAS __attribute__((address_space(1)))
#define LAS __attribute__((address_space(3)))
typedef unsigned short bf16;
typedef float f32x4 __attribute__((ext_vector_type(4)));
typedef float f32x2 __attribute__((ext_vector_type(2)));
typedef unsigned u32x4 __attribute__((ext_vector_type(4)));
typedef unsigned u32x2 __attribute__((ext_vector_type(2)));
#define LDS_WAIT() asm volatile("s_waitcnt lgkmcnt(0)" ::: "memory")
__device__ __forceinline__ unsigned f2bf(float f) { unsigned u = __builtin_bit_cast(unsigned, f); return (u + 0x7fffu + ((u >> 16) & 1u)) >> 16; }
__device__ __forceinline__ unsigned pk2(float lo, float hi) { return f2bf(lo) | (f2bf(hi) << 16); }
__device__ __forceinline__ float bf2f(unsigned short b) { return __builtin_bit_cast(float, ((unsigned)b) << 16); }
__device__ __forceinline__ float wave_sum(float v) {
#pragma unroll
    for (int o = 1; o < 64; o <<= 1) v += __shfl_xor(v, o);
    return v;
}
__device__ __forceinline__ float wave_max(float v) {
#pragma unroll
    for (int o = 1; o < 64; o <<= 1) v = fmaxf(v, __shfl_xor(v, o));
    return v;
}
__device__ __forceinline__ float sigmoidf_(float x) { return 1.0f / (1.0f + expf(-x)); }
template <int CTRL> __device__ __forceinline__ float dpp_f(float v) { return __builtin_bit_cast(float, __builtin_amdgcn_update_dpp(0, __builtin_bit_cast(int, v), CTRL, 0xF, 0xF, true)); }
__device__ __forceinline__ float row16_sum(float v) {
    v += dpp_f<0xB1>(v); v += dpp_f<0x4E>(v); v += dpp_f<0x141>(v); v += dpp_f<0x140>(v); return v;
}

#define XB_TMO      128
#define XB_XCNT(j)  (256  + 64 * (j))
#define XB_XSUB(j)  (1280 + 64 * (j))
#define XB_XGEN(j)  (2304 + 64 * (j))
#define XB_TOP      3328
#define XB_TOPGEN   3392
#define XCD_BAR_WORDS 3456
#define XB_SPIN_CAP (1u << 18)

__device__ __forceinline__ unsigned xb_ld(unsigned* p)              { return __hip_atomic_load(p, __ATOMIC_RELAXED, __HIP_MEMORY_SCOPE_AGENT); }
__device__ __forceinline__ unsigned xb_add(unsigned* p, unsigned v) { return __hip_atomic_fetch_add(p, v, __ATOMIC_RELAXED, __HIP_MEMORY_SCOPE_AGENT); }
__device__ __forceinline__ unsigned xb_xcc_id() { return (unsigned)__builtin_amdgcn_s_getreg((3 << 11) | 20) & 0xFu; }
#define XB_SPIN(cond, bar) do { unsigned _sp = 0; while (cond) { __builtin_amdgcn_s_sleep(1); \
    if ((++_sp & 255u) == 0u) { if (xb_ld(&(bar)[XB_TMO])) break; if (_sp > XB_SPIN_CAP) { atomicAdd(&(bar)[XB_TMO], 1u); break; } } } } while (0)

struct XcdBarrier {
    unsigned* bar; unsigned x;
    volatile LAS unsigned* st;
};

__device__ __forceinline__ XcdBarrier xcd_barrier_post(unsigned* bar, volatile LAS unsigned* st) {
    XcdBarrier b; b.bar = bar; b.x = xb_xcc_id(); b.st = st;
    if (threadIdx.x == 0) (void)xb_add(&bar[XB_XCNT(b.x)], 1u);
    return b;
}
__device__ __forceinline__ void xcd_barrier_complete(unsigned* bar, unsigned x, unsigned& nloc, unsigned& nx) {
    const unsigned G = gridDim.x * gridDim.y * gridDim.z;
    unsigned sum, cnt, mine, sp = 0u;
    for (;;) {
        sum = 0u; cnt = 0u; mine = 0u;
#pragma unroll
        for (unsigned j = 0; j < 16; ++j) { const unsigned c = xb_ld(&bar[XB_XCNT(j)]); sum += c; cnt += (c > 0u) ? 1u : 0u; mine = (j == x) ? c : mine; }
        if (sum == G) break;
        __builtin_amdgcn_s_sleep(1);
        if ((++sp & 255u) == 0u) { if (xb_ld(&bar[XB_TMO])) break; if (sp > XB_SPIN_CAP) { atomicAdd(&bar[XB_TMO], 1u); break; } }
    }
    nloc = mine > 0u ? mine : 1u; nx = cnt > 0u ? cnt : 1u;
}

__device__ __forceinline__ void xcd_barrier(const XcdBarrier& b) {
    asm volatile("s_waitcnt vmcnt(0)" ::: "memory");
    __syncthreads();
    if (threadIdx.x == 0) {
        unsigned* bar = b.bar;
        __builtin_amdgcn_s_waitcnt(0);
        unsigned nloc = b.st[0], nx = b.st[1];
        if (nloc == 0u) { xcd_barrier_complete(bar, b.x, nloc, nx); b.st[0] = nloc; b.st[1] = nx; }
        const unsigned old = xb_add(&bar[XB_XSUB(b.x)], 1u);
        const unsigned gen = old / nloc;
        if (old + 1u == (gen + 1u) * nloc) {
            __builtin_amdgcn_fence(__ATOMIC_RELEASE, "agent");
            asm volatile("s_waitcnt vmcnt(0)" ::: "memory");
            const unsigned og = xb_add(&bar[XB_TOP], 1u);
            const unsigned tg = og / nx;
            if (og + 1u == (tg + 1u) * nx) xb_add(&bar[XB_TOPGEN], 1u);
            else XB_SPIN(xb_ld(&bar[XB_TOPGEN]) == tg, bar);
            __builtin_amdgcn_fence(__ATOMIC_ACQUIRE, "agent");
            xb_add(&bar[XB_XGEN(b.x)], 1u);
            asm volatile("s_waitcnt vmcnt(0)" ::: "memory");
        } else {
            XB_SPIN(xb_ld(&bar[XB_XGEN(b.x)]) == gen, bar);
            __builtin_amdgcn_fence(__ATOMIC_ACQUIRE, "agent");
            asm volatile("s_waitcnt vmcnt(0)" ::: "memory");
        }
    }
    __syncthreads();
}

struct Args { const float* in[34]; float* out; unsigned char* ws; int ph_lo, ph_hi; };
__device__ __forceinline__ int opaque0() { int z = 0; asm volatile("" : "+s"(z)); return z; }
#define OPQ_S(x) asm volatile("" : "+s"(x))
#define OPQ_SI(x) do { (x) = __builtin_amdgcn_readfirstlane(x); asm volatile("" : "+s"(x)); } while (0)
#define OPQ_V(x) asm volatile("" : "+v"(x))
#define INPTR(a, idx) ((a).in[(idx) + opaque0()])
enum { I_X = 0, I_UP1, I_DN1, I_LN1G, I_LN1B, I_WIN, I_MU, I_W0, I_W2, I_A0, I_A2, I_G2, I_KK, I_KA, I_RK, I_GNG, I_GNB, I_PW, I_PB, I_PS, I_PEK, I_PEV, I_CK1, I_CK2, I_CV1, I_CV2, I_GB, I_WOUT, I_LN2G, I_LN2B, I_UP2, I_DN2, I_LN3G, I_LN3B };

__device__ __forceinline__ void transpose_item(const float* W, int K, int Nsrc, bf16* WT, int dst0, LAS float* scr, int k0, int n0, int lane) {
    const int n = n0 + (lane & 31); const bool ok = n < Nsrc;
#pragma unroll 8
    for (int i = 0; i < 32; ++i) { const int kk = 2 * i + (lane >> 5); scr[kk * 33 + (lane & 31)] = ok ? W[(size_t)(k0 + kk) * Nsrc + n] : 0.f; }
    LDS_WAIT();
    const int c = lane & 7;
#pragma unroll
    for (int j = 0; j < 4; ++j) { const int nn = (lane >> 3) + 8 * j; const LAS float* s = scr + (8 * c) * 33 + nn;
        u32x4 o; o.x = pk2(s[0 * 33], s[1 * 33]); o.y = pk2(s[2 * 33], s[3 * 33]); o.z = pk2(s[4 * 33], s[5 * 33]); o.w = pk2(s[6 * 33], s[7 * 33]);
        *(u32x4*)(WT + (size_t)(dst0 + nn) * K + k0 + 8 * c) = o; }
    LDS_WAIT();
}
__device__ __forceinline__ int up_dst_row(int n0) { return n0 < DFF ? 256 * (n0 / 128) + (n0 % 128) : 256 * ((n0 - DFF) / 128) + 128 + ((n0 - DFF) % 128); }

__device__ __forceinline__ void phase_wconv(const Args& a, int l, LAS unsigned char* lds, int gw, int NGW, int wave, int lane) {
    OPQ_SI(gw); OPQ_SI(wave); OPQ_V(lane);
    LAS float* scr = (LAS float*)(lds + wave * 16384);
    unsigned char* ws = a.ws + opaque0();
    constexpr int I_UP = (DM / 64) * (NUP / 32), I_DN = (DFF / 64) * (DM / 32), I_IN = (DM / 64) * (INP / 32), I_OUT = (DM / 64) * (DM / 32);
    constexpr int NIT = 2 * I_UP + 2 * I_DN + I_IN + I_OUT;
    for (int it = gw; it < NIT; it += NGW) {
        int r = it;
        if (r < 2 * I_UP) { const int which = r / I_UP; r -= which * I_UP; const int nblk = NUP / 32, kb = r / nblk, nb = r % nblk;
            const float* W = a.in[which ? I_UP2 : I_UP1] + (size_t)l * DM * NUP; bf16* WT = (bf16*)(ws + (which ? WS_WUP2 : WS_WUP1));
            transpose_item(W, DM, NUP, WT, up_dst_row(32 * nb), scr, 64 * kb, 32 * nb, lane); continue; }
        r -= 2 * I_UP;
        if (r < 2 * I_DN) { const int which = r / I_DN; r -= which * I_DN; const int nblk = DM / 32, kb = r / nblk, nb = r % nblk;
            const float* W = a.in[which ? I_DN2 : I_DN1] + (size_t)l * DFF * DM; bf16* WT = (bf16*)(ws + (which ? WS_WDN2 : WS_WDN1));
            transpose_item(W, DFF, DM, WT, 32 * nb, scr, 64 * kb, 32 * nb, lane); continue; }
        r -= 2 * I_DN;
        if (r < I_IN) { const int nblk = INP / 32, kb = r / nblk, nb = r % nblk;
            transpose_item(INPTR(a, I_WIN) + (size_t)l * DM * INC, DM, INC, (bf16*)(ws + WS_WIN), 32 * nb, scr, 64 * kb, 32 * nb, lane); continue; }
        r -= I_IN;
        { const int nblk = DM / 32, kb = r / nblk, nb = r % nblk;
            transpose_item(INPTR(a, I_WOUT) + (size_t)l * DM * DM, DM, DM, (bf16*)(ws + WS_WOUT), 32 * nb, scr, 64 * kb, 32 * nb, lane); }
    }
}

__device__ __forceinline__ void phase_prologue(const Args& a, int gtid, int NGT) {
    OPQ_V(gtid);
    const f32x4* x4 = (const f32x4*)INPTR(a, I_X); u32x2* xb = (u32x2*)(a.ws + WS_XB);
    for (size_t i = gtid; i < (size_t)MTOK * DM / 4; i += NGT) { const f32x4 v = x4[i]; u32x2 o; o.x = pk2(v.x, v.y); o.y = pk2(v.z, v.w); xb[i] = o; }
    f32x2* rope = (f32x2*)(a.ws + WS_ROPE);
    for (int i = gtid; i < SEQ * 8; i += NGT) { const int s = i >> 3, k = i & 7;
        const float inv = powf(500000.0f, -(float)k * 0.125f); const float ang = (float)s * inv;
        const double ad = (double)ang; const double q = __builtin_rint(ad * 0.15915494309189535); const double rr = ad - q * 6.283185307179586;
        const float rf = (float)rr; rope[i] = (f32x2){cosf(rf), sinf(rf)}; }
}

__device__ __forceinline__ void phase_ln(const float* Y, const float* g, const float* b, float* X, bf16* XB, int gw, int NGW, int lane) {
    OPQ_SI(gw); OPQ_V(lane);
    f32x4 gv[8], bv[8];
#pragma unroll
    for (int j = 0; j < 8; ++j) { gv[j] = ((const f32x4*)g)[64 * j + lane]; bv[j] = ((const f32x4*)b)[64 * j + lane]; }
    for (int m = gw; m < MTOK; m += NGW) {
        const f32x4* yr = (const f32x4*)(Y + (size_t)m * DM) + lane; f32x4 v[8]; float s = 0.f;
#pragma unroll
        for (int j = 0; j < 8; ++j) { v[j] = yr[64 * j]; s += (v[j].x + v[j].y) + (v[j].z + v[j].w); }
        const float mean = wave_sum(s) * (1.f / DM); float s2 = 0.f;
#pragma unroll
        for (int j = 0; j < 8; ++j) { v[j] = v[j] - mean; s2 += (v[j].x * v[j].x + v[j].y * v[j].y) + (v[j].z * v[j].z + v[j].w * v[j].w); }
        const float rstd = 1.f / sqrtf(wave_sum(s2) * (1.f / DM) + LN_EPS);
        f32x4* xr = (f32x4*)(X + (size_t)m * DM) + lane; u32x2* xb = (u32x2*)(XB + (size_t)m * DM) + lane;
#pragma unroll
        for (int j = 0; j < 8; ++j) { const f32x4 o = v[j] * rstd * gv[j] + bv[j]; xr[64 * j] = o; u32x2 w; w.x = pk2(o.x, o.y); w.y = pk2(o.z, o.w); xb[64 * j] = w; }
    }
}

__device__ __forceinline__ void phase_m1(const Args& a, int l, LAS unsigned char* lds, int bid, int G, int tid, int wave, int lane) {
    OPQ_SI(bid); OPQ_V(tid); OPQ_SI(wave); lane = tid & 63;
    unsigned char* ws = a.ws + opaque0(); const float* P = (const float*)(ws + WS_P);
    {
        LAS float* sps = (LAS float*)lds;
        LAS float* tl = sps + 4 * RWC;
        LAS float* sg = tl + 4 * 64;
        const float* mu = INPTR(a, I_MU) + (size_t)l * RWC; const float* w0 = INPTR(a, I_W0) + (size_t)l * DRW; const float* w2 = INPTR(a, I_W2) + (size_t)l * 64 * DRW;
        const float* a0 = INPTR(a, I_A0) + (size_t)l * DRW; const float* a2 = INPTR(a, I_A2) + (size_t)l * 64 * DRW; const float* g2 = INPTR(a, I_G2) + (size_t)l * 128 * DRW;
        const float* k_k = INPTR(a, I_KK) + (size_t)l * DRW; const float* k_a = INPTR(a, I_KA) + (size_t)l * DRW; const float* r_k = INPTR(a, I_RK) + (size_t)l * DRW;
        float* vKK = (float*)(ws + WS_SV); float* vWR = (float*)(ws + WS_SV + SV_STRIDE); float* vW = (float*)(ws + WS_SV + 2 * SV_STRIDE);
        float* vKM = (float*)(ws + WS_SV + 3 * SV_STRIDE); float* vBB = (float*)(ws + WS_SV + 4 * SV_STRIDE); float* vV = (float*)(ws + WS_SV + 5 * SV_STRIDE);
        float* vG = (float*)(ws + WS_G); float* SC = (float*)(ws + WS_SC);
        for (int unit = bid; unit < MTOK / 4; unit += G) {
            const int t0 = unit * 4;
            for (int i = tid; i < 4 * RWC; i += NTHR) { const int tt = i / RWC, c = i - tt * RWC; const int m = t0 + tt; const int s = m & (SEQ - 1);
                const float pc = P[(size_t)m * INP + c]; const float pp = s > 0 ? P[(size_t)(m - 1) * INP + c] : 0.f; sps[i] = pc + (pp - pc) * mu[c]; }
            __syncthreads();
            for (int i = tid; i < 4 * 192; i += NTHR) { const int tt = i / 192, j = i - tt * 192;
                if (j < 64) tl[tt * 64 + j] = tanhf(sps[tt * RWC + 2304 + j]); else sg[tt * 128 + (j - 64)] = sigmoidf_(sps[tt * RWC + 2432 + (j - 64)]); }
            __syncthreads();
            for (int c = tid; c < DRW; c += NTHR) {
                float u[4] = {0.f, 0.f, 0.f, 0.f}, aa[4] = {0.f, 0.f, 0.f, 0.f}, gg[4] = {0.f, 0.f, 0.f, 0.f};
                for (int j = 0; j < 64; ++j) { const float w2v = w2[j * DRW + c], a2v = a2[j * DRW + c];
#pragma unroll
                    for (int tt = 0; tt < 4; ++tt) { u[tt] += tl[tt * 64 + j] * w2v; aa[tt] += sps[tt * RWC + 2368 + j] * a2v; } }
                for (int j = 0; j < 128; ++j) { const float g2v = g2[j * DRW + c];
#pragma unroll
                    for (int tt = 0; tt < 4; ++tt) gg[tt] += sg[tt * 128 + j] * g2v; }
                const float w0c = w0[c], a0c = a0[c], kkc = k_k[c], kac = k_a[c], rkc = r_k[c]; const int h = c >> 6;
#pragma unroll
                for (int tt = 0; tt < 4; ++tt) {
                    const size_t o = (size_t)(t0 + tt) * DRW + c;
                    const float uu = w0c + u[tt]; const float z = -uu; const float sp = z > 20.f ? z : log1pf(expf(z)); const float wlog = -sp - 0.5f; const float decay = expf(-expf(wlog));
                    const float av = sigmoidf_(a0c + aa[tt]);
                    const float r = sps[tt * RWC + c], k = sps[tt * RWC + 768 + c], v = sps[tt * RWC + 1536 + c];
                    const float kr = k * kkc; const float nrm = sqrtf(wave_sum(kr * kr)); const float kk = kr / fmaxf(nrm, 1e-12f);
                    const float km = k * (1.0f + (av - 1.0f) * kac); const float bb = kk * av;
                    vKK[o] = kk; vWR[o] = decay * r; vW[o] = decay; vKM[o] = km; vBB[o] = bb; vV[o] = v; vG[o] = gg[tt];
                    const float c1 = wave_sum(bb * r), c2 = wave_sum(km * r), bc = wave_sum(r * km * rkc);
                    if (lane == 0) *(f32x4*)(SC + ((size_t)(t0 + tt) * 12 + h) * 4) = (f32x4){c1, c2, bc, 0.f};
                }
            }
            __syncthreads();
        }
    }
    {
        LAS float* z = (LAS float*)lds;
        const float* pw = INPTR(a, I_PW) + (size_t)l * 4 * 128 * 128; const float* pb = INPTR(a, I_PB) + (size_t)l * DPOOL; const float* psc = INPTR(a, I_PS) + (size_t)l * DPOOL;
        bf16* CAT = (bf16*)(ws + WS_CAT);
        for (int unit = bid; unit < MTOK / 4; unit += G) {
            const int t0 = unit * 4;
            for (int i = tid; i < 4 * DPOOL; i += NTHR) { const int tt = i >> 9, ch = i & 511, gi = ch >> 7; const int m = t0 + tt, s = m & (SEQ - 1); const int win = 2 << gi; const int cnt = (s + 1) < win ? (s + 1) : win;
                float sum = 0.f; for (int j = 0; j < cnt; ++j) sum += P[(size_t)(m - j) * INP + PO_POOL + ch];
                z[i] = sum / (float)cnt - P[(size_t)m * INP + PO_POOL + ch]; }
            __syncthreads();
            { const int gi = tid >> 7, d = tid & 127; float acc[4] = {0.f, 0.f, 0.f, 0.f};
                for (int c = 0; c < 128; ++c) { const float wv = pw[(size_t)(gi * 128 + c) * 128 + d];
#pragma unroll
                    for (int tt = 0; tt < 4; ++tt) acc[tt] += z[tt * 512 + gi * 128 + c] * wv; }
                const float bv = pb[gi * 128 + d], sv = psc[gi * 128 + d];
#pragma unroll
                for (int tt = 0; tt < 4; ++tt) CAT[(size_t)(t0 + tt) * DM + DRW + gi * 128 + d] = (bf16)f2bf((acc[tt] + bv) * sv); }
            __syncthreads();
        }
    }
    {
        const f32x2* rope = (const f32x2*)(ws + WS_ROPE);
        bf16* QR = (bf16*)(ws + WS_QR); bf16* KS = (bf16*)(ws + WS_KS); bf16* KW = (bf16*)(ws + WS_KW); bf16* VST = (bf16*)(ws + WS_VST); bf16* VWT = (bf16*)(ws + WS_VWT);
        const int NGT = G * NTHR;
        for (int i = bid * NTHR + tid; i < MTOK * 1536; i += NGT) {
            const int m = i / 1536, c = i - m * 1536; const int s = m & (SEQ - 1); const float* pr = P + (size_t)m * INP;
            int src; bf16* dst; float scale = 1.f; bool rot;
            if (c < 768) { src = PO_Q + c; dst = QR + (size_t)m * 768 + c; scale = 0.125f * 1.4426950408889634f; rot = true; }
            else if (c < 960) { src = PO_KS + (c - 768); dst = KS + (size_t)m * 192 + (c - 768); rot = true; }
            else if (c < 1152) { src = PO_KW + (c - 960); dst = KW + (size_t)m * 192 + (c - 960); rot = true; }
            else if (c < 1344) { const int cc = c - 1152; src = PO_VS + cc; dst = VST + ((size_t)((m >> 12) * 3 + (cc >> 6)) * 64 + (cc & 63)) * SEQ + s; rot = false; }
            else { const int cc = c - 1344; src = PO_VW + cc; dst = VWT + ((size_t)((m >> 12) * 3 + (cc >> 6)) * 64 + (cc & 63)) * SEQ + s; rot = false; }
            const int d = c & 63; float v = pr[src];
            if (rot && d < 16) { const f32x2 cs = rope[s * 8 + (d & 7)];
                if (d < 8) v = v * cs.x - pr[src + 8] * cs.y; else v = v * cs.x + pr[src - 8] * cs.y; }
            *dst = (bf16)f2bf(v * scale);
        }
    }
    {
        LAS float* cs = (LAS float*)lds;
        LAS float* hid = cs + 2 * 80 * 64;
        const float* pe[2] = {INPTR(a, I_PEK) + (size_t)l * 2048, INPTR(a, I_PEV) + (size_t)l * 2048};
        const float* w1[2] = {INPTR(a, I_CK1) + (size_t)l * 2048 * 256, INPTR(a, I_CV1) + (size_t)l * 2048 * 256};
        const float* w2[2] = {INPTR(a, I_CK2) + (size_t)l * 256 * 64, INPTR(a, I_CV2) + (size_t)l * 256 * 64};
        const f32x2* rope = (const f32x2*)(ws + WS_ROPE);
        bf16* KC = (bf16*)(ws + WS_KC); bf16* VCT = (bf16*)(ws + WS_VCT);
        for (int unit = bid; unit < NB * 3 * 64; unit += G) {
            const int b = unit / 192, r = unit - b * 192, h = r >> 6, ng = r & 63, n0 = ng * 4;
            for (int i = tid; i < 2 * 80 * 64; i += NTHR) { const int ten = i / 5120, j = i - ten * 5120, tk = j >> 6, d = j & 63; const int s = 16 * n0 + tk;
                cs[i] = s < SEQ ? P[(size_t)(b * SEQ + s) * INP + (ten ? PO_VC : PO_KC) + h * 64 + d] : 0.f; }
            __syncthreads();
            { const int ten = tid >> 8, f = tid & 255; const float* w1p = (ten ? w1[1] : w1[0]) + f; const float* pep = ten ? pe[1] : pe[0]; const LAS float* csp = cs + ten * 5120;
                float acc[4] = {0.f, 0.f, 0.f, 0.f};
                for (int k = 0; k < 2048; ++k) { const float wv = w1p[(size_t)k * 256]; const float pv = pep[k]; const int ll = k >> 6, d = k & 63;
#pragma unroll
                    for (int nn = 0; nn < 4; ++nn) acc[nn] += (csp[(16 * nn + ll) * 64 + d] + pv) * wv; }
#pragma unroll
                for (int nn = 0; nn < 4; ++nn) { const float x = acc[nn]; hid[(ten * 4 + nn) * 256 + f] = 0.5f * x * (1.0f + tanhf(0.7978845608028654f * (x + 0.044715f * x * x * x))); } }
            __syncthreads();
            { const int ten = tid >> 8, nn = (tid >> 6) & 3, d = tid & 63; const float* w2p = (ten ? w2[1] : w2[0]) + d; const LAS float* hp = hid + (ten * 4 + nn) * 256;
                float o = 0.f; for (int f = 0; f < 256; ++f) o += hp[f] * w2p[f * 64];
                const int n = n0 + nn; const float other = __shfl_xor(o, 8);
                if (ten == 0 && d < 16) { const int pos = 16 * n + 31; const f32x2 c2 = rope[(pos & (SEQ - 1)) * 8 + (d & 7)]; o = d < 8 ? o * c2.x - other * c2.y : o * c2.x + other * c2.y; }
                if (n < NCMP) { if (ten) VCT[((size_t)(b * 3 + h) * 64 + d) * NCMPP + n] = (bf16)f2bf(o); else KC[((size_t)(b * NCMPP + n) * 3 + h) * 64 + d] = (bf16)f2bf(o); } }
            __syncthreads();
        }
    }
}

constexpr int SCH = 16, SSTR = 360;
__device__ __forceinline__ void phase_scan(const Args& a, LAS unsigned char* lds, int bid, int tid, int wave, int lane) {
    OPQ_SI(bid); OPQ_V(tid); OPQ_SI(wave); lane = tid & 63;
    unsigned char* ws = a.ws + opaque0();
    const int hd = bid >> 1, half = bid & 1, b = hd / 12, h = hd - b * 12;
    const int rowl = wave * 4 + (lane >> 4), j = lane & 15;
    const float* SC = (const float*)(ws + WS_SC); float* YS = (float*)(ws + WS_YS);
    LAS float* buf = (LAS float*)lds;
    const size_t m0 = (size_t)b * SEQ;
    const float* src[3]; int dsto[3]; bool act[3];
#pragma unroll
    for (int q = 0; q < 3; ++q) { const int i = tid + q * NTHR; act[q] = i < SCH * 88; const int st = i / 88, r = i - st * 88;
        if (r < 80) { const int vec = r >> 4, part = r & 15; src[q] = (const float*)(ws + WS_SV + (size_t)vec * SV_STRIDE) + (m0 + st) * DRW + h * 64 + part * 4; dsto[q] = st * SSTR + vec * 64 + part * 4; }
        else { const int part = r - 80; src[q] = (const float*)(ws + WS_SV + 5 * SV_STRIDE) + (m0 + st) * DRW + h * 64 + half * 32 + part * 4; dsto[q] = st * SSTR + 320 + part * 4; } }
    const float* srcc = SC + ((m0 + (tid & 15)) * 12 + h) * 4; const int dstc = (tid & 15) * SSTR + 352;
    f32x4 pre[3]; f32x2 prec;
#define SCAN_LOAD(ck) do { _Pragma("unroll") for (int q = 0; q < 3; ++q) if (act[q]) pre[q] = *(const f32x4*)(src[q] + (size_t)(ck) * SCH * DRW); if (tid < 16) prec = *(const f32x2*)(srcc + (size_t)(ck) * SCH * 48); } while (0)
#define SCAN_STORE(bb) do { _Pragma("unroll") for (int q = 0; q < 3; ++q) if (act[q]) *(LAS f32x4*)(buf + (bb) * SCH * SSTR + dsto[q]) = pre[q]; if (tid < 16) *(LAS f32x2*)(buf + (bb) * SCH * SSTR + dstc) = prec; } while (0)
    SCAN_LOAD(0); SCAN_STORE(0); __syncthreads();
    float S0 = 0.f, S1 = 0.f, S2 = 0.f, S3 = 0.f;
    constexpr int NCH = SEQ / SCH;
    for (int ck = 0; ck < NCH; ++ck) {
        if (ck + 1 < NCH) SCAN_LOAD(ck + 1);
        const LAS float* cb = buf + (ck & 1) * SCH * SSTR;
#pragma unroll 4
        for (int st = 0; st < SCH; ++st) {
            const LAS float* sb = cb + st * SSTR;
            const f32x4 kk = *(const LAS f32x4*)(sb + 4 * j), wr = *(const LAS f32x4*)(sb + 64 + 4 * j), w = *(const LAS f32x4*)(sb + 128 + 4 * j), km = *(const LAS f32x4*)(sb + 192 + 4 * j), bb = *(const LAS f32x4*)(sb + 256 + 4 * j);
            const float v = sb[320 + rowl]; const f32x2 c = *(const LAS f32x2*)(sb + 352);
            float p1 = S0 * kk.x; p1 = fmaf(S1, kk.y, p1); p1 = fmaf(S2, kk.z, p1); p1 = fmaf(S3, kk.w, p1);
            float p2 = S0 * wr.x; p2 = fmaf(S1, wr.y, p2); p2 = fmaf(S2, wr.z, p2); p2 = fmaf(S3, wr.w, p2);
            const float sa = row16_sum(p1), y0 = row16_sum(p2);
            const float t0 = fmaf(S0, w.x, v * km.x), t1 = fmaf(S1, w.y, v * km.y), t2 = fmaf(S2, w.z, v * km.z), t3 = fmaf(S3, w.w, v * km.w);
            S0 = fmaf(-sa, bb.x, t0); S1 = fmaf(-sa, bb.y, t1); S2 = fmaf(-sa, bb.z, t2); S3 = fmaf(-sa, bb.w, t3);
            const float y = y0 - sa * c.x + v * c.y;
            if (j == 0) YS[(m0 + (size_t)ck * SCH + st) * DRW + h * 64 + half * 32 + rowl] = y;
        }
        if (ck + 1 < NCH) SCAN_STORE((ck + 1) & 1);
        __syncthreads();
    }
#undef SCAN_LOAD
#undef SCAN_STORE
}


typedef float f32x16 __attribute__((ext_vector_type(16)));
typedef short bf16x8 __attribute__((ext_vector_type(8)));
#define MFMA32(a, b, c) __builtin_amdgcn_mfma_f32_32x32x16_bf16((a), (b), (c), 0, 0, 0)
#define WSYNC() asm volatile("s_waitcnt lgkmcnt(0)" ::: "memory")
__device__ __forceinline__ void half_swap(float x, float& lo, float& hi) { float a = x, b = x; asm volatile("s_nop 1\n\tv_permlane32_swap_b32 %0, %1" : "+v"(a), "+v"(b)); lo = a; hi = b; }
__device__ __forceinline__ float half_max(float x) { float lo, hi; half_swap(x, lo, hi); return fmaxf(lo, hi); }
__device__ __forceinline__ float half_sum(float x) { float lo, hi; half_swap(x, lo, hi); return lo + hi; }
__device__ __forceinline__ float other_half(float x, int h) { float lo, hi; half_swap(x, lo, hi); return h ? lo : hi; }
__device__ __forceinline__ unsigned cvtpk(float lo, float hi) { unsigned r; asm volatile("v_cvt_pk_bf16_f32 %0, %1, %2" : "=v"(r) : "v"(lo), "v"(hi)); return r; }
__device__ __forceinline__ void load_k(const bf16* Kb, int key0, int r, int h, bf16x8 (&kf)[4]) {
    const bf16* p = Kb + (size_t)(key0 + r) * 192 + 8 * h;
#pragma unroll
    for (int ks = 0; ks < 4; ++ks) kf[ks] = *(const bf16x8*)(p + 16 * ks);
}
__device__ __forceinline__ void load_v(const bf16* Vt, int ld, int key0, int r, int h, bf16x8 (&vf)[2][2]) {
#pragma unroll
    for (int dt = 0; dt < 2; ++dt)
#pragma unroll
        for (int s = 0; s < 2; ++s) { const bf16* p = Vt + (size_t)(32 * dt + r) * ld + key0 + 16 * s + 4 * h; const u32x2 lo = *(const u32x2*)p, hi = *(const u32x2*)(p + 8);
            u32x4 w; w.x = lo.x; w.y = lo.y; w.z = hi.x; w.w = hi.y; vf[dt][s] = __builtin_bit_cast(bf16x8, w); }
}
__device__ __forceinline__ f32x16 qk_tile(const bf16x8 (&kf)[4], const bf16x8 (&qf)[4]) {
    f32x16 S;
#pragma unroll
    for (int i = 0; i < 16; ++i) S[i] = 0.f;
#pragma unroll
    for (int ks = 0; ks < 4; ++ks) S = MFMA32(kf[ks], qf[ks], S);
    return S;
}
__device__ __forceinline__ void pv_tile(const float (&p)[16], const bf16x8 (&vf)[2][2], f32x16 (&O)[2]) {
#pragma unroll
    for (int s = 0; s < 2; ++s) { u32x4 w; w.x = cvtpk(p[8 * s], p[8 * s + 1]); w.y = cvtpk(p[8 * s + 2], p[8 * s + 3]); w.z = cvtpk(p[8 * s + 4], p[8 * s + 5]); w.w = cvtpk(p[8 * s + 6], p[8 * s + 7]);
        const bf16x8 pf = __builtin_bit_cast(bf16x8, w);
#pragma unroll
        for (int dt = 0; dt < 2; ++dt) O[dt] = MFMA32(vf[dt][s], pf, O[dt]); }
}
template <int MODE> __device__ __forceinline__ void att_tile(const bf16x8 (&kf)[4], const bf16x8 (&qf)[4], const bf16x8 (&vf)[2][2], int key0, int h, int qp, bool colsel, float& m, float& l, f32x16 (&O)[2]) {
    const f32x16 S = qk_tile(kf, qf);
    float sv[16]; float tmax = -INFINITY;
#pragma unroll
    for (int i = 0; i < 16; ++i) { const int key = key0 + (i & 3) + 8 * (i >> 2) + 4 * h;
        const bool ok = MODE == 1 ? colsel : MODE == 2 ? (colsel && key <= qp) : (key <= qp && key >= qp - 511);
        sv[i] = ok ? S[i] : -INFINITY; tmax = fmaxf(tmax, sv[i]); }
    tmax = half_max(tmax);
    const float mn = fmaxf(m, tmax); const float ms = mn == -INFINITY ? 0.f : mn;
    const float alpha = __builtin_amdgcn_exp2f(m - ms);
    float p[16]; float ps = 0.f;
#pragma unroll
    for (int i = 0; i < 16; ++i) { p[i] = __builtin_amdgcn_exp2f(sv[i] - ms); ps += p[i]; }
    l = l * alpha + half_sum(ps); m = mn;
#pragma unroll
    for (int dt = 0; dt < 2; ++dt)
#pragma unroll
        for (int i = 0; i < 16; ++i) O[dt][i] *= alpha;
    pv_tile(p, vf, O);
}
__device__ __forceinline__ void phase_nsa(const Args& a, int l, LAS unsigned char* lds, int bid, int tid, int wave, int lane) {
    OPQ_SI(bid); OPQ_V(tid); OPQ_SI(wave); lane = tid & 63;
    unsigned char* ws = a.ws + opaque0();
    LAS float* impl = (LAS float*)(lds + wave * 2048);
    volatile LAS int* qslot = (volatile LAS int*)(lds + 16384);
    const bf16* QR = (const bf16*)(ws + WS_QR); const float* P = (const float*)(ws + WS_P); const float* gate_b = INPTR(a, I_GB) + (size_t)l * 36; bf16* CAT = (bf16*)(ws + WS_CAT);
    unsigned* qctr = (unsigned*)(ws + WS_CTL) + 8192 + 64 * l;
    const int r = lane & 31, h = lane >> 5, g = r & 3, ql = r >> 2;
    for (;;) {
        __syncthreads();
        if (tid == 0) *qslot = (int)atomicAdd(qctr, 1u);
        __syncthreads();
        const int u = *qslot;
        if (u >= NB * 3 * 64) break;
        const int qt = 63 - u / 12, bk = u - (u / 12) * 12, b = bk / 3, kvh = bk - b * 3;
        const int tile0 = qt * 64, cur = qt; const int qp = tile0 + 8 * wave + ql; const size_t mq = (size_t)b * SEQ + qp; const int head = kvh * 4 + g;
        bf16x8 qf[4];
#pragma unroll
        for (int ks = 0; ks < 4; ++ks) qf[ks] = *(const bf16x8*)(QR + mq * 768 + head * 64 + 16 * ks + 8 * h);
        float g0, g1, g2;
        { const float* gl = P + mq * INP + PO_GL + head * 3; const float* gb = gate_b + head * 3; g0 = sigmoidf_(gl[0] + gb[0]); g1 = sigmoidf_(gl[1] + gb[1]); g2 = sigmoidf_(gl[2] + gb[2]); }
        f32x16 out[2], O[2];
#pragma unroll
        for (int dt = 0; dt < 2; ++dt)
#pragma unroll
            for (int i = 0; i < 16; ++i) out[dt][i] = 0.f;
        unsigned long long mymask = (2ull << cur) - 1ull, umask = mymask;
        {
            const bf16* Kb = (const bf16*)(ws + WS_KC) + ((size_t)b * NCMPP * 3 + kvh) * 64; const bf16* Vt = (const bf16*)(ws + WS_VCT) + (size_t)(b * 3 + kvh) * 64 * NCMPP;
            const int qpw = tile0 + 8 * wave + 7; const int nvw = qpw >= 31 ? ((qpw - 31) >> 4) + 1 : 0; const int nvq = qp >= 31 ? ((qp - 31) >> 4) + 1 : 0; const int ntile = (nvw + 31) >> 5;
            const bool need_imp = cur >= 16;
            if (ntile > 0) {
                float m = -INFINITY, ls = 0.f;
#pragma unroll 1
                for (int kt = 0; kt < ntile; ++kt) { bf16x8 kf[4]; load_k(Kb, 32 * kt, r, h, kf); const f32x16 S = qk_tile(kf, qf);
                    float tmax = -INFINITY; float sv[16];
#pragma unroll
                    for (int i = 0; i < 16; ++i) { const int n = 32 * kt + (i & 3) + 8 * (i >> 2) + 4 * h; sv[i] = n < nvq ? S[i] : -INFINITY; tmax = fmaxf(tmax, sv[i]); }
                    tmax = half_max(tmax); const float mn = fmaxf(m, tmax); const float ms = mn == -INFINITY ? 0.f : mn; float ps = 0.f;
#pragma unroll
                    for (int i = 0; i < 16; ++i) ps += __builtin_amdgcn_exp2f(sv[i] - ms);
                    ls = ls * __builtin_amdgcn_exp2f(m - ms) + half_sum(ps); m = mn; }
                const float ms = m == -INFINITY ? 0.f : m; const float inv = 1.0f / fmaxf(ls, 1.17549435e-38f);
                float carry = 0.f;
#pragma unroll
                for (int dt = 0; dt < 2; ++dt)
#pragma unroll
                    for (int i = 0; i < 16; ++i) O[dt][i] = 0.f;
                if (need_imp) {
#pragma unroll
                    for (int i = 0; i < 8; ++i) impl[i * 64 + lane] = 0.f;
                    WSYNC(); }
#pragma unroll 1
                for (int kt = 0; kt < ntile; ++kt) {
                    bf16x8 kf[4]; bf16x8 vf[2][2]; load_k(Kb, 32 * kt, r, h, kf); load_v(Vt, NCMPP, 32 * kt, r, h, vf); const f32x16 S = qk_tile(kf, qf);
                    float p[16];
#pragma unroll
                    for (int i = 0; i < 16; ++i) { const int n = 32 * kt + (i & 3) + 8 * (i >> 2) + 4 * h; p[i] = n < nvq ? __builtin_amdgcn_exp2f(S[i] - ms) * inv : 0.f; }
                    if (need_imp) {
                        float val[4];
#pragma unroll
                        for (int t = 0; t < 4; ++t) { const float sp = 0.5f * p[4 * t + 3]; const float base = (p[4 * t] + p[4 * t + 1]) + (p[4 * t + 2] + sp); const float rv = other_half(sp, h);
                            val[t] = base + (h ? rv : carry); carry = h ? 0.f : rv; }
#pragma unroll
                        for (int t = 0; t < 4; ++t) { float v = val[t]; v += dpp_f<0xB1>(v); v += dpp_f<0x4E>(v); if (g == 0) impl[ql * 64 + 8 * kt + 2 * t + h] = v; }
                    }
                    pv_tile(p, vf, O);
                }
#pragma unroll
                for (int dt = 0; dt < 2; ++dt)
#pragma unroll
                    for (int i = 0; i < 16; ++i) out[dt][i] = O[dt][i] * g0;
                if (need_imp) {
                    WSYNC();
#pragma unroll 1
                    for (int q = 0; q < 8; ++q) { const float v = impl[q * 64 + lane]; const bool forced = lane == 0 || lane == cur || lane == cur - 1; impl[q * 64 + lane] = lane > cur ? -INFINITY : (forced ? 1e9f : v); }
                    WSYNC();
                    umask = 0ull;
#pragma unroll 1
                    for (int q = 0; q < 8; ++q) { const float sc = impl[q * 64 + lane]; int rank = 0;
#pragma unroll 4
                        for (int i4 = 0; i4 < 16; ++i4) { const f32x4 o = *(const LAS f32x4*)(impl + q * 64 + 4 * i4);
                            rank += (o.x > sc || (o.x == sc && 4 * i4 + 0 < lane)) ? 1 : 0; rank += (o.y > sc || (o.y == sc && 4 * i4 + 1 < lane)) ? 1 : 0;
                            rank += (o.z > sc || (o.z == sc && 4 * i4 + 2 < lane)) ? 1 : 0; rank += (o.w > sc || (o.w == sc && 4 * i4 + 3 < lane)) ? 1 : 0; }
                        const unsigned long long mk = __ballot(lane <= cur && rank < 16);
                        umask |= mk; if (ql == q) mymask = mk; }
                    WSYNC();
                }
            }
        }
        {
            const bf16* Kb = (const bf16*)(ws + WS_KS) + ((size_t)b * SEQ * 3 + kvh) * 64; const bf16* Vt = (const bf16*)(ws + WS_VST) + (size_t)(b * 3 + kvh) * 64 * SEQ;
            float m = -INFINITY, ls = 0.f;
#pragma unroll
            for (int dt = 0; dt < 2; ++dt)
#pragma unroll
                for (int i = 0; i < 16; ++i) O[dt][i] = 0.f;
            const int qpw = tile0 + 8 * wave + 7;
            unsigned long long um = umask;
#pragma unroll 1
            while (um) { const int jb = __builtin_ctzll(um); um &= um - 1ull; const bool colsel = (mymask >> jb) & 1ull;
#pragma unroll 1
                for (int hf = 0; hf < 2; ++hf) { const int key0 = 64 * jb + 32 * hf; if (key0 > qpw) break;
                    bf16x8 kf[4]; bf16x8 vf[2][2]; load_k(Kb, key0, r, h, kf); load_v(Vt, SEQ, key0, r, h, vf);
                    if (jb == cur) att_tile<2>(kf, qf, vf, key0, h, qp, colsel, m, ls, O); else att_tile<1>(kf, qf, vf, key0, h, qp, colsel, m, ls, O); } }
            const float sc = g1 / fmaxf(ls, 1.17549435e-38f);
#pragma unroll
            for (int dt = 0; dt < 2; ++dt)
#pragma unroll
                for (int i = 0; i < 16; ++i) out[dt][i] += O[dt][i] * sc;
        }
        {
            const bf16* Kb = (const bf16*)(ws + WS_KW) + ((size_t)b * SEQ * 3 + kvh) * 64; const bf16* Vt = (const bf16*)(ws + WS_VWT) + (size_t)(b * 3 + kvh) * 64 * SEQ;
            float m = -INFINITY, ls = 0.f;
#pragma unroll
            for (int dt = 0; dt < 2; ++dt)
#pragma unroll
                for (int i = 0; i < 16; ++i) O[dt][i] = 0.f;
            const int q0w = tile0 + 8 * wave; const int lo = q0w - 511 > 0 ? q0w - 511 : 0;
#pragma unroll 1
            for (int t = lo >> 5; t <= (q0w + 7) >> 5; ++t) { bf16x8 kf[4]; bf16x8 vf[2][2]; load_k(Kb, 32 * t, r, h, kf); load_v(Vt, SEQ, 32 * t, r, h, vf); att_tile<3>(kf, qf, vf, 32 * t, h, qp, true, m, ls, O); }
            const float sc = g2 / fmaxf(ls, 1.17549435e-38f);
#pragma unroll
            for (int dt = 0; dt < 2; ++dt)
#pragma unroll
                for (int i = 0; i < 16; ++i) out[dt][i] += O[dt][i] * sc;
        }
        { bf16* op = CAT + mq * DM + DRW + DPOOL + head * 64 + 4 * h;
#pragma unroll
            for (int dt = 0; dt < 2; ++dt)
#pragma unroll
                for (int t = 0; t < 4; ++t) { u32x2 w; w.x = cvtpk(out[dt][4 * t], out[dt][4 * t + 1]); w.y = cvtpk(out[dt][4 * t + 2], out[dt][4 * t + 3]); *(u32x2*)(op + 32 * dt + 8 * t) = w; } }
    }
}

__device__ __forceinline__ void phase_rwkv_out(const Args& a, int l, int gw, int NGW, int lane) {
    OPQ_SI(gw); OPQ_V(lane);
    unsigned char* ws = a.ws + opaque0(); const float* YS = (const float*)(ws + WS_YS); const float* vV = (const float*)(ws + WS_SV + 5 * SV_STRIDE); const float* vG = (const float*)(ws + WS_G); const float* SC = (const float*)(ws + WS_SC);
    const float* gng = INPTR(a, I_GNG) + (size_t)l * DRW; const float* gnb = INPTR(a, I_GNB) + (size_t)l * DRW; bf16* CAT = (bf16*)(ws + WS_CAT);
    for (int id = gw; id < MTOK * 12; id += NGW) { const int m = id / 12, h = id - m * 12, c = h * 64 + lane; const size_t o = (size_t)m * DRW + c;
        const float y = YS[o]; const float mean = wave_sum(y) * (1.f / 64.f); const float d = y - mean; const float var = wave_sum(d * d) * (1.f / 64.f);
        const float yn = d * (1.f / sqrtf(var + GN_EPS)) * gng[c] + gnb[c]; const float bonus = SC[((size_t)m * 12 + h) * 4 + 2] * vV[o];
        CAT[(size_t)m * DM + c] = (bf16)f2bf((yn + bonus) * vG[o]); }
}

template <int PHMASK> __global__ void __launch_bounds__(NTHR, 2) fwd(Args args) {
    extern __shared__ __attribute__((aligned(16))) unsigned char lds_raw[];
    LAS unsigned char* lds = (LAS unsigned char*)lds_raw;
    const int tid = threadIdx.x, lane = tid & 63, wave = __builtin_amdgcn_readfirstlane(tid >> 6);
    const int G = gridDim.x, bid = blockIdx.x; const int gw = bid * NWAVES + wave, NGW = G * NWAVES;
    unsigned char* ws = args.ws;
    for (int u = tid; u < (LDS_BYTES - 131072) / 4; u += NTHR) ((LAS unsigned*)(lds + 131072))[u] = 0u;
    __syncthreads();
    const int lo = args.ph_lo, hi = args.ph_hi;
    XcdBarrier bar; bar.bar = (unsigned*)(ws + WS_CTL) + 4096; bar.x = 0; bar.st = nullptr;
    if (hi - lo > 1) bar = xcd_barrier_post((unsigned*)(ws + WS_CTL) + 4096, (volatile LAS unsigned*)(lds + MISC_OFF) + 8);
#define IN(k) (lo <= (k) && (k) < hi)
#define PHEN(j) (((PHMASK) >> (j)) & 1)
#define SEAM(k) do { if ((k) + 1 < hi) xcd_barrier(bar); } while (0)
    bf16* XB = (bf16*)(ws + WS_XB); bf16* Hb = (bf16*)(ws + WS_H); float* Y = (float*)(ws + WS_Y); float* Pm = (float*)(ws + WS_P); bf16* CAT = (bf16*)(ws + WS_CAT);

    if (PHEN(0) && IN(0)) { phase_prologue(args, bid * NTHR + tid, G * NTHR); SEAM(0); }
    for (int l = 0; l < NLAYER; ++l) {
        const int pb = 1 + 13 * l;
        if (PHEN(1) && IN(pb + 0)) { phase_wconv(args, l, lds, gw, NGW, wave, lane); SEAM(pb + 0); }
        if (PHEN(2) && IN(pb + 1)) {
            pg8::Gemm g{XB, (const bf16*)(ws + WS_WUP1), MTOK, NUP, DM}; pg8::StaticOrder S; S.init(MTOK, NUP, G, bid); pg8::EpiSwiGLU E{Hb, DFF};
            pg8::gemm_phase<pg8::EpiSwiGLU, pg8::StaticOrder, true, true>(lds, g, S, E); SEAM(pb + 1); }
        if (PHEN(3) && IN(pb + 2)) {
            pg8::Gemm g{Hb, (const bf16*)(ws + WS_WDN1), MTOK, DM, DFF}; pg8::StaticOrder S; S.init(MTOK, DM, G, bid); pg8::EpiResid E{l == 0 ? INPTR(args, I_X) : args.out, Y, DM, ALPHA, 0.5f};
            pg8::gemm_phase<pg8::EpiResid, pg8::StaticOrder, true, true>(lds, g, S, E); SEAM(pb + 2); }
        if (PHEN(4) && IN(pb + 3)) { phase_ln(Y, INPTR(args, I_LN1G) + (size_t)l * DM, INPTR(args, I_LN1B) + (size_t)l * DM, args.out, XB, gw, NGW, lane); SEAM(pb + 3); }
        if (PHEN(5) && IN(pb + 4)) {
            pg8::Gemm g{XB, (const bf16*)(ws + WS_WIN), MTOK, INP, DM}; pg8::StaticOrder S; S.init(MTOK, INP, G, bid); pg8::EpiF32 E{Pm, INP};
            pg8::gemm_phase<pg8::EpiF32, pg8::StaticOrder, true, true>(lds, g, S, E); SEAM(pb + 4); }
        if (PHEN(6) && IN(pb + 5)) { phase_m1(args, l, lds, bid, G, tid, wave, lane); SEAM(pb + 5); }
        if (PHEN(7) && IN(pb + 6)) { if (bid < 96) phase_scan(args, lds, bid, tid, wave, lane); phase_nsa(args, l, lds, bid, tid, wave, lane); SEAM(pb + 6); }
        if (PHEN(8) && IN(pb + 7)) { phase_rwkv_out(args, l, gw, NGW, lane); SEAM(pb + 7); }
        if (PHEN(9) && IN(pb + 8)) {
            pg8::Gemm g{CAT, (const bf16*)(ws + WS_WOUT), MTOK, DM, DM}; pg8::StaticOrder S; S.init(MTOK, DM, G, bid); pg8::EpiResid E{args.out, Y, DM, ALPHA, 1.0f};
            pg8::gemm_phase<pg8::EpiResid, pg8::StaticOrder, true, true>(lds, g, S, E); SEAM(pb + 8); }
        if (PHEN(10) && IN(pb + 9)) { phase_ln(Y, INPTR(args, I_LN2G) + (size_t)l * DM, INPTR(args, I_LN2B) + (size_t)l * DM, args.out, XB, gw, NGW, lane); SEAM(pb + 9); }
        if (PHEN(11) && IN(pb + 10)) {
            pg8::Gemm g{XB, (const bf16*)(ws + WS_WUP2), MTOK, NUP, DM}; pg8::StaticOrder S; S.init(MTOK, NUP, G, bid); pg8::EpiSwiGLU E{Hb, DFF};
            pg8::gemm_phase<pg8::EpiSwiGLU, pg8::StaticOrder, true, true>(lds, g, S, E); SEAM(pb + 10); }
        if (PHEN(12) && IN(pb + 11)) {
            pg8::Gemm g{Hb, (const bf16*)(ws + WS_WDN2), MTOK, DM, DFF}; pg8::StaticOrder S; S.init(MTOK, DM, G, bid); pg8::EpiResid E{args.out, Y, DM, ALPHA, 0.5f};
            pg8::gemm_phase<pg8::EpiResid, pg8::StaticOrder, true, true>(lds, g, S, E); SEAM(pb + 11); }
        if (PHEN(13) && IN(pb + 12)) { phase_ln(Y, INPTR(args, I_LN3G) + (size_t)l * DM, INPTR(args, I_LN3B) + (size_t)l * DM, args.out, XB, gw, NGW, lane); SEAM(pb + 12); }
    }
#undef IN
#undef SEAM
}

#ifndef ONE_MASK
#define ONE_MASK 0xFFFFF
#endif
#ifndef MK_ONE_LAUNCH
#define MK_ONE_LAUNCH 1
#endif
typedef void (*kern_t)(Args);
extern "C" void kernel_launch(void* const* d_in, const int* in_sizes, int n_in, void* d_out, int out_size, void* d_ws, size_t ws_size, hipStream_t stream) {
    static int grid = 0;
#if MK_ONE_LAUNCH
    static const kern_t kerns[1] = {fwd<ONE_MASK>};
    constexpr int NK = 1;
#else
    static const kern_t kerns[14] = {fwd<1 << 0>, fwd<1 << 1>, fwd<1 << 2>, fwd<1 << 3>, fwd<1 << 4>, fwd<1 << 5>, fwd<1 << 6>, fwd<1 << 7>, fwd<1 << 8>, fwd<1 << 9>, fwd<1 << 10>, fwd<1 << 11>, fwd<1 << 12>, fwd<1 << 13>};
    constexpr int NK = 14;
#endif
    if (grid == 0) {
        if (n_in != 34 || out_size != MTOK * DM || ws_size < WS_END) { fprintf(stderr, "kernel_launch: unexpected shapes (n_in %d, out %d, ws %zu; need ws >= %zu)\n", n_in, out_size, ws_size, (size_t)WS_END); grid = -1; return; }
        int dev = 0, cus = 0;
        if (hipGetDevice(&dev) != hipSuccess || hipDeviceGetAttribute(&cus, hipDeviceAttributeMultiprocessorCount, dev) != hipSuccess) { grid = -1; return; }
        for (int i = 0; i < NK; ++i) if (hipFuncSetAttribute((const void*)kerns[i], hipFuncAttributeMaxDynamicSharedMemorySize, LDS_BYTES) != hipSuccess) { fprintf(stderr, "kernel_launch: hipFuncSetAttribute failed\n"); grid = -1; return; }
        int per_cu = 0;
        if (hipOccupancyMaxActiveBlocksPerMultiprocessor(&per_cu, (const void*)kerns[0], NTHR, LDS_BYTES) != hipSuccess || per_cu < 1) fprintf(stderr, "kernel_launch: occupancy query says %d blocks per CU\n", per_cu);
        (void)hipGetLastError();
        grid = cus;
    }
    if (grid < 0) return;
    (void)hipMemsetAsync((char*)d_ws + WS_CTL, 0, CTL_ZERO_BYTES, stream);
    Args a{};
    for (int i = 0; i < 34; ++i) a.in[i] = (const float*)d_in[i];
    a.out = (float*)d_out; a.ws = (unsigned char*)d_ws;
#if MK_ONE_LAUNCH
    a.ph_lo = 0; a.ph_hi = NPH;
    hipLaunchKernelGGL(kerns[0], dim3(grid), dim3(NTHR), LDS_BYTES, stream, a);
#else
    for (int k = 0; k < NPH; ++k) { a.ph_lo = k; a.ph_hi = k + 1; const int j = k == 0 ? 0 : (k - 1) % 13 + 1; hipLaunchKernelGGL(kerns[j], dim3(grid), dim3(NTHR), LDS_BYTES, stream, a); }
#endif
}
```

```cpp
#include <hip/hip_runtime.h>
#include <cstdio>
#include <cstdint>
namespace pg8 {
#define PG8_LAS __attribute__((address_space(3)))
typedef unsigned short bf16_t;
typedef short bf16x8 __attribute__((ext_vector_type(8)));
typedef float f32x4 __attribute__((ext_vector_type(4)));
typedef unsigned u32x4 __attribute__((ext_vector_type(4)));
constexpr int BM = 256, BK = 64, HALF = 128, HTB = HALF * BK * 2  , STAGE_BYTES = 8 * HTB, NXCD = 8, WGM = 8;

__host__ __device__ __forceinline__ int lds_byte(int r, int c) { const int st = (r >> 4) * 2 + (c >> 5), rr = r & 15, cc = c & 31, ob = rr * 64 + cc * 2; return st * 1024 + (ob ^ (((ob >> 9) & 1) << 5)); }
__host__ __device__ __forceinline__ void stage_rc(int b, int& R, int& C) { const int st = b / 1024, sb = b % 1024, swz = sb ^ (((sb >> 9) & 1) << 5); R = (st >> 1) * 16 + swz / 64; C = (st & 1) * 32 + (swz % 64) / 2; }
__host__ __device__ __forceinline__ int perm32(int rho) { const int n = rho >> 4, i = rho & 15; return 8 * (i >> 2) + 4 * n + (i & 3); }

struct Unit { int pm, pn; };
struct Gemm { const bf16_t* A; const bf16_t* Bt; int M, N, K; };

struct StaticOrder {
    int nM, nN, nwg, G, c;
    __host__ __device__ void init(int M, int N, int G_, int c_) { nM = M / BM; nN = N / BM; nwg = nM * nN; G = G_; c = c_; }
    __host__ __device__ bool next(int i, Unit& u) const {
        const long L = (long)i * G + c; if (L >= nwg) return false;
        int wgid = (int)L; { const int q = nwg / NXCD, r = nwg % NXCD, xcd = wgid % NXCD, off = wgid / NXCD; wgid = (xcd < r ? xcd * (q + 1) : r * (q + 1) + (xcd - r) * q) + off; }
        const int nig = WGM * nN, gid = wgid / nig, fm = gid * WGM, gsz = (nM - fm) < WGM ? (nM - fm) : WGM;
        u.pm = fm + ((wgid % nig) % gsz); u.pn = (wgid % nig) / gsz; return true;
    }
    __device__ __forceinline__ void a_ready(const Unit&) const {}
    __device__ __forceinline__ void done(const Unit&) const {}
};

__device__ __forceinline__ unsigned cvt_pk_bf16(float lo, float hi) { unsigned r; asm volatile("v_cvt_pk_bf16_f32 %0, %1, %2" : "=v"(r) : "v"(lo), "v"(hi)); return r; }
typedef float f32x2 __attribute__((ext_vector_type(2)));
struct EpiSwiGLU {
    static constexpr bool PERM = true, AFTER_DRAIN = false;
    bf16_t* H; int ldh;
    __device__ __forceinline__ void operator()(const f32x4 (&acc)[2][2][4][2], const Unit& u, int wr, int wc, int fr, int fq) const {
        const int row0 = u.pm * BM + wr * 64 + fr, col0 = u.pn * HALF + wc * 32 + 8 * fq;
#pragma unroll
        for (int ai = 0; ai < 2; ++ai)
#pragma unroll
            for (int m = 0; m < 4; ++m) { bf16_t* rowp = H + (size_t)(row0 + ai * HALF + m * 16) * ldh + col0;
                float hv[8];
#pragma unroll
                for (int n = 0; n < 2; ++n)
#pragma unroll
                    for (int i = 0; i < 4; ++i) { const float a = acc[ai][0][m][n][i], b = acc[ai][1][m][n][i];
                        const float e = __builtin_amdgcn_exp2f(a * -1.44269504089f); hv[n * 4 + i] = a * __builtin_amdgcn_rcpf(1.0f + e) * b; }
                u32x4 w; w.x = cvt_pk_bf16(hv[0], hv[1]); w.y = cvt_pk_bf16(hv[2], hv[3]); w.z = cvt_pk_bf16(hv[4], hv[5]); w.w = cvt_pk_bf16(hv[6], hv[7]);
                *(u32x4*)rowp = w; }
    }
};
struct EpiResid {
    static constexpr bool PERM = false, AFTER_DRAIN = false;
    const float* X; float* Y; int ldc; float alpha, s;
    __device__ __forceinline__ void operator()(const f32x4 (&acc)[2][2][4][2], const Unit& u, int wr, int wc, int fr, int fq) const {
        const int row0 = u.pm * BM + wr * 64 + fr, col0 = u.pn * BM + wc * 32 + 4 * fq;
#pragma unroll
        for (int ai = 0; ai < 2; ++ai)
#pragma unroll
            for (int m = 0; m < 4; ++m) { const size_t off = (size_t)(row0 + ai * HALF + m * 16) * ldc + col0;
#pragma unroll
                for (int bj = 0; bj < 2; ++bj)
#pragma unroll
                    for (int n = 0; n < 2; ++n) { const f32x4 xv = *(const f32x4*)(X + off + bj * HALF + n * 16); *(f32x4*)(Y + off + bj * HALF + n * 16) = xv * alpha + acc[ai][bj][m][n] * s; }
                asm volatile("" ::: "memory"); }
    }
};
struct EpiF32 {
    static constexpr bool PERM = false, AFTER_DRAIN = false;
    float* C; int ldc;
    __device__ __forceinline__ void operator()(const f32x4 (&acc)[2][2][4][2], const Unit& u, int wr, int wc, int fr, int fq) const {
        const int row0 = u.pm * BM + wr * 64 + fr, col0 = u.pn * BM + wc * 32 + 4 * fq;
#pragma unroll
        for (int ai = 0; ai < 2; ++ai)
#pragma unroll
            for (int m = 0; m < 4; ++m) { float* rowp = C + (size_t)(row0 + ai * HALF + m * 16) * ldc + col0;
#pragma unroll
                for (int bj = 0; bj < 2; ++bj)
#pragma unroll
                    for (int n = 0; n < 2; ++n) *(f32x4*)(rowp + bj * HALF + n * 16) = acc[ai][bj][m][n]; }
    }
};

template <class Epi, class Sched, bool ALIGN_EPI = false, bool SP2 = false>
__device__ __forceinline__ void gemm_phase(PG8_LAS unsigned char* lds, const Gemm g, const Sched& S, const Epi& E) {
    int tid_ = threadIdx.x; asm volatile("" : "+v"(tid_));
    const int tid = tid_, wid = __builtin_amdgcn_readfirstlane(tid >> 6), lane = tid & 63, wr = wid >> 2, wc = wid & 3, fr = lane & 15, fq = lane >> 4;
    const int K = g.K, nt = K / BK;
    unsigned voffA[2], voffB[2];
#pragma unroll
    for (int i = 0; i < 2; ++i) { int R, C; stage_rc(tid * 16 + i * 8192, R, C); const int Rb = Epi::PERM ? ((R & ~31) + perm32(R & 31)) : R;
        voffA[i] = (unsigned)(R * K + C) * 2u; voffB[i] = (unsigned)(Rb * K + C) * 2u; }
    const size_t kstep = (size_t)(BK * 2);
    const size_t hstep = (size_t)HALF * K * 2;
    const size_t tstep = 2 * hstep;
    const unsigned ldsw = (unsigned)wid * 1024u;
    const int aoff = lds_byte(wr * 64 + fr, fq * 8), boff = lds_byte(wc * 32 + fr, fq * 8);
#define PG8_SA(b, h) (((b) * 2 + (h)) * HTB)
#define PG8_SB(b, h) ((4 + (b) * 2 + (h)) * HTB)
#define PG8_STAGE(bufoff, gbase, voff) do { _Pragma("unroll") for (int _i = 0; _i < 2; ++_i) \
        __builtin_amdgcn_global_load_lds((const unsigned*)((const char*)(gbase) + (voff)[_i]), (PG8_LAS unsigned*)(lds + (bufoff) + ldsw + _i * 8192), 16, 0, 0); } while (0)
#define PG8_LDA(dst, b, h) do { _Pragma("unroll") for (int m = 0; m < 4; ++m) _Pragma("unroll") for (int k = 0; k < 2; ++k) dst[m][k] = *(const PG8_LAS bf16x8*)(lds + PG8_SA(b, h) + aoff + m * 2048 + k * 1024); } while (0)
#define PG8_LDB(dst, b, h) do { _Pragma("unroll") for (int n = 0; n < 2; ++n) _Pragma("unroll") for (int k = 0; k < 2; ++k) dst[n][k] = *(const PG8_LAS bf16x8*)(lds + PG8_SB(b, h) + boff + n * 2048 + k * 1024); } while (0)
#define PG8_MMA(ai, bj, At, Bt) do { __builtin_amdgcn_s_setprio(1); _Pragma("unroll") for (int m = 0; m < 4; ++m) _Pragma("unroll") for (int n = 0; n < 2; ++n) _Pragma("unroll") for (int k = 0; k < 2; ++k) \
        acc[ai][bj][m][n] = __builtin_amdgcn_mfma_f32_16x16x32_bf16(Bt[n][k], At[m][k], acc[ai][bj][m][n], 0, 0, 0); __builtin_amdgcn_s_setprio(0); } while (0)
#define PG8_WAIT_V(n) asm volatile("s_waitcnt vmcnt(" #n ")" ::: "memory")
#define PG8_WAIT_L(n) asm volatile("s_waitcnt lgkmcnt(" #n ")" ::: "memory")
#define PG8_BAR __builtin_amdgcn_s_barrier()
#define PG8_SCHED __builtin_amdgcn_sched_barrier(0)
    Unit cur, nxt; int ui = 0;
    if (!S.next(0, cur)) return;
    f32x4 acc[2][2][4][2];
#pragma unroll
    for (int a = 0; a < 2; ++a)
#pragma unroll
        for (int b = 0; b < 2; ++b)
#pragma unroll
            for (int m = 0; m < 4; ++m)
#pragma unroll
                for (int n = 0; n < 2; ++n) acc[a][b][m][n] = (f32x4){0.f, 0.f, 0.f, 0.f};
    bf16x8 At[4][2], B0[2][2], B1[2][2];
    const char* cA = (const char*)g.A + (size_t)cur.pm * tstep; const char* cB = (const char*)g.Bt + (size_t)cur.pn * tstep;
    S.a_ready(cur);
    if constexpr (SP2) {
        PG8_STAGE(PG8_SB(0, 0), cB, voffB); PG8_STAGE(PG8_SB(0, 1), cB + hstep, voffB); PG8_STAGE(PG8_SA(0, 0), cA, voffA); PG8_STAGE(PG8_SA(0, 1), cA + hstep, voffA);
        if (wr == 1) PG8_BAR;
        PG8_WAIT_V(2); PG8_BAR;
        PG8_STAGE(PG8_SB(1, 0), cB + kstep, voffB); PG8_STAGE(PG8_SA(1, 0), cA + kstep, voffA); PG8_STAGE(PG8_SB(1, 1), cB + hstep + kstep, voffB);
        PG8_WAIT_V(6); PG8_BAR;
    } else {
        PG8_STAGE(PG8_SB(0, 0), cB, voffB); PG8_STAGE(PG8_SA(0, 0), cA, voffA); PG8_STAGE(PG8_SB(0, 1), cB + hstep, voffB); PG8_STAGE(PG8_SA(0, 1), cA + hstep, voffA);
        if (wr == 1) PG8_BAR;
        PG8_WAIT_V(4); PG8_BAR;
        PG8_STAGE(PG8_SB(1, 0), cB + kstep, voffB); PG8_STAGE(PG8_SA(1, 0), cA + kstep, voffA); PG8_STAGE(PG8_SB(1, 1), cB + hstep + kstep, voffB);
        PG8_WAIT_V(6); PG8_BAR;
    }
    for (;;) {
        const bool has_next = S.next(ui + 1, nxt);
        const char* nA = has_next ? (const char*)g.A + (size_t)nxt.pm * tstep : cA; const char* nB = has_next ? (const char*)g.Bt + (size_t)nxt.pn * tstep : cB;
        for (int t = 0; t < nt; t += 2) {
            const bool last = (t == nt - 2);
            const char* a1 = cA + (size_t)(t + 1) * kstep;
            const char* a2 = last ? nA : cA + (size_t)(t + 2) * kstep; const char* b2 = last ? nB : cB + (size_t)(t + 2) * kstep;
            const char* a3 = a2 + kstep; const char* b3 = b2 + kstep;
            if (last && has_next) S.a_ready(nxt);
            if constexpr (SP2) {
            PG8_LDB(B0, 0, 0); PG8_LDB(B1, 0, 1); PG8_SCHED; PG8_LDA(At, 0, 0); PG8_STAGE(PG8_SA(1, 1), a1 + hstep, voffA);
            PG8_WAIT_V(8); PG8_WAIT_L(0); PG8_BAR; PG8_MMA(0, 0, At, B0); PG8_MMA(0, 1, At, B1); PG8_BAR; PG8_SCHED;
            PG8_LDA(At, 0, 1); PG8_STAGE(PG8_SB(0, 0), b2, voffB); PG8_STAGE(PG8_SB(0, 1), b2 + hstep, voffB); PG8_STAGE(PG8_SA(0, 0), a2, voffA);
            PG8_WAIT_V(8); PG8_WAIT_L(0); PG8_BAR; PG8_MMA(1, 0, At, B0); PG8_MMA(1, 1, At, B1); PG8_BAR; PG8_SCHED;
            PG8_LDB(B0, 1, 0); PG8_LDB(B1, 1, 1); PG8_SCHED; PG8_LDA(At, 1, 0); PG8_STAGE(PG8_SA(0, 1), a2 + hstep, voffA);
            PG8_WAIT_V(8); PG8_WAIT_L(0); PG8_BAR; PG8_MMA(0, 0, At, B0); PG8_MMA(0, 1, At, B1); PG8_BAR; PG8_SCHED;
            PG8_LDA(At, 1, 1); PG8_STAGE(PG8_SB(1, 0), b3, voffB); PG8_STAGE(PG8_SB(1, 1), b3 + hstep, voffB); PG8_STAGE(PG8_SA(1, 0), a3, voffA);
            PG8_WAIT_V(8); PG8_WAIT_L(0); PG8_BAR; PG8_MMA(1, 0, At, B0); PG8_MMA(1, 1, At, B1); PG8_BAR; PG8_SCHED;
            } else {
            PG8_LDB(B0, 0, 0); PG8_SCHED; PG8_LDA(At, 0, 0); PG8_STAGE(PG8_SA(1, 1), a1 + hstep, voffA);
            PG8_WAIT_L(8); PG8_BAR; PG8_WAIT_L(0); PG8_MMA(0, 0, At, B0); PG8_BAR; PG8_SCHED;
            PG8_LDB(B1, 0, 1); PG8_STAGE(PG8_SB(0, 0), b2, voffB);
            PG8_BAR; PG8_WAIT_L(0); PG8_MMA(0, 1, At, B1); PG8_BAR;
            PG8_LDA(At, 0, 1); PG8_STAGE(PG8_SA(0, 0), a2, voffA);
            PG8_BAR; PG8_WAIT_L(0); PG8_MMA(1, 0, At, B0); PG8_BAR; PG8_SCHED;
            PG8_STAGE(PG8_SB(0, 1), b2 + hstep, voffB);
            PG8_WAIT_V(6); PG8_BAR; PG8_MMA(1, 1, At, B1); PG8_BAR;
            PG8_LDB(B0, 1, 0); PG8_SCHED; PG8_LDA(At, 1, 0); PG8_STAGE(PG8_SA(0, 1), a2 + hstep, voffA);
            PG8_WAIT_L(8); PG8_BAR; PG8_WAIT_L(0); PG8_MMA(0, 0, At, B0); PG8_BAR; PG8_SCHED;
            PG8_LDB(B1, 1, 1); PG8_STAGE(PG8_SB(1, 0), b3, voffB);
            PG8_BAR; PG8_WAIT_L(0); PG8_MMA(0, 1, At, B1); PG8_BAR;
            PG8_LDA(At, 1, 1); PG8_STAGE(PG8_SA(1, 0), a3, voffA);
            PG8_BAR; PG8_WAIT_L(0); PG8_MMA(1, 0, At, B0); PG8_BAR; PG8_SCHED;
            PG8_STAGE(PG8_SB(1, 1), b3 + hstep, voffB);
            PG8_WAIT_V(6); PG8_BAR; PG8_MMA(1, 1, At, B1); PG8_BAR;
            }
        }
        if constexpr (ALIGN_EPI) { if (wr == 0) PG8_BAR; }
        if constexpr (!Epi::AFTER_DRAIN) { E(acc, cur, wr, wc, fr, fq); S.done(cur); }
        if (!has_next) break;
#pragma unroll
        for (int a = 0; a < 2; ++a)
#pragma unroll
            for (int b = 0; b < 2; ++b)
#pragma unroll
                for (int m = 0; m < 4; ++m)
#pragma unroll
                    for (int n = 0; n < 2; ++n) acc[a][b][m][n] = (f32x4){0.f, 0.f, 0.f, 0.f};
        cur = nxt; cA = nA; cB = nB; ++ui;
        if constexpr (ALIGN_EPI) { if (wr == 1) PG8_BAR; }
    }
    PG8_WAIT_V(0);
    if constexpr (!ALIGN_EPI) { if (wr == 0) PG8_BAR; }
    PG8_BAR;
    if constexpr (Epi::AFTER_DRAIN) { E.fused(acc, cur, wr, wc, fr, fq, lds, wid, lane); S.done(cur); }
#undef PG8_SA
#undef PG8_SB
#undef PG8_STAGE
#undef PG8_LDA
#undef PG8_LDB
#undef PG8_MMA
#undef PG8_WAIT_V
#undef PG8_WAIT_L
#undef PG8_BAR
#undef PG8_SCHED
}
}

constexpr int NWAVES = 8, NTHR = 512;
constexpr int NB = 4, SEQ = 4096, DM = 2048, MTOK = NB * SEQ, NLAYER = 4;
constexpr int DFF = 5504, NUP = 2 * DFF;
constexpr int INC = 5028, INP = 5120;
constexpr int DRW = 768, RWC = 2560, PO_POOL = 2560, DPOOL = 512, PO_NSA = 3072;
constexpr int PO_Q = PO_NSA, PO_KC = PO_NSA + 768, PO_VC = PO_KC + 192, PO_KS = PO_VC + 192, PO_VS = PO_KS + 192, PO_KW = PO_VS + 192, PO_VW = PO_KW + 192, PO_GL = PO_VW + 192;
static_assert(PO_GL + 36 == INC, "W_in column map");
constexpr int NCMP = 255, NCMPP = 256;
constexpr float ALPHA = 1.6817928305074290f;
constexpr float LN_EPS = 1e-5f, GN_EPS = 64e-5f;
constexpr int NPH = 1 + 13 * NLAYER;

constexpr size_t MiB = 1u << 20;
constexpr size_t WS_CTL = 0, CTL_ZERO_BYTES = 1 * MiB;
constexpr size_t WS_ROPE = 1 * MiB;
constexpr size_t WS_KC = 2 * MiB, WS_VC = 2 * MiB + 512 * 1024;
constexpr size_t WS_SC = 3 * MiB;
constexpr size_t WS_WUP1 = 8 * MiB, WS_WDN1 = 51 * MiB, WS_WIN = WS_WDN1 + 21 * MiB + 512 * 1024, WS_WOUT = WS_WIN + 20 * MiB, WS_WUP2 = WS_WOUT + 8 * MiB, WS_WDN2 = WS_WUP2 + 43 * MiB;
constexpr size_t WS_XB = 165 * MiB;
static_assert(WS_WDN2 + (size_t)DM * DFF * 2 <= WS_XB, "weights map");
constexpr size_t WS_CAT = 229 * MiB;
constexpr size_t WS_QR = 293 * MiB;
constexpr size_t WS_KS = 317 * MiB, WS_KW = 323 * MiB, WS_VS = 329 * MiB, WS_VW = 335 * MiB;
constexpr size_t WS_P = 341 * MiB;
constexpr size_t WS_H = 661 * MiB;
constexpr size_t WS_Y = 833 * MiB;
constexpr size_t WS_SV = WS_H;
constexpr size_t SV_STRIDE = 48 * MiB;
static_assert(WS_SV + 6 * SV_STRIDE <= WS_Y + 128 * MiB, "scan overlay");
constexpr size_t WS_G = 961 * MiB, WS_YS = 1009 * MiB;
constexpr size_t WS_VST = 1057 * MiB, WS_VWT = 1063 * MiB;
constexpr size_t WS_VCT = 6 * MiB;
constexpr size_t WS_SW = 1069 * MiB;
constexpr size_t WS_W2T = WS_SW, WS_A2T = WS_W2T + 768 * 64 * 2, WS_G2T = WS_A2T + 768 * 64 * 2, WS_PWT = WS_G2T + 768 * 128 * 2;
constexpr size_t WS_W1T = WS_PWT + 4 * 128 * 128 * 2, WS_W2CT = WS_W1T + 2 * 256 * 2048 * 2, WS_CBIAS = WS_W2CT + 2 * 64 * 256 * 2;
constexpr size_t WS_END = 1073 * MiB;
static_assert(WS_CBIAS + 2 * 256 * 4 <= WS_END, "small weights map");

constexpr int LDS_BYTES = 147456, MISC_OFF = 131072 + 320;

#define GAS __attribute__((address_space(1)))
#define LAS __attribute__((address_space(3)))
typedef unsigned short bf16;
typedef float f32x4 __attribute__((ext_vector_type(4)));
typedef float f32x2 __attribute__((ext_vector_type(2)));
typedef unsigned u32x4 __attribute__((ext_vector_type(4)));
typedef unsigned u32x2 __attribute__((ext_vector_type(2)));
#define LDS_WAIT() asm volatile("s_waitcnt lgkmcnt(0)" ::: "memory")
__device__ __forceinline__ unsigned f2bf(float f) { unsigned u = __builtin_bit_cast(unsigned, f); return (u + 0x7fffu + ((u >> 16) & 1u)) >> 16; }
__device__ __forceinline__ unsigned pk2(float lo, float hi) { return f2bf(lo) | (f2bf(hi) << 16); }
__device__ __forceinline__ float bf2f(unsigned short b) { return __builtin_bit_cast(float, ((unsigned)b) << 16); }
__device__ __forceinline__ float wave_sum(float v) {
#pragma unroll
    for (int o = 1; o < 64; o <<= 1) v += __shfl_xor(v, o);
    return v;
}
__device__ __forceinline__ float wave_max(float v) {
#pragma unroll
    for (int o = 1; o < 64; o <<= 1) v = fmaxf(v, __shfl_xor(v, o));
    return v;
}
__device__ __forceinline__ float sigmoidf_(float x) { return 1.0f / (1.0f + expf(-x)); }
template <int CTRL> __device__ __forceinline__ float dpp_f(float v) { return __builtin_bit_cast(float, __builtin_amdgcn_update_dpp(0, __builtin_bit_cast(int, v), CTRL, 0xF, 0xF, true)); }
__device__ __forceinline__ float row16_sum(float v) {
    v += dpp_f<0xB1>(v); v += dpp_f<0x4E>(v); v += dpp_f<0x141>(v); v += dpp_f<0x140>(v); return v;
}

#define XB_TMO      128
#define XB_XCNT(j)  (256  + 64 * (j))
#define XB_XSUB(j)  (1280 + 64 * (j))
#define XB_XGEN(j)  (2304 + 64 * (j))
#define XB_TOP      3328
#define XB_TOPGEN   3392
#define XCD_BAR_WORDS 3456
#define XB_SPIN_CAP (1u << 18)

__device__ __forceinline__ unsigned xb_ld(unsigned* p)              { return __hip_atomic_load(p, __ATOMIC_RELAXED, __HIP_MEMORY_SCOPE_AGENT); }
__device__ __forceinline__ unsigned xb_add(unsigned* p, unsigned v) { return __hip_atomic_fetch_add(p, v, __ATOMIC_RELAXED, __HIP_MEMORY_SCOPE_AGENT); }
__device__ __forceinline__ unsigned xb_xcc_id() { return (unsigned)__builtin_amdgcn_s_getreg((3 << 11) | 20) & 0xFu; }
#define XB_SPIN(cond, bar) do { unsigned _sp = 0; while (cond) { __builtin_amdgcn_s_sleep(1); \
    if ((++_sp & 255u) == 0u) { if (xb_ld(&(bar)[XB_TMO])) break; if (_sp > XB_SPIN_CAP) { atomicAdd(&(bar)[XB_TMO], 1u); break; } } } } while (0)

struct XcdBarrier {
    unsigned* bar; unsigned x;
    volatile LAS unsigned* st;
};

__device__ __forceinline__ XcdBarrier xcd_barrier_post(unsigned* bar, volatile LAS unsigned* st) {
    XcdBarrier b; b.bar = bar; b.x = xb_xcc_id(); b.st = st;
    if (threadIdx.x == 0) (void)xb_add(&bar[XB_XCNT(b.x)], 1u);
    return b;
}
__device__ __forceinline__ void xcd_barrier_complete(unsigned* bar, unsigned x, unsigned& nloc, unsigned& nx) {
    const unsigned G = gridDim.x * gridDim.y * gridDim.z;
    unsigned sum, cnt, mine, sp = 0u;
    for (;;) {
        sum = 0u; cnt = 0u; mine = 0u;
#pragma unroll
        for (unsigned j = 0; j < 16; ++j) { const unsigned c = xb_ld(&bar[XB_XCNT(j)]); sum += c; cnt += (c > 0u) ? 1u : 0u; mine = (j == x) ? c : mine; }
        if (sum == G) break;
        __builtin_amdgcn_s_sleep(1);
        if ((++sp & 255u) == 0u) { if (xb_ld(&bar[XB_TMO])) break; if (sp > XB_SPIN_CAP) { atomicAdd(&bar[XB_TMO], 1u); break; } }
    }
    nloc = mine > 0u ? mine : 1u; nx = cnt > 0u ? cnt : 1u;
}

__device__ __forceinline__ void xcd_barrier(const XcdBarrier& b) {
    asm volatile("s_waitcnt vmcnt(0)" ::: "memory");
    __syncthreads();
    if (threadIdx.x == 0) {
        unsigned* bar = b.bar;
        __builtin_amdgcn_s_waitcnt(0);
        unsigned nloc = b.st[0], nx = b.st[1];
        if (nloc == 0u) { xcd_barrier_complete(bar, b.x, nloc, nx); b.st[0] = nloc; b.st[1] = nx; }
        const unsigned old = xb_add(&bar[XB_XSUB(b.x)], 1u);
        const unsigned gen = old / nloc;
        if (old + 1u == (gen + 1u) * nloc) {
            __builtin_amdgcn_fence(__ATOMIC_RELEASE, "agent");
            asm volatile("s_waitcnt vmcnt(0)" ::: "memory");
            const unsigned og = xb_add(&bar[XB_TOP], 1u);
            const unsigned tg = og / nx;
            if (og + 1u == (tg + 1u) * nx) xb_add(&bar[XB_TOPGEN], 1u);
            else XB_SPIN(xb_ld(&bar[XB_TOPGEN]) == tg, bar);
            __builtin_amdgcn_fence(__ATOMIC_ACQUIRE, "agent");
            xb_add(&bar[XB_XGEN(b.x)], 1u);
            asm volatile("s_waitcnt vmcnt(0)" ::: "memory");
        } else {
            XB_SPIN(xb_ld(&bar[XB_XGEN(b.x)]) == gen, bar);
            __builtin_amdgcn_fence(__ATOMIC_ACQUIRE, "agent");
            asm volatile("s_waitcnt vmcnt(0)" ::: "memory");
        }
    }
    __syncthreads();
}

struct Args { const float* in[34]; float* out; unsigned char* ws; int ph_lo, ph_hi; };
__device__ __forceinline__ int opaque0() { int z = 0; asm volatile("" : "+s"(z)); return z; }
#define OPQ_S(x) asm volatile("" : "+s"(x))
#define OPQ_SI(x) do { (x) = __builtin_amdgcn_readfirstlane(x); asm volatile("" : "+s"(x)); } while (0)
#define OPQ_V(x) asm volatile("" : "+v"(x))
#define INPTR(a, idx) ((a).in[(idx) + opaque0()])
enum { I_X = 0, I_UP1, I_DN1, I_LN1G, I_LN1B, I_WIN, I_MU, I_W0, I_W2, I_A0, I_A2, I_G2, I_KK, I_KA, I_RK, I_GNG, I_GNB, I_PW, I_PB, I_PS, I_PEK, I_PEV, I_CK1, I_CK2, I_CV1, I_CV2, I_GB, I_WOUT, I_LN2G, I_LN2B, I_UP2, I_DN2, I_LN3G, I_LN3B };

__device__ __forceinline__ void transpose_item(const float* W, int K, int Nsrc, bf16* WT, int dst0, LAS float* scr, int k0, int n0, int lane) {
    const int n = n0 + (lane & 31); const bool ok = n < Nsrc;
#pragma unroll 8
    for (int i = 0; i < 32; ++i) { const int kk = 2 * i + (lane >> 5); scr[kk * 33 + (lane & 31)] = ok ? W[(size_t)(k0 + kk) * Nsrc + n] : 0.f; }
    LDS_WAIT();
    const int c = lane & 7;
#pragma unroll
    for (int j = 0; j < 4; ++j) { const int nn = (lane >> 3) + 8 * j; const LAS float* s = scr + (8 * c) * 33 + nn;
        u32x4 o; o.x = pk2(s[0 * 33], s[1 * 33]); o.y = pk2(s[2 * 33], s[3 * 33]); o.z = pk2(s[4 * 33], s[5 * 33]); o.w = pk2(s[6 * 33], s[7 * 33]);
        *(u32x4*)(WT + (size_t)(dst0 + nn) * K + k0 + 8 * c) = o; }
    LDS_WAIT();
}
__device__ __forceinline__ int up_dst_row(int n0) { return n0 < DFF ? 256 * (n0 / 128) + (n0 % 128) : 256 * ((n0 - DFF) / 128) + 128 + ((n0 - DFF) % 128); }

__device__ __forceinline__ void phase_wconv(const Args& a, int l, LAS unsigned char* lds, int gw, int NGW, int wave, int lane) {
    OPQ_SI(gw); OPQ_SI(wave); OPQ_V(lane);
    LAS float* scr = (LAS float*)(lds + wave * 16384);
    unsigned char* ws = a.ws + opaque0();
    constexpr int I_UP = (DM / 64) * (NUP / 32), I_DN = (DFF / 64) * (DM / 32), I_IN = (DM / 64) * (INP / 32), I_OUT = (DM / 64) * (DM / 32);
    constexpr int NIT = 2 * I_UP + 2 * I_DN + I_IN + I_OUT + 24 + 24 + 48 + 32 + 512 + 16;
    for (int it = gw; it < NIT; it += NGW) {
        int r = it;
        if (r < 2 * I_UP) { const int which = r / I_UP; r -= which * I_UP; const int nblk = NUP / 32, kb = r / nblk, nb = r % nblk;
            const float* W = a.in[which ? I_UP2 : I_UP1] + (size_t)l * DM * NUP; bf16* WT = (bf16*)(ws + (which ? WS_WUP2 : WS_WUP1));
            transpose_item(W, DM, NUP, WT, up_dst_row(32 * nb), scr, 64 * kb, 32 * nb, lane); continue; }
        r -= 2 * I_UP;
        if (r < 2 * I_DN) { const int which = r / I_DN; r -= which * I_DN; const int nblk = DM / 32, kb = r / nblk, nb = r % nblk;
            const float* W = a.in[which ? I_DN2 : I_DN1] + (size_t)l * DFF * DM; bf16* WT = (bf16*)(ws + (which ? WS_WDN2 : WS_WDN1));
            transpose_item(W, DFF, DM, WT, 32 * nb, scr, 64 * kb, 32 * nb, lane); continue; }
        r -= 2 * I_DN;
        if (r < I_IN) { const int nblk = INP / 32, kb = r / nblk, nb = r % nblk;
            transpose_item(INPTR(a, I_WIN) + (size_t)l * DM * INC, DM, INC, (bf16*)(ws + WS_WIN), 32 * nb, scr, 64 * kb, 32 * nb, lane); continue; }
        r -= I_IN;
        if (r < I_OUT) { const int nblk = DM / 32, kb = r / nblk, nb = r % nblk;
            transpose_item(INPTR(a, I_WOUT) + (size_t)l * DM * DM, DM, DM, (bf16*)(ws + WS_WOUT), 32 * nb, scr, 64 * kb, 32 * nb, lane); continue; }
        r -= I_OUT;
        if (r < 24) { transpose_item(INPTR(a, I_W2) + (size_t)l * 64 * DRW, 64, DRW, (bf16*)(ws + WS_W2T), 32 * r, scr, 0, 32 * r, lane); continue; } r -= 24;
        if (r < 24) { transpose_item(INPTR(a, I_A2) + (size_t)l * 64 * DRW, 64, DRW, (bf16*)(ws + WS_A2T), 32 * r, scr, 0, 32 * r, lane); continue; } r -= 24;
        if (r < 48) { const int kb = r / 24, nb = r % 24; transpose_item(INPTR(a, I_G2) + (size_t)l * 128 * DRW, 128, DRW, (bf16*)(ws + WS_G2T), 32 * nb, scr, 64 * kb, 32 * nb, lane); continue; } r -= 48;
        if (r < 32) { const int gi = r >> 3, q = r & 7, kb = q >> 2, nb = q & 3; transpose_item(INPTR(a, I_PW) + ((size_t)l * 4 + gi) * 128 * 128, 128, 128, (bf16*)(ws + WS_PWT) + gi * 128 * 128, 32 * nb, scr, 64 * kb, 32 * nb, lane); continue; } r -= 32;
        if (r < 512) { const int ten = r >> 8, q = r & 255, kb = q >> 3, nb = q & 7; transpose_item(INPTR(a, ten ? I_CV1 : I_CK1) + (size_t)l * 2048 * 256, 2048, 256, (bf16*)(ws + WS_W1T) + (size_t)ten * 256 * 2048, 32 * nb, scr, 64 * kb, 32 * nb, lane); continue; } r -= 512;
        { const int ten = r >> 3, q = r & 7, kb = q >> 1, nb = q & 1; transpose_item(INPTR(a, ten ? I_CV2 : I_CK2) + (size_t)l * 256 * 64, 256, 64, (bf16*)(ws + WS_W2CT) + (size_t)ten * 64 * 256, 32 * nb, scr, 64 * kb, 32 * nb, lane); }
    }
    if (gw / NWAVES == NGW / NWAVES - 1) { const int tid2 = wave * 64 + lane, ten = tid2 >> 8, f = tid2 & 255;
        const float* pe = INPTR(a, ten ? I_PEV : I_PEK) + (size_t)l * 2048; const float* w1 = INPTR(a, ten ? I_CV1 : I_CK1) + (size_t)l * 2048 * 256 + f; float acc = 0.f;
        for (int k = 0; k < 2048; ++k) acc = fmaf(pe[k], w1[(size_t)k * 256], acc);
        ((float*)(ws + WS_CBIAS))[ten * 256 + f] = acc; }
}

__device__ __forceinline__ void phase_prologue(const Args& a, int gtid, int NGT) {
    OPQ_V(gtid);
    const f32x4* x4 = (const f32x4*)INPTR(a, I_X); u32x2* xb = (u32x2*)(a.ws + WS_XB);
    for (size_t i = gtid; i < (size_t)MTOK * DM / 4; i += NGT) { const f32x4 v = x4[i]; u32x2 o; o.x = pk2(v.x, v.y); o.y = pk2(v.z, v.w); xb[i] = o; }
    f32x2* rope = (f32x2*)(a.ws + WS_ROPE);
    for (int i = gtid; i < SEQ * 8; i += NGT) { const int s = i >> 3, k = i & 7;
        const float inv = powf(500000.0f, -(float)k * 0.125f); const float ang = (float)s * inv;
        const double ad = (double)ang; const double q = __builtin_rint(ad * 0.15915494309189535); const double rr = ad - q * 6.283185307179586;
        const float rf = (float)rr; rope[i] = (f32x2){cosf(rf), sinf(rf)}; }
}

__device__ __forceinline__ void phase_ln(const float* Y, const float* g, const float* b, float* X, bf16* XB, int gw, int NGW, int lane) {
    OPQ_SI(gw); OPQ_V(lane);
    f32x4 gv[8], bv[8];
#pragma unroll
    for (int j = 0; j < 8; ++j) { gv[j] = ((const f32x4*)g)[64 * j + lane]; bv[j] = ((const f32x4*)b)[64 * j + lane]; }
    for (int m = gw; m < MTOK; m += NGW) {
        const f32x4* yr = (const f32x4*)(Y + (size_t)m * DM) + lane; f32x4 v[8]; float s = 0.f;
#pragma unroll
        for (int j = 0; j < 8; ++j) { v[j] = yr[64 * j]; s += (v[j].x + v[j].y) + (v[j].z + v[j].w); }
        const float mean = wave_sum(s) * (1.f / DM); float s2 = 0.f;
#pragma unroll
        for (int j = 0; j < 8; ++j) { v[j] = v[j] - mean; s2 += (v[j].x * v[j].x + v[j].y * v[j].y) + (v[j].z * v[j].z + v[j].w * v[j].w); }
        const float rstd = 1.f / sqrtf(wave_sum(s2) * (1.f / DM) + LN_EPS);
        f32x4* xr = (f32x4*)(X + (size_t)m * DM) + lane; u32x2* xb = (u32x2*)(XB + (size_t)m * DM) + lane;
#pragma unroll
        for (int j = 0; j < 8; ++j) { const f32x4 o = v[j] * rstd * gv[j] + bv[j]; xr[64 * j] = o; u32x2 w; w.x = pk2(o.x, o.y); w.y = pk2(o.z, o.w); xb[64 * j] = w; }
    }
}


typedef float f32x16 __attribute__((ext_vector_type(16)));
typedef short bf16x8 __attribute__((ext_vector_type(8)));
#define MFMA32(a, b, c) __builtin_amdgcn_mfma_f32_32x32x16_bf16((a), (b), (c), 0, 0, 0)
#define WSYNC() asm volatile("s_waitcnt lgkmcnt(0)" ::: "memory")
__device__ __forceinline__ void half_swap(float x, float& lo, float& hi) { float a = x, b = x; asm volatile("s_nop 1\n\tv_permlane32_swap_b32 %0, %1" : "+v"(a), "+v"(b)); lo = a; hi = b; }
__device__ __forceinline__ float half_max(float x) { float lo, hi; half_swap(x, lo, hi); return fmaxf(lo, hi); }
__device__ __forceinline__ float half_sum(float x) { float lo, hi; half_swap(x, lo, hi); return lo + hi; }
__device__ __forceinline__ float other_half(float x, int h) { float lo, hi; half_swap(x, lo, hi); return h ? lo : hi; }
__device__ __forceinline__ unsigned cvtpk(float lo, float hi) { unsigned r; asm volatile("v_cvt_pk_bf16_f32 %0, %1, %2" : "=v"(r) : "v"(lo), "v"(hi)); return r; }
__device__ __forceinline__ float half32_sum(float v) { v = row16_sum(v); float a = v, b = v; asm volatile("s_nop 1\n\tv_permlane16_swap_b32 %0, %1" : "+v"(a), "+v"(b)); return a + b; }

constexpr int XP = 264, ZP = 520, HP = 264;
__device__ __forceinline__ bf16x8 lds_frag(const LAS bf16* p) { return *(const LAS bf16x8*)p; }
__device__ __forceinline__ bf16x8 cvt8(const f32x4 a, const f32x4 b) { u32x4 w; w.x = cvtpk(a.x, a.y); w.y = cvtpk(a.z, a.w); w.z = cvtpk(b.x, b.y); w.w = cvtpk(b.z, b.w); return __builtin_bit_cast(bf16x8, w); }
__device__ __forceinline__ void phase_m1(const Args& a, int l, LAS unsigned char* lds, int bid, int G, int tid, int wave, int lane) {
    OPQ_SI(bid); OPQ_V(tid); OPQ_SI(wave); lane = tid & 63;
    unsigned char* ws = a.ws + opaque0(); const float* P = (const float*)(ws + WS_P);
    const int r = lane & 31, h = lane >> 5;
    const f32x2* rope = (const f32x2*)(ws + WS_ROPE);
    for (int unit = bid; unit < MTOK / 64; unit += G) {
        const int t0 = unit * 64, b = t0 >> 12, s0 = t0 & (SEQ - 1);
        LAS bf16* XL = (LAS bf16*)lds;
        LAS bf16* ZL = (LAS bf16*)(lds + 64 * XP * 2);
        { const float* mu = INPTR(a, I_MU) + (size_t)l * RWC;
            for (int i = tid; i < 64 * 256; i += NTHR) { const int tt = i >> 8, j = i & 255, col = 2304 + j; const int m = t0 + tt;
                const float pc = P[(size_t)m * INP + col]; const float pp = (s0 + tt) > 0 ? P[(size_t)(m - 1) * INP + col] : 0.f; const float v = pc + (pp - pc) * mu[col];
                const float f = j < 64 ? tanhf(v) : (j < 128 ? v : sigmoidf_(v)); XL[tt * XP + j] = (bf16)f2bf(f); }
            for (int i = tid; i < 64 * DPOOL; i += NTHR) { const int tt = i >> 9, ch = i & 511, gi = ch >> 7; const int m = t0 + tt, s = s0 + tt; const int win = 2 << gi; const int cnt = (s + 1) < win ? (s + 1) : win;
                float sum = 0.f; for (int j = 0; j < cnt; ++j) sum += P[(size_t)(m - j) * INP + PO_POOL + ch];
                ZL[tt * ZP + ch] = (bf16)f2bf(sum / (float)cnt - P[(size_t)m * INP + PO_POOL + ch]); } }
        __syncthreads();
        {
            const float* mu = INPTR(a, I_MU) + (size_t)l * RWC; const float* w0 = INPTR(a, I_W0) + (size_t)l * DRW; const float* a0 = INPTR(a, I_A0) + (size_t)l * DRW;
            const float* k_k = INPTR(a, I_KK) + (size_t)l * DRW; const float* k_a = INPTR(a, I_KA) + (size_t)l * DRW; const float* r_k = INPTR(a, I_RK) + (size_t)l * DRW;
            const bf16* W2T = (const bf16*)(ws + WS_W2T); const bf16* A2T = (const bf16*)(ws + WS_A2T); const bf16* G2T = (const bf16*)(ws + WS_G2T);
            float* vKK = (float*)(ws + WS_SV); float* vWR = (float*)(ws + WS_SV + SV_STRIDE); float* vW = (float*)(ws + WS_SV + 2 * SV_STRIDE);
            float* vKM = (float*)(ws + WS_SV + 3 * SV_STRIDE); float* vBB = (float*)(ws + WS_SV + 4 * SV_STRIDE); float* vV = (float*)(ws + WS_SV + 5 * SV_STRIDE);
            float* vG = (float*)(ws + WS_G); float* SC = (float*)(ws + WS_SC);
#pragma unroll 1
            for (int jj = 0; jj < 3; ++jj) {
                const int job = wave + 8 * jj, hd = job >> 1, th = job & 1;
                f32x16 aU[2], aA[2], aG[2];
#pragma unroll
                for (int t = 0; t < 2; ++t)
#pragma unroll
                    for (int i = 0; i < 16; ++i) { aU[t][i] = 0.f; aA[t][i] = 0.f; aG[t][i] = 0.f; }
                const LAS bf16* xa = XL + (32 * th + r) * XP + 8 * h;
#pragma unroll
                for (int ks = 0; ks < 4; ++ks) { const bf16x8 xt = lds_frag(xa + 16 * ks), xl = lds_frag(xa + 64 + 16 * ks);
#pragma unroll
                    for (int t = 0; t < 2; ++t) { const int c = hd * 64 + 32 * t + r;
                        aU[t] = MFMA32(xt, *(const bf16x8*)(W2T + (size_t)c * 64 + 16 * ks + 8 * h), aU[t]);
                        aA[t] = MFMA32(xl, *(const bf16x8*)(A2T + (size_t)c * 64 + 16 * ks + 8 * h), aA[t]); } }
#pragma unroll
                for (int ks = 0; ks < 8; ++ks) { const bf16x8 xg = lds_frag(xa + 128 + 16 * ks);
#pragma unroll
                    for (int t = 0; t < 2; ++t) { const int c = hd * 64 + 32 * t + r; aG[t] = MFMA32(xg, *(const bf16x8*)(G2T + (size_t)c * 128 + 16 * ks + 8 * h), aG[t]); } }
                float pmr[2], pmk[2], pmv[2], pw0[2], pa0[2], pkk[2], pka[2], prk[2];
#pragma unroll
                for (int t = 0; t < 2; ++t) { const int c = hd * 64 + 32 * t + r; pmr[t] = mu[c]; pmk[t] = mu[768 + c]; pmv[t] = mu[1536 + c]; pw0[t] = w0[c]; pa0[t] = a0[c]; pkk[t] = k_k[c]; pka[t] = k_a[c]; prk[t] = r_k[c]; }
                const int lo_p = 4 * h * INP + hd * 64 + r, lo_s = 4 * h * DRW + hd * 64 + r;
#pragma unroll
                for (int i = 0; i < 16; ++i) {
                    const int mrow = t0 + 32 * th + (i & 3) + 8 * (i >> 2); const bool first = (s0 + 32 * th + (i & 3) + 8 * (i >> 2) + 4 * h) == 0;
                    const float* pc = P + (size_t)mrow * INP; const float* pp = pc - INP;
                    float rr[2], kv[2], vv[2], dec[2], av[2], kr[2], km[2];
                    float ss = 0.f, s1 = 0.f, s2 = 0.f, s3 = 0.f;
#pragma unroll
                    for (int t = 0; t < 2; ++t) { const int o = lo_p + 32 * t;
                        const float rc = pc[o], kc = pc[o + 768], vc = pc[o + 1536]; const float rp = first ? 0.f : pp[o], kp = first ? 0.f : pp[o + 768], vp = first ? 0.f : pp[o + 1536];
                        rr[t] = rc + (rp - rc) * pmr[t]; kv[t] = kc + (kp - kc) * pmk[t]; vv[t] = vc + (vp - vc) * pmv[t];
                        const float uu = pw0[t] + aU[t][i]; const float z = -uu; const float sp = z > 20.f ? z : log1pf(expf(z)); dec[t] = expf(-expf(-sp - 0.5f));
                        av[t] = sigmoidf_(pa0[t] + aA[t][i]);
                        kr[t] = kv[t] * pkk[t]; km[t] = kv[t] * (1.0f + (av[t] - 1.0f) * pka[t]);
                        ss += kr[t] * kr[t]; s1 += kr[t] * av[t] * rr[t]; s2 += km[t] * rr[t]; s3 += rr[t] * km[t] * prk[t]; }
                    ss = half32_sum(ss); s1 = half32_sum(s1); s2 = half32_sum(s2); s3 = half32_sum(s3);
                    const float invn = 1.0f / fmaxf(sqrtf(ss), 1e-12f);
                    const size_t ro = (size_t)mrow * DRW;
#pragma unroll
                    for (int t = 0; t < 2; ++t) { const int o = lo_s + 32 * t; const float kk = kr[t] * invn;
                        (vKK + ro)[o] = kk; (vWR + ro)[o] = dec[t] * rr[t]; (vW + ro)[o] = dec[t]; (vKM + ro)[o] = km[t]; (vBB + ro)[o] = kk * av[t]; (vV + ro)[o] = vv[t]; (vG + ro)[o] = aG[t][i]; }
                    if (r == 0) *(f32x4*)(SC + ((size_t)mrow * 12 + hd) * 4 + 4 * h * 48) = (f32x4){s1 * invn, s2, s3, 0.f};
                    asm volatile("" ::: "memory");
                }
            }
        }
        {
            const int gi = wave >> 1, th = wave & 1; const bf16* PWT = (const bf16*)(ws + WS_PWT) + gi * 128 * 128;
            const float* pb = INPTR(a, I_PB) + (size_t)l * DPOOL + gi * 128; const float* psc = INPTR(a, I_PS) + (size_t)l * DPOOL + gi * 128; bf16* CAT = (bf16*)(ws + WS_CAT);
            f32x16 acc[4];
#pragma unroll
            for (int t = 0; t < 4; ++t)
#pragma unroll
                for (int i = 0; i < 16; ++i) acc[t][i] = 0.f;
            const LAS bf16* za = ZL + (32 * th + r) * ZP + gi * 128 + 8 * h;
#pragma unroll
            for (int ks = 0; ks < 8; ++ks) { const bf16x8 zf = lds_frag(za + 16 * ks);
#pragma unroll
                for (int t = 0; t < 4; ++t) acc[t] = MFMA32(zf, *(const bf16x8*)(PWT + (size_t)(32 * t + r) * 128 + 16 * ks + 8 * h), acc[t]); }
#pragma unroll
            for (int t = 0; t < 4; ++t) { const int d = 32 * t + r; const float bv = pb[d], sv = psc[d];
#pragma unroll
                for (int i = 0; i < 16; ++i) { const int m = t0 + 32 * th + (i & 3) + 8 * (i >> 2) + 4 * h; CAT[(size_t)m * DM + DRW + gi * 128 + d] = (bf16)f2bf((acc[t][i] + bv) * sv); } }
        }
        __syncthreads();
        {
            bf16* QR = (bf16*)(ws + WS_QR); bf16* KS = (bf16*)(ws + WS_KS); bf16* KW = (bf16*)(ws + WS_KW); bf16* VST = (bf16*)(ws + WS_VST); bf16* VWT = (bf16*)(ws + WS_VWT);
            LAS float* T0 = (LAS float*)lds; LAS float* T1 = T0 + 64 * 193;
            for (int i = tid; i < 64 * 1152; i += NTHR) { const int tt = i / 1152, c = i - tt * 1152; const int m = t0 + tt, s = s0 + tt; const float* pr = P + (size_t)m * INP;
                int src; bf16* dst; float scale = 1.f;
                if (c < 768) { src = PO_Q + c; dst = QR + (size_t)m * 768 + c; scale = 0.125f * 1.4426950408889634f; }
                else if (c < 960) { src = PO_KS + (c - 768); dst = KS + (size_t)m * 192 + (c - 768); }
                else { src = PO_KW + (c - 960); dst = KW + (size_t)m * 192 + (c - 960); }
                const int d = c & 63; float v = pr[src];
                if (d < 16) { const f32x2 cs = rope[s * 8 + (d & 7)]; v = d < 8 ? v * cs.x - pr[src + 8] * cs.y : v * cs.x + pr[src - 8] * cs.y; }
                *dst = (bf16)f2bf(v * scale); }
            for (int i = tid; i < 64 * 384; i += NTHR) { const int tt = i / 384, c = i - tt * 384; const float* pr = P + (size_t)(t0 + tt) * INP;
                if (c < 192) T0[tt * 193 + c] = pr[PO_VS + c]; else T1[tt * 193 + (c - 192)] = pr[PO_VW + (c - 192)]; }
            __syncthreads();
            for (int i = tid; i < 384 * 64; i += NTHR) { const int c2 = i >> 6, tok = i & 63; const int which = c2 >= 192, c = which ? c2 - 192 : c2;
                const float v = (which ? T1 : T0)[tok * 193 + c]; bf16* dst = (which ? VWT : VST) + ((size_t)(b * 3 + (c >> 6)) * 64 + (c & 63)) * SEQ + s0 + tok; *dst = (bf16)f2bf(v); }
        }
        __syncthreads();
    }
    {
        LAS bf16* HL = (LAS bf16*)lds;
        const float* cbias = (const float*)(ws + WS_CBIAS); bf16* KC = (bf16*)(ws + WS_KC); bf16* VCT = (bf16*)(ws + WS_VCT);
        for (int u = bid; u < 2 * NB * 3 * 8; u += G) {
            const int ten = u / 96, q = u - ten * 96, b = q / 24, q2 = q - b * 24, hh = q2 >> 3, nt = q2 & 7, n0 = 32 * nt;
            const bf16* W1T = (const bf16*)(ws + WS_W1T) + (size_t)ten * 256 * 2048 + (size_t)(32 * wave + r) * 2048 + 8 * h;
            const int tk0 = 16 * (n0 + r);
            const float* pa = P + ((size_t)b * SEQ + tk0) * INP + (ten ? PO_VC : PO_KC) + hh * 64 + 8 * h;
            f32x16 acc;
#pragma unroll
            for (int i = 0; i < 16; ++i) acc[i] = 0.f;
#pragma unroll 2
            for (int ll = 0; ll < 32; ++ll) {
                const bool ok = tk0 + ll < SEQ; const float* pl = pa + (size_t)ll * INP;
#pragma unroll
                for (int ds = 0; ds < 4; ++ds) { f32x4 x0 = {0.f, 0.f, 0.f, 0.f}, x1 = {0.f, 0.f, 0.f, 0.f}; if (ok) { x0 = *(const f32x4*)(pl + 16 * ds); x1 = *(const f32x4*)(pl + 16 * ds + 4); }
                    acc = MFMA32(cvt8(x0, x1), *(const bf16x8*)(W1T + 64 * ll + 16 * ds), acc); }
            }
            { const float cb = cbias[ten * 256 + 32 * wave + r];
#pragma unroll
                for (int i = 0; i < 16; ++i) { const float x = acc[i] + cb; const float gl = 0.5f * x * (1.0f + tanhf(0.7978845608028654f * (x + 0.044715f * x * x * x)));
                    HL[((i & 3) + 8 * (i >> 2) + 4 * h) * HP + 32 * wave + r] = (bf16)f2bf(gl); } }
            __syncthreads();
            if (wave < 2) {
                const bf16* W2CT = (const bf16*)(ws + WS_W2CT) + (size_t)ten * 64 * 256 + (size_t)(32 * wave + r) * 256 + 8 * h;
                f32x16 o;
#pragma unroll
                for (int i = 0; i < 16; ++i) o[i] = 0.f;
                const LAS bf16* ha = HL + r * HP + 8 * h;
#pragma unroll
                for (int ks = 0; ks < 16; ++ks) o = MFMA32(lds_frag(ha + 16 * ks), *(const bf16x8*)(W2CT + 16 * ks), o);
                const int d = 32 * wave + r;
#pragma unroll
                for (int i = 0; i < 16; ++i) { const int n = n0 + (i & 3) + 8 * (i >> 2) + 4 * h; float v = o[i];
                    if (ten == 0) { const float other = dpp_f<0x128>(v);
                        if (wave == 0 && r < 16) { const f32x2 cs = rope[((16 * n + 31) & (SEQ - 1)) * 8 + (r & 7)]; v = r < 8 ? v * cs.x - other * cs.y : v * cs.x + other * cs.y; }
                        if (n < NCMP) KC[((size_t)(b * NCMPP + n) * 3 + hh) * 64 + d] = (bf16)f2bf(v); }
                    else if (n < NCMP) VCT[((size_t)(b * 3 + hh) * 64 + d) * NCMPP + n] = (bf16)f2bf(v); }
            }
            __syncthreads();
        }
    }
}

constexpr int SCH = 16, SSTR = 360;
__device__ __forceinline__ void phase_scan(const Args& a, LAS unsigned char* lds, int bid, int tid, int wave, int lane) {
    OPQ_SI(bid); OPQ_V(tid); OPQ_SI(wave); lane = tid & 63;
    unsigned char* ws = a.ws + opaque0();
    const int hd = bid >> 1, half = bid & 1, b = hd / 12, h = hd - b * 12;
    const int rowl = wave * 4 + (lane >> 4), j = lane & 15;
    const float* SC = (const float*)(ws + WS_SC); float* YS = (float*)(ws + WS_YS);
    LAS float* buf = (LAS float*)lds;
    const size_t m0 = (size_t)b * SEQ;
    const float* src[3]; int dsto[3]; bool act[3];
#pragma unroll
    for (int q = 0; q < 3; ++q) { const int i = tid + q * NTHR; act[q] = i < SCH * 88; const int st = i / 88, r = i - st * 88;
        if (r < 80) { const int vec = r >> 4, part = r & 15; src[q] = (const float*)(ws + WS_SV + (size_t)vec * SV_STRIDE) + (m0 + st) * DRW + h * 64 + part * 4; dsto[q] = st * SSTR + vec * 64 + part * 4; }
        else { const int part = r - 80; src[q] = (const float*)(ws + WS_SV + 5 * SV_STRIDE) + (m0 + st) * DRW + h * 64 + half * 32 + part * 4; dsto[q] = st * SSTR + 320 + part * 4; } }
    const float* srcc = SC + ((m0 + (tid & 15)) * 12 + h) * 4; const int dstc = (tid & 15) * SSTR + 352;
    f32x4 pre[3]; f32x2 prec;
#define SCAN_LOAD(ck) do { _Pragma("unroll") for (int q = 0; q < 3; ++q) if (act[q]) pre[q] = *(const f32x4*)(src[q] + (size_t)(ck) * SCH * DRW); if (tid < 16) prec = *(const f32x2*)(srcc + (size_t)(ck) * SCH * 48); } while (0)
#define SCAN_STORE(bb) do { _Pragma("unroll") for (int q = 0; q < 3; ++q) if (act[q]) *(LAS f32x4*)(buf + (bb) * SCH * SSTR + dsto[q]) = pre[q]; if (tid < 16) *(LAS f32x2*)(buf + (bb) * SCH * SSTR + dstc) = prec; } while (0)
    SCAN_LOAD(0); SCAN_STORE(0); __syncthreads();
    float S0 = 0.f, S1 = 0.f, S2 = 0.f, S3 = 0.f;
    constexpr int NCH = SEQ / SCH;
    for (int ck = 0; ck < NCH; ++ck) {
        if (ck + 1 < NCH) SCAN_LOAD(ck + 1);
        const LAS float* cb = buf + (ck & 1) * SCH * SSTR;
#pragma unroll 4
        for (int st = 0; st < SCH; ++st) {
            const LAS float* sb = cb + st * SSTR;
            const f32x4 kk = *(const LAS f32x4*)(sb + 4 * j), wr = *(const LAS f32x4*)(sb + 64 + 4 * j), w = *(const LAS f32x4*)(sb + 128 + 4 * j), km = *(const LAS f32x4*)(sb + 192 + 4 * j), bb = *(const LAS f32x4*)(sb + 256 + 4 * j);
            const float v = sb[320 + rowl]; const f32x2 c = *(const LAS f32x2*)(sb + 352);
            float p1 = S0 * kk.x; p1 = fmaf(S1, kk.y, p1); p1 = fmaf(S2, kk.z, p1); p1 = fmaf(S3, kk.w, p1);
            float p2 = S0 * wr.x; p2 = fmaf(S1, wr.y, p2); p2 = fmaf(S2, wr.z, p2); p2 = fmaf(S3, wr.w, p2);
            const float sa = row16_sum(p1), y0 = row16_sum(p2);
            const float t0 = fmaf(S0, w.x, v * km.x), t1 = fmaf(S1, w.y, v * km.y), t2 = fmaf(S2, w.z, v * km.z), t3 = fmaf(S3, w.w, v * km.w);
            S0 = fmaf(-sa, bb.x, t0); S1 = fmaf(-sa, bb.y, t1); S2 = fmaf(-sa, bb.z, t2); S3 = fmaf(-sa, bb.w, t3);
            const float y = y0 - sa * c.x + v * c.y;
            if (j == 0) YS[(m0 + (size_t)ck * SCH + st) * DRW + h * 64 + half * 32 + rowl] = y;
        }
        if (ck + 1 < NCH) SCAN_STORE((ck + 1) & 1);
        __syncthreads();
    }
#undef SCAN_LOAD
#undef SCAN_STORE
}


__device__ __forceinline__ void load_k(const bf16* Kb, int key0, int r, int h, bf16x8 (&kf)[4]) {
    const bf16* p = Kb + (size_t)(key0 + r) * 192 + 8 * h;
#pragma unroll
    for (int ks = 0; ks < 4; ++ks) kf[ks] = *(const bf16x8*)(p + 16 * ks);
}
__device__ __forceinline__ void load_v(const bf16* Vt, int ld, int key0, int r, int h, bf16x8 (&vf)[2][2]) {
#pragma unroll
    for (int dt = 0; dt < 2; ++dt)
#pragma unroll
        for (int s = 0; s < 2; ++s) { const bf16* p = Vt + (size_t)(32 * dt + r) * ld + key0 + 16 * s + 4 * h; const u32x2 lo = *(const u32x2*)p, hi = *(const u32x2*)(p + 8);
            u32x4 w; w.x = lo.x; w.y = lo.y; w.z = hi.x; w.w = hi.y; vf[dt][s] = __builtin_bit_cast(bf16x8, w); }
}
__device__ __forceinline__ f32x16 qk_tile(const bf16x8 (&kf)[4], const bf16x8 (&qf)[4]) {
    f32x16 S;
#pragma unroll
    for (int i = 0; i < 16; ++i) S[i] = 0.f;
#pragma unroll
    for (int ks = 0; ks < 4; ++ks) S = MFMA32(kf[ks], qf[ks], S);
    return S;
}
__device__ __forceinline__ void pv_tile(const float (&p)[16], const bf16x8 (&vf)[2][2], f32x16 (&O)[2]) {
#pragma unroll
    for (int s = 0; s < 2; ++s) { u32x4 w; w.x = cvtpk(p[8 * s], p[8 * s + 1]); w.y = cvtpk(p[8 * s + 2], p[8 * s + 3]); w.z = cvtpk(p[8 * s + 4], p[8 * s + 5]); w.w = cvtpk(p[8 * s + 6], p[8 * s + 7]);
        const bf16x8 pf = __builtin_bit_cast(bf16x8, w);
#pragma unroll
        for (int dt = 0; dt < 2; ++dt) O[dt] = MFMA32(vf[dt][s], pf, O[dt]); }
}
template <int MODE> __device__ __forceinline__ void att_tile(const bf16x8 (&kf)[4], const bf16x8 (&qf)[4], const bf16x8 (&vf)[2][2], int key0, int h, int qp, bool colsel, float& m, float& l, f32x16 (&O)[2]) {
    const f32x16 S = qk_tile(kf, qf);
    float sv[16]; float tmax = -INFINITY;
#pragma unroll
    for (int i = 0; i < 16; ++i) { const int key = key0 + (i & 3) + 8 * (i >> 2) + 4 * h;
        const bool ok = MODE == 1 ? colsel : MODE == 2 ? (colsel && key <= qp) : (key <= qp && key >= qp - 511);
        sv[i] = ok ? S[i] : -INFINITY; tmax = fmaxf(tmax, sv[i]); }
    tmax = half_max(tmax);
    const float mn = fmaxf(m, tmax); const float ms = mn == -INFINITY ? 0.f : mn;
    const float alpha = __builtin_amdgcn_exp2f(m - ms);
    float p[16]; float ps = 0.f;
#pragma unroll
    for (int i = 0; i < 16; ++i) { p[i] = __builtin_amdgcn_exp2f(sv[i] - ms); ps += p[i]; }
    l = l * alpha + half_sum(ps); m = mn;
#pragma unroll
    for (int dt = 0; dt < 2; ++dt)
#pragma unroll
        for (int i = 0; i < 16; ++i) O[dt][i] *= alpha;
    pv_tile(p, vf, O);
}
__device__ __forceinline__ void phase_nsa(const Args& a, int l, LAS unsigned char* lds, int bid, int tid, int wave, int lane) {
    OPQ_SI(bid); OPQ_V(tid); OPQ_SI(wave); lane = tid & 63;
    unsigned char* ws = a.ws + opaque0();
    LAS float* impl = (LAS float*)(lds + wave * 2048);
    volatile LAS int* qslot = (volatile LAS int*)(lds + 16384);
    const bf16* QR = (const bf16*)(ws + WS_QR); const float* P = (const float*)(ws + WS_P); const float* gate_b = INPTR(a, I_GB) + (size_t)l * 36; bf16* CAT = (bf16*)(ws + WS_CAT);
    unsigned* qctr = (unsigned*)(ws + WS_CTL) + 8192 + 64 * l;
    const int r = lane & 31, h = lane >> 5, g = r & 3, ql = r >> 2;
    for (;;) {
        __syncthreads();
        if (tid == 0) *qslot = (int)atomicAdd(qctr, 1u);
        __syncthreads();
        const int u = *qslot;
        if (u >= NB * 3 * 64) break;
        const int qt = 63 - u / 12, bk = u - (u / 12) * 12, b = bk / 3, kvh = bk - b * 3;
        const int tile0 = qt * 64, cur = qt; const int qp = tile0 + 8 * wave + ql; const size_t mq = (size_t)b * SEQ + qp; const int head = kvh * 4 + g;
        bf16x8 qf[4];
#pragma unroll
        for (int ks = 0; ks < 4; ++ks) qf[ks] = *(const bf16x8*)(QR + mq * 768 + head * 64 + 16 * ks + 8 * h);
        float g0, g1, g2;
        { const float* gl = P + mq * INP + PO_GL + head * 3; const float* gb = gate_b + head * 3; g0 = sigmoidf_(gl[0] + gb[0]); g1 = sigmoidf_(gl[1] + gb[1]); g2 = sigmoidf_(gl[2] + gb[2]); }
        f32x16 out[2], O[2];
#pragma unroll
        for (int dt = 0; dt < 2; ++dt)
#pragma unroll
            for (int i = 0; i < 16; ++i) out[dt][i] = 0.f;
        unsigned long long mymask = (2ull << cur) - 1ull, umask = mymask;
        {
            const bf16* Kb = (const bf16*)(ws + WS_KC) + ((size_t)b * NCMPP * 3 + kvh) * 64; const bf16* Vt = (const bf16*)(ws + WS_VCT) + (size_t)(b * 3 + kvh) * 64 * NCMPP;
            const int qpw = tile0 + 8 * wave + 7; const int nvw = qpw >= 31 ? ((qpw - 31) >> 4) + 1 : 0; const int nvq = qp >= 31 ? ((qp - 31) >> 4) + 1 : 0; const int ntile = (nvw + 31) >> 5;
            const bool need_imp = cur >= 16;
            if (ntile > 0) {
                float m = -INFINITY, ls = 0.f;
#pragma unroll 1
                for (int kt = 0; kt < ntile; ++kt) { bf16x8 kf[4]; load_k(Kb, 32 * kt, r, h, kf); const f32x16 S = qk_tile(kf, qf);
                    float tmax = -INFINITY; float sv[16];
#pragma unroll
                    for (int i = 0; i < 16; ++i) { const int n = 32 * kt + (i & 3) + 8 * (i >> 2) + 4 * h; sv[i] = n < nvq ? S[i] : -INFINITY; tmax = fmaxf(tmax, sv[i]); }
                    tmax = half_max(tmax); const float mn = fmaxf(m, tmax); const float ms = mn == -INFINITY ? 0.f : mn; float ps = 0.f;
#pragma unroll
                    for (int i = 0; i < 16; ++i) ps += __builtin_amdgcn_exp2f(sv[i] - ms);
                    ls = ls * __builtin_amdgcn_exp2f(m - ms) + half_sum(ps); m = mn; }
                const float ms = m == -INFINITY ? 0.f : m; const float inv = 1.0f / fmaxf(ls, 1.17549435e-38f);
                float carry = 0.f;
#pragma unroll
                for (int dt = 0; dt < 2; ++dt)
#pragma unroll
                    for (int i = 0; i < 16; ++i) O[dt][i] = 0.f;
                if (need_imp) {
#pragma unroll
                    for (int i = 0; i < 8; ++i) impl[i * 64 + lane] = 0.f;
                    WSYNC(); }
#pragma unroll 1
                for (int kt = 0; kt < ntile; ++kt) {
                    bf16x8 kf[4]; bf16x8 vf[2][2]; load_k(Kb, 32 * kt, r, h, kf); load_v(Vt, NCMPP, 32 * kt, r, h, vf); const f32x16 S = qk_tile(kf, qf);
                    float p[16];
#pragma unroll
                    for (int i = 0; i < 16; ++i) { const int n = 32 * kt + (i & 3) + 8 * (i >> 2) + 4 * h; p[i] = n < nvq ? __builtin_amdgcn_exp2f(S[i] - ms) * inv : 0.f; }
                    if (need_imp) {
                        float val[4];
#pragma unroll
                        for (int t = 0; t < 4; ++t) { const float sp = 0.5f * p[4 * t + 3]; const float base = (p[4 * t] + p[4 * t + 1]) + (p[4 * t + 2] + sp); const float rv = other_half(sp, h);
                            val[t] = base + (h ? rv : carry); carry = h ? 0.f : rv; }
#pragma unroll
                        for (int t = 0; t < 4; ++t) { float v = val[t]; v += dpp_f<0xB1>(v); v += dpp_f<0x4E>(v); if (g == 0) impl[ql * 64 + 8 * kt + 2 * t + h] = v; }
                    }
                    pv_tile(p, vf, O);
                }
#pragma unroll
                for (int dt = 0; dt < 2; ++dt)
#pragma unroll
                    for (int i = 0; i < 16; ++i) out[dt][i] = O[dt][i] * g0;
                if (need_imp) {
                    WSYNC();
#pragma unroll 1
                    for (int q = 0; q < 8; ++q) { const float v = impl[q * 64 + lane]; const bool forced = lane == 0 || lane == cur || lane == cur - 1; impl[q * 64 + lane] = lane > cur ? -INFINITY : (forced ? 1e9f : v); }
                    WSYNC();
                    umask = 0ull;
#pragma unroll 1
                    for (int q = 0; q < 8; ++q) { const float sc = impl[q * 64 + lane]; int rank = 0;
#pragma unroll 4
                        for (int i4 = 0; i4 < 16; ++i4) { const f32x4 o = *(const LAS f32x4*)(impl + q * 64 + 4 * i4);
                            rank += (o.x > sc || (o.x == sc && 4 * i4 + 0 < lane)) ? 1 : 0; rank += (o.y > sc || (o.y == sc && 4 * i4 + 1 < lane)) ? 1 : 0;
                            rank += (o.z > sc || (o.z == sc && 4 * i4 + 2 < lane)) ? 1 : 0; rank += (o.w > sc || (o.w == sc && 4 * i4 + 3 < lane)) ? 1 : 0; }
                        const unsigned long long mk = __ballot(lane <= cur && rank < 16);
                        umask |= mk; if (ql == q) mymask = mk; }
                    WSYNC();
                }
            }
        }
        {
            const bf16* Kb = (const bf16*)(ws + WS_KS) + ((size_t)b * SEQ * 3 + kvh) * 64; const bf16* Vt = (const bf16*)(ws + WS_VST) + (size_t)(b * 3 + kvh) * 64 * SEQ;
            float m = -INFINITY, ls = 0.f;
#pragma unroll
            for (int dt = 0; dt < 2; ++dt)
#pragma unroll
                for (int i = 0; i < 16; ++i) O[dt][i] = 0.f;
            const int qpw = tile0 + 8 * wave + 7;
            unsigned long long um = umask;
#pragma unroll 1
            while (um) { const int jb = __builtin_ctzll(um); um &= um - 1ull; const bool colsel = (mymask >> jb) & 1ull;
#pragma unroll 1
                for (int hf = 0; hf < 2; ++hf) { const int key0 = 64 * jb + 32 * hf; if (key0 > qpw) break;
                    bf16x8 kf[4]; bf16x8 vf[2][2]; load_k(Kb, key0, r, h, kf); load_v(Vt, SEQ, key0, r, h, vf);
                    if (jb == cur) att_tile<2>(kf, qf, vf, key0, h, qp, colsel, m, ls, O); else att_tile<1>(kf, qf, vf, key0, h, qp, colsel, m, ls, O); } }
            const float sc = g1 / fmaxf(ls, 1.17549435e-38f);
#pragma unroll
            for (int dt = 0; dt < 2; ++dt)
#pragma unroll
                for (int i = 0; i < 16; ++i) out[dt][i] += O[dt][i] * sc;
        }
        {
            const bf16* Kb = (const bf16*)(ws + WS_KW) + ((size_t)b * SEQ * 3 + kvh) * 64; const bf16* Vt = (const bf16*)(ws + WS_VWT) + (size_t)(b * 3 + kvh) * 64 * SEQ;
            float m = -INFINITY, ls = 0.f;
#pragma unroll
            for (int dt = 0; dt < 2; ++dt)
#pragma unroll
                for (int i = 0; i < 16; ++i) O[dt][i] = 0.f;
            const int q0w = tile0 + 8 * wave; const int lo = q0w - 511 > 0 ? q0w - 511 : 0;
#pragma unroll 1
            for (int t = lo >> 5; t <= (q0w + 7) >> 5; ++t) { bf16x8 kf[4]; bf16x8 vf[2][2]; load_k(Kb, 32 * t, r, h, kf); load_v(Vt, SEQ, 32 * t, r, h, vf); att_tile<3>(kf, qf, vf, 32 * t, h, qp, true, m, ls, O); }
            const float sc = g2 / fmaxf(ls, 1.17549435e-38f);
#pragma unroll
            for (int dt = 0; dt < 2; ++dt)
#pragma unroll
                for (int i = 0; i < 16; ++i) out[dt][i] += O[dt][i] * sc;
        }
        { bf16* op = CAT + mq * DM + DRW + DPOOL + head * 64 + 4 * h;
#pragma unroll
            for (int dt = 0; dt < 2; ++dt)
#pragma unroll
                for (int t = 0; t < 4; ++t) { u32x2 w; w.x = cvtpk(out[dt][4 * t], out[dt][4 * t + 1]); w.y = cvtpk(out[dt][4 * t + 2], out[dt][4 * t + 3]); *(u32x2*)(op + 32 * dt + 8 * t) = w; } }
    }
}

__device__ __forceinline__ void phase_rwkv_out(const Args& a, int l, int gw, int NGW, int lane) {
    OPQ_SI(gw); OPQ_V(lane);
    unsigned char* ws = a.ws + opaque0(); const float* YS = (const float*)(ws + WS_YS); const float* vV = (const float*)(ws + WS_SV + 5 * SV_STRIDE); const float* vG = (const float*)(ws + WS_G); const float* SC = (const float*)(ws + WS_SC);
    const float* gng = INPTR(a, I_GNG) + (size_t)l * DRW; const float* gnb = INPTR(a, I_GNB) + (size_t)l * DRW; bf16* CAT = (bf16*)(ws + WS_CAT);
    for (int id = gw; id < MTOK * 12; id += NGW) { const int m = id / 12, h = id - m * 12, c = h * 64 + lane; const size_t o = (size_t)m * DRW + c;
        const float y = YS[o]; const float mean = wave_sum(y) * (1.f / 64.f); const float d = y - mean; const float var = wave_sum(d * d) * (1.f / 64.f);
        const float yn = d * (1.f / sqrtf(var + GN_EPS)) * gng[c] + gnb[c]; const float bonus = SC[((size_t)m * 12 + h) * 4 + 2] * vV[o];
        CAT[(size_t)m * DM + c] = (bf16)f2bf((yn + bonus) * vG[o]); }
}

template <int PHMASK> __global__ void __launch_bounds__(NTHR, 2) fwd(Args args) {
    extern __shared__ __attribute__((aligned(16))) unsigned char lds_raw[];
    LAS unsigned char* lds = (LAS unsigned char*)lds_raw;
    const int tid = threadIdx.x, lane = tid & 63, wave = __builtin_amdgcn_readfirstlane(tid >> 6);
    const int G = gridDim.x, bid = blockIdx.x; const int gw = bid * NWAVES + wave, NGW = G * NWAVES;
    unsigned char* ws = args.ws;
    for (int u = tid; u < (LDS_BYTES - 131072) / 4; u += NTHR) ((LAS unsigned*)(lds + 131072))[u] = 0u;
    __syncthreads();
    const int lo = args.ph_lo, hi = args.ph_hi;
    XcdBarrier bar; bar.bar = (unsigned*)(ws + WS_CTL) + 4096; bar.x = 0; bar.st = nullptr;
    if (hi - lo > 1) bar = xcd_barrier_post((unsigned*)(ws + WS_CTL) + 4096, (volatile LAS unsigned*)(lds + MISC_OFF) + 8);
#define IN(k) (lo <= (k) && (k) < hi)
#define PHEN(j) (((PHMASK) >> (j)) & 1)
#define SEAM(k) do { if ((k) + 1 < hi) xcd_barrier(bar); } while (0)
    bf16* XB = (bf16*)(ws + WS_XB); bf16* Hb = (bf16*)(ws + WS_H); float* Y = (float*)(ws + WS_Y); float* Pm = (float*)(ws + WS_P); bf16* CAT = (bf16*)(ws + WS_CAT);

    if (PHEN(0) && IN(0)) { phase_prologue(args, bid * NTHR + tid, G * NTHR); SEAM(0); }
    for (int l = 0; l < NLAYER; ++l) {
        const int pb = 1 + 13 * l;
        if (PHEN(1) && IN(pb + 0)) { phase_wconv(args, l, lds, gw, NGW, wave, lane); SEAM(pb + 0); }
        if (PHEN(2) && IN(pb + 1)) {
            pg8::Gemm g{XB, (const bf16*)(ws + WS_WUP1), MTOK, NUP, DM}; pg8::StaticOrder S; S.init(MTOK, NUP, G, bid); pg8::EpiSwiGLU E{Hb, DFF};
            pg8::gemm_phase<pg8::EpiSwiGLU, pg8::StaticOrder, true, true>(lds, g, S, E); SEAM(pb + 1); }
        if (PHEN(3) && IN(pb + 2)) {
            pg8::Gemm g{Hb, (const bf16*)(ws + WS_WDN1), MTOK, DM, DFF}; pg8::StaticOrder S; S.init(MTOK, DM, G, bid); pg8::EpiResid E{l == 0 ? INPTR(args, I_X) : args.out, Y, DM, ALPHA, 0.5f};
            pg8::gemm_phase<pg8::EpiResid, pg8::StaticOrder, true, true>(lds, g, S, E); SEAM(pb + 2); }
        if (PHEN(4) && IN(pb + 3)) { phase_ln(Y, INPTR(args, I_LN1G) + (size_t)l * DM, INPTR(args, I_LN1B) + (size_t)l * DM, args.out, XB, gw, NGW, lane); SEAM(pb + 3); }
        if (PHEN(5) && IN(pb + 4)) {
            pg8::Gemm g{XB, (const bf16*)(ws + WS_WIN), MTOK, INP, DM}; pg8::StaticOrder S; S.init(MTOK, INP, G, bid); pg8::EpiF32 E{Pm, INP};
            pg8::gemm_phase<pg8::EpiF32, pg8::StaticOrder, true, true>(lds, g, S, E); SEAM(pb + 4); }
        if (PHEN(6) && IN(pb + 5)) { phase_m1(args, l, lds, bid, G, tid, wave, lane); SEAM(pb + 5); }
        if (PHEN(7) && IN(pb + 6)) { if (bid < 96) phase_scan(args, lds, bid, tid, wave, lane); phase_nsa(args, l, lds, bid, tid, wave, lane); SEAM(pb + 6); }
        if (PHEN(8) && IN(pb + 7)) { phase_rwkv_out(args, l, gw, NGW, lane); SEAM(pb + 7); }
        if (PHEN(9) && IN(pb + 8)) {
            pg8::Gemm g{CAT, (const bf16*)(ws + WS_WOUT), MTOK, DM, DM}; pg8::StaticOrder S; S.init(MTOK, DM, G, bid); pg8::EpiResid E{args.out, Y, DM, ALPHA, 1.0f};
            pg8::gemm_phase<pg8::EpiResid, pg8::StaticOrder, true, true>(lds, g, S, E); SEAM(pb + 8); }
        if (PHEN(10) && IN(pb + 9)) { phase_ln(Y, INPTR(args, I_LN2G) + (size_t)l * DM, INPTR(args, I_LN2B) + (size_t)l * DM, args.out, XB, gw, NGW, lane); SEAM(pb + 9); }
        if (PHEN(11) && IN(pb + 10)) {
            pg8::Gemm g{XB, (const bf16*)(ws + WS_WUP2), MTOK, NUP, DM}; pg8::StaticOrder S; S.init(MTOK, NUP, G, bid); pg8::EpiSwiGLU E{Hb, DFF};
            pg8::gemm_phase<pg8::EpiSwiGLU, pg8::StaticOrder, true, true>(lds, g, S, E); SEAM(pb + 10); }
        if (PHEN(12) && IN(pb + 11)) {
            pg8::Gemm g{Hb, (const bf16*)(ws + WS_WDN2), MTOK, DM, DFF}; pg8::StaticOrder S; S.init(MTOK, DM, G, bid); pg8::EpiResid E{args.out, Y, DM, ALPHA, 0.5f};
            pg8::gemm_phase<pg8::EpiResid, pg8::StaticOrder, true, true>(lds, g, S, E); SEAM(pb + 11); }
        if (PHEN(13) && IN(pb + 12)) { phase_ln(Y, INPTR(args, I_LN3G) + (size_t)l * DM, INPTR(args, I_LN3B) + (size_t)l * DM, args.out, XB, gw, NGW, lane); SEAM(pb + 12); }
    }
#undef IN
#undef SEAM
}

#ifndef ONE_MASK
#define ONE_MASK 0xFFFFF
#endif
#ifndef MK_ONE_LAUNCH
#define MK_ONE_LAUNCH 1
#endif
typedef void (*kern_t)(Args);
extern "C" void kernel_launch(void* const* d_in, const int* in_sizes, int n_in, void* d_out, int out_size, void* d_ws, size_t ws_size, hipStream_t stream) {
    static int grid = 0;
#if MK_ONE_LAUNCH
    static const kern_t kerns[1] = {fwd<ONE_MASK>};
    constexpr int NK = 1;
#else
    static const kern_t kerns[14] = {fwd<1 << 0>, fwd<1 << 1>, fwd<1 << 2>, fwd<1 << 3>, fwd<1 << 4>, fwd<1 << 5>, fwd<1 << 6>, fwd<1 << 7>, fwd<1 << 8>, fwd<1 << 9>, fwd<1 << 10>, fwd<1 << 11>, fwd<1 << 12>, fwd<1 << 13>};
    constexpr int NK = 14;
#endif
    if (grid == 0) {
        if (n_in != 34 || out_size != MTOK * DM || ws_size < WS_END) { fprintf(stderr, "kernel_launch: unexpected shapes (n_in %d, out %d, ws %zu; need ws >= %zu)\n", n_in, out_size, ws_size, (size_t)WS_END); grid = -1; return; }
        int dev = 0, cus = 0;
        if (hipGetDevice(&dev) != hipSuccess || hipDeviceGetAttribute(&cus, hipDeviceAttributeMultiprocessorCount, dev) != hipSuccess) { grid = -1; return; }
        for (int i = 0; i < NK; ++i) if (hipFuncSetAttribute((const void*)kerns[i], hipFuncAttributeMaxDynamicSharedMemorySize, LDS_BYTES) != hipSuccess) { fprintf(stderr, "kernel_launch: hipFuncSetAttribute failed\n"); grid = -1; return; }
        int per_cu = 0;
        if (hipOccupancyMaxActiveBlocksPerMultiprocessor(&per_cu, (const void*)kerns[0], NTHR, LDS_BYTES) != hipSuccess || per_cu < 1) fprintf(stderr, "kernel_launch: occupancy query says %d blocks per CU\n", per_cu);
        (void)hipGetLastError();
        grid = cus;
    }
    if (grid < 0) return;
    (void)hipMemsetAsync((char*)d_ws + WS_CTL, 0, CTL_ZERO_BYTES, stream);
    Args a{};
    for (int i = 0; i < 34; ++i) a.in[i] = (const float*)d_in[i];
    a.out = (float*)d_out; a.ws = (unsigned char*)d_ws;
#if MK_ONE_LAUNCH
    a.ph_lo = 0; a.ph_hi = NPH;
    hipLaunchKernelGGL(kerns[0], dim3(grid), dim3(NTHR), LDS_BYTES, stream, a);
#else
    for (int k = 0; k < NPH; ++k) { a.ph_lo = k; a.ph_hi = k + 1; const int j = k == 0 ? 0 : (k - 1) % 13 + 1; hipLaunchKernelGGL(kerns[j], dim3(grid), dim3(NTHR), LDS_BYTES, stream, a); }
#endif
}
```

```cpp
#include <hip/hip_runtime.h>
#include <cstdio>
#include <cstdint>
namespace pg8 {
#define PG8_LAS __attribute__((address_space(3)))
typedef unsigned short bf16_t;
typedef short bf16x8 __attribute__((ext_vector_type(8)));
typedef float f32x4 __attribute__((ext_vector_type(4)));
typedef unsigned u32x4 __attribute__((ext_vector_type(4)));
constexpr int BM = 256, BK = 64, HALF = 128, HTB = HALF * BK * 2  , STAGE_BYTES = 8 * HTB, NXCD = 8, WGM = 8;

__host__ __device__ __forceinline__ int lds_byte(int r, int c) { const int st = (r >> 4) * 2 + (c >> 5), rr = r & 15, cc = c & 31, ob = rr * 64 + cc * 2; return st * 1024 + (ob ^ (((ob >> 9) & 1) << 5)); }
__host__ __device__ __forceinline__ void stage_rc(int b, int& R, int& C) { const int st = b / 1024, sb = b % 1024, swz = sb ^ (((sb >> 9) & 1) << 5); R = (st >> 1) * 16 + swz / 64; C = (st & 1) * 32 + (swz % 64) / 2; }
__host__ __device__ __forceinline__ int perm32(int rho) { const int n = rho >> 4, i = rho & 15; return 8 * (i >> 2) + 4 * n + (i & 3); }

struct Unit { int pm, pn; };
struct Gemm { const bf16_t* A; const bf16_t* Bt; int M, N, K; };

struct StaticOrder {
    int nM, nN, nwg, G, c;
    __host__ __device__ void init(int M, int N, int G_, int c_) { nM = M / BM; nN = N / BM; nwg = nM * nN; G = G_; c = c_; }
    __host__ __device__ bool next(int i, Unit& u) const {
        const long L = (long)i * G + c; if (L >= nwg) return false;
        int wgid = (int)L; { const int q = nwg / NXCD, r = nwg % NXCD, xcd = wgid % NXCD, off = wgid / NXCD; wgid = (xcd < r ? xcd * (q + 1) : r * (q + 1) + (xcd - r) * q) + off; }
        const int nig = WGM * nN, gid = wgid / nig, fm = gid * WGM, gsz = (nM - fm) < WGM ? (nM - fm) : WGM;
        u.pm = fm + ((wgid % nig) % gsz); u.pn = (wgid % nig) / gsz; return true;
    }
    __device__ __forceinline__ void a_ready(const Unit&) const {}
    __device__ __forceinline__ void done(const Unit&) const {}
};

__device__ __forceinline__ unsigned cvt_pk_bf16(float lo, float hi) { unsigned r; asm volatile("v_cvt_pk_bf16_f32 %0, %1, %2" : "=v"(r) : "v"(lo), "v"(hi)); return r; }
typedef float f32x2 __attribute__((ext_vector_type(2)));
struct EpiSwiGLU {
    static constexpr bool PERM = true, AFTER_DRAIN = false;
    bf16_t* H; int ldh;
    __device__ __forceinline__ void operator()(const f32x4 (&acc)[2][2][4][2], const Unit& u, int wr, int wc, int fr, int fq) const {
        const int row0 = u.pm * BM + wr * 64 + fr, col0 = u.pn * HALF + wc * 32 + 8 * fq;
#pragma unroll
        for (int ai = 0; ai < 2; ++ai)
#pragma unroll
            for (int m = 0; m < 4; ++m) { bf16_t* rowp = H + (size_t)(row0 + ai * HALF + m * 16) * ldh + col0;
                float hv[8];
#pragma unroll
                for (int n = 0; n < 2; ++n)
#pragma unroll
                    for (int i = 0; i < 4; ++i) { const float a = acc[ai][0][m][n][i], b = acc[ai][1][m][n][i];
                        const float e = __builtin_amdgcn_exp2f(a * -1.44269504089f); hv[n * 4 + i] = a * __builtin_amdgcn_rcpf(1.0f + e) * b; }
                u32x4 w; w.x = cvt_pk_bf16(hv[0], hv[1]); w.y = cvt_pk_bf16(hv[2], hv[3]); w.z = cvt_pk_bf16(hv[4], hv[5]); w.w = cvt_pk_bf16(hv[6], hv[7]);
                *(u32x4*)rowp = w; }
    }
};
struct EpiResid {
    static constexpr bool PERM = false, AFTER_DRAIN = false;
    const float* X; float* Y; int ldc; float alpha, s;
    __device__ __forceinline__ void operator()(const f32x4 (&acc)[2][2][4][2], const Unit& u, int wr, int wc, int fr, int fq) const {
        const int row0 = u.pm * BM + wr * 64 + fr, col0 = u.pn * BM + wc * 32 + 4 * fq;
#pragma unroll
        for (int ai = 0; ai < 2; ++ai)
#pragma unroll
            for (int m = 0; m < 4; ++m) { const size_t off = (size_t)(row0 + ai * HALF + m * 16) * ldc + col0;
#pragma unroll
                for (int bj = 0; bj < 2; ++bj)
#pragma unroll
                    for (int n = 0; n < 2; ++n) { const f32x4 xv = *(const f32x4*)(X + off + bj * HALF + n * 16); *(f32x4*)(Y + off + bj * HALF + n * 16) = xv * alpha + acc[ai][bj][m][n] * s; }
                asm volatile("" ::: "memory"); }
    }
};
struct EpiF32 {
    static constexpr bool PERM = false, AFTER_DRAIN = false;
    float* C; int ldc;
    __device__ __forceinline__ void operator()(const f32x4 (&acc)[2][2][4][2], const Unit& u, int wr, int wc, int fr, int fq) const {
        const int row0 = u.pm * BM + wr * 64 + fr, col0 = u.pn * BM + wc * 32 + 4 * fq;
#pragma unroll
        for (int ai = 0; ai < 2; ++ai)
#pragma unroll
            for (int m = 0; m < 4; ++m) { float* rowp = C + (size_t)(row0 + ai * HALF + m * 16) * ldc + col0;
#pragma unroll
                for (int bj = 0; bj < 2; ++bj)
#pragma unroll
                    for (int n = 0; n < 2; ++n) *(f32x4*)(rowp + bj * HALF + n * 16) = acc[ai][bj][m][n]; }
    }
};

template <class Epi, class Sched, bool ALIGN_EPI = false, bool SP2 = false>
__device__ __forceinline__ void gemm_phase(PG8_LAS unsigned char* lds, const Gemm g, const Sched& S, const Epi& E) {
    int tid_ = threadIdx.x; asm volatile("" : "+v"(tid_));
    const int tid = tid_, wid = __builtin_amdgcn_readfirstlane(tid >> 6), lane = tid & 63, wr = wid >> 2, wc = wid & 3, fr = lane & 15, fq = lane >> 4;
    const int K = g.K, nt = K / BK;
    unsigned voffA[2], voffB[2];
#pragma unroll
    for (int i = 0; i < 2; ++i) { int R, C; stage_rc(tid * 16 + i * 8192, R, C); const int Rb = Epi::PERM ? ((R & ~31) + perm32(R & 31)) : R;
        voffA[i] = (unsigned)(R * K + C) * 2u; voffB[i] = (unsigned)(Rb * K + C) * 2u; }
    const size_t kstep = (size_t)(BK * 2);
    const size_t hstep = (size_t)HALF * K * 2;
    const size_t tstep = 2 * hstep;
    const unsigned ldsw = (unsigned)wid * 1024u;
    const int aoff = lds_byte(wr * 64 + fr, fq * 8), boff = lds_byte(wc * 32 + fr, fq * 8);
#define PG8_SA(b, h) (((b) * 2 + (h)) * HTB)
#define PG8_SB(b, h) ((4 + (b) * 2 + (h)) * HTB)
#define PG8_STAGE(bufoff, gbase, voff) do { _Pragma("unroll") for (int _i = 0; _i < 2; ++_i) \
        __builtin_amdgcn_global_load_lds((const unsigned*)((const char*)(gbase) + (voff)[_i]), (PG8_LAS unsigned*)(lds + (bufoff) + ldsw + _i * 8192), 16, 0, 0); } while (0)
#define PG8_LDA(dst, b, h) do { _Pragma("unroll") for (int m = 0; m < 4; ++m) _Pragma("unroll") for (int k = 0; k < 2; ++k) dst[m][k] = *(const PG8_LAS bf16x8*)(lds + PG8_SA(b, h) + aoff + m * 2048 + k * 1024); } while (0)
#define PG8_LDB(dst, b, h) do { _Pragma("unroll") for (int n = 0; n < 2; ++n) _Pragma("unroll") for (int k = 0; k < 2; ++k) dst[n][k] = *(const PG8_LAS bf16x8*)(lds + PG8_SB(b, h) + boff + n * 2048 + k * 1024); } while (0)
#define PG8_MMA(ai, bj, At, Bt) do { __builtin_amdgcn_s_setprio(1); _Pragma("unroll") for (int m = 0; m < 4; ++m) _Pragma("unroll") for (int n = 0; n < 2; ++n) _Pragma("unroll") for (int k = 0; k < 2; ++k) \
        acc[ai][bj][m][n] = __builtin_amdgcn_mfma_f32_16x16x32_bf16(Bt[n][k], At[m][k], acc[ai][bj][m][n], 0, 0, 0); __builtin_amdgcn_s_setprio(0); } while (0)
#define PG8_WAIT_V(n) asm volatile("s_waitcnt vmcnt(" #n ")" ::: "memory")
#define PG8_WAIT_L(n) asm volatile("s_waitcnt lgkmcnt(" #n ")" ::: "memory")
#define PG8_BAR __builtin_amdgcn_s_barrier()
#define PG8_SCHED __builtin_amdgcn_sched_barrier(0)
    Unit cur, nxt; int ui = 0;
    if (!S.next(0, cur)) return;
    f32x4 acc[2][2][4][2];
#pragma unroll
    for (int a = 0; a < 2; ++a)
#pragma unroll
        for (int b = 0; b < 2; ++b)
#pragma unroll
            for (int m = 0; m < 4; ++m)
#pragma unroll
                for (int n = 0; n < 2; ++n) acc[a][b][m][n] = (f32x4){0.f, 0.f, 0.f, 0.f};
    bf16x8 At[4][2], B0[2][2], B1[2][2];
    const char* cA = (const char*)g.A + (size_t)cur.pm * tstep; const char* cB = (const char*)g.Bt + (size_t)cur.pn * tstep;
    S.a_ready(cur);
    if constexpr (SP2) {
        PG8_STAGE(PG8_SB(0, 0), cB, voffB); PG8_STAGE(PG8_SB(0, 1), cB + hstep, voffB); PG8_STAGE(PG8_SA(0, 0), cA, voffA); PG8_STAGE(PG8_SA(0, 1), cA + hstep, voffA);
        if (wr == 1) PG8_BAR;
        PG8_WAIT_V(2); PG8_BAR;
        PG8_STAGE(PG8_SB(1, 0), cB + kstep, voffB); PG8_STAGE(PG8_SA(1, 0), cA + kstep, voffA); PG8_STAGE(PG8_SB(1, 1), cB + hstep + kstep, voffB);
        PG8_WAIT_V(6); PG8_BAR;
    } else {
        PG8_STAGE(PG8_SB(0, 0), cB, voffB); PG8_STAGE(PG8_SA(0, 0), cA, voffA); PG8_STAGE(PG8_SB(0, 1), cB + hstep, voffB); PG8_STAGE(PG8_SA(0, 1), cA + hstep, voffA);
        if (wr == 1) PG8_BAR;
        PG8_WAIT_V(4); PG8_BAR;
        PG8_STAGE(PG8_SB(1, 0), cB + kstep, voffB); PG8_STAGE(PG8_SA(1, 0), cA + kstep, voffA); PG8_STAGE(PG8_SB(1, 1), cB + hstep + kstep, voffB);
        PG8_WAIT_V(6); PG8_BAR;
    }
    for (;;) {
        const bool has_next = S.next(ui + 1, nxt);
        const char* nA = has_next ? (const char*)g.A + (size_t)nxt.pm * tstep : cA; const char* nB = has_next ? (const char*)g.Bt + (size_t)nxt.pn * tstep : cB;
        for (int t = 0; t < nt; t += 2) {
            const bool last = (t == nt - 2);
            const char* a1 = cA + (size_t)(t + 1) * kstep;
            const char* a2 = last ? nA : cA + (size_t)(t + 2) * kstep; const char* b2 = last ? nB : cB + (size_t)(t + 2) * kstep;
            const char* a3 = a2 + kstep; const char* b3 = b2 + kstep;
            if (last && has_next) S.a_ready(nxt);
            if constexpr (SP2) {
            PG8_LDB(B0, 0, 0); PG8_LDB(B1, 0, 1); PG8_SCHED; PG8_LDA(At, 0, 0); PG8_STAGE(PG8_SA(1, 1), a1 + hstep, voffA);
            PG8_WAIT_V(8); PG8_WAIT_L(0); PG8_BAR; PG8_MMA(0, 0, At, B0); PG8_MMA(0, 1, At, B1); PG8_BAR; PG8_SCHED;
            PG8_LDA(At, 0, 1); PG8_STAGE(PG8_SB(0, 0), b2, voffB); PG8_STAGE(PG8_SB(0, 1), b2 + hstep, voffB); PG8_STAGE(PG8_SA(0, 0), a2, voffA);
            PG8_WAIT_V(8); PG8_WAIT_L(0); PG8_BAR; PG8_MMA(1, 0, At, B0); PG8_MMA(1, 1, At, B1); PG8_BAR; PG8_SCHED;
            PG8_LDB(B0, 1, 0); PG8_LDB(B1, 1, 1); PG8_SCHED; PG8_LDA(At, 1, 0); PG8_STAGE(PG8_SA(0, 1), a2 + hstep, voffA);
            PG8_WAIT_V(8); PG8_WAIT_L(0); PG8_BAR; PG8_MMA(0, 0, At, B0); PG8_MMA(0, 1, At, B1); PG8_BAR; PG8_SCHED;
            PG8_LDA(At, 1, 1); PG8_STAGE(PG8_SB(1, 0), b3, voffB); PG8_STAGE(PG8_SB(1, 1), b3 + hstep, voffB); PG8_STAGE(PG8_SA(1, 0), a3, voffA);
            PG8_WAIT_V(8); PG8_WAIT_L(0); PG8_BAR; PG8_MMA(1, 0, At, B0); PG8_MMA(1, 1, At, B1); PG8_BAR; PG8_SCHED;
            } else {
            PG8_LDB(B0, 0, 0); PG8_SCHED; PG8_LDA(At, 0, 0); PG8_STAGE(PG8_SA(1, 1), a1 + hstep, voffA);
            PG8_WAIT_L(8); PG8_BAR; PG8_WAIT_L(0); PG8_MMA(0, 0, At, B0); PG8_BAR; PG8_SCHED;
            PG8_LDB(B1, 0, 1); PG8_STAGE(PG8_SB(0, 0), b2, voffB);
            PG8_BAR; PG8_WAIT_L(0); PG8_MMA(0, 1, At, B1); PG8_BAR;
            PG8_LDA(At, 0, 1); PG8_STAGE(PG8_SA(0, 0), a2, voffA);
            PG8_BAR; PG8_WAIT_L(0); PG8_MMA(1, 0, At, B0); PG8_BAR; PG8_SCHED;
            PG8_STAGE(PG8_SB(0, 1), b2 + hstep, voffB);
            PG8_WAIT_V(6); PG8_BAR; PG8_MMA(1, 1, At, B1); PG8_BAR;
            PG8_LDB(B0, 1, 0); PG8_SCHED; PG8_LDA(At, 1, 0); PG8_STAGE(PG8_SA(0, 1), a2 + hstep, voffA);
            PG8_WAIT_L(8); PG8_BAR; PG8_WAIT_L(0); PG8_MMA(0, 0, At, B0); PG8_BAR; PG8_SCHED;
            PG8_LDB(B1, 1, 1); PG8_STAGE(PG8_SB(1, 0), b3, voffB);
            PG8_BAR; PG8_WAIT_L(0); PG8_MMA(0, 1, At, B1); PG8_BAR;
            PG8_LDA(At, 1, 1); PG8_STAGE(PG8_SA(1, 0), a3, voffA);
            PG8_BAR; PG8_WAIT_L(0); PG8_MMA(1, 0, At, B0); PG8_BAR; PG8_SCHED;
            PG8_STAGE(PG8_SB(1, 1), b3 + hstep, voffB);
            PG8_WAIT_V(6); PG8_BAR; PG8_MMA(1, 1, At, B1); PG8_BAR;
            }
        }
        if constexpr (ALIGN_EPI) { if (wr == 0) PG8_BAR; }
        if constexpr (!Epi::AFTER_DRAIN) { E(acc, cur, wr, wc, fr, fq); S.done(cur); }
        if (!has_next) break;
#pragma unroll
        for (int a = 0; a < 2; ++a)
#pragma unroll
            for (int b = 0; b < 2; ++b)
#pragma unroll
                for (int m = 0; m < 4; ++m)
#pragma unroll
                    for (int n = 0; n < 2; ++n) acc[a][b][m][n] = (f32x4){0.f, 0.f, 0.f, 0.f};
        cur = nxt; cA = nA; cB = nB; ++ui;
        if constexpr (ALIGN_EPI) { if (wr == 1) PG8_BAR; }
    }
    PG8_WAIT_V(0);
    if constexpr (!ALIGN_EPI) { if (wr == 0) PG8_BAR; }
    PG8_BAR;
    if constexpr (Epi::AFTER_DRAIN) { E.fused(acc, cur, wr, wc, fr, fq, lds, wid, lane); S.done(cur); }
#undef PG8_SA
#undef PG8_SB
#undef PG8_STAGE
#undef PG8_LDA
#undef PG8_LDB
#undef PG8_MMA
#undef PG8_WAIT_V
#undef PG8_WAIT_L
#undef PG8_BAR
#undef PG8_SCHED
}
}

constexpr int NWAVES = 8, NTHR = 512;
constexpr int NB = 4, SEQ = 4096, DM = 2048, MTOK = NB * SEQ, NLAYER = 4;
constexpr int DFF = 5504, NUP = 2 * DFF;
constexpr int INC = 5028, INP = 5120;
constexpr int DRW = 768, RWC = 2560, PO_POOL = 2560, DPOOL = 512, PO_NSA = 3072;
constexpr int PO_Q = PO_NSA, PO_KC = PO_NSA + 768, PO_VC = PO_KC + 192, PO_KS = PO_VC + 192, PO_VS = PO_KS + 192, PO_KW = PO_VS + 192, PO_VW = PO_KW + 192, PO_GL = PO_VW + 192;
static_assert(PO_GL + 36 == INC, "W_in column map");
constexpr int NCMP = 255, NCMPP = 256;
constexpr float ALPHA = 1.6817928305074290f;
constexpr float LN_EPS = 1e-5f, GN_EPS = 64e-5f;
constexpr int NPH = 1 + 13 * NLAYER;

constexpr size_t MiB = 1u << 20;
constexpr size_t WS_CTL = 0, CTL_ZERO_BYTES = 1 * MiB;
constexpr size_t WS_ROPE = 1 * MiB;
constexpr size_t WS_KC = 2 * MiB, WS_VC = 2 * MiB + 512 * 1024;
constexpr size_t WS_SC = 3 * MiB;
constexpr size_t WS_WUP1 = 8 * MiB, WS_WDN1 = 51 * MiB, WS_WIN = WS_WDN1 + 21 * MiB + 512 * 1024, WS_WOUT = WS_WIN + 20 * MiB, WS_WUP2 = WS_WOUT + 8 * MiB, WS_WDN2 = WS_WUP2 + 43 * MiB;
constexpr size_t WS_XB = 165 * MiB;
static_assert(WS_WDN2 + (size_t)DM * DFF * 2 <= WS_XB, "weights map");
constexpr size_t WS_CAT = 229 * MiB;
constexpr size_t WS_QR = 293 * MiB;
constexpr size_t WS_KS = 317 * MiB, WS_KW = 323 * MiB, WS_VS = 329 * MiB, WS_VW = 335 * MiB;
constexpr size_t WS_P = 341 * MiB;
constexpr size_t WS_H = 661 * MiB;
constexpr size_t WS_Y = 833 * MiB;
constexpr size_t WS_SV = WS_H;
constexpr size_t SV_STRIDE = 48 * MiB;
static_assert(WS_SV + 6 * SV_STRIDE <= WS_Y + 128 * MiB, "scan overlay");
constexpr size_t WS_G = 961 * MiB, WS_YS = 1009 * MiB;
constexpr size_t WS_VST = 1057 * MiB, WS_VWT = 1063 * MiB;
constexpr size_t WS_VCT = 6 * MiB;
constexpr size_t WS_SW = 1069 * MiB;
constexpr size_t WS_W2T = WS_SW, WS_A2T = WS_W2T + 768 * 64 * 2, WS_G2T = WS_A2T + 768 * 64 * 2, WS_PWT = WS_G2T + 768 * 128 * 2;
constexpr size_t WS_W1T = WS_PWT + 4 * 128 * 128 * 2, WS_W2CT = WS_W1T + 2 * 256 * 2048 * 2, WS_CBIAS = WS_W2CT + 2 * 64 * 256 * 2;
constexpr size_t WS_END = 1073 * MiB;
static_assert(WS_CBIAS + 2 * 256 * 4 <= WS_END, "small weights map");

constexpr int LDS_BYTES = 147456, MISC_OFF = 131072 + 320;

#define GAS __attribute__((address_space(1)))
#define LAS __attribute__((address_space(3)))
typedef unsigned short bf16;
typedef float f32x4 __attribute__((ext_vector_type(4)));
typedef float f32x2 __attribute__((ext_vector_type(2)));
typedef unsigned u32x4 __attribute__((ext_vector_type(4)));
typedef unsigned u32x2 __attribute__((ext_vector_type(2)));
#define LDS_WAIT() asm volatile("s_waitcnt lgkmcnt(0)" ::: "memory")
__device__ __forceinline__ unsigned f2bf(float f) { unsigned u = __builtin_bit_cast(unsigned, f); return (u + 0x7fffu + ((u >> 16) & 1u)) >> 16; }
__device__ __forceinline__ unsigned pk2(float lo, float hi) { return f2bf(lo) | (f2bf(hi) << 16); }
__device__ __forceinline__ float bf2f(unsigned short b) { return __builtin_bit_cast(float, ((unsigned)b) << 16); }
__device__ __forceinline__ float wave_sum(float v) {
#pragma unroll
    for (int o = 1; o < 64; o <<= 1) v += __shfl_xor(v, o);
    return v;
}
__device__ __forceinline__ float wave_max(float v) {
#pragma unroll
    for (int o = 1; o < 64; o <<= 1) v = fmaxf(v, __shfl_xor(v, o));
    return v;
}
__device__ __forceinline__ float sigmoidf_(float x) { return 1.0f / (1.0f + expf(-x)); }
template <int CTRL> __device__ __forceinline__ float dpp_f(float v) { return __builtin_bit_cast(float, __builtin_amdgcn_update_dpp(0, __builtin_bit_cast(int, v), CTRL, 0xF, 0xF, true)); }
__device__ __forceinline__ float row16_sum(float v) {
    v += dpp_f<0xB1>(v); v += dpp_f<0x4E>(v); v += dpp_f<0x141>(v); v += dpp_f<0x140>(v); return v;
}

#define XB_TMO      128
#define XB_XCNT(j)  (256  + 64 * (j))
#define XB_XSUB(j)  (1280 + 64 * (j))
#define XB_XGEN(j)  (2304 + 64 * (j))
#define XB_TOP      3328
#define XB_TOPGEN   3392
#define XCD_BAR_WORDS 3456
#define XB_SPIN_CAP (1u << 18)

__device__ __forceinline__ unsigned xb_ld(unsigned* p)              { return __hip_atomic_load(p, __ATOMIC_RELAXED, __HIP_MEMORY_SCOPE_AGENT); }
__device__ __forceinline__ unsigned xb_add(unsigned* p, unsigned v) { return __hip_atomic_fetch_add(p, v, __ATOMIC_RELAXED, __HIP_MEMORY_SCOPE_AGENT); }
__device__ __forceinline__ unsigned xb_xcc_id() { return (unsigned)__builtin_amdgcn_s_getreg((3 << 11) | 20) & 0xFu; }
#define XB_SPIN(cond, bar) do { unsigned _sp = 0; while (cond) { __builtin_amdgcn_s_sleep(1); \
    if ((++_sp & 255u) == 0u) { if (xb_ld(&(bar)[XB_TMO])) break; if (_sp > XB_SPIN_CAP) { atomicAdd(&(bar)[XB_TMO], 1u); break; } } } } while (0)

struct XcdBarrier {
    unsigned* bar; unsigned x;
    volatile LAS unsigned* st;
};

__device__ __forceinline__ XcdBarrier xcd_barrier_post(unsigned* bar, volatile LAS unsigned* st) {
    XcdBarrier b; b.bar = bar; b.x = xb_xcc_id(); b.st = st;
    if (threadIdx.x == 0) (void)xb_add(&bar[XB_XCNT(b.x)], 1u);
    return b;
}
__device__ __forceinline__ void xcd_barrier_complete(unsigned* bar, unsigned x, unsigned& nloc, unsigned& nx) {
    const unsigned G = gridDim.x * gridDim.y * gridDim.z;
    unsigned sum, cnt, mine, sp = 0u;
    for (;;) {
        sum = 0u; cnt = 0u; mine = 0u;
#pragma unroll
        for (unsigned j = 0; j < 16; ++j) { const unsigned c = xb_ld(&bar[XB_XCNT(j)]); sum += c; cnt += (c > 0u) ? 1u : 0u; mine = (j == x) ? c : mine; }
        if (sum == G) break;
        __builtin_amdgcn_s_sleep(1);
        if ((++sp & 255u) == 0u) { if (xb_ld(&bar[XB_TMO])) break; if (sp > XB_SPIN_CAP) { atomicAdd(&bar[XB_TMO], 1u); break; } }
    }
    nloc = mine > 0u ? mine : 1u; nx = cnt > 0u ? cnt : 1u;
}

__device__ __forceinline__ void xcd_barrier(const XcdBarrier& b) {
    asm volatile("s_waitcnt vmcnt(0)" ::: "memory");
    __syncthreads();
    if (threadIdx.x == 0) {
        unsigned* bar = b.bar;
        __builtin_amdgcn_s_waitcnt(0);
        unsigned nloc = b.st[0], nx = b.st[1];
        if (nloc == 0u) { xcd_barrier_complete(bar, b.x, nloc, nx); b.st[0] = nloc; b.st[1] = nx; }
        const unsigned old = xb_add(&bar[XB_XSUB(b.x)], 1u);
        const unsigned gen = old / nloc;
        if (old + 1u == (gen + 1u) * nloc) {
            __builtin_amdgcn_fence(__ATOMIC_RELEASE, "agent");
            asm volatile("s_waitcnt vmcnt(0)" ::: "memory");
            const unsigned og = xb_add(&bar[XB_TOP], 1u);
            const unsigned tg = og / nx;
            if (og + 1u == (tg + 1u) * nx) xb_add(&bar[XB_TOPGEN], 1u);
            else XB_SPIN(xb_ld(&bar[XB_TOPGEN]) == tg, bar);
            __builtin_amdgcn_fence(__ATOMIC_ACQUIRE, "agent");
            xb_add(&bar[XB_XGEN(b.x)], 1u);
            asm volatile("s_waitcnt vmcnt(0)" ::: "memory");
        } else {
            XB_SPIN(xb_ld(&bar[XB_XGEN(b.x)]) == gen, bar);
            __builtin_amdgcn_fence(__ATOMIC_ACQUIRE, "agent");
            asm volatile("s_waitcnt vmcnt(0)" ::: "memory");
        }
    }
    __syncthreads();
}

struct Args { const float* in[34]; float* out; unsigned char* ws; int ph_lo, ph_hi; };
__device__ __forceinline__ int opaque0() { int z = 0; asm volatile("" : "+s"(z)); return z; }
#define OPQ_S(x) asm volatile("" : "+s"(x))
#define OPQ_SI(x) do { (x) = __builtin_amdgcn_readfirstlane(x); asm volatile("" : "+s"(x)); } while (0)
#define OPQ_V(x) asm volatile("" : "+v"(x))
#define INPTR(a, idx) ((a).in[(idx) + opaque0()])
enum { I_X = 0, I_UP1, I_DN1, I_LN1G, I_LN1B, I_WIN, I_MU, I_W0, I_W2, I_A0, I_A2, I_G2, I_KK, I_KA, I_RK, I_GNG, I_GNB, I_PW, I_PB, I_PS, I_PEK, I_PEV, I_CK1, I_CK2, I_CV1, I_CV2, I_GB, I_WOUT, I_LN2G, I_LN2B, I_UP2, I_DN2, I_LN3G, I_LN3B };

__device__ __forceinline__ void transpose_item(const float* W, int K, int Nsrc, bf16* WT, int dst0, LAS float* scr, int k0, int n0, int lane) {
    const int n = n0 + (lane & 31); const bool ok = n < Nsrc;
#pragma unroll 8
    for (int i = 0; i < 32; ++i) { const int kk = 2 * i + (lane >> 5); scr[kk * 33 + (lane & 31)] = ok ? W[(size_t)(k0 + kk) * Nsrc + n] : 0.f; }
    LDS_WAIT();
    const int c = lane & 7;
#pragma unroll
    for (int j = 0; j < 4; ++j) { const int nn = (lane >> 3) + 8 * j; const LAS float* s = scr + (8 * c) * 33 + nn;
        u32x4 o; o.x = pk2(s[0 * 33], s[1 * 33]); o.y = pk2(s[2 * 33], s[3 * 33]); o.z = pk2(s[4 * 33], s[5 * 33]); o.w = pk2(s[6 * 33], s[7 * 33]);
        *(u32x4*)(WT + (size_t)(dst0 + nn) * K + k0 + 8 * c) = o; }
    LDS_WAIT();
}
__device__ __forceinline__ int up_dst_row(int n0) { return n0 < DFF ? 256 * (n0 / 128) + (n0 % 128) : 256 * ((n0 - DFF) / 128) + 128 + ((n0 - DFF) % 128); }

__device__ __forceinline__ void phase_wconv(const Args& a, int l, LAS unsigned char* lds, int gw, int NGW, int wave, int lane) {
    OPQ_SI(gw); OPQ_SI(wave); OPQ_V(lane);
    LAS float* scr = (LAS float*)(lds + wave * 16384);
    unsigned char* ws = a.ws + opaque0();
    constexpr int I_UP = (DM / 64) * (NUP / 32), I_DN = (DFF / 64) * (DM / 32), I_IN = (DM / 64) * (INP / 32), I_OUT = (DM / 64) * (DM / 32);
    constexpr int NIT = 2 * I_UP + 2 * I_DN + I_IN + I_OUT + 24 + 24 + 48 + 32 + 512 + 16;
    for (int it = gw; it < NIT; it += NGW) {
        int r = it;
        if (r < 2 * I_UP) { const int which = r / I_UP; r -= which * I_UP; const int nblk = NUP / 32, kb = r / nblk, nb = r % nblk;
            const float* W = a.in[which ? I_UP2 : I_UP1] + (size_t)l * DM * NUP; bf16* WT = (bf16*)(ws + (which ? WS_WUP2 : WS_WUP1));
            transpose_item(W, DM, NUP, WT, up_dst_row(32 * nb), scr, 64 * kb, 32 * nb, lane); continue; }
        r -= 2 * I_UP;
        if (r < 2 * I_DN) { const int which = r / I_DN; r -= which * I_DN; const int nblk = DM / 32, kb = r / nblk, nb = r % nblk;
            const float* W = a.in[which ? I_DN2 : I_DN1] + (size_t)l * DFF * DM; bf16* WT = (bf16*)(ws + (which ? WS_WDN2 : WS_WDN1));
            transpose_item(W, DFF, DM, WT, 32 * nb, scr, 64 * kb, 32 * nb, lane); continue; }
        r -= 2 * I_DN;
        if (r < I_IN) { const int nblk = INP / 32, kb = r / nblk, nb = r % nblk;
            transpose_item(INPTR(a, I_WIN) + (size_t)l * DM * INC, DM, INC, (bf16*)(ws + WS_WIN), 32 * nb, scr, 64 * kb, 32 * nb, lane); continue; }
        r -= I_IN;
        if (r < I_OUT) { const int nblk = DM / 32, kb = r / nblk, nb = r % nblk;
            transpose_item(INPTR(a, I_WOUT) + (size_t)l * DM * DM, DM, DM, (bf16*)(ws + WS_WOUT), 32 * nb, scr, 64 * kb, 32 * nb, lane); continue; }
        r -= I_OUT;
        if (r < 24) { transpose_item(INPTR(a, I_W2) + (size_t)l * 64 * DRW, 64, DRW, (bf16*)(ws + WS_W2T), 32 * r, scr, 0, 32 * r, lane); continue; } r -= 24;
        if (r < 24) { transpose_item(INPTR(a, I_A2) + (size_t)l * 64 * DRW, 64, DRW, (bf16*)(ws + WS_A2T), 32 * r, scr, 0, 32 * r, lane); continue; } r -= 24;
        if (r < 48) { const int kb = r / 24, nb = r % 24; transpose_item(INPTR(a, I_G2) + (size_t)l * 128 * DRW, 128, DRW, (bf16*)(ws + WS_G2T), 32 * nb, scr, 64 * kb, 32 * nb, lane); continue; } r -= 48;
        if (r < 32) { const int gi = r >> 3, q = r & 7, kb = q >> 2, nb = q & 3; transpose_item(INPTR(a, I_PW) + ((size_t)l * 4 + gi) * 128 * 128, 128, 128, (bf16*)(ws + WS_PWT) + gi * 128 * 128, 32 * nb, scr, 64 * kb, 32 * nb, lane); continue; } r -= 32;
        if (r < 512) { const int ten = r >> 8, q = r & 255, kb = q >> 3, nb = q & 7; transpose_item(INPTR(a, ten ? I_CV1 : I_CK1) + (size_t)l * 2048 * 256, 2048, 256, (bf16*)(ws + WS_W1T) + (size_t)ten * 256 * 2048, 32 * nb, scr, 64 * kb, 32 * nb, lane); continue; } r -= 512;
        { const int ten = r >> 3, q = r & 7, kb = q >> 1, nb = q & 1; transpose_item(INPTR(a, ten ? I_CV2 : I_CK2) + (size_t)l * 256 * 64, 256, 64, (bf16*)(ws + WS_W2CT) + (size_t)ten * 64 * 256, 32 * nb, scr, 64 * kb, 32 * nb, lane); }
    }
    if (gw / NWAVES == NGW / NWAVES - 1) { const int tid2 = wave * 64 + lane, ten = tid2 >> 8, f = tid2 & 255;
        const float* pe = INPTR(a, ten ? I_PEV : I_PEK) + (size_t)l * 2048; const float* w1 = INPTR(a, ten ? I_CV1 : I_CK1) + (size_t)l * 2048 * 256 + f; float acc = 0.f;
        for (int k = 0; k < 2048; ++k) acc = fmaf(pe[k], w1[(size_t)k * 256], acc);
        ((float*)(ws + WS_CBIAS))[ten * 256 + f] = acc; }
}

__device__ __forceinline__ void phase_prologue(const Args& a, int gtid, int NGT) {
    OPQ_V(gtid);
    const f32x4* x4 = (const f32x4*)INPTR(a, I_X); u32x2* xb = (u32x2*)(a.ws + WS_XB);
    for (size_t i = gtid; i < (size_t)MTOK * DM / 4; i += NGT) { const f32x4 v = x4[i]; u32x2 o; o.x = pk2(v.x, v.y); o.y = pk2(v.z, v.w); xb[i] = o; }
    f32x2* rope = (f32x2*)(a.ws + WS_ROPE);
    for (int i = gtid; i < SEQ * 8; i += NGT) { const int s = i >> 3, k = i & 7;
        const float inv = powf(500000.0f, -(float)k * 0.125f); const float ang = (float)s * inv;
        const double ad = (double)ang; const double q = __builtin_rint(ad * 0.15915494309189535); const double rr = ad - q * 6.283185307179586;
        const float rf = (float)rr; rope[i] = (f32x2){cosf(rf), sinf(rf)}; }
}

__device__ __forceinline__ void phase_ln(const float* Y, const float* g, const float* b, float* X, bf16* XB, int gw, int NGW, int lane) {
    OPQ_SI(gw); OPQ_V(lane);
    f32x4 gv[8], bv[8];
#pragma unroll
    for (int j = 0; j < 8; ++j) { gv[j] = ((const f32x4*)g)[64 * j + lane]; bv[j] = ((const f32x4*)b)[64 * j + lane]; }
    for (int m = gw; m < MTOK; m += NGW) {
        const f32x4* yr = (const f32x4*)(Y + (size_t)m * DM) + lane; f32x4 v[8]; float s = 0.f;
#pragma unroll
        for (int j = 0; j < 8; ++j) { v[j] = yr[64 * j]; s += (v[j].x + v[j].y) + (v[j].z + v[j].w); }
        const float mean = wave_sum(s) * (1.f / DM); float s2 = 0.f;
#pragma unroll
        for (int j = 0; j < 8; ++j) { v[j] = v[j] - mean; s2 += (v[j].x * v[j].x + v[j].y * v[j].y) + (v[j].z * v[j].z + v[j].w * v[j].w); }
        const float rstd = 1.f / sqrtf(wave_sum(s2) * (1.f / DM) + LN_EPS);
        f32x4* xr = (f32x4*)(X + (size_t)m * DM) + lane; u32x2* xb = (u32x2*)(XB + (size_t)m * DM) + lane;
#pragma unroll
        for (int j = 0; j < 8; ++j) { const f32x4 o = v[j] * rstd * gv[j] + bv[j]; xr[64 * j] = o; u32x2 w; w.x = pk2(o.x, o.y); w.y = pk2(o.z, o.w); xb[64 * j] = w; }
    }
}


typedef float f32x16 __attribute__((ext_vector_type(16)));
typedef short bf16x8 __attribute__((ext_vector_type(8)));
#define MFMA32(a, b, c) __builtin_amdgcn_mfma_f32_32x32x16_bf16((a), (b), (c), 0, 0, 0)
#define WSYNC() asm volatile("s_waitcnt lgkmcnt(0)" ::: "memory")
__device__ __forceinline__ void half_swap(float x, float& lo, float& hi) { float a = x, b = x; asm volatile("s_nop 1\n\tv_permlane32_swap_b32 %0, %1" : "+v"(a), "+v"(b)); lo = a; hi = b; }
__device__ __forceinline__ float half_max(float x) { float lo, hi; half_swap(x, lo, hi); return fmaxf(lo, hi); }
__device__ __forceinline__ float half_sum(float x) { float lo, hi; half_swap(x, lo, hi); return lo + hi; }
__device__ __forceinline__ float other_half(float x, int h) { float lo, hi; half_swap(x, lo, hi); return h ? lo : hi; }
__device__ __forceinline__ unsigned cvtpk(float lo, float hi) { unsigned r; asm volatile("v_cvt_pk_bf16_f32 %0, %1, %2" : "=v"(r) : "v"(lo), "v"(hi)); return r; }
__device__ __forceinline__ float half32_sum(float v) { v = row16_sum(v); float a = v, b = v; asm volatile("s_nop 1\n\tv_permlane16_swap_b32 %0, %1" : "+v"(a), "+v"(b)); return a + b; }
__device__ __forceinline__ int vt_pos(int k) { return 16 * ((k >> 2) & 1) + 8 * (k >> 4) + 4 * ((k >> 3) & 1) + (k & 3); }

constexpr int XP = 264, ZP = 520, HP = 264;
__device__ __forceinline__ bf16x8 lds_frag(const LAS bf16* p) { return *(const LAS bf16x8*)p; }
__device__ __forceinline__ bf16x8 cvt8(const f32x4 a, const f32x4 b) { u32x4 w; w.x = cvtpk(a.x, a.y); w.y = cvtpk(a.z, a.w); w.z = cvtpk(b.x, b.y); w.w = cvtpk(b.z, b.w); return __builtin_bit_cast(bf16x8, w); }
__device__ __forceinline__ void phase_m1(const Args& a, int l, LAS unsigned char* lds, int bid, int G, int tid, int wave, int lane) {
    OPQ_SI(bid); OPQ_V(tid); OPQ_SI(wave); lane = tid & 63;
    unsigned char* ws = a.ws + opaque0(); const float* P = (const float*)(ws + WS_P);
    const int r = lane & 31, h = lane >> 5;
    const f32x2* rope = (const f32x2*)(ws + WS_ROPE);
    for (int unit = bid; unit < MTOK / 64; unit += G) {
        const int t0 = unit * 64, b = t0 >> 12, s0 = t0 & (SEQ - 1);
        LAS bf16* XL = (LAS bf16*)lds;
        LAS bf16* ZL = (LAS bf16*)(lds + 64 * XP * 2);
        { const float* mu = INPTR(a, I_MU) + (size_t)l * RWC;
            for (int i = tid; i < 64 * 256; i += NTHR) { const int tt = i >> 8, j = i & 255, col = 2304 + j; const int m = t0 + tt;
                const float pc = P[(size_t)m * INP + col]; const float pp = (s0 + tt) > 0 ? P[(size_t)(m - 1) * INP + col] : 0.f; const float v = pc + (pp - pc) * mu[col];
                const float f = j < 64 ? tanhf(v) : (j < 128 ? v : sigmoidf_(v)); XL[tt * XP + j] = (bf16)f2bf(f); }
            for (int i = tid; i < 64 * DPOOL; i += NTHR) { const int tt = i >> 9, ch = i & 511, gi = ch >> 7; const int m = t0 + tt, s = s0 + tt; const int win = 2 << gi; const int cnt = (s + 1) < win ? (s + 1) : win;
                float sum = 0.f; for (int j = 0; j < cnt; ++j) sum += P[(size_t)(m - j) * INP + PO_POOL + ch];
                ZL[tt * ZP + ch] = (bf16)f2bf(sum / (float)cnt - P[(size_t)m * INP + PO_POOL + ch]); } }
        __syncthreads();
        {
            const float* mu = INPTR(a, I_MU) + (size_t)l * RWC; const float* w0 = INPTR(a, I_W0) + (size_t)l * DRW; const float* a0 = INPTR(a, I_A0) + (size_t)l * DRW;
            const float* k_k = INPTR(a, I_KK) + (size_t)l * DRW; const float* k_a = INPTR(a, I_KA) + (size_t)l * DRW; const float* r_k = INPTR(a, I_RK) + (size_t)l * DRW;
            const bf16* W2T = (const bf16*)(ws + WS_W2T); const bf16* A2T = (const bf16*)(ws + WS_A2T); const bf16* G2T = (const bf16*)(ws + WS_G2T);
            float* vKK = (float*)(ws + WS_SV); float* vWR = (float*)(ws + WS_SV + SV_STRIDE); float* vW = (float*)(ws + WS_SV + 2 * SV_STRIDE);
            float* vKM = (float*)(ws + WS_SV + 3 * SV_STRIDE); float* vBB = (float*)(ws + WS_SV + 4 * SV_STRIDE); float* vV = (float*)(ws + WS_SV + 5 * SV_STRIDE);
            float* vG = (float*)(ws + WS_G); float* SC = (float*)(ws + WS_SC);
#pragma unroll 1
            for (int jj = 0; jj < 3; ++jj) {
                const int job = wave + 8 * jj, hd = job >> 1, th = job & 1;
                f32x16 aU[2], aA[2];
#pragma unroll
                for (int t = 0; t < 2; ++t)
#pragma unroll
                    for (int i = 0; i < 16; ++i) { aU[t][i] = 0.f; aA[t][i] = 0.f; }
                const LAS bf16* xa = XL + (32 * th + r) * XP + 8 * h;
#pragma unroll
                for (int ks = 0; ks < 4; ++ks) { const bf16x8 xt = lds_frag(xa + 16 * ks), xl = lds_frag(xa + 64 + 16 * ks);
#pragma unroll
                    for (int t = 0; t < 2; ++t) { const int c = hd * 64 + 32 * t + r;
                        aU[t] = MFMA32(xt, *(const bf16x8*)(W2T + (size_t)c * 64 + 16 * ks + 8 * h), aU[t]);
                        aA[t] = MFMA32(xl, *(const bf16x8*)(A2T + (size_t)c * 64 + 16 * ks + 8 * h), aA[t]); } }
                float pmr[2], pmk[2], pmv[2], pw0[2], pa0[2], pkk[2], pka[2], prk[2];
#pragma unroll
                for (int t = 0; t < 2; ++t) { const int c = hd * 64 + 32 * t + r; pmr[t] = mu[c]; pmk[t] = mu[768 + c]; pmv[t] = mu[1536 + c]; pw0[t] = w0[c]; pa0[t] = a0[c]; pkk[t] = k_k[c]; pka[t] = k_a[c]; prk[t] = r_k[c]; }
                const int lo_p = 4 * h * INP + hd * 64 + r, lo_s = 4 * h * DRW + hd * 64 + r;
#pragma unroll
                for (int i = 0; i < 16; ++i) {
                    int mrow = t0 + 32 * th + (i & 3) + 8 * (i >> 2); OPQ_SI(mrow);
                    const bool first = (s0 + 32 * th + (i & 3) + 8 * (i >> 2) + 4 * h) == 0;
                    const float* pc = P + (size_t)mrow * INP; const float* pp = pc - INP;
                    float rr[2], kv[2], vv[2], dec[2], av[2], kr[2], km[2];
                    float ss = 0.f, s1 = 0.f, s2 = 0.f, s3 = 0.f;
#pragma unroll
                    for (int t = 0; t < 2; ++t) { const int o = lo_p + 32 * t;
                        const float rc = pc[o], kc = pc[o + 768], vc = pc[o + 1536]; const float rp = first ? 0.f : pp[o], kp = first ? 0.f : pp[o + 768], vp = first ? 0.f : pp[o + 1536];
                        rr[t] = rc + (rp - rc) * pmr[t]; kv[t] = kc + (kp - kc) * pmk[t]; vv[t] = vc + (vp - vc) * pmv[t];
                        const float uu = pw0[t] + aU[t][i]; const float z = -uu; const float sp = z > 20.f ? z : log1pf(expf(z)); dec[t] = expf(-expf(-sp - 0.5f));
                        av[t] = sigmoidf_(pa0[t] + aA[t][i]);
                        kr[t] = kv[t] * pkk[t]; km[t] = kv[t] * (1.0f + (av[t] - 1.0f) * pka[t]);
                        ss += kr[t] * kr[t]; s1 += kr[t] * av[t] * rr[t]; s2 += km[t] * rr[t]; s3 += rr[t] * km[t] * prk[t]; }
                    ss = half32_sum(ss); s1 = half32_sum(s1); s2 = half32_sum(s2); s3 = half32_sum(s3);
                    const float invn = 1.0f / fmaxf(sqrtf(ss), 1e-12f);
                    const size_t ro = (size_t)mrow * DRW;
#pragma unroll
                    for (int t = 0; t < 2; ++t) { const int o = lo_s + 32 * t; const float kk = kr[t] * invn;
                        (vKK + ro)[o] = kk; (vWR + ro)[o] = dec[t] * rr[t]; (vW + ro)[o] = dec[t]; (vKM + ro)[o] = km[t]; (vBB + ro)[o] = kk * av[t]; (vV + ro)[o] = vv[t]; }
                    if (r == 0) *(f32x4*)(SC + ((size_t)mrow * 12 + hd) * 4 + 4 * h * 48) = (f32x4){s1 * invn, s2, s3, 0.f};
                    asm volatile("" ::: "memory");
                }
                { f32x16 aG[2];
#pragma unroll
                    for (int t = 0; t < 2; ++t)
#pragma unroll
                        for (int i = 0; i < 16; ++i) aG[t][i] = 0.f;
#pragma unroll
                    for (int ks = 0; ks < 8; ++ks) { const bf16x8 xg = lds_frag(xa + 128 + 16 * ks);
#pragma unroll
                        for (int t = 0; t < 2; ++t) { const int c = hd * 64 + 32 * t + r; aG[t] = MFMA32(xg, *(const bf16x8*)(G2T + (size_t)c * 128 + 16 * ks + 8 * h), aG[t]); } }
#pragma unroll
                    for (int i = 0; i < 16; ++i) { int mrow = t0 + 32 * th + (i & 3) + 8 * (i >> 2); OPQ_SI(mrow); float* gp = vG + (size_t)mrow * DRW;
#pragma unroll
                        for (int t = 0; t < 2; ++t) gp[lo_s + 32 * t] = aG[t][i]; } }
            }
        }
        {
            const int gi = wave >> 1, th = wave & 1; const bf16* PWT = (const bf16*)(ws + WS_PWT) + gi * 128 * 128;
            const float* pb = INPTR(a, I_PB) + (size_t)l * DPOOL + gi * 128; const float* psc = INPTR(a, I_PS) + (size_t)l * DPOOL + gi * 128; bf16* CAT = (bf16*)(ws + WS_CAT);
            f32x16 acc[4];
#pragma unroll
            for (int t = 0; t < 4; ++t)
#pragma unroll
                for (int i = 0; i < 16; ++i) acc[t][i] = 0.f;
            const LAS bf16* za = ZL + (32 * th + r) * ZP + gi * 128 + 8 * h;
#pragma unroll
            for (int ks = 0; ks < 8; ++ks) { const bf16x8 zf = lds_frag(za + 16 * ks);
#pragma unroll
                for (int t = 0; t < 4; ++t) acc[t] = MFMA32(zf, *(const bf16x8*)(PWT + (size_t)(32 * t + r) * 128 + 16 * ks + 8 * h), acc[t]); }
#pragma unroll
            for (int t = 0; t < 4; ++t) { const int d = 32 * t + r; const float bv = pb[d], sv = psc[d];
#pragma unroll
                for (int i = 0; i < 16; ++i) { const int m = t0 + 32 * th + (i & 3) + 8 * (i >> 2) + 4 * h; CAT[(size_t)m * DM + DRW + gi * 128 + d] = (bf16)f2bf((acc[t][i] + bv) * sv); } }
        }
        __syncthreads();
        {
            bf16* QR = (bf16*)(ws + WS_QR); bf16* KS = (bf16*)(ws + WS_KS); bf16* KW = (bf16*)(ws + WS_KW); bf16* VST = (bf16*)(ws + WS_VST); bf16* VWT = (bf16*)(ws + WS_VWT);
            LAS float* T0 = (LAS float*)lds; LAS float* T1 = T0 + 64 * 193;
            for (int i = tid; i < 64 * 1152; i += NTHR) { const int tt = i / 1152, c = i - tt * 1152; const int m = t0 + tt, s = s0 + tt; const float* pr = P + (size_t)m * INP;
                int src; bf16* dst; float scale = 1.f;
                if (c < 768) { src = PO_Q + c; dst = QR + (size_t)m * 768 + c; scale = 0.125f * 1.4426950408889634f; }
                else if (c < 960) { src = PO_KS + (c - 768); dst = KS + (size_t)m * 192 + (c - 768); }
                else { src = PO_KW + (c - 960); dst = KW + (size_t)m * 192 + (c - 960); }
                const int d = c & 63; float v = pr[src];
                if (d < 16) { const f32x2 cs = rope[s * 8 + (d & 7)]; v = d < 8 ? v * cs.x - pr[src + 8] * cs.y : v * cs.x + pr[src - 8] * cs.y; }
                *dst = (bf16)f2bf(v * scale); }
            for (int i = tid; i < 64 * 384; i += NTHR) { const int tt = i / 384, c = i - tt * 384; const float* pr = P + (size_t)(t0 + tt) * INP;
                if (c < 192) T0[tt * 193 + c] = pr[PO_VS + c]; else T1[tt * 193 + (c - 192)] = pr[PO_VW + (c - 192)]; }
            __syncthreads();
            for (int i = tid; i < 384 * 64; i += NTHR) { const int c2 = i >> 6, tok = i & 63; const int which = c2 >= 192, c = which ? c2 - 192 : c2;
                const float v = (which ? T1 : T0)[tok * 193 + c]; const int sk = s0 + tok;
                bf16* dst = (which ? VWT : VST) + (((size_t)(b * 3 + (c >> 6)) * 128 + (sk >> 5)) * 64 + (c & 63)) * 32 + vt_pos(sk & 31); *dst = (bf16)f2bf(v); }
        }
        __syncthreads();
    }
    {
        LAS bf16* HL = (LAS bf16*)lds;
        const float* cbias = (const float*)(ws + WS_CBIAS); bf16* KC = (bf16*)(ws + WS_KC); bf16* VCT = (bf16*)(ws + WS_VCT);
        for (int u = bid; u < 2 * NB * 3 * 8; u += G) {
            const int ten = u / 96, q = u - ten * 96, b = q / 24, q2 = q - b * 24, hh = q2 >> 3, nt = q2 & 7, n0 = 32 * nt;
            const bf16* W1T = (const bf16*)(ws + WS_W1T) + (size_t)ten * 256 * 2048 + (size_t)(32 * wave + r) * 2048 + 8 * h;
            const int tk0 = 16 * (n0 + r);
            const float* pa = P + ((size_t)b * SEQ + tk0) * INP + (ten ? PO_VC : PO_KC) + hh * 64 + 8 * h;
            f32x16 acc;
#pragma unroll
            for (int i = 0; i < 16; ++i) acc[i] = 0.f;
#pragma unroll 2
            for (int ll = 0; ll < 32; ++ll) {
                const bool ok = tk0 + ll < SEQ; const float* pl = pa + (size_t)ll * INP;
#pragma unroll
                for (int ds = 0; ds < 4; ++ds) { f32x4 x0 = {0.f, 0.f, 0.f, 0.f}, x1 = {0.f, 0.f, 0.f, 0.f}; if (ok) { x0 = *(const f32x4*)(pl + 16 * ds); x1 = *(const f32x4*)(pl + 16 * ds + 4); }
                    acc = MFMA32(cvt8(x0, x1), *(const bf16x8*)(W1T + 64 * ll + 16 * ds), acc); }
            }
            { const float cb = cbias[ten * 256 + 32 * wave + r];
#pragma unroll
                for (int i = 0; i < 16; ++i) { const float x = acc[i] + cb; const float gl = 0.5f * x * (1.0f + tanhf(0.7978845608028654f * (x + 0.044715f * x * x * x)));
                    HL[((i & 3) + 8 * (i >> 2) + 4 * h) * HP + 32 * wave + r] = (bf16)f2bf(gl); } }
            __syncthreads();
            if (wave < 2) {
                const bf16* W2CT = (const bf16*)(ws + WS_W2CT) + (size_t)ten * 64 * 256 + (size_t)(32 * wave + r) * 256 + 8 * h;
                f32x16 o;
#pragma unroll
                for (int i = 0; i < 16; ++i) o[i] = 0.f;
                const LAS bf16* ha = HL + r * HP + 8 * h;
#pragma unroll
                for (int ks = 0; ks < 16; ++ks) o = MFMA32(lds_frag(ha + 16 * ks), *(const bf16x8*)(W2CT + 16 * ks), o);
                const int d = 32 * wave + r;
#pragma unroll
                for (int i = 0; i < 16; ++i) { const int n = n0 + (i & 3) + 8 * (i >> 2) + 4 * h; float v = o[i];
                    if (ten == 0) { const float other = dpp_f<0x128>(v);
                        if (wave == 0 && r < 16) { const f32x2 cs = rope[((16 * n + 31) & (SEQ - 1)) * 8 + (r & 7)]; v = r < 8 ? v * cs.x - other * cs.y : v * cs.x + other * cs.y; }
                        if (n < NCMP) KC[((size_t)(b * NCMPP + n) * 3 + hh) * 64 + d] = (bf16)f2bf(v); }
                    else if (n < NCMP) VCT[(((size_t)(b * 3 + hh) * 8 + (n >> 5)) * 64 + d) * 32 + vt_pos(n & 31)] = (bf16)f2bf(v); }
            }
            __syncthreads();
        }
    }
}

constexpr int SCH = 16, SSTR = 360;
__device__ __forceinline__ void phase_scan(const Args& a, LAS unsigned char* lds, int bid, int tid, int wave, int lane) {
    OPQ_SI(bid); OPQ_V(tid); OPQ_SI(wave); lane = tid & 63;
    unsigned char* ws = a.ws + opaque0();
    const int hd = bid >> 1, half = bid & 1, b = hd / 12, h = hd - b * 12;
    const int rowl = wave * 4 + (lane >> 4), j = lane & 15;
    const float* SC = (const float*)(ws + WS_SC);
    LAS float* buf = (LAS float*)lds;
    const size_t m0 = (size_t)b * SEQ;
    GAS float* yp = (GAS float*)(ws + WS_YS) + m0 * DRW + h * 64 + half * 32 + (tid & 31);
    const GAS float* src[3]; int dsto[3]; bool act[3];
#pragma unroll
    for (int q = 0; q < 3; ++q) { const int i = tid + q * NTHR; act[q] = i < SCH * 88; const int st = i / 88, r = i - st * 88;
        if (r < 80) { const int vec = r >> 4, part = r & 15; src[q] = (const GAS float*)(ws + WS_SV + (size_t)vec * SV_STRIDE) + (m0 + st) * DRW + h * 64 + part * 4; dsto[q] = st * SSTR + vec * 64 + part * 4; }
        else { const int part = r - 80; src[q] = (const GAS float*)(ws + WS_SV + 5 * SV_STRIDE) + (m0 + st) * DRW + h * 64 + half * 32 + part * 4; dsto[q] = st * SSTR + 320 + part * 4; } }
    const GAS float* srcc = (const GAS float*)SC + ((m0 + (tid & 15)) * 12 + h) * 4; const int dstc = (tid & 15) * SSTR + 352;
    f32x4 ra[3], rb[3]; f32x2 rac, rbc;
    LAS float* yl = buf + 2 * SCH * SSTR;
#define SC_LOAD(R, RC, ck) do { _Pragma("unroll") for (int q = 0; q < 3; ++q) if (act[q]) R[q] = *(const GAS f32x4*)(src[q] + (size_t)(ck) * SCH * DRW); if (tid < 16) RC = *(const GAS f32x2*)(srcc + (size_t)(ck) * SCH * 48); } while (0)
#define SC_STORE(R, RC, bb) do { _Pragma("unroll") for (int q = 0; q < 3; ++q) if (act[q]) *(LAS f32x4*)(buf + (bb) * SCH * SSTR + dsto[q]) = R[q]; if (tid < 16) *(LAS f32x2*)(buf + (bb) * SCH * SSTR + dstc) = RC; } while (0)
#define SC_YSTORE(ck) do { yp[((size_t)(ck) * SCH + (tid >> 5)) * DRW] = yl[((ck) & 1) * SCH * 32 + tid]; } while (0)
#define SC_LDSTEP(X, sb) do { X##kk = *(const LAS f32x4*)((sb) + 4 * j); X##wr = *(const LAS f32x4*)((sb) + 64 + 4 * j); X##w = *(const LAS f32x4*)((sb) + 128 + 4 * j); X##km = *(const LAS f32x4*)((sb) + 192 + 4 * j); \
        X##bb = *(const LAS f32x4*)((sb) + 256 + 4 * j); X##v = (sb)[320 + rowl]; X##c = *(const LAS f32x2*)((sb) + 352); } while (0)
#define SC_STEP(X, yslot) do { \
        float p1 = S0 * X##kk.x; p1 = fmaf(S1, X##kk.y, p1); p1 = fmaf(S2, X##kk.z, p1); p1 = fmaf(S3, X##kk.w, p1); \
        float p2 = S0 * X##wr.x; p2 = fmaf(S1, X##wr.y, p2); p2 = fmaf(S2, X##wr.z, p2); p2 = fmaf(S3, X##wr.w, p2); \
        const float sa = row16_sum(p1), y0 = row16_sum(p2); const float v = X##v; \
        const float t0 = fmaf(S0, X##w.x, v * X##km.x), t1 = fmaf(S1, X##w.y, v * X##km.y), t2 = fmaf(S2, X##w.z, v * X##km.z), t3 = fmaf(S3, X##w.w, v * X##km.w); \
        S0 = fmaf(-sa, X##bb.x, t0); S1 = fmaf(-sa, X##bb.y, t1); S2 = fmaf(-sa, X##bb.z, t2); S3 = fmaf(-sa, X##bb.w, t3); \
        (yslot) = y0 - sa * X##c.x + v * X##c.y; } while (0)
#define SC_COMPUTE(bb) do { const LAS float* cb = buf + (bb) * SCH * SSTR; LAS float* yo = yl + (bb) * SCH * 32 + rowl; \
        f32x4 Akk, Awr, Aw, Akm, Abb, Bkk, Bwr, Bw, Bkm, Bbb; float Av, Bv; f32x2 Ac, Bc; \
        SC_LDSTEP(A, cb); \
        _Pragma("unroll") for (int st = 0; st < SCH; st += 2) { \
            SC_LDSTEP(B, cb + (st + 1) * SSTR); SC_STEP(A, yo[st * 32]); \
            if (st + 2 < SCH) SC_LDSTEP(A, cb + (st + 2) * SSTR); SC_STEP(B, yo[(st + 1) * 32]); } } while (0)
    float S0 = 0.f, S1 = 0.f, S2 = 0.f, S3 = 0.f;
    constexpr int NCH = SEQ / SCH;
    SC_LOAD(ra, rac, 0); SC_STORE(ra, rac, 0); SC_LOAD(ra, rac, 1); __syncthreads();
#pragma unroll 1
    for (int ck = 0; ck < NCH; ck += 2) {
        if (ck + 2 < NCH) SC_LOAD(rb, rbc, ck + 2);
        if (ck > 0) SC_YSTORE(ck - 1);
        SC_COMPUTE(0);
        SC_STORE(ra, rac, 1);
        __syncthreads();
        if (ck + 3 < NCH) SC_LOAD(ra, rac, ck + 3);
        SC_YSTORE(ck);
        SC_COMPUTE(1);
        if (ck + 2 < NCH) SC_STORE(rb, rbc, 0);
        __syncthreads();
    }
    SC_YSTORE(NCH - 1);
#undef SC_LOAD
#undef SC_STORE
#undef SC_YSTORE
#undef SC_COMPUTE
#undef SC_STEP
#undef SC_LDSTEP
}

template <bool WITH_V> __device__ __forceinline__ void dma_tile(LAS unsigned char* RW, const bf16* Kb, int key0, unsigned koff, const bf16* Vt, unsigned voff) {
    const char* kp = (const char*)(Kb + (size_t)key0 * 192) + koff;
#pragma unroll
    for (int ks = 0; ks < 4; ++ks) __builtin_amdgcn_global_load_lds((const unsigned*)(kp + 32 * ks), (LAS unsigned*)(RW + ks * 1024), 16, 0, 0);
    if (WITH_V) { const char* vp = (const char*)(Vt + (size_t)(key0 >> 5) * 2048) + voff;
#pragma unroll
        for (int q = 0; q < 4; ++q) __builtin_amdgcn_global_load_lds((const unsigned*)(vp + (q >> 1) * 2048 + (q & 1) * 16), (LAS unsigned*)(RW + (4 + q) * 1024), 16, 0, 0); }
}
template <bool WITH_V> __device__ __forceinline__ void read_tile(const LAS unsigned char* RW, int lane, bf16x8 (&kf)[4], bf16x8 (&vf)[2][2]) {
    asm volatile("s_waitcnt vmcnt(0)" ::: "memory");
#pragma unroll
    for (int ks = 0; ks < 4; ++ks) kf[ks] = *(const LAS bf16x8*)(RW + ks * 1024 + lane * 16);
    if (WITH_V) {
#pragma unroll
        for (int q = 0; q < 4; ++q) vf[q >> 1][q & 1] = *(const LAS bf16x8*)(RW + (4 + q) * 1024 + lane * 16); }
    asm volatile("s_waitcnt lgkmcnt(0)" ::: "memory");
}
__device__ __forceinline__ f32x16 qk_tile(const bf16x8 (&kf)[4], const bf16x8 (&qf)[4]) {
    f32x16 S;
#pragma unroll
    for (int i = 0; i < 16; ++i) S[i] = 0.f;
#pragma unroll
    for (int ks = 0; ks < 4; ++ks) S = MFMA32(kf[ks], qf[ks], S);
    return S;
}
__device__ __forceinline__ void pv_tile(const float (&p)[16], const bf16x8 (&vf)[2][2], f32x16 (&O)[2]) {
#pragma unroll
    for (int s = 0; s < 2; ++s) { u32x4 w; w.x = cvtpk(p[8 * s], p[8 * s + 1]); w.y = cvtpk(p[8 * s + 2], p[8 * s + 3]); w.z = cvtpk(p[8 * s + 4], p[8 * s + 5]); w.w = cvtpk(p[8 * s + 6], p[8 * s + 7]);
        const bf16x8 pf = __builtin_bit_cast(bf16x8, w);
#pragma unroll
        for (int dt = 0; dt < 2; ++dt) O[dt] = MFMA32(vf[dt][s], pf, O[dt]); }
}
template <int MODE> __device__ __forceinline__ void att_rest(const f32x16& S, const bf16x8 (&vf)[2][2], int key0, int h, int qp, bool colsel, float& m, float& l, f32x16 (&O)[2]) {
    const int kb = key0 + 4 * h;
    float sv[16]; float tmax = -INFINITY;
#pragma unroll
    for (int i = 0; i < 16; ++i) { const int key = kb + (i & 3) + 8 * (i >> 2); const bool ok = MODE == 2 ? (colsel && key <= qp) : (key <= qp && key >= qp - 511); sv[i] = ok ? S[i] : -INFINITY; tmax = fmaxf(tmax, sv[i]); }
    tmax = half_max(tmax);
    const float mn = fmaxf(m, tmax); const float ms = mn == -INFINITY ? 0.f : mn;
    const float alpha = __builtin_amdgcn_exp2f(m - ms);
    float p[16]; float ps = 0.f;
#pragma unroll
    for (int i = 0; i < 16; ++i) { p[i] = __builtin_amdgcn_exp2f(sv[i] - ms); ps += p[i]; }
    l = l * alpha + half_sum(ps); m = mn;
#pragma unroll
    for (int dt = 0; dt < 2; ++dt)
#pragma unroll
        for (int i = 0; i < 16; ++i) O[dt][i] *= alpha;
    pv_tile(p, vf, O);
}
constexpr int NSA_RING0 = 16384;
__device__ __forceinline__ void phase_nsa(const Args& a, int qi, int l, LAS unsigned char* lds, int slot, int lane) {
    OPQ_SI(slot); OPQ_V(lane);
    unsigned char* ws = a.ws + opaque0();
    LAS float* impl = (LAS float*)(lds + slot * 2048);
    LAS unsigned char* RW = lds + NSA_RING0 + slot * 8192;
    const bf16* QR = (const bf16*)(ws + WS_QR); const float* P = (const float*)(ws + WS_P); const float* gate_b = INPTR(a, I_GB) + (size_t)l * 36; bf16* CAT = (bf16*)(ws + WS_CAT);
    unsigned* qctr = (unsigned*)(ws + WS_CTL) + 8192 + 64 * qi;
    const int r = lane & 31, h = lane >> 5, g = r & 3, ql = r >> 2;
    const unsigned koff = (unsigned)(r * 192 + 8 * h) * 2u, voff = (unsigned)(r * 32 + 16 * h) * 2u;
    for (;;) {
        int item = 0; if (lane == 0) item = (int)atomicAdd(qctr, 1u); item = __builtin_amdgcn_readfirstlane(item);
        if (item >= NB * 3 * 64 * 8) break;
        const int u = item >> 3, wave = item & 7;
        const int qt = 63 - u / 12, bk = u - (u / 12) * 12, b = bk / 3, kvh = bk - b * 3;
        const int tile0 = qt * 64, cur = qt; const int qp = tile0 + 8 * wave + ql; const size_t mq = (size_t)b * SEQ + qp; const int head = kvh * 4 + g;
        bf16x8 qf[4];
#pragma unroll
        for (int ks = 0; ks < 4; ++ks) qf[ks] = *(const bf16x8*)(QR + mq * 768 + head * 64 + 16 * ks + 8 * h);
        float g0, g1, g2;
        { const float* gl = P + mq * INP + PO_GL + head * 3; const float* gb = gate_b + head * 3; g0 = sigmoidf_(gl[0] + gb[0]); g1 = sigmoidf_(gl[1] + gb[1]); g2 = sigmoidf_(gl[2] + gb[2]); }
        f32x16 out[2], O[2]; bf16x8 kf[4]; bf16x8 vf[2][2];
#pragma unroll
        for (int dt = 0; dt < 2; ++dt)
#pragma unroll
            for (int i = 0; i < 16; ++i) out[dt][i] = 0.f;
        unsigned long long mymask = (2ull << cur) - 1ull, umask = mymask;
        const int qpw = tile0 + 8 * wave + 7;
        {
            const bf16* Kb = (const bf16*)(ws + WS_KC) + ((size_t)b * NCMPP * 3 + kvh) * 64; const bf16* Vt = (const bf16*)(ws + WS_VCT) + (size_t)(b * 3 + kvh) * 8 * 2048;
            const int nvw = qpw >= 31 ? ((qpw - 31) >> 4) + 1 : 0; const int nvq = qp >= 31 ? ((qp - 31) >> 4) + 1 : 0; const int ntile = (nvw + 31) >> 5;
            const bool need_imp = cur >= 16;
            if (ntile > 0) {
                float m = -INFINITY, ls = 0.f;
                dma_tile<false>(RW, Kb, 0, koff, Vt, voff);
#pragma unroll 1
                for (int kt = 0; kt < ntile; ++kt) { read_tile<false>(RW, lane, kf, vf); if (kt + 1 < ntile) dma_tile<false>(RW, Kb, 32 * (kt + 1), koff, Vt, voff); else dma_tile<true>(RW, Kb, 0, koff, Vt, voff);
                    const f32x16 S = qk_tile(kf, qf);
                    float tmax = -INFINITY; float sv[16];
#pragma unroll
                    for (int i = 0; i < 16; ++i) { const int n = 32 * kt + (i & 3) + 8 * (i >> 2) + 4 * h; sv[i] = n < nvq ? S[i] : -INFINITY; tmax = fmaxf(tmax, sv[i]); }
                    tmax = half_max(tmax); const float mn = fmaxf(m, tmax); const float ms = mn == -INFINITY ? 0.f : mn; float ps = 0.f;
#pragma unroll
                    for (int i = 0; i < 16; ++i) ps += __builtin_amdgcn_exp2f(sv[i] - ms);
                    ls = ls * __builtin_amdgcn_exp2f(m - ms) + half_sum(ps); m = mn; }
                const float ms = m == -INFINITY ? 0.f : m; const float inv = 1.0f / fmaxf(ls, 1.17549435e-38f);
                float carry = 0.f;
#pragma unroll
                for (int dt = 0; dt < 2; ++dt)
#pragma unroll
                    for (int i = 0; i < 16; ++i) O[dt][i] = 0.f;
                if (need_imp) {
#pragma unroll
                    for (int i = 0; i < 8; ++i) impl[i * 64 + lane] = 0.f;
                    WSYNC(); }
#pragma unroll 1
                for (int kt = 0; kt < ntile; ++kt) {
                    read_tile<true>(RW, lane, kf, vf); if (kt + 1 < ntile) dma_tile<true>(RW, Kb, 32 * (kt + 1), koff, Vt, voff);
                    const f32x16 S = qk_tile(kf, qf);
                    float p[16];
#pragma unroll
                    for (int i = 0; i < 16; ++i) { const int n = 32 * kt + (i & 3) + 8 * (i >> 2) + 4 * h; p[i] = n < nvq ? __builtin_amdgcn_exp2f(S[i] - ms) * inv : 0.f; }
                    if (need_imp) {
                        float val[4];
#pragma unroll
                        for (int t = 0; t < 4; ++t) { const float sp = 0.5f * p[4 * t + 3]; const float base = (p[4 * t] + p[4 * t + 1]) + (p[4 * t + 2] + sp); const float rv = other_half(sp, h);
                            val[t] = base + (h ? rv : carry); carry = h ? 0.f : rv; }
#pragma unroll
                        for (int t = 0; t < 4; ++t) { float v = val[t]; v += dpp_f<0xB1>(v); v += dpp_f<0x4E>(v); if (g == 0) impl[ql * 64 + 8 * kt + 2 * t + h] = v; }
                    }
                    pv_tile(p, vf, O);
                }
#pragma unroll
                for (int dt = 0; dt < 2; ++dt)
#pragma unroll
                    for (int i = 0; i < 16; ++i) out[dt][i] = O[dt][i] * g0;
                if (need_imp) {
                    WSYNC();
#pragma unroll 1
                    for (int q = 0; q < 8; ++q) { const float v = impl[q * 64 + lane]; const bool forced = lane == 0 || lane == cur || lane == cur - 1; impl[q * 64 + lane] = lane > cur ? -INFINITY : (forced ? 1e9f : v); }
                    WSYNC();
                    umask = 0ull;
#pragma unroll 1
                    for (int q = 0; q < 8; ++q) { const float sc = impl[q * 64 + lane]; int rank = 0;
#pragma unroll 4
                        for (int i4 = 0; i4 < 16; ++i4) { const f32x4 o = *(const LAS f32x4*)(impl + q * 64 + 4 * i4);
                            rank += (o.x > sc || (o.x == sc && 4 * i4 + 0 < lane)) ? 1 : 0; rank += (o.y > sc || (o.y == sc && 4 * i4 + 1 < lane)) ? 1 : 0;
                            rank += (o.z > sc || (o.z == sc && 4 * i4 + 2 < lane)) ? 1 : 0; rank += (o.w > sc || (o.w == sc && 4 * i4 + 3 < lane)) ? 1 : 0; }
                        const unsigned long long mk = __ballot(lane <= cur && rank < 16);
                        umask |= mk; if (ql == q) mymask = mk; }
                    WSYNC();
                }
            }
        }
        {
            const bf16* Kb = (const bf16*)(ws + WS_KS) + ((size_t)b * SEQ * 3 + kvh) * 64; const bf16* Vt = (const bf16*)(ws + WS_VST) + (size_t)(b * 3 + kvh) * 128 * 2048;
            float m = -INFINITY, ls = 0.f;
#pragma unroll
            for (int dt = 0; dt < 2; ++dt)
#pragma unroll
                for (int i = 0; i < 16; ++i) O[dt][i] = 0.f;
            unsigned long long um = umask; int hf = 0;
#define SEL_NEXT(have, jb, key0) do { have = um != 0ull; if (have) { jb = __builtin_ctzll(um); key0 = 64 * jb + 32 * hf; if (hf == 0 && 64 * jb + 32 <= qpw) hf = 1; else { hf = 0; um &= um - 1ull; } } } while (0)
            bool hA; int jA = 0, kA = 0;
            SEL_NEXT(hA, jA, kA); if (hA) dma_tile<true>(RW, Kb, kA, koff, Vt, voff);
#pragma unroll 1
            while (hA) {
                read_tile<true>(RW, lane, kf, vf);
                const int jC = jA, kC = kA;
                SEL_NEXT(hA, jA, kA); if (hA) dma_tile<true>(RW, Kb, kA, koff, Vt, voff);
                const f32x16 S = qk_tile(kf, qf);
                att_rest<2>(S, vf, kC, h, qp, (mymask >> jC) & 1ull, m, ls, O);
            }
#undef SEL_NEXT
            const float sc = g1 / fmaxf(ls, 1.17549435e-38f);
#pragma unroll
            for (int dt = 0; dt < 2; ++dt)
#pragma unroll
                for (int i = 0; i < 16; ++i) out[dt][i] += O[dt][i] * sc;
        }
        {
            const bf16* Kb = (const bf16*)(ws + WS_KW) + ((size_t)b * SEQ * 3 + kvh) * 64; const bf16* Vt = (const bf16*)(ws + WS_VWT) + (size_t)(b * 3 + kvh) * 128 * 2048;
            float m = -INFINITY, ls = 0.f;
#pragma unroll
            for (int dt = 0; dt < 2; ++dt)
#pragma unroll
                for (int i = 0; i < 16; ++i) O[dt][i] = 0.f;
            const int q0w = tile0 + 8 * wave; const int lo = q0w - 511 > 0 ? q0w - 511 : 0;
            const int tEnd = (q0w + 7) >> 5; int t = lo >> 5;
            dma_tile<true>(RW, Kb, 32 * t, koff, Vt, voff);
#pragma unroll 1
            for (; t <= tEnd; ++t) {
                read_tile<true>(RW, lane, kf, vf);
                if (t + 1 <= tEnd) dma_tile<true>(RW, Kb, 32 * (t + 1), koff, Vt, voff);
                const f32x16 S = qk_tile(kf, qf);
                att_rest<3>(S, vf, 32 * t, h, qp, true, m, ls, O);
            }
            const float sc = g2 / fmaxf(ls, 1.17549435e-38f);
            bf16* op = CAT + mq * DM + DRW + DPOOL + head * 64 + 4 * h;
#pragma unroll
            for (int dt = 0; dt < 2; ++dt)
#pragma unroll
                for (int t2 = 0; t2 < 4; ++t2) { u32x2 w; w.x = cvtpk(out[dt][4 * t2] + O[dt][4 * t2] * sc, out[dt][4 * t2 + 1] + O[dt][4 * t2 + 1] * sc); w.y = cvtpk(out[dt][4 * t2 + 2] + O[dt][4 * t2 + 2] * sc, out[dt][4 * t2 + 3] + O[dt][4 * t2 + 3] * sc);
                    *(u32x2*)(op + 32 * dt + 8 * t2) = w; }
        }
    }
}

__device__ __forceinline__ void phase_rwkv_out(const Args& a, int l, int gw, int NGW, int lane) {
    OPQ_SI(gw); OPQ_V(lane);
    unsigned char* ws = a.ws + opaque0(); const float* YS = (const float*)(ws + WS_YS); const float* vV = (const float*)(ws + WS_SV + 5 * SV_STRIDE); const float* vG = (const float*)(ws + WS_G); const float* SC = (const float*)(ws + WS_SC);
    const float* gng = INPTR(a, I_GNG) + (size_t)l * DRW; const float* gnb = INPTR(a, I_GNB) + (size_t)l * DRW; bf16* CAT = (bf16*)(ws + WS_CAT);
    for (int id = gw; id < MTOK * 12; id += NGW) { const int m = id / 12, h = id - m * 12, c = h * 64 + lane; const size_t o = (size_t)m * DRW + c;
        const float y = YS[o]; const float mean = wave_sum(y) * (1.f / 64.f); const float d = y - mean; const float var = wave_sum(d * d) * (1.f / 64.f);
        const float yn = d * (1.f / sqrtf(var + GN_EPS)) * gng[c] + gnb[c]; const float bonus = SC[((size_t)m * 12 + h) * 4 + 2] * vV[o];
        CAT[(size_t)m * DM + c] = (bf16)f2bf((yn + bonus) * vG[o]); }
}

template <int PHMASK> __global__ void __launch_bounds__(NTHR, 2) fwd(Args args) {
    extern __shared__ __attribute__((aligned(16))) unsigned char lds_raw[];
    LAS unsigned char* lds = (LAS unsigned char*)lds_raw;
    const int tid = threadIdx.x, lane = tid & 63, wave = __builtin_amdgcn_readfirstlane(tid >> 6);
    const int G = gridDim.x, bid = blockIdx.x; const int gw = bid * NWAVES + wave, NGW = G * NWAVES;
    unsigned char* ws = args.ws;
    for (int u = tid; u < (LDS_BYTES - 131072) / 4; u += NTHR) ((LAS unsigned*)(lds + 131072))[u] = 0u;
    __syncthreads();
    const int lo = args.ph_lo, hi = args.ph_hi;
    XcdBarrier bar; bar.bar = (unsigned*)(ws + WS_CTL) + 4096; bar.x = 0; bar.st = nullptr;
    if (hi - lo > 1) bar = xcd_barrier_post((unsigned*)(ws + WS_CTL) + 4096, (volatile LAS unsigned*)(lds + MISC_OFF) + 8);
#define IN(k) (lo <= (k) && (k) < hi)
#define PHEN(j) (((PHMASK) >> (j)) & 1)
#ifndef REP_MASK
#define REP_MASK 0
#endif
#define SEAM(k) do { if ((k) + 1 < hi) xcd_barrier(bar); } while (0)
    bf16* XB = (bf16*)(ws + WS_XB); bf16* Hb = (bf16*)(ws + WS_H); float* Y = (float*)(ws + WS_Y); float* Pm = (float*)(ws + WS_P); bf16* CAT = (bf16*)(ws + WS_CAT);

    if (PHEN(0) && IN(0)) { phase_prologue(args, bid * NTHR + tid, G * NTHR); SEAM(0); }
    for (int l = 0; l < NLAYER; ++l) {
        const int pb = 1 + 13 * l;
        for (int rep = 0; rep < (((REP_MASK) >> 1) & 1 ? 2 : 1); ++rep) if (PHEN(1) && IN(pb + 0)) { phase_wconv(args, l, lds, gw, NGW, wave, lane); SEAM(pb + 0); }
        for (int rep = 0; rep < (((REP_MASK) >> 2) & 1 ? 2 : 1); ++rep) if (PHEN(2) && IN(pb + 1)) {
            pg8::Gemm g{XB, (const bf16*)(ws + WS_WUP1), MTOK, NUP, DM}; pg8::StaticOrder S; S.init(MTOK, NUP, G, bid); pg8::EpiSwiGLU E{Hb, DFF};
            pg8::gemm_phase<pg8::EpiSwiGLU, pg8::StaticOrder, true, true>(lds, g, S, E); SEAM(pb + 1); }
        for (int rep = 0; rep < (((REP_MASK) >> 3) & 1 ? 2 : 1); ++rep) if (PHEN(3) && IN(pb + 2)) {
            pg8::Gemm g{Hb, (const bf16*)(ws + WS_WDN1), MTOK, DM, DFF}; pg8::StaticOrder S; S.init(MTOK, DM, G, bid); pg8::EpiResid E{l == 0 ? INPTR(args, I_X) : args.out, Y, DM, ALPHA, 0.5f};
            pg8::gemm_phase<pg8::EpiResid, pg8::StaticOrder, true, true>(lds, g, S, E); SEAM(pb + 2); }
        for (int rep = 0; rep < (((REP_MASK) >> 4) & 1 ? 2 : 1); ++rep) if (PHEN(4) && IN(pb + 3)) { phase_ln(Y, INPTR(args, I_LN1G) + (size_t)l * DM, INPTR(args, I_LN1B) + (size_t)l * DM, args.out, XB, gw, NGW, lane); SEAM(pb + 3); }
        for (int rep = 0; rep < (((REP_MASK) >> 5) & 1 ? 2 : 1); ++rep) if (PHEN(5) && IN(pb + 4)) {
            pg8::Gemm g{XB, (const bf16*)(ws + WS_WIN), MTOK, INP, DM}; pg8::StaticOrder S; S.init(MTOK, INP, G, bid); pg8::EpiF32 E{Pm, INP};
            pg8::gemm_phase<pg8::EpiF32, pg8::StaticOrder, true, true>(lds, g, S, E); SEAM(pb + 4); }
        for (int rep = 0; rep < (((REP_MASK) >> 6) & 1 ? 2 : 1); ++rep) if (PHEN(6) && IN(pb + 5)) { phase_m1(args, l, lds, bid, G, tid, wave, lane); SEAM(pb + 5); }
        for (int rep = 0; rep < (((REP_MASK) >> 7) & 1 ? 2 : 1); ++rep) if (PHEN(7) && IN(pb + 6)) { for (int r2 = 0; r2 < (((REP_MASK) >> 20) & 1 ? 2 : 1); ++r2) { if (bid < 96) { phase_scan(args, lds, bid, tid, wave, lane); __syncthreads(); } } for (int r3 = 0; r3 < (((REP_MASK) >> 21) & 1 ? 2 : 1); ++r3) phase_nsa(args, l + 4 * rep + 8 * r3, l, lds, wave, lane); SEAM(pb + 6); }
        for (int rep = 0; rep < (((REP_MASK) >> 8) & 1 ? 2 : 1); ++rep) if (PHEN(8) && IN(pb + 7)) { phase_rwkv_out(args, l, gw, NGW, lane); SEAM(pb + 7); }
        for (int rep = 0; rep < (((REP_MASK) >> 9) & 1 ? 2 : 1); ++rep) if (PHEN(9) && IN(pb + 8)) {
            pg8::Gemm g{CAT, (const bf16*)(ws + WS_WOUT), MTOK, DM, DM}; pg8::StaticOrder S; S.init(MTOK, DM, G, bid); pg8::EpiResid E{args.out, Y, DM, ALPHA, 1.0f};
            pg8::gemm_phase<pg8::EpiResid, pg8::StaticOrder, true, true>(lds, g, S, E); SEAM(pb + 8); }
        for (int rep = 0; rep < (((REP_MASK) >> 10) & 1 ? 2 : 1); ++rep) if (PHEN(10) && IN(pb + 9)) { phase_ln(Y, INPTR(args, I_LN2G) + (size_t)l * DM, INPTR(args, I_LN2B) + (size_t)l * DM, args.out, XB, gw, NGW, lane); SEAM(pb + 9); }
        for (int rep = 0; rep < (((REP_MASK) >> 11) & 1 ? 2 : 1); ++rep) if (PHEN(11) && IN(pb + 10)) {
            pg8::Gemm g{XB, (const bf16*)(ws + WS_WUP2), MTOK, NUP, DM}; pg8::StaticOrder S; S.init(MTOK, NUP, G, bid); pg8::EpiSwiGLU E{Hb, DFF};
            pg8::gemm_phase<pg8::EpiSwiGLU, pg8::StaticOrder, true, true>(lds, g, S, E); SEAM(pb + 10); }
        for (int rep = 0; rep < (((REP_MASK) >> 12) & 1 ? 2 : 1); ++rep) if (PHEN(12) && IN(pb + 11)) {
            pg8::Gemm g{Hb, (const bf16*)(ws + WS_WDN2), MTOK, DM, DFF}; pg8::StaticOrder S; S.init(MTOK, DM, G, bid); pg8::EpiResid E{args.out, Y, DM, ALPHA, 0.5f};
            pg8::gemm_phase<pg8::EpiResid, pg8::StaticOrder, true, true>(lds, g, S, E); SEAM(pb + 11); }
        for (int rep = 0; rep < (((REP_MASK) >> 13) & 1 ? 2 : 1); ++rep) if (PHEN(13) && IN(pb + 12)) { phase_ln(Y, INPTR(args, I_LN3G) + (size_t)l * DM, INPTR(args, I_LN3B) + (size_t)l * DM, args.out, XB, gw, NGW, lane); SEAM(pb + 12); }
    }
#undef IN
#undef SEAM
}

#ifndef ONE_MASK
#define ONE_MASK 0xFFFFF
#endif
#ifndef MK_ONE_LAUNCH
#define MK_ONE_LAUNCH 1
#endif
typedef void (*kern_t)(Args);
extern "C" void kernel_launch(void* const* d_in, const int* in_sizes, int n_in, void* d_out, int out_size, void* d_ws, size_t ws_size, hipStream_t stream) {
    static int grid = 0;
#if MK_ONE_LAUNCH
    static const kern_t kerns[1] = {fwd<ONE_MASK>};
    constexpr int NK = 1;
#else
    static const kern_t kerns[14] = {fwd<1 << 0>, fwd<1 << 1>, fwd<1 << 2>, fwd<1 << 3>, fwd<1 << 4>, fwd<1 << 5>, fwd<1 << 6>, fwd<1 << 7>, fwd<1 << 8>, fwd<1 << 9>, fwd<1 << 10>, fwd<1 << 11>, fwd<1 << 12>, fwd<1 << 13>};
    constexpr int NK = 14;
#endif
    if (grid == 0) {
        if (n_in != 34 || out_size != MTOK * DM || ws_size < WS_END) { fprintf(stderr, "kernel_launch: unexpected shapes (n_in %d, out %d, ws %zu; need ws >= %zu)\n", n_in, out_size, ws_size, (size_t)WS_END); grid = -1; return; }
        int dev = 0, cus = 0;
        if (hipGetDevice(&dev) != hipSuccess || hipDeviceGetAttribute(&cus, hipDeviceAttributeMultiprocessorCount, dev) != hipSuccess) { grid = -1; return; }
        for (int i = 0; i < NK; ++i) if (hipFuncSetAttribute((const void*)kerns[i], hipFuncAttributeMaxDynamicSharedMemorySize, LDS_BYTES) != hipSuccess) { fprintf(stderr, "kernel_launch: hipFuncSetAttribute failed\n"); grid = -1; return; }
        int per_cu = 0;
        if (hipOccupancyMaxActiveBlocksPerMultiprocessor(&per_cu, (const void*)kerns[0], NTHR, LDS_BYTES) != hipSuccess || per_cu < 1) fprintf(stderr, "kernel_launch: occupancy query says %d blocks per CU\n", per_cu);
        (void)hipGetLastError();
        grid = cus;
    }
    if (grid < 0) return;
    (void)hipMemsetAsync((char*)d_ws + WS_CTL, 0, CTL_ZERO_BYTES, stream);
    Args a{};
    for (int i = 0; i < 34; ++i) a.in[i] = (const float*)d_in[i];
    a.out = (float*)d_out; a.ws = (unsigned char*)d_ws;
#if MK_ONE_LAUNCH
    a.ph_lo = 0; a.ph_hi = NPH;
    hipLaunchKernelGGL(kerns[0], dim3(grid), dim3(NTHR), LDS_BYTES, stream, a);
#else
    for (int k = 0; k < NPH; ++k) { a.ph_lo = k; a.ph_hi = k + 1; const int j = k == 0 ? 0 : (k - 1) % 13 + 1; hipLaunchKernelGGL(kerns[j], dim3(grid), dim3(NTHR), LDS_BYTES, stream, a); }
#endif
}
```

```cpp
#include <hip/hip_runtime.h>
#include <cstdio>
#include <cstdint>
namespace pg8 {
#define PG8_LAS __attribute__((address_space(3)))
typedef unsigned short bf16_t;
typedef short bf16x8 __attribute__((ext_vector_type(8)));
typedef float f32x4 __attribute__((ext_vector_type(4)));
typedef unsigned u32x4 __attribute__((ext_vector_type(4)));
constexpr int BM = 256, BK = 64, HALF = 128, HTB = HALF * BK * 2  , STAGE_BYTES = 8 * HTB, NXCD = 8, WGM = 8;

__host__ __device__ __forceinline__ int lds_byte(int r, int c) { const int st = (r >> 4) * 2 + (c >> 5), rr = r & 15, cc = c & 31, ob = rr * 64 + cc * 2; return st * 1024 + (ob ^ (((ob >> 9) & 1) << 5)); }
__host__ __device__ __forceinline__ void stage_rc(int b, int& R, int& C) { const int st = b / 1024, sb = b % 1024, swz = sb ^ (((sb >> 9) & 1) << 5); R = (st >> 1) * 16 + swz / 64; C = (st & 1) * 32 + (swz % 64) / 2; }
__host__ __device__ __forceinline__ int perm32(int rho) { const int n = rho >> 4, i = rho & 15; return 8 * (i >> 2) + 4 * n + (i & 3); }

struct Unit { int pm, pn; };
struct Gemm { const bf16_t* A; const bf16_t* Bt; int M, N, K; };

struct StaticOrder {
    int nM, nN, nwg, G, c;
    __host__ __device__ void init(int M, int N, int G_, int c_) { nM = M / BM; nN = N / BM; nwg = nM * nN; G = G_; c = c_; }
    __host__ __device__ bool next(int i, Unit& u) const {
        const long L = (long)i * G + c; if (L >= nwg) return false;
        int wgid = (int)L; { const int q = nwg / NXCD, r = nwg % NXCD, xcd = wgid % NXCD, off = wgid / NXCD; wgid = (xcd < r ? xcd * (q + 1) : r * (q + 1) + (xcd - r) * q) + off; }
        const int nig = WGM * nN, gid = wgid / nig, fm = gid * WGM, gsz = (nM - fm) < WGM ? (nM - fm) : WGM;
        u.pm = fm + ((wgid % nig) % gsz); u.pn = (wgid % nig) / gsz; return true;
    }
    __device__ __forceinline__ void a_ready(const Unit&) const {}
    __device__ __forceinline__ void done(const Unit&) const {}
};

__device__ __forceinline__ unsigned cvt_pk_bf16(float lo, float hi) { unsigned r; asm volatile("v_cvt_pk_bf16_f32 %0, %1, %2" : "=v"(r) : "v"(lo), "v"(hi)); return r; }
typedef float f32x2 __attribute__((ext_vector_type(2)));
struct EpiSwiGLU {
    static constexpr bool PERM = true, AFTER_DRAIN = false;
    bf16_t* H; int ldh;
    __device__ __forceinline__ void operator()(const f32x4 (&acc)[2][2][4][2], const Unit& u, int wr, int wc, int fr, int fq) const {
        const int row0 = u.pm * BM + wr * 64 + fr, col0 = u.pn * HALF + wc * 32 + 8 * fq;
#pragma unroll
        for (int ai = 0; ai < 2; ++ai)
#pragma unroll
            for (int m = 0; m < 4; ++m) { bf16_t* rowp = H + (size_t)(row0 + ai * HALF + m * 16) * ldh + col0;
                float hv[8];
#pragma unroll
                for (int n = 0; n < 2; ++n)
#pragma unroll
                    for (int i = 0; i < 4; ++i) { const float a = acc[ai][0][m][n][i], b = acc[ai][1][m][n][i];
                        const float e = __builtin_amdgcn_exp2f(a * -1.44269504089f); hv[n * 4 + i] = a * __builtin_amdgcn_rcpf(1.0f + e) * b; }
                u32x4 w; w.x = cvt_pk_bf16(hv[0], hv[1]); w.y = cvt_pk_bf16(hv[2], hv[3]); w.z = cvt_pk_bf16(hv[4], hv[5]); w.w = cvt_pk_bf16(hv[6], hv[7]);
                *(u32x4*)rowp = w; }
    }
};
struct EpiResid {
    static constexpr bool PERM = false, AFTER_DRAIN = false;
    const float* X; float* Y; int ldc; float alpha, s;
    __device__ __forceinline__ void operator()(const f32x4 (&acc)[2][2][4][2], const Unit& u, int wr, int wc, int fr, int fq) const {
        const int row0 = u.pm * BM + wr * 64 + fr, col0 = u.pn * BM + wc * 32 + 4 * fq;
#pragma unroll
        for (int ai = 0; ai < 2; ++ai)
#pragma unroll
            for (int m = 0; m < 4; ++m) { const size_t off = (size_t)(row0 + ai * HALF + m * 16) * ldc + col0;
#pragma unroll
                for (int bj = 0; bj < 2; ++bj)
#pragma unroll
                    for (int n = 0; n < 2; ++n) { const f32x4 xv = *(const f32x4*)(X + off + bj * HALF + n * 16); *(f32x4*)(Y + off + bj * HALF + n * 16) = xv * alpha + acc[ai][bj][m][n] * s; }
                asm volatile("" ::: "memory"); }
    }
};
struct EpiF32 {
    static constexpr bool PERM = false, AFTER_DRAIN = false;
    float* C; int ldc;
    __device__ __forceinline__ void operator()(const f32x4 (&acc)[2][2][4][2], const Unit& u, int wr, int wc, int fr, int fq) const {
        const int row0 = u.pm * BM + wr * 64 + fr, col0 = u.pn * BM + wc * 32 + 4 * fq;
#pragma unroll
        for (int ai = 0; ai < 2; ++ai)
#pragma unroll
            for (int m = 0; m < 4; ++m) { float* rowp = C + (size_t)(row0 + ai * HALF + m * 16) * ldc + col0;
#pragma unroll
                for (int bj = 0; bj < 2; ++bj)
#pragma unroll
                    for (int n = 0; n < 2; ++n) *(f32x4*)(rowp + bj * HALF + n * 16) = acc[ai][bj][m][n]; }
    }
};

template <class Epi, class Sched, bool ALIGN_EPI = false, bool SP2 = false>
__device__ __forceinline__ void gemm_phase(PG8_LAS unsigned char* lds, const Gemm g, const Sched& S, const Epi& E) {
    int tid_ = threadIdx.x; asm volatile("" : "+v"(tid_));
    const int tid = tid_, wid = __builtin_amdgcn_readfirstlane(tid >> 6), lane = tid & 63, wr = wid >> 2, wc = wid & 3, fr = lane & 15, fq = lane >> 4;
    const int K = g.K, nt = K / BK;
    unsigned voffA[2], voffB[2];
#pragma unroll
    for (int i = 0; i < 2; ++i) { int R, C; stage_rc(tid * 16 + i * 8192, R, C); const int Rb = Epi::PERM ? ((R & ~31) + perm32(R & 31)) : R;
        voffA[i] = (unsigned)(R * K + C) * 2u; voffB[i] = (unsigned)(Rb * K + C) * 2u; }
    const size_t kstep = (size_t)(BK * 2);
    const size_t hstep = (size_t)HALF * K * 2;
    const size_t tstep = 2 * hstep;
    const unsigned ldsw = (unsigned)wid * 1024u;
    const int aoff = lds_byte(wr * 64 + fr, fq * 8), boff = lds_byte(wc * 32 + fr, fq * 8);
#define PG8_SA(b, h) (((b) * 2 + (h)) * HTB)
#define PG8_SB(b, h) ((4 + (b) * 2 + (h)) * HTB)
#define PG8_STAGE(bufoff, gbase, voff) do { _Pragma("unroll") for (int _i = 0; _i < 2; ++_i) \
        __builtin_amdgcn_global_load_lds((const unsigned*)((const char*)(gbase) + (voff)[_i]), (PG8_LAS unsigned*)(lds + (bufoff) + ldsw + _i * 8192), 16, 0, 0); } while (0)
#define PG8_LDA(dst, b, h) do { _Pragma("unroll") for (int m = 0; m < 4; ++m) _Pragma("unroll") for (int k = 0; k < 2; ++k) dst[m][k] = *(const PG8_LAS bf16x8*)(lds + PG8_SA(b, h) + aoff + m * 2048 + k * 1024); } while (0)
#define PG8_LDB(dst, b, h) do { _Pragma("unroll") for (int n = 0; n < 2; ++n) _Pragma("unroll") for (int k = 0; k < 2; ++k) dst[n][k] = *(const PG8_LAS bf16x8*)(lds + PG8_SB(b, h) + boff + n * 2048 + k * 1024); } while (0)
#define PG8_MMA(ai, bj, At, Bt) do { __builtin_amdgcn_s_setprio(1); _Pragma("unroll") for (int m = 0; m < 4; ++m) _Pragma("unroll") for (int n = 0; n < 2; ++n) _Pragma("unroll") for (int k = 0; k < 2; ++k) \
        acc[ai][bj][m][n] = __builtin_amdgcn_mfma_f32_16x16x32_bf16(Bt[n][k], At[m][k], acc[ai][bj][m][n], 0, 0, 0); __builtin_amdgcn_s_setprio(0); } while (0)
#define PG8_WAIT_V(n) asm volatile("s_waitcnt vmcnt(" #n ")" ::: "memory")
#define PG8_WAIT_L(n) asm volatile("s_waitcnt lgkmcnt(" #n ")" ::: "memory")
#define PG8_BAR __builtin_amdgcn_s_barrier()
#define PG8_SCHED __builtin_amdgcn_sched_barrier(0)
    Unit cur, nxt; int ui = 0;
    if (!S.next(0, cur)) return;
    f32x4 acc[2][2][4][2];
#pragma unroll
    for (int a = 0; a < 2; ++a)
#pragma unroll
        for (int b = 0; b < 2; ++b)
#pragma unroll
            for (int m = 0; m < 4; ++m)
#pragma unroll
                for (int n = 0; n < 2; ++n) acc[a][b][m][n] = (f32x4){0.f, 0.f, 0.f, 0.f};
    bf16x8 At[4][2], B0[2][2], B1[2][2];
    const char* cA = (const char*)g.A + (size_t)cur.pm * tstep; const char* cB = (const char*)g.Bt + (size_t)cur.pn * tstep;
    S.a_ready(cur);
    if constexpr (SP2) {
        PG8_STAGE(PG8_SB(0, 0), cB, voffB); PG8_STAGE(PG8_SB(0, 1), cB + hstep, voffB); PG8_STAGE(PG8_SA(0, 0), cA, voffA); PG8_STAGE(PG8_SA(0, 1), cA + hstep, voffA);
        if (wr == 1) PG8_BAR;
        PG8_WAIT_V(2); PG8_BAR;
        PG8_STAGE(PG8_SB(1, 0), cB + kstep, voffB); PG8_STAGE(PG8_SA(1, 0), cA + kstep, voffA); PG8_STAGE(PG8_SB(1, 1), cB + hstep + kstep, voffB);
        PG8_WAIT_V(6); PG8_BAR;
    } else {
        PG8_STAGE(PG8_SB(0, 0), cB, voffB); PG8_STAGE(PG8_SA(0, 0), cA, voffA); PG8_STAGE(PG8_SB(0, 1), cB + hstep, voffB); PG8_STAGE(PG8_SA(0, 1), cA + hstep, voffA);
        if (wr == 1) PG8_BAR;
        PG8_WAIT_V(4); PG8_BAR;
        PG8_STAGE(PG8_SB(1, 0), cB + kstep, voffB); PG8_STAGE(PG8_SA(1, 0), cA + kstep, voffA); PG8_STAGE(PG8_SB(1, 1), cB + hstep + kstep, voffB);
        PG8_WAIT_V(6); PG8_BAR;
    }
    for (;;) {
        const bool has_next = S.next(ui + 1, nxt);
        const char* nA = has_next ? (const char*)g.A + (size_t)nxt.pm * tstep : cA; const char* nB = has_next ? (const char*)g.Bt + (size_t)nxt.pn * tstep : cB;
        for (int t = 0; t < nt; t += 2) {
            const bool last = (t == nt - 2);
            const char* a1 = cA + (size_t)(t + 1) * kstep;
            const char* a2 = last ? nA : cA + (size_t)(t + 2) * kstep; const char* b2 = last ? nB : cB + (size_t)(t + 2) * kstep;
            const char* a3 = a2 + kstep; const char* b3 = b2 + kstep;
            if (last && has_next) S.a_ready(nxt);
            if constexpr (SP2) {
            PG8_LDB(B0, 0, 0); PG8_LDB(B1, 0, 1); PG8_SCHED; PG8_LDA(At, 0, 0); PG8_STAGE(PG8_SA(1, 1), a1 + hstep, voffA);
            PG8_WAIT_V(8); PG8_WAIT_L(0); PG8_BAR; PG8_MMA(0, 0, At, B0); PG8_MMA(0, 1, At, B1); PG8_BAR; PG8_SCHED;
            PG8_LDA(At, 0, 1); PG8_STAGE(PG8_SB(0, 0), b2, voffB); PG8_STAGE(PG8_SB(0, 1), b2 + hstep, voffB); PG8_STAGE(PG8_SA(0, 0), a2, voffA);
            PG8_WAIT_V(8); PG8_WAIT_L(0); PG8_BAR; PG8_MMA(1, 0, At, B0); PG8_MMA(1, 1, At, B1); PG8_BAR; PG8_SCHED;
            PG8_LDB(B0, 1, 0); PG8_LDB(B1, 1, 1); PG8_SCHED; PG8_LDA(At, 1, 0); PG8_STAGE(PG8_SA(0, 1), a2 + hstep, voffA);
            PG8_WAIT_V(8); PG8_WAIT_L(0); PG8_BAR; PG8_MMA(0, 0, At, B0); PG8_MMA(0, 1, At, B1); PG8_BAR; PG8_SCHED;
            PG8_LDA(At, 1, 1); PG8_STAGE(PG8_SB(1, 0), b3, voffB); PG8_STAGE(PG8_SB(1, 1), b3 + hstep, voffB); PG8_STAGE(PG8_SA(1, 0), a3, voffA);
            PG8_WAIT_V(8); PG8_WAIT_L(0); PG8_BAR; PG8_MMA(1, 0, At, B0); PG8_MMA(1, 1, At, B1); PG8_BAR; PG8_SCHED;
            } else {
            PG8_LDB(B0, 0, 0); PG8_SCHED; PG8_LDA(At, 0, 0); PG8_STAGE(PG8_SA(1, 1), a1 + hstep, voffA);
            PG8_WAIT_L(8); PG8_BAR; PG8_WAIT_L(0); PG8_MMA(0, 0, At, B0); PG8_BAR; PG8_SCHED;
            PG8_LDB(B1, 0, 1); PG8_STAGE(PG8_SB(0, 0), b2, voffB);
            PG8_BAR; PG8_WAIT_L(0); PG8_MMA(0, 1, At, B1); PG8_BAR;
            PG8_LDA(At, 0, 1); PG8_STAGE(PG8_SA(0, 0), a2, voffA);
            PG8_BAR; PG8_WAIT_L(0); PG8_MMA(1, 0, At, B0); PG8_BAR; PG8_SCHED;
            PG8_STAGE(PG8_SB(0, 1), b2 + hstep, voffB);
            PG8_WAIT_V(6); PG8_BAR; PG8_MMA(1, 1, At, B1); PG8_BAR;
            PG8_LDB(B0, 1, 0); PG8_SCHED; PG8_LDA(At, 1, 0); PG8_STAGE(PG8_SA(0, 1), a2 + hstep, voffA);
            PG8_WAIT_L(8); PG8_BAR; PG8_WAIT_L(0); PG8_MMA(0, 0, At, B0); PG8_BAR; PG8_SCHED;
            PG8_LDB(B1, 1, 1); PG8_STAGE(PG8_SB(1, 0), b3, voffB);
            PG8_BAR; PG8_WAIT_L(0); PG8_MMA(0, 1, At, B1); PG8_BAR;
            PG8_LDA(At, 1, 1); PG8_STAGE(PG8_SA(1, 0), a3, voffA);
            PG8_BAR; PG8_WAIT_L(0); PG8_MMA(1, 0, At, B0); PG8_BAR; PG8_SCHED;
            PG8_STAGE(PG8_SB(1, 1), b3 + hstep, voffB);
            PG8_WAIT_V(6); PG8_BAR; PG8_MMA(1, 1, At, B1); PG8_BAR;
            }
        }
        if constexpr (ALIGN_EPI) { if (wr == 0) PG8_BAR; }
        if constexpr (!Epi::AFTER_DRAIN) { E(acc, cur, wr, wc, fr, fq); S.done(cur); }
        if (!has_next) break;
#pragma unroll
        for (int a = 0; a < 2; ++a)
#pragma unroll
            for (int b = 0; b < 2; ++b)
#pragma unroll
                for (int m = 0; m < 4; ++m)
#pragma unroll
                    for (int n = 0; n < 2; ++n) acc[a][b][m][n] = (f32x4){0.f, 0.f, 0.f, 0.f};
        cur = nxt; cA = nA; cB = nB; ++ui;
        if constexpr (ALIGN_EPI) { if (wr == 1) PG8_BAR; }
    }
    PG8_WAIT_V(0);
    if constexpr (!ALIGN_EPI) { if (wr == 0) PG8_BAR; }
    PG8_BAR;
    if constexpr (Epi::AFTER_DRAIN) { E.fused(acc, cur, wr, wc, fr, fq, lds, wid, lane); S.done(cur); }
#undef PG8_SA
#undef PG8_SB
#undef PG8_STAGE
#undef PG8_LDA
#undef PG8_LDB
#undef PG8_MMA
#undef PG8_WAIT_V
#undef PG8_WAIT_L
#undef PG8_BAR
#undef PG8_SCHED
}
}

constexpr int NWAVES = 8, NTHR = 512;
constexpr int NB = 4, SEQ = 4096, DM = 2048, MTOK = NB * SEQ, NLAYER = 4;
constexpr int DFF = 5504, NUP = 2 * DFF;
constexpr int INC = 5028, INP = 5120;
constexpr int DRW = 768, RWC = 2560, PO_POOL = 2560, DPOOL = 512, PO_NSA = 3072;
constexpr int PO_Q = PO_NSA, PO_KC = PO_NSA + 768, PO_VC = PO_KC + 192, PO_KS = PO_VC + 192, PO_VS = PO_KS + 192, PO_KW = PO_VS + 192, PO_VW = PO_KW + 192, PO_GL = PO_VW + 192;
static_assert(PO_GL + 36 == INC, "W_in column map");
constexpr int NCMP = 255, NCMPP = 256;
constexpr float ALPHA = 1.6817928305074290f;
constexpr float LN_EPS = 1e-5f, GN_EPS = 64e-5f;
constexpr int NPH = 1 + 13 * NLAYER;

constexpr size_t MiB = 1u << 20;
constexpr size_t WS_CTL = 0, CTL_ZERO_BYTES = 1 * MiB;
constexpr size_t WS_ROPE = 1 * MiB;
constexpr size_t WS_KC = 2 * MiB, WS_VC = 2 * MiB + 512 * 1024;
constexpr size_t WS_SC = 3 * MiB;
constexpr size_t WS_WUP1 = 8 * MiB, WS_WDN1 = 51 * MiB, WS_WIN = WS_WDN1 + 21 * MiB + 512 * 1024, WS_WOUT = WS_WIN + 20 * MiB, WS_WUP2 = WS_WOUT + 8 * MiB, WS_WDN2 = WS_WUP2 + 43 * MiB;
constexpr size_t WS_XB = 165 * MiB;
static_assert(WS_WDN2 + (size_t)DM * DFF * 2 <= WS_XB, "weights map");
constexpr size_t WS_CAT = 229 * MiB;
constexpr size_t WS_QR = 293 * MiB;
constexpr size_t WS_KS = 317 * MiB, WS_KW = 323 * MiB, WS_VS = 329 * MiB, WS_VW = 335 * MiB;
constexpr size_t WS_P = 341 * MiB;
constexpr size_t WS_H = 661 * MiB;
constexpr size_t WS_Y = 833 * MiB;
constexpr size_t WS_SV = WS_H;
constexpr size_t SV_STRIDE = 48 * MiB;
static_assert(WS_SV + 6 * SV_STRIDE <= WS_Y + 128 * MiB, "scan overlay");
constexpr size_t WS_G = 961 * MiB, WS_YS = 1009 * MiB;
constexpr size_t WS_VST = 1057 * MiB, WS_VWT = 1063 * MiB;
constexpr size_t WS_VCT = 6 * MiB;
constexpr size_t WS_SW = 1069 * MiB;
constexpr size_t WS_W2T = WS_SW, WS_A2T = WS_W2T + 768 * 64 * 2, WS_G2T = WS_A2T + 768 * 64 * 2, WS_PWT = WS_G2T + 768 * 128 * 2;
constexpr size_t WS_W1T = WS_PWT + 4 * 128 * 128 * 2, WS_W2CT = WS_W1T + 2 * 256 * 2048 * 2, WS_CBIAS = WS_W2CT + 2 * 64 * 256 * 2;
constexpr size_t WS_END = 1073 * MiB;
static_assert(WS_CBIAS + 2 * 256 * 4 <= WS_END, "small weights map");

constexpr int LDS_SCRATCH = 147456;
constexpr int LDS_BYTES = LDS_SCRATCH + 1024, MISC_OFF = LDS_SCRATCH + 320;

#define GAS __attribute__((address_space(1)))
#define LAS __attribute__((address_space(3)))
typedef unsigned short bf16;
typedef float f32x4 __attribute__((ext_vector_type(4)));
typedef float f32x2 __attribute__((ext_vector_type(2)));
typedef unsigned u32x4 __attribute__((ext_vector_type(4)));
typedef unsigned u32x2 __attribute__((ext_vector_type(2)));
#define LDS_WAIT() asm volatile("s_waitcnt lgkmcnt(0)" ::: "memory")
__device__ __forceinline__ unsigned f2bf(float f) { unsigned u = __builtin_bit_cast(unsigned, f); return (u + 0x7fffu + ((u >> 16) & 1u)) >> 16; }
__device__ __forceinline__ unsigned pk2(float lo, float hi) { return f2bf(lo) | (f2bf(hi) << 16); }
__device__ __forceinline__ float bf2f(unsigned short b) { return __builtin_bit_cast(float, ((unsigned)b) << 16); }
__device__ __forceinline__ float wave_sum(float v) {
#pragma unroll
    for (int o = 1; o < 64; o <<= 1) v += __shfl_xor(v, o);
    return v;
}
__device__ __forceinline__ float wave_max(float v) {
#pragma unroll
    for (int o = 1; o < 64; o <<= 1) v = fmaxf(v, __shfl_xor(v, o));
    return v;
}
__device__ __forceinline__ float sigmoidf_(float x) { return 1.0f / (1.0f + expf(-x)); }
template <int CTRL> __device__ __forceinline__ float dpp_f(float v) { return __builtin_bit_cast(float, __builtin_amdgcn_update_dpp(0, __builtin_bit_cast(int, v), CTRL, 0xF, 0xF, true)); }
__device__ __forceinline__ float row16_sum(float v) {
    v += dpp_f<0xB1>(v); v += dpp_f<0x4E>(v); v += dpp_f<0x141>(v); v += dpp_f<0x140>(v); return v;
}

#define XB_TMO      128
#define XB_XCNT(j)  (256  + 64 * (j))
#define XB_XSUB(j)  (1280 + 64 * (j))
#define XB_XGEN(j)  (2304 + 64 * (j))
#define XB_TOP      3328
#define XB_TOPGEN   3392
#define XCD_BAR_WORDS 3456
#define XB_SPIN_CAP (1u << 18)

__device__ __forceinline__ unsigned xb_ld(unsigned* p)              { return __hip_atomic_load(p, __ATOMIC_RELAXED, __HIP_MEMORY_SCOPE_AGENT); }
__device__ __forceinline__ unsigned xb_add(unsigned* p, unsigned v) { return __hip_atomic_fetch_add(p, v, __ATOMIC_RELAXED, __HIP_MEMORY_SCOPE_AGENT); }
__device__ __forceinline__ unsigned xb_xcc_id() { return (unsigned)__builtin_amdgcn_s_getreg((3 << 11) | 20) & 0xFu; }
#define XB_SPIN(cond, bar) do { unsigned _sp = 0; while (cond) { __builtin_amdgcn_s_sleep(1); \
    if ((++_sp & 255u) == 0u) { if (xb_ld(&(bar)[XB_TMO])) break; if (_sp > XB_SPIN_CAP) { atomicAdd(&(bar)[XB_TMO], 1u); break; } } } } while (0)

struct XcdBarrier {
    unsigned* bar; unsigned x;
    volatile LAS unsigned* st;
};

__device__ __forceinline__ XcdBarrier xcd_barrier_post(unsigned* bar, volatile LAS unsigned* st) {
    XcdBarrier b; b.bar = bar; b.x = xb_xcc_id(); b.st = st;
    if (threadIdx.x == 0) (void)xb_add(&bar[XB_XCNT(b.x)], 1u);
    return b;
}
__device__ __forceinline__ void xcd_barrier_complete(unsigned* bar, unsigned x, unsigned& nloc, unsigned& nx) {
    const unsigned G = gridDim.x * gridDim.y * gridDim.z;
    unsigned sum, cnt, mine, sp = 0u;
    for (;;) {
        sum = 0u; cnt = 0u; mine = 0u;
#pragma unroll
        for (unsigned j = 0; j < 16; ++j) { const unsigned c = xb_ld(&bar[XB_XCNT(j)]); sum += c; cnt += (c > 0u) ? 1u : 0u; mine = (j == x) ? c : mine; }
        if (sum == G) break;
        __builtin_amdgcn_s_sleep(1);
        if ((++sp & 255u) == 0u) { if (xb_ld(&bar[XB_TMO])) break; if (sp > XB_SPIN_CAP) { atomicAdd(&bar[XB_TMO], 1u); break; } }
    }
    nloc = mine > 0u ? mine : 1u; nx = cnt > 0u ? cnt : 1u;
}

__device__ __forceinline__ void xcd_barrier(const XcdBarrier& b) {
    asm volatile("s_waitcnt vmcnt(0)" ::: "memory");
    __syncthreads();
    if (threadIdx.x == 0) {
        unsigned* bar = b.bar;
        __builtin_amdgcn_s_waitcnt(0);
        unsigned nloc = b.st[0], nx = b.st[1];
        if (nloc == 0u) { xcd_barrier_complete(bar, b.x, nloc, nx); b.st[0] = nloc; b.st[1] = nx; }
        const unsigned old = xb_add(&bar[XB_XSUB(b.x)], 1u);
        const unsigned gen = old / nloc;
        if (old + 1u == (gen + 1u) * nloc) {
            __builtin_amdgcn_fence(__ATOMIC_RELEASE, "agent");
            asm volatile("s_waitcnt vmcnt(0)" ::: "memory");
            const unsigned og = xb_add(&bar[XB_TOP], 1u);
            const unsigned tg = og / nx;
            if (og + 1u == (tg + 1u) * nx) xb_add(&bar[XB_TOPGEN], 1u);
            else XB_SPIN(xb_ld(&bar[XB_TOPGEN]) == tg, bar);
            __builtin_amdgcn_fence(__ATOMIC_ACQUIRE, "agent");
            xb_add(&bar[XB_XGEN(b.x)], 1u);
            asm volatile("s_waitcnt vmcnt(0)" ::: "memory");
        } else {
            XB_SPIN(xb_ld(&bar[XB_XGEN(b.x)]) == gen, bar);
            __builtin_amdgcn_fence(__ATOMIC_ACQUIRE, "agent");
            asm volatile("s_waitcnt vmcnt(0)" ::: "memory");
        }
    }
    __syncthreads();
}

struct Args { const float* in[34]; float* out; unsigned char* ws; int ph_lo, ph_hi; };
__device__ __forceinline__ int opaque0() { int z = 0; asm volatile("" : "+s"(z)); return z; }
#define OPQ_S(x) asm volatile("" : "+s"(x))
#define OPQ_SI(x) do { (x) = __builtin_amdgcn_readfirstlane(x); asm volatile("" : "+s"(x)); } while (0)
#define OPQ_V(x) asm volatile("" : "+v"(x))
#define INPTR(a, idx) ((a).in[(idx) + opaque0()])
enum { I_X = 0, I_UP1, I_DN1, I_LN1G, I_LN1B, I_WIN, I_MU, I_W0, I_W2, I_A0, I_A2, I_G2, I_KK, I_KA, I_RK, I_GNG, I_GNB, I_PW, I_PB, I_PS, I_PEK, I_PEV, I_CK1, I_CK2, I_CV1, I_CV2, I_GB, I_WOUT, I_LN2G, I_LN2B, I_UP2, I_DN2, I_LN3G, I_LN3B };

__device__ __forceinline__ void transpose_item(const float* W, int K, int Nsrc, bf16* WT, int dst0, LAS float* scr, int k0, int n0, int lane) {
    const int n = n0 + (lane & 31); const bool ok = n < Nsrc;
#pragma unroll 8
    for (int i = 0; i < 32; ++i) { const int kk = 2 * i + (lane >> 5); scr[kk * 33 + (lane & 31)] = ok ? W[(size_t)(k0 + kk) * Nsrc + n] : 0.f; }
    LDS_WAIT();
    const int c = lane & 7;
#pragma unroll
    for (int j = 0; j < 4; ++j) { const int nn = (lane >> 3) + 8 * j; const LAS float* s = scr + (8 * c) * 33 + nn;
        u32x4 o; o.x = pk2(s[0 * 33], s[1 * 33]); o.y = pk2(s[2 * 33], s[3 * 33]); o.z = pk2(s[4 * 33], s[5 * 33]); o.w = pk2(s[6 * 33], s[7 * 33]);
        *(u32x4*)(WT + (size_t)(dst0 + nn) * K + k0 + 8 * c) = o; }
    LDS_WAIT();
}
__device__ __forceinline__ int up_dst_row(int n0) { return n0 < DFF ? 256 * (n0 / 128) + (n0 % 128) : 256 * ((n0 - DFF) / 128) + 128 + ((n0 - DFF) % 128); }

__device__ __forceinline__ void phase_wconv(const Args& a, int l, LAS unsigned char* lds, int gw, int NGW, int wave, int lane) {
    OPQ_SI(gw); OPQ_SI(wave); OPQ_V(lane);
    LAS float* scr = (LAS float*)(lds + wave * 16384);
    unsigned char* ws = a.ws + opaque0();
    constexpr int I_UP = (DM / 64) * (NUP / 32), I_DN = (DFF / 64) * (DM / 32), I_IN = (DM / 64) * (INP / 32), I_OUT = (DM / 64) * (DM / 32);
    constexpr int NIT = 2 * I_UP + 2 * I_DN + I_IN + I_OUT + 24 + 24 + 48 + 32 + 512 + 16;
    for (int it = gw; it < NIT; it += NGW) {
        int r = it;
        if (r < 2 * I_UP) { const int which = r / I_UP; r -= which * I_UP; const int nblk = NUP / 32, kb = r / nblk, nb = r % nblk;
            const float* W = a.in[which ? I_UP2 : I_UP1] + (size_t)l * DM * NUP; bf16* WT = (bf16*)(ws + (which ? WS_WUP2 : WS_WUP1));
            transpose_item(W, DM, NUP, WT, up_dst_row(32 * nb), scr, 64 * kb, 32 * nb, lane); continue; }
        r -= 2 * I_UP;
        if (r < 2 * I_DN) { const int which = r / I_DN; r -= which * I_DN; const int nblk = DM / 32, kb = r / nblk, nb = r % nblk;
            const float* W = a.in[which ? I_DN2 : I_DN1] + (size_t)l * DFF * DM; bf16* WT = (bf16*)(ws + (which ? WS_WDN2 : WS_WDN1));
            transpose_item(W, DFF, DM, WT, 32 * nb, scr, 64 * kb, 32 * nb, lane); continue; }
        r -= 2 * I_DN;
        if (r < I_IN) { const int nblk = INP / 32, kb = r / nblk, nb = r % nblk;
            transpose_item(INPTR(a, I_WIN) + (size_t)l * DM * INC, DM, INC, (bf16*)(ws + WS_WIN), 32 * nb, scr, 64 * kb, 32 * nb, lane); continue; }
        r -= I_IN;
        if (r < I_OUT) { const int nblk = DM / 32, kb = r / nblk, nb = r % nblk;
            transpose_item(INPTR(a, I_WOUT) + (size_t)l * DM * DM, DM, DM, (bf16*)(ws + WS_WOUT), 32 * nb, scr, 64 * kb, 32 * nb, lane); continue; }
        r -= I_OUT;
        if (r < 24) { transpose_item(INPTR(a, I_W2) + (size_t)l * 64 * DRW, 64, DRW, (bf16*)(ws + WS_W2T), 32 * r, scr, 0, 32 * r, lane); continue; } r -= 24;
        if (r < 24) { transpose_item(INPTR(a, I_A2) + (size_t)l * 64 * DRW, 64, DRW, (bf16*)(ws + WS_A2T), 32 * r, scr, 0, 32 * r, lane); continue; } r -= 24;
        if (r < 48) { const int kb = r / 24, nb = r % 24; transpose_item(INPTR(a, I_G2) + (size_t)l * 128 * DRW, 128, DRW, (bf16*)(ws + WS_G2T), 32 * nb, scr, 64 * kb, 32 * nb, lane); continue; } r -= 48;
        if (r < 32) { const int gi = r >> 3, q = r & 7, kb = q >> 2, nb = q & 3; transpose_item(INPTR(a, I_PW) + ((size_t)l * 4 + gi) * 128 * 128, 128, 128, (bf16*)(ws + WS_PWT) + gi * 128 * 128, 32 * nb, scr, 64 * kb, 32 * nb, lane); continue; } r -= 32;
        if (r < 512) { const int ten = r >> 8, q = r & 255, kb = q >> 3, nb = q & 7; transpose_item(INPTR(a, ten ? I_CV1 : I_CK1) + (size_t)l * 2048 * 256, 2048, 256, (bf16*)(ws + WS_W1T) + (size_t)ten * 256 * 2048, 32 * nb, scr, 64 * kb, 32 * nb, lane); continue; } r -= 512;
        { const int ten = r >> 3, q = r & 7, kb = q >> 1, nb = q & 1; transpose_item(INPTR(a, ten ? I_CV2 : I_CK2) + (size_t)l * 256 * 64, 256, 64, (bf16*)(ws + WS_W2CT) + (size_t)ten * 64 * 256, 32 * nb, scr, 64 * kb, 32 * nb, lane); }
    }
    if (gw / NWAVES == NGW / NWAVES - 1) { const int tid2 = wave * 64 + lane, ten = tid2 >> 8, f = tid2 & 255;
        const float* pe = INPTR(a, ten ? I_PEV : I_PEK) + (size_t)l * 2048; const float* w1 = INPTR(a, ten ? I_CV1 : I_CK1) + (size_t)l * 2048 * 256 + f; float acc = 0.f;
        for (int k = 0; k < 2048; ++k) acc = fmaf(pe[k], w1[(size_t)k * 256], acc);
        ((float*)(ws + WS_CBIAS))[ten * 256 + f] = acc; }
}

__device__ __forceinline__ void phase_prologue(const Args& a, int gtid, int NGT) {
    OPQ_V(gtid);
    const f32x4* x4 = (const f32x4*)INPTR(a, I_X); u32x2* xb = (u32x2*)(a.ws + WS_XB);
    for (size_t i = gtid; i < (size_t)MTOK * DM / 4; i += NGT) { const f32x4 v = x4[i]; u32x2 o; o.x = pk2(v.x, v.y); o.y = pk2(v.z, v.w); xb[i] = o; }
    f32x2* rope = (f32x2*)(a.ws + WS_ROPE);
    for (int i = gtid; i < SEQ * 8; i += NGT) { const int s = i >> 3, k = i & 7;
        const float inv = powf(500000.0f, -(float)k * 0.125f); const float ang = (float)s * inv;
        const double ad = (double)ang; const double q = __builtin_rint(ad * 0.15915494309189535); const double rr = ad - q * 6.283185307179586;
        const float rf = (float)rr; rope[i] = (f32x2){cosf(rf), sinf(rf)}; }
}

__device__ __forceinline__ void phase_ln(const float* Y, const float* g, const float* b, float* X, bf16* XB, int gw, int NGW, int lane) {
    OPQ_SI(gw); OPQ_V(lane);
    f32x4 gv[8], bv[8];
#pragma unroll
    for (int j = 0; j < 8; ++j) { gv[j] = ((const f32x4*)g)[64 * j + lane]; bv[j] = ((const f32x4*)b)[64 * j + lane]; }
    for (int m = gw; m < MTOK; m += NGW) {
        const f32x4* yr = (const f32x4*)(Y + (size_t)m * DM) + lane; f32x4 v[8]; float s = 0.f;
#pragma unroll
        for (int j = 0; j < 8; ++j) { v[j] = yr[64 * j]; s += (v[j].x + v[j].y) + (v[j].z + v[j].w); }
        const float mean = wave_sum(s) * (1.f / DM); float s2 = 0.f;
#pragma unroll
        for (int j = 0; j < 8; ++j) { v[j] = v[j] - mean; s2 += (v[j].x * v[j].x + v[j].y * v[j].y) + (v[j].z * v[j].z + v[j].w * v[j].w); }
        const float rstd = 1.f / sqrtf(wave_sum(s2) * (1.f / DM) + LN_EPS);
        f32x4* xr = (f32x4*)(X + (size_t)m * DM) + lane; u32x2* xb = (u32x2*)(XB + (size_t)m * DM) + lane;
#pragma unroll
        for (int j = 0; j < 8; ++j) { const f32x4 o = v[j] * rstd * gv[j] + bv[j]; xr[64 * j] = o; u32x2 w; w.x = pk2(o.x, o.y); w.y = pk2(o.z, o.w); xb[64 * j] = w; }
    }
}


typedef float f32x16 __attribute__((ext_vector_type(16)));
typedef short bf16x8 __attribute__((ext_vector_type(8)));
#define MFMA32(a, b, c) __builtin_amdgcn_mfma_f32_32x32x16_bf16((a), (b), (c), 0, 0, 0)
#define WSYNC() asm volatile("s_waitcnt lgkmcnt(0)" ::: "memory")
__device__ __forceinline__ void half_swap(float x, float& lo, float& hi) { float a = x, b = x; asm volatile("s_nop 1\n\tv_permlane32_swap_b32 %0, %1" : "+v"(a), "+v"(b)); lo = a; hi = b; }
__device__ __forceinline__ float half_max(float x) { float lo, hi; half_swap(x, lo, hi); return fmaxf(lo, hi); }
__device__ __forceinline__ float half_sum(float x) { float lo, hi; half_swap(x, lo, hi); return lo + hi; }
__device__ __forceinline__ float other_half(float x, int h) { float lo, hi; half_swap(x, lo, hi); return h ? lo : hi; }
__device__ __forceinline__ unsigned cvtpk(float lo, float hi) { unsigned r; asm volatile("v_cvt_pk_bf16_f32 %0, %1, %2" : "=v"(r) : "v"(lo), "v"(hi)); return r; }
__device__ __forceinline__ float half32_sum(float v) { v = row16_sum(v); float a = v, b = v; asm volatile("s_nop 1\n\tv_permlane16_swap_b32 %0, %1" : "+v"(a), "+v"(b)); return a + b; }
__device__ __forceinline__ int vt_pos(int k) { return 16 * ((k >> 2) & 1) + 8 * (k >> 4) + 4 * ((k >> 3) & 1) + (k & 3); }

#ifndef M1_PREFETCH
#define M1_PREFETCH 1
#endif
constexpr int XP = 264, ZP = 520, HP = 264;
__device__ __forceinline__ bf16x8 lds_frag(const LAS bf16* p) { return *(const LAS bf16x8*)p; }
__device__ __forceinline__ bf16x8 cvt8(const f32x4 a, const f32x4 b) { u32x4 w; w.x = cvtpk(a.x, a.y); w.y = cvtpk(a.z, a.w); w.z = cvtpk(b.x, b.y); w.w = cvtpk(b.z, b.w); return __builtin_bit_cast(bf16x8, w); }
__device__ __forceinline__ void phase_m1(const Args& a, int l, LAS unsigned char* lds, int bid, int G, int tid, int wave, int lane) {
    OPQ_SI(bid); OPQ_V(tid); OPQ_SI(wave); lane = tid & 63;
    unsigned char* ws = a.ws + opaque0(); const float* P = (const float*)(ws + WS_P);
    const int r = lane & 31, h = lane >> 5;
    const f32x2* rope = (const f32x2*)(ws + WS_ROPE);
    for (int unit = bid; unit < MTOK / 64; unit += G) {
        const int t0 = unit * 64, b = t0 >> 12, s0 = t0 & (SEQ - 1);
        LAS bf16* XL = (LAS bf16*)lds;
        LAS bf16* ZL = (LAS bf16*)(lds + 64 * XP * 2);
        { const float* mu = INPTR(a, I_MU) + (size_t)l * RWC;
            for (int i = tid; i < 64 * 256; i += NTHR) { const int tt = i >> 8, j = i & 255, col = 2304 + j; const int m = t0 + tt;
                const float pc = P[(size_t)m * INP + col]; const float pp = (s0 + tt) > 0 ? P[(size_t)(m - 1) * INP + col] : 0.f; const float v = pc + (pp - pc) * mu[col];
                const float f = j < 64 ? tanhf(v) : (j < 128 ? v : sigmoidf_(v)); XL[tt * XP + j] = (bf16)f2bf(f); }
            {
                const int ch = tid, gi = ch >> 7, win = 2 << gi; const float* pp = P + (size_t)t0 * INP + PO_POOL + ch; float sum = 0.f;
                for (int j = 1; j < win; ++j) if (s0 - j >= 0) sum += pp[-(ptrdiff_t)j * INP];
#pragma unroll 8
                for (int tt = 0; tt < 64; ++tt) { const int s = s0 + tt; const float cur = pp[(size_t)tt * INP]; sum += cur; const int cnt = (s + 1) < win ? (s + 1) : win;
                    ZL[tt * ZP + ch] = (bf16)f2bf(sum / (float)cnt - cur); if (s - win + 1 >= 0) sum -= pp[((ptrdiff_t)tt - win + 1) * INP]; } } }
        __syncthreads();
        {
            const float* mu = INPTR(a, I_MU) + (size_t)l * RWC; const float* w0 = INPTR(a, I_W0) + (size_t)l * DRW; const float* a0 = INPTR(a, I_A0) + (size_t)l * DRW;
            const float* k_k = INPTR(a, I_KK) + (size_t)l * DRW; const float* k_a = INPTR(a, I_KA) + (size_t)l * DRW; const float* r_k = INPTR(a, I_RK) + (size_t)l * DRW;
            const bf16* W2T = (const bf16*)(ws + WS_W2T); const bf16* A2T = (const bf16*)(ws + WS_A2T); const bf16* G2T = (const bf16*)(ws + WS_G2T);
            float* vKK = (float*)(ws + WS_SV); float* vWR = (float*)(ws + WS_SV + SV_STRIDE); float* vW = (float*)(ws + WS_SV + 2 * SV_STRIDE);
            float* vKM = (float*)(ws + WS_SV + 3 * SV_STRIDE); float* vBB = (float*)(ws + WS_SV + 4 * SV_STRIDE); float* vV = (float*)(ws + WS_SV + 5 * SV_STRIDE);
            float* vG = (float*)(ws + WS_G); float* SC = (float*)(ws + WS_SC);
#pragma unroll 1
            for (int jj = 0; jj < 3; ++jj) {
                const int job = wave + 8 * jj, hd = job >> 1, th = job & 1;
                f32x16 aU[2], aA[2];
#pragma unroll
                for (int t = 0; t < 2; ++t)
#pragma unroll
                    for (int i = 0; i < 16; ++i) { aU[t][i] = 0.f; aA[t][i] = 0.f; }
                const LAS bf16* xa = XL + (32 * th + r) * XP + 8 * h;
#pragma unroll
                for (int ks = 0; ks < 4; ++ks) { const bf16x8 xt = lds_frag(xa + 16 * ks), xl = lds_frag(xa + 64 + 16 * ks);
#pragma unroll
                    for (int t = 0; t < 2; ++t) { const int c = hd * 64 + 32 * t + r;
                        aU[t] = MFMA32(xt, *(const bf16x8*)(W2T + (size_t)c * 64 + 16 * ks + 8 * h), aU[t]);
                        aA[t] = MFMA32(xl, *(const bf16x8*)(A2T + (size_t)c * 64 + 16 * ks + 8 * h), aA[t]); } }
                float pmr[2], pmk[2], pmv[2], pw0[2], pa0[2], pkk[2], pka[2], prk[2];
#pragma unroll
                for (int t = 0; t < 2; ++t) { const int c = hd * 64 + 32 * t + r; pmr[t] = mu[c]; pmk[t] = mu[768 + c]; pmv[t] = mu[1536 + c]; pw0[t] = w0[c]; pa0[t] = a0[c]; pkk[t] = k_k[c]; pka[t] = k_a[c]; prk[t] = r_k[c]; }
                const int lo_p = 4 * h * INP + hd * 64 + r, lo_s = 4 * h * DRW + hd * 64 + r;
                float ld[2][12];
#define M1_LOADROW(buf, i) do { int mr_ = t0 + 32 * th + ((i) & 3) + 8 * ((i) >> 2); OPQ_SI(mr_); const bool first_ = (s0 + 32 * th + ((i) & 3) + 8 * ((i) >> 2) + 4 * h) == 0; \
        const float* pc_ = P + (size_t)mr_ * INP; const float* pp_ = pc_ - INP; _Pragma("unroll") for (int t = 0; t < 2; ++t) { const int o = lo_p + 32 * t; \
        buf[6 * t + 0] = pc_[o]; buf[6 * t + 1] = pc_[o + 768]; buf[6 * t + 2] = pc_[o + 1536]; buf[6 * t + 3] = first_ ? 0.f : pp_[o]; buf[6 * t + 4] = first_ ? 0.f : pp_[o + 768]; buf[6 * t + 5] = first_ ? 0.f : pp_[o + 1536]; } } while (0)
                M1_LOADROW(ld[0], 0);
#pragma unroll
                for (int i = 0; i < 16; ++i) {
#if M1_PREFETCH
                    if (i + 1 < 16) M1_LOADROW(ld[(i + 1) & 1], i + 1);
#else
                    if (i > 0) M1_LOADROW(ld[i & 1], i);
#endif
                    int mrow = t0 + 32 * th + (i & 3) + 8 * (i >> 2); OPQ_SI(mrow);
                    float rr[2], kv[2], vv[2], dec[2], av[2], kr[2], km[2];
                    float ss = 0.f, s1 = 0.f, s2 = 0.f, s3 = 0.f;
#pragma unroll
                    for (int t = 0; t < 2; ++t) { const float* L = ld[i & 1] + 6 * t;
                        const float rc = L[0], kc = L[1], vc = L[2], rp = L[3], kp = L[4], vp = L[5];
                        rr[t] = rc + (rp - rc) * pmr[t]; kv[t] = kc + (kp - kc) * pmk[t]; vv[t] = vc + (vp - vc) * pmv[t];
                        const float uu = pw0[t] + aU[t][i]; const float z = -uu; const float sp = z > 20.f ? z : log1pf(expf(z)); dec[t] = expf(-expf(-sp - 0.5f));
                        av[t] = sigmoidf_(pa0[t] + aA[t][i]);
                        kr[t] = kv[t] * pkk[t]; km[t] = kv[t] * (1.0f + (av[t] - 1.0f) * pka[t]);
                        ss += kr[t] * kr[t]; s1 += kr[t] * av[t] * rr[t]; s2 += km[t] * rr[t]; s3 += rr[t] * km[t] * prk[t]; }
                    ss = half32_sum(ss); s1 = half32_sum(s1); s2 = half32_sum(s2); s3 = half32_sum(s3);
                    const float invn = 1.0f / fmaxf(sqrtf(ss), 1e-12f);
                    const size_t ro = (size_t)mrow * DRW;
#pragma unroll
                    for (int t = 0; t < 2; ++t) { const int o = lo_s + 32 * t; const float kk = kr[t] * invn;
                        (vKK + ro)[o] = kk; (vWR + ro)[o] = dec[t] * rr[t]; (vW + ro)[o] = dec[t]; (vKM + ro)[o] = km[t]; (vBB + ro)[o] = kk * av[t]; (vV + ro)[o] = vv[t]; }
                    if (r == 0) *(f32x4*)(SC + ((size_t)mrow * 12 + hd) * 4 + 4 * h * 48) = (f32x4){s1 * invn, s2, s3, 0.f};
                    asm volatile("" ::: "memory");
                }
#undef M1_LOADROW
                { f32x16 aG[2];
#pragma unroll
                    for (int t = 0; t < 2; ++t)
#pragma unroll
                        for (int i = 0; i < 16; ++i) aG[t][i] = 0.f;
#pragma unroll
                    for (int ks = 0; ks < 8; ++ks) { const bf16x8 xg = lds_frag(xa + 128 + 16 * ks);
#pragma unroll
                        for (int t = 0; t < 2; ++t) { const int c = hd * 64 + 32 * t + r; aG[t] = MFMA32(xg, *(const bf16x8*)(G2T + (size_t)c * 128 + 16 * ks + 8 * h), aG[t]); } }
#pragma unroll
                    for (int i = 0; i < 16; ++i) { int mrow = t0 + 32 * th + (i & 3) + 8 * (i >> 2); OPQ_SI(mrow); float* gp = vG + (size_t)mrow * DRW;
#pragma unroll
                        for (int t = 0; t < 2; ++t) gp[lo_s + 32 * t] = aG[t][i]; } }
            }
        }
        {
            int lane_b = lane; OPQ_V(lane_b); const int r = lane_b & 31, h = lane_b >> 5;
            const int gi = wave >> 1, th = wave & 1; const bf16* PWT = (const bf16*)(ws + WS_PWT) + gi * 128 * 128;
            const float* pb = INPTR(a, I_PB) + (size_t)l * DPOOL + gi * 128; const float* psc = INPTR(a, I_PS) + (size_t)l * DPOOL + gi * 128; bf16* CAT = (bf16*)(ws + WS_CAT);
            f32x16 acc[4];
#pragma unroll
            for (int t = 0; t < 4; ++t)
#pragma unroll
                for (int i = 0; i < 16; ++i) acc[t][i] = 0.f;
            const LAS bf16* za = ZL + (32 * th + r) * ZP + gi * 128 + 8 * h;
#pragma unroll
            for (int ks = 0; ks < 8; ++ks) { const bf16x8 zf = lds_frag(za + 16 * ks);
#pragma unroll
                for (int t = 0; t < 4; ++t) acc[t] = MFMA32(zf, *(const bf16x8*)(PWT + (size_t)(32 * t + r) * 128 + 16 * ks + 8 * h), acc[t]); }
#pragma unroll
            for (int t = 0; t < 4; ++t) { const int d = 32 * t + r; const float bv = pb[d], sv = psc[d];
#pragma unroll
                for (int i = 0; i < 16; ++i) { const int m = t0 + 32 * th + (i & 3) + 8 * (i >> 2) + 4 * h; CAT[(size_t)m * DM + DRW + gi * 128 + d] = (bf16)f2bf((acc[t][i] + bv) * sv); } }
        }
        __syncthreads();
        {
            int tid_c = tid; OPQ_V(tid_c); const int tid = tid_c;
            bf16* QR = (bf16*)(ws + WS_QR); bf16* KS = (bf16*)(ws + WS_KS); bf16* KW = (bf16*)(ws + WS_KW); bf16* VST = (bf16*)(ws + WS_VST); bf16* VWT = (bf16*)(ws + WS_VWT);
            LAS float* T0 = (LAS float*)lds; LAS float* T1 = T0 + 64 * 193;
            for (int i = tid; i < 64 * 1152; i += NTHR) { const int tt = i / 1152, c = i - tt * 1152; const int m = t0 + tt, s = s0 + tt; const float* pr = P + (size_t)m * INP;
                int src; bf16* dst; float scale = 1.f;
                if (c < 768) { src = PO_Q + c; dst = QR + (size_t)m * 768 + c; scale = 0.125f * 1.4426950408889634f; }
                else if (c < 960) { const int cc = c - 768; src = PO_KS + cc; dst = KS + (((size_t)(b * 3 + (cc >> 6)) * 128 + (s >> 5)) * 32 + (s & 31)) * 64 + (cc & 63); }
                else { const int cc = c - 960; src = PO_KW + cc; dst = KW + (((size_t)(b * 3 + (cc >> 6)) * 128 + (s >> 5)) * 32 + (s & 31)) * 64 + (cc & 63); }
                const int d = c & 63; float v = pr[src];
                if (d < 16) { const f32x2 cs = rope[s * 8 + (d & 7)]; v = d < 8 ? v * cs.x - pr[src + 8] * cs.y : v * cs.x + pr[src - 8] * cs.y; }
                *dst = (bf16)f2bf(v * scale); }
            for (int i = tid; i < 64 * 384; i += NTHR) { const int tt = i / 384, c = i - tt * 384; const float* pr = P + (size_t)(t0 + tt) * INP;
                if (c < 192) T0[tt * 193 + c] = pr[PO_VS + c]; else T1[tt * 193 + (c - 192)] = pr[PO_VW + (c - 192)]; }
            __syncthreads();
            for (int i = tid; i < 384 * 64; i += NTHR) { const int c2 = i >> 6, tok = i & 63; const int which = c2 >= 192, c = which ? c2 - 192 : c2;
                const float v = (which ? T1 : T0)[tok * 193 + c]; const int sk = s0 + tok;
                bf16* dst = (which ? VWT : VST) + (((size_t)(b * 3 + (c >> 6)) * 128 + (sk >> 5)) * 64 + (c & 63)) * 32 + vt_pos(sk & 31); *dst = (bf16)f2bf(v); }
        }
        __syncthreads();
    }
    {
        int lane_d = lane; OPQ_V(lane_d); const int r = lane_d & 31, h = lane_d >> 5;
        LAS bf16* HL = (LAS bf16*)lds;
        const float* cbias = (const float*)(ws + WS_CBIAS); bf16* KC = (bf16*)(ws + WS_KC); bf16* VCT = (bf16*)(ws + WS_VCT);
        for (int u = bid; u < 2 * NB * 3 * 8; u += G) {
            const int ten = u / 96, q = u - ten * 96, b = q / 24, q2 = q - b * 24, hh = q2 >> 3, nt = q2 & 7, n0 = 32 * nt;
            const bf16* W1T = (const bf16*)(ws + WS_W1T) + (size_t)ten * 256 * 2048 + (size_t)(32 * wave + r) * 2048 + 8 * h;
            const int tk0 = 16 * (n0 + r);
            const float* pa = P + ((size_t)b * SEQ + tk0) * INP + (ten ? PO_VC : PO_KC) + hh * 64 + 8 * h;
            f32x16 acc;
#pragma unroll
            for (int i = 0; i < 16; ++i) acc[i] = 0.f;
            f32x4 xa[2][8]; bf16x8 wb[2][4];
#define CMP_LOAD(sl, ll) do { const bool ok_ = tk0 + (ll) < SEQ; const float* pl_ = pa + (size_t)(ll) * INP; _Pragma("unroll") for (int ds = 0; ds < 4; ++ds) { \
        xa[sl][2 * ds] = ok_ ? *(const f32x4*)(pl_ + 16 * ds) : (f32x4){0.f, 0.f, 0.f, 0.f}; xa[sl][2 * ds + 1] = ok_ ? *(const f32x4*)(pl_ + 16 * ds + 4) : (f32x4){0.f, 0.f, 0.f, 0.f}; \
        wb[sl][ds] = *(const bf16x8*)(W1T + 64 * (ll) + 16 * ds); } } while (0)
            CMP_LOAD(0, 0);
#pragma unroll 1
            for (int ll = 0; ll < 32; ll += 2) {
                CMP_LOAD(1, ll + 1);
#pragma unroll
                for (int ds = 0; ds < 4; ++ds) acc = MFMA32(cvt8(xa[0][2 * ds], xa[0][2 * ds + 1]), wb[0][ds], acc);
                if (ll + 2 < 32) CMP_LOAD(0, ll + 2);
#pragma unroll
                for (int ds = 0; ds < 4; ++ds) acc = MFMA32(cvt8(xa[1][2 * ds], xa[1][2 * ds + 1]), wb[1][ds], acc);
            }
#undef CMP_LOAD
            { const float cb = cbias[ten * 256 + 32 * wave + r];
#pragma unroll
                for (int i = 0; i < 16; ++i) { const float x = acc[i] + cb; const float gl = 0.5f * x * (1.0f + tanhf(0.7978845608028654f * (x + 0.044715f * x * x * x)));
                    HL[((i & 3) + 8 * (i >> 2) + 4 * h) * HP + 32 * wave + r] = (bf16)f2bf(gl); } }
            __syncthreads();
            if (wave < 2) {
                const bf16* W2CT = (const bf16*)(ws + WS_W2CT) + (size_t)ten * 64 * 256 + (size_t)(32 * wave + r) * 256 + 8 * h;
                f32x16 o;
#pragma unroll
                for (int i = 0; i < 16; ++i) o[i] = 0.f;
                const LAS bf16* ha = HL + r * HP + 8 * h;
#pragma unroll
                for (int ks = 0; ks < 16; ++ks) o = MFMA32(lds_frag(ha + 16 * ks), *(const bf16x8*)(W2CT + 16 * ks), o);
                const int d = 32 * wave + r;
#pragma unroll
                for (int i = 0; i < 16; ++i) { const int n = n0 + (i & 3) + 8 * (i >> 2) + 4 * h; float v = o[i];
                    if (ten == 0) { const float other = dpp_f<0x128>(v);
                        if (wave == 0 && r < 16) { const f32x2 cs = rope[((16 * n + 31) & (SEQ - 1)) * 8 + (r & 7)]; v = r < 8 ? v * cs.x - other * cs.y : v * cs.x + other * cs.y; }
                        if (n < NCMP) KC[((size_t)(b * 3 + hh) * NCMPP + n) * 64 + d] = (bf16)f2bf(v); }
                    else if (n < NCMP) VCT[(((size_t)(b * 3 + hh) * 8 + (n >> 5)) * 64 + d) * 32 + vt_pos(n & 31)] = (bf16)f2bf(v); }
            }
            __syncthreads();
        }
    }
}

constexpr int SCAN_ROWS = 32, SCAN_WGS = NB * 12 * 2;
constexpr int SCH = 16, SSTR = 320 + 4 * SCAN_ROWS;
__device__ __forceinline__ void phase_scan(const Args& a, LAS unsigned char* lds, int bid, int tid, int wave, int lane) {
    OPQ_SI(bid); OPQ_V(tid); OPQ_SI(wave); lane = tid & 63;
    unsigned char* ws = a.ws + opaque0();
    const int hd = bid >> 1, half = bid & 1, b = hd / 12, h = hd - b * 12;
    const int rowl = wave * 4 + (lane >> 4), j = lane & 15;
    LAS float* buf = (LAS float*)lds;
    LAS float* yl = buf + 3 * SCH * SSTR;
    constexpr int SCAN_DUMP = 3 * SCH * SSTR + 2 * SCH * SCAN_ROWS;
    static_assert((SCAN_DUMP + NTHR * 4) * 4 <= 131072, "scan LDS map");
    const size_t m0 = (size_t)b * SEQ;
    GAS float* yp = (GAS float*)(ws + WS_YS) + (m0 + (tid >> 5)) * DRW + h * 64 + half * 32 + (tid & 31);
    const GAS float* src[3]; int dsto[3];
#pragma unroll
    for (int q = 0; q < 3; ++q) { const int i0_ = tid + q * NTHR; const bool act = i0_ < SCH * 80; const int i = act ? i0_ : 0; const int st = i / 80, r = i - st * 80, vec = r >> 4, part = r & 15;
        src[q] = (const GAS float*)(ws + WS_SV + (size_t)vec * SV_STRIDE) + (m0 + st) * DRW + h * 64 + part * 4; dsto[q] = act ? st * SSTR + vec * 64 + part * 4 : SCAN_DUMP + tid * 4; }
    const GAS float* srcv = (const GAS float*)(ws + WS_SV + 5 * SV_STRIDE) + (m0 + (tid >> 5)) * DRW + h * 64 + half * 32 + (tid & 31);
    const GAS float* srcc = (const GAS float*)(ws + WS_SC) + ((m0 + (tid >> 5)) * 12 + h) * 4; const int dstv = (tid >> 5) * SSTR + 320 + (tid & 31) * 4;
    f32x4 ra[3], rb[3]; f32x2 rac, rbc; float rav, rbv;
#define SC_LOAD(R, RC, RV, ck) do { _Pragma("unroll") for (int q = 0; q < 3; ++q) R[q] = *(const GAS f32x4*)(src[q] + (size_t)(ck) * SCH * DRW); RV = srcv[(size_t)(ck) * SCH * DRW]; RC = *(const GAS f32x2*)(srcc + (size_t)(ck) * SCH * 48); } while (0)
#define SC_STORE(R, RC, RV, bo) do { _Pragma("unroll") for (int q = 0; q < 3; ++q) *(LAS f32x4*)(buf + (dsto[q] >= SCAN_DUMP ? 0 : (bo)) + dsto[q]) = R[q]; *(LAS f32x4*)(buf + (bo) + dstv) = (f32x4){RV, RC.x, RC.y, 0.f}; } while (0)
#define SC_YSTORE(ck) do { yp[(size_t)(ck) * SCH * DRW] = yl[((ck) & 1) * SCH * SCAN_ROWS + tid]; } while (0)
#define SC_LDSTEP(X, sb) do { X##kk = *(const LAS f32x4*)((sb) + 4 * j); X##wr = *(const LAS f32x4*)((sb) + 64 + 4 * j); X##w = *(const LAS f32x4*)((sb) + 128 + 4 * j); X##km = *(const LAS f32x4*)((sb) + 192 + 4 * j); \
        X##bb = *(const LAS f32x4*)((sb) + 256 + 4 * j); X##vc = *(const LAS f32x4*)((sb) + 320 + 4 * rowl); } while (0)
#define SC_STEP(X, yslot) do { \
        f32x2 d1 = S01 * (f32x2){X##kk.x, X##kk.y}; d1 = S23 * (f32x2){X##kk.z, X##kk.w} + d1; \
        f32x2 d2 = S01 * (f32x2){X##wr.x, X##wr.y}; d2 = S23 * (f32x2){X##wr.z, X##wr.w} + d2; \
        const float sa = row16_sum(d1.x + d1.y), y0 = row16_sum(d2.x + d2.y); const float v = X##vc.x; \
        const f32x2 t01 = S01 * (f32x2){X##w.x, X##w.y} + (f32x2){X##km.x, X##km.y} * v, t23 = S23 * (f32x2){X##w.z, X##w.w} + (f32x2){X##km.z, X##km.w} * v; \
        S01 = t01 - (f32x2){X##bb.x, X##bb.y} * sa; S23 = t23 - (f32x2){X##bb.z, X##bb.w} * sa; \
        (yslot) = y0 - sa * X##vc.y + v * X##vc.z; } while (0)
#define SC_ADDR(st) ((st) < SCH ? cb + (st) * SSTR : nb + ((st) - SCH) * SSTR)
#define SC_COMPUTE(cb, nb, yo) do { _Pragma("unroll") for (int st = 0; st < SCH; st += 4) { \
            SC_LDSTEP(D, SC_ADDR(st + 3)); SC_STEP(A, (yo)[st * SCAN_ROWS]); \
            SC_LDSTEP(A, SC_ADDR(st + 4)); SC_STEP(B, (yo)[(st + 1) * SCAN_ROWS]); \
            SC_LDSTEP(B, SC_ADDR(st + 5)); SC_STEP(C, (yo)[(st + 2) * SCAN_ROWS]); \
            SC_LDSTEP(C, SC_ADDR(st + 6)); SC_STEP(D, (yo)[(st + 3) * SCAN_ROWS]); } } while (0)
    f32x2 S01 = {0.f, 0.f}, S23 = {0.f, 0.f};
    f32x4 Akk, Awr, Aw, Akm, Abb, Avc, Bkk, Bwr, Bw, Bkm, Bbb, Bvc, Ckk, Cwr, Cw, Ckm, Cbb, Cvc, Dkk, Dwr, Dw, Dkm, Dbb, Dvc;
    constexpr int NCH = SEQ / SCH, BUFF = SCH * SSTR;
    SC_LOAD(ra, rac, rav, 0); SC_STORE(ra, rac, rav, 0); SC_LOAD(ra, rac, rav, 1); __syncthreads();
    SC_LDSTEP(A, buf); SC_LDSTEP(B, buf + SSTR); SC_LDSTEP(C, buf + 2 * SSTR);
    int b0 = 0, b1 = BUFF, b2 = 2 * BUFF;
#pragma unroll 1
    for (int ck = 0; ck < NCH; ck += 2) {
        SC_LOAD(rb, rbc, rbv, ck + 2 < NCH ? ck + 2 : NCH - 1);
        SC_STORE(ra, rac, rav, b1);
        __syncthreads();
        if (ck > 0) SC_YSTORE(ck - 1);
        { const LAS float* cb = buf + b0; const LAS float* nb = buf + b1; SC_COMPUTE(cb, nb, yl + rowl); }
        SC_LOAD(ra, rac, rav, ck + 3 < NCH ? ck + 3 : NCH - 1);
        SC_STORE(rb, rbc, rbv, b2);
        __syncthreads();
        SC_YSTORE(ck);
        { const LAS float* cb = buf + b1; const LAS float* nb = buf + b2; SC_COMPUTE(cb, nb, yl + SCH * SCAN_ROWS + rowl); }
        { const int t0_ = b0; b0 = b2; b2 = b1; b1 = t0_; }
    }
    __syncthreads();
    SC_YSTORE(NCH - 1);
#undef SC_LOAD
#undef SC_STORE
#undef SC_YSTORE
#undef SC_COMPUTE
#undef SC_ADDR
#undef SC_STEP
#undef SC_LDSTEP
}

template <bool WITH_V> __device__ __forceinline__ void dma_tile(LAS unsigned char* RW, const bf16* Kb, int key0, unsigned koff, const bf16* Vt, unsigned voff) {
    const char* kp = (const char*)(Kb + (size_t)key0 * 64) + koff;
#pragma unroll
    for (int q = 0; q < 4; ++q) __builtin_amdgcn_global_load_lds((const unsigned*)(kp + 1024 * q), (LAS unsigned*)(RW + q * 1024), 16, 0, 0);
    if (WITH_V) { const char* vp = (const char*)(Vt + (size_t)(key0 >> 5) * 2048) + voff;
#pragma unroll
        for (int q = 0; q < 4; ++q) __builtin_amdgcn_global_load_lds((const unsigned*)(vp + 1024 * q), (LAS unsigned*)(RW + (4 + q) * 1024), 16, 0, 0); }
}
template <bool WITH_V> __device__ __forceinline__ void read_tile(const LAS unsigned char* RW, unsigned krd, unsigned vrd, bf16x8 (&kf)[4], bf16x8 (&vf)[2][2], bool younger) {
    if (younger) { if (WITH_V) asm volatile("s_waitcnt vmcnt(8)" ::: "memory"); else asm volatile("s_waitcnt vmcnt(4)" ::: "memory"); } else asm volatile("s_waitcnt vmcnt(0)" ::: "memory");
    const int rk = (krd >> 7) & 7, hh = krd & 1;
#pragma unroll
    for (int ks = 0; ks < 4; ++ks) kf[ks] = *(const LAS bf16x8*)(RW + (krd & ~1u) + (((2 * ks + hh) ^ rk) << 4));
    if (WITH_V) {
#pragma unroll
        for (int q = 0; q < 4; ++q) { const int dt = q >> 1, s = q & 1; const unsigned row = (vrd >> 6) + 32 * dt; vf[dt][s] = *(const LAS bf16x8*)(RW + 4096 + row * 64 + ((((2 * hh + s)) ^ ((row >> 2) & 3)) << 4)); } }
    asm volatile("s_waitcnt lgkmcnt(0)" ::: "memory");
}
__device__ __forceinline__ f32x16 qk_tile(const bf16x8 (&kf)[4], const bf16x8 (&qf)[4]) {
    f32x16 S;
#pragma unroll
    for (int i = 0; i < 16; ++i) S[i] = 0.f;
#pragma unroll
    for (int ks = 0; ks < 4; ++ks) S = MFMA32(kf[ks], qf[ks], S);
    return S;
}
__device__ __forceinline__ void pv_tile(const float (&p)[16], const bf16x8 (&vf)[2][2], f32x16 (&O)[2]) {
#pragma unroll
    for (int s = 0; s < 2; ++s) { u32x4 w; w.x = cvtpk(p[8 * s], p[8 * s + 1]); w.y = cvtpk(p[8 * s + 2], p[8 * s + 3]); w.z = cvtpk(p[8 * s + 4], p[8 * s + 5]); w.w = cvtpk(p[8 * s + 6], p[8 * s + 7]);
        const bf16x8 pf = __builtin_bit_cast(bf16x8, w);
#pragma unroll
        for (int dt = 0; dt < 2; ++dt) O[dt] = MFMA32(vf[dt][s], pf, O[dt]); }
}
template <int MODE> __device__ __forceinline__ void att_rest(const f32x16& S, const bf16x8 (&vf)[2][2], int key0, int h, int qp, bool colsel, float& m, float& l, f32x16 (&O)[2]) {
    const int kb = key0 + 4 * h;
    float sv[16]; float tmax = -INFINITY;
#pragma unroll
    for (int i = 0; i < 16; ++i) { const int key = kb + (i & 3) + 8 * (i >> 2); const bool ok = MODE == 2 ? (colsel && key <= qp) : (key <= qp && key >= qp - 511); sv[i] = ok ? S[i] : -INFINITY; tmax = fmaxf(tmax, sv[i]); }
    tmax = half_max(tmax);
    const float mn = fmaxf(m, tmax); const float ms = mn == -INFINITY ? 0.f : mn;
    const float alpha = __builtin_amdgcn_exp2f(m - ms);
    float p[16]; float ps = 0.f;
#pragma unroll
    for (int i = 0; i < 16; ++i) { p[i] = __builtin_amdgcn_exp2f(sv[i] - ms); ps += p[i]; }
    l = l * alpha + half_sum(ps); m = mn;
#pragma unroll
    for (int dt = 0; dt < 2; ++dt)
#pragma unroll
        for (int i = 0; i < 16; ++i) O[dt][i] *= alpha;
    pv_tile(p, vf, O);
}
constexpr int NSA_RING0 = 16384;
static_assert(NSA_RING0 + 8 * 16384 <= LDS_SCRATCH, "attention LDS map");
__device__ __forceinline__ void phase_nsa(const Args& a, int qi, int l, LAS unsigned char* lds, int slot, int lane) {
    OPQ_SI(slot); OPQ_V(lane);
    unsigned char* ws = a.ws + opaque0();
    LAS float* impl = (LAS float*)(lds + slot * 2048);
    LAS unsigned char* RW = lds + NSA_RING0 + slot * 16384;
    const bf16* QR = (const bf16*)(ws + WS_QR); const float* P = (const float*)(ws + WS_P); const float* gate_b = INPTR(a, I_GB) + (size_t)l * 36; bf16* CAT = (bf16*)(ws + WS_CAT);
    unsigned* qctr = (unsigned*)(ws + WS_CTL) + 8192 + 64 * qi;
    const int r = lane & 31, h = lane >> 5, g = r & 3, ql = r >> 2;
    const unsigned koff = (unsigned)((lane >> 3) * 128 + (((lane & 7) ^ ((lane >> 3) & 7)) << 4)), voff = (unsigned)((lane >> 2) * 64 + (((lane & 3) ^ (((lane >> 2) >> 2) & 3)) << 4));
    const unsigned krd = (unsigned)(r * 128) | (unsigned)h, vrd = (unsigned)(r * 64);
    const int myx = (int)(xb_xcc_id() & 7u); int qsel = 0;
    for (;;) {
        int item = 0, qx = 0;
        for (;;) { qx = (myx + qsel) & 7; if (lane == 0) item = (int)atomicAdd(qctr + 8 * qx, 1u); item = __builtin_amdgcn_readfirstlane(item); if (item < 96 * 8 || qsel >= 7) break; ++qsel; }
        if (item >= 96 * 8) break;
        const int up = item >> 3, wave = item & 7, k3 = up / 3, e3 = up - 3 * k3;
        const int bk = e3 < 2 ? qx : 8 + (qx >> 1); const int qt = e3 == 0 ? 63 - 2 * k3 : (e3 == 1 ? 62 - 2 * k3 : 62 - 2 * k3 + (qx & 1));
        const int b = bk / 3, kvh = bk - b * 3;
        const int tile0 = qt * 64, cur = qt; const int qp = tile0 + 8 * wave + ql; const size_t mq = (size_t)b * SEQ + qp; const int head = kvh * 4 + g;
        bf16x8 qf[4];
#pragma unroll
        for (int ks = 0; ks < 4; ++ks) qf[ks] = *(const bf16x8*)(QR + mq * 768 + head * 64 + 16 * ks + 8 * h);
        float g0, g1, g2;
        { const float* gl = P + mq * INP + PO_GL + head * 3; const float* gb = gate_b + head * 3; g0 = sigmoidf_(gl[0] + gb[0]); g1 = sigmoidf_(gl[1] + gb[1]); g2 = sigmoidf_(gl[2] + gb[2]); }
        f32x16 out[2], O[2]; bf16x8 kf[4]; bf16x8 vf[2][2];
#pragma unroll
        for (int dt = 0; dt < 2; ++dt)
#pragma unroll
            for (int i = 0; i < 16; ++i) out[dt][i] = 0.f;
        unsigned long long mymask = (2ull << cur) - 1ull, umask = mymask;
        const int qpw = tile0 + 8 * wave + 7;
        {
            const bf16* Kb = (const bf16*)(ws + WS_KC) + (size_t)(b * 3 + kvh) * NCMPP * 64; const bf16* Vt = (const bf16*)(ws + WS_VCT) + (size_t)(b * 3 + kvh) * 8 * 2048;
            const int nvw = qpw >= 31 ? ((qpw - 31) >> 4) + 1 : 0; const int nvq = qp >= 31 ? ((qp - 31) >> 4) + 1 : 0; const int ntile = (nvw + 31) >> 5;
            const bool need_imp = cur >= 16;
            if (ntile > 0) {
                float m = -INFINITY, ls = 0.f;
                dma_tile<false>(RW, Kb, 0, koff, Vt, voff);
#pragma unroll 1
                for (int kt = 0; kt < ntile; ++kt) { read_tile<false>(RW, krd, vrd, kf, vf, false); if (kt + 1 < ntile) dma_tile<false>(RW, Kb, 32 * (kt + 1), koff, Vt, voff); else dma_tile<true>(RW, Kb, 0, koff, Vt, voff);
                    const f32x16 S = qk_tile(kf, qf);
                    float tmax = -INFINITY; float sv[16];
#pragma unroll
                    for (int i = 0; i < 16; ++i) { const int n = 32 * kt + (i & 3) + 8 * (i >> 2) + 4 * h; sv[i] = n < nvq ? S[i] : -INFINITY; tmax = fmaxf(tmax, sv[i]); }
                    tmax = half_max(tmax); const float mn = fmaxf(m, tmax); const float ms = mn == -INFINITY ? 0.f : mn; float ps = 0.f;
#pragma unroll
                    for (int i = 0; i < 16; ++i) ps += __builtin_amdgcn_exp2f(sv[i] - ms);
                    ls = ls * __builtin_amdgcn_exp2f(m - ms) + half_sum(ps); m = mn; }
                const float ms = m == -INFINITY ? 0.f : m; const float inv = 1.0f / fmaxf(ls, 1.17549435e-38f);
                float carry = 0.f;
#pragma unroll
                for (int dt = 0; dt < 2; ++dt)
#pragma unroll
                    for (int i = 0; i < 16; ++i) O[dt][i] = 0.f;
                if (need_imp) {
#pragma unroll
                    for (int i = 0; i < 8; ++i) impl[i * 64 + lane] = 0.f;
                    WSYNC(); }
#pragma unroll 1
                for (int kt = 0; kt < ntile; ++kt) {
                    read_tile<true>(RW, krd, vrd, kf, vf, false); if (kt + 1 < ntile) dma_tile<true>(RW, Kb, 32 * (kt + 1), koff, Vt, voff);
                    const f32x16 S = qk_tile(kf, qf);
                    float p[16];
#pragma unroll
                    for (int i = 0; i < 16; ++i) { const int n = 32 * kt + (i & 3) + 8 * (i >> 2) + 4 * h; p[i] = n < nvq ? __builtin_amdgcn_exp2f(S[i] - ms) * inv : 0.f; }
                    if (need_imp) {
                        float val[4];
#pragma unroll
                        for (int t = 0; t < 4; ++t) { const float sp = 0.5f * p[4 * t + 3]; const float base = (p[4 * t] + p[4 * t + 1]) + (p[4 * t + 2] + sp); const float rv = other_half(sp, h);
                            val[t] = base + (h ? rv : carry); carry = h ? 0.f : rv; }
#pragma unroll
                        for (int t = 0; t < 4; ++t) { float v = val[t]; v += dpp_f<0xB1>(v); v += dpp_f<0x4E>(v); if (g == 0) impl[ql * 64 + 8 * kt + 2 * t + h] = v; }
                    }
                    pv_tile(p, vf, O);
                }
#pragma unroll
                for (int dt = 0; dt < 2; ++dt)
#pragma unroll
                    for (int i = 0; i < 16; ++i) out[dt][i] = O[dt][i] * g0;
                if (need_imp) {
                    WSYNC();
#pragma unroll 1
                    for (int q = 0; q < 8; ++q) { const float v = impl[q * 64 + lane]; const bool forced = lane == 0 || lane == cur || lane == cur - 1; impl[q * 64 + lane] = lane > cur ? -INFINITY : (forced ? 1e9f : v); }
                    WSYNC();
                    umask = 0ull;
#pragma unroll 1
                    for (int q = 0; q < 8; ++q) { const float sc = impl[q * 64 + lane]; int rank = 0;
#pragma unroll 4
                        for (int i4 = 0; i4 < 16; ++i4) { const f32x4 o = *(const LAS f32x4*)(impl + q * 64 + 4 * i4);
                            rank += (o.x > sc || (o.x == sc && 4 * i4 + 0 < lane)) ? 1 : 0; rank += (o.y > sc || (o.y == sc && 4 * i4 + 1 < lane)) ? 1 : 0;
                            rank += (o.z > sc || (o.z == sc && 4 * i4 + 2 < lane)) ? 1 : 0; rank += (o.w > sc || (o.w == sc && 4 * i4 + 3 < lane)) ? 1 : 0; }
                        const unsigned long long mk = __ballot(lane <= cur && rank < 16);
                        umask |= mk; if (ql == q) mymask = mk; }
                    WSYNC();
                }
            }
        }
        {
            const bf16* Kb = (const bf16*)(ws + WS_KS) + (size_t)(b * 3 + kvh) * SEQ * 64; const bf16* Vt = (const bf16*)(ws + WS_VST) + (size_t)(b * 3 + kvh) * 128 * 2048;
            float m = -INFINITY, ls = 0.f;
#pragma unroll
            for (int dt = 0; dt < 2; ++dt)
#pragma unroll
                for (int i = 0; i < 16; ++i) O[dt][i] = 0.f;
            unsigned long long um = umask; int hf = 0;
#define SEL_NEXT(have, jb, key0) do { have = um != 0ull; if (have) { jb = __builtin_ctzll(um); key0 = 64 * jb + 32 * hf; if (hf == 0 && 64 * jb + 32 <= qpw) hf = 1; else { hf = 0; um &= um - 1ull; } } } while (0)
            bool h0, h1; int j0 = 0, k0 = 0, j1 = 0, k1 = 0, sl = 0;
            SEL_NEXT(h0, j0, k0); if (h0) dma_tile<true>(RW, Kb, k0, koff, Vt, voff);
            SEL_NEXT(h1, j1, k1); if (h1) dma_tile<true>(RW + 8192, Kb, k1, koff, Vt, voff);
#pragma unroll 1
            while (h0) {
                read_tile<true>(RW + sl * 8192, krd, vrd, kf, vf, h1);
                bool h2; int j2 = 0, k2 = 0; SEL_NEXT(h2, j2, k2); if (h2) dma_tile<true>(RW + sl * 8192, Kb, k2, koff, Vt, voff);
                const f32x16 S = qk_tile(kf, qf);
                att_rest<2>(S, vf, k0, h, qp, (mymask >> j0) & 1ull, m, ls, O);
                h0 = h1; j0 = j1; k0 = k1; h1 = h2; j1 = j2; k1 = k2; sl ^= 1;
            }
#undef SEL_NEXT
            const float sc = g1 / fmaxf(ls, 1.17549435e-38f);
#pragma unroll
            for (int dt = 0; dt < 2; ++dt)
#pragma unroll
                for (int i = 0; i < 16; ++i) out[dt][i] += O[dt][i] * sc;
        }
        {
            const bf16* Kb = (const bf16*)(ws + WS_KW) + (size_t)(b * 3 + kvh) * SEQ * 64; const bf16* Vt = (const bf16*)(ws + WS_VWT) + (size_t)(b * 3 + kvh) * 128 * 2048;
            float m = -INFINITY, ls = 0.f;
#pragma unroll
            for (int dt = 0; dt < 2; ++dt)
#pragma unroll
                for (int i = 0; i < 16; ++i) O[dt][i] = 0.f;
            const int q0w = tile0 + 8 * wave; const int lo = q0w - 511 > 0 ? q0w - 511 : 0;
            const int tEnd = (q0w + 7) >> 5; int t = lo >> 5;
            dma_tile<true>(RW, Kb, 32 * t, koff, Vt, voff); if (t + 1 <= tEnd) dma_tile<true>(RW + 8192, Kb, 32 * (t + 1), koff, Vt, voff);
            int sl = 0;
#pragma unroll 1
            for (; t <= tEnd; ++t) {
                read_tile<true>(RW + sl * 8192, krd, vrd, kf, vf, t + 1 <= tEnd);
                if (t + 2 <= tEnd) dma_tile<true>(RW + sl * 8192, Kb, 32 * (t + 2), koff, Vt, voff);
                const f32x16 S = qk_tile(kf, qf);
                att_rest<3>(S, vf, 32 * t, h, qp, true, m, ls, O);
                sl ^= 1;
            }
            const float sc = g2 / fmaxf(ls, 1.17549435e-38f);
            bf16* op = CAT + mq * DM + DRW + DPOOL + head * 64 + 4 * h;
#pragma unroll
            for (int dt = 0; dt < 2; ++dt)
#pragma unroll
                for (int t2 = 0; t2 < 4; ++t2) { u32x2 w; w.x = cvtpk(out[dt][4 * t2] + O[dt][4 * t2] * sc, out[dt][4 * t2 + 1] + O[dt][4 * t2 + 1] * sc); w.y = cvtpk(out[dt][4 * t2 + 2] + O[dt][4 * t2 + 2] * sc, out[dt][4 * t2 + 3] + O[dt][4 * t2 + 3] * sc);
                    *(u32x2*)(op + 32 * dt + 8 * t2) = w; }
        }
    }
}

__device__ __forceinline__ void phase_rwkv_out(const Args& a, int l, int gw, int NGW, int lane) {
    OPQ_SI(gw); OPQ_V(lane);
    unsigned char* ws = a.ws + opaque0(); const float* YS = (const float*)(ws + WS_YS); const float* vV = (const float*)(ws + WS_SV + 5 * SV_STRIDE); const float* vG = (const float*)(ws + WS_G); const float* SC = (const float*)(ws + WS_SC);
    const float* gng = INPTR(a, I_GNG) + (size_t)l * DRW; const float* gnb = INPTR(a, I_GNB) + (size_t)l * DRW; bf16* CAT = (bf16*)(ws + WS_CAT);
    for (int id = gw; id < MTOK * 12; id += NGW) { const int m = id / 12, h = id - m * 12, c = h * 64 + lane; const size_t o = (size_t)m * DRW + c;
        const float y = YS[o]; const float mean = wave_sum(y) * (1.f / 64.f); const float d = y - mean; const float var = wave_sum(d * d) * (1.f / 64.f);
        const float yn = d * (1.f / sqrtf(var + GN_EPS)) * gng[c] + gnb[c]; const float bonus = SC[((size_t)m * 12 + h) * 4 + 2] * vV[o];
        CAT[(size_t)m * DM + c] = (bf16)f2bf((yn + bonus) * vG[o]); }
}

template <int PHMASK> __global__ void __launch_bounds__(NTHR, 2) fwd(Args args) {
    extern __shared__ __attribute__((aligned(16))) unsigned char lds_raw[];
    LAS unsigned char* lds = (LAS unsigned char*)lds_raw;
    const int tid = threadIdx.x, lane = tid & 63, wave = __builtin_amdgcn_readfirstlane(tid >> 6);
    const int G = gridDim.x, bid = blockIdx.x; const int gw = bid * NWAVES + wave, NGW = G * NWAVES;
    unsigned char* ws = args.ws;
    for (int u = tid; u < (LDS_BYTES - LDS_SCRATCH) / 4; u += NTHR) ((LAS unsigned*)(lds + LDS_SCRATCH))[u] = 0u;
    __syncthreads();
    const int lo = args.ph_lo, hi = args.ph_hi;
    XcdBarrier bar; bar.bar = (unsigned*)(ws + WS_CTL) + 4096; bar.x = 0; bar.st = nullptr;
    if (hi - lo > 1) bar = xcd_barrier_post((unsigned*)(ws + WS_CTL) + 4096, (volatile LAS unsigned*)(lds + MISC_OFF) + 8);
#define IN(k) (lo <= (k) && (k) < hi)
#define PHEN(j) (((PHMASK) >> (j)) & 1)
#ifndef REP_MASK
#define REP_MASK 0
#endif
#define SEAM(k) do { if ((k) + 1 < hi) xcd_barrier(bar); } while (0)
    bf16* XB = (bf16*)(ws + WS_XB); bf16* Hb = (bf16*)(ws + WS_H); float* Y = (float*)(ws + WS_Y); float* Pm = (float*)(ws + WS_P); bf16* CAT = (bf16*)(ws + WS_CAT);

    if (PHEN(0) && IN(0)) { phase_prologue(args, bid * NTHR + tid, G * NTHR); SEAM(0); }
    for (int l = 0; l < NLAYER; ++l) {
        const int pb = 1 + 13 * l;
        for (int rep = 0; rep < (((REP_MASK) >> 1) & 1 ? 2 : 1); ++rep) if (PHEN(1) && IN(pb + 0)) { phase_wconv(args, l, lds, gw, NGW, wave, lane); SEAM(pb + 0); }
        for (int rep = 0; rep < (((REP_MASK) >> 2) & 1 ? 2 : 1); ++rep) if (PHEN(2) && IN(pb + 1)) {
            pg8::Gemm g{XB, (const bf16*)(ws + WS_WUP1), MTOK, NUP, DM}; pg8::StaticOrder S; S.init(MTOK, NUP, G, bid); pg8::EpiSwiGLU E{Hb, DFF};
            pg8::gemm_phase<pg8::EpiSwiGLU, pg8::StaticOrder, true, true>(lds, g, S, E); SEAM(pb + 1); }
        for (int rep = 0; rep < (((REP_MASK) >> 3) & 1 ? 2 : 1); ++rep) if (PHEN(3) && IN(pb + 2)) {
            pg8::Gemm g{Hb, (const bf16*)(ws + WS_WDN1), MTOK, DM, DFF}; pg8::StaticOrder S; S.init(MTOK, DM, G, bid); pg8::EpiResid E{l == 0 ? INPTR(args, I_X) : args.out, Y, DM, ALPHA, 0.5f};
            pg8::gemm_phase<pg8::EpiResid, pg8::StaticOrder, true, true>(lds, g, S, E); SEAM(pb + 2); }
        for (int rep = 0; rep < (((REP_MASK) >> 4) & 1 ? 2 : 1); ++rep) if (PHEN(4) && IN(pb + 3)) { phase_ln(Y, INPTR(args, I_LN1G) + (size_t)l * DM, INPTR(args, I_LN1B) + (size_t)l * DM, args.out, XB, gw, NGW, lane); SEAM(pb + 3); }
        for (int rep = 0; rep < (((REP_MASK) >> 5) & 1 ? 2 : 1); ++rep) if (PHEN(5) && IN(pb + 4)) {
            pg8::Gemm g{XB, (const bf16*)(ws + WS_WIN), MTOK, INP, DM}; pg8::StaticOrder S; S.init(MTOK, INP, G, bid); pg8::EpiF32 E{Pm, INP};
            pg8::gemm_phase<pg8::EpiF32, pg8::StaticOrder, true, true>(lds, g, S, E); SEAM(pb + 4); }
        for (int rep = 0; rep < (((REP_MASK) >> 6) & 1 ? 2 : 1); ++rep) if (PHEN(6) && IN(pb + 5)) { phase_m1(args, l, lds, bid, G, tid, wave, lane); SEAM(pb + 5); }
        for (int rep = 0; rep < (((REP_MASK) >> 7) & 1 ? 2 : 1); ++rep) if (PHEN(7) && IN(pb + 6)) { for (int r2 = 0; r2 < (((REP_MASK) >> 20) & 1 ? 2 : 1); ++r2) { if (bid < SCAN_WGS) { phase_scan(args, lds, bid, tid, wave, lane); __syncthreads(); } } for (int r3 = 0; r3 < (((REP_MASK) >> 21) & 1 ? 2 : 1); ++r3) phase_nsa(args, l + 4 * rep + 8 * r3, l, lds, wave, lane); SEAM(pb + 6); }
        for (int rep = 0; rep < (((REP_MASK) >> 8) & 1 ? 2 : 1); ++rep) if (PHEN(8) && IN(pb + 7)) { phase_rwkv_out(args, l, gw, NGW, lane); SEAM(pb + 7); }
        for (int rep = 0; rep < (((REP_MASK) >> 9) & 1 ? 2 : 1); ++rep) if (PHEN(9) && IN(pb + 8)) {
            pg8::Gemm g{CAT, (const bf16*)(ws + WS_WOUT), MTOK, DM, DM}; pg8::StaticOrder S; S.init(MTOK, DM, G, bid); pg8::EpiResid E{args.out, Y, DM, ALPHA, 1.0f};
            pg8::gemm_phase<pg8::EpiResid, pg8::StaticOrder, true, true>(lds, g, S, E); SEAM(pb + 8); }
        for (int rep = 0; rep < (((REP_MASK) >> 10) & 1 ? 2 : 1); ++rep) if (PHEN(10) && IN(pb + 9)) { phase_ln(Y, INPTR(args, I_LN2G) + (size_t)l * DM, INPTR(args, I_LN2B) + (size_t)l * DM, args.out, XB, gw, NGW, lane); SEAM(pb + 9); }
        for (int rep = 0; rep < (((REP_MASK) >> 11) & 1 ? 2 : 1); ++rep) if (PHEN(11) && IN(pb + 10)) {
            pg8::Gemm g{XB, (const bf16*)(ws + WS_WUP2), MTOK, NUP, DM}; pg8::StaticOrder S; S.init(MTOK, NUP, G, bid); pg8::EpiSwiGLU E{Hb, DFF};
            pg8::gemm_phase<pg8::EpiSwiGLU, pg8::StaticOrder, true, true>(lds, g, S, E); SEAM(pb + 10); }
        for (int rep = 0; rep < (((REP_MASK) >> 12) & 1 ? 2 : 1); ++rep) if (PHEN(12) && IN(pb + 11)) {
            pg8::Gemm g{Hb, (const bf16*)(ws + WS_WDN2), MTOK, DM, DFF}; pg8::StaticOrder S; S.init(MTOK, DM, G, bid); pg8::EpiResid E{args.out, Y, DM, ALPHA, 0.5f};
            pg8::gemm_phase<pg8::EpiResid, pg8::StaticOrder, true, true>(lds, g, S, E); SEAM(pb + 11); }
        for (int rep = 0; rep < (((REP_MASK) >> 13) & 1 ? 2 : 1); ++rep) if (PHEN(13) && IN(pb + 12)) { phase_ln(Y, INPTR(args, I_LN3G) + (size_t)l * DM, INPTR(args, I_LN3B) + (size_t)l * DM, args.out, XB, gw, NGW, lane); SEAM(pb + 12); }
    }
#undef IN
#undef SEAM
}

#ifndef ONE_MASK
#define ONE_MASK 0xFFFFF
#endif
#ifndef MK_ONE_LAUNCH
#define MK_ONE_LAUNCH 1
#endif
typedef void (*kern_t)(Args);
extern "C" void kernel_launch(void* const* d_in, const int* in_sizes, int n_in, void* d_out, int out_size, void* d_ws, size_t ws_size, hipStream_t stream) {
    static int grid = 0;
#if MK_ONE_LAUNCH
    static const kern_t kerns[1] = {fwd<ONE_MASK>};
    constexpr int NK = 1;
#else
    static const kern_t kerns[14] = {fwd<1 << 0>, fwd<1 << 1>, fwd<1 << 2>, fwd<1 << 3>, fwd<1 << 4>, fwd<1 << 5>, fwd<1 << 6>, fwd<1 << 7>, fwd<1 << 8>, fwd<1 << 9>, fwd<1 << 10>, fwd<1 << 11>, fwd<1 << 12>, fwd<1 << 13>};
    constexpr int NK = 14;
#endif
    if (grid == 0) {
        if (n_in != 34 || out_size != MTOK * DM || ws_size < WS_END) { fprintf(stderr, "kernel_launch: unexpected shapes (n_in %d, out %d, ws %zu; need ws >= %zu)\n", n_in, out_size, ws_size, (size_t)WS_END); grid = -1; return; }
        int dev = 0, cus = 0;
        if (hipGetDevice(&dev) != hipSuccess || hipDeviceGetAttribute(&cus, hipDeviceAttributeMultiprocessorCount, dev) != hipSuccess) { grid = -1; return; }
        for (int i = 0; i < NK; ++i) if (hipFuncSetAttribute((const void*)kerns[i], hipFuncAttributeMaxDynamicSharedMemorySize, LDS_BYTES) != hipSuccess) { fprintf(stderr, "kernel_launch: hipFuncSetAttribute failed\n"); grid = -1; return; }
        int per_cu = 0;
        if (hipOccupancyMaxActiveBlocksPerMultiprocessor(&per_cu, (const void*)kerns[0], NTHR, LDS_BYTES) != hipSuccess || per_cu < 1) fprintf(stderr, "kernel_launch: occupancy query says %d blocks per CU\n", per_cu);
        (void)hipGetLastError();
        grid = cus;
    }
    if (grid < 0) return;
    (void)hipMemsetAsync((char*)d_ws + WS_CTL, 0, CTL_ZERO_BYTES, stream);
    Args a{};
    for (int i = 0; i < 34; ++i) a.in[i] = (const float*)d_in[i];
    a.out = (float*)d_out; a.ws = (unsigned char*)d_ws;
#if MK_ONE_LAUNCH
    a.ph_lo = 0; a.ph_hi = NPH;
    hipLaunchKernelGGL(kerns[0], dim3(grid), dim3(NTHR), LDS_BYTES, stream, a);
#else
#ifndef HOST_REP
#define HOST_REP 0
#endif
    for (int k = 0; k < NPH; ++k) { a.ph_lo = k; a.ph_hi = k + 1; const int j = k == 0 ? 0 : (k - 1) % 13 + 1;
        for (int rep = 0; rep < (((HOST_REP) >> j) & 1 ? 2 : 1); ++rep) {
            if (rep && j == 7) (void)hipMemsetAsync((char*)d_ws + WS_CTL + (8192 + 64 * ((k - 1) / 13)) * 4, 0, 256, stream);
            hipLaunchKernelGGL(kerns[j], dim3(grid), dim3(NTHR), LDS_BYTES, stream, a); } }
#endif
}
```

```cpp
#include <hip/hip_runtime.h>
#include <cstdio>
#include <cstdint>
namespace pg8 {
#define PG8_LAS __attribute__((address_space(3)))
typedef unsigned short bf16_t;
typedef short bf16x8 __attribute__((ext_vector_type(8)));
typedef float f32x4 __attribute__((ext_vector_type(4)));
typedef unsigned u32x4 __attribute__((ext_vector_type(4)));
constexpr int BM = 256, BK = 64, HALF = 128, HTB = HALF * BK * 2  , STAGE_BYTES = 8 * HTB, NXCD = 8, WGM = 8;

__host__ __device__ __forceinline__ int lds_byte(int r, int c) { const int st = (r >> 4) * 2 + (c >> 5), rr = r & 15, cc = c & 31, ob = rr * 64 + cc * 2; return st * 1024 + (ob ^ (((ob >> 9) & 1) << 5)); }
__host__ __device__ __forceinline__ void stage_rc(int b, int& R, int& C) { const int st = b / 1024, sb = b % 1024, swz = sb ^ (((sb >> 9) & 1) << 5); R = (st >> 1) * 16 + swz / 64; C = (st & 1) * 32 + (swz % 64) / 2; }
__host__ __device__ __forceinline__ int perm32(int rho) { const int n = rho >> 4, i = rho & 15; return 8 * (i >> 2) + 4 * n + (i & 3); }

struct Unit { int pm, pn; };
struct Gemm { const bf16_t* A; const bf16_t* Bt; int M, N, K; };

struct StaticOrder {
    int nM, nN, nwg, G, c;
    __host__ __device__ void init(int M, int N, int G_, int c_) { nM = M / BM; nN = N / BM; nwg = nM * nN; G = G_; c = c_; }
    __host__ __device__ bool next(int i, Unit& u) const {
        const long L = (long)i * G + c; if (L >= nwg) return false;
        int wgid = (int)L; { const int q = nwg / NXCD, r = nwg % NXCD, xcd = wgid % NXCD, off = wgid / NXCD; wgid = (xcd < r ? xcd * (q + 1) : r * (q + 1) + (xcd - r) * q) + off; }
        const int nig = WGM * nN, gid = wgid / nig, fm = gid * WGM, gsz = (nM - fm) < WGM ? (nM - fm) : WGM;
        u.pm = fm + ((wgid % nig) % gsz); u.pn = (wgid % nig) / gsz; return true;
    }
    __device__ __forceinline__ void a_ready(const Unit&) const {}
    __device__ __forceinline__ void done(const Unit&) const {}
};

__device__ __forceinline__ unsigned cvt_pk_bf16(float lo, float hi) { unsigned r; asm volatile("v_cvt_pk_bf16_f32 %0, %1, %2" : "=v"(r) : "v"(lo), "v"(hi)); return r; }
typedef float f32x2 __attribute__((ext_vector_type(2)));
struct EpiSwiGLU {
    static constexpr bool PERM = true, AFTER_DRAIN = false;
    bf16_t* H; int ldh;
    __device__ __forceinline__ void operator()(const f32x4 (&acc)[2][2][4][2], const Unit& u, int wr, int wc, int fr, int fq) const {
        const int row0 = u.pm * BM + wr * 64 + fr, col0 = u.pn * HALF + wc * 32 + 8 * fq;
#pragma unroll
        for (int ai = 0; ai < 2; ++ai)
#pragma unroll
            for (int m = 0; m < 4; ++m) { bf16_t* rowp = H + (size_t)(row0 + ai * HALF + m * 16) * ldh + col0;
                float hv[8];
#pragma unroll
                for (int n = 0; n < 2; ++n)
#pragma unroll
                    for (int i = 0; i < 4; ++i) { const float a = acc[ai][0][m][n][i], b = acc[ai][1][m][n][i];
                        const float e = __builtin_amdgcn_exp2f(a * -1.44269504089f); hv[n * 4 + i] = a * __builtin_amdgcn_rcpf(1.0f + e) * b; }
                u32x4 w; w.x = cvt_pk_bf16(hv[0], hv[1]); w.y = cvt_pk_bf16(hv[2], hv[3]); w.z = cvt_pk_bf16(hv[4], hv[5]); w.w = cvt_pk_bf16(hv[6], hv[7]);
                *(u32x4*)rowp = w; }
    }
};
struct EpiResid {
    static constexpr bool PERM = false, AFTER_DRAIN = false;
    const float* X; float* Y; int ldc; float alpha, s;
    __device__ __forceinline__ void operator()(const f32x4 (&acc)[2][2][4][2], const Unit& u, int wr, int wc, int fr, int fq) const {
        const int row0 = u.pm * BM + wr * 64 + fr, col0 = u.pn * BM + wc * 32 + 4 * fq;
#pragma unroll
        for (int ai = 0; ai < 2; ++ai)
#pragma unroll
            for (int m = 0; m < 4; ++m) { const size_t off = (size_t)(row0 + ai * HALF + m * 16) * ldc + col0;
#pragma unroll
                for (int bj = 0; bj < 2; ++bj)
#pragma unroll
                    for (int n = 0; n < 2; ++n) { const f32x4 xv = *(const f32x4*)(X + off + bj * HALF + n * 16); *(f32x4*)(Y + off + bj * HALF + n * 16) = xv * alpha + acc[ai][bj][m][n] * s; }
                asm volatile("" ::: "memory"); }
    }
};
struct EpiF32 {
    static constexpr bool PERM = false, AFTER_DRAIN = false;
    float* C; int ldc;
    __device__ __forceinline__ void operator()(const f32x4 (&acc)[2][2][4][2], const Unit& u, int wr, int wc, int fr, int fq) const {
        const int row0 = u.pm * BM + wr * 64 + fr, col0 = u.pn * BM + wc * 32 + 4 * fq;
#pragma unroll
        for (int ai = 0; ai < 2; ++ai)
#pragma unroll
            for (int m = 0; m < 4; ++m) { float* rowp = C + (size_t)(row0 + ai * HALF + m * 16) * ldc + col0;
#pragma unroll
                for (int bj = 0; bj < 2; ++bj)
#pragma unroll
                    for (int n = 0; n < 2; ++n) *(f32x4*)(rowp + bj * HALF + n * 16) = acc[ai][bj][m][n]; }
    }
};

template <class Epi, class Sched, bool ALIGN_EPI = false, bool SP2 = false>
__device__ __forceinline__ void gemm_phase(PG8_LAS unsigned char* lds, const Gemm g, const Sched& S, const Epi& E) {
    int tid_ = threadIdx.x; asm volatile("" : "+v"(tid_));
    const int tid = tid_, wid = __builtin_amdgcn_readfirstlane(tid >> 6), lane = tid & 63, wr = wid >> 2, wc = wid & 3, fr = lane & 15, fq = lane >> 4;
    const int K = g.K, nt = K / BK;
    unsigned voffA[2], voffB[2];
#pragma unroll
    for (int i = 0; i < 2; ++i) { int R, C; stage_rc(tid * 16 + i * 8192, R, C); const int Rb = Epi::PERM ? ((R & ~31) + perm32(R & 31)) : R;
        voffA[i] = (unsigned)(R * K + C) * 2u; voffB[i] = (unsigned)(Rb * K + C) * 2u; }
    const size_t kstep = (size_t)(BK * 2);
    const size_t hstep = (size_t)HALF * K * 2;
    const size_t tstep = 2 * hstep;
    const unsigned ldsw = (unsigned)wid * 1024u;
    const int aoff = lds_byte(wr * 64 + fr, fq * 8), boff = lds_byte(wc * 32 + fr, fq * 8);
#define PG8_SA(b, h) (((b) * 2 + (h)) * HTB)
#define PG8_SB(b, h) ((4 + (b) * 2 + (h)) * HTB)
#define PG8_STAGE(bufoff, gbase, voff) do { _Pragma("unroll") for (int _i = 0; _i < 2; ++_i) \
        __builtin_amdgcn_global_load_lds((const unsigned*)((const char*)(gbase) + (voff)[_i]), (PG8_LAS unsigned*)(lds + (bufoff) + ldsw + _i * 8192), 16, 0, 0); } while (0)
#define PG8_LDA(dst, b, h) do { _Pragma("unroll") for (int m = 0; m < 4; ++m) _Pragma("unroll") for (int k = 0; k < 2; ++k) dst[m][k] = *(const PG8_LAS bf16x8*)(lds + PG8_SA(b, h) + aoff + m * 2048 + k * 1024); } while (0)
#define PG8_LDB(dst, b, h) do { _Pragma("unroll") for (int n = 0; n < 2; ++n) _Pragma("unroll") for (int k = 0; k < 2; ++k) dst[n][k] = *(const PG8_LAS bf16x8*)(lds + PG8_SB(b, h) + boff + n * 2048 + k * 1024); } while (0)
#define PG8_MMA(ai, bj, At, Bt) do { __builtin_amdgcn_s_setprio(1); _Pragma("unroll") for (int m = 0; m < 4; ++m) _Pragma("unroll") for (int n = 0; n < 2; ++n) _Pragma("unroll") for (int k = 0; k < 2; ++k) \
        acc[ai][bj][m][n] = __builtin_amdgcn_mfma_f32_16x16x32_bf16(Bt[n][k], At[m][k], acc[ai][bj][m][n], 0, 0, 0); __builtin_amdgcn_s_setprio(0); } while (0)
#define PG8_WAIT_V(n) asm volatile("s_waitcnt vmcnt(" #n ")" ::: "memory")
#define PG8_WAIT_L(n) asm volatile("s_waitcnt lgkmcnt(" #n ")" ::: "memory")
#define PG8_BAR __builtin_amdgcn_s_barrier()
#define PG8_SCHED __builtin_amdgcn_sched_barrier(0)
    Unit cur, nxt; int ui = 0;
    if (!S.next(0, cur)) return;
    f32x4 acc[2][2][4][2];
#pragma unroll
    for (int a = 0; a < 2; ++a)
#pragma unroll
        for (int b = 0; b < 2; ++b)
#pragma unroll
            for (int m = 0; m < 4; ++m)
#pragma unroll
                for (int n = 0; n < 2; ++n) acc[a][b][m][n] = (f32x4){0.f, 0.f, 0.f, 0.f};
    bf16x8 At[4][2], B0[2][2], B1[2][2];
    const char* cA = (const char*)g.A + (size_t)cur.pm * tstep; const char* cB = (const char*)g.Bt + (size_t)cur.pn * tstep;
    S.a_ready(cur);
    if constexpr (SP2) {
        PG8_STAGE(PG8_SB(0, 0), cB, voffB); PG8_STAGE(PG8_SB(0, 1), cB + hstep, voffB); PG8_STAGE(PG8_SA(0, 0), cA, voffA); PG8_STAGE(PG8_SA(0, 1), cA + hstep, voffA);
        if (wr == 1) PG8_BAR;
        PG8_WAIT_V(2); PG8_BAR;
        PG8_STAGE(PG8_SB(1, 0), cB + kstep, voffB); PG8_STAGE(PG8_SA(1, 0), cA + kstep, voffA); PG8_STAGE(PG8_SB(1, 1), cB + hstep + kstep, voffB);
        PG8_WAIT_V(6); PG8_BAR;
    } else {
        PG8_STAGE(PG8_SB(0, 0), cB, voffB); PG8_STAGE(PG8_SA(0, 0), cA, voffA); PG8_STAGE(PG8_SB(0, 1), cB + hstep, voffB); PG8_STAGE(PG8_SA(0, 1), cA + hstep, voffA);
        if (wr == 1) PG8_BAR;
        PG8_WAIT_V(4); PG8_BAR;
        PG8_STAGE(PG8_SB(1, 0), cB + kstep, voffB); PG8_STAGE(PG8_SA(1, 0), cA + kstep, voffA); PG8_STAGE(PG8_SB(1, 1), cB + hstep + kstep, voffB);
        PG8_WAIT_V(6); PG8_BAR;
    }
    for (;;) {
        const bool has_next = S.next(ui + 1, nxt);
        const char* nA = has_next ? (const char*)g.A + (size_t)nxt.pm * tstep : cA; const char* nB = has_next ? (const char*)g.Bt + (size_t)nxt.pn * tstep : cB;
        for (int t = 0; t < nt; t += 2) {
            const bool last = (t == nt - 2);
            const char* a1 = cA + (size_t)(t + 1) * kstep;
            const char* a2 = last ? nA : cA + (size_t)(t + 2) * kstep; const char* b2 = last ? nB : cB + (size_t)(t + 2) * kstep;
            const char* a3 = a2 + kstep; const char* b3 = b2 + kstep;
            if (last && has_next) S.a_ready(nxt);
            if constexpr (SP2) {
            PG8_LDB(B0, 0, 0); PG8_LDB(B1, 0, 1); PG8_SCHED; PG8_LDA(At, 0, 0); PG8_STAGE(PG8_SA(1, 1), a1 + hstep, voffA);
            PG8_WAIT_V(8); PG8_WAIT_L(0); PG8_BAR; PG8_MMA(0, 0, At, B0); PG8_MMA(0, 1, At, B1); PG8_BAR; PG8_SCHED;
            PG8_LDA(At, 0, 1); PG8_STAGE(PG8_SB(0, 0), b2, voffB); PG8_STAGE(PG8_SB(0, 1), b2 + hstep, voffB); PG8_STAGE(PG8_SA(0, 0), a2, voffA);
            PG8_WAIT_V(8); PG8_WAIT_L(0); PG8_BAR; PG8_MMA(1, 0, At, B0); PG8_MMA(1, 1, At, B1); PG8_BAR; PG8_SCHED;
            PG8_LDB(B0, 1, 0); PG8_LDB(B1, 1, 1); PG8_SCHED; PG8_LDA(At, 1, 0); PG8_STAGE(PG8_SA(0, 1), a2 + hstep, voffA);
            PG8_WAIT_V(8); PG8_WAIT_L(0); PG8_BAR; PG8_MMA(0, 0, At, B0); PG8_MMA(0, 1, At, B1); PG8_BAR; PG8_SCHED;
            PG8_LDA(At, 1, 1); PG8_STAGE(PG8_SB(1, 0), b3, voffB); PG8_STAGE(PG8_SB(1, 1), b3 + hstep, voffB); PG8_STAGE(PG8_SA(1, 0), a3, voffA);
            PG8_WAIT_V(8); PG8_WAIT_L(0); PG8_BAR; PG8_MMA(1, 0, At, B0); PG8_MMA(1, 1, At, B1); PG8_BAR; PG8_SCHED;
            } else {
            PG8_LDB(B0, 0, 0); PG8_SCHED; PG8_LDA(At, 0, 0); PG8_STAGE(PG8_SA(1, 1), a1 + hstep, voffA);
            PG8_WAIT_L(8); PG8_BAR; PG8_WAIT_L(0); PG8_MMA(0, 0, At, B0); PG8_BAR; PG8_SCHED;
            PG8_LDB(B1, 0, 1); PG8_STAGE(PG8_SB(0, 0), b2, voffB);
            PG8_BAR; PG8_WAIT_L(0); PG8_MMA(0, 1, At, B1); PG8_BAR;
            PG8_LDA(At, 0, 1); PG8_STAGE(PG8_SA(0, 0), a2, voffA);
            PG8_BAR; PG8_WAIT_L(0); PG8_MMA(1, 0, At, B0); PG8_BAR; PG8_SCHED;
            PG8_STAGE(PG8_SB(0, 1), b2 + hstep, voffB);
            PG8_WAIT_V(6); PG8_BAR; PG8_MMA(1, 1, At, B1); PG8_BAR;
            PG8_LDB(B0, 1, 0); PG8_SCHED; PG8_LDA(At, 1, 0); PG8_STAGE(PG8_SA(0, 1), a2 + hstep, voffA);
            PG8_WAIT_L(8); PG8_BAR; PG8_WAIT_L(0); PG8_MMA(0, 0, At, B0); PG8_BAR; PG8_SCHED;
            PG8_LDB(B1, 1, 1); PG8_STAGE(PG8_SB(1, 0), b3, voffB);
            PG8_BAR; PG8_WAIT_L(0); PG8_MMA(0, 1, At, B1); PG8_BAR;
            PG8_LDA(At, 1, 1); PG8_STAGE(PG8_SA(1, 0), a3, voffA);
            PG8_BAR; PG8_WAIT_L(0); PG8_MMA(1, 0, At, B0); PG8_BAR; PG8_SCHED;
            PG8_STAGE(PG8_SB(1, 1), b3 + hstep, voffB);
            PG8_WAIT_V(6); PG8_BAR; PG8_MMA(1, 1, At, B1); PG8_BAR;
            }
        }
        if constexpr (ALIGN_EPI) { if (wr == 0) PG8_BAR; }
        if constexpr (!Epi::AFTER_DRAIN) { E(acc, cur, wr, wc, fr, fq); S.done(cur); }
        if (!has_next) break;
#pragma unroll
        for (int a = 0; a < 2; ++a)
#pragma unroll
            for (int b = 0; b < 2; ++b)
#pragma unroll
                for (int m = 0; m < 4; ++m)
#pragma unroll
                    for (int n = 0; n < 2; ++n) acc[a][b][m][n] = (f32x4){0.f, 0.f, 0.f, 0.f};
        cur = nxt; cA = nA; cB = nB; ++ui;
        if constexpr (ALIGN_EPI) { if (wr == 1) PG8_BAR; }
    }
    PG8_WAIT_V(0);
    if constexpr (!ALIGN_EPI) { if (wr == 0) PG8_BAR; }
    PG8_BAR;
    if constexpr (Epi::AFTER_DRAIN) { E.fused(acc, cur, wr, wc, fr, fq, lds, wid, lane); S.done(cur); }
#undef PG8_SA
#undef PG8_SB
#undef PG8_STAGE
#undef PG8_LDA
#undef PG8_LDB
#undef PG8_MMA
#undef PG8_WAIT_V
#undef PG8_WAIT_L
#undef PG8_BAR
#undef PG8_SCHED
}
}

constexpr int NWAVES = 8, NTHR = 512;
constexpr int NB = 4, SEQ = 4096, DM = 2048, MTOK = NB * SEQ, NLAYER = 4;
constexpr int DFF = 5504, NUP = 2 * DFF;
constexpr int INC = 5028, INP = 5120;
constexpr int DRW = 768, RWC = 2560, PO_POOL = 2560, DPOOL = 512, PO_NSA = 3072;
constexpr int PO_Q = PO_NSA, PO_KC = PO_NSA + 768, PO_VC = PO_KC + 192, PO_KS = PO_VC + 192, PO_VS = PO_KS + 192, PO_KW = PO_VS + 192, PO_VW = PO_KW + 192, PO_GL = PO_VW + 192;
static_assert(PO_GL + 36 == INC, "W_in column map");
constexpr int NCMP = 255, NCMPP = 256;
constexpr float ALPHA = 1.6817928305074290f;
constexpr float LN_EPS = 1e-5f, GN_EPS = 64e-5f;
constexpr int NPH = 1 + 14 * NLAYER;

constexpr size_t MiB = 1u << 20;
constexpr size_t WS_CTL = 0, CTL_ZERO_BYTES = 1 * MiB;
constexpr size_t WS_ROPE = 1 * MiB;
constexpr size_t WS_KC = 2 * MiB, WS_VC = 2 * MiB + 512 * 1024;
constexpr size_t WS_SC = 3 * MiB;
constexpr size_t WS_WUP1 = 8 * MiB, WS_WDN1 = 51 * MiB, WS_WIN = WS_WDN1 + 21 * MiB + 512 * 1024, WS_WOUT = WS_WIN + 20 * MiB, WS_WUP2 = WS_WOUT + 8 * MiB, WS_WDN2 = WS_WUP2 + 43 * MiB;
constexpr size_t WS_XB = 165 * MiB;
static_assert(WS_WDN2 + (size_t)DM * DFF * 2 <= WS_XB, "weights map");
constexpr size_t WS_CAT = 229 * MiB;
constexpr size_t WS_QR = 293 * MiB;
constexpr size_t WS_KS = 317 * MiB, WS_KW = 323 * MiB, WS_VS = 329 * MiB, WS_VW = 335 * MiB;
constexpr size_t WS_P = 341 * MiB;
constexpr size_t WS_H = 661 * MiB;
constexpr size_t WS_Y = 833 * MiB;
constexpr size_t WS_SV = WS_H;
constexpr size_t SV_STRIDE = 48 * MiB;
static_assert(WS_SV + 6 * SV_STRIDE <= WS_Y + 128 * MiB, "scan overlay");
constexpr size_t WS_G = 961 * MiB, WS_YS = 1009 * MiB;
constexpr size_t WS_VST = 1057 * MiB, WS_VWT = 1063 * MiB;
constexpr size_t WS_VCT = 6 * MiB;
constexpr size_t WS_SW = 1069 * MiB;
constexpr size_t WS_W2T = WS_SW, WS_A2T = WS_W2T + 768 * 64 * 2, WS_G2T = WS_A2T + 768 * 64 * 2, WS_PWT = WS_G2T + 768 * 128 * 2;
constexpr size_t WS_W1T = WS_PWT + 4 * 128 * 128 * 2, WS_W2CT = WS_W1T + 2 * 256 * 2048 * 2, WS_CBIAS = WS_W2CT + 2 * 64 * 256 * 2;
constexpr size_t WS_SPREC = 1073 * MiB;
constexpr size_t SPREC_BYTES = 15360, WS_END = WS_SPREC + (size_t)NB * 12 * 256 * SPREC_BYTES + MiB;
static_assert(WS_CBIAS + 2 * 256 * 4 <= WS_END, "small weights map");

constexpr int LDS_SCRATCH = 147456;
constexpr int LDS_BYTES = LDS_SCRATCH + 1024, MISC_OFF = LDS_SCRATCH + 320;

#define GAS __attribute__((address_space(1)))
#define LAS __attribute__((address_space(3)))
typedef unsigned short bf16;
typedef float f32x4 __attribute__((ext_vector_type(4)));
typedef float f32x2 __attribute__((ext_vector_type(2)));
typedef unsigned u32x4 __attribute__((ext_vector_type(4)));
typedef unsigned u32x2 __attribute__((ext_vector_type(2)));
#define LDS_WAIT() asm volatile("s_waitcnt lgkmcnt(0)" ::: "memory")
__device__ __forceinline__ unsigned f2bf(float f) { unsigned u = __builtin_bit_cast(unsigned, f); return (u + 0x7fffu + ((u >> 16) & 1u)) >> 16; }
__device__ __forceinline__ unsigned pk2(float lo, float hi) { return f2bf(lo) | (f2bf(hi) << 16); }
__device__ __forceinline__ float bf2f(unsigned short b) { return __builtin_bit_cast(float, ((unsigned)b) << 16); }
__device__ __forceinline__ float wave_sum(float v) {
#pragma unroll
    for (int o = 1; o < 64; o <<= 1) v += __shfl_xor(v, o);
    return v;
}
__device__ __forceinline__ float wave_max(float v) {
#pragma unroll
    for (int o = 1; o < 64; o <<= 1) v = fmaxf(v, __shfl_xor(v, o));
    return v;
}
__device__ __forceinline__ float sigmoidf_(float x) { return 1.0f / (1.0f + expf(-x)); }
template <int CTRL> __device__ __forceinline__ float dpp_f(float v) { return __builtin_bit_cast(float, __builtin_amdgcn_update_dpp(0, __builtin_bit_cast(int, v), CTRL, 0xF, 0xF, true)); }
__device__ __forceinline__ float row16_sum(float v) {
    v += dpp_f<0xB1>(v); v += dpp_f<0x4E>(v); v += dpp_f<0x141>(v); v += dpp_f<0x140>(v); return v;
}

#define XB_TMO      128
#define XB_XCNT(j)  (256  + 64 * (j))
#define XB_XSUB(j)  (1280 + 64 * (j))
#define XB_XGEN(j)  (2304 + 64 * (j))
#define XB_TOP      3328
#define XB_TOPGEN   3392
#define XCD_BAR_WORDS 3456
#define XB_SPIN_CAP (1u << 18)

__device__ __forceinline__ unsigned xb_ld(unsigned* p)              { return __hip_atomic_load(p, __ATOMIC_RELAXED, __HIP_MEMORY_SCOPE_AGENT); }
__device__ __forceinline__ unsigned xb_add(unsigned* p, unsigned v) { return __hip_atomic_fetch_add(p, v, __ATOMIC_RELAXED, __HIP_MEMORY_SCOPE_AGENT); }
__device__ __forceinline__ unsigned xb_xcc_id() { return (unsigned)__builtin_amdgcn_s_getreg((3 << 11) | 20) & 0xFu; }
#define XB_SPIN(cond, bar) do { unsigned _sp = 0; while (cond) { __builtin_amdgcn_s_sleep(1); \
    if ((++_sp & 255u) == 0u) { if (xb_ld(&(bar)[XB_TMO])) break; if (_sp > XB_SPIN_CAP) { atomicAdd(&(bar)[XB_TMO], 1u); break; } } } } while (0)

struct XcdBarrier {
    unsigned* bar; unsigned x;
    volatile LAS unsigned* st;
};

__device__ __forceinline__ XcdBarrier xcd_barrier_post(unsigned* bar, volatile LAS unsigned* st) {
    XcdBarrier b; b.bar = bar; b.x = xb_xcc_id(); b.st = st;
    if (threadIdx.x == 0) (void)xb_add(&bar[XB_XCNT(b.x)], 1u);
    return b;
}
__device__ __forceinline__ void xcd_barrier_complete(unsigned* bar, unsigned x, unsigned& nloc, unsigned& nx) {
    const unsigned G = gridDim.x * gridDim.y * gridDim.z;
    unsigned sum, cnt, mine, sp = 0u;
    for (;;) {
        sum = 0u; cnt = 0u; mine = 0u;
#pragma unroll
        for (unsigned j = 0; j < 16; ++j) { const unsigned c = xb_ld(&bar[XB_XCNT(j)]); sum += c; cnt += (c > 0u) ? 1u : 0u; mine = (j == x) ? c : mine; }
        if (sum == G) break;
        __builtin_amdgcn_s_sleep(1);
        if ((++sp & 255u) == 0u) { if (xb_ld(&bar[XB_TMO])) break; if (sp > XB_SPIN_CAP) { atomicAdd(&bar[XB_TMO], 1u); break; } }
    }
    nloc = mine > 0u ? mine : 1u; nx = cnt > 0u ? cnt : 1u;
}

__device__ __forceinline__ void xcd_barrier(const XcdBarrier& b) {
    asm volatile("s_waitcnt vmcnt(0)" ::: "memory");
    __syncthreads();
    if (threadIdx.x == 0) {
        unsigned* bar = b.bar;
        __builtin_amdgcn_s_waitcnt(0);
        unsigned nloc = b.st[0], nx = b.st[1];
        if (nloc == 0u) { xcd_barrier_complete(bar, b.x, nloc, nx); b.st[0] = nloc; b.st[1] = nx; }
        const unsigned old = xb_add(&bar[XB_XSUB(b.x)], 1u);
        const unsigned gen = old / nloc;
        if (old + 1u == (gen + 1u) * nloc) {
            __builtin_amdgcn_fence(__ATOMIC_RELEASE, "agent");
            asm volatile("s_waitcnt vmcnt(0)" ::: "memory");
            const unsigned og = xb_add(&bar[XB_TOP], 1u);
            const unsigned tg = og / nx;
            if (og + 1u == (tg + 1u) * nx) xb_add(&bar[XB_TOPGEN], 1u);
            else XB_SPIN(xb_ld(&bar[XB_TOPGEN]) == tg, bar);
            __builtin_amdgcn_fence(__ATOMIC_ACQUIRE, "agent");
            xb_add(&bar[XB_XGEN(b.x)], 1u);
            asm volatile("s_waitcnt vmcnt(0)" ::: "memory");
        } else {
            XB_SPIN(xb_ld(&bar[XB_XGEN(b.x)]) == gen, bar);
            __builtin_amdgcn_fence(__ATOMIC_ACQUIRE, "agent");
            asm volatile("s_waitcnt vmcnt(0)" ::: "memory");
        }
    }
    __syncthreads();
}

struct Args { const float* in[34]; float* out; unsigned char* ws; int ph_lo, ph_hi; };
__device__ __forceinline__ int opaque0() { int z = 0; asm volatile("" : "+s"(z)); return z; }
#define OPQ_S(x) asm volatile("" : "+s"(x))
#define OPQ_SI(x) do { (x) = __builtin_amdgcn_readfirstlane(x); asm volatile("" : "+s"(x)); } while (0)
#define OPQ_V(x) asm volatile("" : "+v"(x))
#define INPTR(a, idx) ((a).in[(idx) + opaque0()])
enum { I_X = 0, I_UP1, I_DN1, I_LN1G, I_LN1B, I_WIN, I_MU, I_W0, I_W2, I_A0, I_A2, I_G2, I_KK, I_KA, I_RK, I_GNG, I_GNB, I_PW, I_PB, I_PS, I_PEK, I_PEV, I_CK1, I_CK2, I_CV1, I_CV2, I_GB, I_WOUT, I_LN2G, I_LN2B, I_UP2, I_DN2, I_LN3G, I_LN3B };

__device__ __forceinline__ void transpose_item(const float* W, int K, int Nsrc, bf16* WT, int dst0, LAS float* scr, int k0, int n0, int lane) {
    const int n = n0 + (lane & 31); const bool ok = n < Nsrc;
#pragma unroll 8
    for (int i = 0; i < 32; ++i) { const int kk = 2 * i + (lane >> 5); scr[kk * 33 + (lane & 31)] = ok ? W[(size_t)(k0 + kk) * Nsrc + n] : 0.f; }
    LDS_WAIT();
    const int c = lane & 7;
#pragma unroll
    for (int j = 0; j < 4; ++j) { const int nn = (lane >> 3) + 8 * j; const LAS float* s = scr + (8 * c) * 33 + nn;
        u32x4 o; o.x = pk2(s[0 * 33], s[1 * 33]); o.y = pk2(s[2 * 33], s[3 * 33]); o.z = pk2(s[4 * 33], s[5 * 33]); o.w = pk2(s[6 * 33], s[7 * 33]);
        *(u32x4*)(WT + (size_t)(dst0 + nn) * K + k0 + 8 * c) = o; }
    LDS_WAIT();
}
__device__ __forceinline__ int up_dst_row(int n0) { return n0 < DFF ? 256 * (n0 / 128) + (n0 % 128) : 256 * ((n0 - DFF) / 128) + 128 + ((n0 - DFF) % 128); }

__device__ __forceinline__ void phase_wconv(const Args& a, int l, LAS unsigned char* lds, int gw, int NGW, int wave, int lane) {
    OPQ_SI(gw); OPQ_SI(wave); OPQ_V(lane);
    LAS float* scr = (LAS float*)(lds + wave * 16384);
    unsigned char* ws = a.ws + opaque0();
    constexpr int I_UP = (DM / 64) * (NUP / 32), I_DN = (DFF / 64) * (DM / 32), I_IN = (DM / 64) * (INP / 32), I_OUT = (DM / 64) * (DM / 32);
    constexpr int NIT = 2 * I_UP + 2 * I_DN + I_IN + I_OUT + 24 + 24 + 48 + 32 + 512 + 16;
    for (int it = gw; it < NIT; it += NGW) {
        int r = it;
        if (r < 2 * I_UP) { const int which = r / I_UP; r -= which * I_UP; const int nblk = NUP / 32, kb = r / nblk, nb = r % nblk;
            const float* W = a.in[which ? I_UP2 : I_UP1] + (size_t)l * DM * NUP; bf16* WT = (bf16*)(ws + (which ? WS_WUP2 : WS_WUP1));
            transpose_item(W, DM, NUP, WT, up_dst_row(32 * nb), scr, 64 * kb, 32 * nb, lane); continue; }
        r -= 2 * I_UP;
        if (r < 2 * I_DN) { const int which = r / I_DN; r -= which * I_DN; const int nblk = DM / 32, kb = r / nblk, nb = r % nblk;
            const float* W = a.in[which ? I_DN2 : I_DN1] + (size_t)l * DFF * DM; bf16* WT = (bf16*)(ws + (which ? WS_WDN2 : WS_WDN1));
            transpose_item(W, DFF, DM, WT, 32 * nb, scr, 64 * kb, 32 * nb, lane); continue; }
        r -= 2 * I_DN;
        if (r < I_IN) { const int nblk = INP / 32, kb = r / nblk, nb = r % nblk;
            transpose_item(INPTR(a, I_WIN) + (size_t)l * DM * INC, DM, INC, (bf16*)(ws + WS_WIN), 32 * nb, scr, 64 * kb, 32 * nb, lane); continue; }
        r -= I_IN;
        if (r < I_OUT) { const int nblk = DM / 32, kb = r / nblk, nb = r % nblk;
            transpose_item(INPTR(a, I_WOUT) + (size_t)l * DM * DM, DM, DM, (bf16*)(ws + WS_WOUT), 32 * nb, scr, 64 * kb, 32 * nb, lane); continue; }
        r -= I_OUT;
        if (r < 24) { transpose_item(INPTR(a, I_W2) + (size_t)l * 64 * DRW, 64, DRW, (bf16*)(ws + WS_W2T), 32 * r, scr, 0, 32 * r, lane); continue; } r -= 24;
        if (r < 24) { transpose_item(INPTR(a, I_A2) + (size_t)l * 64 * DRW, 64, DRW, (bf16*)(ws + WS_A2T), 32 * r, scr, 0, 32 * r, lane); continue; } r -= 24;
        if (r < 48) { const int kb = r / 24, nb = r % 24; transpose_item(INPTR(a, I_G2) + (size_t)l * 128 * DRW, 128, DRW, (bf16*)(ws + WS_G2T), 32 * nb, scr, 64 * kb, 32 * nb, lane); continue; } r -= 48;
        if (r < 32) { const int gi = r >> 3, q = r & 7, kb = q >> 2, nb = q & 3; transpose_item(INPTR(a, I_PW) + ((size_t)l * 4 + gi) * 128 * 128, 128, 128, (bf16*)(ws + WS_PWT) + gi * 128 * 128, 32 * nb, scr, 64 * kb, 32 * nb, lane); continue; } r -= 32;
        if (r < 512) { const int ten = r >> 8, q = r & 255, kb = q >> 3, nb = q & 7; transpose_item(INPTR(a, ten ? I_CV1 : I_CK1) + (size_t)l * 2048 * 256, 2048, 256, (bf16*)(ws + WS_W1T) + (size_t)ten * 256 * 2048, 32 * nb, scr, 64 * kb, 32 * nb, lane); continue; } r -= 512;
        { const int ten = r >> 3, q = r & 7, kb = q >> 1, nb = q & 1; transpose_item(INPTR(a, ten ? I_CV2 : I_CK2) + (size_t)l * 256 * 64, 256, 64, (bf16*)(ws + WS_W2CT) + (size_t)ten * 64 * 256, 32 * nb, scr, 64 * kb, 32 * nb, lane); }
    }
    if (gw / NWAVES == NGW / NWAVES - 1) { const int tid2 = wave * 64 + lane, ten = tid2 >> 8, f = tid2 & 255;
        const float* pe = INPTR(a, ten ? I_PEV : I_PEK) + (size_t)l * 2048; const float* w1 = INPTR(a, ten ? I_CV1 : I_CK1) + (size_t)l * 2048 * 256 + f; float acc = 0.f;
        for (int k = 0; k < 2048; ++k) acc = fmaf(pe[k], w1[(size_t)k * 256], acc);
        ((float*)(ws + WS_CBIAS))[ten * 256 + f] = acc; }
}

__device__ __forceinline__ void phase_prologue(const Args& a, int gtid, int NGT) {
    OPQ_V(gtid);
    const f32x4* x4 = (const f32x4*)INPTR(a, I_X); u32x2* xb = (u32x2*)(a.ws + WS_XB);
    for (size_t i = gtid; i < (size_t)MTOK * DM / 4; i += NGT) { const f32x4 v = x4[i]; u32x2 o; o.x = pk2(v.x, v.y); o.y = pk2(v.z, v.w); xb[i] = o; }
    f32x2* rope = (f32x2*)(a.ws + WS_ROPE);
    for (int i = gtid; i < SEQ * 8; i += NGT) { const int s = i >> 3, k = i & 7;
        const float inv = powf(500000.0f, -(float)k * 0.125f); const float ang = (float)s * inv;
        const double ad = (double)ang; const double q = __builtin_rint(ad * 0.15915494309189535); const double rr = ad - q * 6.283185307179586;
        const float rf = (float)rr; rope[i] = (f32x2){cosf(rf), sinf(rf)}; }
}

__device__ __forceinline__ void phase_ln(const float* Y, const float* g, const float* b, float* X, bf16* XB, int gw, int NGW, int lane) {
    OPQ_SI(gw); OPQ_V(lane);
    f32x4 gv[8], bv[8];
#pragma unroll
    for (int j = 0; j < 8; ++j) { gv[j] = ((const f32x4*)g)[64 * j + lane]; bv[j] = ((const f32x4*)b)[64 * j + lane]; }
    for (int m = gw; m < MTOK; m += NGW) {
        const f32x4* yr = (const f32x4*)(Y + (size_t)m * DM) + lane; f32x4 v[8]; float s = 0.f;
#pragma unroll
        for (int j = 0; j < 8; ++j) { v[j] = yr[64 * j]; s += (v[j].x + v[j].y) + (v[j].z + v[j].w); }
        const float mean = wave_sum(s) * (1.f / DM); float s2 = 0.f;
#pragma unroll
        for (int j = 0; j < 8; ++j) { v[j] = v[j] - mean; s2 += (v[j].x * v[j].x + v[j].y * v[j].y) + (v[j].z * v[j].z + v[j].w * v[j].w); }
        const float rstd = 1.f / sqrtf(wave_sum(s2) * (1.f / DM) + LN_EPS);
        f32x4* xr = (f32x4*)(X + (size_t)m * DM) + lane; u32x2* xb = (u32x2*)(XB + (size_t)m * DM) + lane;
#pragma unroll
        for (int j = 0; j < 8; ++j) { const f32x4 o = v[j] * rstd * gv[j] + bv[j]; xr[64 * j] = o; u32x2 w; w.x = pk2(o.x, o.y); w.y = pk2(o.z, o.w); xb[64 * j] = w; }
    }
}


typedef float f32x16 __attribute__((ext_vector_type(16)));
typedef short bf16x8 __attribute__((ext_vector_type(8)));
#define MFMA32(a, b, c) __builtin_amdgcn_mfma_f32_32x32x16_bf16((a), (b), (c), 0, 0, 0)
#define WSYNC() asm volatile("s_waitcnt lgkmcnt(0)" ::: "memory")
__device__ __forceinline__ void half_swap(float x, float& lo, float& hi) { float a = x, b = x; asm volatile("s_nop 1\n\tv_permlane32_swap_b32 %0, %1" : "+v"(a), "+v"(b)); lo = a; hi = b; }
__device__ __forceinline__ float half_max(float x) { float lo, hi; half_swap(x, lo, hi); return fmaxf(lo, hi); }
__device__ __forceinline__ float half_sum(float x) { float lo, hi; half_swap(x, lo, hi); return lo + hi; }
__device__ __forceinline__ float other_half(float x, int h) { float lo, hi; half_swap(x, lo, hi); return h ? lo : hi; }
__device__ __forceinline__ unsigned cvtpk(float lo, float hi) { unsigned r; asm volatile("v_cvt_pk_bf16_f32 %0, %1, %2" : "=v"(r) : "v"(lo), "v"(hi)); return r; }
__device__ __forceinline__ float half32_sum(float v) { v = row16_sum(v); float a = v, b = v; asm volatile("s_nop 1\n\tv_permlane16_swap_b32 %0, %1" : "+v"(a), "+v"(b)); return a + b; }
__device__ __forceinline__ int vt_pos(int k) { return 16 * ((k >> 2) & 1) + 8 * (k >> 4) + 4 * ((k >> 3) & 1) + (k & 3); }

#ifndef M1_PREFETCH
#define M1_PREFETCH 1
#endif
constexpr int XP = 264, ZP = 520, HP = 264;
__device__ __forceinline__ bf16x8 lds_frag(const LAS bf16* p) { return *(const LAS bf16x8*)p; }
__device__ __forceinline__ bf16x8 cvt8(const f32x4 a, const f32x4 b) { u32x4 w; w.x = cvtpk(a.x, a.y); w.y = cvtpk(a.z, a.w); w.z = cvtpk(b.x, b.y); w.w = cvtpk(b.z, b.w); return __builtin_bit_cast(bf16x8, w); }
__device__ __forceinline__ void phase_m1(const Args& a, int l, LAS unsigned char* lds, int bid, int G, int tid, int wave, int lane) {
    OPQ_SI(bid); OPQ_V(tid); OPQ_SI(wave); lane = tid & 63;
    unsigned char* ws = a.ws + opaque0(); const float* P = (const float*)(ws + WS_P);
    const int r = lane & 31, h = lane >> 5;
    const f32x2* rope = (const f32x2*)(ws + WS_ROPE);
    for (int unit = bid; unit < MTOK / 64; unit += G) {
        const int t0 = unit * 64, b = t0 >> 12, s0 = t0 & (SEQ - 1);
        LAS bf16* XL = (LAS bf16*)lds;
        LAS bf16* ZL = (LAS bf16*)(lds + 64 * XP * 2);
        { const float* mu = INPTR(a, I_MU) + (size_t)l * RWC;
            for (int i = tid; i < 64 * 256; i += NTHR) { const int tt = i >> 8, j = i & 255, col = 2304 + j; const int m = t0 + tt;
                const float pc = P[(size_t)m * INP + col]; const float pp = (s0 + tt) > 0 ? P[(size_t)(m - 1) * INP + col] : 0.f; const float v = pc + (pp - pc) * mu[col];
                const float f = j < 64 ? tanhf(v) : (j < 128 ? v : sigmoidf_(v)); XL[tt * XP + j] = (bf16)f2bf(f); }
            {
                const int ch = tid, gi = ch >> 7, win = 2 << gi; const float* pp = P + (size_t)t0 * INP + PO_POOL + ch; float sum = 0.f;
                for (int j = 1; j < win; ++j) if (s0 - j >= 0) sum += pp[-(ptrdiff_t)j * INP];
#pragma unroll 8
                for (int tt = 0; tt < 64; ++tt) { const int s = s0 + tt; const float cur = pp[(size_t)tt * INP]; sum += cur; const int cnt = (s + 1) < win ? (s + 1) : win;
                    ZL[tt * ZP + ch] = (bf16)f2bf(sum / (float)cnt - cur); if (s - win + 1 >= 0) sum -= pp[((ptrdiff_t)tt - win + 1) * INP]; } } }
        __syncthreads();
        {
            const float* mu = INPTR(a, I_MU) + (size_t)l * RWC; const float* w0 = INPTR(a, I_W0) + (size_t)l * DRW; const float* a0 = INPTR(a, I_A0) + (size_t)l * DRW;
            const float* k_k = INPTR(a, I_KK) + (size_t)l * DRW; const float* k_a = INPTR(a, I_KA) + (size_t)l * DRW; const float* r_k = INPTR(a, I_RK) + (size_t)l * DRW;
            const bf16* W2T = (const bf16*)(ws + WS_W2T); const bf16* A2T = (const bf16*)(ws + WS_A2T); const bf16* G2T = (const bf16*)(ws + WS_G2T);
            float* vKK = (float*)(ws + WS_SV); float* vWR = (float*)(ws + WS_SV + SV_STRIDE); float* vW = (float*)(ws + WS_SV + 2 * SV_STRIDE);
            float* vKM = (float*)(ws + WS_SV + 3 * SV_STRIDE); float* vBB = (float*)(ws + WS_SV + 4 * SV_STRIDE); float* vV = (float*)(ws + WS_SV + 5 * SV_STRIDE);
            float* vG = (float*)(ws + WS_G); float* SC = (float*)(ws + WS_SC);
#pragma unroll 1
            for (int jj = 0; jj < 3; ++jj) {
                const int job = wave + 8 * jj, hd = job >> 1, th = job & 1;
                f32x16 aU[2], aA[2];
#pragma unroll
                for (int t = 0; t < 2; ++t)
#pragma unroll
                    for (int i = 0; i < 16; ++i) { aU[t][i] = 0.f; aA[t][i] = 0.f; }
                const LAS bf16* xa = XL + (32 * th + r) * XP + 8 * h;
#pragma unroll
                for (int ks = 0; ks < 4; ++ks) { const bf16x8 xt = lds_frag(xa + 16 * ks), xl = lds_frag(xa + 64 + 16 * ks);
#pragma unroll
                    for (int t = 0; t < 2; ++t) { const int c = hd * 64 + 32 * t + r;
                        aU[t] = MFMA32(xt, *(const bf16x8*)(W2T + (size_t)c * 64 + 16 * ks + 8 * h), aU[t]);
                        aA[t] = MFMA32(xl, *(const bf16x8*)(A2T + (size_t)c * 64 + 16 * ks + 8 * h), aA[t]); } }
                float pmr[2], pmk[2], pmv[2], pw0[2], pa0[2], pkk[2], pka[2], prk[2];
#pragma unroll
                for (int t = 0; t < 2; ++t) { const int c = hd * 64 + 32 * t + r; pmr[t] = mu[c]; pmk[t] = mu[768 + c]; pmv[t] = mu[1536 + c]; pw0[t] = w0[c]; pa0[t] = a0[c]; pkk[t] = k_k[c]; pka[t] = k_a[c]; prk[t] = r_k[c]; }
                const int lo_p = 4 * h * INP + hd * 64 + r, lo_s = 4 * h * DRW + hd * 64 + r;
                float ld[2][12];
#define M1_LOADROW(buf, i) do { int mr_ = t0 + 32 * th + ((i) & 3) + 8 * ((i) >> 2); OPQ_SI(mr_); const bool first_ = (s0 + 32 * th + ((i) & 3) + 8 * ((i) >> 2) + 4 * h) == 0; \
        const float* pc_ = P + (size_t)mr_ * INP; const float* pp_ = pc_ - INP; _Pragma("unroll") for (int t = 0; t < 2; ++t) { const int o = lo_p + 32 * t; \
        buf[6 * t + 0] = pc_[o]; buf[6 * t + 1] = pc_[o + 768]; buf[6 * t + 2] = pc_[o + 1536]; buf[6 * t + 3] = first_ ? 0.f : pp_[o]; buf[6 * t + 4] = first_ ? 0.f : pp_[o + 768]; buf[6 * t + 5] = first_ ? 0.f : pp_[o + 1536]; } } while (0)
                M1_LOADROW(ld[0], 0);
#pragma unroll
                for (int i = 0; i < 16; ++i) {
#if M1_PREFETCH
                    if (i + 1 < 16) M1_LOADROW(ld[(i + 1) & 1], i + 1);
#else
                    if (i > 0) M1_LOADROW(ld[i & 1], i);
#endif
                    int mrow = t0 + 32 * th + (i & 3) + 8 * (i >> 2); OPQ_SI(mrow);
                    float rr[2], kv[2], vv[2], dec[2], av[2], kr[2], km[2];
                    float ss = 0.f, s1 = 0.f, s2 = 0.f, s3 = 0.f;
#pragma unroll
                    for (int t = 0; t < 2; ++t) { const float* L = ld[i & 1] + 6 * t;
                        const float rc = L[0], kc = L[1], vc = L[2], rp = L[3], kp = L[4], vp = L[5];
                        rr[t] = rc + (rp - rc) * pmr[t]; kv[t] = kc + (kp - kc) * pmk[t]; vv[t] = vc + (vp - vc) * pmv[t];
                        const float uu = pw0[t] + aU[t][i]; const float z = -uu; const float sp = z > 20.f ? z : log1pf(expf(z)); dec[t] = expf(-expf(-sp - 0.5f));
                        av[t] = sigmoidf_(pa0[t] + aA[t][i]);
                        kr[t] = kv[t] * pkk[t]; km[t] = kv[t] * (1.0f + (av[t] - 1.0f) * pka[t]);
                        ss += kr[t] * kr[t]; s1 += kr[t] * av[t] * rr[t]; s2 += km[t] * rr[t]; s3 += rr[t] * km[t] * prk[t]; }
                    ss = half32_sum(ss); s1 = half32_sum(s1); s2 = half32_sum(s2); s3 = half32_sum(s3);
                    const float invn = 1.0f / fmaxf(sqrtf(ss), 1e-12f);
                    const size_t ro = (size_t)mrow * DRW;
#pragma unroll
                    for (int t = 0; t < 2; ++t) { const int o = lo_s + 32 * t; const float kk = kr[t] * invn;
                        (vKK + ro)[o] = kk; (vWR + ro)[o] = dec[t] * rr[t]; (vW + ro)[o] = dec[t]; (vKM + ro)[o] = km[t]; (vBB + ro)[o] = kk * av[t]; (vV + ro)[o] = vv[t]; }
                    if (r == 0) *(f32x4*)(SC + ((size_t)mrow * 12 + hd) * 4 + 4 * h * 48) = (f32x4){s1 * invn, s2, s3, 0.f};
                    asm volatile("" ::: "memory");
                }
#undef M1_LOADROW
                { f32x16 aG[2];
#pragma unroll
                    for (int t = 0; t < 2; ++t)
#pragma unroll
                        for (int i = 0; i < 16; ++i) aG[t][i] = 0.f;
#pragma unroll
                    for (int ks = 0; ks < 8; ++ks) { const bf16x8 xg = lds_frag(xa + 128 + 16 * ks);
#pragma unroll
                        for (int t = 0; t < 2; ++t) { const int c = hd * 64 + 32 * t + r; aG[t] = MFMA32(xg, *(const bf16x8*)(G2T + (size_t)c * 128 + 16 * ks + 8 * h), aG[t]); } }
#pragma unroll
                    for (int i = 0; i < 16; ++i) { int mrow = t0 + 32 * th + (i & 3) + 8 * (i >> 2); OPQ_SI(mrow); float* gp = vG + (size_t)mrow * DRW;
#pragma unroll
                        for (int t = 0; t < 2; ++t) gp[lo_s + 32 * t] = aG[t][i]; } }
            }
        }
        {
            int lane_b = lane; OPQ_V(lane_b); const int r = lane_b & 31, h = lane_b >> 5;
            const int gi = wave >> 1, th = wave & 1; const bf16* PWT = (const bf16*)(ws + WS_PWT) + gi * 128 * 128;
            const float* pb = INPTR(a, I_PB) + (size_t)l * DPOOL + gi * 128; const float* psc = INPTR(a, I_PS) + (size_t)l * DPOOL + gi * 128; bf16* CAT = (bf16*)(ws + WS_CAT);
            f32x16 acc[4];
#pragma unroll
            for (int t = 0; t < 4; ++t)
#pragma unroll
                for (int i = 0; i < 16; ++i) acc[t][i] = 0.f;
            const LAS bf16* za = ZL + (32 * th + r) * ZP + gi * 128 + 8 * h;
#pragma unroll
            for (int ks = 0; ks < 8; ++ks) { const bf16x8 zf = lds_frag(za + 16 * ks);
#pragma unroll
                for (int t = 0; t < 4; ++t) acc[t] = MFMA32(zf, *(const bf16x8*)(PWT + (size_t)(32 * t + r) * 128 + 16 * ks + 8 * h), acc[t]); }
#pragma unroll
            for (int t = 0; t < 4; ++t) { const int d = 32 * t + r; const float bv = pb[d], sv = psc[d];
#pragma unroll
                for (int i = 0; i < 16; ++i) { const int m = t0 + 32 * th + (i & 3) + 8 * (i >> 2) + 4 * h; CAT[(size_t)m * DM + DRW + gi * 128 + d] = (bf16)f2bf((acc[t][i] + bv) * sv); } }
        }
        __syncthreads();
        {
            int tid_c = tid; OPQ_V(tid_c); const int tid = tid_c;
            bf16* QR = (bf16*)(ws + WS_QR); bf16* KS = (bf16*)(ws + WS_KS); bf16* KW = (bf16*)(ws + WS_KW); bf16* VST = (bf16*)(ws + WS_VST); bf16* VWT = (bf16*)(ws + WS_VWT);
            LAS float* T0 = (LAS float*)lds; LAS float* T1 = T0 + 64 * 193;
            for (int i = tid; i < 64 * 1152; i += NTHR) { const int tt = i / 1152, c = i - tt * 1152; const int m = t0 + tt, s = s0 + tt; const float* pr = P + (size_t)m * INP;
                int src; bf16* dst; float scale = 1.f;
                if (c < 768) { src = PO_Q + c; dst = QR + (size_t)m * 768 + c; scale = 0.125f * 1.4426950408889634f; }
                else if (c < 960) { const int cc = c - 768; src = PO_KS + cc; dst = KS + (((size_t)(b * 3 + (cc >> 6)) * 128 + (s >> 5)) * 32 + (s & 31)) * 64 + (cc & 63); }
                else { const int cc = c - 960; src = PO_KW + cc; dst = KW + (((size_t)(b * 3 + (cc >> 6)) * 128 + (s >> 5)) * 32 + (s & 31)) * 64 + (cc & 63); }
                const int d = c & 63; float v = pr[src];
                if (d < 16) { const f32x2 cs = rope[s * 8 + (d & 7)]; v = d < 8 ? v * cs.x - pr[src + 8] * cs.y : v * cs.x + pr[src - 8] * cs.y; }
                *dst = (bf16)f2bf(v * scale); }
            for (int i = tid; i < 64 * 384; i += NTHR) { const int tt = i / 384, c = i - tt * 384; const float* pr = P + (size_t)(t0 + tt) * INP;
                if (c < 192) T0[tt * 193 + c] = pr[PO_VS + c]; else T1[tt * 193 + (c - 192)] = pr[PO_VW + (c - 192)]; }
            __syncthreads();
            for (int i = tid; i < 384 * 64; i += NTHR) { const int c2 = i >> 6, tok = i & 63; const int which = c2 >= 192, c = which ? c2 - 192 : c2;
                const float v = (which ? T1 : T0)[tok * 193 + c]; const int sk = s0 + tok;
                bf16* dst = (which ? VWT : VST) + (((size_t)(b * 3 + (c >> 6)) * 128 + (sk >> 5)) * 64 + (c & 63)) * 32 + vt_pos(sk & 31); *dst = (bf16)f2bf(v); }
        }
        __syncthreads();
    }
    {
        int lane_d = lane; OPQ_V(lane_d); const int r = lane_d & 31, h = lane_d >> 5;
        LAS bf16* HL = (LAS bf16*)lds;
        const float* cbias = (const float*)(ws + WS_CBIAS); bf16* KC = (bf16*)(ws + WS_KC); bf16* VCT = (bf16*)(ws + WS_VCT);
        for (int u = bid; u < 2 * NB * 3 * 8; u += G) {
            const int ten = u / 96, q = u - ten * 96, b = q / 24, q2 = q - b * 24, hh = q2 >> 3, nt = q2 & 7, n0 = 32 * nt;
            const bf16* W1T = (const bf16*)(ws + WS_W1T) + (size_t)ten * 256 * 2048 + (size_t)(32 * wave + r) * 2048 + 8 * h;
            const int tk0 = 16 * (n0 + r);
            const float* pa = P + ((size_t)b * SEQ + tk0) * INP + (ten ? PO_VC : PO_KC) + hh * 64 + 8 * h;
            f32x16 acc;
#pragma unroll
            for (int i = 0; i < 16; ++i) acc[i] = 0.f;
            f32x4 xa[2][8]; bf16x8 wb[2][4];
#define CMP_LOAD(sl, ll) do { const bool ok_ = tk0 + (ll) < SEQ; const float* pl_ = pa + (size_t)(ll) * INP; _Pragma("unroll") for (int ds = 0; ds < 4; ++ds) { \
        xa[sl][2 * ds] = ok_ ? *(const f32x4*)(pl_ + 16 * ds) : (f32x4){0.f, 0.f, 0.f, 0.f}; xa[sl][2 * ds + 1] = ok_ ? *(const f32x4*)(pl_ + 16 * ds + 4) : (f32x4){0.f, 0.f, 0.f, 0.f}; \
        wb[sl][ds] = *(const bf16x8*)(W1T + 64 * (ll) + 16 * ds); } } while (0)
            CMP_LOAD(0, 0);
#pragma unroll 1
            for (int ll = 0; ll < 32; ll += 2) {
                CMP_LOAD(1, ll + 1);
#pragma unroll
                for (int ds = 0; ds < 4; ++ds) acc = MFMA32(cvt8(xa[0][2 * ds], xa[0][2 * ds + 1]), wb[0][ds], acc);
                if (ll + 2 < 32) CMP_LOAD(0, ll + 2);
#pragma unroll
                for (int ds = 0; ds < 4; ++ds) acc = MFMA32(cvt8(xa[1][2 * ds], xa[1][2 * ds + 1]), wb[1][ds], acc);
            }
#undef CMP_LOAD
            { const float cb = cbias[ten * 256 + 32 * wave + r];
#pragma unroll
                for (int i = 0; i < 16; ++i) { const float x = acc[i] + cb; const float gl = 0.5f * x * (1.0f + tanhf(0.7978845608028654f * (x + 0.044715f * x * x * x)));
                    HL[((i & 3) + 8 * (i >> 2) + 4 * h) * HP + 32 * wave + r] = (bf16)f2bf(gl); } }
            __syncthreads();
            if (wave < 2) {
                const bf16* W2CT = (const bf16*)(ws + WS_W2CT) + (size_t)ten * 64 * 256 + (size_t)(32 * wave + r) * 256 + 8 * h;
                f32x16 o;
#pragma unroll
                for (int i = 0; i < 16; ++i) o[i] = 0.f;
                const LAS bf16* ha = HL + r * HP + 8 * h;
#pragma unroll
                for (int ks = 0; ks < 16; ++ks) o = MFMA32(lds_frag(ha + 16 * ks), *(const bf16x8*)(W2CT + 16 * ks), o);
                const int d = 32 * wave + r;
#pragma unroll
                for (int i = 0; i < 16; ++i) { const int n = n0 + (i & 3) + 8 * (i >> 2) + 4 * h; float v = o[i];
                    if (ten == 0) { const float other = dpp_f<0x128>(v);
                        if (wave == 0 && r < 16) { const f32x2 cs = rope[((16 * n + 31) & (SEQ - 1)) * 8 + (r & 7)]; v = r < 8 ? v * cs.x - other * cs.y : v * cs.x + other * cs.y; }
                        if (n < NCMP) KC[((size_t)(b * 3 + hh) * NCMPP + n) * 64 + d] = (bf16)f2bf(v); }
                    else if (n < NCMP) VCT[(((size_t)(b * 3 + hh) * 8 + (n >> 5)) * 64 + d) * 32 + vt_pos(n & 31)] = (bf16)f2bf(v); }
            }
            __syncthreads();
        }
    }
}

constexpr int SPX = 72;
__device__ __forceinline__ void phase_scan_prep(const Args& a, LAS unsigned char* lds, int gw, int NGW, int wave, int lane) {
    OPQ_SI(gw); OPQ_SI(wave); OPQ_V(lane);
    unsigned char* ws = a.ws + opaque0();
    LAS unsigned char* wl = lds + wave * 16384;
    LAS bf16* XA = (LAS bf16*)wl; LAS bf16* XR = XA + 16 * SPX; LAS bf16* XB_ = XR + 16 * SPX; LAS bf16* XK = XB_ + 16 * SPX;
    LAS float* GB = (LAS float*)(wl + 4 * 16 * SPX * 2); LAS float* GK = GB + 256; LAS float* HB = GK + 256; LAS float* HK = HB + 256; LAS float* NM = HK + 256;
    const int r = lane & 31, h = lane >> 5;
    const GAS float* vKK = (const GAS float*)(ws + WS_SV); const GAS float* vWR = (const GAS float*)(ws + WS_SV + SV_STRIDE); const GAS float* vW = (const GAS float*)(ws + WS_SV + 2 * SV_STRIDE);
    const GAS float* vKM = (const GAS float*)(ws + WS_SV + 3 * SV_STRIDE); const GAS float* vBB = (const GAS float*)(ws + WS_SV + 4 * SV_STRIDE); const GAS float* vV = (const GAS float*)(ws + WS_SV + 5 * SV_STRIDE);
#pragma unroll 1
    for (int item = gw; item < NB * 12 * 256; item += NGW) {
        const int hd = item >> 8, c = item & 255, b = hd / 12, hh = hd - b * 12;
        const size_t o0 = ((size_t)b * SEQ + 16 * c) * DRW + hh * 64 + lane;
        GAS unsigned char* rec = (GAS unsigned char*)(ws + WS_SPREC) + (size_t)item * SPREC_BYTES;
        float al[16], rh[16], be[16], ka[16], vv[16]; float g = 1.f;
#pragma unroll
        for (int t = 0; t < 16; ++t) { const size_t o = o0 + (size_t)t * DRW; const float w = vW[o], kk = vKK[o], bb = vBB[o], km = vKM[o], wr = vWR[o]; vv[t] = vV[o];
            al[t] = g * kk; rh[t] = g * wr; g *= w; const float ig = 1.0f / g; be[t] = bb * ig; ka[t] = km * ig; }
#pragma unroll
        for (int t = 0; t < 16; ++t) { XA[t * SPX + lane] = (bf16)f2bf(al[t]); XR[t * SPX + lane] = (bf16)f2bf(rh[t]); XB_[t * SPX + lane] = (bf16)f2bf(be[t]); XK[t * SPX + lane] = (bf16)f2bf(ka[t]); }
#pragma unroll
        for (int hp = 0; hp < 2; ++hp) {
            u32x4 wb, wk, wv;
            wb.x = cvtpk(be[4 * hp + 0], be[4 * hp + 1]); wb.y = cvtpk(be[4 * hp + 2], be[4 * hp + 3]); wb.z = cvtpk(be[8 + 4 * hp + 0], be[8 + 4 * hp + 1]); wb.w = cvtpk(be[8 + 4 * hp + 2], be[8 + 4 * hp + 3]);
            wk.x = cvtpk(ka[4 * hp + 0], ka[4 * hp + 1]); wk.y = cvtpk(ka[4 * hp + 2], ka[4 * hp + 3]); wk.z = cvtpk(ka[8 + 4 * hp + 0], ka[8 + 4 * hp + 1]); wk.w = cvtpk(ka[8 + 4 * hp + 2], ka[8 + 4 * hp + 3]);
            wv.x = cvtpk(vv[4 * hp + 0], vv[4 * hp + 1]); wv.y = cvtpk(vv[4 * hp + 2], vv[4 * hp + 3]); wv.z = cvtpk(vv[8 + 4 * hp + 0], vv[8 + 4 * hp + 1]); wv.w = cvtpk(vv[8 + 4 * hp + 2], vv[8 + 4 * hp + 3]);
            *(GAS u32x4*)(rec + 4096 + ((h * 2 + hp) * 32 + r) * 16) = wb; *(GAS u32x4*)(rec + 6144 + ((h * 2 + hp) * 32 + r) * 16) = wk;
            *(GAS u32x4*)(rec + 9216 + h * 3072 + 2048 + (hp * 32 + r) * 16) = wv; }
        *(GAS float*)(rec + 8704 + ((h * 2 + ((r >> 2) & 1)) * 16 + (r & 3) + 4 * (r >> 3)) * 4) = g;
        WSYNC();
        const bool lo16 = r < 16; const bf16x8 zf = {0, 0, 0, 0, 0, 0, 0, 0};
#define SP_GRAM(X1, X2, OUT, INCL) do { f32x16 D; _Pragma("unroll") for (int i = 0; i < 16; ++i) D[i] = 0.f; \
            _Pragma("unroll") for (int ks = 0; ks < 4; ++ks) { const bf16x8 fa = lo16 ? *(const LAS bf16x8*)(X1 + r * SPX + 16 * ks + 8 * h) : zf, fb = lo16 ? *(const LAS bf16x8*)(X2 + r * SPX + 16 * ks + 8 * h) : zf; D = MFMA32(fa, fb, D); } \
            if (lo16) { _Pragma("unroll") for (int i = 0; i < 8; ++i) { const int t = (i & 3) + 8 * (i >> 2) + 4 * h; OUT[t * 16 + r] = (INCL ? r <= t : r < t) ? D[i] : 0.f; } } } while (0)
        SP_GRAM(XA, XB_, GB, false); SP_GRAM(XA, XK, GK, false); SP_GRAM(XR, XB_, HB, true); SP_GRAM(XR, XK, HK, true);
#undef SP_GRAM
        WSYNC();
        { const int cc = lane & 15; float n[16];
#pragma unroll
            for (int t = 0; t < 16; ++t) { float acc = t == cc ? 1.f : 0.f;
#pragma unroll
                for (int s2 = 0; s2 < t; ++s2) acc -= GB[t * 16 + s2] * n[s2];
                n[t] = acc; }
            if (lane < 16) {
#pragma unroll
                for (int t = 0; t < 16; ++t) NM[t * 16 + cc] = n[t]; } }
        if (lo16) { u32x4 w_; const LAS float* hr = HB + r * 16 + 4 * h;
            w_.x = cvtpk(hr[0], hr[1]); w_.y = cvtpk(hr[2], hr[3]); w_.z = cvtpk(hr[8], hr[9]); w_.w = cvtpk(hr[10], hr[11]); *(GAS u32x4*)(rec + 8192 + (h * 16 + r) * 16) = w_; }
        WSYNC();
        { float ap[16];
#pragma unroll
            for (int t = 0; t < 16; ++t) { float acc = 0.f;
#pragma unroll
                for (int s2 = 0; s2 <= t; ++s2) acc = fmaf(NM[t * 16 + s2], al[s2], acc);
                ap[t] = acc; }
#pragma unroll
            for (int t = 0; t < 16; ++t) XA[t * SPX + lane] = (bf16)f2bf(ap[t]); }
        WSYNC();
        if (lo16) {
#pragma unroll
            for (int ks = 0; ks < 4; ++ks) { const LAS bf16* pa = XA + r * SPX + 16 * ks + 4 * h; const LAS bf16* pr = XR + r * SPX + 16 * ks + 4 * h;
                const u32x2 a0 = *(const LAS u32x2*)pa, a1 = *(const LAS u32x2*)(pa + 8), r0 = *(const LAS u32x2*)pr, r1 = *(const LAS u32x2*)(pr + 8);
                *(GAS u32x4*)(rec + ((ks * 2 + h) * 16 + r) * 16) = (u32x4){a0.x, a0.y, a1.x, a1.y}; *(GAS u32x4*)(rec + 2048 + ((ks * 2 + h) * 16 + r) * 16) = (u32x4){r0.x, r0.y, r1.x, r1.y}; } }
        { float wq[16], p1[16], yk[16];
#pragma unroll
            for (int t = 0; t < 16; ++t) { float acc = 0.f, acy = 0.f;
#pragma unroll
                for (int s2 = 0; s2 <= t; ++s2) { if (s2 < t) acc = fmaf(GK[t * 16 + s2], vv[s2], acc); acy = fmaf(HK[t * 16 + s2], vv[s2], acy); }
                wq[t] = acc; yk[t] = acy; }
#pragma unroll
            for (int t = 0; t < 16; ++t) { float acc = 0.f;
#pragma unroll
                for (int s2 = 0; s2 <= t; ++s2) acc = fmaf(NM[t * 16 + s2], wq[s2], acc);
                p1[t] = acc; }
            GAS unsigned char* rv = rec + 9216 + h * 3072;
#pragma unroll
            for (int hq = 0; hq < 2; ++hq) { u32x4 wp, wy;
                wp.x = cvtpk(p1[4 * hq + 0], p1[4 * hq + 1]); wp.y = cvtpk(p1[4 * hq + 2], p1[4 * hq + 3]); wp.z = cvtpk(p1[8 + 4 * hq + 0], p1[8 + 4 * hq + 1]); wp.w = cvtpk(p1[8 + 4 * hq + 2], p1[8 + 4 * hq + 3]);
                wy.x = cvtpk(yk[4 * hq + 0], yk[4 * hq + 1]); wy.y = cvtpk(yk[4 * hq + 2], yk[4 * hq + 3]); wy.z = cvtpk(yk[8 + 4 * hq + 0], yk[8 + 4 * hq + 1]); wy.w = cvtpk(yk[8 + 4 * hq + 2], yk[8 + 4 * hq + 3]);
                *(GAS u32x4*)(rv + (hq * 32 + r) * 16) = wp; *(GAS u32x4*)(rv + 1024 + (hq * 32 + r) * 16) = wy; } }
        WSYNC();
    }
}
__device__ __forceinline__ void scan_seq(const Args& a, LAS unsigned char* lds, int grp, int lane) {
    OPQ_SI(grp); OPQ_V(lane);
    __builtin_amdgcn_s_setprio(3);
    unsigned char* ws = a.ws + opaque0();
    const int hd = grp % 48, vt = grp / 48, b = hd / 12, hh = hd - b * 12;
    const int r = lane & 31, h = lane >> 5; const bool lo16 = r < 16;
    LAS unsigned char* RS = lds + 16384;
    const GAS unsigned char* recs = (const GAS unsigned char*)(ws + WS_SPREC) + (size_t)hd * 256 * SPREC_BYTES;
    GAS float* yp = (GAS float*)(ws + WS_YS) + (size_t)b * SEQ * DRW + hh * 64 + 32 * vt + r;
    const bf16x8 zf = {0, 0, 0, 0, 0, 0, 0, 0};
    f32x16 T0, T1;
#pragma unroll
    for (int i = 0; i < 16; ++i) { T0[i] = 0.f; T1[i] = 0.f; }
#define SQ_DMA(slot, ck) do { const GAS unsigned char* rp_ = recs + (size_t)(ck) * SPREC_BYTES + lane * 16; LAS unsigned char* ls_ = RS + (slot) * 12288; \
        _Pragma("unroll") for (int q = 0; q < 9; ++q) __builtin_amdgcn_global_load_lds((const unsigned*)(rp_ + 1024 * q), (LAS unsigned*)(ls_ + 1024 * q), 16, 0, 0); \
        _Pragma("unroll") for (int q = 0; q < 3; ++q) __builtin_amdgcn_global_load_lds((const unsigned*)(rp_ + 9216 + 3072 * vt + 1024 * q), (LAS unsigned*)(ls_ + 9216 + 1024 * q), 16, 0, 0); } while (0)
    SQ_DMA(0, 0); SQ_DMA(1, 1);
#pragma unroll 1
    for (int ck = 0; ck < 256; ++ck) {
        const LAS unsigned char* L = RS + (ck & 1) * 12288;
        if (ck == 0) asm volatile("s_waitcnt vmcnt(12)" ::: "memory"); else if (ck + 1 < 256) asm volatile("s_waitcnt vmcnt(20)" ::: "memory"); else asm volatile("s_waitcnt vmcnt(0)" ::: "memory");
        bf16x8 tb[4];
#pragma unroll
        for (int s2 = 0; s2 < 2; ++s2) { u32x4 w0, w1;
            w0.x = cvtpk(T0[8 * s2], T0[8 * s2 + 1]); w0.y = cvtpk(T0[8 * s2 + 2], T0[8 * s2 + 3]); w0.z = cvtpk(T0[8 * s2 + 4], T0[8 * s2 + 5]); w0.w = cvtpk(T0[8 * s2 + 6], T0[8 * s2 + 7]);
            w1.x = cvtpk(T1[8 * s2], T1[8 * s2 + 1]); w1.y = cvtpk(T1[8 * s2 + 2], T1[8 * s2 + 3]); w1.z = cvtpk(T1[8 * s2 + 4], T1[8 * s2 + 5]); w1.w = cvtpk(T1[8 * s2 + 6], T1[8 * s2 + 7]);
            tb[s2] = __builtin_bit_cast(bf16x8, w0); tb[2 + s2] = __builtin_bit_cast(bf16x8, w1); }
        f32x16 aU, aY;
#pragma unroll
        for (int i = 0; i < 16; ++i) { aU[i] = 0.f; aY[i] = 0.f; }
        { const u32x4 yk = *(const LAS u32x4*)(L + 9216 + 1024 + lane * 16);
            aY[0] = __builtin_bit_cast(float, yk.x << 16); aY[1] = __builtin_bit_cast(float, yk.x & 0xffff0000u); aY[2] = __builtin_bit_cast(float, yk.y << 16); aY[3] = __builtin_bit_cast(float, yk.y & 0xffff0000u);
            aY[4] = __builtin_bit_cast(float, yk.z << 16); aY[5] = __builtin_bit_cast(float, yk.z & 0xffff0000u); aY[6] = __builtin_bit_cast(float, yk.w << 16); aY[7] = __builtin_bit_cast(float, yk.w & 0xffff0000u); }
#pragma unroll
        for (int ks = 0; ks < 4; ++ks) { const bf16x8 fa = lo16 ? *(const LAS bf16x8*)(L + ((ks * 2 + h) * 16 + r) * 16) : zf, fr = lo16 ? *(const LAS bf16x8*)(L + 2048 + ((ks * 2 + h) * 16 + r) * 16) : zf;
            aU = MFMA32(fa, tb[ks], aU); aY = MFMA32(fr, tb[ks], aY); }
        bf16x8 ub;
        { const u32x4 p1 = *(const LAS u32x4*)(L + 9216 + lane * 16); float u[8];
            u[0] = -aU[0] - __builtin_bit_cast(float, p1.x << 16); u[1] = -aU[1] - __builtin_bit_cast(float, p1.x & 0xffff0000u); u[2] = -aU[2] - __builtin_bit_cast(float, p1.y << 16); u[3] = -aU[3] - __builtin_bit_cast(float, p1.y & 0xffff0000u);
            u[4] = -aU[4] - __builtin_bit_cast(float, p1.z << 16); u[5] = -aU[5] - __builtin_bit_cast(float, p1.z & 0xffff0000u); u[6] = -aU[6] - __builtin_bit_cast(float, p1.w << 16); u[7] = -aU[7] - __builtin_bit_cast(float, p1.w & 0xffff0000u);
            u32x4 w_; w_.x = cvtpk(u[0], u[1]); w_.y = cvtpk(u[2], u[3]); w_.z = cvtpk(u[4], u[5]); w_.w = cvtpk(u[6], u[7]); ub = __builtin_bit_cast(bf16x8, w_); }
        { const bf16x8 fh = lo16 ? *(const LAS bf16x8*)(L + 8192 + (h * 16 + r) * 16) : zf; aY = MFMA32(fh, ub, aY); }
        { const bf16x8 fv = *(const LAS bf16x8*)(L + 9216 + 2048 + lane * 16);
            const bf16x8 b0 = *(const LAS bf16x8*)(L + 4096 + lane * 16), b1 = *(const LAS bf16x8*)(L + 4096 + 1024 + lane * 16), k0 = *(const LAS bf16x8*)(L + 6144 + lane * 16), k1 = *(const LAS bf16x8*)(L + 6144 + 1024 + lane * 16);
            T0 = MFMA32(b0, ub, T0); T1 = MFMA32(b1, ub, T1); T0 = MFMA32(k0, fv, T0); T1 = MFMA32(k1, fv, T1);
#pragma unroll
            for (int q = 0; q < 4; ++q) { const f32x4 g0 = *(const LAS f32x4*)(L + 8704 + (h * 16 + 4 * q) * 4), g1 = *(const LAS f32x4*)(L + 8704 + ((2 + h) * 16 + 4 * q) * 4);
                T0[4 * q] *= g0.x; T0[4 * q + 1] *= g0.y; T0[4 * q + 2] *= g0.z; T0[4 * q + 3] *= g0.w; T1[4 * q] *= g1.x; T1[4 * q + 1] *= g1.y; T1[4 * q + 2] *= g1.z; T1[4 * q + 3] *= g1.w; } }
#pragma unroll
        for (int i = 0; i < 8; ++i) yp[((size_t)ck * 16 + (i & 3) + 8 * (i >> 2) + 4 * h) * DRW] = aY[i];
        asm volatile("s_waitcnt lgkmcnt(0)" ::: "memory");
        if (ck + 2 < 256) SQ_DMA(ck & 1, ck + 2);
    }
#undef SQ_DMA
    asm volatile("s_waitcnt vmcnt(0)" ::: "memory");
    __builtin_amdgcn_s_setprio(0);
}

template <bool WITH_V> __device__ __forceinline__ void dma_tile(LAS unsigned char* RW, const bf16* Kb, int key0, unsigned koff, const bf16* Vt, unsigned voff) {
    const char* kp = (const char*)(Kb + (size_t)key0 * 64) + koff;
#pragma unroll
    for (int q = 0; q < 4; ++q) __builtin_amdgcn_global_load_lds((const unsigned*)(kp + 1024 * q), (LAS unsigned*)(RW + q * 1024), 16, 0, 0);
    if (WITH_V) { const char* vp = (const char*)(Vt + (size_t)(key0 >> 5) * 2048) + voff;
#pragma unroll
        for (int q = 0; q < 4; ++q) __builtin_amdgcn_global_load_lds((const unsigned*)(vp + 1024 * q), (LAS unsigned*)(RW + (4 + q) * 1024), 16, 0, 0); }
}
template <bool WITH_V> __device__ __forceinline__ void read_tile(const LAS unsigned char* RW, unsigned krd, unsigned vrd, bf16x8 (&kf)[4], bf16x8 (&vf)[2][2], bool younger) {
    if (younger) { if (WITH_V) asm volatile("s_waitcnt vmcnt(8)" ::: "memory"); else asm volatile("s_waitcnt vmcnt(4)" ::: "memory"); } else asm volatile("s_waitcnt vmcnt(0)" ::: "memory");
    const int rk = (krd >> 7) & 7, hh = krd & 1;
#pragma unroll
    for (int ks = 0; ks < 4; ++ks) kf[ks] = *(const LAS bf16x8*)(RW + (krd & ~1u) + (((2 * ks + hh) ^ rk) << 4));
    if (WITH_V) {
#pragma unroll
        for (int q = 0; q < 4; ++q) { const int dt = q >> 1, s = q & 1; const unsigned row = (vrd >> 6) + 32 * dt; vf[dt][s] = *(const LAS bf16x8*)(RW + 4096 + row * 64 + ((((2 * hh + s)) ^ ((row >> 2) & 3)) << 4)); } }
    asm volatile("s_waitcnt lgkmcnt(0)" ::: "memory");
}
__device__ __forceinline__ f32x16 qk_tile(const bf16x8 (&kf)[4], const bf16x8 (&qf)[4]) {
    f32x16 S;
#pragma unroll
    for (int i = 0; i < 16; ++i) S[i] = 0.f;
#pragma unroll
    for (int ks = 0; ks < 4; ++ks) S = MFMA32(kf[ks], qf[ks], S);
    return S;
}
__device__ __forceinline__ void pv_tile(const float (&p)[16], const bf16x8 (&vf)[2][2], f32x16 (&O)[2]) {
#pragma unroll
    for (int s = 0; s < 2; ++s) { u32x4 w; w.x = cvtpk(p[8 * s], p[8 * s + 1]); w.y = cvtpk(p[8 * s + 2], p[8 * s + 3]); w.z = cvtpk(p[8 * s + 4], p[8 * s + 5]); w.w = cvtpk(p[8 * s + 6], p[8 * s + 7]);
        const bf16x8 pf = __builtin_bit_cast(bf16x8, w);
#pragma unroll
        for (int dt = 0; dt < 2; ++dt) O[dt] = MFMA32(vf[dt][s], pf, O[dt]); }
}
__device__ __forceinline__ void att_rest(f32x16& S, const bf16x8 (&vf)[2][2], int key0, int h, bool masked, int klo, int khi, bool colsel, float& m, float& l, f32x16 (&O)[2]) {
    if (masked) { const int kb = key0 + 4 * h;
#pragma unroll
        for (int i = 0; i < 16; ++i) { const int key = kb + (i & 3) + 8 * (i >> 2); S[i] = (key <= khi && key >= klo) ? S[i] : -INFINITY; } }
    float tmax = fmaxf(fmaxf(fmaxf(S[0], S[1]), fmaxf(S[2], S[3])), fmaxf(fmaxf(S[4], S[5]), fmaxf(S[6], S[7])));
    tmax = fmaxf(tmax, fmaxf(fmaxf(fmaxf(S[8], S[9]), fmaxf(S[10], S[11])), fmaxf(fmaxf(S[12], S[13]), fmaxf(S[14], S[15]))));
    tmax = half_max(tmax); tmax = colsel ? tmax : -INFINITY;
    if (__builtin_amdgcn_ballot_w64(tmax > m + 8.0f) != 0ull) {
        const float mn = fmaxf(m, tmax); const float ms = mn == -INFINITY ? 0.f : mn; const float alpha = __builtin_amdgcn_exp2f(m - ms);
        l *= alpha; m = mn;
#pragma unroll
        for (int dt = 0; dt < 2; ++dt)
#pragma unroll
            for (int i = 0; i < 16; ++i) O[dt][i] *= alpha;
    }
    float msx = m == -INFINITY ? 0.f : m; msx = colsel ? msx : INFINITY;
    float p[16]; float ps = 0.f;
#pragma unroll
    for (int i = 0; i < 16; ++i) { p[i] = __builtin_amdgcn_exp2f(S[i] - msx); ps += p[i]; }
    l += half_sum(ps);
    pv_tile(p, vf, O);
}
constexpr int NSA_RING0 = 16384;
static_assert(NSA_RING0 + 8 * 16384 <= LDS_SCRATCH, "attention LDS map");
__device__ __forceinline__ void phase_nsa(const Args& a, int qi, int l, LAS unsigned char* lds, int slot, int lane) {
    OPQ_SI(slot); OPQ_V(lane);
    unsigned char* ws = a.ws + opaque0();
    LAS float* impl = (LAS float*)(lds + slot * 2048);
    LAS unsigned char* RW = lds + NSA_RING0 + slot * 16384;
    const bf16* QR = (const bf16*)(ws + WS_QR); const float* P = (const float*)(ws + WS_P); const float* gate_b = INPTR(a, I_GB) + (size_t)l * 36; bf16* CAT = (bf16*)(ws + WS_CAT);
    unsigned* qctr = (unsigned*)(ws + WS_CTL) + 8192 + 64 * qi;
    const int r = lane & 31, h = lane >> 5, g = r & 3, ql = r >> 2;
    const unsigned koff = (unsigned)((lane >> 3) * 128 + (((lane & 7) ^ ((lane >> 3) & 7)) << 4)), voff = (unsigned)((lane >> 2) * 64 + (((lane & 3) ^ (((lane >> 2) >> 2) & 3)) << 4));
    const unsigned krd = (unsigned)(r * 128) | (unsigned)h, vrd = (unsigned)(r * 64);
    const int myx = (int)(xb_xcc_id() & 7u); int qsel = 0;
    for (;;) {
        int item = 0, qx = 0;
        for (;;) { qx = (myx + qsel) & 7; if (lane == 0) item = (int)atomicAdd(qctr + 8 * qx, 1u); item = __builtin_amdgcn_readfirstlane(item); if (item < 96 * 8 || qsel >= 7) break; ++qsel; }
        if (item >= 96 * 8) break;
        const int up = item >> 3, wave = item & 7, k3 = up / 3, e3 = up - 3 * k3;
        const int bk = e3 < 2 ? qx : 8 + (qx >> 1); const int qt = e3 == 0 ? 63 - 2 * k3 : (e3 == 1 ? 62 - 2 * k3 : 62 - 2 * k3 + (qx & 1));
        const int b = bk / 3, kvh = bk - b * 3;
        const int tile0 = qt * 64, cur = qt; const int qp = tile0 + 8 * wave + ql; const size_t mq = (size_t)b * SEQ + qp; const int head = kvh * 4 + g;
        bf16x8 qf[4];
#pragma unroll
        for (int ks = 0; ks < 4; ++ks) qf[ks] = *(const bf16x8*)(QR + mq * 768 + head * 64 + 16 * ks + 8 * h);
        float g0, g1, g2;
        { const float* gl = P + mq * INP + PO_GL + head * 3; const float* gb = gate_b + head * 3; g0 = sigmoidf_(gl[0] + gb[0]); g1 = sigmoidf_(gl[1] + gb[1]); g2 = sigmoidf_(gl[2] + gb[2]); }
        f32x16 out[2], O[2]; bf16x8 kf[4]; bf16x8 vf[2][2];
#pragma unroll
        for (int dt = 0; dt < 2; ++dt)
#pragma unroll
            for (int i = 0; i < 16; ++i) out[dt][i] = 0.f;
        unsigned long long mymask = (2ull << cur) - 1ull, umask = mymask;
        const int qpw = tile0 + 8 * wave + 7;
        {
            const bf16* Kb = (const bf16*)(ws + WS_KC) + (size_t)(b * 3 + kvh) * NCMPP * 64; const bf16* Vt = (const bf16*)(ws + WS_VCT) + (size_t)(b * 3 + kvh) * 8 * 2048;
            const int nvw = qpw >= 31 ? ((qpw - 31) >> 4) + 1 : 0; const int nvq = qp >= 31 ? ((qp - 31) >> 4) + 1 : 0; const int ntile = (nvw + 31) >> 5;
            const bool need_imp = cur >= 16;
            if (ntile > 0) {
                float m = -INFINITY, ls = 0.f;
                dma_tile<false>(RW, Kb, 0, koff, Vt, voff);
#pragma unroll 1
                for (int kt = 0; kt < ntile; ++kt) { read_tile<false>(RW, krd, vrd, kf, vf, false); if (kt + 1 < ntile) dma_tile<false>(RW, Kb, 32 * (kt + 1), koff, Vt, voff); else dma_tile<true>(RW, Kb, 0, koff, Vt, voff);
                    const f32x16 S = qk_tile(kf, qf);
                    float tmax = -INFINITY; float sv[16];
#pragma unroll
                    for (int i = 0; i < 16; ++i) { const int n = 32 * kt + (i & 3) + 8 * (i >> 2) + 4 * h; sv[i] = n < nvq ? S[i] : -INFINITY; tmax = fmaxf(tmax, sv[i]); }
                    tmax = half_max(tmax); const float mn = fmaxf(m, tmax); const float ms = mn == -INFINITY ? 0.f : mn; float ps = 0.f;
#pragma unroll
                    for (int i = 0; i < 16; ++i) ps += __builtin_amdgcn_exp2f(sv[i] - ms);
                    ls = ls * __builtin_amdgcn_exp2f(m - ms) + half_sum(ps); m = mn; }
                const float ms = m == -INFINITY ? 0.f : m; const float inv = 1.0f / fmaxf(ls, 1.17549435e-38f);
                float carry = 0.f;
#pragma unroll
                for (int dt = 0; dt < 2; ++dt)
#pragma unroll
                    for (int i = 0; i < 16; ++i) O[dt][i] = 0.f;
                if (need_imp) {
#pragma unroll
                    for (int i = 0; i < 8; ++i) impl[i * 64 + lane] = 0.f;
                    WSYNC(); }
#pragma unroll 1
                for (int kt = 0; kt < ntile; ++kt) {
                    read_tile<true>(RW, krd, vrd, kf, vf, false); if (kt + 1 < ntile) dma_tile<true>(RW, Kb, 32 * (kt + 1), koff, Vt, voff);
                    const f32x16 S = qk_tile(kf, qf);
                    float p[16];
#pragma unroll
                    for (int i = 0; i < 16; ++i) { const int n = 32 * kt + (i & 3) + 8 * (i >> 2) + 4 * h; p[i] = n < nvq ? __builtin_amdgcn_exp2f(S[i] - ms) * inv : 0.f; }
                    if (need_imp) {
                        float val[4];
#pragma unroll
                        for (int t = 0; t < 4; ++t) { const float sp = 0.5f * p[4 * t + 3]; const float base = (p[4 * t] + p[4 * t + 1]) + (p[4 * t + 2] + sp); const float rv = other_half(sp, h);
                            val[t] = base + (h ? rv : carry); carry = h ? 0.f : rv; }
#pragma unroll
                        for (int t = 0; t < 4; ++t) { float v = val[t]; v += dpp_f<0xB1>(v); v += dpp_f<0x4E>(v); if (g == 0) impl[ql * 64 + 8 * kt + 2 * t + h] = v; }
                    }
                    pv_tile(p, vf, O);
                }
#pragma unroll
                for (int dt = 0; dt < 2; ++dt)
#pragma unroll
                    for (int i = 0; i < 16; ++i) out[dt][i] = O[dt][i] * g0;
                if (need_imp) {
                    WSYNC();
#pragma unroll 1
                    for (int q = 0; q < 8; ++q) { const float v = impl[q * 64 + lane]; const bool forced = lane == 0 || lane == cur || lane == cur - 1; impl[q * 64 + lane] = lane > cur ? -INFINITY : (forced ? 1e9f : v); }
                    WSYNC();
                    umask = 0ull;
#pragma unroll 1
                    for (int q = 0; q < 8; ++q) { const float sc = impl[q * 64 + lane]; int rank = 0;
#pragma unroll 4
                        for (int i4 = 0; i4 < 16; ++i4) { const f32x4 o = *(const LAS f32x4*)(impl + q * 64 + 4 * i4);
                            rank += (o.x > sc || (o.x == sc && 4 * i4 + 0 < lane)) ? 1 : 0; rank += (o.y > sc || (o.y == sc && 4 * i4 + 1 < lane)) ? 1 : 0;
                            rank += (o.z > sc || (o.z == sc && 4 * i4 + 2 < lane)) ? 1 : 0; rank += (o.w > sc || (o.w == sc && 4 * i4 + 3 < lane)) ? 1 : 0; }
                        const unsigned long long mk = __ballot(lane <= cur && rank < 16);
                        umask |= mk; if (ql == q) mymask = mk; }
                    WSYNC();
                }
            }
        }
        {
            const bf16* Kb = (const bf16*)(ws + WS_KS) + (size_t)(b * 3 + kvh) * SEQ * 64; const bf16* Vt = (const bf16*)(ws + WS_VST) + (size_t)(b * 3 + kvh) * 128 * 2048;
            float m = -INFINITY, ls = 0.f;
#pragma unroll
            for (int dt = 0; dt < 2; ++dt)
#pragma unroll
                for (int i = 0; i < 16; ++i) O[dt][i] = 0.f;
            unsigned long long um = umask; int hf = 0;
#define SEL_NEXT(have, jb, key0) do { have = um != 0ull; if (have) { jb = __builtin_ctzll(um); key0 = 64 * jb + 32 * hf; if (hf == 0 && 64 * jb + 32 <= qpw) hf = 1; else { hf = 0; um &= um - 1ull; } } } while (0)
            bool h0, h1; int j0 = 0, k0 = 0, j1 = 0, k1 = 0, sl = 0;
            SEL_NEXT(h0, j0, k0); if (h0) dma_tile<true>(RW, Kb, k0, koff, Vt, voff);
            SEL_NEXT(h1, j1, k1); if (h1) dma_tile<true>(RW + 8192, Kb, k1, koff, Vt, voff);
#pragma unroll 1
            while (h0) {
                read_tile<true>(RW + sl * 8192, krd, vrd, kf, vf, h1);
                bool h2; int j2 = 0, k2 = 0; SEL_NEXT(h2, j2, k2); if (h2) dma_tile<true>(RW + sl * 8192, Kb, k2, koff, Vt, voff);
                f32x16 S = qk_tile(kf, qf);
                att_rest(S, vf, k0, h, j0 == cur, -0x7fffffff, qp, (mymask >> j0) & 1ull, m, ls, O);
                h0 = h1; j0 = j1; k0 = k1; h1 = h2; j1 = j2; k1 = k2; sl ^= 1;
            }
#undef SEL_NEXT
            const float sc = g1 / fmaxf(ls, 1.17549435e-38f);
#pragma unroll
            for (int dt = 0; dt < 2; ++dt)
#pragma unroll
                for (int i = 0; i < 16; ++i) out[dt][i] += O[dt][i] * sc;
        }
        {
            const bf16* Kb = (const bf16*)(ws + WS_KW) + (size_t)(b * 3 + kvh) * SEQ * 64; const bf16* Vt = (const bf16*)(ws + WS_VWT) + (size_t)(b * 3 + kvh) * 128 * 2048;
            float m = -INFINITY, ls = 0.f;
#pragma unroll
            for (int dt = 0; dt < 2; ++dt)
#pragma unroll
                for (int i = 0; i < 16; ++i) O[dt][i] = 0.f;
            const int q0w = tile0 + 8 * wave; const int lo = q0w - 511 > 0 ? q0w - 511 : 0;
            const int tEnd = (q0w + 7) >> 5; int t = lo >> 5;
            dma_tile<true>(RW, Kb, 32 * t, koff, Vt, voff); if (t + 1 <= tEnd) dma_tile<true>(RW + 8192, Kb, 32 * (t + 1), koff, Vt, voff);
            int sl = 0;
#pragma unroll 1
            for (; t <= tEnd; ++t) {
                read_tile<true>(RW + sl * 8192, krd, vrd, kf, vf, t + 1 <= tEnd);
                if (t + 2 <= tEnd) dma_tile<true>(RW + sl * 8192, Kb, 32 * (t + 2), koff, Vt, voff);
                f32x16 S = qk_tile(kf, qf);
                att_rest(S, vf, 32 * t, h, !(32 * t >= q0w + 7 - 511 && 32 * t + 31 <= q0w), qp - 511, qp, true, m, ls, O);
                sl ^= 1;
            }
            const float sc = g2 / fmaxf(ls, 1.17549435e-38f);
            bf16* op = CAT + mq * DM + DRW + DPOOL + head * 64 + 4 * h;
#pragma unroll
            for (int dt = 0; dt < 2; ++dt)
#pragma unroll
                for (int t2 = 0; t2 < 4; ++t2) { u32x2 w; w.x = cvtpk(out[dt][4 * t2] + O[dt][4 * t2] * sc, out[dt][4 * t2 + 1] + O[dt][4 * t2 + 1] * sc); w.y = cvtpk(out[dt][4 * t2 + 2] + O[dt][4 * t2 + 2] * sc, out[dt][4 * t2 + 3] + O[dt][4 * t2 + 3] * sc);
                    *(u32x2*)(op + 32 * dt + 8 * t2) = w; }
        }
    }
}

__device__ __forceinline__ void phase_rwkv_out(const Args& a, int l, int gw, int NGW, int lane) {
    OPQ_SI(gw); OPQ_V(lane);
    unsigned char* ws = a.ws + opaque0(); const float* YS = (const float*)(ws + WS_YS); const float* vV = (const float*)(ws + WS_SV + 5 * SV_STRIDE); const float* vG = (const float*)(ws + WS_G); const float* SC = (const float*)(ws + WS_SC);
    const float* gng = INPTR(a, I_GNG) + (size_t)l * DRW; const float* gnb = INPTR(a, I_GNB) + (size_t)l * DRW; bf16* CAT = (bf16*)(ws + WS_CAT);
    for (int id = gw; id < MTOK * 12; id += NGW) { const int m = id / 12, h = id - m * 12, c = h * 64 + lane; const size_t o = (size_t)m * DRW + c;
        const float y = YS[o]; const float mean = wave_sum(y) * (1.f / 64.f); const float d = y - mean; const float var = wave_sum(d * d) * (1.f / 64.f);
        const float yn = d * (1.f / sqrtf(var + GN_EPS)) * gng[c] + gnb[c]; const float bonus = SC[((size_t)m * 12 + h) * 4 + 2] * vV[o];
        CAT[(size_t)m * DM + c] = (bf16)f2bf((yn + bonus) * vG[o]); }
}

template <int PHMASK> __global__ void __launch_bounds__(NTHR, 2) fwd(Args args) {
    extern __shared__ __attribute__((aligned(16))) unsigned char lds_raw[];
    LAS unsigned char* lds = (LAS unsigned char*)lds_raw;
    const int tid = threadIdx.x, lane = tid & 63, wave = __builtin_amdgcn_readfirstlane(tid >> 6);
    const int G = gridDim.x, bid = blockIdx.x; const int gw = bid * NWAVES + wave, NGW = G * NWAVES;
    unsigned char* ws = args.ws;
    for (int u = tid; u < (LDS_BYTES - LDS_SCRATCH) / 4; u += NTHR) ((LAS unsigned*)(lds + LDS_SCRATCH))[u] = 0u;
    __syncthreads();
    const int lo = args.ph_lo, hi = args.ph_hi;
    XcdBarrier bar; bar.bar = (unsigned*)(ws + WS_CTL) + 4096; bar.x = 0; bar.st = nullptr;
    if (hi - lo > 1) bar = xcd_barrier_post((unsigned*)(ws + WS_CTL) + 4096, (volatile LAS unsigned*)(lds + MISC_OFF) + 8);
#define IN(k) (lo <= (k) && (k) < hi)
#define PHEN(j) (((PHMASK) >> (j)) & 1)
#ifndef REP_MASK
#define REP_MASK 0
#endif
#define SEAM(k) do { if ((k) + 1 < hi) xcd_barrier(bar); } while (0)
    bf16* XB = (bf16*)(ws + WS_XB); bf16* Hb = (bf16*)(ws + WS_H); float* Y = (float*)(ws + WS_Y); float* Pm = (float*)(ws + WS_P); bf16* CAT = (bf16*)(ws + WS_CAT);

    if (PHEN(0) && IN(0)) { phase_prologue(args, bid * NTHR + tid, G * NTHR); SEAM(0); }
    for (int l = 0; l < NLAYER; ++l) {
        const int pb = 1 + 14 * l;
        for (int rep = 0; rep < (((REP_MASK) >> 1) & 1 ? 2 : 1); ++rep) if (PHEN(1) && IN(pb + 0)) { phase_wconv(args, l, lds, gw, NGW, wave, lane); SEAM(pb + 0); }
        for (int rep = 0; rep < (((REP_MASK) >> 2) & 1 ? 2 : 1); ++rep) if (PHEN(2) && IN(pb + 1)) {
            pg8::Gemm g{XB, (const bf16*)(ws + WS_WUP1), MTOK, NUP, DM}; pg8::StaticOrder S; S.init(MTOK, NUP, G, bid); pg8::EpiSwiGLU E{Hb, DFF};
            pg8::gemm_phase<pg8::EpiSwiGLU, pg8::StaticOrder, true, true>(lds, g, S, E); SEAM(pb + 1); }
        for (int rep = 0; rep < (((REP_MASK) >> 3) & 1 ? 2 : 1); ++rep) if (PHEN(3) && IN(pb + 2)) {
            pg8::Gemm g{Hb, (const bf16*)(ws + WS_WDN1), MTOK, DM, DFF}; pg8::StaticOrder S; S.init(MTOK, DM, G, bid); pg8::EpiResid E{l == 0 ? INPTR(args, I_X) : args.out, Y, DM, ALPHA, 0.5f};
            pg8::gemm_phase<pg8::EpiResid, pg8::StaticOrder, true, true>(lds, g, S, E); SEAM(pb + 2); }
        for (int rep = 0; rep < (((REP_MASK) >> 4) & 1 ? 2 : 1); ++rep) if (PHEN(4) && IN(pb + 3)) { phase_ln(Y, INPTR(args, I_LN1G) + (size_t)l * DM, INPTR(args, I_LN1B) + (size_t)l * DM, args.out, XB, gw, NGW, lane); SEAM(pb + 3); }
        for (int rep = 0; rep < (((REP_MASK) >> 5) & 1 ? 2 : 1); ++rep) if (PHEN(5) && IN(pb + 4)) {
            pg8::Gemm g{XB, (const bf16*)(ws + WS_WIN), MTOK, INP, DM}; pg8::StaticOrder S; S.init(MTOK, INP, G, bid); pg8::EpiF32 E{Pm, INP};
            pg8::gemm_phase<pg8::EpiF32, pg8::StaticOrder, true, true>(lds, g, S, E); SEAM(pb + 4); }
        for (int rep = 0; rep < (((REP_MASK) >> 6) & 1 ? 2 : 1); ++rep) if (PHEN(6) && IN(pb + 5)) { phase_m1(args, l, lds, bid, G, tid, wave, lane); SEAM(pb + 5); }
        for (int rep = 0; rep < (((REP_MASK) >> 7) & 1 ? 2 : 1); ++rep) if (PHEN(7) && IN(pb + 6)) { phase_scan_prep(args, lds, gw, NGW, wave, lane); SEAM(pb + 6); }
        for (int rep = 0; rep < (((REP_MASK) >> 8) & 1 ? 2 : 1); ++rep) if (PHEN(8) && IN(pb + 7)) { for (int r2 = 0; r2 < (((REP_MASK) >> 20) & 1 ? 2 : 1); ++r2) { if (bid < 96 && wave == 0) scan_seq(args, lds, bid, lane); } for (int r3 = 0; r3 < (((REP_MASK) >> 21) & 1 ? 2 : 1); ++r3) if (!(bid < 96 && wave == 1)) phase_nsa(args, l + 4 * rep + 8 * r3, l, lds, wave, lane); SEAM(pb + 7); }
        for (int rep = 0; rep < (((REP_MASK) >> 9) & 1 ? 2 : 1); ++rep) if (PHEN(9) && IN(pb + 8)) { phase_rwkv_out(args, l, gw, NGW, lane); SEAM(pb + 8); }
        for (int rep = 0; rep < (((REP_MASK) >> 10) & 1 ? 2 : 1); ++rep) if (PHEN(10) && IN(pb + 9)) {
            pg8::Gemm g{CAT, (const bf16*)(ws + WS_WOUT), MTOK, DM, DM}; pg8::StaticOrder S; S.init(MTOK, DM, G, bid); pg8::EpiResid E{args.out, Y, DM, ALPHA, 1.0f};
            pg8::gemm_phase<pg8::EpiResid, pg8::StaticOrder, true, true>(lds, g, S, E); SEAM(pb + 9); }
        for (int rep = 0; rep < (((REP_MASK) >> 11) & 1 ? 2 : 1); ++rep) if (PHEN(11) && IN(pb + 10)) { phase_ln(Y, INPTR(args, I_LN2G) + (size_t)l * DM, INPTR(args, I_LN2B) + (size_t)l * DM, args.out, XB, gw, NGW, lane); SEAM(pb + 10); }
        for (int rep = 0; rep < (((REP_MASK) >> 12) & 1 ? 2 : 1); ++rep) if (PHEN(12) && IN(pb + 11)) {
            pg8::Gemm g{XB, (const bf16*)(ws + WS_WUP2), MTOK, NUP, DM}; pg8::StaticOrder S; S.init(MTOK, NUP, G, bid); pg8::EpiSwiGLU E{Hb, DFF};
            pg8::gemm_phase<pg8::EpiSwiGLU, pg8::StaticOrder, true, true>(lds, g, S, E); SEAM(pb + 11); }
        for (int rep = 0; rep < (((REP_MASK) >> 13) & 1 ? 2 : 1); ++rep) if (PHEN(13) && IN(pb + 12)) {
            pg8::Gemm g{Hb, (const bf16*)(ws + WS_WDN2), MTOK, DM, DFF}; pg8::StaticOrder S; S.init(MTOK, DM, G, bid); pg8::EpiResid E{args.out, Y, DM, ALPHA, 0.5f};
            pg8::gemm_phase<pg8::EpiResid, pg8::StaticOrder, true, true>(lds, g, S, E); SEAM(pb + 12); }
        for (int rep = 0; rep < (((REP_MASK) >> 14) & 1 ? 2 : 1); ++rep) if (PHEN(14) && IN(pb + 13)) { phase_ln(Y, INPTR(args, I_LN3G) + (size_t)l * DM, INPTR(args, I_LN3B) + (size_t)l * DM, args.out, XB, gw, NGW, lane); SEAM(pb + 13); }
    }
#undef IN
#undef SEAM
}

#ifndef ONE_MASK
#define ONE_MASK 0xFFFFF
#endif
#ifndef MK_ONE_LAUNCH
#define MK_ONE_LAUNCH 1
#endif
typedef void (*kern_t)(Args);
extern "C" void kernel_launch(void* const* d_in, const int* in_sizes, int n_in, void* d_out, int out_size, void* d_ws, size_t ws_size, hipStream_t stream) {
    static int grid = 0;
#if MK_ONE_LAUNCH
    static const kern_t kerns[1] = {fwd<ONE_MASK>};
    constexpr int NK = 1;
#else
    static const kern_t kerns[15] = {fwd<1 << 0>, fwd<1 << 1>, fwd<1 << 2>, fwd<1 << 3>, fwd<1 << 4>, fwd<1 << 5>, fwd<1 << 6>, fwd<1 << 7>, fwd<1 << 8>, fwd<1 << 9>, fwd<1 << 10>, fwd<1 << 11>, fwd<1 << 12>, fwd<1 << 13>, fwd<1 << 14>};
    constexpr int NK = 15;
#endif
    if (grid == 0) {
        if (n_in != 34 || out_size != MTOK * DM || ws_size < WS_END) { fprintf(stderr, "kernel_launch: unexpected shapes (n_in %d, out %d, ws %zu; need ws >= %zu)\n", n_in, out_size, ws_size, (size_t)WS_END); grid = -1; return; }
        int dev = 0, cus = 0;
        if (hipGetDevice(&dev) != hipSuccess || hipDeviceGetAttribute(&cus, hipDeviceAttributeMultiprocessorCount, dev) != hipSuccess) { grid = -1; return; }
        for (int i = 0; i < NK; ++i) if (hipFuncSetAttribute((const void*)kerns[i], hipFuncAttributeMaxDynamicSharedMemorySize, LDS_BYTES) != hipSuccess) { fprintf(stderr, "kernel_launch: hipFuncSetAttribute failed\n"); grid = -1; return; }
        int per_cu = 0;
        if (hipOccupancyMaxActiveBlocksPerMultiprocessor(&per_cu, (const void*)kerns[0], NTHR, LDS_BYTES) != hipSuccess || per_cu < 1) fprintf(stderr, "kernel_launch: occupancy query says %d blocks per CU\n", per_cu);
        (void)hipGetLastError();
        grid = cus;
    }
    if (grid < 0) return;
    (void)hipMemsetAsync((char*)d_ws + WS_CTL, 0, CTL_ZERO_BYTES, stream);
    Args a{};
    for (int i = 0; i < 34; ++i) a.in[i] = (const float*)d_in[i];
    a.out = (float*)d_out; a.ws = (unsigned char*)d_ws;
#if MK_ONE_LAUNCH
    a.ph_lo = 0; a.ph_hi = NPH;
    hipLaunchKernelGGL(kerns[0], dim3(grid), dim3(NTHR), LDS_BYTES, stream, a);
#else
#ifndef HOST_REP
#define HOST_REP 0
#endif
    for (int k = 0; k < NPH; ++k) { a.ph_lo = k; a.ph_hi = k + 1; const int j = k == 0 ? 0 : (k - 1) % 14 + 1;
        for (int rep = 0; rep < (((HOST_REP) >> j) & 1 ? 2 : 1); ++rep) {
            if (rep && j == 8) (void)hipMemsetAsync((char*)d_ws + WS_CTL + (8192 + 64 * ((k - 1) / 14)) * 4, 0, 256, stream);
            hipLaunchKernelGGL(kerns[j], dim3(grid), dim3(NTHR), LDS_BYTES, stream, a); } }
#endif
}
```

```cpp
#include <hip/hip_runtime.h>
#include <cstdio>
#include <cstdint>
namespace pg8 {
#define PG8_LAS __attribute__((address_space(3)))
typedef unsigned short bf16_t;
typedef short bf16x8 __attribute__((ext_vector_type(8)));
typedef float f32x4 __attribute__((ext_vector_type(4)));
typedef unsigned u32x4 __attribute__((ext_vector_type(4)));
constexpr int BM = 256, BK = 64, HALF = 128, HTB = HALF * BK * 2  , STAGE_BYTES = 8 * HTB, NXCD = 8, WGM = 8;

__host__ __device__ __forceinline__ int lds_byte(int r, int c) { const int st = (r >> 4) * 2 + (c >> 5), rr = r & 15, cc = c & 31, ob = rr * 64 + cc * 2; return st * 1024 + (ob ^ (((ob >> 9) & 1) << 5)); }
__host__ __device__ __forceinline__ void stage_rc(int b, int& R, int& C) { const int st = b / 1024, sb = b % 1024, swz = sb ^ (((sb >> 9) & 1) << 5); R = (st >> 1) * 16 + swz / 64; C = (st & 1) * 32 + (swz % 64) / 2; }
__host__ __device__ __forceinline__ int perm32(int rho) { const int n = rho >> 4, i = rho & 15; return 8 * (i >> 2) + 4 * n + (i & 3); }

struct Unit { int pm, pn; };
struct Gemm { const bf16_t* A; const bf16_t* Bt; int M, N, K; };

struct StaticOrder {
    int nM, nN, nwg, G, c;
    __host__ __device__ void init(int M, int N, int G_, int c_) { nM = M / BM; nN = N / BM; nwg = nM * nN; G = G_; c = c_; }
    __host__ __device__ bool next(int i, Unit& u) const {
        const long L = (long)i * G + c; if (L >= nwg) return false;
        int wgid = (int)L; { const int q = nwg / NXCD, r = nwg % NXCD, xcd = wgid % NXCD, off = wgid / NXCD; wgid = (xcd < r ? xcd * (q + 1) : r * (q + 1) + (xcd - r) * q) + off; }
        const int nig = WGM * nN, gid = wgid / nig, fm = gid * WGM, gsz = (nM - fm) < WGM ? (nM - fm) : WGM;
        u.pm = fm + ((wgid % nig) % gsz); u.pn = (wgid % nig) / gsz; return true;
    }
    __device__ __forceinline__ void a_ready(const Unit&) const {}
    __device__ __forceinline__ void done(const Unit&) const {}
};

__device__ __forceinline__ unsigned cvt_pk_bf16(float lo, float hi) { unsigned r; asm volatile("v_cvt_pk_bf16_f32 %0, %1, %2" : "=v"(r) : "v"(lo), "v"(hi)); return r; }
typedef float f32x2 __attribute__((ext_vector_type(2)));
struct EpiSwiGLU {
    static constexpr bool PERM = true, AFTER_DRAIN = false;
    bf16_t* H; int ldh;
    __device__ __forceinline__ void operator()(const f32x4 (&acc)[2][2][4][2], const Unit& u, int wr, int wc, int fr, int fq) const {
        const int row0 = u.pm * BM + wr * 64 + fr, col0 = u.pn * HALF + wc * 32 + 8 * fq;
#pragma unroll
        for (int ai = 0; ai < 2; ++ai)
#pragma unroll
            for (int m = 0; m < 4; ++m) { bf16_t* rowp = H + (size_t)(row0 + ai * HALF + m * 16) * ldh + col0;
                float hv[8];
#pragma unroll
                for (int n = 0; n < 2; ++n)
#pragma unroll
                    for (int i = 0; i < 4; ++i) { const float a = acc[ai][0][m][n][i], b = acc[ai][1][m][n][i];
                        const float e = __builtin_amdgcn_exp2f(a * -1.44269504089f); hv[n * 4 + i] = a * __builtin_amdgcn_rcpf(1.0f + e) * b; }
                u32x4 w; w.x = cvt_pk_bf16(hv[0], hv[1]); w.y = cvt_pk_bf16(hv[2], hv[3]); w.z = cvt_pk_bf16(hv[4], hv[5]); w.w = cvt_pk_bf16(hv[6], hv[7]);
                *(u32x4*)rowp = w; }
    }
};
struct EpiResid {
    static constexpr bool PERM = false, AFTER_DRAIN = false;
    const float* X; float* Y; int ldc; float alpha, s; int ln;
    __device__ __forceinline__ void operator()(const f32x4 (&acc)[2][2][4][2], const Unit& u, int wr, int wc, int fr, int fq) const {
        const int row0 = u.pm * BM + wr * 64 + fr, col0 = u.pn * BM + wc * 32 + 4 * fq;
#pragma unroll
        for (int ai = 0; ai < 2; ++ai)
#pragma unroll
            for (int m = 0; m < 4; ++m) { const int row = row0 + ai * HALF + m * 16; const size_t off = (size_t)row * ldc + col0;
                const float* stats = Y + (size_t)16384 * 2048; const float* lng = stats + 2 * 16384; const float* lnb = lng + 2048;
                f32x2 st = {0.f, 1.f}; if (ln) st = *(const f32x2*)(stats + 2 * (size_t)row);
#pragma unroll
                for (int bj = 0; bj < 2; ++bj)
#pragma unroll
                    for (int n = 0; n < 2; ++n) { f32x4 xv = *(const f32x4*)(X + off + bj * HALF + n * 16);
                        if (ln) { const f32x4 gv = *(const f32x4*)(lng + col0 + bj * HALF + n * 16), bv = *(const f32x4*)(lnb + col0 + bj * HALF + n * 16); xv = (xv - st.x) * st.y * gv + bv; }
                        *(f32x4*)(Y + off + bj * HALF + n * 16) = xv * alpha + acc[ai][bj][m][n] * s; }
                asm volatile("" ::: "memory"); }
    }
};
struct EpiF32 {
    static constexpr bool PERM = false, AFTER_DRAIN = false;
    float* C; int ldc;
    __device__ __forceinline__ void operator()(const f32x4 (&acc)[2][2][4][2], const Unit& u, int wr, int wc, int fr, int fq) const {
        const int row0 = u.pm * BM + wr * 64 + fr, col0 = u.pn * BM + wc * 32 + 4 * fq;
#pragma unroll
        for (int ai = 0; ai < 2; ++ai)
#pragma unroll
            for (int m = 0; m < 4; ++m) { float* rowp = C + (size_t)(row0 + ai * HALF + m * 16) * ldc + col0;
#pragma unroll
                for (int bj = 0; bj < 2; ++bj)
#pragma unroll
                    for (int n = 0; n < 2; ++n) *(f32x4*)(rowp + bj * HALF + n * 16) = acc[ai][bj][m][n]; }
    }
};

template <class Epi, class Sched, bool ALIGN_EPI = false, bool SP2 = false>
__device__ __forceinline__ void gemm_phase(PG8_LAS unsigned char* lds, const Gemm g, const Sched& S, const Epi& E) {
    int tid_ = threadIdx.x; asm volatile("" : "+v"(tid_));
    const int tid = tid_, wid = __builtin_amdgcn_readfirstlane(tid >> 6), lane = tid & 63, wr = wid >> 2, wc = wid & 3, fr = lane & 15, fq = lane >> 4;
    const int K = g.K, nt = K / BK;
    unsigned voffA[2], voffB[2];
#pragma unroll
    for (int i = 0; i < 2; ++i) { int R, C; stage_rc(tid * 16 + i * 8192, R, C); const int Rb = Epi::PERM ? ((R & ~31) + perm32(R & 31)) : R;
        voffA[i] = (unsigned)(R * K + C) * 2u; voffB[i] = (unsigned)(Rb * K + C) * 2u; }
    const size_t kstep = (size_t)(BK * 2);
    const size_t hstep = (size_t)HALF * K * 2;
    const size_t tstep = 2 * hstep;
    const unsigned ldsw = (unsigned)wid * 1024u;
    const int aoff = lds_byte(wr * 64 + fr, fq * 8), boff = lds_byte(wc * 32 + fr, fq * 8);
#define PG8_SA(b, h) (((b) * 2 + (h)) * HTB)
#define PG8_SB(b, h) ((4 + (b) * 2 + (h)) * HTB)
#define PG8_STAGE(bufoff, gbase, voff) do { _Pragma("unroll") for (int _i = 0; _i < 2; ++_i) \
        __builtin_amdgcn_global_load_lds((const unsigned*)((const char*)(gbase) + (voff)[_i]), (PG8_LAS unsigned*)(lds + (bufoff) + ldsw + _i * 8192), 16, 0, 0); } while (0)
#define PG8_LDA(dst, b, h) do { _Pragma("unroll") for (int m = 0; m < 4; ++m) _Pragma("unroll") for (int k = 0; k < 2; ++k) dst[m][k] = *(const PG8_LAS bf16x8*)(lds + PG8_SA(b, h) + aoff + m * 2048 + k * 1024); } while (0)
#define PG8_LDB(dst, b, h) do { _Pragma("unroll") for (int n = 0; n < 2; ++n) _Pragma("unroll") for (int k = 0; k < 2; ++k) dst[n][k] = *(const PG8_LAS bf16x8*)(lds + PG8_SB(b, h) + boff + n * 2048 + k * 1024); } while (0)
#define PG8_MMA(ai, bj, At, Bt) do { __builtin_amdgcn_s_setprio(1); _Pragma("unroll") for (int m = 0; m < 4; ++m) _Pragma("unroll") for (int n = 0; n < 2; ++n) _Pragma("unroll") for (int k = 0; k < 2; ++k) \
        acc[ai][bj][m][n] = __builtin_amdgcn_mfma_f32_16x16x32_bf16(Bt[n][k], At[m][k], acc[ai][bj][m][n], 0, 0, 0); __builtin_amdgcn_s_setprio(0); } while (0)
#define PG8_WAIT_V(n) asm volatile("s_waitcnt vmcnt(" #n ")" ::: "memory")
#define PG8_WAIT_L(n) asm volatile("s_waitcnt lgkmcnt(" #n ")" ::: "memory")
#define PG8_BAR __builtin_amdgcn_s_barrier()
#define PG8_SCHED __builtin_amdgcn_sched_barrier(0)
    Unit cur, nxt; int ui = 0;
    if (!S.next(0, cur)) return;
    f32x4 acc[2][2][4][2];
#pragma unroll
    for (int a = 0; a < 2; ++a)
#pragma unroll
        for (int b = 0; b < 2; ++b)
#pragma unroll
            for (int m = 0; m < 4; ++m)
#pragma unroll
                for (int n = 0; n < 2; ++n) acc[a][b][m][n] = (f32x4){0.f, 0.f, 0.f, 0.f};
    bf16x8 At[4][2], B0[2][2], B1[2][2];
    const char* cA = (const char*)g.A + (size_t)cur.pm * tstep; const char* cB = (const char*)g.Bt + (size_t)cur.pn * tstep;
    S.a_ready(cur);
    if constexpr (SP2) {
        PG8_STAGE(PG8_SB(0, 0), cB, voffB); PG8_STAGE(PG8_SB(0, 1), cB + hstep, voffB); PG8_STAGE(PG8_SA(0, 0), cA, voffA); PG8_STAGE(PG8_SA(0, 1), cA + hstep, voffA);
        if (wr == 1) PG8_BAR;
        PG8_WAIT_V(2); PG8_BAR;
        PG8_STAGE(PG8_SB(1, 0), cB + kstep, voffB); PG8_STAGE(PG8_SA(1, 0), cA + kstep, voffA); PG8_STAGE(PG8_SB(1, 1), cB + hstep + kstep, voffB);
        PG8_WAIT_V(6); PG8_BAR;
    } else {
        PG8_STAGE(PG8_SB(0, 0), cB, voffB); PG8_STAGE(PG8_SA(0, 0), cA, voffA); PG8_STAGE(PG8_SB(0, 1), cB + hstep, voffB); PG8_STAGE(PG8_SA(0, 1), cA + hstep, voffA);
        if (wr == 1) PG8_BAR;
        PG8_WAIT_V(4); PG8_BAR;
        PG8_STAGE(PG8_SB(1, 0), cB + kstep, voffB); PG8_STAGE(PG8_SA(1, 0), cA + kstep, voffA); PG8_STAGE(PG8_SB(1, 1), cB + hstep + kstep, voffB);
        PG8_WAIT_V(6); PG8_BAR;
    }
    for (;;) {
        const bool has_next = S.next(ui + 1, nxt);
        const char* nA = has_next ? (const char*)g.A + (size_t)nxt.pm * tstep : cA; const char* nB = has_next ? (const char*)g.Bt + (size_t)nxt.pn * tstep : cB;
        for (int t = 0; t < nt; t += 2) {
            const bool last = (t == nt - 2);
            const char* a1 = cA + (size_t)(t + 1) * kstep;
            const char* a2 = last ? nA : cA + (size_t)(t + 2) * kstep; const char* b2 = last ? nB : cB + (size_t)(t + 2) * kstep;
            const char* a3 = a2 + kstep; const char* b3 = b2 + kstep;
            if (last && has_next) S.a_ready(nxt);
            if constexpr (SP2) {
            PG8_LDB(B0, 0, 0); PG8_LDB(B1, 0, 1); PG8_SCHED; PG8_LDA(At, 0, 0); PG8_STAGE(PG8_SA(1, 1), a1 + hstep, voffA);
            PG8_WAIT_V(8); PG8_WAIT_L(0); PG8_BAR; PG8_MMA(0, 0, At, B0); PG8_MMA(0, 1, At, B1); PG8_BAR; PG8_SCHED;
            PG8_LDA(At, 0, 1); PG8_STAGE(PG8_SB(0, 0), b2, voffB); PG8_STAGE(PG8_SB(0, 1), b2 + hstep, voffB); PG8_STAGE(PG8_SA(0, 0), a2, voffA);
            PG8_WAIT_V(8); PG8_WAIT_L(0); PG8_BAR; PG8_MMA(1, 0, At, B0); PG8_MMA(1, 1, At, B1); PG8_BAR; PG8_SCHED;
            PG8_LDB(B0, 1, 0); PG8_LDB(B1, 1, 1); PG8_SCHED; PG8_LDA(At, 1, 0); PG8_STAGE(PG8_SA(0, 1), a2 + hstep, voffA);
            PG8_WAIT_V(8); PG8_WAIT_L(0); PG8_BAR; PG8_MMA(0, 0, At, B0); PG8_MMA(0, 1, At, B1); PG8_BAR; PG8_SCHED;
            PG8_LDA(At, 1, 1); PG8_STAGE(PG8_SB(1, 0), b3, voffB); PG8_STAGE(PG8_SB(1, 1), b3 + hstep, voffB); PG8_STAGE(PG8_SA(1, 0), a3, voffA);
            PG8_WAIT_V(8); PG8_WAIT_L(0); PG8_BAR; PG8_MMA(1, 0, At, B0); PG8_MMA(1, 1, At, B1); PG8_BAR; PG8_SCHED;
            } else {
            PG8_LDB(B0, 0, 0); PG8_SCHED; PG8_LDA(At, 0, 0); PG8_STAGE(PG8_SA(1, 1), a1 + hstep, voffA);
            PG8_WAIT_L(8); PG8_BAR; PG8_WAIT_L(0); PG8_MMA(0, 0, At, B0); PG8_BAR; PG8_SCHED;
            PG8_LDB(B1, 0, 1); PG8_STAGE(PG8_SB(0, 0), b2, voffB);
            PG8_BAR; PG8_WAIT_L(0); PG8_MMA(0, 1, At, B1); PG8_BAR;
            PG8_LDA(At, 0, 1); PG8_STAGE(PG8_SA(0, 0), a2, voffA);
            PG8_BAR; PG8_WAIT_L(0); PG8_MMA(1, 0, At, B0); PG8_BAR; PG8_SCHED;
            PG8_STAGE(PG8_SB(0, 1), b2 + hstep, voffB);
            PG8_WAIT_V(6); PG8_BAR; PG8_MMA(1, 1, At, B1); PG8_BAR;
            PG8_LDB(B0, 1, 0); PG8_SCHED; PG8_LDA(At, 1, 0); PG8_STAGE(PG8_SA(0, 1), a2 + hstep, voffA);
            PG8_WAIT_L(8); PG8_BAR; PG8_WAIT_L(0); PG8_MMA(0, 0, At, B0); PG8_BAR; PG8_SCHED;
            PG8_LDB(B1, 1, 1); PG8_STAGE(PG8_SB(1, 0), b3, voffB);
            PG8_BAR; PG8_WAIT_L(0); PG8_MMA(0, 1, At, B1); PG8_BAR;
            PG8_LDA(At, 1, 1); PG8_STAGE(PG8_SA(1, 0), a3, voffA);
            PG8_BAR; PG8_WAIT_L(0); PG8_MMA(1, 0, At, B0); PG8_BAR; PG8_SCHED;
            PG8_STAGE(PG8_SB(1, 1), b3 + hstep, voffB);
            PG8_WAIT_V(6); PG8_BAR; PG8_MMA(1, 1, At, B1); PG8_BAR;
            }
        }
        if constexpr (ALIGN_EPI) { if (wr == 0) PG8_BAR; }
        if constexpr (!Epi::AFTER_DRAIN) { E(acc, cur, wr, wc, fr, fq); S.done(cur); }
        if (!has_next) break;
#pragma unroll
        for (int a = 0; a < 2; ++a)
#pragma unroll
            for (int b = 0; b < 2; ++b)
#pragma unroll
                for (int m = 0; m < 4; ++m)
#pragma unroll
                    for (int n = 0; n < 2; ++n) acc[a][b][m][n] = (f32x4){0.f, 0.f, 0.f, 0.f};
        cur = nxt; cA = nA; cB = nB; ++ui;
        if constexpr (ALIGN_EPI) { if (wr == 1) PG8_BAR; }
    }
    PG8_WAIT_V(0);
    if constexpr (!ALIGN_EPI) { if (wr == 0) PG8_BAR; }
    PG8_BAR;
    if constexpr (Epi::AFTER_DRAIN) { E.fused(acc, cur, wr, wc, fr, fq, lds, wid, lane); S.done(cur); }
#undef PG8_SA
#undef PG8_SB
#undef PG8_STAGE
#undef PG8_LDA
#undef PG8_LDB
#undef PG8_MMA
#undef PG8_WAIT_V
#undef PG8_WAIT_L
#undef PG8_BAR
#undef PG8_SCHED
}
}

constexpr int NWAVES = 8, NTHR = 512;
constexpr int NB = 4, SEQ = 4096, DM = 2048, MTOK = NB * SEQ, NLAYER = 4;
constexpr int DFF = 5504, NUP = 2 * DFF;
constexpr int INC = 5028, INP = 5120;
constexpr int DRW = 768, RWC = 2560, PO_POOL = 2560, DPOOL = 512, PO_NSA = 3072;
constexpr int PO_Q = PO_NSA, PO_KC = PO_NSA + 768, PO_VC = PO_KC + 192, PO_KS = PO_VC + 192, PO_VS = PO_KS + 192, PO_KW = PO_VS + 192, PO_VW = PO_KW + 192, PO_GL = PO_VW + 192;
static_assert(PO_GL + 36 == INC, "W_in column map");
constexpr int NCMP = 255, NCMPP = 256;
constexpr float ALPHA = 1.6817928305074290f;
constexpr float LN_EPS = 1e-5f, GN_EPS = 64e-5f;
constexpr int NPH = 1 + 14 * NLAYER;

constexpr size_t MiB = 1u << 20;
constexpr size_t WS_CTL = 0, CTL_ZERO_BYTES = 1 * MiB;
constexpr size_t WS_ROPE = 1 * MiB;
constexpr size_t WS_KC = 2 * MiB, WS_VC = 2 * MiB + 512 * 1024;
constexpr size_t WS_SC = 3 * MiB;
constexpr size_t WS_WUP1 = 8 * MiB, WS_WDN1 = 51 * MiB, WS_WIN = WS_WDN1 + 21 * MiB + 512 * 1024, WS_WOUT = WS_WIN + 20 * MiB, WS_WUP2 = WS_WOUT + 8 * MiB, WS_WDN2 = WS_WUP2 + 43 * MiB;
constexpr size_t WS_XB = 165 * MiB;
static_assert(WS_WDN2 + (size_t)DM * DFF * 2 <= WS_XB, "weights map");
constexpr size_t WS_CAT = 229 * MiB;
constexpr size_t WS_QR = 293 * MiB;
constexpr size_t WS_KS = 317 * MiB, WS_KW = 323 * MiB, WS_VS = 329 * MiB, WS_VW = 335 * MiB;
constexpr size_t WS_P = 341 * MiB;
constexpr size_t WS_H = 661 * MiB;
constexpr size_t WS_Y = 833 * MiB;
constexpr size_t WS_SV = WS_H;
constexpr size_t SV_STRIDE = 48 * MiB;
static_assert(WS_SV + 6 * SV_STRIDE <= WS_Y + 128 * MiB, "scan overlay");
constexpr size_t WS_G = 961 * MiB, WS_YS = 1009 * MiB;
constexpr size_t WS_VST = 1057 * MiB, WS_VWT = 1063 * MiB;
constexpr size_t WS_VCT = 6 * MiB;
constexpr size_t WS_SW = 1069 * MiB;
constexpr size_t WS_W2T = WS_SW, WS_A2T = WS_W2T + 768 * 64 * 2, WS_G2T = WS_A2T + 768 * 64 * 2, WS_PWT = WS_G2T + 768 * 128 * 2;
constexpr size_t WS_W1T = WS_PWT + 4 * 128 * 128 * 2, WS_W2CT = WS_W1T + 2 * 256 * 2048 * 2, WS_CBIAS = WS_W2CT + 2 * 64 * 256 * 2;
constexpr size_t WS_SPREC = 1073 * MiB;
constexpr size_t SPREC_BYTES = 15360, WS_YR = WS_SPREC + (size_t)NB * 12 * 256 * SPREC_BYTES + MiB;
constexpr size_t WS_STATS = WS_YR + 128 * MiB;
constexpr size_t WS_END = WS_STATS + MiB;
static_assert(WS_CBIAS + 2 * 256 * 4 <= WS_END, "small weights map");

constexpr int LDS_SCRATCH = 147456;
constexpr int LDS_BYTES = LDS_SCRATCH + 1024, MISC_OFF = LDS_SCRATCH + 320;

#define GAS __attribute__((address_space(1)))
#define LAS __attribute__((address_space(3)))
typedef unsigned short bf16;
typedef float f32x4 __attribute__((ext_vector_type(4)));
typedef float f32x2 __attribute__((ext_vector_type(2)));
typedef unsigned u32x4 __attribute__((ext_vector_type(4)));
typedef unsigned u32x2 __attribute__((ext_vector_type(2)));
#define LDS_WAIT() asm volatile("s_waitcnt lgkmcnt(0)" ::: "memory")
__device__ __forceinline__ unsigned f2bf(float f) { unsigned u = __builtin_bit_cast(unsigned, f); return (u + 0x7fffu + ((u >> 16) & 1u)) >> 16; }
__device__ __forceinline__ unsigned pk2(float lo, float hi) { return f2bf(lo) | (f2bf(hi) << 16); }
__device__ __forceinline__ float bf2f(unsigned short b) { return __builtin_bit_cast(float, ((unsigned)b) << 16); }
__device__ __forceinline__ float wave_sum(float v) {
#pragma unroll
    for (int o = 1; o < 64; o <<= 1) v += __shfl_xor(v, o);
    return v;
}
__device__ __forceinline__ float wave_max(float v) {
#pragma unroll
    for (int o = 1; o < 64; o <<= 1) v = fmaxf(v, __shfl_xor(v, o));
    return v;
}
__device__ __forceinline__ float sigmoidf_(float x) { return 1.0f / (1.0f + expf(-x)); }
template <int CTRL> __device__ __forceinline__ float dpp_f(float v) { return __builtin_bit_cast(float, __builtin_amdgcn_update_dpp(0, __builtin_bit_cast(int, v), CTRL, 0xF, 0xF, true)); }
__device__ __forceinline__ float row16_sum(float v) {
    v += dpp_f<0xB1>(v); v += dpp_f<0x4E>(v); v += dpp_f<0x141>(v); v += dpp_f<0x140>(v); return v;
}

#define XB_TMO      128
#define XB_XCNT(j)  (256  + 64 * (j))
#define XB_XSUB(j)  (1280 + 64 * (j))
#define XB_XGEN(j)  (2304 + 64 * (j))
#define XB_TOP      3328
#define XB_TOPGEN   3392
#define XCD_BAR_WORDS 3456
#define XB_SPIN_CAP (1u << 18)

__device__ __forceinline__ unsigned xb_ld(unsigned* p)              { return __hip_atomic_load(p, __ATOMIC_RELAXED, __HIP_MEMORY_SCOPE_AGENT); }
__device__ __forceinline__ unsigned xb_add(unsigned* p, unsigned v) { return __hip_atomic_fetch_add(p, v, __ATOMIC_RELAXED, __HIP_MEMORY_SCOPE_AGENT); }
__device__ __forceinline__ unsigned xb_xcc_id() { return (unsigned)__builtin_amdgcn_s_getreg((3 << 11) | 20) & 0xFu; }
#define XB_SPIN(cond, bar) do { unsigned _sp = 0; while (cond) { __builtin_amdgcn_s_sleep(1); \
    if ((++_sp & 255u) == 0u) { if (xb_ld(&(bar)[XB_TMO])) break; if (_sp > XB_SPIN_CAP) { atomicAdd(&(bar)[XB_TMO], 1u); break; } } } } while (0)

struct XcdBarrier {
    unsigned* bar; unsigned x;
    volatile LAS unsigned* st;
};

__device__ __forceinline__ XcdBarrier xcd_barrier_post(unsigned* bar, volatile LAS unsigned* st) {
    XcdBarrier b; b.bar = bar; b.x = xb_xcc_id(); b.st = st;
    if (threadIdx.x == 0) (void)xb_add(&bar[XB_XCNT(b.x)], 1u);
    return b;
}
__device__ __forceinline__ void xcd_barrier_complete(unsigned* bar, unsigned x, unsigned& nloc, unsigned& nx) {
    const unsigned G = gridDim.x * gridDim.y * gridDim.z;
    unsigned sum, cnt, mine, sp = 0u;
    for (;;) {
        sum = 0u; cnt = 0u; mine = 0u;
#pragma unroll
        for (unsigned j = 0; j < 16; ++j) { const unsigned c = xb_ld(&bar[XB_XCNT(j)]); sum += c; cnt += (c > 0u) ? 1u : 0u; mine = (j == x) ? c : mine; }
        if (sum == G) break;
        __builtin_amdgcn_s_sleep(1);
        if ((++sp & 255u) == 0u) { if (xb_ld(&bar[XB_TMO])) break; if (sp > XB_SPIN_CAP) { atomicAdd(&bar[XB_TMO], 1u); break; } }
    }
    nloc = mine > 0u ? mine : 1u; nx = cnt > 0u ? cnt : 1u;
}

__device__ __forceinline__ void xcd_barrier(const XcdBarrier& b) {
    asm volatile("s_waitcnt vmcnt(0)" ::: "memory");
    __syncthreads();
    if (threadIdx.x == 0) {
        unsigned* bar = b.bar;
        __builtin_amdgcn_s_waitcnt(0);
        unsigned nloc = b.st[0], nx = b.st[1];
        if (nloc == 0u) { xcd_barrier_complete(bar, b.x, nloc, nx); b.st[0] = nloc; b.st[1] = nx; }
        const unsigned old = xb_add(&bar[XB_XSUB(b.x)], 1u);
        const unsigned gen = old / nloc;
        if (old + 1u == (gen + 1u) * nloc) {
            __builtin_amdgcn_fence(__ATOMIC_RELEASE, "agent");
            asm volatile("s_waitcnt vmcnt(0)" ::: "memory");
            const unsigned og = xb_add(&bar[XB_TOP], 1u);
            const unsigned tg = og / nx;
            if (og + 1u == (tg + 1u) * nx) xb_add(&bar[XB_TOPGEN], 1u);
            else XB_SPIN(xb_ld(&bar[XB_TOPGEN]) == tg, bar);
            __builtin_amdgcn_fence(__ATOMIC_ACQUIRE, "agent");
            xb_add(&bar[XB_XGEN(b.x)], 1u);
            asm volatile("s_waitcnt vmcnt(0)" ::: "memory");
        } else {
            XB_SPIN(xb_ld(&bar[XB_XGEN(b.x)]) == gen, bar);
            __builtin_amdgcn_fence(__ATOMIC_ACQUIRE, "agent");
            asm volatile("s_waitcnt vmcnt(0)" ::: "memory");
        }
    }
    __syncthreads();
}

struct Args { const float* in[34]; float* out; unsigned char* ws; int ph_lo, ph_hi; };
__device__ __forceinline__ int opaque0() { int z = 0; asm volatile("" : "+s"(z)); return z; }
#define OPQ_S(x) asm volatile("" : "+s"(x))
#define OPQ_SI(x) do { (x) = __builtin_amdgcn_readfirstlane(x); asm volatile("" : "+s"(x)); } while (0)
#define OPQ_V(x) asm volatile("" : "+v"(x))
#define INPTR(a, idx) ((a).in[(idx) + opaque0()])
enum { I_X = 0, I_UP1, I_DN1, I_LN1G, I_LN1B, I_WIN, I_MU, I_W0, I_W2, I_A0, I_A2, I_G2, I_KK, I_KA, I_RK, I_GNG, I_GNB, I_PW, I_PB, I_PS, I_PEK, I_PEV, I_CK1, I_CK2, I_CV1, I_CV2, I_GB, I_WOUT, I_LN2G, I_LN2B, I_UP2, I_DN2, I_LN3G, I_LN3B };

__device__ __forceinline__ void transpose_item(const float* W, int K, int Nsrc, bf16* WT, int dst0, LAS float* scr, int k0, int n0, int lane) {
    const int c4 = lane & 15, rq = lane >> 4; const int n = n0 + 4 * c4; const bool ok = n < Nsrc;
    const float* wp = W + (size_t)(k0 + rq) * Nsrc + n;
#pragma unroll 8
    for (int i = 0; i < 16; ++i) { const f32x4 v = ok ? *(const f32x4*)(wp + (size_t)(4 * i) * Nsrc) : (f32x4){0.f, 0.f, 0.f, 0.f}; LAS float* d = scr + (4 * i + rq) * 65 + 4 * c4; d[0] = v.x; d[1] = v.y; d[2] = v.z; d[3] = v.w; }
    LDS_WAIT();
    const int c = lane & 7;
#pragma unroll
    for (int j = 0; j < 8; ++j) { const int nn = (lane >> 3) + 8 * j; const LAS float* s = scr + (8 * c) * 65 + nn;
        u32x4 o; o.x = pk2(s[0 * 65], s[1 * 65]); o.y = pk2(s[2 * 65], s[3 * 65]); o.z = pk2(s[4 * 65], s[5 * 65]); o.w = pk2(s[6 * 65], s[7 * 65]);
        *(u32x4*)(WT + (size_t)(dst0 + nn) * K + k0 + 8 * c) = o; }
    LDS_WAIT();
}
__device__ __forceinline__ int up_dst_row(int n0) { return n0 < DFF ? 256 * (n0 / 128) + (n0 % 128) : 256 * ((n0 - DFF) / 128) + 128 + ((n0 - DFF) % 128); }

__device__ __forceinline__ void phase_wconv(const Args& a, int l, LAS unsigned char* lds, int gw, int NGW, int wave, int lane) {
    OPQ_SI(gw); OPQ_SI(wave); OPQ_V(lane);
    LAS float* scr = (LAS float*)(lds + wave * 16640);
    unsigned char* ws = a.ws + opaque0();
    constexpr int I_UP = (DM / 64) * (NUP / 64), I_DN = (DFF / 64) * (DM / 64), I_IN = (DM / 64) * (INP / 64), I_OUT = (DM / 64) * (DM / 64);
    constexpr int NIT = 2 * I_UP + 2 * I_DN + I_IN + I_OUT + 12 + 12 + 24 + 16 + 256 + 8;
    for (int it = gw; it < NIT; it += NGW) {
        int r = it;
        if (r < 2 * I_UP) { const int which = r / I_UP; r -= which * I_UP; const int nblk = NUP / 64, kb = r / nblk, nb = r % nblk;
            const float* W = a.in[which ? I_UP2 : I_UP1] + (size_t)l * DM * NUP; bf16* WT = (bf16*)(ws + (which ? WS_WUP2 : WS_WUP1));
            transpose_item(W, DM, NUP, WT, up_dst_row(64 * nb), scr, 64 * kb, 64 * nb, lane); continue; }
        r -= 2 * I_UP;
        if (r < 2 * I_DN) { const int which = r / I_DN; r -= which * I_DN; const int nblk = DM / 64, kb = r / nblk, nb = r % nblk;
            const float* W = a.in[which ? I_DN2 : I_DN1] + (size_t)l * DFF * DM; bf16* WT = (bf16*)(ws + (which ? WS_WDN2 : WS_WDN1));
            transpose_item(W, DFF, DM, WT, 64 * nb, scr, 64 * kb, 64 * nb, lane); continue; }
        r -= 2 * I_DN;
        if (r < I_IN) { const int nblk = INP / 64, kb = r / nblk, nb = r % nblk;
            transpose_item(INPTR(a, I_WIN) + (size_t)l * DM * INC, DM, INC, (bf16*)(ws + WS_WIN), 64 * nb, scr, 64 * kb, 64 * nb, lane); continue; }
        r -= I_IN;
        if (r < I_OUT) { const int nblk = DM / 64, kb = r / nblk, nb = r % nblk;
            transpose_item(INPTR(a, I_WOUT) + (size_t)l * DM * DM, DM, DM, (bf16*)(ws + WS_WOUT), 64 * nb, scr, 64 * kb, 64 * nb, lane); continue; }
        r -= I_OUT;
        if (r < 12) { transpose_item(INPTR(a, I_W2) + (size_t)l * 64 * DRW, 64, DRW, (bf16*)(ws + WS_W2T), 64 * r, scr, 0, 64 * r, lane); continue; } r -= 12;
        if (r < 12) { transpose_item(INPTR(a, I_A2) + (size_t)l * 64 * DRW, 64, DRW, (bf16*)(ws + WS_A2T), 64 * r, scr, 0, 64 * r, lane); continue; } r -= 12;
        if (r < 24) { const int kb = r / 12, nb = r % 12; transpose_item(INPTR(a, I_G2) + (size_t)l * 128 * DRW, 128, DRW, (bf16*)(ws + WS_G2T), 64 * nb, scr, 64 * kb, 64 * nb, lane); continue; } r -= 24;
        if (r < 16) { const int gi = r >> 2, q = r & 3, kb = q >> 1, nb = q & 1; transpose_item(INPTR(a, I_PW) + ((size_t)l * 4 + gi) * 128 * 128, 128, 128, (bf16*)(ws + WS_PWT) + gi * 128 * 128, 64 * nb, scr, 64 * kb, 64 * nb, lane); continue; } r -= 16;
        if (r < 256) { const int ten = r >> 7, q = r & 127, kb = q >> 2, nb = q & 3; transpose_item(INPTR(a, ten ? I_CV1 : I_CK1) + (size_t)l * 2048 * 256, 2048, 256, (bf16*)(ws + WS_W1T) + (size_t)ten * 256 * 2048, 64 * nb, scr, 64 * kb, 64 * nb, lane); continue; } r -= 256;
        { const int ten = r >> 2, kb = r & 3; transpose_item(INPTR(a, ten ? I_CV2 : I_CK2) + (size_t)l * 256 * 64, 256, 64, (bf16*)(ws + WS_W2CT) + (size_t)ten * 64 * 256, 0, scr, 64 * kb, 0, lane); }
    }
}

__device__ __forceinline__ void phase_prologue(const Args& a, int gtid, int NGT) {
    OPQ_V(gtid);
    const f32x4* x4 = (const f32x4*)INPTR(a, I_X); u32x2* xb = (u32x2*)(a.ws + WS_XB);
    for (size_t i = gtid; i < (size_t)MTOK * DM / 4; i += NGT) { const f32x4 v = x4[i]; u32x2 o; o.x = pk2(v.x, v.y); o.y = pk2(v.z, v.w); xb[i] = o; }
    f32x2* rope = (f32x2*)(a.ws + WS_ROPE);
    for (int i = gtid; i < SEQ * 8; i += NGT) { const int s = i >> 3, k = i & 7;
        const float inv = powf(500000.0f, -(float)k * 0.125f); const float ang = (float)s * inv;
        const double ad = (double)ang; const double q = __builtin_rint(ad * 0.15915494309189535); const double rr = ad - q * 6.283185307179586;
        const float rf = (float)rr; rope[i] = (f32x2){cosf(rf), sinf(rf)}; }
}

__device__ __forceinline__ void phase_ln(const float* Y, const float* g, const float* b, float* X, bf16* XB, float* stats, int gw, int NGW, int lane) {
    OPQ_SI(gw); OPQ_V(lane);
    f32x4 gv[8], bv[8];
#pragma unroll
    for (int j = 0; j < 8; ++j) { gv[j] = ((const f32x4*)g)[64 * j + lane]; bv[j] = ((const f32x4*)b)[64 * j + lane]; }
    if (gw < NWAVES) { f32x4* gd = (f32x4*)(stats + 2 * MTOK) + gw * 64 + lane; gd[0] = ((const f32x4*)g)[gw * 64 + lane]; gd[512] = ((const f32x4*)b)[gw * 64 + lane]; }
    for (int m = gw; m < MTOK; m += NGW) {
        const f32x4* yr = (const f32x4*)(Y + (size_t)m * DM) + lane; f32x4 v[8]; float s = 0.f;
#pragma unroll
        for (int j = 0; j < 8; ++j) { v[j] = yr[64 * j]; s += (v[j].x + v[j].y) + (v[j].z + v[j].w); }
        const float mean = wave_sum(s) * (1.f / DM); float s2 = 0.f;
#pragma unroll
        for (int j = 0; j < 8; ++j) { v[j] = v[j] - mean; s2 += (v[j].x * v[j].x + v[j].y * v[j].y) + (v[j].z * v[j].z + v[j].w * v[j].w); }
        const float rstd = 1.f / sqrtf(wave_sum(s2) * (1.f / DM) + LN_EPS);
        if (lane == 0) *(f32x2*)(stats + 2 * (size_t)m) = (f32x2){mean, rstd};
        u32x2* xb = (u32x2*)(XB + (size_t)m * DM) + lane;
        if (X) { f32x4* xr = (f32x4*)(X + (size_t)m * DM) + lane;
#pragma unroll
            for (int j = 0; j < 8; ++j) { const f32x4 o = v[j] * rstd * gv[j] + bv[j]; xr[64 * j] = o; } }
#pragma unroll
        for (int j = 0; j < 8; ++j) { const f32x4 o = v[j] * rstd * gv[j] + bv[j]; u32x2 w; w.x = pk2(o.x, o.y); w.y = pk2(o.z, o.w); xb[64 * j] = w; }
    }
}


typedef float f32x16 __attribute__((ext_vector_type(16)));
typedef short bf16x8 __attribute__((ext_vector_type(8)));
#define MFMA32(a, b, c) __builtin_amdgcn_mfma_f32_32x32x16_bf16((a), (b), (c), 0, 0, 0)
#define WSYNC() asm volatile("s_waitcnt lgkmcnt(0)" ::: "memory")
__device__ __forceinline__ void half_swap(float x, float& lo, float& hi) { float a = x, b = x; asm volatile("s_nop 1\n\tv_permlane32_swap_b32 %0, %1" : "+v"(a), "+v"(b)); lo = a; hi = b; }
__device__ __forceinline__ float half_max(float x) { float lo, hi; half_swap(x, lo, hi); return fmaxf(lo, hi); }
__device__ __forceinline__ float half_sum(float x) { float lo, hi; half_swap(x, lo, hi); return lo + hi; }
__device__ __forceinline__ float other_half(float x, int h) { float lo, hi; half_swap(x, lo, hi); return h ? lo : hi; }
__device__ __forceinline__ unsigned cvtpk(float lo, float hi) { unsigned r; asm volatile("v_cvt_pk_bf16_f32 %0, %1, %2" : "=v"(r) : "v"(lo), "v"(hi)); return r; }
__device__ __forceinline__ float half32_sum(float v) { v = row16_sum(v); float a = v, b = v; asm volatile("s_nop 1\n\tv_permlane16_swap_b32 %0, %1" : "+v"(a), "+v"(b)); return a + b; }
__device__ __forceinline__ int vt_pos(int k) { return 16 * ((k >> 2) & 1) + 8 * (k >> 4) + 4 * ((k >> 3) & 1) + (k & 3); }

#ifndef M1_PREFETCH
#define M1_PREFETCH 1
#endif
constexpr int XP = 264, ZP = 520, HP = 264;
__device__ __forceinline__ bf16x8 lds_frag(const LAS bf16* p) { return *(const LAS bf16x8*)p; }
__device__ __forceinline__ bf16x8 cvt8(const f32x4 a, const f32x4 b) { u32x4 w; w.x = cvtpk(a.x, a.y); w.y = cvtpk(a.z, a.w); w.z = cvtpk(b.x, b.y); w.w = cvtpk(b.z, b.w); return __builtin_bit_cast(bf16x8, w); }
__device__ __forceinline__ void phase_m1(const Args& a, int l, LAS unsigned char* lds, int bid, int G, int tid, int wave, int lane) {
    OPQ_SI(bid); OPQ_V(tid); OPQ_SI(wave); lane = tid & 63;
    unsigned char* ws = a.ws + opaque0(); const float* P = (const float*)(ws + WS_P);
    const int r = lane & 31, h = lane >> 5;
    const f32x2* rope = (const f32x2*)(ws + WS_ROPE);
    for (int unit = bid; unit < MTOK / 64; unit += G) {
        const int t0 = unit * 64, b = t0 >> 12, s0 = t0 & (SEQ - 1);
        LAS bf16* XL = (LAS bf16*)lds;
        LAS bf16* ZL = (LAS bf16*)(lds + 64 * XP * 2);
        { const float* mu = INPTR(a, I_MU) + (size_t)l * RWC;
            for (int i = tid; i < 64 * 256; i += NTHR) { const int tt = i >> 8, j = i & 255, col = 2304 + j; const int m = t0 + tt;
                const float pc = P[(size_t)m * INP + col]; const float pp = (s0 + tt) > 0 ? P[(size_t)(m - 1) * INP + col] : 0.f; const float v = pc + (pp - pc) * mu[col];
                const float f = j < 64 ? tanhf(v) : (j < 128 ? v : sigmoidf_(v)); XL[tt * XP + j] = (bf16)f2bf(f); }
            {
                const int ch = tid, gi = ch >> 7, win = 2 << gi; const float* pp = P + (size_t)t0 * INP + PO_POOL + ch; float sum = 0.f;
                for (int j = 1; j < win; ++j) if (s0 - j >= 0) sum += pp[-(ptrdiff_t)j * INP];
#pragma unroll 8
                for (int tt = 0; tt < 64; ++tt) { const int s = s0 + tt; const float cur = pp[(size_t)tt * INP]; sum += cur; const int cnt = (s + 1) < win ? (s + 1) : win;
                    ZL[tt * ZP + ch] = (bf16)f2bf(sum / (float)cnt - cur); if (s - win + 1 >= 0) sum -= pp[((ptrdiff_t)tt - win + 1) * INP]; } } }
        __syncthreads();
        {
            const float* mu = INPTR(a, I_MU) + (size_t)l * RWC; const float* w0 = INPTR(a, I_W0) + (size_t)l * DRW; const float* a0 = INPTR(a, I_A0) + (size_t)l * DRW;
            const float* k_k = INPTR(a, I_KK) + (size_t)l * DRW; const float* k_a = INPTR(a, I_KA) + (size_t)l * DRW; const float* r_k = INPTR(a, I_RK) + (size_t)l * DRW;
            const bf16* W2T = (const bf16*)(ws + WS_W2T); const bf16* A2T = (const bf16*)(ws + WS_A2T); const bf16* G2T = (const bf16*)(ws + WS_G2T);
            float* vKK = (float*)(ws + WS_SV); float* vWR = (float*)(ws + WS_SV + SV_STRIDE); float* vW = (float*)(ws + WS_SV + 2 * SV_STRIDE);
            float* vKM = (float*)(ws + WS_SV + 3 * SV_STRIDE); float* vBB = (float*)(ws + WS_SV + 4 * SV_STRIDE); float* vV = (float*)(ws + WS_SV + 5 * SV_STRIDE);
            float* vG = (float*)(ws + WS_G); float* SC = (float*)(ws + WS_SC);
#pragma unroll 1
            for (int jj = 0; jj < 3; ++jj) {
                const int job = wave + 8 * jj, hd = job >> 1, th = job & 1;
                f32x16 aU[2], aA[2];
#pragma unroll
                for (int t = 0; t < 2; ++t)
#pragma unroll
                    for (int i = 0; i < 16; ++i) { aU[t][i] = 0.f; aA[t][i] = 0.f; }
                const LAS bf16* xa = XL + (32 * th + r) * XP + 8 * h;
#pragma unroll
                for (int ks = 0; ks < 4; ++ks) { const bf16x8 xt = lds_frag(xa + 16 * ks), xl = lds_frag(xa + 64 + 16 * ks);
#pragma unroll
                    for (int t = 0; t < 2; ++t) { const int c = hd * 64 + 32 * t + r;
                        aU[t] = MFMA32(xt, *(const bf16x8*)(W2T + (size_t)c * 64 + 16 * ks + 8 * h), aU[t]);
                        aA[t] = MFMA32(xl, *(const bf16x8*)(A2T + (size_t)c * 64 + 16 * ks + 8 * h), aA[t]); } }
                float pmr[2], pmk[2], pmv[2], pw0[2], pa0[2], pkk[2], pka[2], prk[2];
#pragma unroll
                for (int t = 0; t < 2; ++t) { const int c = hd * 64 + 32 * t + r; pmr[t] = mu[c]; pmk[t] = mu[768 + c]; pmv[t] = mu[1536 + c]; pw0[t] = w0[c]; pa0[t] = a0[c]; pkk[t] = k_k[c]; pka[t] = k_a[c]; prk[t] = r_k[c]; }
                const int lo_p = 4 * h * INP + hd * 64 + r, lo_s = 4 * h * DRW + hd * 64 + r;
                float ld[2][12];
#define M1_LOADROW(buf, i) do { int mr_ = t0 + 32 * th + ((i) & 3) + 8 * ((i) >> 2); OPQ_SI(mr_); const bool first_ = (s0 + 32 * th + ((i) & 3) + 8 * ((i) >> 2) + 4 * h) == 0; \
        const float* pc_ = P + (size_t)mr_ * INP; const float* pp_ = pc_ - INP; _Pragma("unroll") for (int t = 0; t < 2; ++t) { const int o = lo_p + 32 * t; \
        buf[6 * t + 0] = pc_[o]; buf[6 * t + 1] = pc_[o + 768]; buf[6 * t + 2] = pc_[o + 1536]; buf[6 * t + 3] = first_ ? 0.f : pp_[o]; buf[6 * t + 4] = first_ ? 0.f : pp_[o + 768]; buf[6 * t + 5] = first_ ? 0.f : pp_[o + 1536]; } } while (0)
                M1_LOADROW(ld[0], 0);
#pragma unroll
                for (int i = 0; i < 16; ++i) {
#if M1_PREFETCH
                    if (i + 1 < 16) M1_LOADROW(ld[(i + 1) & 1], i + 1);
#else
                    if (i > 0) M1_LOADROW(ld[i & 1], i);
#endif
                    int mrow = t0 + 32 * th + (i & 3) + 8 * (i >> 2); OPQ_SI(mrow);
                    float rr[2], kv[2], vv[2], dec[2], av[2], kr[2], km[2];
                    float ss = 0.f, s1 = 0.f, s2 = 0.f, s3 = 0.f;
#pragma unroll
                    for (int t = 0; t < 2; ++t) { const float* L = ld[i & 1] + 6 * t;
                        const float rc = L[0], kc = L[1], vc = L[2], rp = L[3], kp = L[4], vp = L[5];
                        rr[t] = rc + (rp - rc) * pmr[t]; kv[t] = kc + (kp - kc) * pmk[t]; vv[t] = vc + (vp - vc) * pmv[t];
                        const float uu = pw0[t] + aU[t][i]; const float z = -uu; const float sp = z > 20.f ? z : log1pf(expf(z)); dec[t] = expf(-expf(-sp - 0.5f));
                        av[t] = sigmoidf_(pa0[t] + aA[t][i]);
                        kr[t] = kv[t] * pkk[t]; km[t] = kv[t] * (1.0f + (av[t] - 1.0f) * pka[t]);
                        ss += kr[t] * kr[t]; s1 += kr[t] * av[t] * rr[t]; s2 += km[t] * rr[t]; s3 += rr[t] * km[t] * prk[t]; }
                    ss = half32_sum(ss); s1 = half32_sum(s1); s2 = half32_sum(s2); s3 = half32_sum(s3);
                    const float invn = 1.0f / fmaxf(sqrtf(ss), 1e-12f);
                    const size_t ro = (size_t)mrow * DRW;
#pragma unroll
                    for (int t = 0; t < 2; ++t) { const int o = lo_s + 32 * t; const float kk = kr[t] * invn;
                        (vKK + ro)[o] = kk; (vWR + ro)[o] = dec[t] * rr[t]; (vW + ro)[o] = dec[t]; (vKM + ro)[o] = km[t]; (vBB + ro)[o] = kk * av[t]; (vV + ro)[o] = vv[t]; }
                    if (r == 0) *(f32x4*)(SC + ((size_t)mrow * 12 + hd) * 4 + 4 * h * 48) = (f32x4){s1 * invn, s2, s3, 0.f};
                    asm volatile("" ::: "memory");
                }
#undef M1_LOADROW
                { f32x16 aG[2];
#pragma unroll
                    for (int t = 0; t < 2; ++t)
#pragma unroll
                        for (int i = 0; i < 16; ++i) aG[t][i] = 0.f;
#pragma unroll
                    for (int ks = 0; ks < 8; ++ks) { const bf16x8 xg = lds_frag(xa + 128 + 16 * ks);
#pragma unroll
                        for (int t = 0; t < 2; ++t) { const int c = hd * 64 + 32 * t + r; aG[t] = MFMA32(xg, *(const bf16x8*)(G2T + (size_t)c * 128 + 16 * ks + 8 * h), aG[t]); } }
#pragma unroll
                    for (int i = 0; i < 16; ++i) { int mrow = t0 + 32 * th + (i & 3) + 8 * (i >> 2); OPQ_SI(mrow); float* gp = vG + (size_t)mrow * DRW;
#pragma unroll
                        for (int t = 0; t < 2; ++t) gp[lo_s + 32 * t] = aG[t][i]; } }
            }
        }
        {
            int lane_b = lane; OPQ_V(lane_b); const int r = lane_b & 31, h = lane_b >> 5;
            const int gi = wave >> 1, th = wave & 1; const bf16* PWT = (const bf16*)(ws + WS_PWT) + gi * 128 * 128;
            const float* pb = INPTR(a, I_PB) + (size_t)l * DPOOL + gi * 128; const float* psc = INPTR(a, I_PS) + (size_t)l * DPOOL + gi * 128; bf16* CAT = (bf16*)(ws + WS_CAT);
            f32x16 acc[4];
#pragma unroll
            for (int t = 0; t < 4; ++t)
#pragma unroll
                for (int i = 0; i < 16; ++i) acc[t][i] = 0.f;
            const LAS bf16* za = ZL + (32 * th + r) * ZP + gi * 128 + 8 * h;
#pragma unroll
            for (int ks = 0; ks < 8; ++ks) { const bf16x8 zf = lds_frag(za + 16 * ks);
#pragma unroll
                for (int t = 0; t < 4; ++t) acc[t] = MFMA32(zf, *(const bf16x8*)(PWT + (size_t)(32 * t + r) * 128 + 16 * ks + 8 * h), acc[t]); }
#pragma unroll
            for (int t = 0; t < 4; ++t) { const int d = 32 * t + r; const float bv = pb[d], sv = psc[d];
#pragma unroll
                for (int i = 0; i < 16; ++i) { const int m = t0 + 32 * th + (i & 3) + 8 * (i >> 2) + 4 * h; CAT[(size_t)m * DM + DRW + gi * 128 + d] = (bf16)f2bf((acc[t][i] + bv) * sv); } }
        }
        __syncthreads();
        {
            int tid_c = tid; OPQ_V(tid_c); const int tid = tid_c;
            bf16* QR = (bf16*)(ws + WS_QR); bf16* KS = (bf16*)(ws + WS_KS); bf16* KW = (bf16*)(ws + WS_KW); bf16* VST = (bf16*)(ws + WS_VST); bf16* VWT = (bf16*)(ws + WS_VWT);
            LAS float* T0 = (LAS float*)lds; LAS float* T1 = T0 + 64 * 193;
            for (int i = tid; i < 64 * 1152; i += NTHR) { const int tt = i / 1152, c = i - tt * 1152; const int m = t0 + tt, s = s0 + tt; const float* pr = P + (size_t)m * INP;
                int src; bf16* dst; float scale = 1.f;
                if (c < 768) { src = PO_Q + c; dst = QR + (size_t)m * 768 + c; scale = 0.125f * 1.4426950408889634f; }
                else if (c < 960) { const int cc = c - 768; src = PO_KS + cc; dst = KS + (((size_t)(b * 3 + (cc >> 6)) * 128 + (s >> 5)) * 32 + (s & 31)) * 64 + (cc & 63); }
                else { const int cc = c - 960; src = PO_KW + cc; dst = KW + (((size_t)(b * 3 + (cc >> 6)) * 128 + (s >> 5)) * 32 + (s & 31)) * 64 + (cc & 63); }
                const int d = c & 63; float v = pr[src];
                if (d < 16) { const f32x2 cs = rope[s * 8 + (d & 7)]; v = d < 8 ? v * cs.x - pr[src + 8] * cs.y : v * cs.x + pr[src - 8] * cs.y; }
                *dst = (bf16)f2bf(v * scale); }
            for (int i = tid; i < 64 * 384; i += NTHR) { const int tt = i / 384, c = i - tt * 384; const float* pr = P + (size_t)(t0 + tt) * INP;
                if (c < 192) T0[tt * 193 + c] = pr[PO_VS + c]; else T1[tt * 193 + (c - 192)] = pr[PO_VW + (c - 192)]; }
            __syncthreads();
            for (int i = tid; i < 384 * 64; i += NTHR) { const int c2 = i >> 6, tok = i & 63; const int which = c2 >= 192, c = which ? c2 - 192 : c2;
                const float v = (which ? T1 : T0)[tok * 193 + c]; const int sk = s0 + tok;
                bf16* dst = (which ? VWT : VST) + (((size_t)(b * 3 + (c >> 6)) * 128 + (sk >> 5)) * 64 + (c & 63)) * 32 + vt_pos(sk & 31); *dst = (bf16)f2bf(v); }
        }
        __syncthreads();
    }
    {
        int lane_d = lane; OPQ_V(lane_d); const int r = lane_d & 31, h = lane_d >> 5;
        LAS bf16* HL = (LAS bf16*)lds;
        bf16* KC = (bf16*)(ws + WS_KC); bf16* VCT = (bf16*)(ws + WS_VCT);
        for (int u = bid; u < 2 * NB * 3 * 8; u += G) {
            const int ten = u / 96, q = u - ten * 96, b = q / 24, q2 = q - b * 24, hh = q2 >> 3, nt = q2 & 7, n0 = 32 * nt;
            const bf16* W1T = (const bf16*)(ws + WS_W1T) + (size_t)ten * 256 * 2048 + (size_t)(32 * wave + r) * 2048 + 8 * h;
            const int tk0 = 16 * (n0 + r);
            const float* pa = P + ((size_t)b * SEQ + tk0) * INP + (ten ? PO_VC : PO_KC) + hh * 64 + 8 * h;
            const float* pep = INPTR(a, ten ? I_PEV : I_PEK) + (size_t)l * 2048 + 8 * h;
            f32x16 acc;
#pragma unroll
            for (int i = 0; i < 16; ++i) acc[i] = 0.f;
            f32x4 xa[2][8]; bf16x8 wb[2][4];
#define CMP_LOAD(sl, ll) do { const bool ok_ = tk0 + (ll) < SEQ; const float* pl_ = pa + (size_t)(ll) * INP; const float* pe_ = pep + 64 * (ll); _Pragma("unroll") for (int ds = 0; ds < 4; ++ds) { \
        xa[sl][2 * ds] = (ok_ ? *(const f32x4*)(pl_ + 16 * ds) : (f32x4){0.f, 0.f, 0.f, 0.f}) + *(const f32x4*)(pe_ + 16 * ds); xa[sl][2 * ds + 1] = (ok_ ? *(const f32x4*)(pl_ + 16 * ds + 4) : (f32x4){0.f, 0.f, 0.f, 0.f}) + *(const f32x4*)(pe_ + 16 * ds + 4); \
        wb[sl][ds] = *(const bf16x8*)(W1T + 64 * (ll) + 16 * ds); } } while (0)
            CMP_LOAD(0, 0);
#pragma unroll 1
            for (int ll = 0; ll < 32; ll += 2) {
                CMP_LOAD(1, ll + 1);
#pragma unroll
                for (int ds = 0; ds < 4; ++ds) acc = MFMA32(cvt8(xa[0][2 * ds], xa[0][2 * ds + 1]), wb[0][ds], acc);
                if (ll + 2 < 32) CMP_LOAD(0, ll + 2);
#pragma unroll
                for (int ds = 0; ds < 4; ++ds) acc = MFMA32(cvt8(xa[1][2 * ds], xa[1][2 * ds + 1]), wb[1][ds], acc);
            }
#undef CMP_LOAD
            {
#pragma unroll
                for (int i = 0; i < 16; ++i) { const float x = acc[i]; const float gl = 0.5f * x * (1.0f + tanhf(0.7978845608028654f * (x + 0.044715f * x * x * x)));
                    HL[((i & 3) + 8 * (i >> 2) + 4 * h) * HP + 32 * wave + r] = (bf16)f2bf(gl); } }
            __syncthreads();
            if (wave < 2) {
                const bf16* W2CT = (const bf16*)(ws + WS_W2CT) + (size_t)ten * 64 * 256 + (size_t)(32 * wave + r) * 256 + 8 * h;
                f32x16 o;
#pragma unroll
                for (int i = 0; i < 16; ++i) o[i] = 0.f;
                const LAS bf16* ha = HL + r * HP + 8 * h;
#pragma unroll
                for (int ks = 0; ks < 16; ++ks) o = MFMA32(lds_frag(ha + 16 * ks), *(const bf16x8*)(W2CT + 16 * ks), o);
                const int d = 32 * wave + r;
#pragma unroll
                for (int i = 0; i < 16; ++i) { const int n = n0 + (i & 3) + 8 * (i >> 2) + 4 * h; float v = o[i];
                    if (ten == 0) { const float other = dpp_f<0x128>(v);
                        if (wave == 0 && r < 16) { const f32x2 cs = rope[((16 * n + 31) & (SEQ - 1)) * 8 + (r & 7)]; v = r < 8 ? v * cs.x - other * cs.y : v * cs.x + other * cs.y; }
                        if (n < NCMP) KC[((size_t)(b * 3 + hh) * NCMPP + n) * 64 + d] = (bf16)f2bf(v); }
                    else if (n < NCMP) VCT[(((size_t)(b * 3 + hh) * 8 + (n >> 5)) * 64 + d) * 32 + vt_pos(n & 31)] = (bf16)f2bf(v); }
            }
            __syncthreads();
        }
    }
}

constexpr int SPX = 72;
__device__ __forceinline__ void phase_scan_prep(const Args& a, LAS unsigned char* lds, int gw, int NGW, int wave, int lane) {
    OPQ_SI(gw); OPQ_SI(wave); OPQ_V(lane);
    unsigned char* ws = a.ws + opaque0();
    LAS unsigned char* wl = lds + wave * 16384;
    LAS bf16* XA = (LAS bf16*)wl; LAS bf16* XR = XA + 16 * SPX; LAS bf16* XB_ = XR + 16 * SPX; LAS bf16* XK = XB_ + 16 * SPX;
    LAS float* GB = (LAS float*)(wl + 4 * 16 * SPX * 2); LAS float* GK = GB + 256; LAS float* HB = GK + 256; LAS float* HK = HB + 256; LAS float* NM = HK + 256;
    const int r = lane & 31, h = lane >> 5;
    const GAS float* vKK = (const GAS float*)(ws + WS_SV); const GAS float* vWR = (const GAS float*)(ws + WS_SV + SV_STRIDE); const GAS float* vW = (const GAS float*)(ws + WS_SV + 2 * SV_STRIDE);
    const GAS float* vKM = (const GAS float*)(ws + WS_SV + 3 * SV_STRIDE); const GAS float* vBB = (const GAS float*)(ws + WS_SV + 4 * SV_STRIDE); const GAS float* vV = (const GAS float*)(ws + WS_SV + 5 * SV_STRIDE);
#pragma unroll 1
    for (int item = gw; item < NB * 12 * 256; item += NGW) {
        const int hd = item >> 8, c = item & 255, b = hd / 12, hh = hd - b * 12;
        const size_t o0 = ((size_t)b * SEQ + 16 * c) * DRW + hh * 64 + lane;
        GAS unsigned char* rec = (GAS unsigned char*)(ws + WS_SPREC) + (size_t)item * SPREC_BYTES;
        float al[16], rh[16], be[16], ka[16], vv[16]; float g = 1.f;
#pragma unroll
        for (int t = 0; t < 16; ++t) { const size_t o = o0 + (size_t)t * DRW; const float w = vW[o], kk = vKK[o], bb = vBB[o], km = vKM[o], wr = vWR[o]; vv[t] = vV[o];
            al[t] = g * kk; rh[t] = g * wr; g *= w; const float ig = 1.0f / g; be[t] = bb * ig; ka[t] = km * ig; }
#pragma unroll
        for (int t = 0; t < 16; ++t) { XA[t * SPX + lane] = (bf16)f2bf(al[t]); XR[t * SPX + lane] = (bf16)f2bf(rh[t]); XB_[t * SPX + lane] = (bf16)f2bf(be[t]); XK[t * SPX + lane] = (bf16)f2bf(ka[t]); }
#pragma unroll
        for (int hp = 0; hp < 2; ++hp) {
            u32x4 wb, wk, wv;
            wb.x = cvtpk(be[4 * hp + 0], be[4 * hp + 1]); wb.y = cvtpk(be[4 * hp + 2], be[4 * hp + 3]); wb.z = cvtpk(be[8 + 4 * hp + 0], be[8 + 4 * hp + 1]); wb.w = cvtpk(be[8 + 4 * hp + 2], be[8 + 4 * hp + 3]);
            wk.x = cvtpk(ka[4 * hp + 0], ka[4 * hp + 1]); wk.y = cvtpk(ka[4 * hp + 2], ka[4 * hp + 3]); wk.z = cvtpk(ka[8 + 4 * hp + 0], ka[8 + 4 * hp + 1]); wk.w = cvtpk(ka[8 + 4 * hp + 2], ka[8 + 4 * hp + 3]);
            wv.x = cvtpk(vv[4 * hp + 0], vv[4 * hp + 1]); wv.y = cvtpk(vv[4 * hp + 2], vv[4 * hp + 3]); wv.z = cvtpk(vv[8 + 4 * hp + 0], vv[8 + 4 * hp + 1]); wv.w = cvtpk(vv[8 + 4 * hp + 2], vv[8 + 4 * hp + 3]);
            *(GAS u32x4*)(rec + 4096 + ((h * 2 + hp) * 32 + r) * 16) = wb; *(GAS u32x4*)(rec + 6144 + ((h * 2 + hp) * 32 + r) * 16) = wk;
            *(GAS u32x4*)(rec + 9216 + h * 3072 + 2048 + (hp * 32 + r) * 16) = wv; }
        *(GAS float*)(rec + 8704 + ((h * 2 + ((r >> 2) & 1)) * 16 + (r & 3) + 4 * (r >> 3)) * 4) = g;
        WSYNC();
        const bool lo16 = r < 16; const bf16x8 zf = {0, 0, 0, 0, 0, 0, 0, 0};
#define SP_GRAM(X1, X2, OUT, INCL) do { f32x16 D; _Pragma("unroll") for (int i = 0; i < 16; ++i) D[i] = 0.f; \
            _Pragma("unroll") for (int ks = 0; ks < 4; ++ks) { const bf16x8 fa = lo16 ? *(const LAS bf16x8*)(X1 + r * SPX + 16 * ks + 8 * h) : zf, fb = lo16 ? *(const LAS bf16x8*)(X2 + r * SPX + 16 * ks + 8 * h) : zf; D = MFMA32(fa, fb, D); } \
            if (lo16) { _Pragma("unroll") for (int i = 0; i < 8; ++i) { const int t = (i & 3) + 8 * (i >> 2) + 4 * h; OUT[t * 16 + r] = (INCL ? r <= t : r < t) ? D[i] : 0.f; } } } while (0)
        SP_GRAM(XA, XB_, GB, false); SP_GRAM(XA, XK, GK, false); SP_GRAM(XR, XB_, HB, true); SP_GRAM(XR, XK, HK, true);
#undef SP_GRAM
        WSYNC();
        { const int cc = lane & 15; float n[16];
#pragma unroll
            for (int t = 0; t < 16; ++t) { float acc = t == cc ? 1.f : 0.f;
#pragma unroll
                for (int s2 = 0; s2 < t; ++s2) acc -= GB[t * 16 + s2] * n[s2];
                n[t] = acc; }
            if (lane < 16) {
#pragma unroll
                for (int t = 0; t < 16; ++t) NM[t * 16 + cc] = n[t]; } }
        if (lo16) { u32x4 w_; const LAS float* hr = HB + r * 16 + 4 * h;
            w_.x = cvtpk(hr[0], hr[1]); w_.y = cvtpk(hr[2], hr[3]); w_.z = cvtpk(hr[8], hr[9]); w_.w = cvtpk(hr[10], hr[11]); *(GAS u32x4*)(rec + 8192 + (h * 16 + r) * 16) = w_; }
        WSYNC();
        { float ap[16];
#pragma unroll
            for (int t = 0; t < 16; ++t) { float acc = 0.f;
#pragma unroll
                for (int s2 = 0; s2 <= t; ++s2) acc = fmaf(NM[t * 16 + s2], al[s2], acc);
                ap[t] = acc; }
#pragma unroll
            for (int t = 0; t < 16; ++t) XA[t * SPX + lane] = (bf16)f2bf(ap[t]); }
        WSYNC();
        if (lo16) {
#pragma unroll
            for (int ks = 0; ks < 4; ++ks) { const LAS bf16* pa = XA + r * SPX + 16 * ks + 4 * h; const LAS bf16* pr = XR + r * SPX + 16 * ks + 4 * h;
                const u32x2 a0 = *(const LAS u32x2*)pa, a1 = *(const LAS u32x2*)(pa + 8), r0 = *(const LAS u32x2*)pr, r1 = *(const LAS u32x2*)(pr + 8);
                *(GAS u32x4*)(rec + ((ks * 2 + h) * 16 + r) * 16) = (u32x4){a0.x, a0.y, a1.x, a1.y}; *(GAS u32x4*)(rec + 2048 + ((ks * 2 + h) * 16 + r) * 16) = (u32x4){r0.x, r0.y, r1.x, r1.y}; } }
        { float wq[16], p1[16], yk[16];
#pragma unroll
            for (int t = 0; t < 16; ++t) { float acc = 0.f, acy = 0.f;
#pragma unroll
                for (int s2 = 0; s2 <= t; ++s2) { if (s2 < t) acc = fmaf(GK[t * 16 + s2], vv[s2], acc); acy = fmaf(HK[t * 16 + s2], vv[s2], acy); }
                wq[t] = acc; yk[t] = acy; }
#pragma unroll
            for (int t = 0; t < 16; ++t) { float acc = 0.f;
#pragma unroll
                for (int s2 = 0; s2 <= t; ++s2) acc = fmaf(NM[t * 16 + s2], wq[s2], acc);
                p1[t] = acc; }
            GAS unsigned char* rv = rec + 9216 + h * 3072;
#pragma unroll
            for (int hq = 0; hq < 2; ++hq) { u32x4 wp, wy;
                wp.x = cvtpk(p1[4 * hq + 0], p1[4 * hq + 1]); wp.y = cvtpk(p1[4 * hq + 2], p1[4 * hq + 3]); wp.z = cvtpk(p1[8 + 4 * hq + 0], p1[8 + 4 * hq + 1]); wp.w = cvtpk(p1[8 + 4 * hq + 2], p1[8 + 4 * hq + 3]);
                wy.x = cvtpk(yk[4 * hq + 0], yk[4 * hq + 1]); wy.y = cvtpk(yk[4 * hq + 2], yk[4 * hq + 3]); wy.z = cvtpk(yk[8 + 4 * hq + 0], yk[8 + 4 * hq + 1]); wy.w = cvtpk(yk[8 + 4 * hq + 2], yk[8 + 4 * hq + 3]);
                *(GAS u32x4*)(rv + (hq * 32 + r) * 16) = wp; *(GAS u32x4*)(rv + 1024 + (hq * 32 + r) * 16) = wy; } }
        WSYNC();
    }
}
__device__ __forceinline__ void scan_seq(const Args& a, LAS unsigned char* lds, int grp, int lane) {
    OPQ_SI(grp); OPQ_V(lane);
    __builtin_amdgcn_s_setprio(3);
    unsigned char* ws = a.ws + opaque0();
    const int hd = grp % 48, vt = grp / 48, b = hd / 12, hh = hd - b * 12;
    const int r = lane & 31, h = lane >> 5; const bool lo16 = r < 16;
    LAS unsigned char* RS = lds + 16384;
    const GAS unsigned char* recs = (const GAS unsigned char*)(ws + WS_SPREC) + (size_t)hd * 256 * SPREC_BYTES;
    GAS float* yp = (GAS float*)(ws + WS_YS) + (size_t)b * SEQ * DRW + hh * 64 + 32 * vt + r;
    const bf16x8 zf = {0, 0, 0, 0, 0, 0, 0, 0};
    f32x16 T0, T1;
#pragma unroll
    for (int i = 0; i < 16; ++i) { T0[i] = 0.f; T1[i] = 0.f; }
#define SQ_DMA(slot, ck) do { const GAS unsigned char* rp_ = recs + (size_t)(ck) * SPREC_BYTES + lane * 16; LAS unsigned char* ls_ = RS + (slot) * 12288; \
        _Pragma("unroll") for (int q = 0; q < 9; ++q) __builtin_amdgcn_global_load_lds((const unsigned*)(rp_ + 1024 * q), (LAS unsigned*)(ls_ + 1024 * q), 16, 0, 0); \
        _Pragma("unroll") for (int q = 0; q < 3; ++q) __builtin_amdgcn_global_load_lds((const unsigned*)(rp_ + 9216 + 3072 * vt + 1024 * q), (LAS unsigned*)(ls_ + 9216 + 1024 * q), 16, 0, 0); } while (0)
    SQ_DMA(0, 0); SQ_DMA(1, 1);
#pragma unroll 1
    for (int ck = 0; ck < 256; ++ck) {
        const LAS unsigned char* L = RS + (ck & 1) * 12288;
        if (ck == 0) asm volatile("s_waitcnt vmcnt(12)" ::: "memory"); else if (ck + 1 < 256) asm volatile("s_waitcnt vmcnt(20)" ::: "memory"); else asm volatile("s_waitcnt vmcnt(0)" ::: "memory");
        bf16x8 tb[4];
#pragma unroll
        for (int s2 = 0; s2 < 2; ++s2) { u32x4 w0, w1;
            w0.x = cvtpk(T0[8 * s2], T0[8 * s2 + 1]); w0.y = cvtpk(T0[8 * s2 + 2], T0[8 * s2 + 3]); w0.z = cvtpk(T0[8 * s2 + 4], T0[8 * s2 + 5]); w0.w = cvtpk(T0[8 * s2 + 6], T0[8 * s2 + 7]);
            w1.x = cvtpk(T1[8 * s2], T1[8 * s2 + 1]); w1.y = cvtpk(T1[8 * s2 + 2], T1[8 * s2 + 3]); w1.z = cvtpk(T1[8 * s2 + 4], T1[8 * s2 + 5]); w1.w = cvtpk(T1[8 * s2 + 6], T1[8 * s2 + 7]);
            tb[s2] = __builtin_bit_cast(bf16x8, w0); tb[2 + s2] = __builtin_bit_cast(bf16x8, w1); }
        f32x16 aU, aY;
#pragma unroll
        for (int i = 0; i < 16; ++i) { aU[i] = 0.f; aY[i] = 0.f; }
        { const u32x4 yk = *(const LAS u32x4*)(L + 9216 + 1024 + lane * 16);
            aY[0] = __builtin_bit_cast(float, yk.x << 16); aY[1] = __builtin_bit_cast(float, yk.x & 0xffff0000u); aY[2] = __builtin_bit_cast(float, yk.y << 16); aY[3] = __builtin_bit_cast(float, yk.y & 0xffff0000u);
            aY[4] = __builtin_bit_cast(float, yk.z << 16); aY[5] = __builtin_bit_cast(float, yk.z & 0xffff0000u); aY[6] = __builtin_bit_cast(float, yk.w << 16); aY[7] = __builtin_bit_cast(float, yk.w & 0xffff0000u); }
#pragma unroll
        for (int ks = 0; ks < 4; ++ks) { const bf16x8 fa = lo16 ? *(const LAS bf16x8*)(L + ((ks * 2 + h) * 16 + r) * 16) : zf, fr = lo16 ? *(const LAS bf16x8*)(L + 2048 + ((ks * 2 + h) * 16 + r) * 16) : zf;
            aU = MFMA32(fa, tb[ks], aU); aY = MFMA32(fr, tb[ks], aY); }
        bf16x8 ub;
        { const u32x4 p1 = *(const LAS u32x4*)(L + 9216 + lane * 16); float u[8];
            u[0] = -aU[0] - __builtin_bit_cast(float, p1.x << 16); u[1] = -aU[1] - __builtin_bit_cast(float, p1.x & 0xffff0000u); u[2] = -aU[2] - __builtin_bit_cast(float, p1.y << 16); u[3] = -aU[3] - __builtin_bit_cast(float, p1.y & 0xffff0000u);
            u[4] = -aU[4] - __builtin_bit_cast(float, p1.z << 16); u[5] = -aU[5] - __builtin_bit_cast(float, p1.z & 0xffff0000u); u[6] = -aU[6] - __builtin_bit_cast(float, p1.w << 16); u[7] = -aU[7] - __builtin_bit_cast(float, p1.w & 0xffff0000u);
            u32x4 w_; w_.x = cvtpk(u[0], u[1]); w_.y = cvtpk(u[2], u[3]); w_.z = cvtpk(u[4], u[5]); w_.w = cvtpk(u[6], u[7]); ub = __builtin_bit_cast(bf16x8, w_); }
        { const bf16x8 fh = lo16 ? *(const LAS bf16x8*)(L + 8192 + (h * 16 + r) * 16) : zf; aY = MFMA32(fh, ub, aY); }
        { const bf16x8 fv = *(const LAS bf16x8*)(L + 9216 + 2048 + lane * 16);
            const bf16x8 b0 = *(const LAS bf16x8*)(L + 4096 + lane * 16), b1 = *(const LAS bf16x8*)(L + 4096 + 1024 + lane * 16), k0 = *(const LAS bf16x8*)(L + 6144 + lane * 16), k1 = *(const LAS bf16x8*)(L + 6144 + 1024 + lane * 16);
            T0 = MFMA32(b0, ub, T0); T1 = MFMA32(b1, ub, T1); T0 = MFMA32(k0, fv, T0); T1 = MFMA32(k1, fv, T1);
#pragma unroll
            for (int q = 0; q < 4; ++q) { const f32x4 g0 = *(const LAS f32x4*)(L + 8704 + (h * 16 + 4 * q) * 4), g1 = *(const LAS f32x4*)(L + 8704 + ((2 + h) * 16 + 4 * q) * 4);
                T0[4 * q] *= g0.x; T0[4 * q + 1] *= g0.y; T0[4 * q + 2] *= g0.z; T0[4 * q + 3] *= g0.w; T1[4 * q] *= g1.x; T1[4 * q + 1] *= g1.y; T1[4 * q + 2] *= g1.z; T1[4 * q + 3] *= g1.w; } }
#pragma unroll
        for (int i = 0; i < 8; ++i) yp[((size_t)ck * 16 + (i & 3) + 8 * (i >> 2) + 4 * h) * DRW] = aY[i];
        asm volatile("s_waitcnt lgkmcnt(0)" ::: "memory");
        if (ck + 2 < 256) SQ_DMA(ck & 1, ck + 2);
    }
#undef SQ_DMA
    asm volatile("s_waitcnt vmcnt(0)" ::: "memory");
    __builtin_amdgcn_s_setprio(0);
}

template <bool WITH_V> __device__ __forceinline__ void dma_tile(LAS unsigned char* RW, const bf16* Kb, int key0, unsigned koff, const bf16* Vt, unsigned voff) {
    const char* kp = (const char*)(Kb + (size_t)key0 * 64) + koff;
#pragma unroll
    for (int q = 0; q < 4; ++q) __builtin_amdgcn_global_load_lds((const unsigned*)(kp + 1024 * q), (LAS unsigned*)(RW + q * 1024), 16, 0, 0);
    if (WITH_V) { const char* vp = (const char*)(Vt + (size_t)(key0 >> 5) * 2048) + voff;
#pragma unroll
        for (int q = 0; q < 4; ++q) __builtin_amdgcn_global_load_lds((const unsigned*)(vp + 1024 * q), (LAS unsigned*)(RW + (4 + q) * 1024), 16, 0, 0); }
}
template <bool WITH_V> __device__ __forceinline__ void read_tile(const LAS unsigned char* RW, unsigned krd, unsigned vrd, bf16x8 (&kf)[4], bf16x8 (&vf)[2][2], bool younger) {
    if (younger) { if (WITH_V) asm volatile("s_waitcnt vmcnt(8)" ::: "memory"); else asm volatile("s_waitcnt vmcnt(4)" ::: "memory"); } else asm volatile("s_waitcnt vmcnt(0)" ::: "memory");
    const int rk = (krd >> 7) & 7, hh = krd & 1;
#pragma unroll
    for (int ks = 0; ks < 4; ++ks) kf[ks] = *(const LAS bf16x8*)(RW + (krd & ~1u) + (((2 * ks + hh) ^ rk) << 4));
    if (WITH_V) {
#pragma unroll
        for (int q = 0; q < 4; ++q) { const int dt = q >> 1, s = q & 1; const unsigned row = (vrd >> 6) + 32 * dt; vf[dt][s] = *(const LAS bf16x8*)(RW + 4096 + row * 64 + ((((2 * hh + s)) ^ ((row >> 2) & 3)) << 4)); } }
    asm volatile("s_waitcnt lgkmcnt(0)" ::: "memory");
}
__device__ __forceinline__ f32x16 qk_tile(const bf16x8 (&kf)[4], const bf16x8 (&qf)[4]) {
    f32x16 S;
#pragma unroll
    for (int i = 0; i < 16; ++i) S[i] = 0.f;
#pragma unroll
    for (int ks = 0; ks < 4; ++ks) S = MFMA32(kf[ks], qf[ks], S);
    return S;
}
__device__ __forceinline__ void pv_tile(const float (&p)[16], const bf16x8 (&vf)[2][2], f32x16 (&O)[2]) {
#pragma unroll
    for (int s = 0; s < 2; ++s) { u32x4 w; w.x = cvtpk(p[8 * s], p[8 * s + 1]); w.y = cvtpk(p[8 * s + 2], p[8 * s + 3]); w.z = cvtpk(p[8 * s + 4], p[8 * s + 5]); w.w = cvtpk(p[8 * s + 6], p[8 * s + 7]);
        const bf16x8 pf = __builtin_bit_cast(bf16x8, w);
#pragma unroll
        for (int dt = 0; dt < 2; ++dt) O[dt] = MFMA32(vf[dt][s], pf, O[dt]); }
}
__device__ __forceinline__ void att_rest(f32x16& S, const bf16x8 (&vf)[2][2], int key0, int h, bool masked, int klo, int khi, bool colsel, float& m, float& l, f32x16 (&O)[2]) {
    if (masked) { const int kb = key0 + 4 * h;
#pragma unroll
        for (int i = 0; i < 16; ++i) { const int key = kb + (i & 3) + 8 * (i >> 2); S[i] = (key <= khi && key >= klo) ? S[i] : -INFINITY; } }
    float tmax = fmaxf(fmaxf(fmaxf(S[0], S[1]), fmaxf(S[2], S[3])), fmaxf(fmaxf(S[4], S[5]), fmaxf(S[6], S[7])));
    tmax = fmaxf(tmax, fmaxf(fmaxf(fmaxf(S[8], S[9]), fmaxf(S[10], S[11])), fmaxf(fmaxf(S[12], S[13]), fmaxf(S[14], S[15]))));
    tmax = half_max(tmax); tmax = colsel ? tmax : -INFINITY;
    if (__builtin_amdgcn_ballot_w64(tmax > m + 8.0f) != 0ull) {
        const float mn = fmaxf(m, tmax); const float ms = mn == -INFINITY ? 0.f : mn; const float alpha = __builtin_amdgcn_exp2f(m - ms);
        l *= alpha; m = mn;
#pragma unroll
        for (int dt = 0; dt < 2; ++dt)
#pragma unroll
            for (int i = 0; i < 16; ++i) O[dt][i] *= alpha;
    }
    float msx = m == -INFINITY ? 0.f : m; msx = colsel ? msx : INFINITY;
    float p[16]; float ps = 0.f;
#pragma unroll
    for (int i = 0; i < 16; ++i) { p[i] = __builtin_amdgcn_exp2f(S[i] - msx); ps += p[i]; }
    l += half_sum(ps);
    pv_tile(p, vf, O);
}
constexpr int NSA_RING0 = 16384;
static_assert(NSA_RING0 + 8 * 16384 <= LDS_SCRATCH, "attention LDS map");
__device__ __forceinline__ void phase_nsa(const Args& a, int qi, int l, LAS unsigned char* lds, int slot, int lane) {
    OPQ_SI(slot); OPQ_V(lane);
    unsigned char* ws = a.ws + opaque0();
    LAS float* impl = (LAS float*)(lds + slot * 2048);
    LAS unsigned char* RW = lds + NSA_RING0 + slot * 16384;
    const bf16* QR = (const bf16*)(ws + WS_QR); const float* P = (const float*)(ws + WS_P); const float* gate_b = INPTR(a, I_GB) + (size_t)l * 36; bf16* CAT = (bf16*)(ws + WS_CAT);
    unsigned* qctr = (unsigned*)(ws + WS_CTL) + 8192 + 64 * qi;
    const int r = lane & 31, h = lane >> 5, g = r & 3, ql = r >> 2;
    const unsigned koff = (unsigned)((lane >> 3) * 128 + (((lane & 7) ^ ((lane >> 3) & 7)) << 4)), voff = (unsigned)((lane >> 2) * 64 + (((lane & 3) ^ (((lane >> 2) >> 2) & 3)) << 4));
    const unsigned krd = (unsigned)(r * 128) | (unsigned)h, vrd = (unsigned)(r * 64);
    const int myx = (int)(xb_xcc_id() & 7u); int qsel = 0;
    for (;;) {
        int item = 0, qx = 0;
        for (;;) { qx = (myx + qsel) & 7; if (lane == 0) item = (int)atomicAdd(qctr + 8 * qx, 1u); item = __builtin_amdgcn_readfirstlane(item); if (item < 96 * 8 || qsel >= 7) break; ++qsel; }
        if (item >= 96 * 8) break;
        const int up = item >> 3, wave = item & 7, k3 = up / 3, e3 = up - 3 * k3;
        const int bk = e3 < 2 ? qx : 8 + (qx >> 1); const int qt = e3 == 0 ? 63 - 2 * k3 : (e3 == 1 ? 62 - 2 * k3 : 62 - 2 * k3 + (qx & 1));
        const int b = bk / 3, kvh = bk - b * 3;
        const int tile0 = qt * 64, cur = qt; const int qp = tile0 + 8 * wave + ql; const size_t mq = (size_t)b * SEQ + qp; const int head = kvh * 4 + g;
        bf16x8 qf[4];
#pragma unroll
        for (int ks = 0; ks < 4; ++ks) qf[ks] = *(const bf16x8*)(QR + mq * 768 + head * 64 + 16 * ks + 8 * h);
        float g0, g1, g2;
        { const float* gl = P + mq * INP + PO_GL + head * 3; const float* gb = gate_b + head * 3; g0 = sigmoidf_(gl[0] + gb[0]); g1 = sigmoidf_(gl[1] + gb[1]); g2 = sigmoidf_(gl[2] + gb[2]); }
        f32x16 out[2], O[2]; bf16x8 kf[4]; bf16x8 vf[2][2];
#pragma unroll
        for (int dt = 0; dt < 2; ++dt)
#pragma unroll
            for (int i = 0; i < 16; ++i) out[dt][i] = 0.f;
        unsigned long long mymask = (2ull << cur) - 1ull, umask = mymask;
        const int qpw = tile0 + 8 * wave + 7;
        {
            const bf16* Kb = (const bf16*)(ws + WS_KC) + (size_t)(b * 3 + kvh) * NCMPP * 64; const bf16* Vt = (const bf16*)(ws + WS_VCT) + (size_t)(b * 3 + kvh) * 8 * 2048;
            const int nvw = qpw >= 31 ? ((qpw - 31) >> 4) + 1 : 0; const int nvq = qp >= 31 ? ((qp - 31) >> 4) + 1 : 0; const int ntile = (nvw + 31) >> 5;
            const bool need_imp = cur >= 16;
            if (ntile > 0) {
                float m = -INFINITY, ls = 0.f;
                dma_tile<false>(RW, Kb, 0, koff, Vt, voff);
#pragma unroll 1
                for (int kt = 0; kt < ntile; ++kt) { read_tile<false>(RW, krd, vrd, kf, vf, false); if (kt + 1 < ntile) dma_tile<false>(RW, Kb, 32 * (kt + 1), koff, Vt, voff); else dma_tile<true>(RW, Kb, 0, koff, Vt, voff);
                    const f32x16 S = qk_tile(kf, qf);
                    float tmax = -INFINITY; float sv[16];
#pragma unroll
                    for (int i = 0; i < 16; ++i) { const int n = 32 * kt + (i & 3) + 8 * (i >> 2) + 4 * h; sv[i] = n < nvq ? S[i] : -INFINITY; tmax = fmaxf(tmax, sv[i]); }
                    tmax = half_max(tmax); const float mn = fmaxf(m, tmax); const float ms = mn == -INFINITY ? 0.f : mn; float ps = 0.f;
#pragma unroll
                    for (int i = 0; i < 16; ++i) ps += __builtin_amdgcn_exp2f(sv[i] - ms);
                    ls = ls * __builtin_amdgcn_exp2f(m - ms) + half_sum(ps); m = mn; }
                const float ms = m == -INFINITY ? 0.f : m; const float inv = 1.0f / fmaxf(ls, 1.17549435e-38f);
                float carry = 0.f;
#pragma unroll
                for (int dt = 0; dt < 2; ++dt)
#pragma unroll
                    for (int i = 0; i < 16; ++i) O[dt][i] = 0.f;
                if (need_imp) {
#pragma unroll
                    for (int i = 0; i < 8; ++i) impl[i * 64 + lane] = 0.f;
                    WSYNC(); }
#pragma unroll 1
                for (int kt = 0; kt < ntile; ++kt) {
                    read_tile<true>(RW, krd, vrd, kf, vf, false); if (kt + 1 < ntile) dma_tile<true>(RW, Kb, 32 * (kt + 1), koff, Vt, voff);
                    const f32x16 S = qk_tile(kf, qf);
                    float p[16];
#pragma unroll
                    for (int i = 0; i < 16; ++i) { const int n = 32 * kt + (i & 3) + 8 * (i >> 2) + 4 * h; p[i] = n < nvq ? __builtin_amdgcn_exp2f(S[i] - ms) * inv : 0.f; }
                    if (need_imp) {
                        float val[4];
#pragma unroll
                        for (int t = 0; t < 4; ++t) { const float sp = 0.5f * p[4 * t + 3]; const float base = (p[4 * t] + p[4 * t + 1]) + (p[4 * t + 2] + sp); const float rv = other_half(sp, h);
                            val[t] = base + (h ? rv : carry); carry = h ? 0.f : rv; }
#pragma unroll
                        for (int t = 0; t < 4; ++t) { float v = val[t]; v += dpp_f<0xB1>(v); v += dpp_f<0x4E>(v); if (g == 0) impl[ql * 64 + 8 * kt + 2 * t + h] = v; }
                    }
                    pv_tile(p, vf, O);
                }
#pragma unroll
                for (int dt = 0; dt < 2; ++dt)
#pragma unroll
                    for (int i = 0; i < 16; ++i) out[dt][i] = O[dt][i] * g0;
                if (need_imp) {
                    WSYNC();
#pragma unroll 1
                    for (int q = 0; q < 8; ++q) { const float v = impl[q * 64 + lane]; const bool forced = lane == 0 || lane == cur || lane == cur - 1; impl[q * 64 + lane] = lane > cur ? -INFINITY : (forced ? 1e9f : v); }
                    WSYNC();
                    umask = 0ull;
#pragma unroll 1
                    for (int q = 0; q < 8; ++q) { const float sc = impl[q * 64 + lane]; int rank = 0;
#pragma unroll 4
                        for (int i4 = 0; i4 < 16; ++i4) { const f32x4 o = *(const LAS f32x4*)(impl + q * 64 + 4 * i4);
                            rank += (o.x > sc || (o.x == sc && 4 * i4 + 0 < lane)) ? 1 : 0; rank += (o.y > sc || (o.y == sc && 4 * i4 + 1 < lane)) ? 1 : 0;
                            rank += (o.z > sc || (o.z == sc && 4 * i4 + 2 < lane)) ? 1 : 0; rank += (o.w > sc || (o.w == sc && 4 * i4 + 3 < lane)) ? 1 : 0; }
                        const unsigned long long mk = __ballot(lane <= cur && rank < 16);
                        umask |= mk; if (ql == q) mymask = mk; }
                    WSYNC();
                }
            }
        }
        {
            const bf16* Kb = (const bf16*)(ws + WS_KS) + (size_t)(b * 3 + kvh) * SEQ * 64; const bf16* Vt = (const bf16*)(ws + WS_VST) + (size_t)(b * 3 + kvh) * 128 * 2048;
            float m = -INFINITY, ls = 0.f;
#pragma unroll
            for (int dt = 0; dt < 2; ++dt)
#pragma unroll
                for (int i = 0; i < 16; ++i) O[dt][i] = 0.f;
            unsigned long long um = umask; int hf = 0;
#define SEL_NEXT(have, jb, key0) do { have = um != 0ull; if (have) { jb = __builtin_ctzll(um); key0 = 64 * jb + 32 * hf; if (hf == 0 && 64 * jb + 32 <= qpw) hf = 1; else { hf = 0; um &= um - 1ull; } } } while (0)
            bool h0, h1; int j0 = 0, k0 = 0, j1 = 0, k1 = 0, sl = 0;
            SEL_NEXT(h0, j0, k0); if (h0) dma_tile<true>(RW, Kb, k0, koff, Vt, voff);
            SEL_NEXT(h1, j1, k1); if (h1) dma_tile<true>(RW + 8192, Kb, k1, koff, Vt, voff);
#pragma unroll 1
            while (h0) {
                read_tile<true>(RW + sl * 8192, krd, vrd, kf, vf, h1);
                bool h2; int j2 = 0, k2 = 0; SEL_NEXT(h2, j2, k2); if (h2) dma_tile<true>(RW + sl * 8192, Kb, k2, koff, Vt, voff);
                f32x16 S = qk_tile(kf, qf);
                att_rest(S, vf, k0, h, j0 == cur, -0x7fffffff, qp, (mymask >> j0) & 1ull, m, ls, O);
                h0 = h1; j0 = j1; k0 = k1; h1 = h2; j1 = j2; k1 = k2; sl ^= 1;
            }
#undef SEL_NEXT
            const float sc = g1 / fmaxf(ls, 1.17549435e-38f);
#pragma unroll
            for (int dt = 0; dt < 2; ++dt)
#pragma unroll
                for (int i = 0; i < 16; ++i) out[dt][i] += O[dt][i] * sc;
        }
        {
            const bf16* Kb = (const bf16*)(ws + WS_KW) + (size_t)(b * 3 + kvh) * SEQ * 64; const bf16* Vt = (const bf16*)(ws + WS_VWT) + (size_t)(b * 3 + kvh) * 128 * 2048;
            float m = -INFINITY, ls = 0.f;
#pragma unroll
            for (int dt = 0; dt < 2; ++dt)
#pragma unroll
                for (int i = 0; i < 16; ++i) O[dt][i] = 0.f;
            const int q0w = tile0 + 8 * wave; const int lo = q0w - 511 > 0 ? q0w - 511 : 0;
            const int tEnd = (q0w + 7) >> 5; int t = lo >> 5;
            dma_tile<true>(RW, Kb, 32 * t, koff, Vt, voff); if (t + 1 <= tEnd) dma_tile<true>(RW + 8192, Kb, 32 * (t + 1), koff, Vt, voff);
            int sl = 0;
#pragma unroll 1
            for (; t <= tEnd; ++t) {
                read_tile<true>(RW + sl * 8192, krd, vrd, kf, vf, t + 1 <= tEnd);
                if (t + 2 <= tEnd) dma_tile<true>(RW + sl * 8192, Kb, 32 * (t + 2), koff, Vt, voff);
                f32x16 S = qk_tile(kf, qf);
                att_rest(S, vf, 32 * t, h, !(32 * t >= q0w + 7 - 511 && 32 * t + 31 <= q0w), qp - 511, qp, true, m, ls, O);
                sl ^= 1;
            }
            const float sc = g2 / fmaxf(ls, 1.17549435e-38f);
            bf16* op = CAT + mq * DM + DRW + DPOOL + head * 64 + 4 * h;
#pragma unroll
            for (int dt = 0; dt < 2; ++dt)
#pragma unroll
                for (int t2 = 0; t2 < 4; ++t2) { u32x2 w; w.x = cvtpk(out[dt][4 * t2] + O[dt][4 * t2] * sc, out[dt][4 * t2 + 1] + O[dt][4 * t2 + 1] * sc); w.y = cvtpk(out[dt][4 * t2 + 2] + O[dt][4 * t2 + 2] * sc, out[dt][4 * t2 + 3] + O[dt][4 * t2 + 3] * sc);
                    *(u32x2*)(op + 32 * dt + 8 * t2) = w; }
        }
    }
}

__device__ __forceinline__ void phase_rwkv_out(const Args& a, int l, int gw, int NGW, int lane) {
    OPQ_SI(gw); OPQ_V(lane);
    unsigned char* ws = a.ws + opaque0(); const float* YS = (const float*)(ws + WS_YS); const float* vV = (const float*)(ws + WS_SV + 5 * SV_STRIDE); const float* vG = (const float*)(ws + WS_G); const float* SC = (const float*)(ws + WS_SC);
    const float* gng = INPTR(a, I_GNG) + (size_t)l * DRW; const float* gnb = INPTR(a, I_GNB) + (size_t)l * DRW; bf16* CAT = (bf16*)(ws + WS_CAT);
    for (int id = gw; id < MTOK * 12; id += NGW) { const int m = id / 12, h = id - m * 12, c = h * 64 + lane; const size_t o = (size_t)m * DRW + c;
        const float y = YS[o]; const float mean = wave_sum(y) * (1.f / 64.f); const float d = y - mean; const float var = wave_sum(d * d) * (1.f / 64.f);
        const float yn = d * (1.f / sqrtf(var + GN_EPS)) * gng[c] + gnb[c]; const float bonus = SC[((size_t)m * 12 + h) * 4 + 2] * vV[o];
        CAT[(size_t)m * DM + c] = (bf16)f2bf((yn + bonus) * vG[o]); }
}

template <int PHMASK> __global__ void __launch_bounds__(NTHR, 2) fwd(Args args) {
    extern __shared__ __attribute__((aligned(16))) unsigned char lds_raw[];
    LAS unsigned char* lds = (LAS unsigned char*)lds_raw;
    const int tid = threadIdx.x, lane = tid & 63, wave = __builtin_amdgcn_readfirstlane(tid >> 6);
    const int G = gridDim.x, bid = blockIdx.x; const int gw = bid * NWAVES + wave, NGW = G * NWAVES;
    unsigned char* ws = args.ws;
    for (int u = tid; u < (LDS_BYTES - LDS_SCRATCH) / 4; u += NTHR) ((LAS unsigned*)(lds + LDS_SCRATCH))[u] = 0u;
    __syncthreads();
    const int lo = args.ph_lo, hi = args.ph_hi;
    XcdBarrier bar; bar.bar = (unsigned*)(ws + WS_CTL) + 4096; bar.x = 0; bar.st = nullptr;
    if (hi - lo > 1) bar = xcd_barrier_post((unsigned*)(ws + WS_CTL) + 4096, (volatile LAS unsigned*)(lds + MISC_OFF) + 8);
#define IN(k) (lo <= (k) && (k) < hi)
#define PHEN(j) (((PHMASK) >> (j)) & 1)
#ifndef REP_MASK
#define REP_MASK 0
#endif
#define SEAM(k) do { if ((k) + 1 < hi) xcd_barrier(bar); } while (0)
    bf16* XB = (bf16*)(ws + WS_XB); bf16* Hb = (bf16*)(ws + WS_H); float* Y = (float*)(ws + WS_YR); float* STATS = (float*)(ws + WS_STATS); float* Pm = (float*)(ws + WS_P); bf16* CAT = (bf16*)(ws + WS_CAT);

    if (PHEN(0) && IN(0)) { phase_prologue(args, bid * NTHR + tid, G * NTHR); SEAM(0); }
    for (int l = 0; l < NLAYER; ++l) {
        const int pb = 1 + 14 * l;
        for (int rep = 0; rep < (((REP_MASK) >> 1) & 1 ? 2 : 1); ++rep) if (PHEN(1) && IN(pb + 0)) { phase_wconv(args, l, lds, gw, NGW, wave, lane); SEAM(pb + 0); }
        for (int rep = 0; rep < (((REP_MASK) >> 2) & 1 ? 2 : 1); ++rep) if (PHEN(2) && IN(pb + 1)) {
            pg8::Gemm g{XB, (const bf16*)(ws + WS_WUP1), MTOK, NUP, DM}; pg8::StaticOrder S; S.init(MTOK, NUP, G, bid); pg8::EpiSwiGLU E{Hb, DFF};
            pg8::gemm_phase<pg8::EpiSwiGLU, pg8::StaticOrder, true, true>(lds, g, S, E); SEAM(pb + 1); }
        for (int rep = 0; rep < (((REP_MASK) >> 3) & 1 ? 2 : 1); ++rep) if (PHEN(3) && IN(pb + 2)) {
            pg8::Gemm g{Hb, (const bf16*)(ws + WS_WDN1), MTOK, DM, DFF}; pg8::StaticOrder S; S.init(MTOK, DM, G, bid); pg8::EpiResid E{l == 0 ? INPTR(args, I_X) : Y, Y, DM, ALPHA, 0.5f, l == 0 ? 0 : 1};
            pg8::gemm_phase<pg8::EpiResid, pg8::StaticOrder, true, true>(lds, g, S, E); SEAM(pb + 2); }
        for (int rep = 0; rep < (((REP_MASK) >> 4) & 1 ? 2 : 1); ++rep) if (PHEN(4) && IN(pb + 3)) { phase_ln(Y, INPTR(args, I_LN1G) + (size_t)l * DM, INPTR(args, I_LN1B) + (size_t)l * DM, nullptr, XB, STATS, gw, NGW, lane); SEAM(pb + 3); }
        for (int rep = 0; rep < (((REP_MASK) >> 5) & 1 ? 2 : 1); ++rep) if (PHEN(5) && IN(pb + 4)) {
            pg8::Gemm g{XB, (const bf16*)(ws + WS_WIN), MTOK, INP, DM}; pg8::StaticOrder S; S.init(MTOK, INP, G, bid); pg8::EpiF32 E{Pm, INP};
            pg8::gemm_phase<pg8::EpiF32, pg8::StaticOrder, true, true>(lds, g, S, E); SEAM(pb + 4); }
        for (int rep = 0; rep < (((REP_MASK) >> 6) & 1 ? 2 : 1); ++rep) if (PHEN(6) && IN(pb + 5)) { phase_m1(args, l, lds, bid, G, tid, wave, lane); SEAM(pb + 5); }
        for (int rep = 0; rep < (((REP_MASK) >> 7) & 1 ? 2 : 1); ++rep) if (PHEN(7) && IN(pb + 6)) { phase_scan_prep(args, lds, gw, NGW, wave, lane); SEAM(pb + 6); }
        for (int rep = 0; rep < (((REP_MASK) >> 8) & 1 ? 2 : 1); ++rep) if (PHEN(8) && IN(pb + 7)) { for (int r2 = 0; r2 < (((REP_MASK) >> 20) & 1 ? 2 : 1); ++r2) { if (bid < 96 && wave == 0) scan_seq(args, lds, bid, lane); } for (int r3 = 0; r3 < (((REP_MASK) >> 21) & 1 ? 2 : 1); ++r3) if (!(bid < 96 && wave == 1)) phase_nsa(args, l + 4 * rep + 8 * r3, l, lds, wave, lane); SEAM(pb + 7); }
        for (int rep = 0; rep < (((REP_MASK) >> 9) & 1 ? 2 : 1); ++rep) if (PHEN(9) && IN(pb + 8)) { phase_rwkv_out(args, l, gw, NGW, lane); SEAM(pb + 8); }
        for (int rep = 0; rep < (((REP_MASK) >> 10) & 1 ? 2 : 1); ++rep) if (PHEN(10) && IN(pb + 9)) {
            pg8::Gemm g{CAT, (const bf16*)(ws + WS_WOUT), MTOK, DM, DM}; pg8::StaticOrder S; S.init(MTOK, DM, G, bid); pg8::EpiResid E{Y, Y, DM, ALPHA, 1.0f, 1};
            pg8::gemm_phase<pg8::EpiResid, pg8::StaticOrder, true, true>(lds, g, S, E); SEAM(pb + 9); }
        for (int rep = 0; rep < (((REP_MASK) >> 11) & 1 ? 2 : 1); ++rep) if (PHEN(11) && IN(pb + 10)) { phase_ln(Y, INPTR(args, I_LN2G) + (size_t)l * DM, INPTR(args, I_LN2B) + (size_t)l * DM, nullptr, XB, STATS, gw, NGW, lane); SEAM(pb + 10); }
        for (int rep = 0; rep < (((REP_MASK) >> 12) & 1 ? 2 : 1); ++rep) if (PHEN(12) && IN(pb + 11)) {
            pg8::Gemm g{XB, (const bf16*)(ws + WS_WUP2), MTOK, NUP, DM}; pg8::StaticOrder S; S.init(MTOK, NUP, G, bid); pg8::EpiSwiGLU E{Hb, DFF};
            pg8::gemm_phase<pg8::EpiSwiGLU, pg8::StaticOrder, true, true>(lds, g, S, E); SEAM(pb + 11); }
        for (int rep = 0; rep < (((REP_MASK) >> 13) & 1 ? 2 : 1); ++rep) if (PHEN(13) && IN(pb + 12)) {
            pg8::Gemm g{Hb, (const bf16*)(ws + WS_WDN2), MTOK, DM, DFF}; pg8::StaticOrder S; S.init(MTOK, DM, G, bid); pg8::EpiResid E{Y, Y, DM, ALPHA, 0.5f, 1};
            pg8::gemm_phase<pg8::EpiResid, pg8::StaticOrder, true, true>(lds, g, S, E); SEAM(pb + 12); }
        for (int rep = 0; rep < (((REP_MASK) >> 14) & 1 ? 2 : 1); ++rep) if (PHEN(14) && IN(pb + 13)) { phase_ln(Y, INPTR(args, I_LN3G) + (size_t)l * DM, INPTR(args, I_LN3B) + (size_t)l * DM, l == NLAYER - 1 ? args.out : nullptr, XB, STATS, gw, NGW, lane); SEAM(pb + 13); }
    }
#undef IN
#undef SEAM
}

#ifndef ONE_MASK
#define ONE_MASK 0xFFFFF
#endif
#ifndef MK_ONE_LAUNCH
#define MK_ONE_LAUNCH 1
#endif
typedef void (*kern_t)(Args);
extern "C" void kernel_launch(void* const* d_in, const int* in_sizes, int n_in, void* d_out, int out_size, void* d_ws, size_t ws_size, hipStream_t stream) {
    static int grid = 0;
#if MK_ONE_LAUNCH
    static const kern_t kerns[1] = {fwd<ONE_MASK>};
    constexpr int NK = 1;
#else
    static const kern_t kerns[15] = {fwd<1 << 0>, fwd<1 << 1>, fwd<1 << 2>, fwd<1 << 3>, fwd<1 << 4>, fwd<1 << 5>, fwd<1 << 6>, fwd<1 << 7>, fwd<1 << 8>, fwd<1 << 9>, fwd<1 << 10>, fwd<1 << 11>, fwd<1 << 12>, fwd<1 << 13>, fwd<1 << 14>};
    constexpr int NK = 15;
#endif
    if (grid == 0) {
        if (n_in != 34 || out_size != MTOK * DM || ws_size < WS_END) { fprintf(stderr, "kernel_launch: unexpected shapes (n_in %d, out %d, ws %zu; need ws >= %zu)\n", n_in, out_size, ws_size, (size_t)WS_END); grid = -1; return; }
        int dev = 0, cus = 0;
        if (hipGetDevice(&dev) != hipSuccess || hipDeviceGetAttribute(&cus, hipDeviceAttributeMultiprocessorCount, dev) != hipSuccess) { grid = -1; return; }
        for (int i = 0; i < NK; ++i) if (hipFuncSetAttribute((const void*)kerns[i], hipFuncAttributeMaxDynamicSharedMemorySize, LDS_BYTES) != hipSuccess) { fprintf(stderr, "kernel_launch: hipFuncSetAttribute failed\n"); grid = -1; return; }
        int per_cu = 0;
        if (hipOccupancyMaxActiveBlocksPerMultiprocessor(&per_cu, (const void*)kerns[0], NTHR, LDS_BYTES) != hipSuccess || per_cu < 1) fprintf(stderr, "kernel_launch: occupancy query says %d blocks per CU\n", per_cu);
        (void)hipGetLastError();
        grid = cus;
    }
    if (grid < 0) return;
    (void)hipMemsetAsync((char*)d_ws + WS_CTL, 0, CTL_ZERO_BYTES, stream);
    Args a{};
    for (int i = 0; i < 34; ++i) a.in[i] = (const float*)d_in[i];
    a.out = (float*)d_out; a.ws = (unsigned char*)d_ws;
#if MK_ONE_LAUNCH
    a.ph_lo = 0; a.ph_hi = NPH;
    hipLaunchKernelGGL(kerns[0], dim3(grid), dim3(NTHR), LDS_BYTES, stream, a);
#else
#ifndef HOST_REP
#define HOST_REP 0
#endif
    for (int k = 0; k < NPH; ++k) { a.ph_lo = k; a.ph_hi = k + 1; const int j = k == 0 ? 0 : (k - 1) % 14 + 1;
        for (int rep = 0; rep < (((HOST_REP) >> j) & 1 ? 2 : 1); ++rep) {
            if (rep && j == 8) (void)hipMemsetAsync((char*)d_ws + WS_CTL + (8192 + 64 * ((k - 1) / 14)) * 4, 0, 256, stream);
            hipLaunchKernelGGL(kerns[j], dim3(grid), dim3(NTHR), LDS_BYTES, stream, a); } }
#endif
}
```

```cpp
#include <hip/hip_runtime.h>
#include <cstdio>
#include <cstdint>
namespace pg8 {
#define PG8_LAS __attribute__((address_space(3)))
typedef unsigned short bf16_t;
typedef short bf16x8 __attribute__((ext_vector_type(8)));
typedef float f32x4 __attribute__((ext_vector_type(4)));
typedef unsigned u32x4 __attribute__((ext_vector_type(4)));
constexpr int BM = 256, BK = 64, HALF = 128, HTB = HALF * BK * 2  , STAGE_BYTES = 8 * HTB, NXCD = 8, WGM = 8;

__host__ __device__ __forceinline__ int lds_byte(int r, int c) { const int st = (r >> 4) * 2 + (c >> 5), rr = r & 15, cc = c & 31, ob = rr * 64 + cc * 2; return st * 1024 + (ob ^ (((ob >> 9) & 1) << 5)); }
__host__ __device__ __forceinline__ void stage_rc(int b, int& R, int& C) { const int st = b / 1024, sb = b % 1024, swz = sb ^ (((sb >> 9) & 1) << 5); R = (st >> 1) * 16 + swz / 64; C = (st & 1) * 32 + (swz % 64) / 2; }
__host__ __device__ __forceinline__ int perm32(int rho) { const int n = rho >> 4, i = rho & 15; return 8 * (i >> 2) + 4 * n + (i & 3); }

struct Unit { int pm, pn; };
struct Gemm { const bf16_t* A; const bf16_t* Bt; int M, N, K; };

struct StaticOrder {
    int nM, nN, nwg, G, c;
    __host__ __device__ void init(int M, int N, int G_, int c_) { nM = M / BM; nN = N / BM; nwg = nM * nN; G = G_; c = c_; }
    __host__ __device__ bool next(int i, Unit& u) const {
        const long L = (long)i * G + c; if (L >= nwg) return false;
        int wgid = (int)L; { const int q = nwg / NXCD, r = nwg % NXCD, xcd = wgid % NXCD, off = wgid / NXCD; wgid = (xcd < r ? xcd * (q + 1) : r * (q + 1) + (xcd - r) * q) + off; }
        const int nig = WGM * nN, gid = wgid / nig, fm = gid * WGM, gsz = (nM - fm) < WGM ? (nM - fm) : WGM;
        u.pm = fm + ((wgid % nig) % gsz); u.pn = (wgid % nig) / gsz; return true;
    }
    __device__ __forceinline__ void a_ready(const Unit&) const {}
    __device__ __forceinline__ void done(const Unit&) const {}
};

__device__ __forceinline__ unsigned cvt_pk_bf16(float lo, float hi) { unsigned r; asm volatile("v_cvt_pk_bf16_f32 %0, %1, %2" : "=v"(r) : "v"(lo), "v"(hi)); return r; }
typedef float f32x2 __attribute__((ext_vector_type(2)));
constexpr int A_MT = 16384, A_DM = 2048, A_GWBW = 12 * A_MT * 2, A_GWN = 27136, A_LNGB = A_GWBW + 4 * 2 * A_GWN;
#define PG8_GAS __attribute__((address_space(1)))
template <class T> __device__ __forceinline__ PG8_GAS T* uni_ptr(T* p) { const unsigned long long v = (unsigned long long)p; const unsigned lo = __builtin_amdgcn_readfirstlane((unsigned)v), hi = __builtin_amdgcn_readfirstlane((unsigned)(v >> 32)); return (PG8_GAS T*)(((unsigned long long)hi << 32) | lo); }
__device__ __forceinline__ f32x2 ln_stats(const float* aux, int q, int row) { const f32x2 s = *(const f32x2*)(aux + ((size_t)q * A_MT + row) * 2); const float mean = s.x * (1.0f / A_DM);
    const float var = s.y * (1.0f / A_DM) - mean * mean; return (f32x2){mean, 1.0f / sqrtf(var + 1e-5f)}; }
struct EpiSwiGLU {
    static constexpr bool PERM = true, AFTER_DRAIN = false;
    bf16_t* H; int ldh; const float* aux; int q, gwo;
    __device__ __forceinline__ void operator()(const f32x4 (&acc)[2][2][4][2], const Unit& u, int wr, int wc, int fr, int fq, PG8_LAS unsigned char* xl) const {
        const int row0 = u.pm * BM + wr * 64 + fr, col0 = u.pn * HALF + wc * 32 + 8 * fq;
        const float* gwa = aux + A_GWBW + gwo + col0; const float* stp = aux + ((size_t)(q < 0 ? 0 : q) * A_MT + row0) * 2;
        f32x4 ga[2], gb[2], ba[2], bb[2]; f32x2 sr[8];
#pragma unroll
        for (int n = 0; n < 2; ++n) { ga[n] = (f32x4){0.f, 0.f, 0.f, 0.f}; gb[n] = ga[n]; ba[n] = ga[n]; bb[n] = ga[n]; }
#pragma unroll
        for (int k = 0; k < 8; ++k) sr[k] = (f32x2){0.f, (float)A_DM * (1.0f - 1e-5f)};
        if (q >= 0) {
#pragma unroll
            for (int n = 0; n < 2; ++n) { ga[n] = *(const f32x4*)(gwa + 4 * n); gb[n] = *(const f32x4*)(gwa + 5504 + 4 * n); ba[n] = *(const f32x4*)(gwa + A_GWN + 4 * n); bb[n] = *(const f32x4*)(gwa + A_GWN + 5504 + 4 * n); }
#pragma unroll
            for (int k = 0; k < 8; ++k) sr[k] = *(const f32x2*)(stp + ((k >> 2) * HALF + (k & 3) * 16) * 2);
        }
        asm volatile("" ::: "memory");
#pragma unroll
        for (int ai = 0; ai < 2; ++ai)
#pragma unroll
            for (int m = 0; m < 4; ++m) { const int row = row0 + ai * HALF + m * 16; bf16_t* rowp = H + (size_t)row * ldh + col0;
                const float mean = sr[ai * 4 + m].x * (1.0f / A_DM), rstd = 1.0f / sqrtf(sr[ai * 4 + m].y * (1.0f / A_DM) - mean * mean + 1e-5f);
                float hv[8];
#pragma unroll
                for (int n = 0; n < 2; ++n) {
#pragma unroll
                    for (int i = 0; i < 4; ++i) { const float a = (acc[ai][0][m][n][i] - mean * ga[n][i]) * rstd + ba[n][i], b = (acc[ai][1][m][n][i] - mean * gb[n][i]) * rstd + bb[n][i];
                        const float e = __builtin_amdgcn_exp2f(a * -1.44269504089f); hv[n * 4 + i] = a * __builtin_amdgcn_rcpf(1.0f + e) * b; } }
                u32x4 w; w.x = cvt_pk_bf16(hv[0], hv[1]); w.y = cvt_pk_bf16(hv[2], hv[3]); w.z = cvt_pk_bf16(hv[4], hv[5]); w.w = cvt_pk_bf16(hv[6], hv[7]);
                *(u32x4*)rowp = w; asm volatile("" ::: "memory"); }
    }
};
struct EpiResid {
    static constexpr bool PERM = false, AFTER_DRAIN = false;
    const float* X; float* Y; bf16_t* YB; int ldc; float alpha, s; int qp, qn;
    __device__ __forceinline__ void operator()(const f32x4 (&acc)[2][2][4][2], const Unit& u, int wr, int wc, int fr, int fq, PG8_LAS unsigned char* xl) const {
        const int urow0 = __builtin_amdgcn_readfirstlane(u.pm * BM + wr * 64), ucol0 = __builtin_amdgcn_readfirstlane(u.pn * BM + wc * 32); const unsigned lob = (unsigned)(fr * ldc + 4 * fq) * 4u;
        float al_ = alpha, sc_ = s; asm volatile("" : "+s"(al_), "+s"(sc_));
        const PG8_GAS float* Xu = uni_ptr(X); PG8_GAS float* Yu = uni_ptr(Y); PG8_GAS bf16_t* YBu = uni_ptr(YB);
        PG8_GAS float* aux = Yu + (size_t)A_MT * A_DM; const PG8_GAS float* lng = aux + A_LNGB + (size_t)(qp < 0 ? 0 : qp) * 2 * A_DM + ucol0 + 4 * fq; const PG8_GAS float* lnb = lng + A_DM;
        PG8_LAS float* wl = (PG8_LAS float*)(xl + (wr * 4 + wc) * 2048); PG8_LAS float* wacc = wl + 256;
#pragma unroll
        for (int e = 0; e < 2; ++e) { const int k = 2 * fq + e, j = 16 * k + fr; f32x2 st = {0.f, 1.f};
            if (qp >= 0) { const f32x2 sr = *(const PG8_GAS f32x2*)(aux + ((size_t)qp * A_MT + urow0 + (k >> 2) * HALF + (k & 3) * 16 + fr) * 2); const float mean = sr.x * (1.0f / A_DM);
                st.x = mean; st.y = 1.0f / sqrtf(sr.y * (1.0f / A_DM) - mean * mean + 1e-5f); }
            *(PG8_LAS f32x2*)(wl + 2 * j) = st; *(PG8_LAS f32x2*)(wacc + 2 * j) = (f32x2){0.f, 0.f}; }
        asm volatile("s_waitcnt lgkmcnt(0)" ::: "memory");
#pragma unroll
        for (int c = 0; c < 4; ++c) { const int ai = c >> 1, bj = c & 1;
            f32x4 gv[2], bv[2];
#pragma unroll
            for (int n = 0; n < 2; ++n) { gv[n] = (f32x4){1.f, 1.f, 1.f, 1.f}; bv[n] = (f32x4){0.f, 0.f, 0.f, 0.f}; }
            if (qp >= 0) {
#pragma unroll
                for (int n = 0; n < 2; ++n) { gv[n] = *(const PG8_GAS f32x4*)(lng + bj * HALF + n * 16); bv[n] = *(const PG8_GAS f32x4*)(lnb + bj * HALF + n * 16); } }
            f32x4 xv[4][2];
#pragma unroll
            for (int m = 0; m < 4; ++m) { int ur = urow0 + ai * HALF + m * 16; asm volatile("" : "+s"(ur));
#pragma unroll
                for (int n = 0; n < 2; ++n) xv[m][n] = *(const PG8_GAS f32x4*)((const PG8_GAS char*)(Xu + (size_t)ur * ldc + ucol0 + bj * HALF + n * 16) + lob); }
            asm volatile("" ::: "memory");
#pragma unroll
            for (int m = 0; m < 4; ++m) { int ur = urow0 + ai * HALF + m * 16; asm volatile("" : "+s"(ur)); const size_t uoff = (size_t)ur * ldc + ucol0 + bj * HALF;
                const int j = 16 * (ai * 4 + m) + fr; const f32x2 st = *(const PG8_LAS f32x2*)(wl + 2 * j); float p1 = 0.f, p2 = 0.f;
#pragma unroll
                for (int n = 0; n < 2; ++n) {
                    const f32x4 x = (xv[m][n] - st.x) * st.y * gv[n] + bv[n];
                    const f32x4 y = x * al_ + acc[ai][bj][m][n] * sc_;
                    *(PG8_GAS f32x4*)((PG8_GAS char*)(Yu + uoff + n * 16) + lob) = y;
                    typedef unsigned u32x2_ __attribute__((ext_vector_type(2))); u32x2_ wb; wb.x = cvt_pk_bf16(y.x, y.y); wb.y = cvt_pk_bf16(y.z, y.w); *(PG8_GAS u32x2_*)((PG8_GAS char*)(YBu + uoff + n * 16) + (lob >> 1)) = wb;
                    p1 += (y.x + y.y) + (y.z + y.w); p2 += (y.x * y.x + y.y * y.y) + (y.z * y.z + y.w * y.w); }
                __hip_atomic_fetch_add(wacc + 2 * j, p1, __ATOMIC_RELAXED, __HIP_MEMORY_SCOPE_WORKGROUP); __hip_atomic_fetch_add(wacc + 2 * j + 1, p2, __ATOMIC_RELAXED, __HIP_MEMORY_SCOPE_WORKGROUP); }
            asm volatile("" ::: "memory"); }
        asm volatile("s_waitcnt lgkmcnt(0)" ::: "memory");
#pragma unroll
        for (int e = 0; e < 2; ++e) { const int k = 2 * fq + e, j = 16 * k + fr; const f32x2 t = *(const PG8_LAS f32x2*)(wacc + 2 * j);
            PG8_GAS float* sp = aux + ((size_t)qn * A_MT + urow0 + (k >> 2) * HALF + (k & 3) * 16 + fr) * 2;
            __hip_atomic_fetch_add(sp, t.x, __ATOMIC_RELAXED, __HIP_MEMORY_SCOPE_AGENT); __hip_atomic_fetch_add(sp + 1, t.y, __ATOMIC_RELAXED, __HIP_MEMORY_SCOPE_AGENT); }
        asm volatile("s_waitcnt lgkmcnt(0)" ::: "memory");
    }
};
struct EpiF32 {
    static constexpr bool PERM = false, AFTER_DRAIN = false;
    float* C; int ldc; const float* aux; int q, gwo;
    __device__ __forceinline__ void operator()(const f32x4 (&acc)[2][2][4][2], const Unit& u, int wr, int wc, int fr, int fq, PG8_LAS unsigned char* xl) const {
        const int row0 = u.pm * BM + wr * 64 + fr, col0 = u.pn * BM + wc * 32 + 4 * fq;
        const float* gw = aux + A_GWBW + gwo + col0; const float* stp = aux + ((size_t)q * A_MT + row0) * 2;
        f32x4 g4[2][2], b4[2][2]; f32x2 sr[8];
#pragma unroll
        for (int bj = 0; bj < 2; ++bj)
#pragma unroll
            for (int n = 0; n < 2; ++n) { g4[bj][n] = *(const f32x4*)(gw + bj * HALF + n * 16); b4[bj][n] = *(const f32x4*)(gw + A_GWN + bj * HALF + n * 16); }
#pragma unroll
        for (int k = 0; k < 8; ++k) sr[k] = *(const f32x2*)(stp + ((k >> 2) * HALF + (k & 3) * 16) * 2);
        asm volatile("" ::: "memory");
#pragma unroll
        for (int ai = 0; ai < 2; ++ai)
#pragma unroll
            for (int m = 0; m < 4; ++m) { const int row = row0 + ai * HALF + m * 16; float* rowp = C + (size_t)row * ldc + col0;
                const float mean = sr[ai * 4 + m].x * (1.0f / A_DM), rstd = 1.0f / sqrtf(sr[ai * 4 + m].y * (1.0f / A_DM) - mean * mean + 1e-5f);
#pragma unroll
                for (int bj = 0; bj < 2; ++bj)
#pragma unroll
                    for (int n = 0; n < 2; ++n) *(f32x4*)(rowp + bj * HALF + n * 16) = (acc[ai][bj][m][n] - g4[bj][n] * mean) * rstd + b4[bj][n];
                asm volatile("" ::: "memory"); }
    }
};

template <class Epi, class Sched, bool ALIGN_EPI = false, bool SP2 = false>
__device__ __forceinline__ void gemm_phase(PG8_LAS unsigned char* lds, const Gemm g, const Sched& S, const Epi& E) {
    int tid_ = threadIdx.x; asm volatile("" : "+v"(tid_));
    const int tid = tid_, wid = __builtin_amdgcn_readfirstlane(tid >> 6), lane = tid & 63, wr = wid >> 2, wc = wid & 3, fr = lane & 15, fq = lane >> 4;
    const int K = g.K, nt = K / BK;
    unsigned voffA[2], voffB[2];
#pragma unroll
    for (int i = 0; i < 2; ++i) { int R, C; stage_rc(tid * 16 + i * 8192, R, C); const int Rb = Epi::PERM ? ((R & ~31) + perm32(R & 31)) : R;
        voffA[i] = (unsigned)(R * K + C) * 2u; voffB[i] = (unsigned)(Rb * K + C) * 2u; }
    const size_t kstep = (size_t)(BK * 2);
    const size_t hstep = (size_t)HALF * K * 2;
    const size_t tstep = 2 * hstep;
    const unsigned ldsw = (unsigned)wid * 1024u;
    const int aoff = lds_byte(wr * 64 + fr, fq * 8), boff = lds_byte(wc * 32 + fr, fq * 8);
#define PG8_SA(b, h) (((b) * 2 + (h)) * HTB)
#define PG8_SB(b, h) ((4 + (b) * 2 + (h)) * HTB)
#define PG8_STAGE(bufoff, gbase, voff) do { _Pragma("unroll") for (int _i = 0; _i < 2; ++_i) \
        __builtin_amdgcn_global_load_lds((const unsigned*)((const char*)(gbase) + (voff)[_i]), (PG8_LAS unsigned*)(lds + (bufoff) + ldsw + _i * 8192), 16, 0, 0); } while (0)
#define PG8_LDA(dst, b, h) do { _Pragma("unroll") for (int m = 0; m < 4; ++m) _Pragma("unroll") for (int k = 0; k < 2; ++k) dst[m][k] = *(const PG8_LAS bf16x8*)(lds + PG8_SA(b, h) + aoff + m * 2048 + k * 1024); } while (0)
#define PG8_LDB(dst, b, h) do { _Pragma("unroll") for (int n = 0; n < 2; ++n) _Pragma("unroll") for (int k = 0; k < 2; ++k) dst[n][k] = *(const PG8_LAS bf16x8*)(lds + PG8_SB(b, h) + boff + n * 2048 + k * 1024); } while (0)
#define PG8_MMA(ai, bj, At, Bt) do { __builtin_amdgcn_s_setprio(1); _Pragma("unroll") for (int m = 0; m < 4; ++m) _Pragma("unroll") for (int n = 0; n < 2; ++n) _Pragma("unroll") for (int k = 0; k < 2; ++k) \
        acc[ai][bj][m][n] = __builtin_amdgcn_mfma_f32_16x16x32_bf16(Bt[n][k], At[m][k], acc[ai][bj][m][n], 0, 0, 0); __builtin_amdgcn_s_setprio(0); } while (0)
#define PG8_WAIT_V(n) asm volatile("s_waitcnt vmcnt(" #n ")" ::: "memory")
#define PG8_WAIT_L(n) asm volatile("s_waitcnt lgkmcnt(" #n ")" ::: "memory")
#define PG8_BAR __builtin_amdgcn_s_barrier()
#define PG8_SCHED __builtin_amdgcn_sched_barrier(0)
    Unit cur, nxt; int ui = 0;
    if (!S.next(0, cur)) return;
    f32x4 acc[2][2][4][2];
#pragma unroll
    for (int a = 0; a < 2; ++a)
#pragma unroll
        for (int b = 0; b < 2; ++b)
#pragma unroll
            for (int m = 0; m < 4; ++m)
#pragma unroll
                for (int n = 0; n < 2; ++n) acc[a][b][m][n] = (f32x4){0.f, 0.f, 0.f, 0.f};
    bf16x8 At[4][2], B0[2][2], B1[2][2];
    const char* cA = (const char*)g.A + (size_t)cur.pm * tstep; const char* cB = (const char*)g.Bt + (size_t)cur.pn * tstep;
    S.a_ready(cur);
    if constexpr (SP2) {
        PG8_STAGE(PG8_SB(0, 0), cB, voffB); PG8_STAGE(PG8_SB(0, 1), cB + hstep, voffB); PG8_STAGE(PG8_SA(0, 0), cA, voffA); PG8_STAGE(PG8_SA(0, 1), cA + hstep, voffA);
        if (wr == 1) PG8_BAR;
        PG8_WAIT_V(2); PG8_BAR;
        PG8_STAGE(PG8_SB(1, 0), cB + kstep, voffB); PG8_STAGE(PG8_SA(1, 0), cA + kstep, voffA); PG8_STAGE(PG8_SB(1, 1), cB + hstep + kstep, voffB);
        PG8_WAIT_V(6); PG8_BAR;
    } else {
        PG8_STAGE(PG8_SB(0, 0), cB, voffB); PG8_STAGE(PG8_SA(0, 0), cA, voffA); PG8_STAGE(PG8_SB(0, 1), cB + hstep, voffB); PG8_STAGE(PG8_SA(0, 1), cA + hstep, voffA);
        if (wr == 1) PG8_BAR;
        PG8_WAIT_V(4); PG8_BAR;
        PG8_STAGE(PG8_SB(1, 0), cB + kstep, voffB); PG8_STAGE(PG8_SA(1, 0), cA + kstep, voffA); PG8_STAGE(PG8_SB(1, 1), cB + hstep + kstep, voffB);
        PG8_WAIT_V(6); PG8_BAR;
    }
    for (;;) {
        const bool has_next = S.next(ui + 1, nxt);
        const char* nA = has_next ? (const char*)g.A + (size_t)nxt.pm * tstep : cA; const char* nB = has_next ? (const char*)g.Bt + (size_t)nxt.pn * tstep : cB;
        for (int t = 0; t < nt; t += 2) {
            const bool last = (t == nt - 2);
            const char* a1 = cA + (size_t)(t + 1) * kstep;
            const char* a2 = last ? nA : cA + (size_t)(t + 2) * kstep; const char* b2 = last ? nB : cB + (size_t)(t + 2) * kstep;
            const char* a3 = a2 + kstep; const char* b3 = b2 + kstep;
            if (last && has_next) S.a_ready(nxt);
            if constexpr (SP2) {
            PG8_LDB(B0, 0, 0); PG8_LDB(B1, 0, 1); PG8_SCHED; PG8_LDA(At, 0, 0); PG8_STAGE(PG8_SA(1, 1), a1 + hstep, voffA);
            PG8_WAIT_V(8); PG8_WAIT_L(0); PG8_BAR; PG8_MMA(0, 0, At, B0); PG8_MMA(0, 1, At, B1); PG8_BAR; PG8_SCHED;
            PG8_LDA(At, 0, 1); PG8_STAGE(PG8_SB(0, 0), b2, voffB); PG8_STAGE(PG8_SB(0, 1), b2 + hstep, voffB); PG8_STAGE(PG8_SA(0, 0), a2, voffA);
            PG8_WAIT_V(8); PG8_WAIT_L(0); PG8_BAR; PG8_MMA(1, 0, At, B0); PG8_MMA(1, 1, At, B1); PG8_BAR; PG8_SCHED;
            PG8_LDB(B0, 1, 0); PG8_LDB(B1, 1, 1); PG8_SCHED; PG8_LDA(At, 1, 0); PG8_STAGE(PG8_SA(0, 1), a2 + hstep, voffA);
            PG8_WAIT_V(8); PG8_WAIT_L(0); PG8_BAR; PG8_MMA(0, 0, At, B0); PG8_MMA(0, 1, At, B1); PG8_BAR; PG8_SCHED;
            PG8_LDA(At, 1, 1); PG8_STAGE(PG8_SB(1, 0), b3, voffB); PG8_STAGE(PG8_SB(1, 1), b3 + hstep, voffB); PG8_STAGE(PG8_SA(1, 0), a3, voffA);
            PG8_WAIT_V(8); PG8_WAIT_L(0); PG8_BAR; PG8_MMA(1, 0, At, B0); PG8_MMA(1, 1, At, B1); PG8_BAR; PG8_SCHED;
            } else {
            PG8_LDB(B0, 0, 0); PG8_SCHED; PG8_LDA(At, 0, 0); PG8_STAGE(PG8_SA(1, 1), a1 + hstep, voffA);
            PG8_WAIT_L(8); PG8_BAR; PG8_WAIT_L(0); PG8_MMA(0, 0, At, B0); PG8_BAR; PG8_SCHED;
            PG8_LDB(B1, 0, 1); PG8_STAGE(PG8_SB(0, 0), b2, voffB);
            PG8_BAR; PG8_WAIT_L(0); PG8_MMA(0, 1, At, B1); PG8_BAR;
            PG8_LDA(At, 0, 1); PG8_STAGE(PG8_SA(0, 0), a2, voffA);
            PG8_BAR; PG8_WAIT_L(0); PG8_MMA(1, 0, At, B0); PG8_BAR; PG8_SCHED;
            PG8_STAGE(PG8_SB(0, 1), b2 + hstep, voffB);
            PG8_WAIT_V(6); PG8_BAR; PG8_MMA(1, 1, At, B1); PG8_BAR;
            PG8_LDB(B0, 1, 0); PG8_SCHED; PG8_LDA(At, 1, 0); PG8_STAGE(PG8_SA(0, 1), a2 + hstep, voffA);
            PG8_WAIT_L(8); PG8_BAR; PG8_WAIT_L(0); PG8_MMA(0, 0, At, B0); PG8_BAR; PG8_SCHED;
            PG8_LDB(B1, 1, 1); PG8_STAGE(PG8_SB(1, 0), b3, voffB);
            PG8_BAR; PG8_WAIT_L(0); PG8_MMA(0, 1, At, B1); PG8_BAR;
            PG8_LDA(At, 1, 1); PG8_STAGE(PG8_SA(1, 0), a3, voffA);
            PG8_BAR; PG8_WAIT_L(0); PG8_MMA(1, 0, At, B0); PG8_BAR; PG8_SCHED;
            PG8_STAGE(PG8_SB(1, 1), b3 + hstep, voffB);
            PG8_WAIT_V(6); PG8_BAR; PG8_MMA(1, 1, At, B1); PG8_BAR;
            }
        }
        if constexpr (ALIGN_EPI) { if (wr == 0) PG8_BAR; }
        if constexpr (!Epi::AFTER_DRAIN) { E(acc, cur, wr, wc, fr, fq, lds + STAGE_BYTES); S.done(cur); }
        if (!has_next) break;
#pragma unroll
        for (int a = 0; a < 2; ++a)
#pragma unroll
            for (int b = 0; b < 2; ++b)
#pragma unroll
                for (int m = 0; m < 4; ++m)
#pragma unroll
                    for (int n = 0; n < 2; ++n) acc[a][b][m][n] = (f32x4){0.f, 0.f, 0.f, 0.f};
        cur = nxt; cA = nA; cB = nB; ++ui;
        if constexpr (ALIGN_EPI) { if (wr == 1) PG8_BAR; }
    }
    PG8_WAIT_V(0);
    if constexpr (!ALIGN_EPI) { if (wr == 0) PG8_BAR; }
    PG8_BAR;
    if constexpr (Epi::AFTER_DRAIN) { E.fused(acc, cur, wr, wc, fr, fq, lds, wid, lane); S.done(cur); }
#undef PG8_SA
#undef PG8_SB
#undef PG8_STAGE
#undef PG8_LDA
#undef PG8_LDB
#undef PG8_MMA
#undef PG8_WAIT_V
#undef PG8_WAIT_L
#undef PG8_BAR
#undef PG8_SCHED
}
}

constexpr int NWAVES = 8, NTHR = 512;
constexpr int NB = 4, SEQ = 4096, DM = 2048, MTOK = NB * SEQ, NLAYER = 4;
constexpr int DFF = 5504, NUP = 2 * DFF;
constexpr int INC = 5028, INP = 5120;
constexpr int DRW = 768, RWC = 2560, PO_POOL = 2560, DPOOL = 512, PO_NSA = 3072;
constexpr int PO_Q = PO_NSA, PO_KC = PO_NSA + 768, PO_VC = PO_KC + 192, PO_KS = PO_VC + 192, PO_VS = PO_KS + 192, PO_KW = PO_VS + 192, PO_VW = PO_KW + 192, PO_GL = PO_VW + 192;
static_assert(PO_GL + 36 == INC, "W_in column map");
constexpr int NCMP = 255, NCMPP = 256;
constexpr float ALPHA = 1.6817928305074290f;
constexpr float LN_EPS = 1e-5f, GN_EPS = 64e-5f;
constexpr int NPH = 1 + 14 * NLAYER;

constexpr size_t MiB = 1u << 20;
constexpr size_t WS_CTL = 0, CTL_ZERO_BYTES = 1 * MiB;
constexpr size_t WS_ROPE = 1 * MiB;
constexpr size_t WS_KC = 2 * MiB, WS_VC = 2 * MiB + 512 * 1024;
constexpr size_t WS_SC = 3 * MiB;
constexpr size_t WS_WUP1 = 8 * MiB, WS_WDN1 = 51 * MiB, WS_WIN = WS_WDN1 + 21 * MiB + 512 * 1024, WS_WOUT = WS_WIN + 20 * MiB, WS_WUP2 = WS_WOUT + 8 * MiB, WS_WDN2 = WS_WUP2 + 43 * MiB;
constexpr size_t WS_XB = 165 * MiB;
static_assert(WS_WDN2 + (size_t)DM * DFF * 2 <= WS_XB, "weights map");
constexpr size_t WS_CAT = 229 * MiB;
constexpr size_t WS_QR = 293 * MiB;
constexpr size_t WS_KS = 317 * MiB, WS_KW = 323 * MiB, WS_VS = 329 * MiB, WS_VW = 335 * MiB;
constexpr size_t WS_P = 341 * MiB;
constexpr size_t WS_H = 661 * MiB;
constexpr size_t WS_Y = 833 * MiB;
constexpr size_t WS_SV = WS_H;
constexpr size_t SV_STRIDE = 48 * MiB;
static_assert(WS_SV + 6 * SV_STRIDE <= WS_Y + 128 * MiB, "scan overlay");
constexpr size_t WS_G = 961 * MiB, WS_YS = 1009 * MiB;
constexpr size_t WS_VST = 1057 * MiB, WS_VWT = 1063 * MiB;
constexpr size_t WS_VCT = 6 * MiB;
constexpr size_t WS_SW = 1069 * MiB;
constexpr size_t WS_W2T = WS_SW, WS_A2T = WS_W2T + 768 * 64 * 2, WS_G2T = WS_A2T + 768 * 64 * 2, WS_PWT = WS_G2T + 768 * 128 * 2;
constexpr size_t WS_W1T = WS_PWT + 4 * 128 * 128 * 2, WS_W2CT = WS_W1T + 2 * 256 * 2048 * 2, WS_CBIAS = WS_W2CT + 2 * 64 * 256 * 2;
constexpr size_t WS_SPREC = 1073 * MiB;
constexpr size_t SPREC_BYTES = 15360, WS_YR = WS_SPREC + (size_t)NB * 12 * 256 * SPREC_BYTES + MiB;
constexpr int GWN = NUP + INP + NUP;
constexpr size_t WS_AUX = WS_YR + 128 * MiB;
constexpr size_t AUX_ST = 0, AUX_GWBW = AUX_ST + (size_t)12 * MTOK * 2 * 4, AUX_ZERO_BYTES = AUX_GWBW + (size_t)NLAYER * 2 * GWN * 4, AUX_LNGB = (AUX_ZERO_BYTES + 255) & ~(size_t)255;
constexpr size_t WS_END = WS_AUX + AUX_LNGB + (size_t)12 * 2 * DM * 4 + MiB;
static_assert(WS_CBIAS + 2 * 256 * 4 <= WS_END, "small weights map");

constexpr int LDS_SCRATCH = 147456;
constexpr int LDS_BYTES = LDS_SCRATCH + 1024, MISC_OFF = LDS_SCRATCH + 320;

#define GAS __attribute__((address_space(1)))
#define LAS __attribute__((address_space(3)))
typedef unsigned short bf16;
typedef float f32x4 __attribute__((ext_vector_type(4)));
typedef float f32x2 __attribute__((ext_vector_type(2)));
typedef unsigned u32x4 __attribute__((ext_vector_type(4)));
typedef unsigned u32x2 __attribute__((ext_vector_type(2)));
#define LDS_WAIT() asm volatile("s_waitcnt lgkmcnt(0)" ::: "memory")
__device__ __forceinline__ unsigned f2bf(float f) { unsigned u = __builtin_bit_cast(unsigned, f); return (u + 0x7fffu + ((u >> 16) & 1u)) >> 16; }
__device__ __forceinline__ unsigned pk2(float lo, float hi) { return f2bf(lo) | (f2bf(hi) << 16); }
__device__ __forceinline__ float bf2f(unsigned short b) { return __builtin_bit_cast(float, ((unsigned)b) << 16); }
__device__ __forceinline__ float wave_sum(float v) {
#pragma unroll
    for (int o = 1; o < 64; o <<= 1) v += __shfl_xor(v, o);
    return v;
}
__device__ __forceinline__ float wave_max(float v) {
#pragma unroll
    for (int o = 1; o < 64; o <<= 1) v = fmaxf(v, __shfl_xor(v, o));
    return v;
}
__device__ __forceinline__ float sigmoidf_(float x) { return 1.0f / (1.0f + expf(-x)); }
template <int CTRL> __device__ __forceinline__ float dpp_f(float v) { return __builtin_bit_cast(float, __builtin_amdgcn_update_dpp(0, __builtin_bit_cast(int, v), CTRL, 0xF, 0xF, true)); }
__device__ __forceinline__ float row16_sum(float v) {
    v += dpp_f<0xB1>(v); v += dpp_f<0x4E>(v); v += dpp_f<0x141>(v); v += dpp_f<0x140>(v); return v;
}

#define XB_TMO      128
#define XB_XCNT(j)  (256  + 64 * (j))
#define XB_XSUB(j)  (1280 + 64 * (j))
#define XB_XGEN(j)  (2304 + 64 * (j))
#define XB_TOP      3328
#define XB_TOPGEN   3392
#define XCD_BAR_WORDS 3456
#define XB_SPIN_CAP (1u << 18)

__device__ __forceinline__ unsigned xb_ld(unsigned* p)              { return __hip_atomic_load(p, __ATOMIC_RELAXED, __HIP_MEMORY_SCOPE_AGENT); }
__device__ __forceinline__ unsigned xb_add(unsigned* p, unsigned v) { return __hip_atomic_fetch_add(p, v, __ATOMIC_RELAXED, __HIP_MEMORY_SCOPE_AGENT); }
__device__ __forceinline__ unsigned xb_xcc_id() { return (unsigned)__builtin_amdgcn_s_getreg((3 << 11) | 20) & 0xFu; }
#define XB_SPIN(cond, bar) do { unsigned _sp = 0; while (cond) { __builtin_amdgcn_s_sleep(1); \
    if ((++_sp & 255u) == 0u) { if (xb_ld(&(bar)[XB_TMO])) break; if (_sp > XB_SPIN_CAP) { atomicAdd(&(bar)[XB_TMO], 1u); break; } } } } while (0)

struct XcdBarrier {
    unsigned* bar; unsigned x;
    volatile LAS unsigned* st;
};

__device__ __forceinline__ XcdBarrier xcd_barrier_post(unsigned* bar, volatile LAS unsigned* st) {
    XcdBarrier b; b.bar = bar; b.x = xb_xcc_id(); b.st = st;
    if (threadIdx.x == 0) (void)xb_add(&bar[XB_XCNT(b.x)], 1u);
    return b;
}
__device__ __forceinline__ void xcd_barrier_complete(unsigned* bar, unsigned x, unsigned& nloc, unsigned& nx) {
    const unsigned G = gridDim.x * gridDim.y * gridDim.z;
    unsigned sum, cnt, mine, sp = 0u;
    for (;;) {
        sum = 0u; cnt = 0u; mine = 0u;
#pragma unroll
        for (unsigned j = 0; j < 16; ++j) { const unsigned c = xb_ld(&bar[XB_XCNT(j)]); sum += c; cnt += (c > 0u) ? 1u : 0u; mine = (j == x) ? c : mine; }
        if (sum == G) break;
        __builtin_amdgcn_s_sleep(1);
        if ((++sp & 255u) == 0u) { if (xb_ld(&bar[XB_TMO])) break; if (sp > XB_SPIN_CAP) { atomicAdd(&bar[XB_TMO], 1u); break; } }
    }
    nloc = mine > 0u ? mine : 1u; nx = cnt > 0u ? cnt : 1u;
}

__device__ __forceinline__ void xcd_barrier(const XcdBarrier& b) {
    asm volatile("s_waitcnt vmcnt(0)" ::: "memory");
    __syncthreads();
    if (threadIdx.x == 0) {
        unsigned* bar = b.bar;
        __builtin_amdgcn_s_waitcnt(0);
        unsigned nloc = b.st[0], nx = b.st[1];
        if (nloc == 0u) { xcd_barrier_complete(bar, b.x, nloc, nx); b.st[0] = nloc; b.st[1] = nx; }
        const unsigned old = xb_add(&bar[XB_XSUB(b.x)], 1u);
        const unsigned gen = old / nloc;
        if (old + 1u == (gen + 1u) * nloc) {
            __builtin_amdgcn_fence(__ATOMIC_RELEASE, "agent");
            asm volatile("s_waitcnt vmcnt(0)" ::: "memory");
            const unsigned og = xb_add(&bar[XB_TOP], 1u);
            const unsigned tg = og / nx;
            if (og + 1u == (tg + 1u) * nx) xb_add(&bar[XB_TOPGEN], 1u);
            else XB_SPIN(xb_ld(&bar[XB_TOPGEN]) == tg, bar);
            __builtin_amdgcn_fence(__ATOMIC_ACQUIRE, "agent");
            xb_add(&bar[XB_XGEN(b.x)], 1u);
            asm volatile("s_waitcnt vmcnt(0)" ::: "memory");
        } else {
            XB_SPIN(xb_ld(&bar[XB_XGEN(b.x)]) == gen, bar);
            __builtin_amdgcn_fence(__ATOMIC_ACQUIRE, "agent");
            asm volatile("s_waitcnt vmcnt(0)" ::: "memory");
        }
    }
    __syncthreads();
}

struct Args { const float* in[34]; float* out; unsigned char* ws; int ph_lo, ph_hi; };
__device__ __forceinline__ int opaque0() { int z = 0; asm volatile("" : "+s"(z)); return z; }
#define OPQ_S(x) asm volatile("" : "+s"(x))
#define OPQ_SI(x) do { (x) = __builtin_amdgcn_readfirstlane(x); asm volatile("" : "+s"(x)); } while (0)
#define OPQ_V(x) asm volatile("" : "+v"(x))
#define INPTR(a, idx) ((a).in[(idx) + opaque0()])
enum { I_X = 0, I_UP1, I_DN1, I_LN1G, I_LN1B, I_WIN, I_MU, I_W0, I_W2, I_A0, I_A2, I_G2, I_KK, I_KA, I_RK, I_GNG, I_GNB, I_PW, I_PB, I_PS, I_PEK, I_PEV, I_CK1, I_CK2, I_CV1, I_CV2, I_GB, I_WOUT, I_LN2G, I_LN2B, I_UP2, I_DN2, I_LN3G, I_LN3B };

template <bool LN = false> __device__ __forceinline__ void transpose_item(const float* W, int K, int Nsrc, bf16* WT, int dst0, LAS float* scr, int k0, int n0, int lane, const float* lng = nullptr, const float* lnb = nullptr, float* gwp = nullptr) {
    const int c4 = lane & 15, rq = lane >> 4; const int n = n0 + 4 * c4; const bool ok = n < Nsrc;
    const float* wp = W + (size_t)(k0 + rq) * Nsrc + n;
    f32x4 sg = {0.f, 0.f, 0.f, 0.f}, sb = sg;
#pragma unroll 8
    for (int i = 0; i < 16; ++i) { f32x4 v = ok ? *(const f32x4*)(wp + (size_t)(4 * i) * Nsrc) : (f32x4){0.f, 0.f, 0.f, 0.f};
        if constexpr (LN) { const float g = lng[k0 + 4 * i + rq], b = lnb[k0 + 4 * i + rq]; sb += v * b; v = v * g; sg += v; }
        LAS float* d = scr + (4 * i + rq) * 65 + 4 * c4; d[0] = v.x; d[1] = v.y; d[2] = v.z; d[3] = v.w; }
    if constexpr (LN) {
#pragma unroll
        for (int e = 0; e < 4; ++e) { sg[e] += __shfl_xor(sg[e], 16); sg[e] += __shfl_xor(sg[e], 32); sb[e] += __shfl_xor(sb[e], 16); sb[e] += __shfl_xor(sb[e], 32); }
        if (rq == 0 && ok) {
#pragma unroll
            for (int e = 0; e < 4; ++e) { __hip_atomic_fetch_add((GAS float*)gwp + n + e, sg[e], __ATOMIC_RELAXED, __HIP_MEMORY_SCOPE_AGENT); __hip_atomic_fetch_add((GAS float*)gwp + GWN + n + e, sb[e], __ATOMIC_RELAXED, __HIP_MEMORY_SCOPE_AGENT); } } }
    LDS_WAIT();
    const int c = lane & 7;
#pragma unroll
    for (int j = 0; j < 8; ++j) { const int nn = (lane >> 3) + 8 * j; const LAS float* s = scr + (8 * c) * 65 + nn;
        u32x4 o; o.x = pk2(s[0 * 65], s[1 * 65]); o.y = pk2(s[2 * 65], s[3 * 65]); o.z = pk2(s[4 * 65], s[5 * 65]); o.w = pk2(s[6 * 65], s[7 * 65]);
        *(u32x4*)(WT + (size_t)(dst0 + nn) * K + k0 + 8 * c) = o; }
    LDS_WAIT();
}
__device__ __forceinline__ int up_dst_row(int n0) { return n0 < DFF ? 256 * (n0 / 128) + (n0 % 128) : 256 * ((n0 - DFF) / 128) + 128 + ((n0 - DFF) % 128); }

__device__ __forceinline__ void phase_wconv(const Args& a, int l, LAS unsigned char* lds, int gw, int NGW, int wave, int lane) {
    OPQ_SI(gw); OPQ_SI(wave); OPQ_V(lane);
    LAS float* scr = (LAS float*)(lds + wave * 16640);
    unsigned char* ws = a.ws + opaque0();
    float* gwl = (float*)(ws + WS_AUX + AUX_GWBW) + (size_t)l * 2 * GWN;
    {
        const int gt = gw * 64 + lane; if (gt < 3 * 2 * (DM / 4)) { const int j = gt / (2 * (DM / 4)), r2 = gt - j * 2 * (DM / 4), isb = r2 / (DM / 4), c4_ = r2 - isb * (DM / 4);
            const float* src = (j == 0 ? (isb ? INPTR(a, I_LN1B) : INPTR(a, I_LN1G)) : j == 1 ? (isb ? INPTR(a, I_LN2B) : INPTR(a, I_LN2G)) : (isb ? INPTR(a, I_LN3B) : INPTR(a, I_LN3G))) + (size_t)l * DM;
            ((f32x4*)(ws + WS_AUX + AUX_LNGB))[((size_t)(3 * l + j) * 2 + isb) * (DM / 4) + c4_] = ((const f32x4*)src)[c4_]; } }
    constexpr int I_UP = (DM / 64) * (NUP / 64), I_DN = (DFF / 64) * (DM / 64), I_IN = (DM / 64) * (INP / 64), I_OUT = (DM / 64) * (DM / 64);
    constexpr int NIT = 2 * I_UP + 2 * I_DN + I_IN + I_OUT + 12 + 12 + 24 + 16 + 256 + 8;
    for (int it = gw; it < NIT; it += NGW) {
        int r = it;
        if (r < 2 * I_UP) { const int which = r / I_UP; r -= which * I_UP; const int nblk = NUP / 64, kb = r / nblk, nb = r % nblk;
            const float* W = a.in[which ? I_UP2 : I_UP1] + (size_t)l * DM * NUP; bf16* WT = (bf16*)(ws + (which ? WS_WUP2 : WS_WUP1));
            const float* lg = which ? INPTR(a, I_LN2G) + (size_t)l * DM : (l > 0 ? INPTR(a, I_LN3G) + (size_t)(l - 1) * DM : nullptr);
            const float* lb = which ? INPTR(a, I_LN2B) + (size_t)l * DM : (l > 0 ? INPTR(a, I_LN3B) + (size_t)(l - 1) * DM : nullptr);
            if (lg) transpose_item<true>(W, DM, NUP, WT, up_dst_row(64 * nb), scr, 64 * kb, 64 * nb, lane, lg, lb, gwl + (which ? NUP + INP : 0)); else transpose_item<false>(W, DM, NUP, WT, up_dst_row(64 * nb), scr, 64 * kb, 64 * nb, lane); continue; }
        r -= 2 * I_UP;
        if (r < 2 * I_DN) { const int which = r / I_DN; r -= which * I_DN; const int nblk = DM / 64, kb = r / nblk, nb = r % nblk;
            const float* W = a.in[which ? I_DN2 : I_DN1] + (size_t)l * DFF * DM; bf16* WT = (bf16*)(ws + (which ? WS_WDN2 : WS_WDN1));
            transpose_item(W, DFF, DM, WT, 64 * nb, scr, 64 * kb, 64 * nb, lane); continue; }
        r -= 2 * I_DN;
        if (r < I_IN) { const int nblk = INP / 64, kb = r / nblk, nb = r % nblk;
            transpose_item<true>(INPTR(a, I_WIN) + (size_t)l * DM * INC, DM, INC, (bf16*)(ws + WS_WIN), 64 * nb, scr, 64 * kb, 64 * nb, lane, INPTR(a, I_LN1G) + (size_t)l * DM, INPTR(a, I_LN1B) + (size_t)l * DM, gwl + NUP); continue; }
        r -= I_IN;
        if (r < I_OUT) { const int nblk = DM / 64, kb = r / nblk, nb = r % nblk;
            transpose_item(INPTR(a, I_WOUT) + (size_t)l * DM * DM, DM, DM, (bf16*)(ws + WS_WOUT), 64 * nb, scr, 64 * kb, 64 * nb, lane); continue; }
        r -= I_OUT;
        if (r < 12) { transpose_item(INPTR(a, I_W2) + (size_t)l * 64 * DRW, 64, DRW, (bf16*)(ws + WS_W2T), 64 * r, scr, 0, 64 * r, lane); continue; } r -= 12;
        if (r < 12) { transpose_item(INPTR(a, I_A2) + (size_t)l * 64 * DRW, 64, DRW, (bf16*)(ws + WS_A2T), 64 * r, scr, 0, 64 * r, lane); continue; } r -= 12;
        if (r < 24) { const int kb = r / 12, nb = r % 12; transpose_item(INPTR(a, I_G2) + (size_t)l * 128 * DRW, 128, DRW, (bf16*)(ws + WS_G2T), 64 * nb, scr, 64 * kb, 64 * nb, lane); continue; } r -= 24;
        if (r < 16) { const int gi = r >> 2, q = r & 3, kb = q >> 1, nb = q & 1; transpose_item(INPTR(a, I_PW) + ((size_t)l * 4 + gi) * 128 * 128, 128, 128, (bf16*)(ws + WS_PWT) + gi * 128 * 128, 64 * nb, scr, 64 * kb, 64 * nb, lane); continue; } r -= 16;
        if (r < 256) { const int ten = r >> 7, q = r & 127, kb = q >> 2, nb = q & 3; transpose_item(INPTR(a, ten ? I_CV1 : I_CK1) + (size_t)l * 2048 * 256, 2048, 256, (bf16*)(ws + WS_W1T) + (size_t)ten * 256 * 2048, 64 * nb, scr, 64 * kb, 64 * nb, lane); continue; } r -= 256;
        { const int ten = r >> 2, kb = r & 3; transpose_item(INPTR(a, ten ? I_CV2 : I_CK2) + (size_t)l * 256 * 64, 256, 64, (bf16*)(ws + WS_W2CT) + (size_t)ten * 64 * 256, 0, scr, 64 * kb, 0, lane); }
    }
}

__device__ __forceinline__ void phase_prologue(const Args& a, int gtid, int NGT) {
    OPQ_V(gtid);
    const f32x4* x4 = (const f32x4*)INPTR(a, I_X); u32x2* xb = (u32x2*)(a.ws + WS_XB);
    for (size_t i = gtid; i < (size_t)MTOK * DM / 4; i += NGT) { const f32x4 v = x4[i]; u32x2 o; o.x = pk2(v.x, v.y); o.y = pk2(v.z, v.w); xb[i] = o; }
    f32x2* rope = (f32x2*)(a.ws + WS_ROPE);
    for (int i = gtid; i < SEQ * 8; i += NGT) { const int s = i >> 3, k = i & 7;
        const float inv = powf(500000.0f, -(float)k * 0.125f); const float ang = (float)s * inv;
        const double ad = (double)ang; const double q = __builtin_rint(ad * 0.15915494309189535); const double rr = ad - q * 6.283185307179586;
        const float rf = (float)rr; rope[i] = (f32x2){cosf(rf), sinf(rf)}; }
}

__device__ __forceinline__ void phase_ln(const float* Y, const float* g, const float* b, float* X, bf16* XB, float* stats, int gw, int NGW, int lane) {
    OPQ_SI(gw); OPQ_V(lane);
    f32x4 gv[8], bv[8];
#pragma unroll
    for (int j = 0; j < 8; ++j) { gv[j] = ((const f32x4*)g)[64 * j + lane]; bv[j] = ((const f32x4*)b)[64 * j + lane]; }
    if (gw < NWAVES) { f32x4* gd = (f32x4*)(stats + 2 * MTOK) + gw * 64 + lane; gd[0] = ((const f32x4*)g)[gw * 64 + lane]; gd[512] = ((const f32x4*)b)[gw * 64 + lane]; }
    f32x4 nx[8];
    { const f32x4* yr0 = (const f32x4*)(Y + (size_t)(gw < MTOK ? gw : 0) * DM) + lane;
#pragma unroll
        for (int j = 0; j < 8; ++j) nx[j] = yr0[64 * j]; }
    for (int m = gw; m < MTOK; m += NGW) {
        f32x4 v[8]; float s = 0.f;
#pragma unroll
        for (int j = 0; j < 8; ++j) v[j] = nx[j];
        { const int mn = m + NGW < MTOK ? m + NGW : m; const f32x4* yrn = (const f32x4*)(Y + (size_t)mn * DM) + lane;
#pragma unroll
            for (int j = 0; j < 8; ++j) nx[j] = yrn[64 * j]; }
#pragma unroll
        for (int j = 0; j < 8; ++j) s += (v[j].x + v[j].y) + (v[j].z + v[j].w);
        const float mean = wave_sum(s) * (1.f / DM); float s2 = 0.f;
#pragma unroll
        for (int j = 0; j < 8; ++j) { v[j] = v[j] - mean; s2 += (v[j].x * v[j].x + v[j].y * v[j].y) + (v[j].z * v[j].z + v[j].w * v[j].w); }
        const float rstd = 1.f / sqrtf(wave_sum(s2) * (1.f / DM) + LN_EPS);
        if (lane == 0) *(f32x2*)(stats + 2 * (size_t)m) = (f32x2){mean, rstd};
        u32x2* xb = (u32x2*)(XB + (size_t)m * DM) + lane;
        if (X) { f32x4* xr = (f32x4*)(X + (size_t)m * DM) + lane;
#pragma unroll
            for (int j = 0; j < 8; ++j) { const f32x4 o = v[j] * rstd * gv[j] + bv[j]; xr[64 * j] = o; } }
#pragma unroll
        for (int j = 0; j < 8; ++j) { const f32x4 o = v[j] * rstd * gv[j] + bv[j]; u32x2 w; w.x = pk2(o.x, o.y); w.y = pk2(o.z, o.w); xb[64 * j] = w; }
    }
}


typedef float f32x16 __attribute__((ext_vector_type(16)));
typedef short bf16x8 __attribute__((ext_vector_type(8)));
#define MFMA32(a, b, c) __builtin_amdgcn_mfma_f32_32x32x16_bf16((a), (b), (c), 0, 0, 0)
#define WSYNC() asm volatile("s_waitcnt lgkmcnt(0)" ::: "memory")
__device__ __forceinline__ void half_swap(float x, float& lo, float& hi) { float a = x, b = x; asm volatile("s_nop 1\n\tv_permlane32_swap_b32 %0, %1" : "+v"(a), "+v"(b)); lo = a; hi = b; }
__device__ __forceinline__ float half_max(float x) { float lo, hi; half_swap(x, lo, hi); return fmaxf(lo, hi); }
__device__ __forceinline__ float half_sum(float x) { float lo, hi; half_swap(x, lo, hi); return lo + hi; }
__device__ __forceinline__ float other_half(float x, int h) { float lo, hi; half_swap(x, lo, hi); return h ? lo : hi; }
__device__ __forceinline__ unsigned cvtpk(float lo, float hi) { unsigned r; asm volatile("v_cvt_pk_bf16_f32 %0, %1, %2" : "=v"(r) : "v"(lo), "v"(hi)); return r; }
__device__ __forceinline__ float half32_sum(float v) { v = row16_sum(v); float a = v, b = v; asm volatile("s_nop 1\n\tv_permlane16_swap_b32 %0, %1" : "+v"(a), "+v"(b)); return a + b; }
__device__ __forceinline__ int vt_pos(int k) { return 16 * ((k >> 2) & 1) + 8 * (k >> 4) + 4 * ((k >> 3) & 1) + (k & 3); }
__device__ __forceinline__ float fexp(float x) { return __builtin_amdgcn_exp2f(x * 1.4426950408889634f); }
__device__ __forceinline__ float fsigmoid(float x) { return __builtin_amdgcn_rcpf(1.0f + __builtin_amdgcn_exp2f(x * -1.4426950408889634f)); }
__device__ __forceinline__ float ftanh(float x) { const float xc = fminf(fmaxf(x, -15.f), 15.f); return 1.0f - 2.0f * __builtin_amdgcn_rcpf(1.0f + __builtin_amdgcn_exp2f(xc * 2.8853900817779268f)); }
__device__ __forceinline__ float fsoftplus(float z) { return z > 20.f ? z : __builtin_amdgcn_logf(1.0f + __builtin_amdgcn_exp2f(z * 1.4426950408889634f)) * 0.6931471805599453f; }

#ifndef REP_MASK
#define REP_MASK 0
#endif
#ifndef M1_PREFETCH
#define M1_PREFETCH 1
#endif
constexpr int XP = 264, ZP = 520, HP = 264;
__device__ __forceinline__ bf16x8 lds_frag(const LAS bf16* p) { return *(const LAS bf16x8*)p; }
__device__ __forceinline__ bf16x8 cvt8(const f32x4 a, const f32x4 b) { u32x4 w; w.x = cvtpk(a.x, a.y); w.y = cvtpk(a.z, a.w); w.z = cvtpk(b.x, b.y); w.w = cvtpk(b.z, b.w); return __builtin_bit_cast(bf16x8, w); }
__device__ __forceinline__ void phase_m1(const Args& a, int l, LAS unsigned char* lds, int bid, int G, int tid, int wave, int lane) {
    OPQ_SI(bid); OPQ_V(tid); OPQ_SI(wave); lane = tid & 63;
    unsigned char* ws = a.ws + opaque0(); const float* P = (const float*)(ws + WS_P);
    const int r = lane & 31, h = lane >> 5;
    const f32x2* rope = (const f32x2*)(ws + WS_ROPE);
    for (int rp1 = 0; rp1 < (((REP_MASK) >> 22) & 1 ? 2 : 1); ++rp1)
    for (int unit = bid; unit < MTOK / 64; unit += G) {
        const int t0 = unit * 64, b = t0 >> 12, s0 = t0 & (SEQ - 1);
        LAS bf16* XL = (LAS bf16*)lds;
        LAS bf16* ZL = (LAS bf16*)(lds + 64 * XP * 2);
        { const float* mu = INPTR(a, I_MU) + (size_t)l * RWC;
#pragma unroll 8
            for (int i = tid; i < 64 * 256; i += NTHR) { const int tt = i >> 8, j = i & 255, col = 2304 + j; const int m = t0 + tt;
                const float pc = P[(size_t)m * INP + col]; const float pp = (s0 + tt) > 0 ? P[(size_t)(m - 1) * INP + col] : 0.f; const float v = pc + (pp - pc) * mu[col];
                const float f = j < 64 ? ftanh(v) : (j < 128 ? v : fsigmoid(v)); XL[tt * XP + j] = (bf16)f2bf(f); }
            {
                const int ch = tid, gi = ch >> 7, win = 2 << gi; const float* pp = P + (size_t)t0 * INP + PO_POOL + ch; float sum = 0.f;
                for (int j = 1; j < win; ++j) if (s0 - j >= 0) sum += pp[-(ptrdiff_t)j * INP];
#pragma unroll 8
                for (int tt = 0; tt < 64; ++tt) { const int s = s0 + tt; const float cur = pp[(size_t)tt * INP]; sum += cur; const int cnt = (s + 1) < win ? (s + 1) : win;
                    ZL[tt * ZP + ch] = (bf16)f2bf(sum / (float)cnt - cur); if (s - win + 1 >= 0) sum -= pp[((ptrdiff_t)tt - win + 1) * INP]; } } }
        __syncthreads();
        {
            const float* mu = INPTR(a, I_MU) + (size_t)l * RWC; const float* w0 = INPTR(a, I_W0) + (size_t)l * DRW; const float* a0 = INPTR(a, I_A0) + (size_t)l * DRW;
            const float* k_k = INPTR(a, I_KK) + (size_t)l * DRW; const float* k_a = INPTR(a, I_KA) + (size_t)l * DRW; const float* r_k = INPTR(a, I_RK) + (size_t)l * DRW;
            const bf16* W2T = (const bf16*)(ws + WS_W2T); const bf16* A2T = (const bf16*)(ws + WS_A2T); const bf16* G2T = (const bf16*)(ws + WS_G2T);
            float* vKK = (float*)(ws + WS_SV); float* vWR = (float*)(ws + WS_SV + SV_STRIDE); float* vW = (float*)(ws + WS_SV + 2 * SV_STRIDE);
            float* vKM = (float*)(ws + WS_SV + 3 * SV_STRIDE); float* vBB = (float*)(ws + WS_SV + 4 * SV_STRIDE); float* vV = (float*)(ws + WS_SV + 5 * SV_STRIDE);
            float* vG = (float*)(ws + WS_G); float* SC = (float*)(ws + WS_SC);
#pragma unroll 1
            for (int jj = 0; jj < 3; ++jj) {
                const int job = wave + 8 * jj, hd = job >> 1, th = job & 1;
                f32x16 aU[2], aA[2];
#pragma unroll
                for (int t = 0; t < 2; ++t)
#pragma unroll
                    for (int i = 0; i < 16; ++i) { aU[t][i] = 0.f; aA[t][i] = 0.f; }
                const LAS bf16* xa = XL + (32 * th + r) * XP + 8 * h;
#pragma unroll
                for (int ks = 0; ks < 4; ++ks) { const bf16x8 xt = lds_frag(xa + 16 * ks), xl = lds_frag(xa + 64 + 16 * ks);
#pragma unroll
                    for (int t = 0; t < 2; ++t) { const int c = hd * 64 + 32 * t + r;
                        aU[t] = MFMA32(xt, *(const bf16x8*)(W2T + (size_t)c * 64 + 16 * ks + 8 * h), aU[t]);
                        aA[t] = MFMA32(xl, *(const bf16x8*)(A2T + (size_t)c * 64 + 16 * ks + 8 * h), aA[t]); } }
                float pmr[2], pmk[2], pmv[2], pw0[2], pa0[2], pkk[2], pka[2], prk[2];
#pragma unroll
                for (int t = 0; t < 2; ++t) { const int c = hd * 64 + 32 * t + r; pmr[t] = mu[c]; pmk[t] = mu[768 + c]; pmv[t] = mu[1536 + c]; pw0[t] = w0[c]; pa0[t] = a0[c]; pkk[t] = k_k[c]; pka[t] = k_a[c]; prk[t] = r_k[c]; }
                const int lo_p = 4 * h * INP + hd * 64 + r, lo_s = 4 * h * DRW + hd * 64 + r;
                float ld[2][12];
#define M1_LOADROW(buf, i) do { int mr_ = t0 + 32 * th + ((i) & 3) + 8 * ((i) >> 2); OPQ_SI(mr_); const bool first_ = (s0 + 32 * th + ((i) & 3) + 8 * ((i) >> 2) + 4 * h) == 0; \
        const float* pc_ = P + (size_t)mr_ * INP; const float* pp_ = pc_ - INP; _Pragma("unroll") for (int t = 0; t < 2; ++t) { const int o = lo_p + 32 * t; \
        buf[6 * t + 0] = pc_[o]; buf[6 * t + 1] = pc_[o + 768]; buf[6 * t + 2] = pc_[o + 1536]; buf[6 * t + 3] = first_ ? 0.f : pp_[o]; buf[6 * t + 4] = first_ ? 0.f : pp_[o + 768]; buf[6 * t + 5] = first_ ? 0.f : pp_[o + 1536]; } } while (0)
                M1_LOADROW(ld[0], 0);
#pragma unroll
                for (int i = 0; i < 16; ++i) {
#if M1_PREFETCH
                    if (i + 1 < 16) M1_LOADROW(ld[(i + 1) & 1], i + 1);
#else
                    if (i > 0) M1_LOADROW(ld[i & 1], i);
#endif
                    int mrow = t0 + 32 * th + (i & 3) + 8 * (i >> 2); OPQ_SI(mrow);
                    float rr[2], kv[2], vv[2], dec[2], av[2], kr[2], km[2];
                    float ss = 0.f, s1 = 0.f, s2 = 0.f, s3 = 0.f;
#pragma unroll
                    for (int t = 0; t < 2; ++t) { const float* L = ld[i & 1] + 6 * t;
                        const float rc = L[0], kc = L[1], vc = L[2], rp = L[3], kp = L[4], vp = L[5];
                        rr[t] = rc + (rp - rc) * pmr[t]; kv[t] = kc + (kp - kc) * pmk[t]; vv[t] = vc + (vp - vc) * pmv[t];
                        const float uu = pw0[t] + aU[t][i]; const float z = -uu; const float sp = fsoftplus(z); dec[t] = fexp(-fexp(-sp - 0.5f));
                        av[t] = fsigmoid(pa0[t] + aA[t][i]);
                        kr[t] = kv[t] * pkk[t]; km[t] = kv[t] * (1.0f + (av[t] - 1.0f) * pka[t]);
                        ss += kr[t] * kr[t]; s1 += kr[t] * av[t] * rr[t]; s2 += km[t] * rr[t]; s3 += rr[t] * km[t] * prk[t]; }
                    ss = half32_sum(ss); s1 = half32_sum(s1); s2 = half32_sum(s2); s3 = half32_sum(s3);
                    const float invn = 1.0f / fmaxf(sqrtf(ss), 1e-12f);
                    const size_t ro = (size_t)mrow * DRW;
#pragma unroll
                    for (int t = 0; t < 2; ++t) { const int o = lo_s + 32 * t; const float kk = kr[t] * invn;
                        (vKK + ro)[o] = kk; (vWR + ro)[o] = dec[t] * rr[t]; (vW + ro)[o] = dec[t]; (vKM + ro)[o] = km[t]; (vBB + ro)[o] = kk * av[t]; (vV + ro)[o] = vv[t]; }
                    if (r == 0) *(f32x4*)(SC + ((size_t)mrow * 12 + hd) * 4 + 4 * h * 48) = (f32x4){s1 * invn, s2, s3, 0.f};
                    asm volatile("" ::: "memory");
                }
#undef M1_LOADROW
                { f32x16 aG[2];
#pragma unroll
                    for (int t = 0; t < 2; ++t)
#pragma unroll
                        for (int i = 0; i < 16; ++i) aG[t][i] = 0.f;
#pragma unroll
                    for (int ks = 0; ks < 8; ++ks) { const bf16x8 xg = lds_frag(xa + 128 + 16 * ks);
#pragma unroll
                        for (int t = 0; t < 2; ++t) { const int c = hd * 64 + 32 * t + r; aG[t] = MFMA32(xg, *(const bf16x8*)(G2T + (size_t)c * 128 + 16 * ks + 8 * h), aG[t]); } }
#pragma unroll
                    for (int i = 0; i < 16; ++i) { int mrow = t0 + 32 * th + (i & 3) + 8 * (i >> 2); OPQ_SI(mrow); float* gp = vG + (size_t)mrow * DRW;
#pragma unroll
                        for (int t = 0; t < 2; ++t) gp[lo_s + 32 * t] = aG[t][i]; } }
            }
        }
        {
            int lane_b = lane; OPQ_V(lane_b); const int r = lane_b & 31, h = lane_b >> 5;
            const int gi = wave >> 1, th = wave & 1; const bf16* PWT = (const bf16*)(ws + WS_PWT) + gi * 128 * 128;
            const float* pb = INPTR(a, I_PB) + (size_t)l * DPOOL + gi * 128; const float* psc = INPTR(a, I_PS) + (size_t)l * DPOOL + gi * 128; bf16* CAT = (bf16*)(ws + WS_CAT);
            f32x16 acc[4];
#pragma unroll
            for (int t = 0; t < 4; ++t)
#pragma unroll
                for (int i = 0; i < 16; ++i) acc[t][i] = 0.f;
            const LAS bf16* za = ZL + (32 * th + r) * ZP + gi * 128 + 8 * h;
#pragma unroll
            for (int ks = 0; ks < 8; ++ks) { const bf16x8 zf = lds_frag(za + 16 * ks);
#pragma unroll
                for (int t = 0; t < 4; ++t) acc[t] = MFMA32(zf, *(const bf16x8*)(PWT + (size_t)(32 * t + r) * 128 + 16 * ks + 8 * h), acc[t]); }
#pragma unroll
            for (int t = 0; t < 4; ++t) { const int d = 32 * t + r; const float bv = pb[d], sv = psc[d];
#pragma unroll
                for (int i = 0; i < 16; ++i) { const int m = t0 + 32 * th + (i & 3) + 8 * (i >> 2) + 4 * h; CAT[(size_t)m * DM + DRW + gi * 128 + d] = (bf16)f2bf((acc[t][i] + bv) * sv); } }
        }
        __syncthreads();
        {
            int tid_c = tid; OPQ_V(tid_c); const int tid = tid_c;
            bf16* QR = (bf16*)(ws + WS_QR); bf16* KS = (bf16*)(ws + WS_KS); bf16* KW = (bf16*)(ws + WS_KW); bf16* VST = (bf16*)(ws + WS_VST); bf16* VWT = (bf16*)(ws + WS_VWT);
            LAS float* T0 = (LAS float*)lds; LAS float* T1 = T0 + 64 * 193;
#pragma unroll 1
            for (int c = tid; c < 1152; c += NTHR) {
                int src; float scale = 1.f; const int d = c & 63; const bool isq = c < 768; const int cc = isq ? c : (c < 960 ? c - 768 : c - 960);
                bf16* dbase;
                if (isq) { src = PO_Q + c; dbase = QR + (size_t)t0 * 768 + c; scale = 0.125f * 1.4426950408889634f; }
                else if (c < 960) { src = PO_KS + cc; dbase = KS + ((size_t)(b * 3 + (cc >> 6)) * SEQ + s0) * 64 + (cc & 63); }
                else { src = PO_KW + cc; dbase = KW + ((size_t)(b * 3 + (cc >> 6)) * SEQ + s0) * 64 + (cc & 63); }
                const int dstep = isq ? 768 : 64; const bool rot = d < 16; const int po = d < 8 ? 8 : -8; const float sg = d < 8 ? -1.f : 1.f;
                const float* pr = P + (size_t)t0 * INP + src; const f32x2* rp = rope + s0 * 8 + (d & 7);
#pragma unroll 1
                for (int t8 = 0; t8 < 64; t8 += 8) { float v[8], pv[8]; f32x2 cs[8];
#pragma unroll
                    for (int e = 0; e < 8; ++e) { v[e] = pr[(size_t)(t8 + e) * INP]; pv[e] = pr[(size_t)(t8 + e) * INP + (rot ? po : 0)]; cs[e] = rp[(t8 + e) * 8]; }
#pragma unroll
                    for (int e = 0; e < 8; ++e) { const float o = rot ? v[e] * cs[e].x + sg * pv[e] * cs[e].y : v[e]; dbase[(size_t)(t8 + e) * dstep] = (bf16)f2bf(o * scale); } } }
            if (tid < 384) { const int c = tid; const float* pr = P + (size_t)t0 * INP + (c < 192 ? PO_VS + c : PO_VW + (c - 192)); LAS float* td = c < 192 ? T0 + c : T1 + (c - 192);
#pragma unroll 1
                for (int t8 = 0; t8 < 64; t8 += 16) { float v[16];
#pragma unroll
                    for (int e = 0; e < 16; ++e) v[e] = pr[(size_t)(t8 + e) * INP];
#pragma unroll
                    for (int e = 0; e < 16; ++e) td[(t8 + e) * 193] = v[e]; } }
            __syncthreads();
            for (int i = tid; i < 384 * 64; i += NTHR) { const int c2 = i >> 6, tok = i & 63; const int which = c2 >= 192, c = which ? c2 - 192 : c2;
                const float v = (which ? T1 : T0)[tok * 193 + c]; const int sk = s0 + tok;
                bf16* dst = (which ? VWT : VST) + (((size_t)(b * 3 + (c >> 6)) * 128 + (sk >> 5)) * 64 + (c & 63)) * 32 + vt_pos(sk & 31); *dst = (bf16)f2bf(v); }
        }
        __syncthreads();
    }
    {
        int lane_d = lane; OPQ_V(lane_d); const int r = lane_d & 31, h = lane_d >> 5;
        LAS bf16* HL = (LAS bf16*)lds;
        bf16* KC = (bf16*)(ws + WS_KC); bf16* VCT = (bf16*)(ws + WS_VCT);
        for (int rp2 = 0; rp2 < (((REP_MASK) >> 23) & 1 ? 2 : 1); ++rp2)
        for (int u = bid; u < 2 * NB * 3 * 8; u += G) {
            const int ten = u / 96, q = u - ten * 96, b = q / 24, q2 = q - b * 24, hh = q2 >> 3, nt = q2 & 7, n0 = 32 * nt;
            const bf16* W1T = (const bf16*)(ws + WS_W1T) + (size_t)ten * 256 * 2048 + (size_t)(32 * wave + r) * 2048 + 8 * h;
            const int tk0 = 16 * (n0 + r);
            const float* pa = P + ((size_t)b * SEQ + tk0) * INP + (ten ? PO_VC : PO_KC) + hh * 64 + 8 * h;
            const float* pep = INPTR(a, ten ? I_PEV : I_PEK) + (size_t)l * 2048 + 8 * h;
            f32x16 acc;
#pragma unroll
            for (int i = 0; i < 16; ++i) acc[i] = 0.f;
            f32x4 xa[2][8]; bf16x8 wb[2][4];
#define CMP_LOAD(sl, ll) do { const bool ok_ = tk0 + (ll) < SEQ; const float* pl_ = pa + (size_t)(ll) * INP; const float* pe_ = pep + 64 * (ll); _Pragma("unroll") for (int ds = 0; ds < 4; ++ds) { \
        xa[sl][2 * ds] = (ok_ ? *(const f32x4*)(pl_ + 16 * ds) : (f32x4){0.f, 0.f, 0.f, 0.f}) + *(const f32x4*)(pe_ + 16 * ds); xa[sl][2 * ds + 1] = (ok_ ? *(const f32x4*)(pl_ + 16 * ds + 4) : (f32x4){0.f, 0.f, 0.f, 0.f}) + *(const f32x4*)(pe_ + 16 * ds + 4); \
        wb[sl][ds] = *(const bf16x8*)(W1T + 64 * (ll) + 16 * ds); } } while (0)
            CMP_LOAD(0, 0);
#pragma unroll 1
            for (int ll = 0; ll < 32; ll += 2) {
                CMP_LOAD(1, ll + 1);
#pragma unroll
                for (int ds = 0; ds < 4; ++ds) acc = MFMA32(cvt8(xa[0][2 * ds], xa[0][2 * ds + 1]), wb[0][ds], acc);
                if (ll + 2 < 32) CMP_LOAD(0, ll + 2);
#pragma unroll
                for (int ds = 0; ds < 4; ++ds) acc = MFMA32(cvt8(xa[1][2 * ds], xa[1][2 * ds + 1]), wb[1][ds], acc);
            }
#undef CMP_LOAD
            {
#pragma unroll
                for (int i = 0; i < 16; ++i) { const float x = acc[i]; const float gl = 0.5f * x * (1.0f + ftanh(0.7978845608028654f * (x + 0.044715f * x * x * x)));
                    HL[((i & 3) + 8 * (i >> 2) + 4 * h) * HP + 32 * wave + r] = (bf16)f2bf(gl); } }
            __syncthreads();
            if (wave < 2) {
                const bf16* W2CT = (const bf16*)(ws + WS_W2CT) + (size_t)ten * 64 * 256 + (size_t)(32 * wave + r) * 256 + 8 * h;
                f32x16 o;
#pragma unroll
                for (int i = 0; i < 16; ++i) o[i] = 0.f;
                const LAS bf16* ha = HL + r * HP + 8 * h;
#pragma unroll
                for (int ks = 0; ks < 16; ++ks) o = MFMA32(lds_frag(ha + 16 * ks), *(const bf16x8*)(W2CT + 16 * ks), o);
                const int d = 32 * wave + r;
#pragma unroll
                for (int i = 0; i < 16; ++i) { const int n = n0 + (i & 3) + 8 * (i >> 2) + 4 * h; float v = o[i];
                    if (ten == 0) { const float other = dpp_f<0x128>(v);
                        if (wave == 0 && r < 16) { const f32x2 cs = rope[((16 * n + 31) & (SEQ - 1)) * 8 + (r & 7)]; v = r < 8 ? v * cs.x - other * cs.y : v * cs.x + other * cs.y; }
                        if (n < NCMP) KC[((size_t)(b * 3 + hh) * NCMPP + n) * 64 + d] = (bf16)f2bf(v); }
                    else if (n < NCMP) VCT[(((size_t)(b * 3 + hh) * 8 + (n >> 5)) * 64 + d) * 32 + vt_pos(n & 31)] = (bf16)f2bf(v); }
            }
            __syncthreads();
        }
    }
}

constexpr int SPX = 72;
__device__ __forceinline__ void phase_scan_prep(const Args& a, LAS unsigned char* lds, int gw, int NGW, int wave, int lane) {
    OPQ_SI(gw); OPQ_SI(wave); OPQ_V(lane);
    unsigned char* ws = a.ws + opaque0();
    LAS unsigned char* wl = lds + wave * 16384;
    LAS bf16* XA = (LAS bf16*)wl; LAS bf16* XR = XA + 16 * SPX; LAS bf16* XB_ = XR + 16 * SPX; LAS bf16* XK = XB_ + 16 * SPX;
    LAS float* GB = (LAS float*)(wl + 4 * 16 * SPX * 2); LAS float* GK = GB + 256; LAS float* HB = GK + 256; LAS float* HK = HB + 256; LAS float* NM = HK + 256;
    const int r = lane & 31, h = lane >> 5;
    const GAS float* vKK = (const GAS float*)(ws + WS_SV); const GAS float* vWR = (const GAS float*)(ws + WS_SV + SV_STRIDE); const GAS float* vW = (const GAS float*)(ws + WS_SV + 2 * SV_STRIDE);
    const GAS float* vKM = (const GAS float*)(ws + WS_SV + 3 * SV_STRIDE); const GAS float* vBB = (const GAS float*)(ws + WS_SV + 4 * SV_STRIDE); const GAS float* vV = (const GAS float*)(ws + WS_SV + 5 * SV_STRIDE);
#pragma unroll 1
    for (int item = gw; item < NB * 12 * 256; item += NGW) {
        const int hd = item >> 8, c = item & 255, b = hd / 12, hh = hd - b * 12;
        const size_t o0 = ((size_t)b * SEQ + 16 * c) * DRW + hh * 64 + lane;
        GAS unsigned char* rec = (GAS unsigned char*)(ws + WS_SPREC) + (size_t)item * SPREC_BYTES;
        float al[16], rh[16], be[16], ka[16], vv[16]; float g = 1.f;
#pragma unroll
        for (int t = 0; t < 16; ++t) { const size_t o = o0 + (size_t)t * DRW; const float w = vW[o], kk = vKK[o], bb = vBB[o], km = vKM[o], wr = vWR[o]; vv[t] = vV[o];
            al[t] = g * kk; rh[t] = g * wr; g *= w; const float ig = 1.0f / g; be[t] = bb * ig; ka[t] = km * ig; }
#pragma unroll
        for (int t = 0; t < 16; ++t) { XA[t * SPX + lane] = (bf16)f2bf(al[t]); XR[t * SPX + lane] = (bf16)f2bf(rh[t]); XB_[t * SPX + lane] = (bf16)f2bf(be[t]); XK[t * SPX + lane] = (bf16)f2bf(ka[t]); }
#pragma unroll
        for (int hp = 0; hp < 2; ++hp) {
            u32x4 wb, wk, wv;
            wb.x = cvtpk(be[4 * hp + 0], be[4 * hp + 1]); wb.y = cvtpk(be[4 * hp + 2], be[4 * hp + 3]); wb.z = cvtpk(be[8 + 4 * hp + 0], be[8 + 4 * hp + 1]); wb.w = cvtpk(be[8 + 4 * hp + 2], be[8 + 4 * hp + 3]);
            wk.x = cvtpk(ka[4 * hp + 0], ka[4 * hp + 1]); wk.y = cvtpk(ka[4 * hp + 2], ka[4 * hp + 3]); wk.z = cvtpk(ka[8 + 4 * hp + 0], ka[8 + 4 * hp + 1]); wk.w = cvtpk(ka[8 + 4 * hp + 2], ka[8 + 4 * hp + 3]);
            wv.x = cvtpk(vv[4 * hp + 0], vv[4 * hp + 1]); wv.y = cvtpk(vv[4 * hp + 2], vv[4 * hp + 3]); wv.z = cvtpk(vv[8 + 4 * hp + 0], vv[8 + 4 * hp + 1]); wv.w = cvtpk(vv[8 + 4 * hp + 2], vv[8 + 4 * hp + 3]);
            *(GAS u32x4*)(rec + 4096 + ((h * 2 + hp) * 32 + r) * 16) = wb; *(GAS u32x4*)(rec + 6144 + ((h * 2 + hp) * 32 + r) * 16) = wk;
            *(GAS u32x4*)(rec + 9216 + h * 3072 + 2048 + (hp * 32 + r) * 16) = wv; }
        *(GAS float*)(rec + 8704 + ((h * 2 + ((r >> 2) & 1)) * 16 + (r & 3) + 4 * (r >> 3)) * 4) = g;
        WSYNC();
        const bool lo16 = r < 16; const bf16x8 zf = {0, 0, 0, 0, 0, 0, 0, 0};
#define SP_GRAM(X1, X2, OUT, INCL) do { f32x16 D; _Pragma("unroll") for (int i = 0; i < 16; ++i) D[i] = 0.f; \
            _Pragma("unroll") for (int ks = 0; ks < 4; ++ks) { const bf16x8 fa = lo16 ? *(const LAS bf16x8*)(X1 + r * SPX + 16 * ks + 8 * h) : zf, fb = lo16 ? *(const LAS bf16x8*)(X2 + r * SPX + 16 * ks + 8 * h) : zf; D = MFMA32(fa, fb, D); } \
            if (lo16) { _Pragma("unroll") for (int i = 0; i < 8; ++i) { const int t = (i & 3) + 8 * (i >> 2) + 4 * h; OUT[t * 16 + r] = (INCL ? r <= t : r < t) ? D[i] : 0.f; } } } while (0)
        SP_GRAM(XA, XB_, GB, false); SP_GRAM(XA, XK, GK, false); SP_GRAM(XR, XB_, HB, true); SP_GRAM(XR, XK, HK, true);
#undef SP_GRAM
        WSYNC();
        { const int cc = lane & 15; float n[16];
#pragma unroll
            for (int t = 0; t < 16; ++t) { float acc = t == cc ? 1.f : 0.f;
#pragma unroll
                for (int s2 = 0; s2 < t; ++s2) acc -= GB[t * 16 + s2] * n[s2];
                n[t] = acc; }
            if (lane < 16) {
#pragma unroll
                for (int t = 0; t < 16; ++t) NM[t * 16 + cc] = n[t]; } }
        if (lo16) { u32x4 w_; const LAS float* hr = HB + r * 16 + 4 * h;
            w_.x = cvtpk(hr[0], hr[1]); w_.y = cvtpk(hr[2], hr[3]); w_.z = cvtpk(hr[8], hr[9]); w_.w = cvtpk(hr[10], hr[11]); *(GAS u32x4*)(rec + 8192 + (h * 16 + r) * 16) = w_; }
        WSYNC();
        { float ap[16];
#pragma unroll
            for (int t = 0; t < 16; ++t) { float acc = 0.f;
#pragma unroll
                for (int s2 = 0; s2 <= t; ++s2) acc = fmaf(NM[t * 16 + s2], al[s2], acc);
                ap[t] = acc; }
#pragma unroll
            for (int t = 0; t < 16; ++t) XA[t * SPX + lane] = (bf16)f2bf(ap[t]); }
        WSYNC();
        if (lo16) {
#pragma unroll
            for (int ks = 0; ks < 4; ++ks) { const LAS bf16* pa = XA + r * SPX + 16 * ks + 4 * h; const LAS bf16* pr = XR + r * SPX + 16 * ks + 4 * h;
                const u32x2 a0 = *(const LAS u32x2*)pa, a1 = *(const LAS u32x2*)(pa + 8), r0 = *(const LAS u32x2*)pr, r1 = *(const LAS u32x2*)(pr + 8);
                *(GAS u32x4*)(rec + ((ks * 2 + h) * 16 + r) * 16) = (u32x4){a0.x, a0.y, a1.x, a1.y}; *(GAS u32x4*)(rec + 2048 + ((ks * 2 + h) * 16 + r) * 16) = (u32x4){r0.x, r0.y, r1.x, r1.y}; } }
        { float wq[16], p1[16], yk[16];
#pragma unroll
            for (int t = 0; t < 16; ++t) { float acc = 0.f, acy = 0.f;
#pragma unroll
                for (int s2 = 0; s2 <= t; ++s2) { if (s2 < t) acc = fmaf(GK[t * 16 + s2], vv[s2], acc); acy = fmaf(HK[t * 16 + s2], vv[s2], acy); }
                wq[t] = acc; yk[t] = acy; }
#pragma unroll
            for (int t = 0; t < 16; ++t) { float acc = 0.f;
#pragma unroll
                for (int s2 = 0; s2 <= t; ++s2) acc = fmaf(NM[t * 16 + s2], wq[s2], acc);
                p1[t] = acc; }
            GAS unsigned char* rv = rec + 9216 + h * 3072;
#pragma unroll
            for (int hq = 0; hq < 2; ++hq) { u32x4 wp, wy;
                wp.x = cvtpk(p1[4 * hq + 0], p1[4 * hq + 1]); wp.y = cvtpk(p1[4 * hq + 2], p1[4 * hq + 3]); wp.z = cvtpk(p1[8 + 4 * hq + 0], p1[8 + 4 * hq + 1]); wp.w = cvtpk(p1[8 + 4 * hq + 2], p1[8 + 4 * hq + 3]);
                wy.x = cvtpk(yk[4 * hq + 0], yk[4 * hq + 1]); wy.y = cvtpk(yk[4 * hq + 2], yk[4 * hq + 3]); wy.z = cvtpk(yk[8 + 4 * hq + 0], yk[8 + 4 * hq + 1]); wy.w = cvtpk(yk[8 + 4 * hq + 2], yk[8 + 4 * hq + 3]);
                *(GAS u32x4*)(rv + (hq * 32 + r) * 16) = wp; *(GAS u32x4*)(rv + 1024 + (hq * 32 + r) * 16) = wy; } }
        WSYNC();
    }
}
__device__ __forceinline__ void scan_seq(const Args& a, LAS unsigned char* lds, int grp, int lane) {
    OPQ_SI(grp); OPQ_V(lane);
    __builtin_amdgcn_s_setprio(3);
    unsigned char* ws = a.ws + opaque0();
    const int hd = grp % 48, vt = grp / 48, b = hd / 12, hh = hd - b * 12;
    const int r = lane & 31, h = lane >> 5; const bool lo16 = r < 16;
    LAS unsigned char* RS = lds + 16384;
    const GAS unsigned char* recs = (const GAS unsigned char*)(ws + WS_SPREC) + (size_t)hd * 256 * SPREC_BYTES;
    GAS float* yp = (GAS float*)(ws + WS_YS) + (size_t)b * SEQ * DRW + hh * 64 + 32 * vt + r;
    const bf16x8 zf = {0, 0, 0, 0, 0, 0, 0, 0};
    f32x16 T0, T1;
#pragma unroll
    for (int i = 0; i < 16; ++i) { T0[i] = 0.f; T1[i] = 0.f; }
#define SQ_DMA(slot, ck) do { const GAS unsigned char* rp_ = recs + (size_t)(ck) * SPREC_BYTES + lane * 16; LAS unsigned char* ls_ = RS + (slot) * 12288; \
        _Pragma("unroll") for (int q = 0; q < 9; ++q) __builtin_amdgcn_global_load_lds((const unsigned*)(rp_ + 1024 * q), (LAS unsigned*)(ls_ + 1024 * q), 16, 0, 0); \
        _Pragma("unroll") for (int q = 0; q < 3; ++q) __builtin_amdgcn_global_load_lds((const unsigned*)(rp_ + 9216 + 3072 * vt + 1024 * q), (LAS unsigned*)(ls_ + 9216 + 1024 * q), 16, 0, 0); } while (0)
    SQ_DMA(0, 0); SQ_DMA(1, 1);
#pragma unroll 1
    for (int ck = 0; ck < 256; ++ck) {
        const LAS unsigned char* L = RS + (ck & 1) * 12288;
        if (ck == 0) asm volatile("s_waitcnt vmcnt(12)" ::: "memory"); else if (ck + 1 < 256) asm volatile("s_waitcnt vmcnt(20)" ::: "memory"); else asm volatile("s_waitcnt vmcnt(0)" ::: "memory");
        bf16x8 tb[4];
#pragma unroll
        for (int s2 = 0; s2 < 2; ++s2) { u32x4 w0, w1;
            w0.x = cvtpk(T0[8 * s2], T0[8 * s2 + 1]); w0.y = cvtpk(T0[8 * s2 + 2], T0[8 * s2 + 3]); w0.z = cvtpk(T0[8 * s2 + 4], T0[8 * s2 + 5]); w0.w = cvtpk(T0[8 * s2 + 6], T0[8 * s2 + 7]);
            w1.x = cvtpk(T1[8 * s2], T1[8 * s2 + 1]); w1.y = cvtpk(T1[8 * s2 + 2], T1[8 * s2 + 3]); w1.z = cvtpk(T1[8 * s2 + 4], T1[8 * s2 + 5]); w1.w = cvtpk(T1[8 * s2 + 6], T1[8 * s2 + 7]);
            tb[s2] = __builtin_bit_cast(bf16x8, w0); tb[2 + s2] = __builtin_bit_cast(bf16x8, w1); }
        f32x16 aU, aY;
#pragma unroll
        for (int i = 0; i < 16; ++i) { aU[i] = 0.f; aY[i] = 0.f; }
        { const u32x4 yk = *(const LAS u32x4*)(L + 9216 + 1024 + lane * 16);
            aY[0] = __builtin_bit_cast(float, yk.x << 16); aY[1] = __builtin_bit_cast(float, yk.x & 0xffff0000u); aY[2] = __builtin_bit_cast(float, yk.y << 16); aY[3] = __builtin_bit_cast(float, yk.y & 0xffff0000u);
            aY[4] = __builtin_bit_cast(float, yk.z << 16); aY[5] = __builtin_bit_cast(float, yk.z & 0xffff0000u); aY[6] = __builtin_bit_cast(float, yk.w << 16); aY[7] = __builtin_bit_cast(float, yk.w & 0xffff0000u); }
#pragma unroll
        for (int ks = 0; ks < 4; ++ks) { const bf16x8 fa = lo16 ? *(const LAS bf16x8*)(L + ((ks * 2 + h) * 16 + r) * 16) : zf, fr = lo16 ? *(const LAS bf16x8*)(L + 2048 + ((ks * 2 + h) * 16 + r) * 16) : zf;
            aU = MFMA32(fa, tb[ks], aU); aY = MFMA32(fr, tb[ks], aY); }
        bf16x8 ub;
        { const u32x4 p1 = *(const LAS u32x4*)(L + 9216 + lane * 16); float u[8];
            u[0] = -aU[0] - __builtin_bit_cast(float, p1.x << 16); u[1] = -aU[1] - __builtin_bit_cast(float, p1.x & 0xffff0000u); u[2] = -aU[2] - __builtin_bit_cast(float, p1.y << 16); u[3] = -aU[3] - __builtin_bit_cast(float, p1.y & 0xffff0000u);
            u[4] = -aU[4] - __builtin_bit_cast(float, p1.z << 16); u[5] = -aU[5] - __builtin_bit_cast(float, p1.z & 0xffff0000u); u[6] = -aU[6] - __builtin_bit_cast(float, p1.w << 16); u[7] = -aU[7] - __builtin_bit_cast(float, p1.w & 0xffff0000u);
            u32x4 w_; w_.x = cvtpk(u[0], u[1]); w_.y = cvtpk(u[2], u[3]); w_.z = cvtpk(u[4], u[5]); w_.w = cvtpk(u[6], u[7]); ub = __builtin_bit_cast(bf16x8, w_); }
        { const bf16x8 fh = lo16 ? *(const LAS bf16x8*)(L + 8192 + (h * 16 + r) * 16) : zf; aY = MFMA32(fh, ub, aY); }
        { const bf16x8 fv = *(const LAS bf16x8*)(L + 9216 + 2048 + lane * 16);
            const bf16x8 b0 = *(const LAS bf16x8*)(L + 4096 + lane * 16), b1 = *(const LAS bf16x8*)(L + 4096 + 1024 + lane * 16), k0 = *(const LAS bf16x8*)(L + 6144 + lane * 16), k1 = *(const LAS bf16x8*)(L + 6144 + 1024 + lane * 16);
            T0 = MFMA32(b0, ub, T0); T1 = MFMA32(b1, ub, T1); T0 = MFMA32(k0, fv, T0); T1 = MFMA32(k1, fv, T1);
#pragma unroll
            for (int q = 0; q < 4; ++q) { const f32x4 g0 = *(const LAS f32x4*)(L + 8704 + (h * 16 + 4 * q) * 4), g1 = *(const LAS f32x4*)(L + 8704 + ((2 + h) * 16 + 4 * q) * 4);
                T0[4 * q] *= g0.x; T0[4 * q + 1] *= g0.y; T0[4 * q + 2] *= g0.z; T0[4 * q + 3] *= g0.w; T1[4 * q] *= g1.x; T1[4 * q + 1] *= g1.y; T1[4 * q + 2] *= g1.z; T1[4 * q + 3] *= g1.w; } }
#pragma unroll
        for (int i = 0; i < 8; ++i) yp[((size_t)ck * 16 + (i & 3) + 8 * (i >> 2) + 4 * h) * DRW] = aY[i];
        asm volatile("s_waitcnt lgkmcnt(0)" ::: "memory");
        if (ck + 2 < 256) SQ_DMA(ck & 1, ck + 2);
    }
#undef SQ_DMA
    asm volatile("s_waitcnt vmcnt(0)" ::: "memory");
    __builtin_amdgcn_s_setprio(0);
}

template <bool WITH_V> __device__ __forceinline__ void dma_tile(LAS unsigned char* RW, const bf16* Kb, int key0, unsigned koff, const bf16* Vt, unsigned voff) {
    const char* kp = (const char*)(Kb + (size_t)key0 * 64) + koff;
#pragma unroll
    for (int q = 0; q < 4; ++q) __builtin_amdgcn_global_load_lds((const unsigned*)(kp + 1024 * q), (LAS unsigned*)(RW + q * 1024), 16, 0, 0);
    if (WITH_V) { const char* vp = (const char*)(Vt + (size_t)(key0 >> 5) * 2048) + voff;
#pragma unroll
        for (int q = 0; q < 4; ++q) __builtin_amdgcn_global_load_lds((const unsigned*)(vp + 1024 * q), (LAS unsigned*)(RW + (4 + q) * 1024), 16, 0, 0); }
}
template <bool WITH_V> __device__ __forceinline__ void read_tile(const LAS unsigned char* RW, unsigned krd, unsigned vrd, bf16x8 (&kf)[4], bf16x8 (&vf)[2][2], bool younger) {
    if (younger) { if (WITH_V) asm volatile("s_waitcnt vmcnt(8)" ::: "memory"); else asm volatile("s_waitcnt vmcnt(4)" ::: "memory"); } else asm volatile("s_waitcnt vmcnt(0)" ::: "memory");
    const int rk = (krd >> 7) & 7, hh = krd & 1;
#pragma unroll
    for (int ks = 0; ks < 4; ++ks) kf[ks] = *(const LAS bf16x8*)(RW + (krd & ~1u) + (((2 * ks + hh) ^ rk) << 4));
    if (WITH_V) {
#pragma unroll
        for (int q = 0; q < 4; ++q) { const int dt = q >> 1, s = q & 1; const unsigned row = (vrd >> 6) + 32 * dt; vf[dt][s] = *(const LAS bf16x8*)(RW + 4096 + row * 64 + ((((2 * hh + s)) ^ ((row >> 2) & 3)) << 4)); } }
    asm volatile("s_waitcnt lgkmcnt(0)" ::: "memory");
}
__device__ __forceinline__ f32x16 qk_tile(const bf16x8 (&kf)[4], const bf16x8 (&qf)[4]) {
    f32x16 S;
#pragma unroll
    for (int i = 0; i < 16; ++i) S[i] = 0.f;
#pragma unroll
    for (int ks = 0; ks < 4; ++ks) S = MFMA32(kf[ks], qf[ks], S);
    return S;
}
__device__ __forceinline__ void pv_tile(const float (&p)[16], const bf16x8 (&vf)[2][2], f32x16 (&O)[2]) {
#pragma unroll
    for (int s = 0; s < 2; ++s) { u32x4 w; w.x = cvtpk(p[8 * s], p[8 * s + 1]); w.y = cvtpk(p[8 * s + 2], p[8 * s + 3]); w.z = cvtpk(p[8 * s + 4], p[8 * s + 5]); w.w = cvtpk(p[8 * s + 6], p[8 * s + 7]);
        const bf16x8 pf = __builtin_bit_cast(bf16x8, w);
#pragma unroll
        for (int dt = 0; dt < 2; ++dt) O[dt] = MFMA32(vf[dt][s], pf, O[dt]); }
}
__device__ __forceinline__ void att_rest(f32x16& S, const bf16x8 (&vf)[2][2], int key0, int h, bool masked, int klo, int khi, bool colsel, float& m, float& l, f32x16 (&O)[2]) {
    if (masked) { const int kb = key0 + 4 * h;
#pragma unroll
        for (int i = 0; i < 16; ++i) { const int key = kb + (i & 3) + 8 * (i >> 2); S[i] = (key <= khi && key >= klo) ? S[i] : -INFINITY; } }
    float tmax = fmaxf(fmaxf(fmaxf(S[0], S[1]), fmaxf(S[2], S[3])), fmaxf(fmaxf(S[4], S[5]), fmaxf(S[6], S[7])));
    tmax = fmaxf(tmax, fmaxf(fmaxf(fmaxf(S[8], S[9]), fmaxf(S[10], S[11])), fmaxf(fmaxf(S[12], S[13]), fmaxf(S[14], S[15]))));
    tmax = half_max(tmax); tmax = colsel ? tmax : -INFINITY;
    if (__builtin_amdgcn_ballot_w64(tmax > m + 8.0f) != 0ull) {
        const float mn = fmaxf(m, tmax); const float ms = mn == -INFINITY ? 0.f : mn; const float alpha = __builtin_amdgcn_exp2f(m - ms);
        l *= alpha; m = mn;
#pragma unroll
        for (int dt = 0; dt < 2; ++dt)
#pragma unroll
            for (int i = 0; i < 16; ++i) O[dt][i] *= alpha;
    }
    float msx = m == -INFINITY ? 0.f : m; msx = colsel ? msx : INFINITY;
    float p[16]; float ps = 0.f;
#pragma unroll
    for (int i = 0; i < 16; ++i) { p[i] = __builtin_amdgcn_exp2f(S[i] - msx); ps += p[i]; }
    l += half_sum(ps);
    pv_tile(p, vf, O);
}
constexpr int NSA_RING0 = 16384;
static_assert(NSA_RING0 + 8 * 16384 <= LDS_SCRATCH, "attention LDS map");
__device__ __forceinline__ void phase_nsa(const Args& a, int qi, int l, LAS unsigned char* lds, int slot, int lane) {
    OPQ_SI(slot); OPQ_V(lane);
    unsigned char* ws = a.ws + opaque0();
    LAS float* impl = (LAS float*)(lds + slot * 2048);
    LAS unsigned char* RW = lds + NSA_RING0 + slot * 16384;
    const bf16* QR = (const bf16*)(ws + WS_QR); const float* P = (const float*)(ws + WS_P); const float* gate_b = INPTR(a, I_GB) + (size_t)l * 36; bf16* CAT = (bf16*)(ws + WS_CAT);
    unsigned* qctr = (unsigned*)(ws + WS_CTL) + 8192 + 64 * qi;
    const int r = lane & 31, h = lane >> 5, g = r & 3, ql = r >> 2;
    const unsigned koff = (unsigned)((lane >> 3) * 128 + (((lane & 7) ^ ((lane >> 3) & 7)) << 4)), voff = (unsigned)((lane >> 2) * 64 + (((lane & 3) ^ (((lane >> 2) >> 2) & 3)) << 4));
    const unsigned krd = (unsigned)(r * 128) | (unsigned)h, vrd = (unsigned)(r * 64);
    const int myx = (int)(xb_xcc_id() & 7u); int qsel = 0;
    for (;;) {
        int item = 0, qx = 0;
        for (;;) { qx = (myx + qsel) & 7; if (lane == 0) item = (int)atomicAdd(qctr + 8 * qx, 1u); item = __builtin_amdgcn_readfirstlane(item); if (item < 96 * 8 || qsel >= 7) break; ++qsel; }
        if (item >= 96 * 8) break;
        const int up = item >> 3, wave = item & 7, k3 = up / 3, e3 = up - 3 * k3;
        const int bk = e3 < 2 ? qx : 8 + (qx >> 1); const int qt = e3 == 0 ? 63 - 2 * k3 : (e3 == 1 ? 62 - 2 * k3 : 62 - 2 * k3 + (qx & 1));
        const int b = bk / 3, kvh = bk - b * 3;
        const int tile0 = qt * 64, cur = qt; const int qp = tile0 + 8 * wave + ql; const size_t mq = (size_t)b * SEQ + qp; const int head = kvh * 4 + g;
        bf16x8 qf[4];
#pragma unroll
        for (int ks = 0; ks < 4; ++ks) qf[ks] = *(const bf16x8*)(QR + mq * 768 + head * 64 + 16 * ks + 8 * h);
        float g0, g1, g2;
        { const float* gl = P + mq * INP + PO_GL + head * 3; const float* gb = gate_b + head * 3; g0 = sigmoidf_(gl[0] + gb[0]); g1 = sigmoidf_(gl[1] + gb[1]); g2 = sigmoidf_(gl[2] + gb[2]); }
        f32x16 out[2], O[2]; bf16x8 kf[4]; bf16x8 vf[2][2];
#pragma unroll
        for (int dt = 0; dt < 2; ++dt)
#pragma unroll
            for (int i = 0; i < 16; ++i) out[dt][i] = 0.f;
        unsigned long long mymask = (2ull << cur) - 1ull, umask = mymask;
        const int qpw = tile0 + 8 * wave + 7;
        {
            const bf16* Kb = (const bf16*)(ws + WS_KC) + (size_t)(b * 3 + kvh) * NCMPP * 64; const bf16* Vt = (const bf16*)(ws + WS_VCT) + (size_t)(b * 3 + kvh) * 8 * 2048;
            const int nvw = qpw >= 31 ? ((qpw - 31) >> 4) + 1 : 0; const int nvq = qp >= 31 ? ((qp - 31) >> 4) + 1 : 0; const int ntile = (nvw + 31) >> 5;
            const bool need_imp = cur >= 16;
            if (ntile > 0) {
                float m = -INFINITY, ls = 0.f;
                dma_tile<false>(RW, Kb, 0, koff, Vt, voff);
#pragma unroll 1
                for (int kt = 0; kt < ntile; ++kt) { read_tile<false>(RW, krd, vrd, kf, vf, false); if (kt + 1 < ntile) dma_tile<false>(RW, Kb, 32 * (kt + 1), koff, Vt, voff); else dma_tile<true>(RW, Kb, 0, koff, Vt, voff);
                    const f32x16 S = qk_tile(kf, qf);
                    float tmax = -INFINITY; float sv[16];
#pragma unroll
                    for (int i = 0; i < 16; ++i) { const int n = 32 * kt + (i & 3) + 8 * (i >> 2) + 4 * h; sv[i] = n < nvq ? S[i] : -INFINITY; tmax = fmaxf(tmax, sv[i]); }
                    tmax = half_max(tmax); const float mn = fmaxf(m, tmax); const float ms = mn == -INFINITY ? 0.f : mn; float ps = 0.f;
#pragma unroll
                    for (int i = 0; i < 16; ++i) ps += __builtin_amdgcn_exp2f(sv[i] - ms);
                    ls = ls * __builtin_amdgcn_exp2f(m - ms) + half_sum(ps); m = mn; }
                const float ms = m == -INFINITY ? 0.f : m; const float inv = 1.0f / fmaxf(ls, 1.17549435e-38f);
                float carry = 0.f;
#pragma unroll
                for (int dt = 0; dt < 2; ++dt)
#pragma unroll
                    for (int i = 0; i < 16; ++i) O[dt][i] = 0.f;
                if (need_imp) {
#pragma unroll
                    for (int i = 0; i < 8; ++i) impl[i * 64 + lane] = 0.f;
                    WSYNC(); }
#pragma unroll 1
                for (int kt = 0; kt < ntile; ++kt) {
                    read_tile<true>(RW, krd, vrd, kf, vf, false); if (kt + 1 < ntile) dma_tile<true>(RW, Kb, 32 * (kt + 1), koff, Vt, voff);
                    const f32x16 S = qk_tile(kf, qf);
                    float p[16];
#pragma unroll
                    for (int i = 0; i < 16; ++i) { const int n = 32 * kt + (i & 3) + 8 * (i >> 2) + 4 * h; p[i] = n < nvq ? __builtin_amdgcn_exp2f(S[i] - ms) * inv : 0.f; }
                    if (need_imp) {
                        float val[4];
#pragma unroll
                        for (int t = 0; t < 4; ++t) { const float sp = 0.5f * p[4 * t + 3]; const float base = (p[4 * t] + p[4 * t + 1]) + (p[4 * t + 2] + sp); const float rv = other_half(sp, h);
                            val[t] = base + (h ? rv : carry); carry = h ? 0.f : rv; }
#pragma unroll
                        for (int t = 0; t < 4; ++t) { float v = val[t]; v += dpp_f<0xB1>(v); v += dpp_f<0x4E>(v); if (g == 0) impl[ql * 64 + 8 * kt + 2 * t + h] = v; }
                    }
                    pv_tile(p, vf, O);
                }
#pragma unroll
                for (int dt = 0; dt < 2; ++dt)
#pragma unroll
                    for (int i = 0; i < 16; ++i) out[dt][i] = O[dt][i] * g0;
                if (need_imp) {
                    WSYNC();
#pragma unroll 1
                    for (int q = 0; q < 8; ++q) { const float v = impl[q * 64 + lane]; const bool forced = lane == 0 || lane == cur || lane == cur - 1; impl[q * 64 + lane] = lane > cur ? -INFINITY : (forced ? 1e9f : v); }
                    WSYNC();
                    umask = 0ull;
#pragma unroll 1
                    for (int q = 0; q < 8; ++q) { const float sc = impl[q * 64 + lane]; int rank = 0;
#pragma unroll 4
                        for (int i4 = 0; i4 < 16; ++i4) { const f32x4 o = *(const LAS f32x4*)(impl + q * 64 + 4 * i4);
                            rank += (o.x > sc || (o.x == sc && 4 * i4 + 0 < lane)) ? 1 : 0; rank += (o.y > sc || (o.y == sc && 4 * i4 + 1 < lane)) ? 1 : 0;
                            rank += (o.z > sc || (o.z == sc && 4 * i4 + 2 < lane)) ? 1 : 0; rank += (o.w > sc || (o.w == sc && 4 * i4 + 3 < lane)) ? 1 : 0; }
                        const unsigned long long mk = __ballot(lane <= cur && rank < 16);
                        umask |= mk; if (ql == q) mymask = mk; }
                    WSYNC();
                }
            }
        }
        {
            const bf16* Kb = (const bf16*)(ws + WS_KS) + (size_t)(b * 3 + kvh) * SEQ * 64; const bf16* Vt = (const bf16*)(ws + WS_VST) + (size_t)(b * 3 + kvh) * 128 * 2048;
            float m = -INFINITY, ls = 0.f;
#pragma unroll
            for (int dt = 0; dt < 2; ++dt)
#pragma unroll
                for (int i = 0; i < 16; ++i) O[dt][i] = 0.f;
            unsigned long long um = umask; int hf = 0;
#define SEL_NEXT(have, jb, key0) do { have = um != 0ull; if (have) { jb = __builtin_ctzll(um); key0 = 64 * jb + 32 * hf; if (hf == 0 && 64 * jb + 32 <= qpw) hf = 1; else { hf = 0; um &= um - 1ull; } } } while (0)
            bool h0, h1; int j0 = 0, k0 = 0, j1 = 0, k1 = 0, sl = 0;
            SEL_NEXT(h0, j0, k0); if (h0) dma_tile<true>(RW, Kb, k0, koff, Vt, voff);
            SEL_NEXT(h1, j1, k1); if (h1) dma_tile<true>(RW + 8192, Kb, k1, koff, Vt, voff);
#pragma unroll 1
            while (h0) {
                read_tile<true>(RW + sl * 8192, krd, vrd, kf, vf, h1);
                bool h2; int j2 = 0, k2 = 0; SEL_NEXT(h2, j2, k2); if (h2) dma_tile<true>(RW + sl * 8192, Kb, k2, koff, Vt, voff);
                f32x16 S = qk_tile(kf, qf);
                att_rest(S, vf, k0, h, j0 == cur, -0x7fffffff, qp, (mymask >> j0) & 1ull, m, ls, O);
                h0 = h1; j0 = j1; k0 = k1; h1 = h2; j1 = j2; k1 = k2; sl ^= 1;
            }
#undef SEL_NEXT
            const float sc = g1 / fmaxf(ls, 1.17549435e-38f);
#pragma unroll
            for (int dt = 0; dt < 2; ++dt)
#pragma unroll
                for (int i = 0; i < 16; ++i) out[dt][i] += O[dt][i] * sc;
        }
        {
            const bf16* Kb = (const bf16*)(ws + WS_KW) + (size_t)(b * 3 + kvh) * SEQ * 64; const bf16* Vt = (const bf16*)(ws + WS_VWT) + (size_t)(b * 3 + kvh) * 128 * 2048;
            float m = -INFINITY, ls = 0.f;
#pragma unroll
            for (int dt = 0; dt < 2; ++dt)
#pragma unroll
                for (int i = 0; i < 16; ++i) O[dt][i] = 0.f;
            const int q0w = tile0 + 8 * wave; const int lo = q0w - 511 > 0 ? q0w - 511 : 0;
            const int tEnd = (q0w + 7) >> 5; int t = lo >> 5;
            dma_tile<true>(RW, Kb, 32 * t, koff, Vt, voff); if (t + 1 <= tEnd) dma_tile<true>(RW + 8192, Kb, 32 * (t + 1), koff, Vt, voff);
            int sl = 0;
#pragma unroll 1
            for (; t <= tEnd; ++t) {
                read_tile<true>(RW + sl * 8192, krd, vrd, kf, vf, t + 1 <= tEnd);
                if (t + 2 <= tEnd) dma_tile<true>(RW + sl * 8192, Kb, 32 * (t + 2), koff, Vt, voff);
                f32x16 S = qk_tile(kf, qf);
                att_rest(S, vf, 32 * t, h, !(32 * t >= q0w + 7 - 511 && 32 * t + 31 <= q0w), qp - 511, qp, true, m, ls, O);
                sl ^= 1;
            }
            const float sc = g2 / fmaxf(ls, 1.17549435e-38f);
            bf16* op = CAT + mq * DM + DRW + DPOOL + head * 64 + 4 * h;
#pragma unroll
            for (int dt = 0; dt < 2; ++dt)
#pragma unroll
                for (int t2 = 0; t2 < 4; ++t2) { u32x2 w; w.x = cvtpk(out[dt][4 * t2] + O[dt][4 * t2] * sc, out[dt][4 * t2 + 1] + O[dt][4 * t2 + 1] * sc); w.y = cvtpk(out[dt][4 * t2 + 2] + O[dt][4 * t2 + 2] * sc, out[dt][4 * t2 + 3] + O[dt][4 * t2 + 3] * sc);
                    *(u32x2*)(op + 32 * dt + 8 * t2) = w; }
        }
    }
}

__device__ __forceinline__ void phase_rwkv_out(const Args& a, int l, int gw, int NGW, int lane) {
    OPQ_SI(gw); OPQ_V(lane);
    unsigned char* ws = a.ws + opaque0(); const float* YS = (const float*)(ws + WS_YS); const float* vV = (const float*)(ws + WS_SV + 5 * SV_STRIDE); const float* vG = (const float*)(ws + WS_G); const float* SC = (const float*)(ws + WS_SC);
    const float* gng = INPTR(a, I_GNG) + (size_t)l * DRW; const float* gnb = INPTR(a, I_GNB) + (size_t)l * DRW; bf16* CAT = (bf16*)(ws + WS_CAT);
    for (int id0 = gw * 4; id0 < MTOK * 12; id0 += NGW * 4) {
        float y[4], vv[4], gg[4], bc[4]; int cc[4], mm[4]; size_t oo[4];
#pragma unroll
        for (int e = 0; e < 4; ++e) { const int id = id0 + e, m = id / 12, h = id - m * 12; cc[e] = h * 64 + lane; mm[e] = m; oo[e] = (size_t)m * DRW + cc[e]; y[e] = YS[oo[e]]; vv[e] = vV[oo[e]]; gg[e] = vG[oo[e]]; bc[e] = SC[((size_t)m * 12 + h) * 4 + 2]; }
#pragma unroll
        for (int e = 0; e < 4; ++e) { const float mean = wave_sum(y[e]) * (1.f / 64.f); const float d = y[e] - mean; const float var = wave_sum(d * d) * (1.f / 64.f);
            const float yn = d * (1.f / sqrtf(var + GN_EPS)) * gng[cc[e]] + gnb[cc[e]];
            CAT[(size_t)mm[e] * DM + cc[e]] = (bf16)f2bf((yn + bc[e] * vv[e]) * gg[e]); } }
}

template <int PHMASK> __global__ void __launch_bounds__(NTHR, 2) fwd(Args args) {
    extern __shared__ __attribute__((aligned(16))) unsigned char lds_raw[];
    LAS unsigned char* lds = (LAS unsigned char*)lds_raw;
    const int tid = threadIdx.x, lane = tid & 63, wave = __builtin_amdgcn_readfirstlane(tid >> 6);
    const int G = gridDim.x, bid = blockIdx.x; const int gw = bid * NWAVES + wave, NGW = G * NWAVES;
    unsigned char* ws = args.ws;
    for (int u = tid; u < (LDS_BYTES - LDS_SCRATCH) / 4; u += NTHR) ((LAS unsigned*)(lds + LDS_SCRATCH))[u] = 0u;
    __syncthreads();
    const int lo = args.ph_lo, hi = args.ph_hi;
    XcdBarrier bar; bar.bar = (unsigned*)(ws + WS_CTL) + 4096; bar.x = 0; bar.st = nullptr;
    if (hi - lo > 1) bar = xcd_barrier_post((unsigned*)(ws + WS_CTL) + 4096, (volatile LAS unsigned*)(lds + MISC_OFF) + 8);
#define IN(k) (lo <= (k) && (k) < hi)
#define PHEN(j) (((PHMASK) >> (j)) & 1)

#define SEAM(k) do { if ((k) + 1 < hi) xcd_barrier(bar); } while (0)
    bf16* XB = (bf16*)(ws + WS_XB); bf16* Hb = (bf16*)(ws + WS_H); float* Y = (float*)(ws + WS_YR); const float* AUX = (const float*)(ws + WS_AUX); float* Pm = (float*)(ws + WS_P); bf16* CAT = (bf16*)(ws + WS_CAT);

    if (PHEN(0) && IN(0)) { phase_prologue(args, bid * NTHR + tid, G * NTHR); SEAM(0); }
    for (int l = 0; l < NLAYER; ++l) {
        const int pb = 1 + 14 * l;
        for (int rep = 0; rep < (((REP_MASK) >> 1) & 1 ? 2 : 1); ++rep) if (PHEN(1) && IN(pb + 0)) { phase_wconv(args, l, lds, gw, NGW, wave, lane); SEAM(pb + 0); }
        for (int rep = 0; rep < (((REP_MASK) >> 2) & 1 ? 2 : 1); ++rep) if (PHEN(2) && IN(pb + 1)) {
            pg8::Gemm g{XB, (const bf16*)(ws + WS_WUP1), MTOK, NUP, DM}; pg8::StaticOrder S; S.init(MTOK, NUP, G, bid); pg8::EpiSwiGLU E{Hb, DFF, AUX, 3 * l - 1, l * 2 * GWN};
            pg8::gemm_phase<pg8::EpiSwiGLU, pg8::StaticOrder, true, true>(lds, g, S, E); SEAM(pb + 1); }
        for (int rep = 0; rep < (((REP_MASK) >> 3) & 1 ? 2 : 1); ++rep) if (PHEN(3) && IN(pb + 2)) {
            pg8::Gemm g{Hb, (const bf16*)(ws + WS_WDN1), MTOK, DM, DFF}; pg8::StaticOrder S; S.init(MTOK, DM, G, bid); pg8::EpiResid E{l == 0 ? INPTR(args, I_X) : Y, Y, XB, DM, ALPHA, 0.5f, 3 * l - 1, 3 * l};
            pg8::gemm_phase<pg8::EpiResid, pg8::StaticOrder, true, true>(lds, g, S, E); SEAM(pb + 2); }
        for (int rep = 0; rep < (((REP_MASK) >> 4) & 1 ? 2 : 1); ++rep) if (false && PHEN(4) && IN(pb + 3)) { phase_ln(Y, INPTR(args, I_LN1G) + (size_t)l * DM, INPTR(args, I_LN1B) + (size_t)l * DM, nullptr, XB, (float*)AUX, gw, NGW, lane); SEAM(pb + 3); }
        for (int rep = 0; rep < (((REP_MASK) >> 5) & 1 ? 2 : 1); ++rep) if (PHEN(5) && IN(pb + 4)) {
            pg8::Gemm g{XB, (const bf16*)(ws + WS_WIN), MTOK, INP, DM}; pg8::StaticOrder S; S.init(MTOK, INP, G, bid); pg8::EpiF32 E{Pm, INP, AUX, 3 * l, l * 2 * GWN + NUP};
            pg8::gemm_phase<pg8::EpiF32, pg8::StaticOrder, true, true>(lds, g, S, E); SEAM(pb + 4); }
        for (int rep = 0; rep < (((REP_MASK) >> 6) & 1 ? 2 : 1); ++rep) if (PHEN(6) && IN(pb + 5)) { phase_m1(args, l, lds, bid, G, tid, wave, lane); SEAM(pb + 5); }
        for (int rep = 0; rep < (((REP_MASK) >> 7) & 1 ? 2 : 1); ++rep) if (PHEN(7) && IN(pb + 6)) { phase_scan_prep(args, lds, gw, NGW, wave, lane); SEAM(pb + 6); }
        for (int rep = 0; rep < (((REP_MASK) >> 8) & 1 ? 2 : 1); ++rep) if (PHEN(8) && IN(pb + 7)) { for (int r2 = 0; r2 < (((REP_MASK) >> 20) & 1 ? 2 : 1); ++r2) { if (bid < 96 && wave == 0) scan_seq(args, lds, bid, lane); } for (int r3 = 0; r3 < (((REP_MASK) >> 21) & 1 ? 2 : 1); ++r3) if (!(bid < 96 && wave == 1)) phase_nsa(args, l + 4 * rep + 8 * r3, l, lds, wave, lane); SEAM(pb + 7); }
        for (int rep = 0; rep < (((REP_MASK) >> 9) & 1 ? 2 : 1); ++rep) if (PHEN(9) && IN(pb + 8)) { phase_rwkv_out(args, l, gw, NGW, lane); SEAM(pb + 8); }
        for (int rep = 0; rep < (((REP_MASK) >> 10) & 1 ? 2 : 1); ++rep) if (PHEN(10) && IN(pb + 9)) {
            pg8::Gemm g{CAT, (const bf16*)(ws + WS_WOUT), MTOK, DM, DM}; pg8::StaticOrder S; S.init(MTOK, DM, G, bid); pg8::EpiResid E{Y, Y, XB, DM, ALPHA, 1.0f, 3 * l, 3 * l + 1};
            pg8::gemm_phase<pg8::EpiResid, pg8::StaticOrder, true, true>(lds, g, S, E); SEAM(pb + 9); }
        for (int rep = 0; rep < (((REP_MASK) >> 11) & 1 ? 2 : 1); ++rep) if (false && PHEN(11) && IN(pb + 10)) { phase_ln(Y, INPTR(args, I_LN2G) + (size_t)l * DM, INPTR(args, I_LN2B) + (size_t)l * DM, nullptr, XB, (float*)AUX, gw, NGW, lane); SEAM(pb + 10); }
        for (int rep = 0; rep < (((REP_MASK) >> 12) & 1 ? 2 : 1); ++rep) if (PHEN(12) && IN(pb + 11)) {
            pg8::Gemm g{XB, (const bf16*)(ws + WS_WUP2), MTOK, NUP, DM}; pg8::StaticOrder S; S.init(MTOK, NUP, G, bid); pg8::EpiSwiGLU E{Hb, DFF, AUX, 3 * l + 1, l * 2 * GWN + NUP + INP};
            pg8::gemm_phase<pg8::EpiSwiGLU, pg8::StaticOrder, true, true>(lds, g, S, E); SEAM(pb + 11); }
        for (int rep = 0; rep < (((REP_MASK) >> 13) & 1 ? 2 : 1); ++rep) if (PHEN(13) && IN(pb + 12)) {
            pg8::Gemm g{Hb, (const bf16*)(ws + WS_WDN2), MTOK, DM, DFF}; pg8::StaticOrder S; S.init(MTOK, DM, G, bid); pg8::EpiResid E{Y, Y, XB, DM, ALPHA, 0.5f, 3 * l + 1, 3 * l + 2};
            pg8::gemm_phase<pg8::EpiResid, pg8::StaticOrder, true, true>(lds, g, S, E); SEAM(pb + 12); }
        for (int rep = 0; rep < (((REP_MASK) >> 14) & 1 ? 2 : 1); ++rep) if (l == NLAYER - 1 && PHEN(14) && IN(pb + 13)) { phase_ln(Y, INPTR(args, I_LN3G) + (size_t)l * DM, INPTR(args, I_LN3B) + (size_t)l * DM, args.out, XB, (float*)(ws + WS_SC), gw, NGW, lane); SEAM(pb + 13); }
    }
#undef IN
#undef SEAM
}

#ifndef ONE_MASK
#define ONE_MASK 0xFFFFF
#endif
#ifndef MK_ONE_LAUNCH
#define MK_ONE_LAUNCH 1
#endif
typedef void (*kern_t)(Args);
extern "C" void kernel_launch(void* const* d_in, const int* in_sizes, int n_in, void* d_out, int out_size, void* d_ws, size_t ws_size, hipStream_t stream) {
    static int grid = 0;
#if MK_ONE_LAUNCH
    static const kern_t kerns[1] = {fwd<ONE_MASK>};
    constexpr int NK = 1;
#else
    static const kern_t kerns[15] = {fwd<1 << 0>, fwd<1 << 1>, fwd<1 << 2>, fwd<1 << 3>, fwd<1 << 4>, fwd<1 << 5>, fwd<1 << 6>, fwd<1 << 7>, fwd<1 << 8>, fwd<1 << 9>, fwd<1 << 10>, fwd<1 << 11>, fwd<1 << 12>, fwd<1 << 13>, fwd<1 << 14>};
    constexpr int NK = 15;
#endif
    if (grid == 0) {
        if (n_in != 34 || out_size != MTOK * DM || ws_size < WS_END) { fprintf(stderr, "kernel_launch: unexpected shapes (n_in %d, out %d, ws %zu; need ws >= %zu)\n", n_in, out_size, ws_size, (size_t)WS_END); grid = -1; return; }
        int dev = 0, cus = 0;
        if (hipGetDevice(&dev) != hipSuccess || hipDeviceGetAttribute(&cus, hipDeviceAttributeMultiprocessorCount, dev) != hipSuccess) { grid = -1; return; }
        for (int i = 0; i < NK; ++i) if (hipFuncSetAttribute((const void*)kerns[i], hipFuncAttributeMaxDynamicSharedMemorySize, LDS_BYTES) != hipSuccess) { fprintf(stderr, "kernel_launch: hipFuncSetAttribute failed\n"); grid = -1; return; }
        int per_cu = 0;
        if (hipOccupancyMaxActiveBlocksPerMultiprocessor(&per_cu, (const void*)kerns[0], NTHR, LDS_BYTES) != hipSuccess || per_cu < 1) fprintf(stderr, "kernel_launch: occupancy query says %d blocks per CU\n", per_cu);
        (void)hipGetLastError();
        grid = cus;
    }
    if (grid < 0) return;
    (void)hipMemsetAsync((char*)d_ws + WS_CTL, 0, CTL_ZERO_BYTES, stream);
    (void)hipMemsetAsync((char*)d_ws + WS_AUX, 0, AUX_ZERO_BYTES, stream);
    Args a{};
    for (int i = 0; i < 34; ++i) a.in[i] = (const float*)d_in[i];
    a.out = (float*)d_out; a.ws = (unsigned char*)d_ws;
#if MK_ONE_LAUNCH
    a.ph_lo = 0; a.ph_hi = NPH;
    hipLaunchKernelGGL(kerns[0], dim3(grid), dim3(NTHR), LDS_BYTES, stream, a);
#else
#ifndef HOST_REP
#define HOST_REP 0
#endif
    for (int k = 0; k < NPH; ++k) { a.ph_lo = k; a.ph_hi = k + 1; const int j = k == 0 ? 0 : (k - 1) % 14 + 1;
        for (int rep = 0; rep < (((HOST_REP) >> j) & 1 ? 2 : 1); ++rep) {
            if (rep && j == 8) (void)hipMemsetAsync((char*)d_ws + WS_CTL + (8192 + 64 * ((k - 1) / 14)) * 4, 0, 256, stream);
            hipLaunchKernelGGL(kerns[j], dim3(grid), dim3(NTHR), LDS_BYTES, stream, a); } }
#endif
}
```

```cpp
#include <hip/hip_runtime.h>
#include <cstdio>
#include <cstdint>
namespace pg8 {
#define PG8_LAS __attribute__((address_space(3)))
typedef unsigned short bf16_t;
typedef short bf16x8 __attribute__((ext_vector_type(8)));
typedef float f32x4 __attribute__((ext_vector_type(4)));
typedef unsigned u32x4 __attribute__((ext_vector_type(4)));
constexpr int BM = 256, BK = 64, HALF = 128, HTB = HALF * BK * 2  , STAGE_BYTES = 8 * HTB, NXCD = 8, WGM = 8;

__host__ __device__ __forceinline__ int lds_byte(int r, int c) { const int st = (r >> 4) * 2 + (c >> 5), rr = r & 15, cc = c & 31, ob = rr * 64 + cc * 2; return st * 1024 + (ob ^ (((ob >> 9) & 1) << 5)); }
__host__ __device__ __forceinline__ void stage_rc(int b, int& R, int& C) { const int st = b / 1024, sb = b % 1024, swz = sb ^ (((sb >> 9) & 1) << 5); R = (st >> 1) * 16 + swz / 64; C = (st & 1) * 32 + (swz % 64) / 2; }
__host__ __device__ __forceinline__ int perm32(int rho) { const int n = rho >> 4, i = rho & 15; return 8 * (i >> 2) + 4 * n + (i & 3); }

struct Unit { int pm, pn; };
struct Gemm { const bf16_t* A; const bf16_t* Bt; int M, N, K; };

struct StaticOrder {
    int nM, nN, nwg, G, c;
    __host__ __device__ void init(int M, int N, int G_, int c_) { nM = M / BM; nN = N / BM; nwg = nM * nN; G = G_; c = c_; }
    __host__ __device__ bool next(int i, Unit& u) const {
        const long L = (long)i * G + c; if (L >= nwg) return false;
        int wgid = (int)L; { const int q = nwg / NXCD, r = nwg % NXCD, xcd = wgid % NXCD, off = wgid / NXCD; wgid = (xcd < r ? xcd * (q + 1) : r * (q + 1) + (xcd - r) * q) + off; }
        const int nig = WGM * nN, gid = wgid / nig, fm = gid * WGM, gsz = (nM - fm) < WGM ? (nM - fm) : WGM;
        u.pm = fm + ((wgid % nig) % gsz); u.pn = (wgid % nig) / gsz; return true;
    }
    __device__ __forceinline__ void a_ready(const Unit&) const {}
    __device__ __forceinline__ void done(const Unit&) const {}
};

__device__ __forceinline__ unsigned cvt_pk_bf16(float lo, float hi) { unsigned r; asm volatile("v_cvt_pk_bf16_f32 %0, %1, %2" : "=v"(r) : "v"(lo), "v"(hi)); return r; }
typedef float f32x2 __attribute__((ext_vector_type(2)));
constexpr int A_MT = 16384, A_DM = 2048, A_GWBW = 12 * A_MT * 2, A_GWN = 27136, A_LNGB = A_GWBW + 4 * 2 * A_GWN;
#define PG8_GAS __attribute__((address_space(1)))
__device__ __forceinline__ float quad16_sum(float x) { float a = x, b = x; asm volatile("s_nop 1\n\tv_permlane16_swap_b32 %0, %1" : "+v"(a), "+v"(b)); float y = a + b, c = y, d = y; asm volatile("s_nop 1\n\tv_permlane32_swap_b32 %0, %1" : "+v"(c), "+v"(d)); return c + d; }
template <class T> __device__ __forceinline__ PG8_GAS T* uni_ptr(T* p) { const unsigned long long v = (unsigned long long)p; const unsigned lo = __builtin_amdgcn_readfirstlane((unsigned)v), hi = __builtin_amdgcn_readfirstlane((unsigned)(v >> 32)); return (PG8_GAS T*)(((unsigned long long)hi << 32) | lo); }
__device__ __forceinline__ f32x2 ln_stats(const float* aux, int q, int row) { const f32x2 s = *(const f32x2*)(aux + ((size_t)q * A_MT + row) * 2); const float mean = s.x * (1.0f / A_DM);
    const float var = s.y * (1.0f / A_DM) - mean * mean; return (f32x2){mean, 1.0f / sqrtf(var + 1e-5f)}; }
struct EpiSwiGLU {
    static constexpr bool PERM = true, AFTER_DRAIN = false, PREFETCH = true;
    bf16_t* H; int ldh; const float* aux; int q, gwo;
    __device__ __forceinline__ void prefetch(const Unit& u, PG8_LAS unsigned char* xl, int wid, int lane) const {
        const int w = wid & 3, qq = q < 0 ? 0 : q; const PG8_GAS float* au = uni_ptr(aux);
        const PG8_GAS float* src = w < 2 ? au + ((size_t)qq * A_MT + u.pm * BM) * 2 + (w * 64 + lane) * 4
                                         : au + A_GWBW + gwo + (w == 3 ? A_GWN : 0) + (lane >= 32 ? 5504 : 0) + u.pn * HALF + (lane & 31) * 4;
        __builtin_amdgcn_global_load_lds((const unsigned*)src, (PG8_LAS unsigned*)(xl + wid * 1024), 16, 0, 0);
    }
    __device__ __forceinline__ void operator()(const f32x4 (&acc)[2][2][4][2], const Unit& u, int wr, int wc, int fr, int fq, PG8_LAS unsigned char* xl) const {
        const int row0 = u.pm * BM + wr * 64 + fr, col0 = u.pn * HALF + wc * 32 + 8 * fq;
        f32x4 ga[2], gb[2], ba[2], bb[2]; f32x2 sr[8];
#pragma unroll
        for (int n = 0; n < 2; ++n) { ga[n] = (f32x4){0.f, 0.f, 0.f, 0.f}; gb[n] = ga[n]; ba[n] = ga[n]; bb[n] = ga[n]; }
#pragma unroll
        for (int k = 0; k < 8; ++k) sr[k] = (f32x2){0.f, (float)A_DM * (1.0f - 1e-5f)};
        if (q >= 0) { const PG8_LAS float* cv = (const PG8_LAS float*)(xl + 2048) + wc * 32 + 8 * fq; const PG8_LAS float* rs = (const PG8_LAS float*)xl + (wr * 64 + fr) * 2;
#pragma unroll
            for (int n = 0; n < 2; ++n) { ga[n] = *(const PG8_LAS f32x4*)(cv + 4 * n); gb[n] = *(const PG8_LAS f32x4*)(cv + 128 + 4 * n); ba[n] = *(const PG8_LAS f32x4*)(cv + 256 + 4 * n); bb[n] = *(const PG8_LAS f32x4*)(cv + 384 + 4 * n); }
#pragma unroll
            for (int k = 0; k < 8; ++k) sr[k] = *(const PG8_LAS f32x2*)(rs + ((k >> 2) * HALF + (k & 3) * 16) * 2);
        }
        asm volatile("" ::: "memory");
#pragma unroll
        for (int ai = 0; ai < 2; ++ai)
#pragma unroll
            for (int m = 0; m < 4; ++m) { const int row = row0 + ai * HALF + m * 16; bf16_t* rowp = H + (size_t)row * ldh + col0;
                const float mean = sr[ai * 4 + m].x * (1.0f / A_DM), rstd = 1.0f / sqrtf(sr[ai * 4 + m].y * (1.0f / A_DM) - mean * mean + 1e-5f);
                float hv[8];
#pragma unroll
                for (int n = 0; n < 2; ++n) {
#pragma unroll
                    for (int i = 0; i < 4; ++i) { const float a = (acc[ai][0][m][n][i] - mean * ga[n][i]) * rstd + ba[n][i], b = (acc[ai][1][m][n][i] - mean * gb[n][i]) * rstd + bb[n][i];
                        const float e = __builtin_amdgcn_exp2f(a * -1.44269504089f); hv[n * 4 + i] = a * __builtin_amdgcn_rcpf(1.0f + e) * b; } }
                u32x4 w; w.x = cvt_pk_bf16(hv[0], hv[1]); w.y = cvt_pk_bf16(hv[2], hv[3]); w.z = cvt_pk_bf16(hv[4], hv[5]); w.w = cvt_pk_bf16(hv[6], hv[7]);
                *(u32x4*)rowp = w; asm volatile("" ::: "memory"); }
    }
};
struct EpiResid {
    static constexpr bool PERM = true, AFTER_DRAIN = false, PREFETCH = false;
    float* Y; bf16_t* YB; unsigned char* L8; float* YF; int ldc; float alpha, s; int qp, qn; int wy;
    __device__ __forceinline__ void operator()(const f32x4 (&acc)[2][2][4][2], const Unit& u, int wr, int wc, int fr, int fq, PG8_LAS unsigned char* xl) const {
        const int urow0 = __builtin_amdgcn_readfirstlane(u.pm * BM + wr * 64), ucol0 = __builtin_amdgcn_readfirstlane(u.pn * BM + wc * 32); const unsigned lob = (unsigned)(fr * ldc + 8 * fq) * 4u;
        float al_ = alpha, sc_ = s; asm volatile("" : "+s"(al_), "+s"(sc_));
        PG8_GAS float* Yu = uni_ptr(Y); PG8_GAS bf16_t* YBu = uni_ptr(YB); PG8_GAS unsigned char* L8u = uni_ptr(L8); PG8_GAS float* YFu = uni_ptr(YF);
        PG8_GAS float* aux = Yu + (size_t)A_MT * A_DM; const PG8_GAS float* lng = aux + A_LNGB + (size_t)(qp < 0 ? 0 : qp) * 2 * A_DM + ucol0 + 8 * fq; const PG8_GAS float* lnb = lng + A_DM;
        PG8_LAS float* wl = (PG8_LAS float*)(xl + (wr * 4 + wc) * 2048); float t1[2] = {0.f, 0.f}, t2[2] = {0.f, 0.f};
#pragma unroll
        for (int e = 0; e < 2; ++e) { const int k = 2 * fq + e, j = 16 * k + fr; f32x2 st = {0.f, 1.f};
            if (qp >= 0) { const f32x2 sr = *(const PG8_GAS f32x2*)(aux + ((size_t)qp * A_MT + urow0 + (k >> 2) * HALF + (k & 3) * 16 + fr) * 2); const float mean = sr.x * (1.0f / A_DM);
                st.x = mean; st.y = 1.0f / sqrtf(sr.y * (1.0f / A_DM) - mean * mean + 1e-5f); }
            *(PG8_LAS f32x2*)(wl + 2 * j) = st; }
        asm volatile("s_waitcnt lgkmcnt(0)" ::: "memory");
        typedef unsigned u32x2_ __attribute__((ext_vector_type(2)));
#pragma unroll
        for (int c = 0; c < 4; ++c) { const int ai = c >> 1, bj = c & 1;
            f32x4 gv[2], bv[2];
#pragma unroll
            for (int n = 0; n < 2; ++n) { gv[n] = (f32x4){1.f, 1.f, 1.f, 1.f}; bv[n] = (f32x4){0.f, 0.f, 0.f, 0.f}; }
            u32x4 xb[4]; u32x2_ xl8[4];
            if (qp >= 0) {
#pragma unroll
                for (int n = 0; n < 2; ++n) { gv[n] = *(const PG8_GAS f32x4*)(lng + bj * HALF + n * 4); bv[n] = *(const PG8_GAS f32x4*)(lnb + bj * HALF + n * 4); } }
#pragma unroll
            for (int m = 0; m < 4; ++m) { int ur = urow0 + ai * HALF + m * 16; ur = __builtin_amdgcn_readfirstlane(ur); asm volatile("" : "+s"(ur));
                const size_t eo = (size_t)ur * ldc + ucol0 + bj * HALF; xb[m] = *(const PG8_GAS u32x4*)((const PG8_GAS char*)(YBu + eo) + (lob >> 1)); xl8[m] = *(const PG8_GAS u32x2_*)(L8u + eo + (lob >> 2)); }
            asm volatile("" ::: "memory");
#pragma unroll
            for (int m = 0; m < 4; ++m) { int ur = urow0 + ai * HALF + m * 16; ur = __builtin_amdgcn_readfirstlane(ur); asm volatile("" : "+s"(ur)); const size_t uoff = (size_t)ur * ldc + ucol0 + bj * HALF;
                const int j = 16 * (ai * 4 + m) + fr; const f32x2 st = *(const PG8_LAS f32x2*)(wl + 2 * j); float p1 = 0.f, p2 = 0.f; u32x4 wb; u32x2_ wl8;
#pragma unroll
                for (int n = 0; n < 2; ++n) {
                    f32x4 xr; { const unsigned w0 = n ? xb[m].z : xb[m].x, w1 = n ? xb[m].w : xb[m].y; const int lw = (int)(n ? xl8[m].y : xl8[m].x); const f32x2 l0 = __builtin_amdgcn_cvt_pk_f32_bf8(lw, false), l1 = __builtin_amdgcn_cvt_pk_f32_bf8(lw, true);
                        xr.x = __builtin_bit_cast(float, w0 << 16) + l0.x; xr.y = __builtin_bit_cast(float, w0 & 0xffff0000u) + l0.y; xr.z = __builtin_bit_cast(float, w1 << 16) + l1.x; xr.w = __builtin_bit_cast(float, w1 & 0xffff0000u) + l1.y; }
                    const f32x4 x = (xr - st.x) * st.y * gv[n] + bv[n];
                    const f32x4 y = x * al_ + acc[ai][bj][m][n] * sc_;
                    if (wy) *(PG8_GAS f32x4*)((PG8_GAS char*)(YFu + uoff + n * 4) + lob) = y;
                    const unsigned h0 = cvt_pk_bf16(y.x, y.y), h1 = cvt_pk_bf16(y.z, y.w);
                    int l8 = __builtin_amdgcn_cvt_pk_bf8_f32(y.x - __builtin_bit_cast(float, h0 << 16), y.y - __builtin_bit_cast(float, h0 & 0xffff0000u), 0, false);
                    l8 = __builtin_amdgcn_cvt_pk_bf8_f32(y.z - __builtin_bit_cast(float, h1 << 16), y.w - __builtin_bit_cast(float, h1 & 0xffff0000u), l8, true);
                    if (n == 0) { wb.x = h0; wb.y = h1; wl8.x = (unsigned)l8; } else { wb.z = h0; wb.w = h1; wl8.y = (unsigned)l8; }
                    p1 += (y.x + y.y) + (y.z + y.w); p2 += (y.x * y.x + y.y * y.y) + (y.z * y.z + y.w * y.w); }
                *(PG8_GAS u32x4*)((PG8_GAS char*)(YBu + uoff) + (lob >> 1)) = wb; *(PG8_GAS u32x2_*)(L8u + uoff + (lob >> 2)) = wl8;
                p1 = quad16_sum(p1); p2 = quad16_sum(p2); const bool mine = fq == ((ai * 4 + m) >> 1);
                t1[m & 1] += mine ? p1 : 0.f; t2[m & 1] += mine ? p2 : 0.f; }
            asm volatile("" ::: "memory"); }
#pragma unroll
        for (int e = 0; e < 2; ++e) { const int k = 2 * fq + e;
            PG8_GAS float* sp = aux + ((size_t)qn * A_MT + urow0 + (k >> 2) * HALF + (k & 3) * 16 + fr) * 2;
            __hip_atomic_fetch_add(sp, __builtin_rintf(t1[e] * 1024.0f) * (1.0f / 1024.0f), __ATOMIC_RELAXED, __HIP_MEMORY_SCOPE_AGENT); __hip_atomic_fetch_add(sp + 1, __builtin_rintf(t2[e] * 64.0f) * (1.0f / 64.0f), __ATOMIC_RELAXED, __HIP_MEMORY_SCOPE_AGENT); }
        asm volatile("s_waitcnt lgkmcnt(0)" ::: "memory");
    }
};
struct EpiF32 {
    static constexpr bool PERM = false, AFTER_DRAIN = false, PREFETCH = true;
    float* C; int ldc; const float* aux; int q, gwo;
    __device__ __forceinline__ void prefetch(const Unit& u, PG8_LAS unsigned char* xl, int wid, int lane) const {
        const int w = wid & 3; const PG8_GAS float* au = uni_ptr(aux);
        const PG8_GAS float* src = w < 2 ? au + ((size_t)q * A_MT + u.pm * BM) * 2 + (w * 64 + lane) * 4 : au + A_GWBW + gwo + (w == 3 ? A_GWN : 0) + u.pn * BM + lane * 4;
        __builtin_amdgcn_global_load_lds((const unsigned*)src, (PG8_LAS unsigned*)(xl + wid * 1024), 16, 0, 0);
    }
    __device__ __forceinline__ void operator()(const f32x4 (&acc)[2][2][4][2], const Unit& u, int wr, int wc, int fr, int fq, PG8_LAS unsigned char* xl) const {
        const int row0 = u.pm * BM + wr * 64 + fr, col0 = u.pn * BM + wc * 32 + 4 * fq;
        const PG8_LAS float* cv = (const PG8_LAS float*)(xl + 2048) + wc * 32 + 4 * fq; const PG8_LAS float* rs = (const PG8_LAS float*)xl + (wr * 64 + fr) * 2;
        f32x4 g4[2][2], b4[2][2]; f32x2 sr[8];
#pragma unroll
        for (int bj = 0; bj < 2; ++bj)
#pragma unroll
            for (int n = 0; n < 2; ++n) { g4[bj][n] = *(const PG8_LAS f32x4*)(cv + bj * HALF + n * 16); b4[bj][n] = *(const PG8_LAS f32x4*)(cv + 256 + bj * HALF + n * 16); }
#pragma unroll
        for (int k = 0; k < 8; ++k) sr[k] = *(const PG8_LAS f32x2*)(rs + ((k >> 2) * HALF + (k & 3) * 16) * 2);
        asm volatile("" ::: "memory");
#pragma unroll
        for (int ai = 0; ai < 2; ++ai)
#pragma unroll
            for (int m = 0; m < 4; ++m) { const int row = row0 + ai * HALF + m * 16; float* rowp = C + (size_t)row * ldc + col0;
                const float mean = sr[ai * 4 + m].x * (1.0f / A_DM), rstd = 1.0f / sqrtf(sr[ai * 4 + m].y * (1.0f / A_DM) - mean * mean + 1e-5f);
#pragma unroll
                for (int bj = 0; bj < 2; ++bj)
#pragma unroll
                    for (int n = 0; n < 2; ++n) *(f32x4*)(rowp + bj * HALF + n * 16) = (acc[ai][bj][m][n] - g4[bj][n] * mean) * rstd + b4[bj][n];
                asm volatile("" ::: "memory"); }
    }
};

template <class Epi, class Sched, bool ALIGN_EPI = false, bool SP2 = false>
__device__ __forceinline__ void gemm_phase(PG8_LAS unsigned char* lds, const Gemm g, const Sched& S, const Epi& E) {
    int tid_ = threadIdx.x; asm volatile("" : "+v"(tid_));
    const int tid = tid_, wid = __builtin_amdgcn_readfirstlane(tid >> 6), lane = tid & 63, wr = wid >> 2, wc = wid & 3, fr = lane & 15, fq = lane >> 4;
    const int K = g.K, nt = K / BK;
    unsigned voffA[2], voffB[2];
#pragma unroll
    for (int i = 0; i < 2; ++i) { int R, C; stage_rc(tid * 16 + i * 8192, R, C); const int Rb = Epi::PERM ? ((R & ~31) + perm32(R & 31)) : R;
        voffA[i] = (unsigned)(R * K + C) * 2u; voffB[i] = (unsigned)(Rb * K + C) * 2u; }
    const size_t kstep = (size_t)(BK * 2);
    const size_t hstep = (size_t)HALF * K * 2;
    const size_t tstep = 2 * hstep;
    const unsigned ldsw = (unsigned)wid * 1024u;
    const int aoff = lds_byte(wr * 64 + fr, fq * 8), boff = lds_byte(wc * 32 + fr, fq * 8);
#define PG8_SA(b, h) (((b) * 2 + (h)) * HTB)
#define PG8_SB(b, h) ((4 + (b) * 2 + (h)) * HTB)
#define PG8_STAGE(bufoff, gbase, voff) do { _Pragma("unroll") for (int _i = 0; _i < 2; ++_i) \
        __builtin_amdgcn_global_load_lds((const unsigned*)((const char*)(gbase) + (voff)[_i]), (PG8_LAS unsigned*)(lds + (bufoff) + ldsw + _i * 8192), 16, 0, 0); } while (0)
#define PG8_LDA(dst, b, h) do { _Pragma("unroll") for (int m = 0; m < 4; ++m) _Pragma("unroll") for (int k = 0; k < 2; ++k) dst[m][k] = *(const PG8_LAS bf16x8*)(lds + PG8_SA(b, h) + aoff + m * 2048 + k * 1024); } while (0)
#define PG8_LDB(dst, b, h) do { _Pragma("unroll") for (int n = 0; n < 2; ++n) _Pragma("unroll") for (int k = 0; k < 2; ++k) dst[n][k] = *(const PG8_LAS bf16x8*)(lds + PG8_SB(b, h) + boff + n * 2048 + k * 1024); } while (0)
#define PG8_MMA(ai, bj, At, Bt) do { __builtin_amdgcn_s_setprio(1); _Pragma("unroll") for (int m = 0; m < 4; ++m) _Pragma("unroll") for (int n = 0; n < 2; ++n) _Pragma("unroll") for (int k = 0; k < 2; ++k) \
        acc[ai][bj][m][n] = __builtin_amdgcn_mfma_f32_16x16x32_bf16(Bt[n][k], At[m][k], acc[ai][bj][m][n], 0, 0, 0); __builtin_amdgcn_s_setprio(0); } while (0)
#define PG8_WAIT_V(n) asm volatile("s_waitcnt vmcnt(" #n ")" ::: "memory")
#define PG8_WAIT_L(n) asm volatile("s_waitcnt lgkmcnt(" #n ")" ::: "memory")
#define PG8_BAR __builtin_amdgcn_s_barrier()
#define PG8_SCHED __builtin_amdgcn_sched_barrier(0)
    Unit cur, nxt; int ui = 0;
    if (!S.next(0, cur)) return;
    f32x4 acc[2][2][4][2];
#pragma unroll
    for (int a = 0; a < 2; ++a)
#pragma unroll
        for (int b = 0; b < 2; ++b)
#pragma unroll
            for (int m = 0; m < 4; ++m)
#pragma unroll
                for (int n = 0; n < 2; ++n) acc[a][b][m][n] = (f32x4){0.f, 0.f, 0.f, 0.f};
    bf16x8 At[4][2], B0[2][2], B1[2][2];
    const char* cA = (const char*)g.A + (size_t)cur.pm * tstep; const char* cB = (const char*)g.Bt + (size_t)cur.pn * tstep;
    S.a_ready(cur);
    if constexpr (SP2) {
        PG8_STAGE(PG8_SB(0, 0), cB, voffB); PG8_STAGE(PG8_SB(0, 1), cB + hstep, voffB); PG8_STAGE(PG8_SA(0, 0), cA, voffA); PG8_STAGE(PG8_SA(0, 1), cA + hstep, voffA);
        if (wr == 1) PG8_BAR;
        PG8_WAIT_V(2); PG8_BAR;
        PG8_STAGE(PG8_SB(1, 0), cB + kstep, voffB); PG8_STAGE(PG8_SA(1, 0), cA + kstep, voffA); PG8_STAGE(PG8_SB(1, 1), cB + hstep + kstep, voffB);
        PG8_WAIT_V(6); PG8_BAR;
    } else {
        PG8_STAGE(PG8_SB(0, 0), cB, voffB); PG8_STAGE(PG8_SA(0, 0), cA, voffA); PG8_STAGE(PG8_SB(0, 1), cB + hstep, voffB); PG8_STAGE(PG8_SA(0, 1), cA + hstep, voffA);
        if (wr == 1) PG8_BAR;
        PG8_WAIT_V(4); PG8_BAR;
        PG8_STAGE(PG8_SB(1, 0), cB + kstep, voffB); PG8_STAGE(PG8_SA(1, 0), cA + kstep, voffA); PG8_STAGE(PG8_SB(1, 1), cB + hstep + kstep, voffB);
        PG8_WAIT_V(6); PG8_BAR;
    }
    for (;;) {
        const bool has_next = S.next(ui + 1, nxt);
        const char* nA = has_next ? (const char*)g.A + (size_t)nxt.pm * tstep : cA; const char* nB = has_next ? (const char*)g.Bt + (size_t)nxt.pn * tstep : cB;
        for (int t = 0; t < nt; t += 2) {
            const bool last = (t == nt - 2);
            const char* a1 = cA + (size_t)(t + 1) * kstep;
            const char* a2 = last ? nA : cA + (size_t)(t + 2) * kstep; const char* b2 = last ? nB : cB + (size_t)(t + 2) * kstep;
            const char* a3 = a2 + kstep; const char* b3 = b2 + kstep;
            if (last && has_next) S.a_ready(nxt);
            if constexpr (Epi::PREFETCH) { if (last) E.prefetch(cur, lds + STAGE_BYTES, wid, lane); }
            if constexpr (SP2) {
            PG8_LDB(B0, 0, 0); PG8_LDB(B1, 0, 1); PG8_SCHED; PG8_LDA(At, 0, 0); PG8_STAGE(PG8_SA(1, 1), a1 + hstep, voffA);
            PG8_WAIT_V(8); PG8_WAIT_L(0); PG8_BAR; PG8_MMA(0, 0, At, B0); PG8_MMA(0, 1, At, B1); PG8_BAR; PG8_SCHED;
            PG8_LDA(At, 0, 1); PG8_STAGE(PG8_SB(0, 0), b2, voffB); PG8_STAGE(PG8_SB(0, 1), b2 + hstep, voffB); PG8_STAGE(PG8_SA(0, 0), a2, voffA);
            PG8_WAIT_V(8); PG8_WAIT_L(0); PG8_BAR; PG8_MMA(1, 0, At, B0); PG8_MMA(1, 1, At, B1); PG8_BAR; PG8_SCHED;
            PG8_LDB(B0, 1, 0); PG8_LDB(B1, 1, 1); PG8_SCHED; PG8_LDA(At, 1, 0); PG8_STAGE(PG8_SA(0, 1), a2 + hstep, voffA);
            PG8_WAIT_V(8); PG8_WAIT_L(0); PG8_BAR; PG8_MMA(0, 0, At, B0); PG8_MMA(0, 1, At, B1); PG8_BAR; PG8_SCHED;
            PG8_LDA(At, 1, 1); PG8_STAGE(PG8_SB(1, 0), b3, voffB); PG8_STAGE(PG8_SB(1, 1), b3 + hstep, voffB); PG8_STAGE(PG8_SA(1, 0), a3, voffA);
            PG8_WAIT_V(8); PG8_WAIT_L(0); PG8_BAR; PG8_MMA(1, 0, At, B0); PG8_MMA(1, 1, At, B1); PG8_BAR; PG8_SCHED;
            } else {
            PG8_LDB(B0, 0, 0); PG8_SCHED; PG8_LDA(At, 0, 0); PG8_STAGE(PG8_SA(1, 1), a1 + hstep, voffA);
            PG8_WAIT_L(8); PG8_BAR; PG8_WAIT_L(0); PG8_MMA(0, 0, At, B0); PG8_BAR; PG8_SCHED;
            PG8_LDB(B1, 0, 1); PG8_STAGE(PG8_SB(0, 0), b2, voffB);
            PG8_BAR; PG8_WAIT_L(0); PG8_MMA(0, 1, At, B1); PG8_BAR;
            PG8_LDA(At, 0, 1); PG8_STAGE(PG8_SA(0, 0), a2, voffA);
            PG8_BAR; PG8_WAIT_L(0); PG8_MMA(1, 0, At, B0); PG8_BAR; PG8_SCHED;
            PG8_STAGE(PG8_SB(0, 1), b2 + hstep, voffB);
            PG8_WAIT_V(6); PG8_BAR; PG8_MMA(1, 1, At, B1); PG8_BAR;
            PG8_LDB(B0, 1, 0); PG8_SCHED; PG8_LDA(At, 1, 0); PG8_STAGE(PG8_SA(0, 1), a2 + hstep, voffA);
            PG8_WAIT_L(8); PG8_BAR; PG8_WAIT_L(0); PG8_MMA(0, 0, At, B0); PG8_BAR; PG8_SCHED;
            PG8_LDB(B1, 1, 1); PG8_STAGE(PG8_SB(1, 0), b3, voffB);
            PG8_BAR; PG8_WAIT_L(0); PG8_MMA(0, 1, At, B1); PG8_BAR;
            PG8_LDA(At, 1, 1); PG8_STAGE(PG8_SA(1, 0), a3, voffA);
            PG8_BAR; PG8_WAIT_L(0); PG8_MMA(1, 0, At, B0); PG8_BAR; PG8_SCHED;
            PG8_STAGE(PG8_SB(1, 1), b3 + hstep, voffB);
            PG8_WAIT_V(6); PG8_BAR; PG8_MMA(1, 1, At, B1); PG8_BAR;
            }
        }
        if constexpr (ALIGN_EPI) { if (wr == 0) PG8_BAR; }
        if constexpr (!Epi::AFTER_DRAIN) { E(acc, cur, wr, wc, fr, fq, lds + STAGE_BYTES); S.done(cur); }
        if (!has_next) break;
#pragma unroll
        for (int a = 0; a < 2; ++a)
#pragma unroll
            for (int b = 0; b < 2; ++b)
#pragma unroll
                for (int m = 0; m < 4; ++m)
#pragma unroll
                    for (int n = 0; n < 2; ++n) acc[a][b][m][n] = (f32x4){0.f, 0.f, 0.f, 0.f};
        cur = nxt; cA = nA; cB = nB; ++ui;
        if constexpr (ALIGN_EPI) { if (wr == 1) PG8_BAR; }
    }
    PG8_WAIT_V(0);
    if constexpr (!ALIGN_EPI) { if (wr == 0) PG8_BAR; }
    PG8_BAR;
    if constexpr (Epi::AFTER_DRAIN) { E.fused(acc, cur, wr, wc, fr, fq, lds, wid, lane); S.done(cur); }
#undef PG8_SA
#undef PG8_SB
#undef PG8_STAGE
#undef PG8_LDA
#undef PG8_LDB
#undef PG8_MMA
#undef PG8_WAIT_V
#undef PG8_WAIT_L
#undef PG8_BAR
#undef PG8_SCHED
}
}

constexpr int NWAVES = 8, NTHR = 512;
constexpr int NB = 4, SEQ = 4096, DM = 2048, MTOK = NB * SEQ, NLAYER = 4;
constexpr int DFF = 5504, NUP = 2 * DFF;
constexpr int INC = 5028, INP = 5120;
constexpr int DRW = 768, RWC = 2560, PO_POOL = 2560, DPOOL = 512, PO_NSA = 3072;
constexpr int PO_Q = PO_NSA, PO_KC = PO_NSA + 768, PO_VC = PO_KC + 192, PO_KS = PO_VC + 192, PO_VS = PO_KS + 192, PO_KW = PO_VS + 192, PO_VW = PO_KW + 192, PO_GL = PO_VW + 192;
static_assert(PO_GL + 36 == INC, "W_in column map");
constexpr int NCMP = 255, NCMPP = 256;
constexpr float ALPHA = 1.6817928305074290f;
constexpr float LN_EPS = 1e-5f, GN_EPS = 64e-5f;
constexpr int NPH = 1 + 14 * NLAYER;

constexpr size_t MiB = 1u << 20;
constexpr size_t WS_CTL = 0, CTL_ZERO_BYTES = 1 * MiB;
constexpr size_t WS_ROPE = 1 * MiB;
constexpr size_t WS_KC = 2 * MiB, WS_VC = 2 * MiB + 512 * 1024;
constexpr size_t WS_SC = 3 * MiB;
constexpr size_t WS_WUP1 = 8 * MiB, WS_WDN1 = 51 * MiB, WS_WIN = WS_WDN1 + 21 * MiB + 512 * 1024, WS_WOUT = WS_WIN + 20 * MiB, WS_WUP2 = WS_WOUT + 8 * MiB, WS_WDN2 = WS_WUP2 + 43 * MiB;
constexpr size_t WS_XB = 165 * MiB;
static_assert(WS_WDN2 + (size_t)DM * DFF * 2 <= WS_XB, "weights map");
constexpr size_t WS_CAT = 229 * MiB;
constexpr size_t WS_QR = 293 * MiB;
constexpr size_t WS_KS = 317 * MiB, WS_KW = 323 * MiB, WS_VS = 329 * MiB, WS_VW = 335 * MiB;
constexpr size_t WS_P = 341 * MiB;
constexpr size_t WS_H = 661 * MiB;
constexpr size_t WS_Y = 833 * MiB;
constexpr size_t WS_SV = WS_H;
constexpr size_t SV_STRIDE = 48 * MiB;
static_assert(WS_SV + 6 * SV_STRIDE <= WS_Y + 128 * MiB, "scan overlay");
constexpr size_t WS_G = 961 * MiB, WS_YS = 1009 * MiB;
constexpr size_t WS_VST = 1057 * MiB, WS_VWT = 1063 * MiB;
constexpr size_t WS_VCT = 6 * MiB;
constexpr size_t WS_SW = 1069 * MiB;
constexpr size_t WS_W2T = WS_SW, WS_A2T = WS_W2T + 768 * 64 * 2, WS_G2T = WS_A2T + 768 * 64 * 2, WS_PWT = WS_G2T + 768 * 128 * 2;
constexpr size_t WS_W1T = WS_PWT + 4 * 128 * 128 * 2, WS_W2CT = WS_W1T + 2 * 256 * 2048 * 2, WS_CBIAS = WS_W2CT + 2 * 64 * 256 * 2;
constexpr size_t WS_SPREC = 1073 * MiB;
constexpr size_t SPREC_BYTES = 15360, WS_YR = WS_SPREC + (size_t)NB * 12 * 256 * SPREC_BYTES + MiB;
constexpr size_t WS_XL8 = WS_YR;
constexpr int GWN = NUP + INP + NUP;
constexpr size_t WS_AUX = WS_YR + 128 * MiB;
constexpr size_t AUX_ST = 0, AUX_GWBW = AUX_ST + (size_t)12 * MTOK * 2 * 4, AUX_ZERO_BYTES = AUX_GWBW + (size_t)NLAYER * 2 * GWN * 4, AUX_LNGB = (AUX_ZERO_BYTES + 255) & ~(size_t)255;
constexpr size_t WS_END = WS_AUX + AUX_LNGB + (size_t)12 * 2 * DM * 4 + MiB;
static_assert(WS_CBIAS + 2 * 256 * 4 <= WS_END, "small weights map");

constexpr int LDS_SCRATCH = 147456;
constexpr int LDS_BYTES = LDS_SCRATCH + 1024, MISC_OFF = LDS_SCRATCH + 320;

#define GAS __attribute__((address_space(1)))
#define LAS __attribute__((address_space(3)))
typedef unsigned short bf16;
typedef float f32x4 __attribute__((ext_vector_type(4)));
typedef float f32x2 __attribute__((ext_vector_type(2)));
typedef unsigned u32x4 __attribute__((ext_vector_type(4)));
typedef unsigned u32x2 __attribute__((ext_vector_type(2)));
#define LDS_WAIT() asm volatile("s_waitcnt lgkmcnt(0)" ::: "memory")
__device__ __forceinline__ unsigned f2bf(float f) { unsigned u = __builtin_bit_cast(unsigned, f); return (u + 0x7fffu + ((u >> 16) & 1u)) >> 16; }
__device__ __forceinline__ unsigned pk2(float lo, float hi) { return f2bf(lo) | (f2bf(hi) << 16); }
__device__ __forceinline__ float bf2f(unsigned short b) { return __builtin_bit_cast(float, ((unsigned)b) << 16); }
__device__ __forceinline__ float wave_sum(float v) {
#pragma unroll
    for (int o = 1; o < 64; o <<= 1) v += __shfl_xor(v, o);
    return v;
}
__device__ __forceinline__ float wave_max(float v) {
#pragma unroll
    for (int o = 1; o < 64; o <<= 1) v = fmaxf(v, __shfl_xor(v, o));
    return v;
}
__device__ __forceinline__ float sigmoidf_(float x) { return 1.0f / (1.0f + expf(-x)); }
template <int CTRL> __device__ __forceinline__ float dpp_f(float v) { return __builtin_bit_cast(float, __builtin_amdgcn_update_dpp(0, __builtin_bit_cast(int, v), CTRL, 0xF, 0xF, true)); }
__device__ __forceinline__ float row16_sum(float v) {
    v += dpp_f<0xB1>(v); v += dpp_f<0x4E>(v); v += dpp_f<0x141>(v); v += dpp_f<0x140>(v); return v;
}

#define XB_TMO      128
#define XB_XCNT(j)  (256  + 64 * (j))
#define XB_XSUB(j)  (1280 + 64 * (j))
#define XB_XGEN(j)  (2304 + 64 * (j))
#define XB_TOP      3328
#define XB_TOPGEN   3392
#define XCD_BAR_WORDS 3456
#define XB_SPIN_CAP (1u << 18)

__device__ __forceinline__ unsigned xb_ld(unsigned* p)              { return __hip_atomic_load(p, __ATOMIC_RELAXED, __HIP_MEMORY_SCOPE_AGENT); }
__device__ __forceinline__ unsigned xb_add(unsigned* p, unsigned v) { return __hip_atomic_fetch_add(p, v, __ATOMIC_RELAXED, __HIP_MEMORY_SCOPE_AGENT); }
__device__ __forceinline__ unsigned xb_xcc_id() { return (unsigned)__builtin_amdgcn_s_getreg((3 << 11) | 20) & 0xFu; }
#define XB_SPIN(cond, bar) do { unsigned _sp = 0; while (cond) { __builtin_amdgcn_s_sleep(1); \
    if ((++_sp & 255u) == 0u) { if (xb_ld(&(bar)[XB_TMO])) break; if (_sp > XB_SPIN_CAP) { atomicAdd(&(bar)[XB_TMO], 1u); break; } } } } while (0)

struct XcdBarrier {
    unsigned* bar; unsigned x;
    volatile LAS unsigned* st;
};

__device__ __forceinline__ XcdBarrier xcd_barrier_post(unsigned* bar, volatile LAS unsigned* st) {
    XcdBarrier b; b.bar = bar; b.x = xb_xcc_id(); b.st = st;
    if (threadIdx.x == 0) (void)xb_add(&bar[XB_XCNT(b.x)], 1u);
    return b;
}
__device__ __forceinline__ void xcd_barrier_complete(unsigned* bar, unsigned x, unsigned& nloc, unsigned& nx) {
    const unsigned G = gridDim.x * gridDim.y * gridDim.z;
    unsigned sum, cnt, mine, sp = 0u;
    for (;;) {
        sum = 0u; cnt = 0u; mine = 0u;
#pragma unroll
        for (unsigned j = 0; j < 16; ++j) { const unsigned c = xb_ld(&bar[XB_XCNT(j)]); sum += c; cnt += (c > 0u) ? 1u : 0u; mine = (j == x) ? c : mine; }
        if (sum == G) break;
        __builtin_amdgcn_s_sleep(1);
        if ((++sp & 255u) == 0u) { if (xb_ld(&bar[XB_TMO])) break; if (sp > XB_SPIN_CAP) { atomicAdd(&bar[XB_TMO], 1u); break; } }
    }
    nloc = mine > 0u ? mine : 1u; nx = cnt > 0u ? cnt : 1u;
}

__device__ __forceinline__ void xcd_barrier(const XcdBarrier& b) {
    asm volatile("s_waitcnt vmcnt(0)" ::: "memory");
    __syncthreads();
    if (threadIdx.x == 0) {
        unsigned* bar = b.bar;
        __builtin_amdgcn_s_waitcnt(0);
        unsigned nloc = b.st[0], nx = b.st[1];
        if (nloc == 0u) { xcd_barrier_complete(bar, b.x, nloc, nx); b.st[0] = nloc; b.st[1] = nx; }
        const unsigned old = xb_add(&bar[XB_XSUB(b.x)], 1u);
        const unsigned gen = old / nloc;
        if (old + 1u == (gen + 1u) * nloc) {
            __builtin_amdgcn_fence(__ATOMIC_RELEASE, "agent");
            asm volatile("s_waitcnt vmcnt(0)" ::: "memory");
            const unsigned og = xb_add(&bar[XB_TOP], 1u);
            const unsigned tg = og / nx;
            if (og + 1u == (tg + 1u) * nx) xb_add(&bar[XB_TOPGEN], 1u);
            else XB_SPIN(xb_ld(&bar[XB_TOPGEN]) == tg, bar);
            __builtin_amdgcn_fence(__ATOMIC_ACQUIRE, "agent");
            xb_add(&bar[XB_XGEN(b.x)], 1u);
            asm volatile("s_waitcnt vmcnt(0)" ::: "memory");
        } else {
            XB_SPIN(xb_ld(&bar[XB_XGEN(b.x)]) == gen, bar);
            __builtin_amdgcn_fence(__ATOMIC_ACQUIRE, "agent");
            asm volatile("s_waitcnt vmcnt(0)" ::: "memory");
        }
    }
    __syncthreads();
}

struct Args { const float* in[34]; float* out; unsigned char* ws; int ph_lo, ph_hi, rep; };
__device__ __forceinline__ int opaque0() { int z = 0; asm volatile("" : "+s"(z)); return z; }
#define OPQ_S(x) asm volatile("" : "+s"(x))
#define OPQ_SI(x) do { (x) = __builtin_amdgcn_readfirstlane(x); asm volatile("" : "+s"(x)); } while (0)
#define OPQ_V(x) asm volatile("" : "+v"(x))
#define INPTR(a, idx) ((a).in[(idx) + opaque0()])
enum { I_X = 0, I_UP1, I_DN1, I_LN1G, I_LN1B, I_WIN, I_MU, I_W0, I_W2, I_A0, I_A2, I_G2, I_KK, I_KA, I_RK, I_GNG, I_GNB, I_PW, I_PB, I_PS, I_PEK, I_PEV, I_CK1, I_CK2, I_CV1, I_CV2, I_GB, I_WOUT, I_LN2G, I_LN2B, I_UP2, I_DN2, I_LN3G, I_LN3B };

template <bool LN = false> __device__ __forceinline__ void transpose_item(const float* W, int K, int Nsrc, bf16* WT, int dst0, LAS float* scr, int k0, int n0, int lane, const float* lng = nullptr, const float* lnb = nullptr, float* gwp = nullptr) {
    const int c4 = lane & 15, rq = lane >> 4; const int n = n0 + 4 * c4; const bool ok = n < Nsrc;
    const float* wp = W + (size_t)(k0 + rq) * Nsrc + n;
    f32x4 sg = {0.f, 0.f, 0.f, 0.f}, sb = sg;
#pragma unroll 8
    for (int i = 0; i < 16; ++i) { f32x4 v = ok ? *(const f32x4*)(wp + (size_t)(4 * i) * Nsrc) : (f32x4){0.f, 0.f, 0.f, 0.f};
        if constexpr (LN) { const float g = lng[k0 + 4 * i + rq], b = lnb[k0 + 4 * i + rq]; sb += v * b; v = v * g; sg += v; }
        LAS float* d = scr + (4 * i + rq) * 65 + 4 * c4; d[0] = v.x; d[1] = v.y; d[2] = v.z; d[3] = v.w; }
    if constexpr (LN) {
#pragma unroll
        for (int e = 0; e < 4; ++e) { sg[e] += __shfl_xor(sg[e], 16); sg[e] += __shfl_xor(sg[e], 32); sb[e] += __shfl_xor(sb[e], 16); sb[e] += __shfl_xor(sb[e], 32); }
        if (rq == 0 && ok) {
#pragma unroll
            for (int e = 0; e < 4; ++e) {
                __hip_atomic_fetch_add((GAS float*)gwp + n + e, __builtin_rintf(sg[e] * 65536.0f) * (1.0f / 65536.0f), __ATOMIC_RELAXED, __HIP_MEMORY_SCOPE_AGENT); __hip_atomic_fetch_add((GAS float*)gwp + GWN + n + e, __builtin_rintf(sb[e] * 65536.0f) * (1.0f / 65536.0f), __ATOMIC_RELAXED, __HIP_MEMORY_SCOPE_AGENT); } } }
    LDS_WAIT();
    const int c = lane & 7;
#pragma unroll
    for (int j = 0; j < 8; ++j) { const int nn = (lane >> 3) + 8 * j; const LAS float* s = scr + (8 * c) * 65 + nn;
        u32x4 o; o.x = pk2(s[0 * 65], s[1 * 65]); o.y = pk2(s[2 * 65], s[3 * 65]); o.z = pk2(s[4 * 65], s[5 * 65]); o.w = pk2(s[6 * 65], s[7 * 65]);
        *(u32x4*)(WT + (size_t)(dst0 + nn) * K + k0 + 8 * c) = o; }
    LDS_WAIT();
}
__device__ __forceinline__ int up_dst_row(int n0) { return n0 < DFF ? 256 * (n0 / 128) + (n0 % 128) : 256 * ((n0 - DFF) / 128) + 128 + ((n0 - DFF) % 128); }

__device__ __forceinline__ void phase_wconv(const Args& a, int l, LAS unsigned char* lds, int gw, int NGW, int wave, int lane) {
    OPQ_SI(gw); OPQ_SI(wave); OPQ_V(lane);
    LAS float* scr = (LAS float*)(lds + wave * 16640);
    unsigned char* ws = a.ws + opaque0();
    float* gwl = a.rep ? (float*)(ws + WS_END - MiB) : (float*)(ws + WS_AUX + AUX_GWBW) + (size_t)l * 2 * GWN;
    {
        const int gt = gw * 64 + lane; if (gt < 3 * 2 * (DM / 4)) { const int j = gt / (2 * (DM / 4)), r2 = gt - j * 2 * (DM / 4), isb = r2 / (DM / 4), c4_ = r2 - isb * (DM / 4);
            const float* src = (j == 0 ? (isb ? INPTR(a, I_LN1B) : INPTR(a, I_LN1G)) : j == 1 ? (isb ? INPTR(a, I_LN2B) : INPTR(a, I_LN2G)) : (isb ? INPTR(a, I_LN3B) : INPTR(a, I_LN3G))) + (size_t)l * DM;
            ((f32x4*)(ws + WS_AUX + AUX_LNGB))[((size_t)(3 * l + j) * 2 + isb) * (DM / 4) + c4_] = ((const f32x4*)src)[c4_]; } }
    constexpr int I_UP = (DM / 64) * (NUP / 64), I_DN = (DFF / 64) * (DM / 64), I_IN = (DM / 64) * (INP / 64), I_OUT = (DM / 64) * (DM / 64);
    constexpr int NIT = 2 * I_UP + 2 * I_DN + I_IN + I_OUT + 12 + 12 + 24 + 16 + 256 + 8;
    for (int it = gw; it < NIT; it += NGW) {
        int r = it;
        if (r < 2 * I_UP) { const int which = r / I_UP; r -= which * I_UP; const int nblk = NUP / 64, kb = r / nblk, nb = r % nblk;
            const float* W = a.in[which ? I_UP2 : I_UP1] + (size_t)l * DM * NUP; bf16* WT = (bf16*)(ws + (which ? WS_WUP2 : WS_WUP1));
            const float* lg = which ? INPTR(a, I_LN2G) + (size_t)l * DM : (l > 0 ? INPTR(a, I_LN3G) + (size_t)(l - 1) * DM : nullptr);
            const float* lb = which ? INPTR(a, I_LN2B) + (size_t)l * DM : (l > 0 ? INPTR(a, I_LN3B) + (size_t)(l - 1) * DM : nullptr);
            if (lg) transpose_item<true>(W, DM, NUP, WT, up_dst_row(64 * nb), scr, 64 * kb, 64 * nb, lane, lg, lb, gwl + (which ? NUP + INP : 0)); else transpose_item<false>(W, DM, NUP, WT, up_dst_row(64 * nb), scr, 64 * kb, 64 * nb, lane); continue; }
        r -= 2 * I_UP;
        if (r < 2 * I_DN) { const int which = r / I_DN; r -= which * I_DN; const int nblk = DM / 64, kb = r / nblk, nb = r % nblk;
            const float* W = a.in[which ? I_DN2 : I_DN1] + (size_t)l * DFF * DM; bf16* WT = (bf16*)(ws + (which ? WS_WDN2 : WS_WDN1));
            transpose_item(W, DFF, DM, WT, 64 * nb, scr, 64 * kb, 64 * nb, lane); continue; }
        r -= 2 * I_DN;
        if (r < I_IN) { const int nblk = INP / 64, kb = r / nblk, nb = r % nblk;
            transpose_item<true>(INPTR(a, I_WIN) + (size_t)l * DM * INC, DM, INC, (bf16*)(ws + WS_WIN), 64 * nb, scr, 64 * kb, 64 * nb, lane, INPTR(a, I_LN1G) + (size_t)l * DM, INPTR(a, I_LN1B) + (size_t)l * DM, gwl + NUP); continue; }
        r -= I_IN;
        if (r < I_OUT) { const int nblk = DM / 64, kb = r / nblk, nb = r % nblk;
            transpose_item(INPTR(a, I_WOUT) + (size_t)l * DM * DM, DM, DM, (bf16*)(ws + WS_WOUT), 64 * nb, scr, 64 * kb, 64 * nb, lane); continue; }
        r -= I_OUT;
        if (r < 12) { transpose_item(INPTR(a, I_W2) + (size_t)l * 64 * DRW, 64, DRW, (bf16*)(ws + WS_W2T), 64 * r, scr, 0, 64 * r, lane); continue; } r -= 12;
        if (r < 12) { transpose_item(INPTR(a, I_A2) + (size_t)l * 64 * DRW, 64, DRW, (bf16*)(ws + WS_A2T), 64 * r, scr, 0, 64 * r, lane); continue; } r -= 12;
        if (r < 24) { const int kb = r / 12, nb = r % 12; transpose_item(INPTR(a, I_G2) + (size_t)l * 128 * DRW, 128, DRW, (bf16*)(ws + WS_G2T), 64 * nb, scr, 64 * kb, 64 * nb, lane); continue; } r -= 24;
        if (r < 16) { const int gi = r >> 2, q = r & 3, kb = q >> 1, nb = q & 1; transpose_item(INPTR(a, I_PW) + ((size_t)l * 4 + gi) * 128 * 128, 128, 128, (bf16*)(ws + WS_PWT) + gi * 128 * 128, 64 * nb, scr, 64 * kb, 64 * nb, lane); continue; } r -= 16;
        if (r < 256) { const int ten = r >> 7, q = r & 127, kb = q >> 2, nb = q & 3; transpose_item(INPTR(a, ten ? I_CV1 : I_CK1) + (size_t)l * 2048 * 256, 2048, 256, (bf16*)(ws + WS_W1T) + (size_t)ten * 256 * 2048, 64 * nb, scr, 64 * kb, 64 * nb, lane); continue; } r -= 256;
        { const int ten = r >> 2, kb = r & 3; transpose_item(INPTR(a, ten ? I_CV2 : I_CK2) + (size_t)l * 256 * 64, 256, 64, (bf16*)(ws + WS_W2CT) + (size_t)ten * 64 * 256, 0, scr, 64 * kb, 0, lane); }
    }
}

__device__ __forceinline__ void phase_prologue(const Args& a, int gtid, int NGT) {
    OPQ_V(gtid);
    const f32x4* x4 = (const f32x4*)INPTR(a, I_X); u32x2* xb = (u32x2*)(a.ws + WS_XB);
    int* xl8 = (int*)(a.ws + WS_XL8);
    for (size_t i = gtid; i < (size_t)MTOK * DM / 4; i += NGT) { const f32x4 v = x4[i]; u32x2 o; o.x = pk2(v.x, v.y); o.y = pk2(v.z, v.w); xb[i] = o;
        int w = __builtin_amdgcn_cvt_pk_bf8_f32(v.x - __builtin_bit_cast(float, o.x << 16), v.y - __builtin_bit_cast(float, o.x & 0xffff0000u), 0, false);
        w = __builtin_amdgcn_cvt_pk_bf8_f32(v.z - __builtin_bit_cast(float, o.y << 16), v.w - __builtin_bit_cast(float, o.y & 0xffff0000u), w, true); xl8[i] = w; }
    f32x2* rope = (f32x2*)(a.ws + WS_ROPE);
    for (int i = gtid; i < SEQ * 8; i += NGT) { const int s = i >> 3, k = i & 7;
        const float inv = powf(500000.0f, -(float)k * 0.125f); const float ang = (float)s * inv;
        const double ad = (double)ang; const double q = __builtin_rint(ad * 0.15915494309189535); const double rr = ad - q * 6.283185307179586;
        const float rf = (float)rr; rope[i] = (f32x2){cosf(rf), sinf(rf)}; }
}

__device__ __forceinline__ void phase_ln(const float* Y, const float* g, const float* b, float* X, bf16* XB, float* stats, int gw, int NGW, int lane) {
    OPQ_SI(gw); OPQ_V(lane);
    f32x4 gv[8], bv[8];
#pragma unroll
    for (int j = 0; j < 8; ++j) { gv[j] = ((const f32x4*)g)[64 * j + lane]; bv[j] = ((const f32x4*)b)[64 * j + lane]; }
    if (gw < NWAVES) { f32x4* gd = (f32x4*)(stats + 2 * MTOK) + gw * 64 + lane; gd[0] = ((const f32x4*)g)[gw * 64 + lane]; gd[512] = ((const f32x4*)b)[gw * 64 + lane]; }
    f32x4 nx[8];
    { const f32x4* yr0 = (const f32x4*)(Y + (size_t)(gw < MTOK ? gw : 0) * DM) + lane;
#pragma unroll
        for (int j = 0; j < 8; ++j) nx[j] = yr0[64 * j]; }
    for (int m = gw; m < MTOK; m += NGW) {
        f32x4 v[8]; float s = 0.f;
#pragma unroll
        for (int j = 0; j < 8; ++j) v[j] = nx[j];
        { const int mn = m + NGW < MTOK ? m + NGW : m; const f32x4* yrn = (const f32x4*)(Y + (size_t)mn * DM) + lane;
#pragma unroll
            for (int j = 0; j < 8; ++j) nx[j] = yrn[64 * j]; }
#pragma unroll
        for (int j = 0; j < 8; ++j) s += (v[j].x + v[j].y) + (v[j].z + v[j].w);
        const float mean = wave_sum(s) * (1.f / DM); float s2 = 0.f;
#pragma unroll
        for (int j = 0; j < 8; ++j) { v[j] = v[j] - mean; s2 += (v[j].x * v[j].x + v[j].y * v[j].y) + (v[j].z * v[j].z + v[j].w * v[j].w); }
        const float rstd = 1.f / sqrtf(wave_sum(s2) * (1.f / DM) + LN_EPS);
        if (lane == 0) *(f32x2*)(stats + 2 * (size_t)m) = (f32x2){mean, rstd};
        u32x2* xb = (u32x2*)(XB + (size_t)m * DM) + lane;
        if (X) { f32x4* xr = (f32x4*)(X + (size_t)m * DM) + lane;
#pragma unroll
            for (int j = 0; j < 8; ++j) { const f32x4 o = v[j] * rstd * gv[j] + bv[j]; xr[64 * j] = o; } }
#pragma unroll
        for (int j = 0; j < 8; ++j) { const f32x4 o = v[j] * rstd * gv[j] + bv[j]; u32x2 w; w.x = pk2(o.x, o.y); w.y = pk2(o.z, o.w); xb[64 * j] = w; }
    }
}


typedef float f32x16 __attribute__((ext_vector_type(16)));
typedef short bf16x8 __attribute__((ext_vector_type(8)));
#define MFMA32(a, b, c) __builtin_amdgcn_mfma_f32_32x32x16_bf16((a), (b), (c), 0, 0, 0)
#define WSYNC() asm volatile("s_waitcnt lgkmcnt(0)" ::: "memory")
__device__ __forceinline__ void half_swap(float x, float& lo, float& hi) { float a = x, b = x; asm volatile("s_nop 1\n\tv_permlane32_swap_b32 %0, %1" : "+v"(a), "+v"(b)); lo = a; hi = b; }
__device__ __forceinline__ float half_max(float x) { float lo, hi; half_swap(x, lo, hi); return fmaxf(lo, hi); }
__device__ __forceinline__ float half_sum(float x) { float lo, hi; half_swap(x, lo, hi); return lo + hi; }
__device__ __forceinline__ float other_half(float x, int h) { float lo, hi; half_swap(x, lo, hi); return h ? lo : hi; }
__device__ __forceinline__ unsigned cvtpk(float lo, float hi) { unsigned r; asm volatile("v_cvt_pk_bf16_f32 %0, %1, %2" : "=v"(r) : "v"(lo), "v"(hi)); return r; }
__device__ __forceinline__ float half32_sum(float v) { v = row16_sum(v); float a = v, b = v; asm volatile("s_nop 1\n\tv_permlane16_swap_b32 %0, %1" : "+v"(a), "+v"(b)); return a + b; }
__device__ __forceinline__ int vt_pos(int k) { return 16 * ((k >> 2) & 1) + 8 * (k >> 4) + 4 * ((k >> 3) & 1) + (k & 3); }
__device__ __forceinline__ float fexp(float x) { return __builtin_amdgcn_exp2f(x * 1.4426950408889634f); }
__device__ __forceinline__ float fsigmoid(float x) { return __builtin_amdgcn_rcpf(1.0f + __builtin_amdgcn_exp2f(x * -1.4426950408889634f)); }
__device__ __forceinline__ float ftanh(float x) { const float xc = fminf(fmaxf(x, -15.f), 15.f); return 1.0f - 2.0f * __builtin_amdgcn_rcpf(1.0f + __builtin_amdgcn_exp2f(xc * 2.8853900817779268f)); }
__device__ __forceinline__ float fsoftplus(float z) { return z > 20.f ? z : __builtin_amdgcn_logf(1.0f + __builtin_amdgcn_exp2f(z * 1.4426950408889634f)) * 0.6931471805599453f; }

#ifndef REP_MASK
#define REP_MASK 0
#endif
#ifndef M1_PREFETCH
#define M1_PREFETCH 1
#endif
constexpr int XP = 264, ZP = 520, HP = 264;
__device__ __forceinline__ bf16x8 lds_frag(const LAS bf16* p) { return *(const LAS bf16x8*)p; }
__device__ __forceinline__ bf16x8 cvt8(const f32x4 a, const f32x4 b) { u32x4 w; w.x = cvtpk(a.x, a.y); w.y = cvtpk(a.z, a.w); w.z = cvtpk(b.x, b.y); w.w = cvtpk(b.z, b.w); return __builtin_bit_cast(bf16x8, w); }
__device__ __forceinline__ void phase_m1(const Args& a, int l, LAS unsigned char* lds, int bid, int G, int tid, int wave, int lane) {
    OPQ_SI(bid); OPQ_V(tid); OPQ_SI(wave); lane = tid & 63;
    unsigned char* ws = a.ws + opaque0(); const float* P = (const float*)(ws + WS_P);
    const int r = lane & 31, h = lane >> 5;
    const f32x2* rope = (const f32x2*)(ws + WS_ROPE);
    for (int rp1 = 0; rp1 < (((REP_MASK) >> 22) & 1 ? 2 : 1); ++rp1)
    for (int unit = bid; unit < MTOK / 64; unit += G) {
        const int t0 = unit * 64, b = t0 >> 12, s0 = t0 & (SEQ - 1);
        LAS bf16* XL = (LAS bf16*)lds;
        LAS bf16* ZL = (LAS bf16*)(lds + 64 * XP * 2);
        { const float* mu = INPTR(a, I_MU) + (size_t)l * RWC;
#pragma unroll 8
            for (int i = tid; i < 64 * 256; i += NTHR) { const int tt = i >> 8, j = i & 255, col = 2304 + j; const int m = t0 + tt;
                const float pc = P[(size_t)m * INP + col]; const float pp = (s0 + tt) > 0 ? P[(size_t)(m - 1) * INP + col] : 0.f; const float v = pc + (pp - pc) * mu[col];
                const float f = j < 64 ? ftanh(v) : (j < 128 ? v : fsigmoid(v)); XL[tt * XP + j] = (bf16)f2bf(f); }
            {
                const int ch = tid, gi = ch >> 7, win = 2 << gi; const float* pp = P + (size_t)t0 * INP + PO_POOL + ch; float sum = 0.f;
                for (int j = 1; j < win; ++j) if (s0 - j >= 0) sum += pp[-(ptrdiff_t)j * INP];
#pragma unroll 8
                for (int tt = 0; tt < 64; ++tt) { const int s = s0 + tt; const float cur = pp[(size_t)tt * INP]; sum += cur; const int cnt = (s + 1) < win ? (s + 1) : win;
                    ZL[tt * ZP + ch] = (bf16)f2bf(sum / (float)cnt - cur); if (s - win + 1 >= 0) sum -= pp[((ptrdiff_t)tt - win + 1) * INP]; } } }
        __syncthreads();
        {
            const float* mu = INPTR(a, I_MU) + (size_t)l * RWC; const float* w0 = INPTR(a, I_W0) + (size_t)l * DRW; const float* a0 = INPTR(a, I_A0) + (size_t)l * DRW;
            const float* k_k = INPTR(a, I_KK) + (size_t)l * DRW; const float* k_a = INPTR(a, I_KA) + (size_t)l * DRW; const float* r_k = INPTR(a, I_RK) + (size_t)l * DRW;
            const bf16* W2T = (const bf16*)(ws + WS_W2T); const bf16* A2T = (const bf16*)(ws + WS_A2T); const bf16* G2T = (const bf16*)(ws + WS_G2T);
            float* vKK = (float*)(ws + WS_SV); float* vWR = (float*)(ws + WS_SV + SV_STRIDE); float* vW = (float*)(ws + WS_SV + 2 * SV_STRIDE);
            float* vKM = (float*)(ws + WS_SV + 3 * SV_STRIDE); float* vBB = (float*)(ws + WS_SV + 4 * SV_STRIDE); float* vV = (float*)(ws + WS_SV + 5 * SV_STRIDE);
            float* vG = (float*)(ws + WS_G); float* SC = (float*)(ws + WS_SC);
#pragma unroll 1
            for (int jj = 0; jj < 3; ++jj) {
                const int job = wave + 8 * jj, hd = job >> 1, th = job & 1;
                f32x16 aU[2], aA[2];
#pragma unroll
                for (int t = 0; t < 2; ++t)
#pragma unroll
                    for (int i = 0; i < 16; ++i) { aU[t][i] = 0.f; aA[t][i] = 0.f; }
                const LAS bf16* xa = XL + (32 * th + r) * XP + 8 * h;
#pragma unroll
                for (int ks = 0; ks < 4; ++ks) { const bf16x8 xt = lds_frag(xa + 16 * ks), xl = lds_frag(xa + 64 + 16 * ks);
#pragma unroll
                    for (int t = 0; t < 2; ++t) { const int c = hd * 64 + 32 * t + r;
                        aU[t] = MFMA32(xt, *(const bf16x8*)(W2T + (size_t)c * 64 + 16 * ks + 8 * h), aU[t]);
                        aA[t] = MFMA32(xl, *(const bf16x8*)(A2T + (size_t)c * 64 + 16 * ks + 8 * h), aA[t]); } }
                float pmr[2], pmk[2], pmv[2], pw0[2], pa0[2], pkk[2], pka[2], prk[2];
#pragma unroll
                for (int t = 0; t < 2; ++t) { const int c = hd * 64 + 32 * t + r; pmr[t] = mu[c]; pmk[t] = mu[768 + c]; pmv[t] = mu[1536 + c]; pw0[t] = w0[c]; pa0[t] = a0[c]; pkk[t] = k_k[c]; pka[t] = k_a[c]; prk[t] = r_k[c]; }
                const int lo_p = 4 * h * INP + hd * 64 + r, lo_s = 4 * h * DRW + hd * 64 + r;
                float ld[2][12];
#define M1_LOADROW(buf, i) do { int mr_ = t0 + 32 * th + ((i) & 3) + 8 * ((i) >> 2); OPQ_SI(mr_); const bool first_ = (s0 + 32 * th + ((i) & 3) + 8 * ((i) >> 2) + 4 * h) == 0; \
        const float* pc_ = P + (size_t)mr_ * INP; const float* pp_ = pc_ - INP; _Pragma("unroll") for (int t = 0; t < 2; ++t) { const int o = lo_p + 32 * t; \
        buf[6 * t + 0] = pc_[o]; buf[6 * t + 1] = pc_[o + 768]; buf[6 * t + 2] = pc_[o + 1536]; buf[6 * t + 3] = first_ ? 0.f : pp_[o]; buf[6 * t + 4] = first_ ? 0.f : pp_[o + 768]; buf[6 * t + 5] = first_ ? 0.f : pp_[o + 1536]; } } while (0)
                M1_LOADROW(ld[0], 0);
#pragma unroll
                for (int i = 0; i < 16; ++i) {
#if M1_PREFETCH
                    if (i + 1 < 16) M1_LOADROW(ld[(i + 1) & 1], i + 1);
#else
                    if (i > 0) M1_LOADROW(ld[i & 1], i);
#endif
                    int mrow = t0 + 32 * th + (i & 3) + 8 * (i >> 2); OPQ_SI(mrow);
                    float rr[2], kv[2], vv[2], dec[2], av[2], kr[2], km[2];
                    float ss = 0.f, s1 = 0.f, s2 = 0.f, s3 = 0.f;
#pragma unroll
                    for (int t = 0; t < 2; ++t) { const float* L = ld[i & 1] + 6 * t;
                        const float rc = L[0], kc = L[1], vc = L[2], rp = L[3], kp = L[4], vp = L[5];
                        rr[t] = rc + (rp - rc) * pmr[t]; kv[t] = kc + (kp - kc) * pmk[t]; vv[t] = vc + (vp - vc) * pmv[t];
                        const float uu = pw0[t] + aU[t][i]; const float z = -uu; const float sp = fsoftplus(z); dec[t] = fexp(-fexp(-sp - 0.5f));
                        av[t] = fsigmoid(pa0[t] + aA[t][i]);
                        kr[t] = kv[t] * pkk[t]; km[t] = kv[t] * (1.0f + (av[t] - 1.0f) * pka[t]);
                        ss += kr[t] * kr[t]; s1 += kr[t] * av[t] * rr[t]; s2 += km[t] * rr[t]; s3 += rr[t] * km[t] * prk[t]; }
                    ss = half32_sum(ss); s1 = half32_sum(s1); s2 = half32_sum(s2); s3 = half32_sum(s3);
                    const float invn = 1.0f / fmaxf(sqrtf(ss), 1e-12f);
                    const size_t ro = (size_t)mrow * DRW;
#pragma unroll
                    for (int t = 0; t < 2; ++t) { const int o = lo_s + 32 * t; const float kk = kr[t] * invn;
                        (vKK + ro)[o] = kk; (vWR + ro)[o] = dec[t] * rr[t]; (vW + ro)[o] = dec[t]; (vKM + ro)[o] = km[t]; (vBB + ro)[o] = kk * av[t]; (vV + ro)[o] = vv[t]; }
                    if (r == 0) *(f32x4*)(SC + ((size_t)mrow * 12 + hd) * 4 + 4 * h * 48) = (f32x4){s1 * invn, s2, s3, 0.f};
                    asm volatile("" ::: "memory");
                }
#undef M1_LOADROW
                { f32x16 aG[2];
#pragma unroll
                    for (int t = 0; t < 2; ++t)
#pragma unroll
                        for (int i = 0; i < 16; ++i) aG[t][i] = 0.f;
#pragma unroll
                    for (int ks = 0; ks < 8; ++ks) { const bf16x8 xg = lds_frag(xa + 128 + 16 * ks);
#pragma unroll
                        for (int t = 0; t < 2; ++t) { const int c = hd * 64 + 32 * t + r; aG[t] = MFMA32(xg, *(const bf16x8*)(G2T + (size_t)c * 128 + 16 * ks + 8 * h), aG[t]); } }
#pragma unroll
                    for (int i = 0; i < 16; ++i) { int mrow = t0 + 32 * th + (i & 3) + 8 * (i >> 2); OPQ_SI(mrow); float* gp = vG + (size_t)mrow * DRW;
#pragma unroll
                        for (int t = 0; t < 2; ++t) gp[lo_s + 32 * t] = aG[t][i]; } }
            }
        }
        {
            int lane_b = lane; OPQ_V(lane_b); const int r = lane_b & 31, h = lane_b >> 5;
            const int gi = wave >> 1, th = wave & 1; const bf16* PWT = (const bf16*)(ws + WS_PWT) + gi * 128 * 128;
            const float* pb = INPTR(a, I_PB) + (size_t)l * DPOOL + gi * 128; const float* psc = INPTR(a, I_PS) + (size_t)l * DPOOL + gi * 128; bf16* CAT = (bf16*)(ws + WS_CAT);
            f32x16 acc[4];
#pragma unroll
            for (int t = 0; t < 4; ++t)
#pragma unroll
                for (int i = 0; i < 16; ++i) acc[t][i] = 0.f;
            const LAS bf16* za = ZL + (32 * th + r) * ZP + gi * 128 + 8 * h;
#pragma unroll
            for (int ks = 0; ks < 8; ++ks) { const bf16x8 zf = lds_frag(za + 16 * ks);
#pragma unroll
                for (int t = 0; t < 4; ++t) acc[t] = MFMA32(zf, *(const bf16x8*)(PWT + (size_t)(32 * t + r) * 128 + 16 * ks + 8 * h), acc[t]); }
#pragma unroll
            for (int t = 0; t < 4; ++t) { const int d = 32 * t + r; const float bv = pb[d], sv = psc[d];
#pragma unroll
                for (int i = 0; i < 16; ++i) { const int m = t0 + 32 * th + (i & 3) + 8 * (i >> 2) + 4 * h; CAT[(size_t)m * DM + DRW + gi * 128 + d] = (bf16)f2bf((acc[t][i] + bv) * sv); } }
        }
        __syncthreads();
        {
            int tid_c = tid; OPQ_V(tid_c); const int tid = tid_c;
            bf16* QR = (bf16*)(ws + WS_QR); bf16* KS = (bf16*)(ws + WS_KS); bf16* KW = (bf16*)(ws + WS_KW); bf16* VST = (bf16*)(ws + WS_VST); bf16* VWT = (bf16*)(ws + WS_VWT);
            LAS float* T0 = (LAS float*)lds; LAS float* T1 = T0 + 64 * 193;
#pragma unroll 1
            for (int c = tid; c < 1152; c += NTHR) {
                int src; float scale = 1.f; const int d = c & 63; const bool isq = c < 768; const int cc = isq ? c : (c < 960 ? c - 768 : c - 960);
                bf16* dbase;
                if (isq) { src = PO_Q + c; dbase = QR + (size_t)t0 * 768 + c; scale = 0.125f * 1.4426950408889634f; }
                else if (c < 960) { src = PO_KS + cc; dbase = KS + ((size_t)(b * 3 + (cc >> 6)) * SEQ + s0) * 64 + (cc & 63); }
                else { src = PO_KW + cc; dbase = KW + ((size_t)(b * 3 + (cc >> 6)) * SEQ + s0) * 64 + (cc & 63); }
                const int dstep = isq ? 768 : 64; const bool rot = d < 16; const int po = d < 8 ? 8 : -8; const float sg = d < 8 ? -1.f : 1.f;
                const float* pr = P + (size_t)t0 * INP + src; const f32x2* rp = rope + s0 * 8 + (d & 7);
#pragma unroll 1
                for (int t8 = 0; t8 < 64; t8 += 8) { float v[8], pv[8]; f32x2 cs[8];
#pragma unroll
                    for (int e = 0; e < 8; ++e) { v[e] = pr[(size_t)(t8 + e) * INP]; pv[e] = pr[(size_t)(t8 + e) * INP + (rot ? po : 0)]; cs[e] = rp[(t8 + e) * 8]; }
#pragma unroll
                    for (int e = 0; e < 8; ++e) { const float o = rot ? v[e] * cs[e].x + sg * pv[e] * cs[e].y : v[e]; dbase[(size_t)(t8 + e) * dstep] = (bf16)f2bf(o * scale); } } }
            if (tid < 384) { const int c = tid; const float* pr = P + (size_t)t0 * INP + (c < 192 ? PO_VS + c : PO_VW + (c - 192)); LAS float* td = c < 192 ? T0 + c : T1 + (c - 192);
#pragma unroll 1
                for (int t8 = 0; t8 < 64; t8 += 16) { float v[16];
#pragma unroll
                    for (int e = 0; e < 16; ++e) v[e] = pr[(size_t)(t8 + e) * INP];
#pragma unroll
                    for (int e = 0; e < 16; ++e) td[(t8 + e) * 193] = v[e]; } }
            __syncthreads();
            for (int i = tid; i < 384 * 64; i += NTHR) { const int c2 = i >> 6, tok = i & 63; const int which = c2 >= 192, c = which ? c2 - 192 : c2;
                const float v = (which ? T1 : T0)[tok * 193 + c]; const int sk = s0 + tok;
                bf16* dst = (which ? VWT : VST) + (((size_t)(b * 3 + (c >> 6)) * 128 + (sk >> 5)) * 64 + (c & 63)) * 32 + vt_pos(sk & 31); *dst = (bf16)f2bf(v); }
        }
        __syncthreads();
    }
    {
        int lane_d = lane; OPQ_V(lane_d); const int r = lane_d & 31, h = lane_d >> 5;
        LAS bf16* HL = (LAS bf16*)lds;
        bf16* KC = (bf16*)(ws + WS_KC); bf16* VCT = (bf16*)(ws + WS_VCT);
        for (int rp2 = 0; rp2 < (((REP_MASK) >> 23) & 1 ? 2 : 1); ++rp2)
        for (int u = bid; u < 2 * NB * 3 * 8; u += G) {
            const int ten = u / 96, q = u - ten * 96, b = q / 24, q2 = q - b * 24, hh = q2 >> 3, nt = q2 & 7, n0 = 32 * nt;
            const bf16* W1T = (const bf16*)(ws + WS_W1T) + (size_t)ten * 256 * 2048 + (size_t)(32 * wave + r) * 2048 + 8 * h;
            const int tk0 = 16 * (n0 + r);
            const float* pa = P + ((size_t)b * SEQ + tk0) * INP + (ten ? PO_VC : PO_KC) + hh * 64 + 8 * h;
            const float* pep = INPTR(a, ten ? I_PEV : I_PEK) + (size_t)l * 2048 + 8 * h;
            f32x16 acc;
#pragma unroll
            for (int i = 0; i < 16; ++i) acc[i] = 0.f;
            f32x4 xa[2][8]; bf16x8 wb[2][4];
#define CMP_LOAD(sl, ll) do { const bool ok_ = tk0 + (ll) < SEQ; const float* pl_ = pa + (size_t)(ll) * INP; const float* pe_ = pep + 64 * (ll); _Pragma("unroll") for (int ds = 0; ds < 4; ++ds) { \
        xa[sl][2 * ds] = (ok_ ? *(const f32x4*)(pl_ + 16 * ds) : (f32x4){0.f, 0.f, 0.f, 0.f}) + *(const f32x4*)(pe_ + 16 * ds); xa[sl][2 * ds + 1] = (ok_ ? *(const f32x4*)(pl_ + 16 * ds + 4) : (f32x4){0.f, 0.f, 0.f, 0.f}) + *(const f32x4*)(pe_ + 16 * ds + 4); \
        wb[sl][ds] = *(const bf16x8*)(W1T + 64 * (ll) + 16 * ds); } } while (0)
            CMP_LOAD(0, 0);
#pragma unroll 1
            for (int ll = 0; ll < 32; ll += 2) {
                CMP_LOAD(1, ll + 1);
#pragma unroll
                for (int ds = 0; ds < 4; ++ds) acc = MFMA32(cvt8(xa[0][2 * ds], xa[0][2 * ds + 1]), wb[0][ds], acc);
                if (ll + 2 < 32) CMP_LOAD(0, ll + 2);
#pragma unroll
                for (int ds = 0; ds < 4; ++ds) acc = MFMA32(cvt8(xa[1][2 * ds], xa[1][2 * ds + 1]), wb[1][ds], acc);
            }
#undef CMP_LOAD
            {
#pragma unroll
                for (int i = 0; i < 16; ++i) { const float x = acc[i]; const float gl = 0.5f * x * (1.0f + ftanh(0.7978845608028654f * (x + 0.044715f * x * x * x)));
                    HL[((i & 3) + 8 * (i >> 2) + 4 * h) * HP + 32 * wave + r] = (bf16)f2bf(gl); } }
            __syncthreads();
            if (wave < 2) {
                const bf16* W2CT = (const bf16*)(ws + WS_W2CT) + (size_t)ten * 64 * 256 + (size_t)(32 * wave + r) * 256 + 8 * h;
                f32x16 o;
#pragma unroll
                for (int i = 0; i < 16; ++i) o[i] = 0.f;
                const LAS bf16* ha = HL + r * HP + 8 * h;
#pragma unroll
                for (int ks = 0; ks < 16; ++ks) o = MFMA32(lds_frag(ha + 16 * ks), *(const bf16x8*)(W2CT + 16 * ks), o);
                const int d = 32 * wave + r;
#pragma unroll
                for (int i = 0; i < 16; ++i) { const int n = n0 + (i & 3) + 8 * (i >> 2) + 4 * h; float v = o[i];
                    if (ten == 0) { const float other = dpp_f<0x128>(v);
                        if (wave == 0 && r < 16) { const f32x2 cs = rope[((16 * n + 31) & (SEQ - 1)) * 8 + (r & 7)]; v = r < 8 ? v * cs.x - other * cs.y : v * cs.x + other * cs.y; }
                        if (n < NCMP) KC[((size_t)(b * 3 + hh) * NCMPP + n) * 64 + d] = (bf16)f2bf(v); }
                    else if (n < NCMP) VCT[(((size_t)(b * 3 + hh) * 8 + (n >> 5)) * 64 + d) * 32 + vt_pos(n & 31)] = (bf16)f2bf(v); }
            }
            __syncthreads();
        }
    }
}

constexpr int SPX = 72;
__device__ __forceinline__ void phase_scan_prep(const Args& a, LAS unsigned char* lds, int gw, int NGW, int wave, int lane) {
    OPQ_SI(gw); OPQ_SI(wave); OPQ_V(lane);
    unsigned char* ws = a.ws + opaque0();
    LAS unsigned char* wl = lds + wave * 16384;
    LAS bf16* XA = (LAS bf16*)wl; LAS bf16* XR = XA + 16 * SPX; LAS bf16* XB_ = XR + 16 * SPX; LAS bf16* XK = XB_ + 16 * SPX;
    LAS float* GB = (LAS float*)(wl + 4 * 16 * SPX * 2); LAS float* GK = GB + 256; LAS float* HB = GK + 256; LAS float* HK = HB + 256; LAS float* NM = HK + 256;
    const int r = lane & 31, h = lane >> 5;
    const GAS float* vKK = (const GAS float*)(ws + WS_SV); const GAS float* vWR = (const GAS float*)(ws + WS_SV + SV_STRIDE); const GAS float* vW = (const GAS float*)(ws + WS_SV + 2 * SV_STRIDE);
    const GAS float* vKM = (const GAS float*)(ws + WS_SV + 3 * SV_STRIDE); const GAS float* vBB = (const GAS float*)(ws + WS_SV + 4 * SV_STRIDE); const GAS float* vV = (const GAS float*)(ws + WS_SV + 5 * SV_STRIDE);
#pragma unroll 1
    for (int item = gw; item < NB * 12 * 256; item += NGW) {
        const int hd = item >> 8, c = item & 255, b = hd / 12, hh = hd - b * 12;
        const size_t o0 = ((size_t)b * SEQ + 16 * c) * DRW + hh * 64 + lane;
        GAS unsigned char* rec = (GAS unsigned char*)(ws + WS_SPREC) + (size_t)item * SPREC_BYTES;
        float al[16], rh[16], be[16], ka[16], vv[16]; float g = 1.f;
#pragma unroll
        for (int t = 0; t < 16; ++t) { const size_t o = o0 + (size_t)t * DRW; const float w = vW[o], kk = vKK[o], bb = vBB[o], km = vKM[o], wr = vWR[o]; vv[t] = vV[o];
            al[t] = g * kk; rh[t] = g * wr; g *= w; const float ig = 1.0f / g; be[t] = bb * ig; ka[t] = km * ig; }
#pragma unroll
        for (int t = 0; t < 16; ++t) { XA[t * SPX + lane] = (bf16)f2bf(al[t]); XR[t * SPX + lane] = (bf16)f2bf(rh[t]); XB_[t * SPX + lane] = (bf16)f2bf(be[t]); XK[t * SPX + lane] = (bf16)f2bf(ka[t]); }
#pragma unroll
        for (int hp = 0; hp < 2; ++hp) {
            u32x4 wb, wk, wv;
            wb.x = cvtpk(be[4 * hp + 0], be[4 * hp + 1]); wb.y = cvtpk(be[4 * hp + 2], be[4 * hp + 3]); wb.z = cvtpk(be[8 + 4 * hp + 0], be[8 + 4 * hp + 1]); wb.w = cvtpk(be[8 + 4 * hp + 2], be[8 + 4 * hp + 3]);
            wk.x = cvtpk(ka[4 * hp + 0], ka[4 * hp + 1]); wk.y = cvtpk(ka[4 * hp + 2], ka[4 * hp + 3]); wk.z = cvtpk(ka[8 + 4 * hp + 0], ka[8 + 4 * hp + 1]); wk.w = cvtpk(ka[8 + 4 * hp + 2], ka[8 + 4 * hp + 3]);
            wv.x = cvtpk(vv[4 * hp + 0], vv[4 * hp + 1]); wv.y = cvtpk(vv[4 * hp + 2], vv[4 * hp + 3]); wv.z = cvtpk(vv[8 + 4 * hp + 0], vv[8 + 4 * hp + 1]); wv.w = cvtpk(vv[8 + 4 * hp + 2], vv[8 + 4 * hp + 3]);
            *(GAS u32x4*)(rec + 4096 + ((h * 2 + hp) * 32 + r) * 16) = wb; *(GAS u32x4*)(rec + 6144 + ((h * 2 + hp) * 32 + r) * 16) = wk;
            *(GAS u32x4*)(rec + 9216 + h * 3072 + 2048 + (hp * 32 + r) * 16) = wv; }
        *(GAS float*)(rec + 8704 + ((h * 2 + ((r >> 2) & 1)) * 16 + (r & 3) + 4 * (r >> 3)) * 4) = g;
        WSYNC();
        const bool lo16 = r < 16; const bf16x8 zf = {0, 0, 0, 0, 0, 0, 0, 0};
#define SP_GRAM(X1, X2, OUT, INCL) do { f32x16 D; _Pragma("unroll") for (int i = 0; i < 16; ++i) D[i] = 0.f; \
            _Pragma("unroll") for (int ks = 0; ks < 4; ++ks) { const bf16x8 fa = lo16 ? *(const LAS bf16x8*)(X1 + r * SPX + 16 * ks + 8 * h) : zf, fb = lo16 ? *(const LAS bf16x8*)(X2 + r * SPX + 16 * ks + 8 * h) : zf; D = MFMA32(fa, fb, D); } \
            if (lo16) { _Pragma("unroll") for (int i = 0; i < 8; ++i) { const int t = (i & 3) + 8 * (i >> 2) + 4 * h; OUT[t * 16 + r] = (INCL ? r <= t : r < t) ? D[i] : 0.f; } } } while (0)
        SP_GRAM(XA, XB_, GB, false); SP_GRAM(XA, XK, GK, false); SP_GRAM(XR, XB_, HB, true); SP_GRAM(XR, XK, HK, true);
#undef SP_GRAM
        WSYNC();
        { const int cc = lane & 15; float n[16];
#pragma unroll
            for (int t = 0; t < 16; ++t) { float acc = t == cc ? 1.f : 0.f;
#pragma unroll
                for (int s2 = 0; s2 < t; ++s2) acc -= GB[t * 16 + s2] * n[s2];
                n[t] = acc; }
            if (lane < 16) {
#pragma unroll
                for (int t = 0; t < 16; ++t) NM[t * 16 + cc] = n[t]; } }
        if (lo16) { u32x4 w_; const LAS float* hr = HB + r * 16 + 4 * h;
            w_.x = cvtpk(hr[0], hr[1]); w_.y = cvtpk(hr[2], hr[3]); w_.z = cvtpk(hr[8], hr[9]); w_.w = cvtpk(hr[10], hr[11]); *(GAS u32x4*)(rec + 8192 + (h * 16 + r) * 16) = w_; }
        WSYNC();
        { float ap[16];
#pragma unroll
            for (int t = 0; t < 16; ++t) { float acc = 0.f;
#pragma unroll
                for (int s2 = 0; s2 <= t; ++s2) acc = fmaf(NM[t * 16 + s2], al[s2], acc);
                ap[t] = acc; }
#pragma unroll
            for (int t = 0; t < 16; ++t) XA[t * SPX + lane] = (bf16)f2bf(ap[t]); }
        WSYNC();
        if (lo16) {
#pragma unroll
            for (int ks = 0; ks < 4; ++ks) { const LAS bf16* pa = XA + r * SPX + 16 * ks + 4 * h; const LAS bf16* pr = XR + r * SPX + 16 * ks + 4 * h;
                const u32x2 a0 = *(const LAS u32x2*)pa, a1 = *(const LAS u32x2*)(pa + 8), r0 = *(const LAS u32x2*)pr, r1 = *(const LAS u32x2*)(pr + 8);
                *(GAS u32x4*)(rec + ((ks * 2 + h) * 16 + r) * 16) = (u32x4){a0.x, a0.y, a1.x, a1.y}; *(GAS u32x4*)(rec + 2048 + ((ks * 2 + h) * 16 + r) * 16) = (u32x4){r0.x, r0.y, r1.x, r1.y}; } }
        { float wq[16], p1[16], yk[16];
#pragma unroll
            for (int t = 0; t < 16; ++t) { float acc = 0.f, acy = 0.f;
#pragma unroll
                for (int s2 = 0; s2 <= t; ++s2) { if (s2 < t) acc = fmaf(GK[t * 16 + s2], vv[s2], acc); acy = fmaf(HK[t * 16 + s2], vv[s2], acy); }
                wq[t] = acc; yk[t] = acy; }
#pragma unroll
            for (int t = 0; t < 16; ++t) { float acc = 0.f;
#pragma unroll
                for (int s2 = 0; s2 <= t; ++s2) acc = fmaf(NM[t * 16 + s2], wq[s2], acc);
                p1[t] = acc; }
            GAS unsigned char* rv = rec + 9216 + h * 3072;
#pragma unroll
            for (int hq = 0; hq < 2; ++hq) { u32x4 wp, wy;
                wp.x = cvtpk(p1[4 * hq + 0], p1[4 * hq + 1]); wp.y = cvtpk(p1[4 * hq + 2], p1[4 * hq + 3]); wp.z = cvtpk(p1[8 + 4 * hq + 0], p1[8 + 4 * hq + 1]); wp.w = cvtpk(p1[8 + 4 * hq + 2], p1[8 + 4 * hq + 3]);
                wy.x = cvtpk(yk[4 * hq + 0], yk[4 * hq + 1]); wy.y = cvtpk(yk[4 * hq + 2], yk[4 * hq + 3]); wy.z = cvtpk(yk[8 + 4 * hq + 0], yk[8 + 4 * hq + 1]); wy.w = cvtpk(yk[8 + 4 * hq + 2], yk[8 + 4 * hq + 3]);
                *(GAS u32x4*)(rv + (hq * 32 + r) * 16) = wp; *(GAS u32x4*)(rv + 1024 + (hq * 32 + r) * 16) = wy; } }
        WSYNC();
    }
}
__device__ __forceinline__ void scan_seq(const Args& a, LAS unsigned char* lds, int grp, int lane) {
    OPQ_SI(grp); OPQ_V(lane);
    __builtin_amdgcn_s_setprio(3);
    unsigned char* ws = a.ws + opaque0();
    const int hd = grp % 48, vt = grp / 48, b = hd / 12, hh = hd - b * 12;
    const int r = lane & 31, h = lane >> 5; const bool lo16 = r < 16;
    LAS unsigned char* RS = lds + 16384;
    const GAS unsigned char* recs = (const GAS unsigned char*)(ws + WS_SPREC) + (size_t)hd * 256 * SPREC_BYTES;
    GAS float* yp = (GAS float*)(ws + WS_YS) + (size_t)b * SEQ * DRW + hh * 64 + 32 * vt + r;
    const bf16x8 zf = {0, 0, 0, 0, 0, 0, 0, 0};
    f32x16 T0, T1;
#pragma unroll
    for (int i = 0; i < 16; ++i) { T0[i] = 0.f; T1[i] = 0.f; }
#define SQ_DMA(slot, ck) do { const GAS unsigned char* rp_ = recs + (size_t)(ck) * SPREC_BYTES + lane * 16; LAS unsigned char* ls_ = RS + (slot) * 12288; \
        _Pragma("unroll") for (int q = 0; q < 9; ++q) __builtin_amdgcn_global_load_lds((const unsigned*)(rp_ + 1024 * q), (LAS unsigned*)(ls_ + 1024 * q), 16, 0, 0); \
        _Pragma("unroll") for (int q = 0; q < 3; ++q) __builtin_amdgcn_global_load_lds((const unsigned*)(rp_ + 9216 + 3072 * vt + 1024 * q), (LAS unsigned*)(ls_ + 9216 + 1024 * q), 16, 0, 0); } while (0)
    SQ_DMA(0, 0); SQ_DMA(1, 1);
#pragma unroll 1
    for (int ck = 0; ck < 256; ++ck) {
        const LAS unsigned char* L = RS + (ck & 1) * 12288;
        if (ck == 0) asm volatile("s_waitcnt vmcnt(12)" ::: "memory"); else if (ck + 1 < 256) asm volatile("s_waitcnt vmcnt(20)" ::: "memory"); else asm volatile("s_waitcnt vmcnt(0)" ::: "memory");
        bf16x8 tb[4];
#pragma unroll
        for (int s2 = 0; s2 < 2; ++s2) { u32x4 w0, w1;
            w0.x = cvtpk(T0[8 * s2], T0[8 * s2 + 1]); w0.y = cvtpk(T0[8 * s2 + 2], T0[8 * s2 + 3]); w0.z = cvtpk(T0[8 * s2 + 4], T0[8 * s2 + 5]); w0.w = cvtpk(T0[8 * s2 + 6], T0[8 * s2 + 7]);
            w1.x = cvtpk(T1[8 * s2], T1[8 * s2 + 1]); w1.y = cvtpk(T1[8 * s2 + 2], T1[8 * s2 + 3]); w1.z = cvtpk(T1[8 * s2 + 4], T1[8 * s2 + 5]); w1.w = cvtpk(T1[8 * s2 + 6], T1[8 * s2 + 7]);
            tb[s2] = __builtin_bit_cast(bf16x8, w0); tb[2 + s2] = __builtin_bit_cast(bf16x8, w1); }
        f32x16 aU, aY;
#pragma unroll
        for (int i = 0; i < 16; ++i) { aU[i] = 0.f; aY[i] = 0.f; }
        { const u32x4 yk = *(const LAS u32x4*)(L + 9216 + 1024 + lane * 16);
            aY[0] = __builtin_bit_cast(float, yk.x << 16); aY[1] = __builtin_bit_cast(float, yk.x & 0xffff0000u); aY[2] = __builtin_bit_cast(float, yk.y << 16); aY[3] = __builtin_bit_cast(float, yk.y & 0xffff0000u);
            aY[4] = __builtin_bit_cast(float, yk.z << 16); aY[5] = __builtin_bit_cast(float, yk.z & 0xffff0000u); aY[6] = __builtin_bit_cast(float, yk.w << 16); aY[7] = __builtin_bit_cast(float, yk.w & 0xffff0000u); }
#pragma unroll
        for (int ks = 0; ks < 4; ++ks) { const bf16x8 fa = lo16 ? *(const LAS bf16x8*)(L + ((ks * 2 + h) * 16 + r) * 16) : zf, fr = lo16 ? *(const LAS bf16x8*)(L + 2048 + ((ks * 2 + h) * 16 + r) * 16) : zf;
            aU = MFMA32(fa, tb[ks], aU); aY = MFMA32(fr, tb[ks], aY); }
        bf16x8 ub;
        { const u32x4 p1 = *(const LAS u32x4*)(L + 9216 + lane * 16); float u[8];
            u[0] = -aU[0] - __builtin_bit_cast(float, p1.x << 16); u[1] = -aU[1] - __builtin_bit_cast(float, p1.x & 0xffff0000u); u[2] = -aU[2] - __builtin_bit_cast(float, p1.y << 16); u[3] = -aU[3] - __builtin_bit_cast(float, p1.y & 0xffff0000u);
            u[4] = -aU[4] - __builtin_bit_cast(float, p1.z << 16); u[5] = -aU[5] - __builtin_bit_cast(float, p1.z & 0xffff0000u); u[6] = -aU[6] - __builtin_bit_cast(float, p1.w << 16); u[7] = -aU[7] - __builtin_bit_cast(float, p1.w & 0xffff0000u);
            u32x4 w_; w_.x = cvtpk(u[0], u[1]); w_.y = cvtpk(u[2], u[3]); w_.z = cvtpk(u[4], u[5]); w_.w = cvtpk(u[6], u[7]); ub = __builtin_bit_cast(bf16x8, w_); }
        { const bf16x8 fh = lo16 ? *(const LAS bf16x8*)(L + 8192 + (h * 16 + r) * 16) : zf; aY = MFMA32(fh, ub, aY); }
        { const bf16x8 fv = *(const LAS bf16x8*)(L + 9216 + 2048 + lane * 16);
            const bf16x8 b0 = *(const LAS bf16x8*)(L + 4096 + lane * 16), b1 = *(const LAS bf16x8*)(L + 4096 + 1024 + lane * 16), k0 = *(const LAS bf16x8*)(L + 6144 + lane * 16), k1 = *(const LAS bf16x8*)(L + 6144 + 1024 + lane * 16);
            T0 = MFMA32(b0, ub, T0); T1 = MFMA32(b1, ub, T1); T0 = MFMA32(k0, fv, T0); T1 = MFMA32(k1, fv, T1);
#pragma unroll
            for (int q = 0; q < 4; ++q) { const f32x4 g0 = *(const LAS f32x4*)(L + 8704 + (h * 16 + 4 * q) * 4), g1 = *(const LAS f32x4*)(L + 8704 + ((2 + h) * 16 + 4 * q) * 4);
                T0[4 * q] *= g0.x; T0[4 * q + 1] *= g0.y; T0[4 * q + 2] *= g0.z; T0[4 * q + 3] *= g0.w; T1[4 * q] *= g1.x; T1[4 * q + 1] *= g1.y; T1[4 * q + 2] *= g1.z; T1[4 * q + 3] *= g1.w; } }
#pragma unroll
        for (int i = 0; i < 8; ++i) yp[((size_t)ck * 16 + (i & 3) + 8 * (i >> 2) + 4 * h) * DRW] = aY[i];
        asm volatile("s_waitcnt lgkmcnt(0)" ::: "memory");
        if (ck + 2 < 256) SQ_DMA(ck & 1, ck + 2);
    }
#undef SQ_DMA
    asm volatile("s_waitcnt vmcnt(0)" ::: "memory");
    __builtin_amdgcn_s_setprio(0);
}

template <bool WITH_V> __device__ __forceinline__ void dma_tile(LAS unsigned char* RW, const bf16* Kb, int key0, unsigned koff, const bf16* Vt, unsigned voff) {
    const char* kp = (const char*)(Kb + (size_t)key0 * 64) + koff;
#pragma unroll
    for (int q = 0; q < 4; ++q) __builtin_amdgcn_global_load_lds((const unsigned*)(kp + 1024 * q), (LAS unsigned*)(RW + q * 1024), 16, 0, 0);
    if (WITH_V) { const char* vp = (const char*)(Vt + (size_t)(key0 >> 5) * 2048) + voff;
#pragma unroll
        for (int q = 0; q < 4; ++q) __builtin_amdgcn_global_load_lds((const unsigned*)(vp + 1024 * q), (LAS unsigned*)(RW + (4 + q) * 1024), 16, 0, 0); }
}
template <bool WITH_V> __device__ __forceinline__ void read_tile(const LAS unsigned char* RW, unsigned krd, unsigned vrd, bf16x8 (&kf)[4], bf16x8 (&vf)[2][2], bool younger) {
    if (younger) { if (WITH_V) asm volatile("s_waitcnt vmcnt(8)" ::: "memory"); else asm volatile("s_waitcnt vmcnt(4)" ::: "memory"); } else asm volatile("s_waitcnt vmcnt(0)" ::: "memory");
    const int rk = (krd >> 7) & 7, hh = krd & 1;
#pragma unroll
    for (int ks = 0; ks < 4; ++ks) kf[ks] = *(const LAS bf16x8*)(RW + (krd & ~1u) + (((2 * ks + hh) ^ rk) << 4));
    if (WITH_V) {
#pragma unroll
        for (int q = 0; q < 4; ++q) { const int dt = q >> 1, s = q & 1; const unsigned row = (vrd >> 6) + 32 * dt; vf[dt][s] = *(const LAS bf16x8*)(RW + 4096 + row * 64 + ((((2 * hh + s)) ^ ((row >> 2) & 3)) << 4)); } }
    asm volatile("s_waitcnt lgkmcnt(0)" ::: "memory");
}
__device__ __forceinline__ f32x16 qk_tile(const bf16x8 (&kf)[4], const bf16x8 (&qf)[4]) {
    f32x16 S;
#pragma unroll
    for (int i = 0; i < 16; ++i) S[i] = 0.f;
#pragma unroll
    for (int ks = 0; ks < 4; ++ks) S = MFMA32(kf[ks], qf[ks], S);
    return S;
}
__device__ __forceinline__ void pv_tile(const float (&p)[16], const bf16x8 (&vf)[2][2], f32x16 (&O)[2]) {
#pragma unroll
    for (int s = 0; s < 2; ++s) { u32x4 w; w.x = cvtpk(p[8 * s], p[8 * s + 1]); w.y = cvtpk(p[8 * s + 2], p[8 * s + 3]); w.z = cvtpk(p[8 * s + 4], p[8 * s + 5]); w.w = cvtpk(p[8 * s + 6], p[8 * s + 7]);
        const bf16x8 pf = __builtin_bit_cast(bf16x8, w);
#pragma unroll
        for (int dt = 0; dt < 2; ++dt) O[dt] = MFMA32(vf[dt][s], pf, O[dt]); }
}
__device__ __forceinline__ void att_rest(f32x16& S, const bf16x8 (&vf)[2][2], int key0, int h, bool masked, int klo, int khi, bool colsel, float& m, float& l, f32x16 (&O)[2]) {
    if (masked) { const int kb = key0 + 4 * h;
#pragma unroll
        for (int i = 0; i < 16; ++i) { const int key = kb + (i & 3) + 8 * (i >> 2); S[i] = (key <= khi && key >= klo) ? S[i] : -INFINITY; } }
    float tmax = fmaxf(fmaxf(fmaxf(S[0], S[1]), fmaxf(S[2], S[3])), fmaxf(fmaxf(S[4], S[5]), fmaxf(S[6], S[7])));
    tmax = fmaxf(tmax, fmaxf(fmaxf(fmaxf(S[8], S[9]), fmaxf(S[10], S[11])), fmaxf(fmaxf(S[12], S[13]), fmaxf(S[14], S[15]))));
    tmax = half_max(tmax); tmax = colsel ? tmax : -INFINITY;
    if (__builtin_amdgcn_ballot_w64(tmax > m + 8.0f) != 0ull) {
        const float mn = fmaxf(m, tmax); const float ms = mn == -INFINITY ? 0.f : mn; const float alpha = __builtin_amdgcn_exp2f(m - ms);
        l *= alpha; m = mn;
#pragma unroll
        for (int dt = 0; dt < 2; ++dt)
#pragma unroll
            for (int i = 0; i < 16; ++i) O[dt][i] *= alpha;
    }
    float msx = m == -INFINITY ? 0.f : m; msx = colsel ? msx : INFINITY;
    float p[16]; float ps = 0.f;
#pragma unroll
    for (int i = 0; i < 16; ++i) { p[i] = __builtin_amdgcn_exp2f(S[i] - msx); ps += p[i]; }
    l += half_sum(ps);
    pv_tile(p, vf, O);
}
constexpr int NSA_RING0 = 16384;
static_assert(NSA_RING0 + 8 * 16384 <= LDS_SCRATCH, "attention LDS map");
__device__ __forceinline__ void phase_nsa(const Args& a, int qi, int l, LAS unsigned char* lds, int slot, int lane) {
    OPQ_SI(slot); OPQ_V(lane);
    unsigned char* ws = a.ws + opaque0();
    LAS float* impl = (LAS float*)(lds + slot * 2048);
    LAS unsigned char* RW = lds + NSA_RING0 + slot * 16384;
    const bf16* QR = (const bf16*)(ws + WS_QR); const float* P = (const float*)(ws + WS_P); const float* gate_b = INPTR(a, I_GB) + (size_t)l * 36; bf16* CAT = (bf16*)(ws + WS_CAT);
    unsigned* qctr = (unsigned*)(ws + WS_CTL) + 8192 + 64 * qi;
    const int r = lane & 31, h = lane >> 5, g = r & 3, ql = r >> 2;
    const unsigned koff = (unsigned)((lane >> 3) * 128 + (((lane & 7) ^ ((lane >> 3) & 7)) << 4)), voff = (unsigned)((lane >> 2) * 64 + (((lane & 3) ^ (((lane >> 2) >> 2) & 3)) << 4));
    const unsigned krd = (unsigned)(r * 128) | (unsigned)h, vrd = (unsigned)(r * 64);
    const int myx = (int)(xb_xcc_id() & 7u); int qsel = 0;
    for (;;) {
        int item = 0, qx = 0;
        for (;;) { qx = (myx + qsel) & 7; if (lane == 0) item = (int)atomicAdd(qctr + 8 * qx, 1u); item = __builtin_amdgcn_readfirstlane(item); if (item < 96 * 8 || qsel >= 7) break; ++qsel; }
        if (item >= 96 * 8) break;
        const int up = item >> 3, wave = item & 7, k3 = up / 3, e3 = up - 3 * k3;
        const int bk = e3 < 2 ? qx : 8 + (qx >> 1); const int qt = e3 == 0 ? 63 - 2 * k3 : (e3 == 1 ? 62 - 2 * k3 : 62 - 2 * k3 + (qx & 1));
        const int b = bk / 3, kvh = bk - b * 3;
        const int tile0 = qt * 64, cur = qt; const int qp = tile0 + 8 * wave + ql; const size_t mq = (size_t)b * SEQ + qp; const int head = kvh * 4 + g;
        bf16x8 qf[4];
#pragma unroll
        for (int ks = 0; ks < 4; ++ks) qf[ks] = *(const bf16x8*)(QR + mq * 768 + head * 64 + 16 * ks + 8 * h);
        float g0, g1, g2;
        { const float* gl = P + mq * INP + PO_GL + head * 3; const float* gb = gate_b + head * 3; g0 = sigmoidf_(gl[0] + gb[0]); g1 = sigmoidf_(gl[1] + gb[1]); g2 = sigmoidf_(gl[2] + gb[2]); }
        f32x16 out[2], O[2]; bf16x8 kf[4]; bf16x8 vf[2][2];
#pragma unroll
        for (int dt = 0; dt < 2; ++dt)
#pragma unroll
            for (int i = 0; i < 16; ++i) out[dt][i] = 0.f;
        unsigned long long mymask = (2ull << cur) - 1ull, umask = mymask;
        const int qpw = tile0 + 8 * wave + 7;
        {
            const bf16* Kb = (const bf16*)(ws + WS_KC) + (size_t)(b * 3 + kvh) * NCMPP * 64; const bf16* Vt = (const bf16*)(ws + WS_VCT) + (size_t)(b * 3 + kvh) * 8 * 2048;
            const int nvw = qpw >= 31 ? ((qpw - 31) >> 4) + 1 : 0; const int nvq = qp >= 31 ? ((qp - 31) >> 4) + 1 : 0; const int ntile = (nvw + 31) >> 5;
            const bool need_imp = cur >= 16;
            if (ntile > 0) {
                float m = -INFINITY, ls = 0.f;
                dma_tile<false>(RW, Kb, 0, koff, Vt, voff);
#pragma unroll 1
                for (int kt = 0; kt < ntile; ++kt) { read_tile<false>(RW, krd, vrd, kf, vf, false); if (kt + 1 < ntile) dma_tile<false>(RW, Kb, 32 * (kt + 1), koff, Vt, voff); else dma_tile<true>(RW, Kb, 0, koff, Vt, voff);
                    const f32x16 S = qk_tile(kf, qf);
                    float tmax = -INFINITY; float sv[16];
#pragma unroll
                    for (int i = 0; i < 16; ++i) { const int n = 32 * kt + (i & 3) + 8 * (i >> 2) + 4 * h; sv[i] = n < nvq ? S[i] : -INFINITY; tmax = fmaxf(tmax, sv[i]); }
                    tmax = half_max(tmax); const float mn = fmaxf(m, tmax); const float ms = mn == -INFINITY ? 0.f : mn; float ps = 0.f;
#pragma unroll
                    for (int i = 0; i < 16; ++i) ps += __builtin_amdgcn_exp2f(sv[i] - ms);
                    ls = ls * __builtin_amdgcn_exp2f(m - ms) + half_sum(ps); m = mn; }
                const float ms = m == -INFINITY ? 0.f : m; const float inv = 1.0f / fmaxf(ls, 1.17549435e-38f);
                float carry = 0.f;
#pragma unroll
                for (int dt = 0; dt < 2; ++dt)
#pragma unroll
                    for (int i = 0; i < 16; ++i) O[dt][i] = 0.f;
                if (need_imp) {
#pragma unroll
                    for (int i = 0; i < 8; ++i) impl[i * 64 + lane] = 0.f;
                    WSYNC(); }
#pragma unroll 1
                for (int kt = 0; kt < ntile; ++kt) {
                    read_tile<true>(RW, krd, vrd, kf, vf, false); if (kt + 1 < ntile) dma_tile<true>(RW, Kb, 32 * (kt + 1), koff, Vt, voff);
                    const f32x16 S = qk_tile(kf, qf);
                    float p[16];
#pragma unroll
                    for (int i = 0; i < 16; ++i) { const int n = 32 * kt + (i & 3) + 8 * (i >> 2) + 4 * h; p[i] = n < nvq ? __builtin_amdgcn_exp2f(S[i] - ms) * inv : 0.f; }
                    if (need_imp) {
                        float val[4];
#pragma unroll
                        for (int t = 0; t < 4; ++t) { const float sp = 0.5f * p[4 * t + 3]; const float base = (p[4 * t] + p[4 * t + 1]) + (p[4 * t + 2] + sp); const float rv = other_half(sp, h);
                            val[t] = base + (h ? rv : carry); carry = h ? 0.f : rv; }
#pragma unroll
                        for (int t = 0; t < 4; ++t) { float v = val[t]; v += dpp_f<0xB1>(v); v += dpp_f<0x4E>(v); if (g == 0) impl[ql * 64 + 8 * kt + 2 * t + h] = v; }
                    }
                    pv_tile(p, vf, O);
                }
#pragma unroll
                for (int dt = 0; dt < 2; ++dt)
#pragma unroll
                    for (int i = 0; i < 16; ++i) out[dt][i] = O[dt][i] * g0;
                if (need_imp) {
                    WSYNC();
#pragma unroll 1
                    for (int q = 0; q < 8; ++q) { const float v = impl[q * 64 + lane]; const bool forced = lane == 0 || lane == cur || lane == cur - 1; impl[q * 64 + lane] = lane > cur ? -INFINITY : (forced ? 1e9f : v); }
                    WSYNC();
                    umask = 0ull;
#pragma unroll 1
                    for (int q = 0; q < 8; ++q) { const float sc = impl[q * 64 + lane]; int rank = 0;
#pragma unroll 4
                        for (int i4 = 0; i4 < 16; ++i4) { const f32x4 o = *(const LAS f32x4*)(impl + q * 64 + 4 * i4);
                            rank += (o.x > sc || (o.x == sc && 4 * i4 + 0 < lane)) ? 1 : 0; rank += (o.y > sc || (o.y == sc && 4 * i4 + 1 < lane)) ? 1 : 0;
                            rank += (o.z > sc || (o.z == sc && 4 * i4 + 2 < lane)) ? 1 : 0; rank += (o.w > sc || (o.w == sc && 4 * i4 + 3 < lane)) ? 1 : 0; }
                        const unsigned long long mk = __ballot(lane <= cur && rank < 16);
                        umask |= mk; if (ql == q) mymask = mk; }
                    WSYNC();
                }
            }
        }
        {
            const bf16* Kb = (const bf16*)(ws + WS_KS) + (size_t)(b * 3 + kvh) * SEQ * 64; const bf16* Vt = (const bf16*)(ws + WS_VST) + (size_t)(b * 3 + kvh) * 128 * 2048;
            float m = -INFINITY, ls = 0.f;
#pragma unroll
            for (int dt = 0; dt < 2; ++dt)
#pragma unroll
                for (int i = 0; i < 16; ++i) O[dt][i] = 0.f;
            unsigned long long um = umask; int hf = 0;
#define SEL_NEXT(have, jb, key0) do { have = um != 0ull; if (have) { jb = __builtin_ctzll(um); key0 = 64 * jb + 32 * hf; if (hf == 0 && 64 * jb + 32 <= qpw) hf = 1; else { hf = 0; um &= um - 1ull; } } } while (0)
            bool h0, h1; int j0 = 0, k0 = 0, j1 = 0, k1 = 0, sl = 0;
            SEL_NEXT(h0, j0, k0); if (h0) dma_tile<true>(RW, Kb, k0, koff, Vt, voff);
            SEL_NEXT(h1, j1, k1); if (h1) dma_tile<true>(RW + 8192, Kb, k1, koff, Vt, voff);
#pragma unroll 1
            while (h0) {
                read_tile<true>(RW + sl * 8192, krd, vrd, kf, vf, h1);
                bool h2; int j2 = 0, k2 = 0; SEL_NEXT(h2, j2, k2); if (h2) dma_tile<true>(RW + sl * 8192, Kb, k2, koff, Vt, voff);
                f32x16 S = qk_tile(kf, qf);
                att_rest(S, vf, k0, h, j0 == cur, -0x7fffffff, qp, (mymask >> j0) & 1ull, m, ls, O);
                h0 = h1; j0 = j1; k0 = k1; h1 = h2; j1 = j2; k1 = k2; sl ^= 1;
            }
#undef SEL_NEXT
            const float sc = g1 / fmaxf(ls, 1.17549435e-38f);
#pragma unroll
            for (int dt = 0; dt < 2; ++dt)
#pragma unroll
                for (int i = 0; i < 16; ++i) out[dt][i] += O[dt][i] * sc;
        }
        {
            const bf16* Kb = (const bf16*)(ws + WS_KW) + (size_t)(b * 3 + kvh) * SEQ * 64; const bf16* Vt = (const bf16*)(ws + WS_VWT) + (size_t)(b * 3 + kvh) * 128 * 2048;
            float m = -INFINITY, ls = 0.f;
#pragma unroll
            for (int dt = 0; dt < 2; ++dt)
#pragma unroll
                for (int i = 0; i < 16; ++i) O[dt][i] = 0.f;
            const int q0w = tile0 + 8 * wave; const int lo = q0w - 511 > 0 ? q0w - 511 : 0;
            const int tEnd = (q0w + 7) >> 5; int t = lo >> 5;
            dma_tile<true>(RW, Kb, 32 * t, koff, Vt, voff); if (t + 1 <= tEnd) dma_tile<true>(RW + 8192, Kb, 32 * (t + 1), koff, Vt, voff);
            int sl = 0;
#pragma unroll 1
            for (; t <= tEnd; ++t) {
                read_tile<true>(RW + sl * 8192, krd, vrd, kf, vf, t + 1 <= tEnd);
                if (t + 2 <= tEnd) dma_tile<true>(RW + sl * 8192, Kb, 32 * (t + 2), koff, Vt, voff);
                f32x16 S = qk_tile(kf, qf);
                att_rest(S, vf, 32 * t, h, !(32 * t >= q0w + 7 - 511 && 32 * t + 31 <= q0w), qp - 511, qp, true, m, ls, O);
                sl ^= 1;
            }
            const float sc = g2 / fmaxf(ls, 1.17549435e-38f);
            bf16* op = CAT + mq * DM + DRW + DPOOL + head * 64 + 4 * h;
#pragma unroll
            for (int dt = 0; dt < 2; ++dt)
#pragma unroll
                for (int t2 = 0; t2 < 4; ++t2) { u32x2 w; w.x = cvtpk(out[dt][4 * t2] + O[dt][4 * t2] * sc, out[dt][4 * t2 + 1] + O[dt][4 * t2 + 1] * sc); w.y = cvtpk(out[dt][4 * t2 + 2] + O[dt][4 * t2 + 2] * sc, out[dt][4 * t2 + 3] + O[dt][4 * t2 + 3] * sc);
                    *(u32x2*)(op + 32 * dt + 8 * t2) = w; }
        }
    }
}

__device__ __forceinline__ void phase_rwkv_out(const Args& a, int l, int gw, int NGW, int lane) {
    OPQ_SI(gw); OPQ_V(lane);
    unsigned char* ws = a.ws + opaque0(); const float* YS = (const float*)(ws + WS_YS); const float* vV = (const float*)(ws + WS_SV + 5 * SV_STRIDE); const float* vG = (const float*)(ws + WS_G); const float* SC = (const float*)(ws + WS_SC);
    const float* gng = INPTR(a, I_GNG) + (size_t)l * DRW; const float* gnb = INPTR(a, I_GNB) + (size_t)l * DRW; bf16* CAT = (bf16*)(ws + WS_CAT);
    for (int id0 = gw * 4; id0 < MTOK * 12; id0 += NGW * 4) {
        float y[4], vv[4], gg[4], bc[4]; int cc[4], mm[4]; size_t oo[4];
#pragma unroll
        for (int e = 0; e < 4; ++e) { const int id = id0 + e, m = id / 12, h = id - m * 12; cc[e] = h * 64 + lane; mm[e] = m; oo[e] = (size_t)m * DRW + cc[e]; y[e] = YS[oo[e]]; vv[e] = vV[oo[e]]; gg[e] = vG[oo[e]]; bc[e] = SC[((size_t)m * 12 + h) * 4 + 2]; }
#pragma unroll
        for (int e = 0; e < 4; ++e) { const float mean = wave_sum(y[e]) * (1.f / 64.f); const float d = y[e] - mean; const float var = wave_sum(d * d) * (1.f / 64.f);
            const float yn = d * (1.f / sqrtf(var + GN_EPS)) * gng[cc[e]] + gnb[cc[e]];
            CAT[(size_t)mm[e] * DM + cc[e]] = (bf16)f2bf((yn + bc[e] * vv[e]) * gg[e]); } }
}

#ifndef PROBE_MODE
#define PROBE_MODE 0
#endif
template <int PHMASK> __global__ void __launch_bounds__(NTHR, 2) fwd(Args args) {
    extern __shared__ __attribute__((aligned(16))) unsigned char lds_raw[];
    LAS unsigned char* lds = (LAS unsigned char*)lds_raw;
    const int tid = threadIdx.x, lane = tid & 63, wave = __builtin_amdgcn_readfirstlane(tid >> 6);
    const int G = gridDim.x, bid = blockIdx.x; const int gw = bid * NWAVES + wave, NGW = G * NWAVES;
    unsigned char* ws = args.ws;
    for (int u = tid; u < (LDS_BYTES - LDS_SCRATCH) / 4; u += NTHR) ((LAS unsigned*)(lds + LDS_SCRATCH))[u] = 0u;
    __syncthreads();
    const int lo = args.ph_lo, hi = args.ph_hi;
    XcdBarrier bar; bar.bar = (unsigned*)(ws + WS_CTL) + 4096; bar.x = 0; bar.st = nullptr;
    if (hi - lo > 1) bar = xcd_barrier_post((unsigned*)(ws + WS_CTL) + 4096, (volatile LAS unsigned*)(lds + MISC_OFF) + 8);
#define IN(k) (lo <= (k) && (k) < hi)
#define PHEN(j) (((PHMASK) >> (j)) & 1)

#define SEAM(k) do { if ((k) + 1 < hi) xcd_barrier(bar); } while (0)
    bf16* XB = (bf16*)(ws + WS_XB); bf16* Hb = (bf16*)(ws + WS_H); float* Y = (float*)(ws + WS_YR); unsigned char* XL8 = ws + WS_XL8; float* YF = (float*)(ws + WS_P); const float* AUX = (const float*)(ws + WS_AUX); float* Pm = (float*)(ws + WS_P); bf16* CAT = (bf16*)(ws + WS_CAT);

    if (PHEN(0) && IN(0)) { phase_prologue(args, bid * NTHR + tid, G * NTHR); SEAM(0); }
    for (int l = 0; l < NLAYER; ++l) {
        const int pb = 1 + 14 * l;
        for (int rep = 0; rep < (((REP_MASK) >> 1) & 1 ? 2 : 1); ++rep) if (PHEN(1) && IN(pb + 0)) { phase_wconv(args, l, lds, gw, NGW, wave, lane); SEAM(pb + 0); }
        for (int rep = 0; rep < (((REP_MASK) >> 2) & 1 ? 2 : 1); ++rep) if (PHEN(2) && IN(pb + 1)) {
            pg8::Gemm g{XB, (const bf16*)(ws + WS_WUP1), MTOK, NUP, DM}; pg8::StaticOrder S; S.init(MTOK, NUP, G, bid); pg8::EpiSwiGLU E{Hb, DFF, AUX, 3 * l - 1, l * 2 * GWN};
            pg8::gemm_phase<pg8::EpiSwiGLU, pg8::StaticOrder, true, true>(lds, g, S, E); SEAM(pb + 1); }
        for (int rep = 0; rep < (((REP_MASK) >> 3) & 1 ? 2 : 1); ++rep) if (PHEN(3) && IN(pb + 2)) {
            pg8::Gemm g{Hb, (const bf16*)(ws + WS_WDN1), MTOK, DM, DFF}; pg8::StaticOrder S; S.init(MTOK, DM, G, bid); pg8::EpiResid E{Y, XB, XL8, YF, DM, ALPHA, 0.5f, 3 * l - 1, 3 * l, 0};
            pg8::gemm_phase<pg8::EpiResid, pg8::StaticOrder, true, true>(lds, g, S, E); SEAM(pb + 2); }
        for (int rep = 0; rep < (((REP_MASK) >> 4) & 1 ? 2 : 1); ++rep) if (false && PHEN(4) && IN(pb + 3)) { phase_ln(Y, INPTR(args, I_LN1G) + (size_t)l * DM, INPTR(args, I_LN1B) + (size_t)l * DM, nullptr, XB, (float*)AUX, gw, NGW, lane); SEAM(pb + 3); }
        for (int rep = 0; rep < (((REP_MASK) >> 5) & 1 ? 2 : 1); ++rep) if (PHEN(5) && IN(pb + 4)) {
            pg8::Gemm g{XB, (const bf16*)(ws + WS_WIN), MTOK, INP, DM}; pg8::StaticOrder S; S.init(MTOK, INP, G, bid); pg8::EpiF32 E{Pm, INP, AUX, 3 * l, l * 2 * GWN + NUP};
            pg8::gemm_phase<pg8::EpiF32, pg8::StaticOrder, true, true>(lds, g, S, E); SEAM(pb + 4); }
        for (int rep = 0; rep < (((REP_MASK) >> 6) & 1 ? 2 : 1); ++rep) if (PHEN(6) && IN(pb + 5)) { phase_m1(args, l, lds, bid, G, tid, wave, lane); SEAM(pb + 5); }
        for (int rep = 0; rep < (((REP_MASK) >> 7) & 1 ? 2 : 1); ++rep) if (PHEN(7) && IN(pb + 6)) { phase_scan_prep(args, lds, gw, NGW, wave, lane); SEAM(pb + 6); }
        for (int rep = 0; rep < (((REP_MASK) >> 8) & 1 ? 2 : 1); ++rep) if (PHEN(8) && IN(pb + 7)) { for (int r2 = 0; r2 < (((REP_MASK) >> 20) & 1 ? 2 : 1); ++r2) { if (bid < 96 && wave == 0) scan_seq(args, lds, bid, lane); } for (int r3 = 0; r3 < (((REP_MASK) >> 21) & 1 ? 2 : 1); ++r3) if (!(bid < 96 && wave == 1)) phase_nsa(args, l + 4 * rep + 8 * r3, l, lds, wave, lane); SEAM(pb + 7); }
        for (int rep = 0; rep < (((REP_MASK) >> 9) & 1 ? 2 : 1); ++rep) if (PHEN(9) && IN(pb + 8)) { phase_rwkv_out(args, l, gw, NGW, lane); SEAM(pb + 8); }
        for (int rep = 0; rep < (((REP_MASK) >> 10) & 1 ? 2 : 1); ++rep) if (PHEN(10) && IN(pb + 9)) {
            pg8::Gemm g{CAT, (const bf16*)(ws + WS_WOUT), MTOK, DM, DM}; pg8::StaticOrder S; S.init(MTOK, DM, G, bid); pg8::EpiResid E{Y, XB, XL8, YF, DM, ALPHA, 1.0f, 3 * l, 3 * l + 1, 0};
            pg8::gemm_phase<pg8::EpiResid, pg8::StaticOrder, true, true>(lds, g, S, E); SEAM(pb + 9); }
        for (int rep = 0; rep < (((REP_MASK) >> 11) & 1 ? 2 : 1); ++rep) if (false && PHEN(11) && IN(pb + 10)) { phase_ln(Y, INPTR(args, I_LN2G) + (size_t)l * DM, INPTR(args, I_LN2B) + (size_t)l * DM, nullptr, XB, (float*)AUX, gw, NGW, lane); SEAM(pb + 10); }
        for (int rep = 0; rep < (((REP_MASK) >> 12) & 1 ? 2 : 1); ++rep) if (PHEN(12) && IN(pb + 11)) {
            pg8::Gemm g{XB, (const bf16*)(ws + WS_WUP2), MTOK, NUP, DM}; pg8::StaticOrder S; S.init(MTOK, NUP, G, bid); pg8::EpiSwiGLU E{Hb, DFF, AUX, 3 * l + 1, l * 2 * GWN + NUP + INP};
            pg8::gemm_phase<pg8::EpiSwiGLU, pg8::StaticOrder, true, true>(lds, g, S, E); SEAM(pb + 11); }
        for (int rep = 0; rep < (((REP_MASK) >> 13) & 1 ? 2 : 1); ++rep) if (PHEN(13) && IN(pb + 12)) {
            pg8::Gemm g{Hb, (const bf16*)(ws + WS_WDN2), MTOK, DM, DFF}; pg8::StaticOrder S; S.init(MTOK, DM, G, bid); pg8::EpiResid E{Y, XB, XL8, YF, DM, ALPHA, 0.5f, 3 * l + 1, 3 * l + 2, l == NLAYER - 1};
            pg8::gemm_phase<pg8::EpiResid, pg8::StaticOrder, true, true>(lds, g, S, E); SEAM(pb + 12); }
        for (int rep = 0; rep < (((REP_MASK) >> 14) & 1 ? 2 : 1); ++rep) if (l == NLAYER - 1 && PHEN(14) && IN(pb + 13)) { phase_ln(YF, INPTR(args, I_LN3G) + (size_t)l * DM, INPTR(args, I_LN3B) + (size_t)l * DM, args.out, XB, (float*)(ws + WS_SC), gw, NGW, lane); SEAM(pb + 13); }
    }
#undef IN
#undef SEAM
}

#ifndef ONE_MASK
#define ONE_MASK 0xFFFFF
#endif
#ifndef MK_ONE_LAUNCH
#define MK_ONE_LAUNCH 1
#endif
typedef void (*kern_t)(Args);
extern "C" void kernel_launch(void* const* d_in, const int* in_sizes, int n_in, void* d_out, int out_size, void* d_ws, size_t ws_size, hipStream_t stream) {
    static int grid = 0;
#if MK_ONE_LAUNCH
    static const kern_t kerns[1] = {fwd<ONE_MASK>};
    constexpr int NK = 1;
#else
    static const kern_t kerns[15] = {fwd<1 << 0>, fwd<1 << 1>, fwd<1 << 2>, fwd<1 << 3>, fwd<1 << 4>, fwd<1 << 5>, fwd<1 << 6>, fwd<1 << 7>, fwd<1 << 8>, fwd<1 << 9>, fwd<1 << 10>, fwd<1 << 11>, fwd<1 << 12>, fwd<1 << 13>, fwd<1 << 14>};
    constexpr int NK = 15;
#endif
    if (grid == 0) {
        if (n_in != 34 || out_size != MTOK * DM || ws_size < WS_END) { fprintf(stderr, "kernel_launch: unexpected shapes (n_in %d, out %d, ws %zu; need ws >= %zu)\n", n_in, out_size, ws_size, (size_t)WS_END); grid = -1; return; }
        int dev = 0, cus = 0;
        if (hipGetDevice(&dev) != hipSuccess || hipDeviceGetAttribute(&cus, hipDeviceAttributeMultiprocessorCount, dev) != hipSuccess) { grid = -1; return; }
        for (int i = 0; i < NK; ++i) if (hipFuncSetAttribute((const void*)kerns[i], hipFuncAttributeMaxDynamicSharedMemorySize, LDS_BYTES) != hipSuccess) { fprintf(stderr, "kernel_launch: hipFuncSetAttribute failed\n"); grid = -1; return; }
        int per_cu = 0;
        if (hipOccupancyMaxActiveBlocksPerMultiprocessor(&per_cu, (const void*)kerns[0], NTHR, LDS_BYTES) != hipSuccess || per_cu < 1) fprintf(stderr, "kernel_launch: occupancy query says %d blocks per CU\n", per_cu);
        (void)hipGetLastError();
        grid = cus;
    }
    if (grid < 0) return;
    (void)hipMemsetAsync((char*)d_ws + WS_CTL, 0, CTL_ZERO_BYTES, stream);
    (void)hipMemsetAsync((char*)d_ws + WS_AUX, 0, AUX_ZERO_BYTES, stream);
    Args a{};
    for (int i = 0; i < 34; ++i) a.in[i] = (const float*)d_in[i];
    a.out = (float*)d_out; a.ws = (unsigned char*)d_ws;
#if MK_ONE_LAUNCH
    a.ph_lo = 0; a.ph_hi = NPH;
    hipLaunchKernelGGL(kerns[0], dim3(grid), dim3(NTHR), LDS_BYTES, stream, a);
#else
#ifndef HOST_REP
#define HOST_REP 0
#endif
    for (int k = 0; k < NPH; ++k) { a.ph_lo = k; a.ph_hi = k + 1; const int j = k == 0 ? 0 : (k - 1) % 14 + 1;
        for (int rep = 0; rep < (((HOST_REP) >> j) & 1 ? 2 : 1); ++rep) {
            if (rep && j == 8) (void)hipMemsetAsync((char*)d_ws + WS_CTL + (8192 + 64 * ((k - 1) / 14)) * 4, 0, 256, stream);
            a.rep = rep; hipLaunchKernelGGL(kerns[j], dim3(grid), dim3(NTHR), LDS_BYTES, stream, a); } }
#endif
}
```

```cpp
#include <hip/hip_runtime.h>
#include <cstdio>
#include <cstdint>
__device__ __forceinline__ int lane_now() { unsigned m = ~0u; asm volatile("" : "+s"(m)); return (int)__builtin_amdgcn_mbcnt_hi(m, __builtin_amdgcn_mbcnt_lo(m, 0u)); }
namespace pg8 {
#define PG8_LAS __attribute__((address_space(3)))
typedef unsigned short bf16_t;
typedef short bf16x8 __attribute__((ext_vector_type(8)));
typedef float f32x4 __attribute__((ext_vector_type(4)));
typedef unsigned u32x4 __attribute__((ext_vector_type(4)));
constexpr int BM = 256, BK = 64, HALF = 128, HTB = HALF * BK * 2  , STAGE_BYTES = 8 * HTB, NXCD = 8, WGM = 8;

__host__ __device__ __forceinline__ int lds_byte(int r, int c) { const int st = (r >> 4) * 2 + (c >> 5), rr = r & 15, cc = c & 31, ob = rr * 64 + cc * 2; return st * 1024 + (ob ^ (((ob >> 9) & 1) << 5)); }
__host__ __device__ __forceinline__ void stage_rc(int b, int& R, int& C) { const int st = b / 1024, sb = b % 1024, swz = sb ^ (((sb >> 9) & 1) << 5); R = (st >> 1) * 16 + swz / 64; C = (st & 1) * 32 + (swz % 64) / 2; }
__host__ __device__ __forceinline__ int perm32(int rho) { const int n = rho >> 4, i = rho & 15; return 8 * (i >> 2) + 4 * n + (i & 3); }

struct Unit { int pm, pn; };
struct Gemm { const bf16_t* A; const bf16_t* Bt; int M, N, K; };

struct StaticOrder {
    int nM, nN, nwg, G, c;
    __host__ __device__ void init(int M, int N, int G_, int c_) { nM = M / BM; nN = N / BM; nwg = nM * nN; G = G_; c = c_; }
    __host__ __device__ bool next(int i, Unit& u) const {
        const long L = (long)i * G + c; if (L >= nwg) return false;
        int wgid = (int)L; { const int q = nwg / NXCD, r = nwg % NXCD, xcd = wgid % NXCD, off = wgid / NXCD; wgid = (xcd < r ? xcd * (q + 1) : r * (q + 1) + (xcd - r) * q) + off; }
        const int nig = WGM * nN, gid = wgid / nig, fm = gid * WGM, gsz = (nM - fm) < WGM ? (nM - fm) : WGM;
        u.pm = fm + ((wgid % nig) % gsz); u.pn = (wgid % nig) / gsz; return true;
    }
    __device__ __forceinline__ void a_ready(const Unit&) const {}
    __device__ __forceinline__ void done(const Unit&) const {}
};

__device__ __forceinline__ unsigned cvt_pk_bf16(float lo, float hi) { unsigned r; asm volatile("v_cvt_pk_bf16_f32 %0, %1, %2" : "=v"(r) : "v"(lo), "v"(hi)); return r; }
typedef float f32x2 __attribute__((ext_vector_type(2)));
constexpr int A_MT = 16384, A_DM = 2048, A_GWBW = 12 * A_MT * 2, A_GWN = 27136, A_LNGB = A_GWBW + 4 * 2 * A_GWN;
#define PG8_GAS __attribute__((address_space(1)))
__device__ __forceinline__ float quad16_sum(float x) { float a = x, b = x; asm volatile("s_nop 1\n\tv_permlane16_swap_b32 %0, %1" : "+v"(a), "+v"(b)); float y = a + b, c = y, d = y; asm volatile("s_nop 1\n\tv_permlane32_swap_b32 %0, %1" : "+v"(c), "+v"(d)); return c + d; }
template <class T> __device__ __forceinline__ PG8_GAS T* uni_ptr(T* p) { const unsigned long long v = (unsigned long long)p; const unsigned lo = __builtin_amdgcn_readfirstlane((unsigned)v), hi = __builtin_amdgcn_readfirstlane((unsigned)(v >> 32)); return (PG8_GAS T*)(((unsigned long long)hi << 32) | lo); }
__device__ __forceinline__ f32x2 ln_stats(const float* aux, int q, int row) { const f32x2 s = *(const f32x2*)(aux + ((size_t)q * A_MT + row) * 2); const float mean = s.x * (1.0f / A_DM);
    const float var = s.y * (1.0f / A_DM) - mean * mean; return (f32x2){mean, 1.0f / sqrtf(var + 1e-5f)}; }
struct EpiSwiGLU {
    static constexpr bool PERM = true, AFTER_DRAIN = false, PREFETCH = true;
    bf16_t* H; int ldh; const float* aux; int q, gwo;
    __device__ __forceinline__ void prefetch(const Unit& u, PG8_LAS unsigned char* xl, int wid, int lane) const {
        const int w = wid & 3, qq = q < 0 ? 0 : q; const PG8_GAS float* au = uni_ptr(aux);
        const PG8_GAS float* src = w < 2 ? au + ((size_t)qq * A_MT + u.pm * BM) * 2 + (w * 64 + lane) * 4
                                         : au + A_GWBW + gwo + (w == 3 ? A_GWN : 0) + (lane >= 32 ? 5504 : 0) + u.pn * HALF + (lane & 31) * 4;
        __builtin_amdgcn_global_load_lds((const unsigned*)src, (PG8_LAS unsigned*)(xl + wid * 1024), 16, 0, 0);
    }
    __device__ __forceinline__ void operator()(const f32x4 (&acc)[2][2][4][2], const Unit& u, int wr, int wc, int fr, int fq, PG8_LAS unsigned char* xl) const {
        const int row0 = u.pm * BM + wr * 64 + fr, col0 = u.pn * HALF + wc * 32 + 8 * fq;
        f32x4 ga[2], gb[2], ba[2], bb[2]; f32x2 sr[8];
#pragma unroll
        for (int n = 0; n < 2; ++n) { ga[n] = (f32x4){0.f, 0.f, 0.f, 0.f}; gb[n] = ga[n]; ba[n] = ga[n]; bb[n] = ga[n]; }
#pragma unroll
        for (int k = 0; k < 8; ++k) sr[k] = (f32x2){0.f, (float)A_DM * (1.0f - 1e-5f)};
        if (q >= 0) { const PG8_LAS float* cv = (const PG8_LAS float*)(xl + 2048) + wc * 32 + 8 * fq; const PG8_LAS float* rs = (const PG8_LAS float*)xl + (wr * 64 + fr) * 2;
#pragma unroll
            for (int n = 0; n < 2; ++n) { ga[n] = *(const PG8_LAS f32x4*)(cv + 4 * n); gb[n] = *(const PG8_LAS f32x4*)(cv + 128 + 4 * n); ba[n] = *(const PG8_LAS f32x4*)(cv + 256 + 4 * n); bb[n] = *(const PG8_LAS f32x4*)(cv + 384 + 4 * n); }
#pragma unroll
            for (int k = 0; k < 8; ++k) sr[k] = *(const PG8_LAS f32x2*)(rs + ((k >> 2) * HALF + (k & 3) * 16) * 2);
        }
        asm volatile("" ::: "memory");
#pragma unroll
        for (int ai = 0; ai < 2; ++ai)
#pragma unroll
            for (int m = 0; m < 4; ++m) { const int row = row0 + ai * HALF + m * 16; bf16_t* rowp = H + (size_t)row * ldh + col0;
                const float mean = sr[ai * 4 + m].x * (1.0f / A_DM), rstd = 1.0f / sqrtf(sr[ai * 4 + m].y * (1.0f / A_DM) - mean * mean + 1e-5f);
                float hv[8];
#pragma unroll
                for (int n = 0; n < 2; ++n) {
#pragma unroll
                    for (int i = 0; i < 4; ++i) { const float a = (acc[ai][0][m][n][i] - mean * ga[n][i]) * rstd + ba[n][i], b = (acc[ai][1][m][n][i] - mean * gb[n][i]) * rstd + bb[n][i];
                        const float e = __builtin_amdgcn_exp2f(a * -1.44269504089f); hv[n * 4 + i] = a * __builtin_amdgcn_rcpf(1.0f + e) * b; } }
                u32x4 w; w.x = cvt_pk_bf16(hv[0], hv[1]); w.y = cvt_pk_bf16(hv[2], hv[3]); w.z = cvt_pk_bf16(hv[4], hv[5]); w.w = cvt_pk_bf16(hv[6], hv[7]);
                *(u32x4*)rowp = w; asm volatile("" ::: "memory"); }
    }
};
struct EpiResid {
    static constexpr bool PERM = true, AFTER_DRAIN = false, PREFETCH = false;
    float* Y; bf16_t* YB; unsigned char* L8; int ldc; float alpha, s; int qp, qn;
    __device__ __forceinline__ void operator()(const f32x4 (&acc)[2][2][4][2], const Unit& u, int wr, int wc, int fr, int fq, PG8_LAS unsigned char* xl) const {
        const int urow0 = __builtin_amdgcn_readfirstlane(u.pm * BM + wr * 64), ucol0 = __builtin_amdgcn_readfirstlane(u.pn * BM + wc * 32); const unsigned lob = (unsigned)(fr * ldc + 8 * fq) * 4u;
        float al_ = alpha, sc_ = s; asm volatile("" : "+s"(al_), "+s"(sc_));
        PG8_GAS float* Yu = uni_ptr(Y); PG8_GAS bf16_t* YBu = uni_ptr(YB); PG8_GAS unsigned char* L8u = uni_ptr(L8);
        PG8_GAS float* aux = Yu + (size_t)A_MT * A_DM; const PG8_GAS float* lng = aux + A_LNGB + (size_t)(qp < 0 ? 0 : qp) * 2 * A_DM + ucol0 + 8 * fq; const PG8_GAS float* lnb = lng + A_DM;
        PG8_LAS float* wl = (PG8_LAS float*)(xl + (wr * 4 + wc) * 2048); float t1[2] = {0.f, 0.f}, t2[2] = {0.f, 0.f};
#pragma unroll
        for (int e = 0; e < 2; ++e) { const int k = 2 * fq + e, j = 16 * k + fr; f32x2 st = {0.f, 1.f};
            if (qp >= 0) { const f32x2 sr = *(const PG8_GAS f32x2*)(aux + ((size_t)qp * A_MT + urow0 + (k >> 2) * HALF + (k & 3) * 16 + fr) * 2); const float mean = sr.x * (1.0f / A_DM);
                st.x = mean; st.y = 1.0f / sqrtf(sr.y * (1.0f / A_DM) - mean * mean + 1e-5f); }
            *(PG8_LAS f32x2*)(wl + 2 * j) = st; }
        asm volatile("s_waitcnt lgkmcnt(0)" ::: "memory");
        typedef unsigned u32x2_ __attribute__((ext_vector_type(2)));
#pragma unroll
        for (int c = 0; c < 4; ++c) { const int ai = c >> 1, bj = c & 1;
            f32x4 gv[2], bv[2];
#pragma unroll
            for (int n = 0; n < 2; ++n) { gv[n] = (f32x4){1.f, 1.f, 1.f, 1.f}; bv[n] = (f32x4){0.f, 0.f, 0.f, 0.f}; }
            u32x4 xb[4]; u32x2_ xl8[4];
            if (qp >= 0) {
#pragma unroll
                for (int n = 0; n < 2; ++n) { gv[n] = *(const PG8_GAS f32x4*)(lng + bj * HALF + n * 4); bv[n] = *(const PG8_GAS f32x4*)(lnb + bj * HALF + n * 4); } }
#pragma unroll
            for (int m = 0; m < 4; ++m) { int ur = urow0 + ai * HALF + m * 16; ur = __builtin_amdgcn_readfirstlane(ur); asm volatile("" : "+s"(ur));
                const size_t eo = (size_t)ur * ldc + ucol0 + bj * HALF; xb[m] = *(const PG8_GAS u32x4*)((const PG8_GAS char*)(YBu + eo) + (lob >> 1)); xl8[m] = *(const PG8_GAS u32x2_*)(L8u + eo + (lob >> 2)); }
            asm volatile("" ::: "memory");
#pragma unroll
            for (int m = 0; m < 4; ++m) { int ur = urow0 + ai * HALF + m * 16; ur = __builtin_amdgcn_readfirstlane(ur); asm volatile("" : "+s"(ur)); const size_t uoff = (size_t)ur * ldc + ucol0 + bj * HALF;
                const int j = 16 * (ai * 4 + m) + fr; const f32x2 st = *(const PG8_LAS f32x2*)(wl + 2 * j); float p1 = 0.f, p2 = 0.f; u32x4 wb; u32x2_ wl8;
#pragma unroll
                for (int n = 0; n < 2; ++n) {
                    f32x4 xr; { const unsigned w0 = n ? xb[m].z : xb[m].x, w1 = n ? xb[m].w : xb[m].y; const int lw = (int)(n ? xl8[m].y : xl8[m].x); const f32x2 l0 = __builtin_amdgcn_cvt_pk_f32_bf8(lw, false), l1 = __builtin_amdgcn_cvt_pk_f32_bf8(lw, true);
                        xr.x = __builtin_bit_cast(float, w0 << 16) + l0.x; xr.y = __builtin_bit_cast(float, w0 & 0xffff0000u) + l0.y; xr.z = __builtin_bit_cast(float, w1 << 16) + l1.x; xr.w = __builtin_bit_cast(float, w1 & 0xffff0000u) + l1.y; }
                    const f32x4 x = (xr - st.x) * st.y * gv[n] + bv[n];
                    const f32x4 y = x * al_ + acc[ai][bj][m][n] * sc_;
                    const unsigned h0 = cvt_pk_bf16(y.x, y.y), h1 = cvt_pk_bf16(y.z, y.w);
                    int l8 = __builtin_amdgcn_cvt_pk_bf8_f32(y.x - __builtin_bit_cast(float, h0 << 16), y.y - __builtin_bit_cast(float, h0 & 0xffff0000u), 0, false);
                    l8 = __builtin_amdgcn_cvt_pk_bf8_f32(y.z - __builtin_bit_cast(float, h1 << 16), y.w - __builtin_bit_cast(float, h1 & 0xffff0000u), l8, true);
                    if (n == 0) { wb.x = h0; wb.y = h1; wl8.x = (unsigned)l8; } else { wb.z = h0; wb.w = h1; wl8.y = (unsigned)l8; }
                    p1 += (y.x + y.y) + (y.z + y.w); p2 += (y.x * y.x + y.y * y.y) + (y.z * y.z + y.w * y.w); }
                *(PG8_GAS u32x4*)((PG8_GAS char*)(YBu + uoff) + (lob >> 1)) = wb; *(PG8_GAS u32x2_*)(L8u + uoff + (lob >> 2)) = wl8;
                p1 = quad16_sum(p1); p2 = quad16_sum(p2); const bool mine = fq == ((ai * 4 + m) >> 1);
                t1[m & 1] += mine ? p1 : 0.f; t2[m & 1] += mine ? p2 : 0.f; }
            asm volatile("" ::: "memory"); }
#pragma unroll
        for (int e = 0; e < 2; ++e) { const int k = 2 * fq + e;
            PG8_GAS float* sp = aux + ((size_t)qn * A_MT + urow0 + (k >> 2) * HALF + (k & 3) * 16 + fr) * 2;
            __hip_atomic_fetch_add(sp, __builtin_rintf(t1[e] * 1024.0f) * (1.0f / 1024.0f), __ATOMIC_RELAXED, __HIP_MEMORY_SCOPE_AGENT); __hip_atomic_fetch_add(sp + 1, __builtin_rintf(t2[e] * 64.0f) * (1.0f / 64.0f), __ATOMIC_RELAXED, __HIP_MEMORY_SCOPE_AGENT); }
        asm volatile("s_waitcnt lgkmcnt(0)" ::: "memory");
    }
};
struct EpiF32 {
    static constexpr bool PERM = false, AFTER_DRAIN = false, PREFETCH = true;
    float* C; int ldc; const float* aux; int q, gwo;
    __device__ __forceinline__ void prefetch(const Unit& u, PG8_LAS unsigned char* xl, int wid, int lane) const {
        const int w = wid & 3; const PG8_GAS float* au = uni_ptr(aux);
        const PG8_GAS float* src = w < 2 ? au + ((size_t)q * A_MT + u.pm * BM) * 2 + (w * 64 + lane) * 4 : au + A_GWBW + gwo + (w == 3 ? A_GWN : 0) + u.pn * BM + lane * 4;
        __builtin_amdgcn_global_load_lds((const unsigned*)src, (PG8_LAS unsigned*)(xl + wid * 1024), 16, 0, 0);
    }
    __device__ __forceinline__ void operator()(const f32x4 (&acc)[2][2][4][2], const Unit& u, int wr, int wc, int fr, int fq, PG8_LAS unsigned char* xl) const {
        const int row0 = u.pm * BM + wr * 64 + fr, col0 = u.pn * BM + wc * 32 + 4 * fq;
        const PG8_LAS float* cv = (const PG8_LAS float*)(xl + 2048) + wc * 32 + 4 * fq; const PG8_LAS float* rs = (const PG8_LAS float*)xl + (wr * 64 + fr) * 2;
        f32x4 g4[2][2], b4[2][2]; f32x2 sr[8];
#pragma unroll
        for (int bj = 0; bj < 2; ++bj)
#pragma unroll
            for (int n = 0; n < 2; ++n) { g4[bj][n] = *(const PG8_LAS f32x4*)(cv + bj * HALF + n * 16); b4[bj][n] = *(const PG8_LAS f32x4*)(cv + 256 + bj * HALF + n * 16); }
#pragma unroll
        for (int k = 0; k < 8; ++k) sr[k] = *(const PG8_LAS f32x2*)(rs + ((k >> 2) * HALF + (k & 3) * 16) * 2);
        asm volatile("" ::: "memory");
#pragma unroll
        for (int ai = 0; ai < 2; ++ai)
#pragma unroll
            for (int m = 0; m < 4; ++m) { const int row = row0 + ai * HALF + m * 16; float* rowp = C + (size_t)row * ldc + col0;
                const float mean = sr[ai * 4 + m].x * (1.0f / A_DM), rstd = 1.0f / sqrtf(sr[ai * 4 + m].y * (1.0f / A_DM) - mean * mean + 1e-5f);
#pragma unroll
                for (int bj = 0; bj < 2; ++bj)
#pragma unroll
                    for (int n = 0; n < 2; ++n) *(f32x4*)(rowp + bj * HALF + n * 16) = (acc[ai][bj][m][n] - g4[bj][n] * mean) * rstd + b4[bj][n];
                asm volatile("" ::: "memory"); }
    }
};

template <class Epi, class Sched, bool ALIGN_EPI = false, bool SP2 = false>
__device__ __forceinline__ void gemm_phase(PG8_LAS unsigned char* lds, const Gemm g, const Sched& S, const Epi& E) {
    int tid_ = threadIdx.x; asm volatile("" : "+v"(tid_));
    const int tid = tid_, wid = __builtin_amdgcn_readfirstlane(tid >> 6), lane = tid & 63, wr = wid >> 2, wc = wid & 3, fr = lane & 15, fq = lane >> 4;
    const int K = g.K, nt = K / BK;
    unsigned voffA[2], voffB[2];
#pragma unroll
    for (int i = 0; i < 2; ++i) { int R, C; stage_rc(tid * 16 + i * 8192, R, C); const int Rb = Epi::PERM ? ((R & ~31) + perm32(R & 31)) : R;
        voffA[i] = (unsigned)(R * K + C) * 2u; voffB[i] = (unsigned)(Rb * K + C) * 2u; }
    const size_t kstep = (size_t)(BK * 2);
    const size_t hstep = (size_t)HALF * K * 2;
    const size_t tstep = 2 * hstep;
    const unsigned ldsw = (unsigned)wid * 1024u;
    const int aoff = lds_byte(wr * 64 + fr, fq * 8), boff = lds_byte(wc * 32 + fr, fq * 8);
#define PG8_SA(b, h) (((b) * 2 + (h)) * HTB)
#define PG8_SB(b, h) ((4 + (b) * 2 + (h)) * HTB)
#define PG8_STAGE(bufoff, gbase, voff) do { _Pragma("unroll") for (int _i = 0; _i < 2; ++_i) \
        __builtin_amdgcn_global_load_lds((const unsigned*)((const char*)(gbase) + (voff)[_i]), (PG8_LAS unsigned*)(lds + (bufoff) + ldsw + _i * 8192), 16, 0, 0); } while (0)
#define PG8_LDA(dst, b, h) do { _Pragma("unroll") for (int m = 0; m < 4; ++m) _Pragma("unroll") for (int k = 0; k < 2; ++k) dst[m][k] = *(const PG8_LAS bf16x8*)(lds + PG8_SA(b, h) + aoff + m * 2048 + k * 1024); } while (0)
#define PG8_LDB(dst, b, h) do { _Pragma("unroll") for (int n = 0; n < 2; ++n) _Pragma("unroll") for (int k = 0; k < 2; ++k) dst[n][k] = *(const PG8_LAS bf16x8*)(lds + PG8_SB(b, h) + boff + n * 2048 + k * 1024); } while (0)
#define PG8_MMA(ai, bj, At, Bt) do { __builtin_amdgcn_s_setprio(1); _Pragma("unroll") for (int m = 0; m < 4; ++m) _Pragma("unroll") for (int n = 0; n < 2; ++n) _Pragma("unroll") for (int k = 0; k < 2; ++k) \
        acc[ai][bj][m][n] = __builtin_amdgcn_mfma_f32_16x16x32_bf16(Bt[n][k], At[m][k], acc[ai][bj][m][n], 0, 0, 0); __builtin_amdgcn_s_setprio(0); } while (0)
#define PG8_WAIT_V(n) asm volatile("s_waitcnt vmcnt(" #n ")" ::: "memory")
#define PG8_WAIT_L(n) asm volatile("s_waitcnt lgkmcnt(" #n ")" ::: "memory")
#define PG8_BAR __builtin_amdgcn_s_barrier()
#define PG8_SCHED __builtin_amdgcn_sched_barrier(0)
    Unit cur, nxt; int ui = 0;
    if (!S.next(0, cur)) return;
    f32x4 acc[2][2][4][2];
#pragma unroll
    for (int a = 0; a < 2; ++a)
#pragma unroll
        for (int b = 0; b < 2; ++b)
#pragma unroll
            for (int m = 0; m < 4; ++m)
#pragma unroll
                for (int n = 0; n < 2; ++n) acc[a][b][m][n] = (f32x4){0.f, 0.f, 0.f, 0.f};
    bf16x8 At[4][2], B0[2][2], B1[2][2];
    const char* cA = (const char*)g.A + (size_t)cur.pm * tstep; const char* cB = (const char*)g.Bt + (size_t)cur.pn * tstep;
    S.a_ready(cur);
    if constexpr (SP2) {
        PG8_STAGE(PG8_SB(0, 0), cB, voffB); PG8_STAGE(PG8_SB(0, 1), cB + hstep, voffB); PG8_STAGE(PG8_SA(0, 0), cA, voffA); PG8_STAGE(PG8_SA(0, 1), cA + hstep, voffA);
        if (wr == 1) PG8_BAR;
        PG8_WAIT_V(2); PG8_BAR;
        PG8_STAGE(PG8_SB(1, 0), cB + kstep, voffB); PG8_STAGE(PG8_SA(1, 0), cA + kstep, voffA); PG8_STAGE(PG8_SB(1, 1), cB + hstep + kstep, voffB);
        PG8_WAIT_V(6); PG8_BAR;
    } else {
        PG8_STAGE(PG8_SB(0, 0), cB, voffB); PG8_STAGE(PG8_SA(0, 0), cA, voffA); PG8_STAGE(PG8_SB(0, 1), cB + hstep, voffB); PG8_STAGE(PG8_SA(0, 1), cA + hstep, voffA);
        if (wr == 1) PG8_BAR;
        PG8_WAIT_V(4); PG8_BAR;
        PG8_STAGE(PG8_SB(1, 0), cB + kstep, voffB); PG8_STAGE(PG8_SA(1, 0), cA + kstep, voffA); PG8_STAGE(PG8_SB(1, 1), cB + hstep + kstep, voffB);
        PG8_WAIT_V(6); PG8_BAR;
    }
    for (;;) {
        const bool has_next = S.next(ui + 1, nxt);
        const char* nA = has_next ? (const char*)g.A + (size_t)nxt.pm * tstep : cA; const char* nB = has_next ? (const char*)g.Bt + (size_t)nxt.pn * tstep : cB;
        for (int t = 0; t < nt; t += 2) {
            const bool last = (t == nt - 2);
            const char* a1 = cA + (size_t)(t + 1) * kstep;
            const char* a2 = last ? nA : cA + (size_t)(t + 2) * kstep; const char* b2 = last ? nB : cB + (size_t)(t + 2) * kstep;
            const char* a3 = a2 + kstep; const char* b3 = b2 + kstep;
            if (last && has_next) S.a_ready(nxt);
            if constexpr (Epi::PREFETCH) { if (last) E.prefetch(cur, lds + STAGE_BYTES, wid, lane); }
            if constexpr (SP2) {
            PG8_LDB(B0, 0, 0); PG8_LDB(B1, 0, 1); PG8_SCHED; PG8_LDA(At, 0, 0); PG8_STAGE(PG8_SA(1, 1), a1 + hstep, voffA);
            PG8_WAIT_V(8); PG8_WAIT_L(0); PG8_BAR; PG8_MMA(0, 0, At, B0); PG8_MMA(0, 1, At, B1); PG8_BAR; PG8_SCHED;
            PG8_LDA(At, 0, 1); PG8_STAGE(PG8_SB(0, 0), b2, voffB); PG8_STAGE(PG8_SB(0, 1), b2 + hstep, voffB); PG8_STAGE(PG8_SA(0, 0), a2, voffA);
            PG8_WAIT_V(8); PG8_WAIT_L(0); PG8_BAR; PG8_MMA(1, 0, At, B0); PG8_MMA(1, 1, At, B1); PG8_BAR; PG8_SCHED;
            PG8_LDB(B0, 1, 0); PG8_LDB(B1, 1, 1); PG8_SCHED; PG8_LDA(At, 1, 0); PG8_STAGE(PG8_SA(0, 1), a2 + hstep, voffA);
            PG8_WAIT_V(8); PG8_WAIT_L(0); PG8_BAR; PG8_MMA(0, 0, At, B0); PG8_MMA(0, 1, At, B1); PG8_BAR; PG8_SCHED;
            PG8_LDA(At, 1, 1); PG8_STAGE(PG8_SB(1, 0), b3, voffB); PG8_STAGE(PG8_SB(1, 1), b3 + hstep, voffB); PG8_STAGE(PG8_SA(1, 0), a3, voffA);
            PG8_WAIT_V(8); PG8_WAIT_L(0); PG8_BAR; PG8_MMA(1, 0, At, B0); PG8_MMA(1, 1, At, B1); PG8_BAR; PG8_SCHED;
            } else {
            PG8_LDB(B0, 0, 0); PG8_SCHED; PG8_LDA(At, 0, 0); PG8_STAGE(PG8_SA(1, 1), a1 + hstep, voffA);
            PG8_WAIT_L(8); PG8_BAR; PG8_WAIT_L(0); PG8_MMA(0, 0, At, B0); PG8_BAR; PG8_SCHED;
            PG8_LDB(B1, 0, 1); PG8_STAGE(PG8_SB(0, 0), b2, voffB);
            PG8_BAR; PG8_WAIT_L(0); PG8_MMA(0, 1, At, B1); PG8_BAR;
            PG8_LDA(At, 0, 1); PG8_STAGE(PG8_SA(0, 0), a2, voffA);
            PG8_BAR; PG8_WAIT_L(0); PG8_MMA(1, 0, At, B0); PG8_BAR; PG8_SCHED;
            PG8_STAGE(PG8_SB(0, 1), b2 + hstep, voffB);
            PG8_WAIT_V(6); PG8_BAR; PG8_MMA(1, 1, At, B1); PG8_BAR;
            PG8_LDB(B0, 1, 0); PG8_SCHED; PG8_LDA(At, 1, 0); PG8_STAGE(PG8_SA(0, 1), a2 + hstep, voffA);
            PG8_WAIT_L(8); PG8_BAR; PG8_WAIT_L(0); PG8_MMA(0, 0, At, B0); PG8_BAR; PG8_SCHED;
            PG8_LDB(B1, 1, 1); PG8_STAGE(PG8_SB(1, 0), b3, voffB);
            PG8_BAR; PG8_WAIT_L(0); PG8_MMA(0, 1, At, B1); PG8_BAR;
            PG8_LDA(At, 1, 1); PG8_STAGE(PG8_SA(1, 0), a3, voffA);
            PG8_BAR; PG8_WAIT_L(0); PG8_MMA(1, 0, At, B0); PG8_BAR; PG8_SCHED;
            PG8_STAGE(PG8_SB(1, 1), b3 + hstep, voffB);
            PG8_WAIT_V(6); PG8_BAR; PG8_MMA(1, 1, At, B1); PG8_BAR;
            }
        }
        if constexpr (ALIGN_EPI) { if (wr == 0) PG8_BAR; }
        if constexpr (!Epi::AFTER_DRAIN) { E(acc, cur, wr, wc, fr, fq, lds + STAGE_BYTES); S.done(cur); }
        if (!has_next) break;
#pragma unroll
        for (int a = 0; a < 2; ++a)
#pragma unroll
            for (int b = 0; b < 2; ++b)
#pragma unroll
                for (int m = 0; m < 4; ++m)
#pragma unroll
                    for (int n = 0; n < 2; ++n) acc[a][b][m][n] = (f32x4){0.f, 0.f, 0.f, 0.f};
        cur = nxt; cA = nA; cB = nB; ++ui;
        if constexpr (ALIGN_EPI) { if (wr == 1) PG8_BAR; }
    }
    PG8_WAIT_V(0);
    if constexpr (!ALIGN_EPI) { if (wr == 0) PG8_BAR; }
    PG8_BAR;
    if constexpr (Epi::AFTER_DRAIN) { E.fused(acc, cur, wr, wc, fr, fq, lds, wid, lane); S.done(cur); }
#undef PG8_SA
#undef PG8_SB
#undef PG8_STAGE
#undef PG8_LDA
#undef PG8_LDB
#undef PG8_MMA
#undef PG8_WAIT_V
#undef PG8_WAIT_L
#undef PG8_BAR
#undef PG8_SCHED
}
}

constexpr int NWAVES = 8, NTHR = 512;
constexpr int NB = 4, SEQ = 4096, DM = 2048, MTOK = NB * SEQ, NLAYER = 4;
constexpr int DFF = 5504, NUP = 2 * DFF;
constexpr int INC = 5028, INP = 5120;
constexpr int DRW = 768, RWC = 2560, PO_POOL = 2560, DPOOL = 512, PO_NSA = 3072;
constexpr int PO_Q = PO_NSA, PO_KC = PO_NSA + 768, PO_VC = PO_KC + 192, PO_KS = PO_VC + 192, PO_VS = PO_KS + 192, PO_KW = PO_VS + 192, PO_VW = PO_KW + 192, PO_GL = PO_VW + 192;
static_assert(PO_GL + 36 == INC, "W_in column map");
constexpr int NCMP = 255, NCMPP = 256;
constexpr float ALPHA = 1.6817928305074290f;
constexpr float LN_EPS = 1e-5f, GN_EPS = 64e-5f;
constexpr int NPH = 1 + 14 * NLAYER;

constexpr size_t MiB = 1u << 20;
constexpr size_t WS_CTL = 0, CTL_ZERO_BYTES = 1 * MiB;
constexpr size_t WS_ROPE = 1 * MiB;
constexpr size_t WS_KC = 2 * MiB, WS_VC = 2 * MiB + 512 * 1024;
constexpr size_t WS_SC = 3 * MiB;
constexpr size_t WS_WUP1 = 8 * MiB, WS_WDN1 = 51 * MiB, WS_WIN = WS_WDN1 + 21 * MiB + 512 * 1024, WS_WOUT = WS_WIN + 20 * MiB, WS_WUP2 = WS_WOUT + 8 * MiB, WS_WDN2 = WS_WUP2 + 43 * MiB;
constexpr size_t WS_XB = 165 * MiB;
static_assert(WS_WDN2 + (size_t)DM * DFF * 2 <= WS_XB, "weights map");
constexpr size_t WS_CAT = 229 * MiB;
constexpr size_t WS_QR = 293 * MiB;
constexpr size_t WS_KS = 317 * MiB, WS_KW = 323 * MiB, WS_VS = 329 * MiB, WS_VW = 335 * MiB;
constexpr size_t WS_P = 341 * MiB;
constexpr size_t WS_H = 661 * MiB;
constexpr size_t WS_Y = 833 * MiB;
constexpr size_t WS_SV = WS_H;
constexpr size_t SV_STRIDE = 48 * MiB;
static_assert(WS_SV + 6 * SV_STRIDE <= WS_Y + 128 * MiB, "scan overlay");
constexpr size_t WS_G = 961 * MiB, WS_YS = 1009 * MiB;
constexpr size_t WS_VST = 1057 * MiB, WS_VWT = 1063 * MiB;
constexpr size_t WS_VCT = 6 * MiB;
constexpr size_t WS_SW = 1069 * MiB;
constexpr size_t WS_W2T = WS_SW, WS_A2T = WS_W2T + 768 * 64 * 2, WS_G2T = WS_A2T + 768 * 64 * 2, WS_PWT = WS_G2T + 768 * 128 * 2;
constexpr size_t WS_W1T = WS_PWT + 4 * 128 * 128 * 2, WS_W2CT = WS_W1T + 2 * 256 * 2048 * 2, WS_CBIAS = WS_W2CT + 2 * 64 * 256 * 2;
constexpr size_t WS_SPREC = 1073 * MiB;
constexpr size_t SPREC_BYTES = 15360, WS_YR = WS_SPREC + (size_t)NB * 12 * 256 * SPREC_BYTES + MiB;
static_assert(true, ""); constexpr size_t WS_XL8 = WS_YR;
constexpr int GWN = NUP + INP + NUP;
constexpr size_t WS_AUX = WS_YR + 128 * MiB;
constexpr size_t AUX_ST = 0, AUX_GWBW = AUX_ST + (size_t)12 * MTOK * 2 * 4, AUX_ZERO_BYTES = AUX_GWBW + (size_t)NLAYER * 2 * GWN * 4, AUX_LNGB = (AUX_ZERO_BYTES + 255) & ~(size_t)255;
constexpr size_t WS_END = WS_AUX + AUX_LNGB + (size_t)12 * 2 * DM * 4 + MiB;
static_assert(WS_CBIAS + 2 * 256 * 4 <= WS_END, "small weights map");

constexpr int LDS_SCRATCH = 147456;
constexpr int LDS_BYTES = LDS_SCRATCH + 1024, MISC_OFF = LDS_SCRATCH + 320;

#define GAS __attribute__((address_space(1)))
#define LAS __attribute__((address_space(3)))
typedef unsigned short bf16;
typedef float f32x4 __attribute__((ext_vector_type(4)));
typedef float f32x2 __attribute__((ext_vector_type(2)));
typedef unsigned u32x4 __attribute__((ext_vector_type(4)));
typedef unsigned u32x2 __attribute__((ext_vector_type(2)));
#define LDS_WAIT() asm volatile("s_waitcnt lgkmcnt(0)" ::: "memory")
__device__ __forceinline__ unsigned f2bf(float f) { unsigned u = __builtin_bit_cast(unsigned, f); return (u + 0x7fffu + ((u >> 16) & 1u)) >> 16; }
__device__ __forceinline__ unsigned pk2(float lo, float hi) { return f2bf(lo) | (f2bf(hi) << 16); }
__device__ __forceinline__ float bf2f(unsigned short b) { return __builtin_bit_cast(float, ((unsigned)b) << 16); }
__device__ __forceinline__ float wave_sum(float v) {
#pragma unroll
    for (int o = 1; o < 64; o <<= 1) v += __shfl_xor(v, o);
    return v;
}
__device__ __forceinline__ float wave_max(float v) {
#pragma unroll
    for (int o = 1; o < 64; o <<= 1) v = fmaxf(v, __shfl_xor(v, o));
    return v;
}
__device__ __forceinline__ float sigmoidf_(float x) { return 1.0f / (1.0f + expf(-x)); }
template <int CTRL> __device__ __forceinline__ float dpp_f(float v) { return __builtin_bit_cast(float, __builtin_amdgcn_update_dpp(0, __builtin_bit_cast(int, v), CTRL, 0xF, 0xF, true)); }
__device__ __forceinline__ float row16_sum(float v) {
    v += dpp_f<0xB1>(v); v += dpp_f<0x4E>(v); v += dpp_f<0x141>(v); v += dpp_f<0x140>(v); return v;
}

#define XB_TMO      128
#define XB_XCNT(j)  (256  + 64 * (j))
#define XB_XSUB(j)  (1280 + 64 * (j))
#define XB_XGEN(j)  (2304 + 64 * (j))
#define XB_TOP      3328
#define XB_TOPGEN   3392
#define XCD_BAR_WORDS 3456
#define XB_SPIN_CAP (1u << 18)

__device__ __forceinline__ unsigned xb_ld(unsigned* p)              { return __hip_atomic_load(p, __ATOMIC_RELAXED, __HIP_MEMORY_SCOPE_AGENT); }
__device__ __forceinline__ unsigned xb_add(unsigned* p, unsigned v) { return __hip_atomic_fetch_add(p, v, __ATOMIC_RELAXED, __HIP_MEMORY_SCOPE_AGENT); }
__device__ __forceinline__ unsigned xb_xcc_id() { return (unsigned)__builtin_amdgcn_s_getreg((3 << 11) | 20) & 0xFu; }
#define XB_SPIN(cond, bar) do { unsigned _sp = 0; while (cond) { __builtin_amdgcn_s_sleep(1); \
    if ((++_sp & 255u) == 0u) { if (xb_ld(&(bar)[XB_TMO])) break; if (_sp > XB_SPIN_CAP) { atomicAdd(&(bar)[XB_TMO], 1u); break; } } } } while (0)

struct XcdBarrier {
    unsigned* bar; unsigned x;
    volatile LAS unsigned* st;
};

__device__ __forceinline__ XcdBarrier xcd_barrier_post(unsigned* bar, volatile LAS unsigned* st) {
    XcdBarrier b; b.bar = bar; b.x = xb_xcc_id(); b.st = st;
    if (threadIdx.x == 0) (void)xb_add(&bar[XB_XCNT(b.x)], 1u);
    return b;
}
__device__ __forceinline__ void xcd_barrier_complete(unsigned* bar, unsigned x, unsigned& nloc, unsigned& nx) {
    const unsigned G = gridDim.x * gridDim.y * gridDim.z;
    unsigned sum, cnt, mine, sp = 0u;
    for (;;) {
        sum = 0u; cnt = 0u; mine = 0u;
#pragma unroll
        for (unsigned j = 0; j < 16; ++j) { const unsigned c = xb_ld(&bar[XB_XCNT(j)]); sum += c; cnt += (c > 0u) ? 1u : 0u; mine = (j == x) ? c : mine; }
        if (sum == G) break;
        __builtin_amdgcn_s_sleep(1);
        if ((++sp & 255u) == 0u) { if (xb_ld(&bar[XB_TMO])) break; if (sp > XB_SPIN_CAP) { atomicAdd(&bar[XB_TMO], 1u); break; } }
    }
    nloc = mine > 0u ? mine : 1u; nx = cnt > 0u ? cnt : 1u;
}

__device__ __forceinline__ void xcd_barrier(const XcdBarrier& b) {
    asm volatile("s_waitcnt vmcnt(0)" ::: "memory");
    __syncthreads();
    if (threadIdx.x == 0) {
        unsigned* bar = b.bar;
        __builtin_amdgcn_s_waitcnt(0);
        unsigned nloc = b.st[0], nx = b.st[1];
        if (nloc == 0u) { xcd_barrier_complete(bar, b.x, nloc, nx); b.st[0] = nloc; b.st[1] = nx; }
        const unsigned old = xb_add(&bar[XB_XSUB(b.x)], 1u);
        const unsigned gen = old / nloc;
        if (old + 1u == (gen + 1u) * nloc) {
            __builtin_amdgcn_fence(__ATOMIC_RELEASE, "agent");
            asm volatile("s_waitcnt vmcnt(0)" ::: "memory");
            const unsigned og = xb_add(&bar[XB_TOP], 1u);
            const unsigned tg = og / nx;
            if (og + 1u == (tg + 1u) * nx) xb_add(&bar[XB_TOPGEN], 1u);
            else XB_SPIN(xb_ld(&bar[XB_TOPGEN]) == tg, bar);
            __builtin_amdgcn_fence(__ATOMIC_ACQUIRE, "agent");
            xb_add(&bar[XB_XGEN(b.x)], 1u);
            asm volatile("s_waitcnt vmcnt(0)" ::: "memory");
        } else {
            XB_SPIN(xb_ld(&bar[XB_XGEN(b.x)]) == gen, bar);
            __builtin_amdgcn_fence(__ATOMIC_ACQUIRE, "agent");
            asm volatile("s_waitcnt vmcnt(0)" ::: "memory");
        }
    }
    __syncthreads();
}

struct Args { const float* in[34]; float* out; unsigned char* ws; int ph_lo, ph_hi, rep; };
__device__ __forceinline__ int opaque0() { int z = 0; asm volatile("" : "+s"(z)); return z; }
#define OPQ_S(x) asm volatile("" : "+s"(x))
#define OPQ_SI(x) do { (x) = __builtin_amdgcn_readfirstlane(x); asm volatile("" : "+s"(x)); } while (0)
#define OPQ_V(x) asm volatile("" : "+v"(x))
#define INPTR(a, idx) ((a).in[(idx) + opaque0()])
enum { I_X = 0, I_UP1, I_DN1, I_LN1G, I_LN1B, I_WIN, I_MU, I_W0, I_W2, I_A0, I_A2, I_G2, I_KK, I_KA, I_RK, I_GNG, I_GNB, I_PW, I_PB, I_PS, I_PEK, I_PEV, I_CK1, I_CK2, I_CV1, I_CV2, I_GB, I_WOUT, I_LN2G, I_LN2B, I_UP2, I_DN2, I_LN3G, I_LN3B };

template <bool LN = false> __device__ __forceinline__ void transpose_item(const float* W, int K, int Nsrc, bf16* WT, int dst0, LAS float* scr, int k0, int n0, int lane, const float* lng = nullptr, const float* lnb = nullptr, float* gwp = nullptr) {
    const int c4 = lane & 15, rq = lane >> 4; const int n = n0 + 4 * c4; const bool ok = n < Nsrc;
    const float* wp = W + (size_t)(k0 + rq) * Nsrc + n;
#pragma unroll 8
    for (int i = 0; i < 16; ++i) { const f32x4 v = ok ? *(const f32x4*)(wp + (size_t)(4 * i) * Nsrc) : (f32x4){0.f, 0.f, 0.f, 0.f};
        LAS float* d = scr + (4 * i + rq) * 65 + 4 * c4; d[0] = v.x; d[1] = v.y; d[2] = v.z; d[3] = v.w; }
    const int c = lane & 7;
    f32x4 g0 = {1.f, 1.f, 1.f, 1.f}, g1 = g0, b0 = {0.f, 0.f, 0.f, 0.f}, b1 = b0;
    if constexpr (LN) { g0 = *(const f32x4*)(lng + k0 + 8 * c); g1 = *(const f32x4*)(lng + k0 + 8 * c + 4); b0 = *(const f32x4*)(lnb + k0 + 8 * c); b1 = *(const f32x4*)(lnb + k0 + 8 * c + 4); }
    LDS_WAIT();
    float mg = 0.f, mb = 0.f;
#pragma unroll
    for (int j = 0; j < 8; ++j) { const int nn = (lane >> 3) + 8 * j; const LAS float* s = scr + (8 * c) * 65 + nn;
        float v[8];
#pragma unroll
        for (int q = 0; q < 8; ++q) v[q] = s[q * 65];
        if constexpr (LN) {
            float pb = v[0] * b0.x + v[1] * b0.y + v[2] * b0.z + v[3] * b0.w + v[4] * b1.x + v[5] * b1.y + v[6] * b1.z + v[7] * b1.w;
            v[0] *= g0.x; v[1] *= g0.y; v[2] *= g0.z; v[3] *= g0.w; v[4] *= g1.x; v[5] *= g1.y; v[6] *= g1.z; v[7] *= g1.w;
            float pg = ((v[0] + v[1]) + (v[2] + v[3])) + ((v[4] + v[5]) + (v[6] + v[7]));
            pg += dpp_f<0xB1>(pg); pg += dpp_f<0x4E>(pg); pg += dpp_f<0x141>(pg); pb += dpp_f<0xB1>(pb); pb += dpp_f<0x4E>(pb); pb += dpp_f<0x141>(pb);
            mg = c == j ? pg : mg; mb = c == j ? pb : mb; }
        u32x4 o; o.x = pk2(v[0], v[1]); o.y = pk2(v[2], v[3]); o.z = pk2(v[4], v[5]); o.w = pk2(v[6], v[7]);
        *(u32x4*)(WT + (size_t)(dst0 + nn) * K + k0 + 8 * c) = o; }
    if constexpr (LN) { const int nm = n0 + (lane >> 3) + 8 * c;
        if (nm < Nsrc) {
            __hip_atomic_fetch_add((GAS float*)gwp + nm, __builtin_rintf(mg * 65536.0f) * (1.0f / 65536.0f), __ATOMIC_RELAXED, __HIP_MEMORY_SCOPE_AGENT);
            __hip_atomic_fetch_add((GAS float*)gwp + GWN + nm, __builtin_rintf(mb * 65536.0f) * (1.0f / 65536.0f), __ATOMIC_RELAXED, __HIP_MEMORY_SCOPE_AGENT); } }
    LDS_WAIT();
}
__device__ __forceinline__ int up_dst_row(int n0) { return n0 < DFF ? 256 * (n0 / 128) + (n0 % 128) : 256 * ((n0 - DFF) / 128) + 128 + ((n0 - DFF) % 128); }

__device__ __forceinline__ void phase_wconv(const Args& a, int l, LAS unsigned char* lds, int gw, int NGW, int wave, int lane) {
    OPQ_SI(gw); OPQ_SI(wave); OPQ_V(lane);
    LAS float* scr = (LAS float*)(lds + wave * 16640);
    unsigned char* ws = a.ws + opaque0();
    float* gwl = a.rep ? (float*)(ws + WS_END - MiB) : (float*)(ws + WS_AUX + AUX_GWBW) + (size_t)l * 2 * GWN;
    {
        const int gt = gw * 64 + lane; if (gt < 3 * 2 * (DM / 4)) { const int j = gt / (2 * (DM / 4)), r2 = gt - j * 2 * (DM / 4), isb = r2 / (DM / 4), c4_ = r2 - isb * (DM / 4);
            const float* src = (j == 0 ? (isb ? INPTR(a, I_LN1B) : INPTR(a, I_LN1G)) : j == 1 ? (isb ? INPTR(a, I_LN2B) : INPTR(a, I_LN2G)) : (isb ? INPTR(a, I_LN3B) : INPTR(a, I_LN3G))) + (size_t)l * DM;
            ((f32x4*)(ws + WS_AUX + AUX_LNGB))[((size_t)(3 * l + j) * 2 + isb) * (DM / 4) + c4_] = ((const f32x4*)src)[c4_]; } }
    constexpr int I_UP = (DM / 64) * (NUP / 64), I_DN = (DFF / 64) * (DM / 64), I_IN = (DM / 64) * (INP / 64), I_OUT = (DM / 64) * (DM / 64);
    constexpr int NIT = 2 * I_UP + 2 * I_DN + I_IN + I_OUT + 12 + 12 + 24 + 16 + 256 + 8;
    for (int it = gw; it < NIT; it += NGW) {
        int r = it;
        if (r < 2 * I_UP) { const int which = r / I_UP; r -= which * I_UP; const int nblk = NUP / 64, kb = r / nblk, nb = r % nblk;
            const float* W = a.in[which ? I_UP2 : I_UP1] + (size_t)l * DM * NUP; bf16* WT = (bf16*)(ws + (which ? WS_WUP2 : WS_WUP1));
            const float* lg = which ? INPTR(a, I_LN2G) + (size_t)l * DM : (l > 0 ? INPTR(a, I_LN3G) + (size_t)(l - 1) * DM : nullptr);
            const float* lb = which ? INPTR(a, I_LN2B) + (size_t)l * DM : (l > 0 ? INPTR(a, I_LN3B) + (size_t)(l - 1) * DM : nullptr);
            if (lg) transpose_item<true>(W, DM, NUP, WT, up_dst_row(64 * nb), scr, 64 * kb, 64 * nb, lane, lg, lb, gwl + (which ? NUP + INP : 0)); else transpose_item<false>(W, DM, NUP, WT, up_dst_row(64 * nb), scr, 64 * kb, 64 * nb, lane); continue; }
        r -= 2 * I_UP;
        if (r < 2 * I_DN) { const int which = r / I_DN; r -= which * I_DN; const int nblk = DM / 64, kb = r / nblk, nb = r % nblk;
            const float* W = a.in[which ? I_DN2 : I_DN1] + (size_t)l * DFF * DM; bf16* WT = (bf16*)(ws + (which ? WS_WDN2 : WS_WDN1));
            transpose_item(W, DFF, DM, WT, 64 * nb, scr, 64 * kb, 64 * nb, lane); continue; }
        r -= 2 * I_DN;
        if (r < I_IN) { const int nblk = INP / 64, kb = r / nblk, nb = r % nblk;
            transpose_item<true>(INPTR(a, I_WIN) + (size_t)l * DM * INC, DM, INC, (bf16*)(ws + WS_WIN), 64 * nb, scr, 64 * kb, 64 * nb, lane, INPTR(a, I_LN1G) + (size_t)l * DM, INPTR(a, I_LN1B) + (size_t)l * DM, gwl + NUP); continue; }
        r -= I_IN;
        if (r < I_OUT) { const int nblk = DM / 64, kb = r / nblk, nb = r % nblk;
            transpose_item(INPTR(a, I_WOUT) + (size_t)l * DM * DM, DM, DM, (bf16*)(ws + WS_WOUT), 64 * nb, scr, 64 * kb, 64 * nb, lane); continue; }
        r -= I_OUT;
        if (r < 12) { transpose_item(INPTR(a, I_W2) + (size_t)l * 64 * DRW, 64, DRW, (bf16*)(ws + WS_W2T), 64 * r, scr, 0, 64 * r, lane); continue; } r -= 12;
        if (r < 12) { transpose_item(INPTR(a, I_A2) + (size_t)l * 64 * DRW, 64, DRW, (bf16*)(ws + WS_A2T), 64 * r, scr, 0, 64 * r, lane); continue; } r -= 12;
        if (r < 24) { const int kb = r / 12, nb = r % 12; transpose_item(INPTR(a, I_G2) + (size_t)l * 128 * DRW, 128, DRW, (bf16*)(ws + WS_G2T), 64 * nb, scr, 64 * kb, 64 * nb, lane); continue; } r -= 24;
        if (r < 16) { const int gi = r >> 2, q = r & 3, kb = q >> 1, nb = q & 1; transpose_item(INPTR(a, I_PW) + ((size_t)l * 4 + gi) * 128 * 128, 128, 128, (bf16*)(ws + WS_PWT) + gi * 128 * 128, 64 * nb, scr, 64 * kb, 64 * nb, lane); continue; } r -= 16;
        if (r < 256) { const int ten = r >> 7, q = r & 127, kb = q >> 2, nb = q & 3; transpose_item(INPTR(a, ten ? I_CV1 : I_CK1) + (size_t)l * 2048 * 256, 2048, 256, (bf16*)(ws + WS_W1T) + (size_t)ten * 256 * 2048, 64 * nb, scr, 64 * kb, 64 * nb, lane); continue; } r -= 256;
        { const int ten = r >> 2, kb = r & 3; transpose_item(INPTR(a, ten ? I_CV2 : I_CK2) + (size_t)l * 256 * 64, 256, 64, (bf16*)(ws + WS_W2CT) + (size_t)ten * 64 * 256, 0, scr, 64 * kb, 0, lane); }
    }
}

__device__ __forceinline__ void phase_prologue(const Args& a, int gtid, int NGT) {
    OPQ_V(gtid);
    const f32x4* x4 = (const f32x4*)INPTR(a, I_X); u32x2* xb = (u32x2*)(a.ws + WS_XB);
    int* xl8 = (int*)(a.ws + WS_XL8);
    for (size_t i = gtid; i < (size_t)MTOK * DM / 4; i += NGT) { const f32x4 v = x4[i]; u32x2 o; o.x = pk2(v.x, v.y); o.y = pk2(v.z, v.w); xb[i] = o;
        int w = __builtin_amdgcn_cvt_pk_bf8_f32(v.x - __builtin_bit_cast(float, o.x << 16), v.y - __builtin_bit_cast(float, o.x & 0xffff0000u), 0, false);
        w = __builtin_amdgcn_cvt_pk_bf8_f32(v.z - __builtin_bit_cast(float, o.y << 16), v.w - __builtin_bit_cast(float, o.y & 0xffff0000u), w, true); xl8[i] = w; }
    f32x2* rope = (f32x2*)(a.ws + WS_ROPE);
    for (int i = gtid; i < SEQ * 8; i += NGT) { const int s = i >> 3, k = i & 7;
        const float inv = powf(500000.0f, -(float)k * 0.125f); const float ang = (float)s * inv;
        const double ad = (double)ang; const double q = __builtin_rint(ad * 0.15915494309189535); const double rr = ad - q * 6.283185307179586;
        const float rf = (float)rr; rope[i] = (f32x2){cosf(rf), sinf(rf)}; }
}

__device__ __forceinline__ void phase_ln_final(const bf16* HI, const unsigned char* LO, const float* g, const float* b, float* X, int gw, int NGW, int lane) {
    OPQ_SI(gw); OPQ_V(lane);
    f32x4 gv[8], bv[8];
#pragma unroll
    for (int j = 0; j < 8; ++j) { gv[j] = ((const f32x4*)g)[64 * j + lane]; bv[j] = ((const f32x4*)b)[64 * j + lane]; }
    u32x2 nh[8]; unsigned nl[8];
    { const size_t m0 = (size_t)(gw < MTOK ? gw : 0) * DM;
#pragma unroll
        for (int j = 0; j < 8; ++j) { nh[j] = ((const u32x2*)(HI + m0))[64 * j + lane]; nl[j] = ((const unsigned*)(LO + m0))[64 * j + lane]; } }
    for (int m = gw; m < MTOK; m += NGW) {
        f32x4 v[8]; float s = 0.f;
#pragma unroll
        for (int j = 0; j < 8; ++j) { const f32x2 l0 = __builtin_amdgcn_cvt_pk_f32_bf8((int)nl[j], false), l1 = __builtin_amdgcn_cvt_pk_f32_bf8((int)nl[j], true);
            v[j].x = __builtin_bit_cast(float, nh[j].x << 16) + l0.x; v[j].y = __builtin_bit_cast(float, nh[j].x & 0xffff0000u) + l0.y; v[j].z = __builtin_bit_cast(float, nh[j].y << 16) + l1.x; v[j].w = __builtin_bit_cast(float, nh[j].y & 0xffff0000u) + l1.y; }
        { const size_t mn = (size_t)(m + NGW < MTOK ? m + NGW : m) * DM;
#pragma unroll
            for (int j = 0; j < 8; ++j) { nh[j] = ((const u32x2*)(HI + mn))[64 * j + lane]; nl[j] = ((const unsigned*)(LO + mn))[64 * j + lane]; } }
#pragma unroll
        for (int j = 0; j < 8; ++j) s += (v[j].x + v[j].y) + (v[j].z + v[j].w);
        const float mean = wave_sum(s) * (1.f / DM); float s2 = 0.f;
#pragma unroll
        for (int j = 0; j < 8; ++j) { v[j] = v[j] - mean; s2 += (v[j].x * v[j].x + v[j].y * v[j].y) + (v[j].z * v[j].z + v[j].w * v[j].w); }
        const float rstd = 1.f / sqrtf(wave_sum(s2) * (1.f / DM) + LN_EPS);
        f32x4* xr = (f32x4*)(X + (size_t)m * DM) + lane;
#pragma unroll
        for (int j = 0; j < 8; ++j) xr[64 * j] = v[j] * rstd * gv[j] + bv[j];
    }
}
__device__ __forceinline__ void phase_ln(const float* Y, const float* g, const float* b, float* X, bf16* XB, float* stats, int gw, int NGW, int lane) {
    OPQ_SI(gw); OPQ_V(lane);
    f32x4 gv[8], bv[8];
#pragma unroll
    for (int j = 0; j < 8; ++j) { gv[j] = ((const f32x4*)g)[64 * j + lane]; bv[j] = ((const f32x4*)b)[64 * j + lane]; }
    if (gw < NWAVES) { f32x4* gd = (f32x4*)(stats + 2 * MTOK) + gw * 64 + lane; gd[0] = ((const f32x4*)g)[gw * 64 + lane]; gd[512] = ((const f32x4*)b)[gw * 64 + lane]; }
    f32x4 nx[8];
    { const f32x4* yr0 = (const f32x4*)(Y + (size_t)(gw < MTOK ? gw : 0) * DM) + lane;
#pragma unroll
        for (int j = 0; j < 8; ++j) nx[j] = yr0[64 * j]; }
    for (int m = gw; m < MTOK; m += NGW) {
        f32x4 v[8]; float s = 0.f;
#pragma unroll
        for (int j = 0; j < 8; ++j) v[j] = nx[j];
        { const int mn = m + NGW < MTOK ? m + NGW : m; const f32x4* yrn = (const f32x4*)(Y + (size_t)mn * DM) + lane;
#pragma unroll
            for (int j = 0; j < 8; ++j) nx[j] = yrn[64 * j]; }
#pragma unroll
        for (int j = 0; j < 8; ++j) s += (v[j].x + v[j].y) + (v[j].z + v[j].w);
        const float mean = wave_sum(s) * (1.f / DM); float s2 = 0.f;
#pragma unroll
        for (int j = 0; j < 8; ++j) { v[j] = v[j] - mean; s2 += (v[j].x * v[j].x + v[j].y * v[j].y) + (v[j].z * v[j].z + v[j].w * v[j].w); }
        const float rstd = 1.f / sqrtf(wave_sum(s2) * (1.f / DM) + LN_EPS);
        if (lane == 0) *(f32x2*)(stats + 2 * (size_t)m) = (f32x2){mean, rstd};
        u32x2* xb = (u32x2*)(XB + (size_t)m * DM) + lane;
        if (X) { f32x4* xr = (f32x4*)(X + (size_t)m * DM) + lane;
#pragma unroll
            for (int j = 0; j < 8; ++j) { const f32x4 o = v[j] * rstd * gv[j] + bv[j]; xr[64 * j] = o; } }
#pragma unroll
        for (int j = 0; j < 8; ++j) { const f32x4 o = v[j] * rstd * gv[j] + bv[j]; u32x2 w; w.x = pk2(o.x, o.y); w.y = pk2(o.z, o.w); xb[64 * j] = w; }
    }
}


typedef float f32x16 __attribute__((ext_vector_type(16)));
typedef short bf16x8 __attribute__((ext_vector_type(8)));
#define MFMA32(a, b, c) __builtin_amdgcn_mfma_f32_32x32x16_bf16((a), (b), (c), 0, 0, 0)
#define WSYNC() asm volatile("s_waitcnt lgkmcnt(0)" ::: "memory")
__device__ __forceinline__ void half_swap(float x, float& lo, float& hi) { float a = x, b = x; asm volatile("s_nop 1\n\tv_permlane32_swap_b32 %0, %1" : "+v"(a), "+v"(b)); lo = a; hi = b; }
__device__ __forceinline__ float half_max(float x) { float lo, hi; half_swap(x, lo, hi); return fmaxf(lo, hi); }
__device__ __forceinline__ float half_sum(float x) { float lo, hi; half_swap(x, lo, hi); return lo + hi; }
__device__ __forceinline__ float other_half(float x, int h) { float lo, hi; half_swap(x, lo, hi); return h ? lo : hi; }
__device__ __forceinline__ unsigned cvtpk(float lo, float hi) { unsigned r; asm volatile("v_cvt_pk_bf16_f32 %0, %1, %2" : "=v"(r) : "v"(lo), "v"(hi)); return r; }
__device__ __forceinline__ float half32_sum(float v) { v = row16_sum(v); float a = v, b = v; asm volatile("s_nop 1\n\tv_permlane16_swap_b32 %0, %1" : "+v"(a), "+v"(b)); return a + b; }
__device__ __forceinline__ int vt_pos(int k) { return 16 * ((k >> 2) & 1) + 8 * (k >> 4) + 4 * ((k >> 3) & 1) + (k & 3); }
__device__ __forceinline__ float fexp(float x) { return __builtin_amdgcn_exp2f(x * 1.4426950408889634f); }
__device__ __forceinline__ float fsigmoid(float x) { return __builtin_amdgcn_rcpf(1.0f + __builtin_amdgcn_exp2f(x * -1.4426950408889634f)); }
__device__ __forceinline__ float ftanh(float x) { const float xc = fminf(fmaxf(x, -15.f), 15.f); return 1.0f - 2.0f * __builtin_amdgcn_rcpf(1.0f + __builtin_amdgcn_exp2f(xc * 2.8853900817779268f)); }
__device__ __forceinline__ float fsoftplus(float z) { return z > 20.f ? z : __builtin_amdgcn_logf(1.0f + __builtin_amdgcn_exp2f(z * 1.4426950408889634f)) * 0.6931471805599453f; }

#ifndef REP_MASK
#define REP_MASK 0
#endif
#ifndef M1_PREFETCH
#define M1_PREFETCH 1
#endif
constexpr int XP = 264, ZP = 520, HP = 264;
__device__ __forceinline__ bf16x8 lds_frag(const LAS bf16* p) { return *(const LAS bf16x8*)p; }
__device__ __forceinline__ bf16x8 cvt8(const f32x4 a, const f32x4 b) { u32x4 w; w.x = cvtpk(a.x, a.y); w.y = cvtpk(a.z, a.w); w.z = cvtpk(b.x, b.y); w.w = cvtpk(b.z, b.w); return __builtin_bit_cast(bf16x8, w); }
__device__ __forceinline__ void phase_m1(const Args& a, int l, LAS unsigned char* lds, int bid, int G, int tid, int wave, int lane) {
    OPQ_SI(bid); OPQ_V(tid); OPQ_SI(wave); lane = tid & 63;
    unsigned char* ws = a.ws + opaque0(); const float* P = (const float*)(ws + WS_P);
    const int r = lane & 31, h = lane >> 5;
    const f32x2* rope = (const f32x2*)(ws + WS_ROPE);
    for (int rp1 = 0; rp1 < (((REP_MASK) >> 22) & 1 ? 2 : 1); ++rp1)
    for (int unit = bid; unit < MTOK / 64; unit += G) {
        const int t0 = unit * 64, b = t0 >> 12, s0 = t0 & (SEQ - 1);
        LAS bf16* XL = (LAS bf16*)lds;
        LAS bf16* ZL = (LAS bf16*)(lds + 64 * XP * 2);
        { const float* mu = INPTR(a, I_MU) + (size_t)l * RWC;
#pragma unroll 8
            for (int i = tid; i < 64 * 256; i += NTHR) { const int tt = i >> 8, j = i & 255, col = 2304 + j; const int m = t0 + tt;
                const float pc = P[(size_t)m * INP + col]; const float pp = (s0 + tt) > 0 ? P[(size_t)(m - 1) * INP + col] : 0.f; const float v = pc + (pp - pc) * mu[col];
                const float f = j < 64 ? ftanh(v) : (j < 128 ? v : fsigmoid(v)); XL[tt * XP + j] = (bf16)f2bf(f); }
            {
                const int ch = tid, gi = ch >> 7, win = 2 << gi; const float* pp = P + (size_t)t0 * INP + PO_POOL + ch; float sum = 0.f;
                for (int j = 1; j < win; ++j) if (s0 - j >= 0) sum += pp[-(ptrdiff_t)j * INP];
#pragma unroll 8
                for (int tt = 0; tt < 64; ++tt) { const int s = s0 + tt; const float cur = pp[(size_t)tt * INP]; sum += cur; const int cnt = (s + 1) < win ? (s + 1) : win;
                    ZL[tt * ZP + ch] = (bf16)f2bf(sum / (float)cnt - cur); if (s - win + 1 >= 0) sum -= pp[((ptrdiff_t)tt - win + 1) * INP]; } } }
        __syncthreads();
        {
            const float* mu = INPTR(a, I_MU) + (size_t)l * RWC; const float* w0 = INPTR(a, I_W0) + (size_t)l * DRW; const float* a0 = INPTR(a, I_A0) + (size_t)l * DRW;
            const float* k_k = INPTR(a, I_KK) + (size_t)l * DRW; const float* k_a = INPTR(a, I_KA) + (size_t)l * DRW; const float* r_k = INPTR(a, I_RK) + (size_t)l * DRW;
            const bf16* W2T = (const bf16*)(ws + WS_W2T); const bf16* A2T = (const bf16*)(ws + WS_A2T); const bf16* G2T = (const bf16*)(ws + WS_G2T);
            float* vKK = (float*)(ws + WS_SV); float* vWR = (float*)(ws + WS_SV + SV_STRIDE); float* vW = (float*)(ws + WS_SV + 2 * SV_STRIDE);
            float* vKM = (float*)(ws + WS_SV + 3 * SV_STRIDE); float* vBB = (float*)(ws + WS_SV + 4 * SV_STRIDE); float* vV = (float*)(ws + WS_SV + 5 * SV_STRIDE);
            float* vG = (float*)(ws + WS_G); float* SC = (float*)(ws + WS_SC);
#pragma unroll 1
            for (int jj = 0; jj < 3; ++jj) {
                const int job = wave + 8 * jj, hd = job >> 1, th = job & 1;
                f32x16 aU[2], aA[2];
#pragma unroll
                for (int t = 0; t < 2; ++t)
#pragma unroll
                    for (int i = 0; i < 16; ++i) { aU[t][i] = 0.f; aA[t][i] = 0.f; }
                const LAS bf16* xa = XL + (32 * th + r) * XP + 8 * h;
#pragma unroll
                for (int ks = 0; ks < 4; ++ks) { const bf16x8 xt = lds_frag(xa + 16 * ks), xl = lds_frag(xa + 64 + 16 * ks);
#pragma unroll
                    for (int t = 0; t < 2; ++t) { const int c = hd * 64 + 32 * t + r;
                        aU[t] = MFMA32(xt, *(const bf16x8*)(W2T + (size_t)c * 64 + 16 * ks + 8 * h), aU[t]);
                        aA[t] = MFMA32(xl, *(const bf16x8*)(A2T + (size_t)c * 64 + 16 * ks + 8 * h), aA[t]); } }
                float pmr[2], pmk[2], pmv[2], pw0[2], pa0[2], pkk[2], pka[2], prk[2];
#pragma unroll
                for (int t = 0; t < 2; ++t) { const int c = hd * 64 + 32 * t + r; pmr[t] = mu[c]; pmk[t] = mu[768 + c]; pmv[t] = mu[1536 + c]; pw0[t] = w0[c]; pa0[t] = a0[c]; pkk[t] = k_k[c]; pka[t] = k_a[c]; prk[t] = r_k[c]; }
                const int lo_p = 4 * h * INP + hd * 64 + r, lo_s = 4 * h * DRW + hd * 64 + r;
                float ld[5][12];
#define M1_LOADROW(buf, i) do { int mr_ = t0 + 32 * th + ((i) & 3) + 8 * ((i) >> 2); OPQ_SI(mr_); const bool first_ = (s0 + 32 * th + ((i) & 3) + 8 * ((i) >> 2) + 4 * h) == 0; \
        const float* pc_ = P + (size_t)mr_ * INP; const float* pp_ = pc_ - INP; _Pragma("unroll") for (int t = 0; t < 2; ++t) { const int o = lo_p + 32 * t; \
        buf[6 * t + 0] = pc_[o]; buf[6 * t + 1] = pc_[o + 768]; buf[6 * t + 2] = pc_[o + 1536]; \
        if (((i) & 3) == 0) { buf[6 * t + 3] = first_ ? 0.f : pp_[o]; buf[6 * t + 4] = first_ ? 0.f : pp_[o + 768]; buf[6 * t + 5] = first_ ? 0.f : pp_[o + 1536]; } } } while (0)
#if M1_PREFETCH
                M1_LOADROW(ld[0], 0); M1_LOADROW(ld[1], 1); M1_LOADROW(ld[2], 2);
#else
                M1_LOADROW(ld[0], 0);
#endif
#pragma unroll
                for (int i = 0; i < 16; ++i) {
#if M1_PREFETCH
                    if (i + 3 < 16) M1_LOADROW(ld[(i + 3) % 5], i + 3);
#else
                    if (i > 0) M1_LOADROW(ld[i % 5], i);
#endif
                    int mrow = t0 + 32 * th + (i & 3) + 8 * (i >> 2); OPQ_SI(mrow);
                    float rr[2], kv[2], vv[2], dec[2], av[2], kr[2], km[2];
                    float ss = 0.f, s1 = 0.f, s2 = 0.f, s3 = 0.f;
#pragma unroll
                    for (int t = 0; t < 2; ++t) { const float* L = ld[i % 5] + 6 * t; const float* Lp = (i & 3) == 0 ? L + 3 : ld[(i + 4) % 5] + 6 * t;
                        const float rc = L[0], kc = L[1], vc = L[2], rp = Lp[0], kp = Lp[1], vp = Lp[2];
                        rr[t] = rc + (rp - rc) * pmr[t]; kv[t] = kc + (kp - kc) * pmk[t]; vv[t] = vc + (vp - vc) * pmv[t];
                        const float uu = pw0[t] + aU[t][i]; const float z = -uu; const float sp = fsoftplus(z); dec[t] = fexp(-fexp(-sp - 0.5f));
                        av[t] = fsigmoid(pa0[t] + aA[t][i]);
                        kr[t] = kv[t] * pkk[t]; km[t] = kv[t] * (1.0f + (av[t] - 1.0f) * pka[t]);
                        ss += kr[t] * kr[t]; s1 += kr[t] * av[t] * rr[t]; s2 += km[t] * rr[t]; s3 += rr[t] * km[t] * prk[t]; }
                    ss = half32_sum(ss); s1 = half32_sum(s1); s2 = half32_sum(s2); s3 = half32_sum(s3);
                    const float invn = 1.0f / fmaxf(sqrtf(ss), 1e-12f);
                    const size_t ro = (size_t)mrow * DRW;
#pragma unroll
                    for (int t = 0; t < 2; ++t) { const int o = lo_s + 32 * t; const float kk = kr[t] * invn;
                        (vKK + ro)[o] = kk; (vWR + ro)[o] = dec[t] * rr[t]; (vW + ro)[o] = dec[t]; (vKM + ro)[o] = km[t]; (vBB + ro)[o] = kk * av[t]; (vV + ro)[o] = vv[t]; }
                    if (r == 0) *(f32x4*)(SC + ((size_t)mrow * 12 + hd) * 4 + 4 * h * 48) = (f32x4){s1 * invn, s2, s3, 0.f};
                    asm volatile("" ::: "memory");
                }
#undef M1_LOADROW
                { f32x16 aG[2];
#pragma unroll
                    for (int t = 0; t < 2; ++t)
#pragma unroll
                        for (int i = 0; i < 16; ++i) aG[t][i] = 0.f;
#pragma unroll
                    for (int ks = 0; ks < 8; ++ks) { const bf16x8 xg = lds_frag(xa + 128 + 16 * ks);
#pragma unroll
                        for (int t = 0; t < 2; ++t) { const int c = hd * 64 + 32 * t + r; aG[t] = MFMA32(xg, *(const bf16x8*)(G2T + (size_t)c * 128 + 16 * ks + 8 * h), aG[t]); } }
#pragma unroll
                    for (int i = 0; i < 16; ++i) { int mrow = t0 + 32 * th + (i & 3) + 8 * (i >> 2); OPQ_SI(mrow); float* gp = vG + (size_t)mrow * DRW;
#pragma unroll
                        for (int t = 0; t < 2; ++t) gp[lo_s + 32 * t] = aG[t][i]; } }
            }
        }
        {
            int lane_b = lane; OPQ_V(lane_b); const int r = lane_b & 31, h = lane_b >> 5;
            const int gi = wave >> 1, th = wave & 1; const bf16* PWT = (const bf16*)(ws + WS_PWT) + gi * 128 * 128;
            const float* pb = INPTR(a, I_PB) + (size_t)l * DPOOL + gi * 128; const float* psc = INPTR(a, I_PS) + (size_t)l * DPOOL + gi * 128; bf16* CAT = (bf16*)(ws + WS_CAT);
            f32x16 acc[4];
#pragma unroll
            for (int t = 0; t < 4; ++t)
#pragma unroll
                for (int i = 0; i < 16; ++i) acc[t][i] = 0.f;
            const LAS bf16* za = ZL + (32 * th + r) * ZP + gi * 128 + 8 * h;
#pragma unroll
            for (int ks = 0; ks < 8; ++ks) { const bf16x8 zf = lds_frag(za + 16 * ks);
#pragma unroll
                for (int t = 0; t < 4; ++t) acc[t] = MFMA32(zf, *(const bf16x8*)(PWT + (size_t)(32 * t + r) * 128 + 16 * ks + 8 * h), acc[t]); }
#pragma unroll
            for (int t = 0; t < 4; ++t) { const int d = 32 * t + r; const float bv = pb[d], sv = psc[d];
#pragma unroll
                for (int i = 0; i < 16; ++i) { const int m = t0 + 32 * th + (i & 3) + 8 * (i >> 2) + 4 * h; CAT[(size_t)m * DM + DRW + gi * 128 + d] = (bf16)f2bf((acc[t][i] + bv) * sv); } }
        }
        __syncthreads();
        {
            int tid_c = tid; OPQ_V(tid_c); const int tid = tid_c;
            bf16* QR = (bf16*)(ws + WS_QR); bf16* KS = (bf16*)(ws + WS_KS); bf16* KW = (bf16*)(ws + WS_KW); bf16* VST = (bf16*)(ws + WS_VST); bf16* VWT = (bf16*)(ws + WS_VWT);
            LAS float* T0 = (LAS float*)lds; LAS float* T1 = T0 + 64 * 193;
#pragma unroll 1
            for (int c = tid; c < 1152; c += NTHR) {
                int src; float scale = 1.f; const int d = c & 63; const bool isq = c < 768; const int cc = isq ? c : (c < 960 ? c - 768 : c - 960);
                bf16* dbase;
                if (isq) { src = PO_Q + c; dbase = QR + (size_t)t0 * 768 + c; scale = 0.125f * 1.4426950408889634f; }
                else if (c < 960) { src = PO_KS + cc; dbase = KS + ((size_t)(b * 3 + (cc >> 6)) * SEQ + s0) * 64 + (cc & 63); }
                else { src = PO_KW + cc; dbase = KW + ((size_t)(b * 3 + (cc >> 6)) * SEQ + s0) * 64 + (cc & 63); }
                const int dstep = isq ? 768 : 64; const bool rot = d < 16; const int po = d < 8 ? 8 : -8; const float sg = d < 8 ? -1.f : 1.f;
                const float* pr = P + (size_t)t0 * INP + src; const f32x2* rp = rope + s0 * 8 + (d & 7);
#pragma unroll 1
                for (int t8 = 0; t8 < 64; t8 += 8) { float v[8], pv[8]; f32x2 cs[8];
#pragma unroll
                    for (int e = 0; e < 8; ++e) { v[e] = pr[(size_t)(t8 + e) * INP]; pv[e] = pr[(size_t)(t8 + e) * INP + (rot ? po : 0)]; cs[e] = rp[(t8 + e) * 8]; }
#pragma unroll
                    for (int e = 0; e < 8; ++e) { const float o = rot ? v[e] * cs[e].x + sg * pv[e] * cs[e].y : v[e]; dbase[(size_t)(t8 + e) * dstep] = (bf16)f2bf(o * scale); } } }
            if (tid < 384) { const int c = tid; const float* pr = P + (size_t)t0 * INP + (c < 192 ? PO_VS + c : PO_VW + (c - 192)); LAS float* td = c < 192 ? T0 + c : T1 + (c - 192);
#pragma unroll 1
                for (int t8 = 0; t8 < 64; t8 += 16) { float v[16];
#pragma unroll
                    for (int e = 0; e < 16; ++e) v[e] = pr[(size_t)(t8 + e) * INP];
#pragma unroll
                    for (int e = 0; e < 16; ++e) td[(t8 + e) * 193] = v[e]; } }
            __syncthreads();
            for (int i = tid; i < 384 * 64; i += NTHR) { const int c2 = i >> 6, tok = i & 63; const int which = c2 >= 192, c = which ? c2 - 192 : c2;
                const float v = (which ? T1 : T0)[tok * 193 + c]; const int sk = s0 + tok;
                bf16* dst = (which ? VWT : VST) + (((size_t)(b * 3 + (c >> 6)) * 128 + (sk >> 5)) * 64 + (c & 63)) * 32 + vt_pos(sk & 31); *dst = (bf16)f2bf(v); }
        }
        __syncthreads();
    }
    {
        int lane_d = lane; OPQ_V(lane_d); const int r = lane_d & 31, h = lane_d >> 5;
        LAS bf16* HL = (LAS bf16*)lds;
        bf16* KC = (bf16*)(ws + WS_KC); bf16* VCT = (bf16*)(ws + WS_VCT);
        for (int rp2 = 0; rp2 < (((REP_MASK) >> 23) & 1 ? 2 : 1); ++rp2)
        for (int u = bid; u < 2 * NB * 3 * 8; u += G) {
            const int ten = u / 96, q = u - ten * 96, b = q / 24, q2 = q - b * 24, hh = q2 >> 3, nt = q2 & 7, n0 = 32 * nt;
            const bf16* W1T = (const bf16*)(ws + WS_W1T) + (size_t)ten * 256 * 2048 + (size_t)(32 * wave + r) * 2048 + 8 * h;
            const int tk0 = 16 * (n0 + r);
            const float* pa = P + ((size_t)b * SEQ + tk0) * INP + (ten ? PO_VC : PO_KC) + hh * 64 + 8 * h;
            const float* pep = INPTR(a, ten ? I_PEV : I_PEK) + (size_t)l * 2048 + 8 * h;
            f32x16 acc;
#pragma unroll
            for (int i = 0; i < 16; ++i) acc[i] = 0.f;
            f32x4 xa[2][8]; bf16x8 wb[2][4];
#define CMP_LOAD(sl, ll) do { const bool ok_ = tk0 + (ll) < SEQ; const float* pl_ = pa + (size_t)(ll) * INP; const float* pe_ = pep + 64 * (ll); _Pragma("unroll") for (int ds = 0; ds < 4; ++ds) { \
        xa[sl][2 * ds] = (ok_ ? *(const f32x4*)(pl_ + 16 * ds) : (f32x4){0.f, 0.f, 0.f, 0.f}) + *(const f32x4*)(pe_ + 16 * ds); xa[sl][2 * ds + 1] = (ok_ ? *(const f32x4*)(pl_ + 16 * ds + 4) : (f32x4){0.f, 0.f, 0.f, 0.f}) + *(const f32x4*)(pe_ + 16 * ds + 4); \
        wb[sl][ds] = *(const bf16x8*)(W1T + 64 * (ll) + 16 * ds); } } while (0)
            CMP_LOAD(0, 0);
#pragma unroll 1
            for (int ll = 0; ll < 32; ll += 2) {
                CMP_LOAD(1, ll + 1);
#pragma unroll
                for (int ds = 0; ds < 4; ++ds) acc = MFMA32(cvt8(xa[0][2 * ds], xa[0][2 * ds + 1]), wb[0][ds], acc);
                if (ll + 2 < 32) CMP_LOAD(0, ll + 2);
#pragma unroll
                for (int ds = 0; ds < 4; ++ds) acc = MFMA32(cvt8(xa[1][2 * ds], xa[1][2 * ds + 1]), wb[1][ds], acc);
            }
#undef CMP_LOAD
            {
#pragma unroll
                for (int i = 0; i < 16; ++i) { const float x = acc[i]; const float gl = 0.5f * x * (1.0f + ftanh(0.7978845608028654f * (x + 0.044715f * x * x * x)));
                    HL[((i & 3) + 8 * (i >> 2) + 4 * h) * HP + 32 * wave + r] = (bf16)f2bf(gl); } }
            __syncthreads();
            if (wave < 2) {
                const bf16* W2CT = (const bf16*)(ws + WS_W2CT) + (size_t)ten * 64 * 256 + (size_t)(32 * wave + r) * 256 + 8 * h;
                f32x16 o;
#pragma unroll
                for (int i = 0; i < 16; ++i) o[i] = 0.f;
                const LAS bf16* ha = HL + r * HP + 8 * h;
#pragma unroll
                for (int ks = 0; ks < 16; ++ks) o = MFMA32(lds_frag(ha + 16 * ks), *(const bf16x8*)(W2CT + 16 * ks), o);
                const int d = 32 * wave + r;
#pragma unroll
                for (int i = 0; i < 16; ++i) { const int n = n0 + (i & 3) + 8 * (i >> 2) + 4 * h; float v = o[i];
                    if (ten == 0) { const float other = dpp_f<0x128>(v);
                        if (wave == 0 && r < 16) { const f32x2 cs = rope[((16 * n + 31) & (SEQ - 1)) * 8 + (r & 7)]; v = r < 8 ? v * cs.x - other * cs.y : v * cs.x + other * cs.y; }
                        if (n < NCMP) KC[((size_t)(b * 3 + hh) * NCMPP + n) * 64 + d] = (bf16)f2bf(v); }
                    else if (n < NCMP) VCT[(((size_t)(b * 3 + hh) * 8 + (n >> 5)) * 64 + d) * 32 + vt_pos(n & 31)] = (bf16)f2bf(v); }
            }
            __syncthreads();
        }
    }
}

constexpr int SPX = 72;
__device__ __forceinline__ void phase_scan_prep(const Args& a, LAS unsigned char* lds, int gw, int NGW, int wave, int lane) {
    OPQ_SI(gw); OPQ_SI(wave); OPQ_V(lane);
    unsigned char* ws = a.ws + opaque0();
    LAS unsigned char* wl = lds + wave * 16384;
    LAS bf16* XA = (LAS bf16*)wl; LAS bf16* XR = XA + 16 * SPX; LAS bf16* XB_ = XR + 16 * SPX; LAS bf16* XK = XB_ + 16 * SPX;
    LAS float* GB = (LAS float*)(wl + 4 * 16 * SPX * 2); LAS float* GK = GB + 256; LAS float* HB = GK + 256; LAS float* HK = HB + 256; LAS float* NM = HK + 256;
    const int r = lane & 31, h = lane >> 5;
    const GAS float* vKK = (const GAS float*)(ws + WS_SV); const GAS float* vWR = (const GAS float*)(ws + WS_SV + SV_STRIDE); const GAS float* vW = (const GAS float*)(ws + WS_SV + 2 * SV_STRIDE);
    const GAS float* vKM = (const GAS float*)(ws + WS_SV + 3 * SV_STRIDE); const GAS float* vBB = (const GAS float*)(ws + WS_SV + 4 * SV_STRIDE); const GAS float* vV = (const GAS float*)(ws + WS_SV + 5 * SV_STRIDE);
#pragma unroll 1
    for (int item = gw; item < NB * 12 * 256; item += NGW) {
        const int hd = item >> 8, c = item & 255, b = hd / 12, hh = hd - b * 12;
        const size_t o0 = ((size_t)b * SEQ + 16 * c) * DRW + hh * 64 + lane;
        GAS unsigned char* rec = (GAS unsigned char*)(ws + WS_SPREC) + (size_t)item * SPREC_BYTES;
        float al[16], rh[16], be[16], ka[16], vv[16]; float g = 1.f;
#pragma unroll
        for (int t = 0; t < 16; ++t) { const size_t o = o0 + (size_t)t * DRW; const float w = vW[o], kk = vKK[o], bb = vBB[o], km = vKM[o], wr = vWR[o]; vv[t] = vV[o];
            al[t] = g * kk; rh[t] = g * wr; g *= w; const float ig = 1.0f / g; be[t] = bb * ig; ka[t] = km * ig; }
#pragma unroll
        for (int t = 0; t < 16; ++t) { XA[t * SPX + lane] = (bf16)f2bf(al[t]); XR[t * SPX + lane] = (bf16)f2bf(rh[t]); XB_[t * SPX + lane] = (bf16)f2bf(be[t]); XK[t * SPX + lane] = (bf16)f2bf(ka[t]); }
#pragma unroll
        for (int hp = 0; hp < 2; ++hp) {
            u32x4 wb, wk, wv;
            wb.x = cvtpk(be[4 * hp + 0], be[4 * hp + 1]); wb.y = cvtpk(be[4 * hp + 2], be[4 * hp + 3]); wb.z = cvtpk(be[8 + 4 * hp + 0], be[8 + 4 * hp + 1]); wb.w = cvtpk(be[8 + 4 * hp + 2], be[8 + 4 * hp + 3]);
            wk.x = cvtpk(ka[4 * hp + 0], ka[4 * hp + 1]); wk.y = cvtpk(ka[4 * hp + 2], ka[4 * hp + 3]); wk.z = cvtpk(ka[8 + 4 * hp + 0], ka[8 + 4 * hp + 1]); wk.w = cvtpk(ka[8 + 4 * hp + 2], ka[8 + 4 * hp + 3]);
            wv.x = cvtpk(vv[4 * hp + 0], vv[4 * hp + 1]); wv.y = cvtpk(vv[4 * hp + 2], vv[4 * hp + 3]); wv.z = cvtpk(vv[8 + 4 * hp + 0], vv[8 + 4 * hp + 1]); wv.w = cvtpk(vv[8 + 4 * hp + 2], vv[8 + 4 * hp + 3]);
            *(GAS u32x4*)(rec + 4096 + ((h * 2 + hp) * 32 + r) * 16) = wb; *(GAS u32x4*)(rec + 6144 + ((h * 2 + hp) * 32 + r) * 16) = wk;
            *(GAS u32x4*)(rec + 9216 + h * 3072 + 2048 + (hp * 32 + r) * 16) = wv; }
        *(GAS float*)(rec + 8704 + ((h * 2 + ((r >> 2) & 1)) * 16 + (r & 3) + 4 * (r >> 3)) * 4) = g;
        WSYNC();
        const bool lo16 = r < 16; const bf16x8 zf = {0, 0, 0, 0, 0, 0, 0, 0};
#define SP_GRAM(X1, X2, OUT, INCL) do { f32x16 D; _Pragma("unroll") for (int i = 0; i < 16; ++i) D[i] = 0.f; \
            _Pragma("unroll") for (int ks = 0; ks < 4; ++ks) { const bf16x8 fa = lo16 ? *(const LAS bf16x8*)(X1 + r * SPX + 16 * ks + 8 * h) : zf, fb = lo16 ? *(const LAS bf16x8*)(X2 + r * SPX + 16 * ks + 8 * h) : zf; D = MFMA32(fa, fb, D); } \
            if (lo16) { _Pragma("unroll") for (int i = 0; i < 8; ++i) { const int t = (i & 3) + 8 * (i >> 2) + 4 * h; OUT[t * 16 + r] = (INCL ? r <= t : r < t) ? D[i] : 0.f; } } } while (0)
        SP_GRAM(XA, XB_, GB, false); SP_GRAM(XA, XK, GK, false); SP_GRAM(XR, XB_, HB, true); SP_GRAM(XR, XK, HK, true);
#undef SP_GRAM
        WSYNC();
        { const int cc = lane & 15; float n[16];
#pragma unroll
            for (int t = 0; t < 16; ++t) { float acc = t == cc ? 1.f : 0.f;
#pragma unroll
                for (int s2 = 0; s2 < t; ++s2) acc -= GB[t * 16 + s2] * n[s2];
                n[t] = acc; }
            if (lane < 16) {
#pragma unroll
                for (int t = 0; t < 16; ++t) NM[t * 16 + cc] = n[t]; } }
        if (lo16) { u32x4 w_; const LAS float* hr = HB + r * 16 + 4 * h;
            w_.x = cvtpk(hr[0], hr[1]); w_.y = cvtpk(hr[2], hr[3]); w_.z = cvtpk(hr[8], hr[9]); w_.w = cvtpk(hr[10], hr[11]); *(GAS u32x4*)(rec + 8192 + (h * 16 + r) * 16) = w_; }
        WSYNC();
        { float ap[16];
#pragma unroll
            for (int t = 0; t < 16; ++t) { float acc = 0.f;
#pragma unroll
                for (int s2 = 0; s2 <= t; ++s2) acc = fmaf(NM[t * 16 + s2], al[s2], acc);
                ap[t] = acc; }
#pragma unroll
            for (int t = 0; t < 16; ++t) XA[t * SPX + lane] = (bf16)f2bf(ap[t]); }
        WSYNC();
        if (lo16) {
#pragma unroll
            for (int ks = 0; ks < 4; ++ks) { const LAS bf16* pa = XA + r * SPX + 16 * ks + 4 * h; const LAS bf16* pr = XR + r * SPX + 16 * ks + 4 * h;
                const u32x2 a0 = *(const LAS u32x2*)pa, a1 = *(const LAS u32x2*)(pa + 8), r0 = *(const LAS u32x2*)pr, r1 = *(const LAS u32x2*)(pr + 8);
                *(GAS u32x4*)(rec + ((ks * 2 + h) * 16 + r) * 16) = (u32x4){a0.x, a0.y, a1.x, a1.y}; *(GAS u32x4*)(rec + 2048 + ((ks * 2 + h) * 16 + r) * 16) = (u32x4){r0.x, r0.y, r1.x, r1.y}; } }
        { float wq[16], p1[16], yk[16];
#pragma unroll
            for (int t = 0; t < 16; ++t) { float acc = 0.f, acy = 0.f;
#pragma unroll
                for (int s2 = 0; s2 <= t; ++s2) { if (s2 < t) acc = fmaf(GK[t * 16 + s2], vv[s2], acc); acy = fmaf(HK[t * 16 + s2], vv[s2], acy); }
                wq[t] = acc; yk[t] = acy; }
#pragma unroll
            for (int t = 0; t < 16; ++t) { float acc = 0.f;
#pragma unroll
                for (int s2 = 0; s2 <= t; ++s2) acc = fmaf(NM[t * 16 + s2], wq[s2], acc);
                p1[t] = acc; }
            GAS unsigned char* rv = rec + 9216 + h * 3072;
#pragma unroll
            for (int hq = 0; hq < 2; ++hq) { u32x4 wp, wy;
                wp.x = cvtpk(p1[4 * hq + 0], p1[4 * hq + 1]); wp.y = cvtpk(p1[4 * hq + 2], p1[4 * hq + 3]); wp.z = cvtpk(p1[8 + 4 * hq + 0], p1[8 + 4 * hq + 1]); wp.w = cvtpk(p1[8 + 4 * hq + 2], p1[8 + 4 * hq + 3]);
                wy.x = cvtpk(yk[4 * hq + 0], yk[4 * hq + 1]); wy.y = cvtpk(yk[4 * hq + 2], yk[4 * hq + 3]); wy.z = cvtpk(yk[8 + 4 * hq + 0], yk[8 + 4 * hq + 1]); wy.w = cvtpk(yk[8 + 4 * hq + 2], yk[8 + 4 * hq + 3]);
                *(GAS u32x4*)(rv + (hq * 32 + r) * 16) = wp; *(GAS u32x4*)(rv + 1024 + (hq * 32 + r) * 16) = wy; } }
        WSYNC();
    }
}
__device__ __forceinline__ void scan_seq(const Args& a, LAS unsigned char* lds, int grp, int lane) {
    OPQ_SI(grp); OPQ_V(lane);
    __builtin_amdgcn_s_setprio(3);
    unsigned char* ws = a.ws + opaque0();
    const int hd = grp % 48, vt = grp / 48, b = hd / 12, hh = hd - b * 12;
    const int r = lane & 31, h = lane >> 5; const bool lo16 = r < 16;
    LAS unsigned char* RS = lds + 16384;
    const GAS unsigned char* recs = (const GAS unsigned char*)(ws + WS_SPREC) + (size_t)hd * 256 * SPREC_BYTES;
    GAS float* yp = (GAS float*)(ws + WS_YS) + (size_t)b * SEQ * DRW + hh * 64 + 32 * vt + r;
    const bf16x8 zf = {0, 0, 0, 0, 0, 0, 0, 0};
    f32x16 T0, T1;
#pragma unroll
    for (int i = 0; i < 16; ++i) { T0[i] = 0.f; T1[i] = 0.f; }
#define SQ_DMA(slot, ck) do { const GAS unsigned char* rp_ = recs + (size_t)(ck) * SPREC_BYTES + lane * 16; LAS unsigned char* ls_ = RS + (slot) * 12288; \
        _Pragma("unroll") for (int q = 0; q < 9; ++q) __builtin_amdgcn_global_load_lds((const unsigned*)(rp_ + 1024 * q), (LAS unsigned*)(ls_ + 1024 * q), 16, 0, 0); \
        _Pragma("unroll") for (int q = 0; q < 3; ++q) __builtin_amdgcn_global_load_lds((const unsigned*)(rp_ + 9216 + 3072 * vt + 1024 * q), (LAS unsigned*)(ls_ + 9216 + 1024 * q), 16, 0, 0); } while (0)
    SQ_DMA(0, 0); SQ_DMA(1, 1);
#pragma unroll 1
    for (int ck = 0; ck < 256; ++ck) {
        const LAS unsigned char* L = RS + (ck & 1) * 12288;
        if (ck == 0) asm volatile("s_waitcnt vmcnt(12)" ::: "memory"); else if (ck + 1 < 256) asm volatile("s_waitcnt vmcnt(20)" ::: "memory"); else asm volatile("s_waitcnt vmcnt(0)" ::: "memory");
        bf16x8 tb[4];
#pragma unroll
        for (int s2 = 0; s2 < 2; ++s2) { u32x4 w0, w1;
            w0.x = cvtpk(T0[8 * s2], T0[8 * s2 + 1]); w0.y = cvtpk(T0[8 * s2 + 2], T0[8 * s2 + 3]); w0.z = cvtpk(T0[8 * s2 + 4], T0[8 * s2 + 5]); w0.w = cvtpk(T0[8 * s2 + 6], T0[8 * s2 + 7]);
            w1.x = cvtpk(T1[8 * s2], T1[8 * s2 + 1]); w1.y = cvtpk(T1[8 * s2 + 2], T1[8 * s2 + 3]); w1.z = cvtpk(T1[8 * s2 + 4], T1[8 * s2 + 5]); w1.w = cvtpk(T1[8 * s2 + 6], T1[8 * s2 + 7]);
            tb[s2] = __builtin_bit_cast(bf16x8, w0); tb[2 + s2] = __builtin_bit_cast(bf16x8, w1); }
        f32x16 aU, aY;
#pragma unroll
        for (int i = 0; i < 16; ++i) { aU[i] = 0.f; aY[i] = 0.f; }
        { const u32x4 yk = *(const LAS u32x4*)(L + 9216 + 1024 + lane * 16);
            aY[0] = __builtin_bit_cast(float, yk.x << 16); aY[1] = __builtin_bit_cast(float, yk.x & 0xffff0000u); aY[2] = __builtin_bit_cast(float, yk.y << 16); aY[3] = __builtin_bit_cast(float, yk.y & 0xffff0000u);
            aY[4] = __builtin_bit_cast(float, yk.z << 16); aY[5] = __builtin_bit_cast(float, yk.z & 0xffff0000u); aY[6] = __builtin_bit_cast(float, yk.w << 16); aY[7] = __builtin_bit_cast(float, yk.w & 0xffff0000u); }
#pragma unroll
        for (int ks = 0; ks < 4; ++ks) { const bf16x8 fa = lo16 ? *(const LAS bf16x8*)(L + ((ks * 2 + h) * 16 + r) * 16) : zf, fr = lo16 ? *(const LAS bf16x8*)(L + 2048 + ((ks * 2 + h) * 16 + r) * 16) : zf;
            aU = MFMA32(fa, tb[ks], aU); aY = MFMA32(fr, tb[ks], aY); }
        bf16x8 ub;
        { const u32x4 p1 = *(const LAS u32x4*)(L + 9216 + lane * 16); float u[8];
            u[0] = -aU[0] - __builtin_bit_cast(float, p1.x << 16); u[1] = -aU[1] - __builtin_bit_cast(float, p1.x & 0xffff0000u); u[2] = -aU[2] - __builtin_bit_cast(float, p1.y << 16); u[3] = -aU[3] - __builtin_bit_cast(float, p1.y & 0xffff0000u);
            u[4] = -aU[4] - __builtin_bit_cast(float, p1.z << 16); u[5] = -aU[5] - __builtin_bit_cast(float, p1.z & 0xffff0000u); u[6] = -aU[6] - __builtin_bit_cast(float, p1.w << 16); u[7] = -aU[7] - __builtin_bit_cast(float, p1.w & 0xffff0000u);
            u32x4 w_; w_.x = cvtpk(u[0], u[1]); w_.y = cvtpk(u[2], u[3]); w_.z = cvtpk(u[4], u[5]); w_.w = cvtpk(u[6], u[7]); ub = __builtin_bit_cast(bf16x8, w_); }
        { const bf16x8 fh = lo16 ? *(const LAS bf16x8*)(L + 8192 + (h * 16 + r) * 16) : zf; aY = MFMA32(fh, ub, aY); }
        { const bf16x8 fv = *(const LAS bf16x8*)(L + 9216 + 2048 + lane * 16);
            const bf16x8 b0 = *(const LAS bf16x8*)(L + 4096 + lane * 16), b1 = *(const LAS bf16x8*)(L + 4096 + 1024 + lane * 16), k0 = *(const LAS bf16x8*)(L + 6144 + lane * 16), k1 = *(const LAS bf16x8*)(L + 6144 + 1024 + lane * 16);
            T0 = MFMA32(b0, ub, T0); T1 = MFMA32(b1, ub, T1); T0 = MFMA32(k0, fv, T0); T1 = MFMA32(k1, fv, T1);
#pragma unroll
            for (int q = 0; q < 4; ++q) { const f32x4 g0 = *(const LAS f32x4*)(L + 8704 + (h * 16 + 4 * q) * 4), g1 = *(const LAS f32x4*)(L + 8704 + ((2 + h) * 16 + 4 * q) * 4);
                T0[4 * q] *= g0.x; T0[4 * q + 1] *= g0.y; T0[4 * q + 2] *= g0.z; T0[4 * q + 3] *= g0.w; T1[4 * q] *= g1.x; T1[4 * q + 1] *= g1.y; T1[4 * q + 2] *= g1.z; T1[4 * q + 3] *= g1.w; } }
#pragma unroll
        for (int i = 0; i < 8; ++i) yp[((size_t)ck * 16 + (i & 3) + 8 * (i >> 2) + 4 * h) * DRW] = aY[i];
        asm volatile("s_waitcnt lgkmcnt(0)" ::: "memory");
        if (ck + 2 < 256) SQ_DMA(ck & 1, ck + 2);
    }
#undef SQ_DMA
    asm volatile("s_waitcnt vmcnt(0)" ::: "memory");
    __builtin_amdgcn_s_setprio(0);
}

template <bool WITH_V> __device__ __forceinline__ void dma_tile(LAS unsigned char* RW, const bf16* Kb, int key0, unsigned koff, const bf16* Vt, unsigned voff) {
    const char* kp = (const char*)(Kb + (size_t)key0 * 64) + koff;
#pragma unroll
    for (int q = 0; q < 4; ++q) __builtin_amdgcn_global_load_lds((const unsigned*)(kp + 1024 * q), (LAS unsigned*)(RW + q * 1024), 16, 0, 0);
    if (WITH_V) { const char* vp = (const char*)(Vt + (size_t)(key0 >> 5) * 2048) + voff;
#pragma unroll
        for (int q = 0; q < 4; ++q) __builtin_amdgcn_global_load_lds((const unsigned*)(vp + 1024 * q), (LAS unsigned*)(RW + (4 + q) * 1024), 16, 0, 0); }
}
template <bool WITH_V> __device__ __forceinline__ void read_tile(const LAS unsigned char* RW, unsigned krd, unsigned vrd, bf16x8 (&kf)[4], bf16x8 (&vf)[2][2], bool younger) {
    if (younger) { if (WITH_V) asm volatile("s_waitcnt vmcnt(8)" ::: "memory"); else asm volatile("s_waitcnt vmcnt(4)" ::: "memory"); } else asm volatile("s_waitcnt vmcnt(0)" ::: "memory");
    const int rk = (krd >> 7) & 7, hh = krd & 1;
#pragma unroll
    for (int ks = 0; ks < 4; ++ks) kf[ks] = *(const LAS bf16x8*)(RW + (krd & ~1u) + (((2 * ks + hh) ^ rk) << 4));
    if (WITH_V) {
#pragma unroll
        for (int q = 0; q < 4; ++q) { const int dt = q >> 1, s = q & 1; const unsigned row = (vrd >> 6) + 32 * dt; vf[dt][s] = *(const LAS bf16x8*)(RW + 4096 + row * 64 + ((((2 * hh + s)) ^ ((row >> 2) & 3)) << 4)); } }
    asm volatile("s_waitcnt lgkmcnt(0)" ::: "memory");
}
__device__ __forceinline__ f32x16 qk_tile(const bf16x8 (&kf)[4], const bf16x8 (&qf)[4]) {
    f32x16 S;
#pragma unroll
    for (int i = 0; i < 16; ++i) S[i] = 0.f;
#pragma unroll
    for (int ks = 0; ks < 4; ++ks) S = MFMA32(kf[ks], qf[ks], S);
    return S;
}
__device__ __forceinline__ void pv_tile(const float (&p)[16], const bf16x8 (&vf)[2][2], f32x16 (&O)[2]) {
#pragma unroll
    for (int s = 0; s < 2; ++s) { u32x4 w; w.x = cvtpk(p[8 * s], p[8 * s + 1]); w.y = cvtpk(p[8 * s + 2], p[8 * s + 3]); w.z = cvtpk(p[8 * s + 4], p[8 * s + 5]); w.w = cvtpk(p[8 * s + 6], p[8 * s + 7]);
        const bf16x8 pf = __builtin_bit_cast(bf16x8, w);
#pragma unroll
        for (int dt = 0; dt < 2; ++dt) O[dt] = MFMA32(vf[dt][s], pf, O[dt]); }
}
__device__ __forceinline__ void att_rest(f32x16& S, const bf16x8 (&vf)[2][2], int key0, int h, bool masked, int klo, int khi, bool colsel, float& m, float& l, f32x16 (&O)[2]) {
    if (masked) { const int kb = key0 + 4 * h;
#pragma unroll
        for (int i = 0; i < 16; ++i) { const int key = kb + (i & 3) + 8 * (i >> 2); S[i] = (key <= khi && key >= klo) ? S[i] : -INFINITY; } }
    float tmax = fmaxf(fmaxf(fmaxf(S[0], S[1]), fmaxf(S[2], S[3])), fmaxf(fmaxf(S[4], S[5]), fmaxf(S[6], S[7])));
    tmax = fmaxf(tmax, fmaxf(fmaxf(fmaxf(S[8], S[9]), fmaxf(S[10], S[11])), fmaxf(fmaxf(S[12], S[13]), fmaxf(S[14], S[15]))));
    tmax = half_max(tmax); tmax = colsel ? tmax : -INFINITY;
    if (__builtin_amdgcn_ballot_w64(tmax > m + 8.0f) != 0ull) {
        const float mn = fmaxf(m, tmax); const float ms = mn == -INFINITY ? 0.f : mn; const float alpha = __builtin_amdgcn_exp2f(m - ms);
        l *= alpha; m = mn;
#pragma unroll
        for (int dt = 0; dt < 2; ++dt)
#pragma unroll
            for (int i = 0; i < 16; ++i) O[dt][i] *= alpha;
    }
    float msx = m == -INFINITY ? 0.f : m; msx = colsel ? msx : INFINITY;
    float p[16]; float ps = 0.f;
#pragma unroll
    for (int i = 0; i < 16; ++i) { p[i] = __builtin_amdgcn_exp2f(S[i] - msx); ps += p[i]; }
    l += half_sum(ps);
    pv_tile(p, vf, O);
}
constexpr int NSA_RING0 = 16384;
static_assert(NSA_RING0 + 8 * 16384 <= LDS_SCRATCH, "attention LDS map");
__device__ __forceinline__ void phase_nsa(const Args& a, int qi, int l, LAS unsigned char* lds, int slot, int lane) {
    OPQ_SI(slot); OPQ_V(lane);
    unsigned char* ws = a.ws + opaque0();
    LAS float* impl = (LAS float*)(lds + slot * 2048);
    LAS unsigned char* RW = lds + NSA_RING0 + slot * 16384;
    const bf16* QR = (const bf16*)(ws + WS_QR); const float* P = (const float*)(ws + WS_P); const float* gate_b = INPTR(a, I_GB) + (size_t)l * 36; bf16* CAT = (bf16*)(ws + WS_CAT);
    unsigned* qctr = (unsigned*)(ws + WS_CTL) + 8192 + 64 * qi;
    const int r = lane & 31, h = lane >> 5, g = r & 3, ql = r >> 2;
    const unsigned koff = (unsigned)((lane >> 3) * 128 + (((lane & 7) ^ ((lane >> 3) & 7)) << 4)), voff = (unsigned)((lane >> 2) * 64 + (((lane & 3) ^ (((lane >> 2) >> 2) & 3)) << 4));
    const unsigned krd = (unsigned)(r * 128) | (unsigned)h, vrd = (unsigned)(r * 64);
    const int myx = (int)(xb_xcc_id() & 7u); int qsel = 0;
    for (;;) {
        int item = 0, qx = 0;
        for (;;) { qx = (myx + qsel) & 7; if (lane == 0) item = (int)atomicAdd(qctr + 8 * qx, 1u); item = __builtin_amdgcn_readfirstlane(item); if (item < 96 * 8 || qsel >= 7) break; ++qsel; }
        if (item >= 96 * 8) break;
        const int up = item >> 3, wave = item & 7, k3 = up / 3, e3 = up - 3 * k3;
        const int bk = e3 < 2 ? qx : 8 + (qx >> 1); const int qt = e3 == 0 ? 63 - 2 * k3 : (e3 == 1 ? 62 - 2 * k3 : 62 - 2 * k3 + (qx & 1));
        const int b = bk / 3, kvh = bk - b * 3;
        const int tile0 = qt * 64, cur = qt; const int qp = tile0 + 8 * wave + ql; const size_t mq = (size_t)b * SEQ + qp; const int head = kvh * 4 + g;
        bf16x8 qf[4];
#pragma unroll
        for (int ks = 0; ks < 4; ++ks) qf[ks] = *(const bf16x8*)(QR + mq * 768 + head * 64 + 16 * ks + 8 * h);
        float g0, g1, g2;
        { const float* gl = P + mq * INP + PO_GL + head * 3; const float* gb = gate_b + head * 3; g0 = sigmoidf_(gl[0] + gb[0]); g1 = sigmoidf_(gl[1] + gb[1]); g2 = sigmoidf_(gl[2] + gb[2]); }
        f32x16 out[2], O[2]; bf16x8 kf[4]; bf16x8 vf[2][2];
#pragma unroll
        for (int dt = 0; dt < 2; ++dt)
#pragma unroll
            for (int i = 0; i < 16; ++i) out[dt][i] = 0.f;
        unsigned long long mymask = (2ull << cur) - 1ull, umask = mymask;
        const int qpw = tile0 + 8 * wave + 7;
        {
            const bf16* Kb = (const bf16*)(ws + WS_KC) + (size_t)(b * 3 + kvh) * NCMPP * 64; const bf16* Vt = (const bf16*)(ws + WS_VCT) + (size_t)(b * 3 + kvh) * 8 * 2048;
            const int nvw = qpw >= 31 ? ((qpw - 31) >> 4) + 1 : 0; const int nvq = qp >= 31 ? ((qp - 31) >> 4) + 1 : 0; const int ntile = (nvw + 31) >> 5;
            const bool need_imp = cur >= 16;
            if (ntile > 0) {
                float m = -INFINITY, ls = 0.f;
                dma_tile<false>(RW, Kb, 0, koff, Vt, voff);
#pragma unroll 1
                for (int kt = 0; kt < ntile; ++kt) { read_tile<false>(RW, krd, vrd, kf, vf, false); if (kt + 1 < ntile) dma_tile<false>(RW, Kb, 32 * (kt + 1), koff, Vt, voff); else dma_tile<true>(RW, Kb, 0, koff, Vt, voff);
                    const f32x16 S = qk_tile(kf, qf);
                    float tmax = -INFINITY; float sv[16];
#pragma unroll
                    for (int i = 0; i < 16; ++i) { const int n = 32 * kt + (i & 3) + 8 * (i >> 2) + 4 * h; sv[i] = n < nvq ? S[i] : -INFINITY; tmax = fmaxf(tmax, sv[i]); }
                    tmax = half_max(tmax); const float mn = fmaxf(m, tmax); const float ms = mn == -INFINITY ? 0.f : mn; float ps = 0.f;
#pragma unroll
                    for (int i = 0; i < 16; ++i) ps += __builtin_amdgcn_exp2f(sv[i] - ms);
                    ls = ls * __builtin_amdgcn_exp2f(m - ms) + half_sum(ps); m = mn; }
                const float ms = m == -INFINITY ? 0.f : m; const float inv = 1.0f / fmaxf(ls, 1.17549435e-38f);
                float carry = 0.f;
#pragma unroll
                for (int dt = 0; dt < 2; ++dt)
#pragma unroll
                    for (int i = 0; i < 16; ++i) O[dt][i] = 0.f;
                if (need_imp) {
#pragma unroll
                    for (int i = 0; i < 8; ++i) impl[i * 64 + lane] = 0.f;
                    WSYNC(); }
#pragma unroll 1
                for (int kt = 0; kt < ntile; ++kt) {
                    read_tile<true>(RW, krd, vrd, kf, vf, false); if (kt + 1 < ntile) dma_tile<true>(RW, Kb, 32 * (kt + 1), koff, Vt, voff);
                    const f32x16 S = qk_tile(kf, qf);
                    float p[16];
#pragma unroll
                    for (int i = 0; i < 16; ++i) { const int n = 32 * kt + (i & 3) + 8 * (i >> 2) + 4 * h; p[i] = n < nvq ? __builtin_amdgcn_exp2f(S[i] - ms) * inv : 0.f; }
                    if (need_imp) {
                        float val[4];
#pragma unroll
                        for (int t = 0; t < 4; ++t) { const float sp = 0.5f * p[4 * t + 3]; const float base = (p[4 * t] + p[4 * t + 1]) + (p[4 * t + 2] + sp); const float rv = other_half(sp, h);
                            val[t] = base + (h ? rv : carry); carry = h ? 0.f : rv; }
#pragma unroll
                        for (int t = 0; t < 4; ++t) { float v = val[t]; v += dpp_f<0xB1>(v); v += dpp_f<0x4E>(v); if (g == 0) impl[ql * 64 + 8 * kt + 2 * t + h] = v; }
                    }
                    pv_tile(p, vf, O);
                }
#pragma unroll
                for (int dt = 0; dt < 2; ++dt)
#pragma unroll
                    for (int i = 0; i < 16; ++i) out[dt][i] = O[dt][i] * g0;
                if (need_imp) {
                    WSYNC();
#pragma unroll 1
                    for (int q = 0; q < 8; ++q) { const float v = impl[q * 64 + lane]; const bool forced = lane == 0 || lane == cur || lane == cur - 1; impl[q * 64 + lane] = lane > cur ? -INFINITY : (forced ? 1e9f : v); }
                    WSYNC();
                    umask = 0ull;
#pragma unroll 1
                    for (int q = 0; q < 8; ++q) { const float sc = impl[q * 64 + lane]; int rank = 0;
#pragma unroll 4
                        for (int i4 = 0; i4 < 16; ++i4) { const f32x4 o = *(const LAS f32x4*)(impl + q * 64 + 4 * i4);
                            rank += (o.x > sc || (o.x == sc && 4 * i4 + 0 < lane)) ? 1 : 0; rank += (o.y > sc || (o.y == sc && 4 * i4 + 1 < lane)) ? 1 : 0;
                            rank += (o.z > sc || (o.z == sc && 4 * i4 + 2 < lane)) ? 1 : 0; rank += (o.w > sc || (o.w == sc && 4 * i4 + 3 < lane)) ? 1 : 0; }
                        const unsigned long long mk = __ballot(lane <= cur && rank < 16);
                        umask |= mk; if (ql == q) mymask = mk; }
                    WSYNC();
                }
            }
        }
        {
            const bf16* Kb = (const bf16*)(ws + WS_KS) + (size_t)(b * 3 + kvh) * SEQ * 64; const bf16* Vt = (const bf16*)(ws + WS_VST) + (size_t)(b * 3 + kvh) * 128 * 2048;
            float m = -INFINITY, ls = 0.f;
#pragma unroll
            for (int dt = 0; dt < 2; ++dt)
#pragma unroll
                for (int i = 0; i < 16; ++i) O[dt][i] = 0.f;
            unsigned long long um = umask; int hf = 0;
#define SEL_NEXT(have, jb, key0) do { have = um != 0ull; if (have) { jb = __builtin_ctzll(um); key0 = 64 * jb + 32 * hf; if (hf == 0 && 64 * jb + 32 <= qpw) hf = 1; else { hf = 0; um &= um - 1ull; } } } while (0)
            bool h0, h1; int j0 = 0, k0 = 0, j1 = 0, k1 = 0, sl = 0;
            SEL_NEXT(h0, j0, k0); if (h0) dma_tile<true>(RW, Kb, k0, koff, Vt, voff);
            SEL_NEXT(h1, j1, k1); if (h1) dma_tile<true>(RW + 8192, Kb, k1, koff, Vt, voff);
#pragma unroll 1
            while (h0) {
                read_tile<true>(RW + sl * 8192, krd, vrd, kf, vf, h1);
                bool h2; int j2 = 0, k2 = 0; SEL_NEXT(h2, j2, k2); if (h2) dma_tile<true>(RW + sl * 8192, Kb, k2, koff, Vt, voff);
                f32x16 S = qk_tile(kf, qf);
                att_rest(S, vf, k0, h, j0 == cur, -0x7fffffff, qp, (mymask >> j0) & 1ull, m, ls, O);
                h0 = h1; j0 = j1; k0 = k1; h1 = h2; j1 = j2; k1 = k2; sl ^= 1;
            }
#undef SEL_NEXT
            const float sc = g1 / fmaxf(ls, 1.17549435e-38f);
#pragma unroll
            for (int dt = 0; dt < 2; ++dt)
#pragma unroll
                for (int i = 0; i < 16; ++i) out[dt][i] += O[dt][i] * sc;
        }
        {
            const bf16* Kb = (const bf16*)(ws + WS_KW) + (size_t)(b * 3 + kvh) * SEQ * 64; const bf16* Vt = (const bf16*)(ws + WS_VWT) + (size_t)(b * 3 + kvh) * 128 * 2048;
            float m = -INFINITY, ls = 0.f;
#pragma unroll
            for (int dt = 0; dt < 2; ++dt)
#pragma unroll
                for (int i = 0; i < 16; ++i) O[dt][i] = 0.f;
            const int q0w = tile0 + 8 * wave; const int lo = q0w - 511 > 0 ? q0w - 511 : 0;
            const int tEnd = (q0w + 7) >> 5; int t = lo >> 5;
            dma_tile<true>(RW, Kb, 32 * t, koff, Vt, voff); if (t + 1 <= tEnd) dma_tile<true>(RW + 8192, Kb, 32 * (t + 1), koff, Vt, voff);
            int sl = 0;
#pragma unroll 1
            for (; t <= tEnd; ++t) {
                read_tile<true>(RW + sl * 8192, krd, vrd, kf, vf, t + 1 <= tEnd);
                if (t + 2 <= tEnd) dma_tile<true>(RW + sl * 8192, Kb, 32 * (t + 2), koff, Vt, voff);
                f32x16 S = qk_tile(kf, qf);
                att_rest(S, vf, 32 * t, h, !(32 * t >= q0w + 7 - 511 && 32 * t + 31 <= q0w), qp - 511, qp, true, m, ls, O);
                sl ^= 1;
            }
            const float sc = g2 / fmaxf(ls, 1.17549435e-38f);
            bf16* op = CAT + mq * DM + DRW + DPOOL + head * 64 + 4 * h;
#pragma unroll
            for (int dt = 0; dt < 2; ++dt)
#pragma unroll
                for (int t2 = 0; t2 < 4; ++t2) { u32x2 w; w.x = cvtpk(out[dt][4 * t2] + O[dt][4 * t2] * sc, out[dt][4 * t2 + 1] + O[dt][4 * t2 + 1] * sc); w.y = cvtpk(out[dt][4 * t2 + 2] + O[dt][4 * t2 + 2] * sc, out[dt][4 * t2 + 3] + O[dt][4 * t2 + 3] * sc);
                    *(u32x2*)(op + 32 * dt + 8 * t2) = w; }
        }
    }
}

__device__ __forceinline__ void phase_rwkv_out(const Args& a, int l, int gw, int NGW, int lane) {
    OPQ_SI(gw); OPQ_V(lane);
    unsigned char* ws = a.ws + opaque0(); const float* YS = (const float*)(ws + WS_YS); const float* vV = (const float*)(ws + WS_SV + 5 * SV_STRIDE); const float* vG = (const float*)(ws + WS_G); const float* SC = (const float*)(ws + WS_SC);
    const float* gng = INPTR(a, I_GNG) + (size_t)l * DRW; const float* gnb = INPTR(a, I_GNB) + (size_t)l * DRW; bf16* CAT = (bf16*)(ws + WS_CAT);
    for (int id0 = gw * 4; id0 < MTOK * 12; id0 += NGW * 4) {
        float y[4], vv[4], gg[4], bc[4]; int cc[4], mm[4]; size_t oo[4];
#pragma unroll
        for (int e = 0; e < 4; ++e) { const int id = id0 + e, m = id / 12, h = id - m * 12; cc[e] = h * 64 + lane; mm[e] = m; oo[e] = (size_t)m * DRW + cc[e]; y[e] = YS[oo[e]]; vv[e] = vV[oo[e]]; gg[e] = vG[oo[e]]; bc[e] = SC[((size_t)m * 12 + h) * 4 + 2]; }
#pragma unroll
        for (int e = 0; e < 4; ++e) { const float mean = wave_sum(y[e]) * (1.f / 64.f); const float d = y[e] - mean; const float var = wave_sum(d * d) * (1.f / 64.f);
            const float yn = d * (1.f / sqrtf(var + GN_EPS)) * gng[cc[e]] + gnb[cc[e]];
            CAT[(size_t)mm[e] * DM + cc[e]] = (bf16)f2bf((yn + bc[e] * vv[e]) * gg[e]); } }
}

#ifndef PROBE_MODE
#define PROBE_MODE 0
#endif
template <int PHMASK> __global__ void __launch_bounds__(NTHR, 2) fwd(Args args) {
    extern __shared__ __attribute__((aligned(16))) unsigned char lds_raw[];
    LAS unsigned char* lds = (LAS unsigned char*)lds_raw;
    const int tid = threadIdx.x, lane = tid & 63, wave = __builtin_amdgcn_readfirstlane(tid >> 6);
#define LANE lane
#define TID tid
    const int G = gridDim.x, bid = blockIdx.x; const int gw = bid * NWAVES + wave, NGW = G * NWAVES;
    unsigned char* ws = args.ws;
    for (int u = TID; u < (LDS_BYTES - LDS_SCRATCH) / 4; u += NTHR) ((LAS unsigned*)(lds + LDS_SCRATCH))[u] = 0u;
    __syncthreads();
    const int lo = args.ph_lo, hi = args.ph_hi;
    XcdBarrier bar; bar.bar = (unsigned*)(ws + WS_CTL) + 4096; bar.x = 0; bar.st = nullptr;
    if (hi - lo > 1) bar = xcd_barrier_post((unsigned*)(ws + WS_CTL) + 4096, (volatile LAS unsigned*)(lds + MISC_OFF) + 8);
#define IN(k) (lo <= (k) && (k) < hi)
#define PHEN(j) (((PHMASK) >> (j)) & 1)

#define SEAM(k) do { if ((k) + 1 < hi) xcd_barrier(bar); } while (0)
    bf16* XB = (bf16*)(ws + WS_XB); bf16* Hb = (bf16*)(ws + WS_H); float* Y = (float*)(ws + WS_YR); const float* AUX = (const float*)(ws + WS_AUX); float* Pm = (float*)(ws + WS_P); bf16* CAT = (bf16*)(ws + WS_CAT);

    if (PHEN(0) && IN(0)) { phase_prologue(args, bid * NTHR + TID, G * NTHR); SEAM(0); }
    for (int l = 0; l < NLAYER; ++l) {
        const int pb = 1 + 14 * l;
        for (int rep = 0; rep < (((REP_MASK) >> 1) & 1 ? 2 : 1); ++rep) if (PHEN(1) && IN(pb + 0)) { phase_wconv(args, l, lds, gw, NGW, wave, LANE); SEAM(pb + 0); }
        for (int rep = 0; rep < (((REP_MASK) >> 2) & 1 ? 2 : 1); ++rep) if (PHEN(2) && IN(pb + 1)) {
            pg8::Gemm g{XB, (const bf16*)(ws + WS_WUP1), MTOK, NUP, DM}; pg8::StaticOrder S; S.init(MTOK, NUP, G, bid); pg8::EpiSwiGLU E{Hb, DFF, AUX, 3 * l - 1, l * 2 * GWN};
            pg8::gemm_phase<pg8::EpiSwiGLU, pg8::StaticOrder, true, true>(lds, g, S, E); SEAM(pb + 1); }
        for (int rep = 0; rep < (((REP_MASK) >> 3) & 1 ? 2 : 1); ++rep) if (PHEN(3) && IN(pb + 2)) {
            pg8::Gemm g{Hb, (const bf16*)(ws + WS_WDN1), MTOK, DM, DFF}; pg8::StaticOrder S; S.init(MTOK, DM, G, bid); pg8::EpiResid E{args.rep ? (float*)(ws + WS_P + 128 * MiB) : Y, args.rep ? (bf16*)(ws + WS_P) : XB, args.rep ? ws + WS_P + 64 * MiB : (unsigned char*)Y, DM, ALPHA, 0.5f, 3 * l - 1, 3 * l};
            pg8::gemm_phase<pg8::EpiResid, pg8::StaticOrder, true, true>(lds, g, S, E); SEAM(pb + 2); }
        for (int rep = 0; rep < (((REP_MASK) >> 5) & 1 ? 2 : 1); ++rep) if (PHEN(5) && IN(pb + 4)) {
            pg8::Gemm g{XB, (const bf16*)(ws + WS_WIN), MTOK, INP, DM}; pg8::StaticOrder S; S.init(MTOK, INP, G, bid); pg8::EpiF32 E{Pm, INP, AUX, 3 * l, l * 2 * GWN + NUP};
            pg8::gemm_phase<pg8::EpiF32, pg8::StaticOrder, true, true>(lds, g, S, E); SEAM(pb + 4); }
        for (int rep = 0; rep < (((REP_MASK) >> 6) & 1 ? 2 : 1); ++rep) if (PHEN(6) && IN(pb + 5)) { phase_m1(args, l, lds, bid, G, TID, wave, LANE); SEAM(pb + 5); }
        for (int rep = 0; rep < (((REP_MASK) >> 7) & 1 ? 2 : 1); ++rep) if (PHEN(7) && IN(pb + 6)) { phase_scan_prep(args, lds, gw, NGW, wave, LANE); SEAM(pb + 6); }
        for (int rep = 0; rep < (((REP_MASK) >> 8) & 1 ? 2 : 1); ++rep) if (PHEN(8) && IN(pb + 7)) { for (int r2 = 0; r2 < (((REP_MASK) >> 20) & 1 ? 2 : 1); ++r2) { if (bid < 96 && wave == 0) scan_seq(args, lds, bid, LANE); } for (int r3 = 0; r3 < (((REP_MASK) >> 21) & 1 ? 2 : 1); ++r3) if (!(bid < 96 && wave == 1)) phase_nsa(args, l + 4 * rep + 8 * r3, l, lds, wave, LANE); SEAM(pb + 7); }
        for (int rep = 0; rep < (((REP_MASK) >> 9) & 1 ? 2 : 1); ++rep) if (PHEN(9) && IN(pb + 8)) { phase_rwkv_out(args, l, gw, NGW, LANE); SEAM(pb + 8); }
        for (int rep = 0; rep < (((REP_MASK) >> 10) & 1 ? 2 : 1); ++rep) if (PHEN(10) && IN(pb + 9)) {
            pg8::Gemm g{CAT, (const bf16*)(ws + WS_WOUT), MTOK, DM, DM}; pg8::StaticOrder S; S.init(MTOK, DM, G, bid); pg8::EpiResid E{Y, XB, (unsigned char*)Y, DM, ALPHA, 1.0f, 3 * l, 3 * l + 1};
            pg8::gemm_phase<pg8::EpiResid, pg8::StaticOrder, true, true>(lds, g, S, E); SEAM(pb + 9); }
        for (int rep = 0; rep < (((REP_MASK) >> 12) & 1 ? 2 : 1); ++rep) if (PHEN(12) && IN(pb + 11)) {
            pg8::Gemm g{XB, (const bf16*)(ws + WS_WUP2), MTOK, NUP, DM}; pg8::StaticOrder S; S.init(MTOK, NUP, G, bid); pg8::EpiSwiGLU E{Hb, DFF, AUX, 3 * l + 1, l * 2 * GWN + NUP + INP};
            pg8::gemm_phase<pg8::EpiSwiGLU, pg8::StaticOrder, true, true>(lds, g, S, E); SEAM(pb + 11); }
        for (int rep = 0; rep < (((REP_MASK) >> 13) & 1 ? 2 : 1); ++rep) if (PHEN(13) && IN(pb + 12)) {
            pg8::Gemm g{Hb, (const bf16*)(ws + WS_WDN2), MTOK, DM, DFF}; pg8::StaticOrder S; S.init(MTOK, DM, G, bid); pg8::EpiResid E{Y, XB, (unsigned char*)Y, DM, ALPHA, 0.5f, 3 * l + 1, 3 * l + 2};
            pg8::gemm_phase<pg8::EpiResid, pg8::StaticOrder, true, true>(lds, g, S, E); SEAM(pb + 12); }
        for (int rep = 0; rep < (((REP_MASK) >> 14) & 1 ? 2 : 1); ++rep) if (l == NLAYER - 1 && PHEN(14) && IN(pb + 13)) { phase_ln_final(XB, (const unsigned char*)Y, INPTR(args, I_LN3G) + (size_t)l * DM, INPTR(args, I_LN3B) + (size_t)l * DM, args.out, gw, NGW, LANE); SEAM(pb + 13); }
    }
#undef IN
#undef SEAM
}

#ifndef ONE_MASK
#define ONE_MASK 0xFFFFF
#endif
#ifndef MK_ONE_LAUNCH
#define MK_ONE_LAUNCH 1
#endif
typedef void (*kern_t)(Args);
extern "C" void kernel_launch(void* const* d_in, const int* in_sizes, int n_in, void* d_out, int out_size, void* d_ws, size_t ws_size, hipStream_t stream) {
    static int grid = 0;
#if MK_ONE_LAUNCH
    static const kern_t kerns[1] = {fwd<ONE_MASK>};
    constexpr int NK = 1;
#else
    static const kern_t kerns[15] = {fwd<1 << 0>, fwd<1 << 1>, fwd<1 << 2>, fwd<1 << 3>, fwd<1 << 4>, fwd<1 << 5>, fwd<1 << 6>, fwd<1 << 7>, fwd<1 << 8>, fwd<1 << 9>, fwd<1 << 10>, fwd<1 << 11>, fwd<1 << 12>, fwd<1 << 13>, fwd<1 << 14>};
    constexpr int NK = 15;
#endif
    if (grid == 0) {
        if (n_in != 34 || out_size != MTOK * DM || ws_size < WS_END) { fprintf(stderr, "kernel_launch: unexpected shapes (n_in %d, out %d, ws %zu; need ws >= %zu)\n", n_in, out_size, ws_size, (size_t)WS_END); grid = -1; return; }
        int dev = 0, cus = 0;
        if (hipGetDevice(&dev) != hipSuccess || hipDeviceGetAttribute(&cus, hipDeviceAttributeMultiprocessorCount, dev) != hipSuccess) { grid = -1; return; }
        for (int i = 0; i < NK; ++i) if (hipFuncSetAttribute((const void*)kerns[i], hipFuncAttributeMaxDynamicSharedMemorySize, LDS_BYTES) != hipSuccess) { fprintf(stderr, "kernel_launch: hipFuncSetAttribute failed\n"); grid = -1; return; }
        int per_cu = 0;
        if (hipOccupancyMaxActiveBlocksPerMultiprocessor(&per_cu, (const void*)kerns[0], NTHR, LDS_BYTES) != hipSuccess || per_cu < 1) fprintf(stderr, "kernel_launch: occupancy query says %d blocks per CU\n", per_cu);
        (void)hipGetLastError();
        grid = cus;
    }
    if (grid < 0) return;
    (void)hipMemsetAsync((char*)d_ws + WS_CTL, 0, CTL_ZERO_BYTES, stream);
    (void)hipMemsetAsync((char*)d_ws + WS_AUX, 0, AUX_ZERO_BYTES, stream);
    Args a{};
    for (int i = 0; i < 34; ++i) a.in[i] = (const float*)d_in[i];
    a.out = (float*)d_out; a.ws = (unsigned char*)d_ws;
#if MK_ONE_LAUNCH
    a.ph_lo = 0; a.ph_hi = NPH;
    hipLaunchKernelGGL(kerns[0], dim3(grid), dim3(NTHR), LDS_BYTES, stream, a);
#else
#ifndef HOST_REP
#define HOST_REP 0
#endif
    for (int k = 0; k < NPH; ++k) { a.ph_lo = k; a.ph_hi = k + 1; const int j = k == 0 ? 0 : (k - 1) % 14 + 1;
        for (int rep = 0; rep < (((HOST_REP) >> j) & 1 ? 2 : 1); ++rep) {
            if (rep && j == 8) (void)hipMemsetAsync((char*)d_ws + WS_CTL + (8192 + 64 * ((k - 1) / 14)) * 4, 0, 256, stream);
            a.rep = rep; hipLaunchKernelGGL(kerns[j], dim3(grid), dim3(NTHR), LDS_BYTES, stream, a); } }
#endif
}
```

```cpp
#include <hip/hip_runtime.h>
#include <cstdio>
#include <cstdint>
__device__ __forceinline__ int lane_now() { unsigned m = ~0u; asm volatile("" : "+s"(m)); return (int)__builtin_amdgcn_mbcnt_hi(m, __builtin_amdgcn_mbcnt_lo(m, 0u)); }
namespace pg8 {
#define PG8_LAS __attribute__((address_space(3)))
typedef unsigned short bf16_t;
typedef short bf16x8 __attribute__((ext_vector_type(8)));
typedef float f32x4 __attribute__((ext_vector_type(4)));
typedef unsigned u32x4 __attribute__((ext_vector_type(4)));
constexpr int BM = 256, BK = 64, HALF = 128, HTB = HALF * BK * 2  , STAGE_BYTES = 8 * HTB, NXCD = 8, WGM = 8;

__host__ __device__ __forceinline__ int lds_byte(int r, int c) { const int st = (r >> 4) * 2 + (c >> 5), rr = r & 15, cc = c & 31, ob = rr * 64 + cc * 2; return st * 1024 + (ob ^ (((ob >> 9) & 1) << 5)); }
__host__ __device__ __forceinline__ void stage_rc(int b, int& R, int& C) { const int st = b / 1024, sb = b % 1024, swz = sb ^ (((sb >> 9) & 1) << 5); R = (st >> 1) * 16 + swz / 64; C = (st & 1) * 32 + (swz % 64) / 2; }
__host__ __device__ __forceinline__ int perm32(int rho) { const int n = rho >> 4, i = rho & 15; return 8 * (i >> 2) + 4 * n + (i & 3); }

struct Unit { int pm, pn; };
struct Gemm { const bf16_t* A; const bf16_t* Bt; int M, N, K; };

struct StaticOrder {
    int nM, nN, nwg, G, c;
    __host__ __device__ void init(int M, int N, int G_, int c_) { nM = M / BM; nN = N / BM; nwg = nM * nN; G = G_; c = c_; }
    __host__ __device__ bool next(int i, Unit& u) const {
        const long L = (long)i * G + c; if (L >= nwg) return false;
        int wgid = (int)L; { const int q = nwg / NXCD, r = nwg % NXCD, xcd = wgid % NXCD, off = wgid / NXCD; wgid = (xcd < r ? xcd * (q + 1) : r * (q + 1) + (xcd - r) * q) + off; }
        const int nig = WGM * nN, gid = wgid / nig, fm = gid * WGM, gsz = (nM - fm) < WGM ? (nM - fm) : WGM;
        u.pm = fm + ((wgid % nig) % gsz); u.pn = (wgid % nig) / gsz; return true;
    }
    __device__ __forceinline__ void a_ready(const Unit&) const {}
    __device__ __forceinline__ void done(const Unit&) const {}
};

__device__ __forceinline__ unsigned cvt_pk_bf16(float lo, float hi) { unsigned r; asm volatile("v_cvt_pk_bf16_f32 %0, %1, %2" : "=v"(r) : "v"(lo), "v"(hi)); return r; }
typedef float f32x2 __attribute__((ext_vector_type(2)));
constexpr int A_MT = 16384, A_DM = 2048, A_GWBW = 12 * A_MT * 2, A_GWN = 27136, A_LNGB = A_GWBW + 4 * 2 * A_GWN;
#define PG8_GAS __attribute__((address_space(1)))
__device__ __forceinline__ float quad16_sum(float x) { float a = x, b = x; asm volatile("s_nop 1\n\tv_permlane16_swap_b32 %0, %1" : "+v"(a), "+v"(b)); float y = a + b, c = y, d = y; asm volatile("s_nop 1\n\tv_permlane32_swap_b32 %0, %1" : "+v"(c), "+v"(d)); return c + d; }
template <class T> __device__ __forceinline__ PG8_GAS T* uni_ptr(T* p) { const unsigned long long v = (unsigned long long)p; const unsigned lo = __builtin_amdgcn_readfirstlane((unsigned)v), hi = __builtin_amdgcn_readfirstlane((unsigned)(v >> 32)); return (PG8_GAS T*)(((unsigned long long)hi << 32) | lo); }
__device__ __forceinline__ f32x2 ln_stats(const float* aux, int q, int row) { const f32x2 s = *(const f32x2*)(aux + ((size_t)q * A_MT + row) * 2); const float mean = s.x * (1.0f / A_DM);
    const float var = s.y * (1.0f / A_DM) - mean * mean; return (f32x2){mean, 1.0f / sqrtf(var + 1e-5f)}; }
struct EpiSwiGLU {
    static constexpr bool PERM = true, AFTER_DRAIN = false, PREFETCH = true;
    bf16_t* H; int ldh; const float* aux; int q, gwo;
    __device__ __forceinline__ void prefetch(const Unit& u, PG8_LAS unsigned char* xl, int wid, int lane) const {
        const int w = wid & 3, qq = q < 0 ? 0 : q; const PG8_GAS float* au = uni_ptr(aux);
        const PG8_GAS float* src = w < 2 ? au + ((size_t)qq * A_MT + u.pm * BM) * 2 + (w * 64 + lane) * 4
                                         : au + A_GWBW + gwo + (w == 3 ? A_GWN : 0) + (lane >= 32 ? 5504 : 0) + u.pn * HALF + (lane & 31) * 4;
        __builtin_amdgcn_global_load_lds((const unsigned*)src, (PG8_LAS unsigned*)(xl + wid * 1024), 16, 0, 0);
    }
    __device__ __forceinline__ void operator()(const f32x4 (&acc)[2][2][4][2], const Unit& u, int wr, int wc, int fr, int fq, PG8_LAS unsigned char* xl) const {
        const int row0 = u.pm * BM + wr * 64 + fr, col0 = u.pn * HALF + wc * 32 + 8 * fq;
        f32x4 ga[2], gb[2], ba[2], bb[2]; f32x2 sr[8];
#pragma unroll
        for (int n = 0; n < 2; ++n) { ga[n] = (f32x4){0.f, 0.f, 0.f, 0.f}; gb[n] = ga[n]; ba[n] = ga[n]; bb[n] = ga[n]; }
#pragma unroll
        for (int k = 0; k < 8; ++k) sr[k] = (f32x2){0.f, (float)A_DM * (1.0f - 1e-5f)};
        if (q >= 0) { const PG8_LAS float* cv = (const PG8_LAS float*)(xl + 2048) + wc * 32 + 8 * fq; const PG8_LAS float* rs = (const PG8_LAS float*)xl + (wr * 64 + fr) * 2;
#pragma unroll
            for (int n = 0; n < 2; ++n) { ga[n] = *(const PG8_LAS f32x4*)(cv + 4 * n); gb[n] = *(const PG8_LAS f32x4*)(cv + 128 + 4 * n); ba[n] = *(const PG8_LAS f32x4*)(cv + 256 + 4 * n); bb[n] = *(const PG8_LAS f32x4*)(cv + 384 + 4 * n); }
#pragma unroll
            for (int k = 0; k < 8; ++k) sr[k] = *(const PG8_LAS f32x2*)(rs + ((k >> 2) * HALF + (k & 3) * 16) * 2);
        }
        asm volatile("" ::: "memory");
#pragma unroll
        for (int ai = 0; ai < 2; ++ai)
#pragma unroll
            for (int m = 0; m < 4; ++m) { const int row = row0 + ai * HALF + m * 16; bf16_t* rowp = H + (size_t)row * ldh + col0;
                const float mean = sr[ai * 4 + m].x * (1.0f / A_DM), rstd = 1.0f / sqrtf(sr[ai * 4 + m].y * (1.0f / A_DM) - mean * mean + 1e-5f);
                float hv[8];
#pragma unroll
                for (int n = 0; n < 2; ++n) {
#pragma unroll
                    for (int i = 0; i < 4; ++i) { const float a = (acc[ai][0][m][n][i] - mean * ga[n][i]) * rstd + ba[n][i], b = (acc[ai][1][m][n][i] - mean * gb[n][i]) * rstd + bb[n][i];
                        const float e = __builtin_amdgcn_exp2f(a * -1.44269504089f); hv[n * 4 + i] = a * __builtin_amdgcn_rcpf(1.0f + e) * b; } }
                u32x4 w; w.x = cvt_pk_bf16(hv[0], hv[1]); w.y = cvt_pk_bf16(hv[2], hv[3]); w.z = cvt_pk_bf16(hv[4], hv[5]); w.w = cvt_pk_bf16(hv[6], hv[7]);
                *(u32x4*)rowp = w; asm volatile("" ::: "memory"); }
    }
};
struct EpiResid {
    static constexpr bool PERM = true, AFTER_DRAIN = false, PREFETCH = false;
    float* Y; bf16_t* YB; unsigned char* L8; int ldc; float alpha, s; int qp, qn;
    __device__ __forceinline__ void operator()(const f32x4 (&acc)[2][2][4][2], const Unit& u, int wr, int wc, int fr, int fq, PG8_LAS unsigned char* xl) const {
        const int urow0 = __builtin_amdgcn_readfirstlane(u.pm * BM + wr * 64), ucol0 = __builtin_amdgcn_readfirstlane(u.pn * BM + wc * 32); const unsigned lob = (unsigned)(fr * ldc + 8 * fq) * 4u;
        float al_ = alpha, sc_ = s; asm volatile("" : "+s"(al_), "+s"(sc_));
        PG8_GAS float* Yu = uni_ptr(Y); PG8_GAS bf16_t* YBu = uni_ptr(YB); PG8_GAS unsigned char* L8u = uni_ptr(L8);
        PG8_GAS float* aux = Yu + (size_t)A_MT * A_DM; const PG8_GAS float* lng = aux + A_LNGB + (size_t)(qp < 0 ? 0 : qp) * 2 * A_DM + ucol0 + 8 * fq; const PG8_GAS float* lnb = lng + A_DM;
        PG8_LAS float* wl = (PG8_LAS float*)(xl + (wr * 4 + wc) * 2048); float t1[2] = {0.f, 0.f}, t2[2] = {0.f, 0.f};
#pragma unroll
        for (int e = 0; e < 2; ++e) { const int k = 2 * fq + e, j = 16 * k + fr; f32x2 st = {0.f, 1.f};
            if (qp >= 0) { const f32x2 sr = *(const PG8_GAS f32x2*)(aux + ((size_t)qp * A_MT + urow0 + (k >> 2) * HALF + (k & 3) * 16 + fr) * 2); const float mean = sr.x * (1.0f / A_DM);
                st.x = mean; st.y = 1.0f / sqrtf(sr.y * (1.0f / A_DM) - mean * mean + 1e-5f); }
            *(PG8_LAS f32x2*)(wl + 2 * j) = st; }
        asm volatile("s_waitcnt lgkmcnt(0)" ::: "memory");
        typedef unsigned u32x2_ __attribute__((ext_vector_type(2)));
#pragma unroll
        for (int c = 0; c < 4; ++c) { const int ai = c >> 1, bj = c & 1;
            f32x4 gv[2], bv[2];
#pragma unroll
            for (int n = 0; n < 2; ++n) { gv[n] = (f32x4){1.f, 1.f, 1.f, 1.f}; bv[n] = (f32x4){0.f, 0.f, 0.f, 0.f}; }
            u32x4 xb[4]; u32x2_ xl8[4];
            if (qp >= 0) {
#pragma unroll
                for (int n = 0; n < 2; ++n) { gv[n] = *(const PG8_GAS f32x4*)(lng + bj * HALF + n * 4); bv[n] = *(const PG8_GAS f32x4*)(lnb + bj * HALF + n * 4); } }
#pragma unroll
            for (int m = 0; m < 4; ++m) { int ur = urow0 + ai * HALF + m * 16; ur = __builtin_amdgcn_readfirstlane(ur); asm volatile("" : "+s"(ur));
                const size_t eo = (size_t)ur * ldc + ucol0 + bj * HALF; xb[m] = *(const PG8_GAS u32x4*)((const PG8_GAS char*)(YBu + eo) + (lob >> 1)); xl8[m] = *(const PG8_GAS u32x2_*)(L8u + eo + (lob >> 2)); }
            asm volatile("" ::: "memory");
#pragma unroll
            for (int m = 0; m < 4; ++m) { int ur = urow0 + ai * HALF + m * 16; ur = __builtin_amdgcn_readfirstlane(ur); asm volatile("" : "+s"(ur)); const size_t uoff = (size_t)ur * ldc + ucol0 + bj * HALF;
                const int j = 16 * (ai * 4 + m) + fr; const f32x2 st = *(const PG8_LAS f32x2*)(wl + 2 * j); float p1 = 0.f, p2 = 0.f; u32x4 wb; u32x2_ wl8;
#pragma unroll
                for (int n = 0; n < 2; ++n) {
                    f32x4 xr; { const unsigned w0 = n ? xb[m].z : xb[m].x, w1 = n ? xb[m].w : xb[m].y; const int lw = (int)(n ? xl8[m].y : xl8[m].x); const f32x2 l0 = __builtin_amdgcn_cvt_pk_f32_bf8(lw, false), l1 = __builtin_amdgcn_cvt_pk_f32_bf8(lw, true);
                        xr.x = __builtin_bit_cast(float, w0 << 16) + l0.x; xr.y = __builtin_bit_cast(float, w0 & 0xffff0000u) + l0.y; xr.z = __builtin_bit_cast(float, w1 << 16) + l1.x; xr.w = __builtin_bit_cast(float, w1 & 0xffff0000u) + l1.y; }
                    const f32x4 x = (xr - st.x) * st.y * gv[n] + bv[n];
                    const f32x4 y = x * al_ + acc[ai][bj][m][n] * sc_;
                    const unsigned h0 = cvt_pk_bf16(y.x, y.y), h1 = cvt_pk_bf16(y.z, y.w);
                    int l8 = __builtin_amdgcn_cvt_pk_bf8_f32(y.x - __builtin_bit_cast(float, h0 << 16), y.y - __builtin_bit_cast(float, h0 & 0xffff0000u), 0, false);
                    l8 = __builtin_amdgcn_cvt_pk_bf8_f32(y.z - __builtin_bit_cast(float, h1 << 16), y.w - __builtin_bit_cast(float, h1 & 0xffff0000u), l8, true);
                    if (n == 0) { wb.x = h0; wb.y = h1; wl8.x = (unsigned)l8; } else { wb.z = h0; wb.w = h1; wl8.y = (unsigned)l8; }
                    p1 += (y.x + y.y) + (y.z + y.w); p2 += (y.x * y.x + y.y * y.y) + (y.z * y.z + y.w * y.w); }
                *(PG8_GAS u32x4*)((PG8_GAS char*)(YBu + uoff) + (lob >> 1)) = wb; *(PG8_GAS u32x2_*)(L8u + uoff + (lob >> 2)) = wl8;
                p1 = quad16_sum(p1); p2 = quad16_sum(p2); const bool mine = fq == ((ai * 4 + m) >> 1);
                t1[m & 1] += mine ? p1 : 0.f; t2[m & 1] += mine ? p2 : 0.f; }
            asm volatile("" ::: "memory"); }
#pragma unroll
        for (int e = 0; e < 2; ++e) { const int k = 2 * fq + e;
            PG8_GAS float* sp = aux + ((size_t)qn * A_MT + urow0 + (k >> 2) * HALF + (k & 3) * 16 + fr) * 2;
            __hip_atomic_fetch_add(sp, __builtin_rintf(t1[e] * 1024.0f) * (1.0f / 1024.0f), __ATOMIC_RELAXED, __HIP_MEMORY_SCOPE_AGENT); __hip_atomic_fetch_add(sp + 1, __builtin_rintf(t2[e] * 64.0f) * (1.0f / 64.0f), __ATOMIC_RELAXED, __HIP_MEMORY_SCOPE_AGENT); }
        asm volatile("s_waitcnt lgkmcnt(0)" ::: "memory");
    }
};
struct EpiF32 {
    static constexpr bool PERM = false, AFTER_DRAIN = false, PREFETCH = true;
    float* C; int ldc; const float* aux; int q, gwo;
    __device__ __forceinline__ void prefetch(const Unit& u, PG8_LAS unsigned char* xl, int wid, int lane) const {
        const int w = wid & 3; const PG8_GAS float* au = uni_ptr(aux);
        const PG8_GAS float* src = w < 2 ? au + ((size_t)q * A_MT + u.pm * BM) * 2 + (w * 64 + lane) * 4 : au + A_GWBW + gwo + (w == 3 ? A_GWN : 0) + u.pn * BM + lane * 4;
        __builtin_amdgcn_global_load_lds((const unsigned*)src, (PG8_LAS unsigned*)(xl + wid * 1024), 16, 0, 0);
    }
    __device__ __forceinline__ void operator()(const f32x4 (&acc)[2][2][4][2], const Unit& u, int wr, int wc, int fr, int fq, PG8_LAS unsigned char* xl) const {
        const int row0 = u.pm * BM + wr * 64 + fr, col0 = u.pn * BM + wc * 32 + 4 * fq;
        const PG8_LAS float* cv = (const PG8_LAS float*)(xl + 2048) + wc * 32 + 4 * fq; const PG8_LAS float* rs = (const PG8_LAS float*)xl + (wr * 64 + fr) * 2;
        f32x4 g4[2][2], b4[2][2]; f32x2 sr[8];
#pragma unroll
        for (int bj = 0; bj < 2; ++bj)
#pragma unroll
            for (int n = 0; n < 2; ++n) { g4[bj][n] = *(const PG8_LAS f32x4*)(cv + bj * HALF + n * 16); b4[bj][n] = *(const PG8_LAS f32x4*)(cv + 256 + bj * HALF + n * 16); }
#pragma unroll
        for (int k = 0; k < 8; ++k) sr[k] = *(const PG8_LAS f32x2*)(rs + ((k >> 2) * HALF + (k & 3) * 16) * 2);
        asm volatile("" ::: "memory");
#pragma unroll
        for (int ai = 0; ai < 2; ++ai)
#pragma unroll
            for (int m = 0; m < 4; ++m) { const int row = row0 + ai * HALF + m * 16; float* rowp = C + (size_t)row * ldc + col0;
                const float mean = sr[ai * 4 + m].x * (1.0f / A_DM), rstd = 1.0f / sqrtf(sr[ai * 4 + m].y * (1.0f / A_DM) - mean * mean + 1e-5f);
#pragma unroll
                for (int bj = 0; bj < 2; ++bj)
#pragma unroll
                    for (int n = 0; n < 2; ++n) *(f32x4*)(rowp + bj * HALF + n * 16) = (acc[ai][bj][m][n] - g4[bj][n] * mean) * rstd + b4[bj][n];
                asm volatile("" ::: "memory"); }
    }
};

template <class Epi, class Sched, bool ALIGN_EPI = false, bool SP2 = false>
__device__ __forceinline__ void gemm_phase(PG8_LAS unsigned char* lds, const Gemm g, const Sched& S, const Epi& E) {
    int tid_ = threadIdx.x; asm volatile("" : "+v"(tid_));
    const int tid = tid_, wid = __builtin_amdgcn_readfirstlane(tid >> 6), lane = tid & 63, wr = wid >> 2, wc = wid & 3, fr = lane & 15, fq = lane >> 4;
    const int K = g.K, nt = K / BK;
    unsigned voffA[2], voffB[2];
#pragma unroll
    for (int i = 0; i < 2; ++i) { int R, C; stage_rc(tid * 16 + i * 8192, R, C); const int Rb = Epi::PERM ? ((R & ~31) + perm32(R & 31)) : R;
        voffA[i] = (unsigned)(R * K + C) * 2u; voffB[i] = (unsigned)(Rb * K + C) * 2u; }
    const size_t kstep = (size_t)(BK * 2);
    const size_t hstep = (size_t)HALF * K * 2;
    const size_t tstep = 2 * hstep;
    const unsigned ldsw = (unsigned)wid * 1024u;
    const int aoff = lds_byte(wr * 64 + fr, fq * 8), boff = lds_byte(wc * 32 + fr, fq * 8);
#define PG8_SA(b, h) (((b) * 2 + (h)) * HTB)
#define PG8_SB(b, h) ((4 + (b) * 2 + (h)) * HTB)
#define PG8_STAGE(bufoff, gbase, voff) do { _Pragma("unroll") for (int _i = 0; _i < 2; ++_i) \
        __builtin_amdgcn_global_load_lds((const unsigned*)((const char*)(gbase) + (voff)[_i]), (PG8_LAS unsigned*)(lds + (bufoff) + ldsw + _i * 8192), 16, 0, 0); } while (0)
#define PG8_LDA(dst, b, h) do { _Pragma("unroll") for (int m = 0; m < 4; ++m) _Pragma("unroll") for (int k = 0; k < 2; ++k) dst[m][k] = *(const PG8_LAS bf16x8*)(lds + PG8_SA(b, h) + aoff + m * 2048 + k * 1024); } while (0)
#define PG8_LDB(dst, b, h) do { _Pragma("unroll") for (int n = 0; n < 2; ++n) _Pragma("unroll") for (int k = 0; k < 2; ++k) dst[n][k] = *(const PG8_LAS bf16x8*)(lds + PG8_SB(b, h) + boff + n * 2048 + k * 1024); } while (0)
#define PG8_MMA(ai, bj, At, Bt) do { __builtin_amdgcn_s_setprio(1); _Pragma("unroll") for (int m = 0; m < 4; ++m) _Pragma("unroll") for (int n = 0; n < 2; ++n) _Pragma("unroll") for (int k = 0; k < 2; ++k) \
        acc[ai][bj][m][n] = __builtin_amdgcn_mfma_f32_16x16x32_bf16(Bt[n][k], At[m][k], acc[ai][bj][m][n], 0, 0, 0); __builtin_amdgcn_s_setprio(0); } while (0)
#define PG8_WAIT_V(n) asm volatile("s_waitcnt vmcnt(" #n ")" ::: "memory")
#define PG8_WAIT_L(n) asm volatile("s_waitcnt lgkmcnt(" #n ")" ::: "memory")
#define PG8_BAR __builtin_amdgcn_s_barrier()
#define PG8_SCHED __builtin_amdgcn_sched_barrier(0)
    Unit cur, nxt; int ui = 0;
    if (!S.next(0, cur)) return;
    f32x4 acc[2][2][4][2];
#pragma unroll
    for (int a = 0; a < 2; ++a)
#pragma unroll
        for (int b = 0; b < 2; ++b)
#pragma unroll
            for (int m = 0; m < 4; ++m)
#pragma unroll
                for (int n = 0; n < 2; ++n) acc[a][b][m][n] = (f32x4){0.f, 0.f, 0.f, 0.f};
    bf16x8 At[4][2], B0[2][2], B1[2][2];
    const char* cA = (const char*)g.A + (size_t)cur.pm * tstep; const char* cB = (const char*)g.Bt + (size_t)cur.pn * tstep;
    S.a_ready(cur);
    if constexpr (SP2) {
        PG8_STAGE(PG8_SB(0, 0), cB, voffB); PG8_STAGE(PG8_SB(0, 1), cB + hstep, voffB); PG8_STAGE(PG8_SA(0, 0), cA, voffA); PG8_STAGE(PG8_SA(0, 1), cA + hstep, voffA);
        if (wr == 1) PG8_BAR;
        PG8_WAIT_V(2); PG8_BAR;
        PG8_STAGE(PG8_SB(1, 0), cB + kstep, voffB); PG8_STAGE(PG8_SA(1, 0), cA + kstep, voffA); PG8_STAGE(PG8_SB(1, 1), cB + hstep + kstep, voffB);
        PG8_WAIT_V(6); PG8_BAR;
    } else {
        PG8_STAGE(PG8_SB(0, 0), cB, voffB); PG8_STAGE(PG8_SA(0, 0), cA, voffA); PG8_STAGE(PG8_SB(0, 1), cB + hstep, voffB); PG8_STAGE(PG8_SA(0, 1), cA + hstep, voffA);
        if (wr == 1) PG8_BAR;
        PG8_WAIT_V(4); PG8_BAR;
        PG8_STAGE(PG8_SB(1, 0), cB + kstep, voffB); PG8_STAGE(PG8_SA(1, 0), cA + kstep, voffA); PG8_STAGE(PG8_SB(1, 1), cB + hstep + kstep, voffB);
        PG8_WAIT_V(6); PG8_BAR;
    }
    for (;;) {
        const bool has_next = S.next(ui + 1, nxt);
        const char* nA = has_next ? (const char*)g.A + (size_t)nxt.pm * tstep : cA; const char* nB = has_next ? (const char*)g.Bt + (size_t)nxt.pn * tstep : cB;
        for (int t = 0; t < nt; t += 2) {
            const bool last = (t == nt - 2);
            const char* a1 = cA + (size_t)(t + 1) * kstep;
            const char* a2 = last ? nA : cA + (size_t)(t + 2) * kstep; const char* b2 = last ? nB : cB + (size_t)(t + 2) * kstep;
            const char* a3 = a2 + kstep; const char* b3 = b2 + kstep;
            if (last && has_next) S.a_ready(nxt);
            if constexpr (Epi::PREFETCH) { if (last) E.prefetch(cur, lds + STAGE_BYTES, wid, lane); }
            if constexpr (SP2) {
            PG8_LDB(B0, 0, 0); PG8_LDB(B1, 0, 1); PG8_SCHED; PG8_LDA(At, 0, 0); PG8_STAGE(PG8_SA(1, 1), a1 + hstep, voffA);
            PG8_WAIT_V(8); PG8_WAIT_L(0); PG8_BAR; PG8_MMA(0, 0, At, B0); PG8_MMA(0, 1, At, B1); PG8_BAR; PG8_SCHED;
            PG8_LDA(At, 0, 1); PG8_STAGE(PG8_SB(0, 0), b2, voffB); PG8_STAGE(PG8_SB(0, 1), b2 + hstep, voffB); PG8_STAGE(PG8_SA(0, 0), a2, voffA);
            PG8_WAIT_V(8); PG8_WAIT_L(0); PG8_BAR; PG8_MMA(1, 0, At, B0); PG8_MMA(1, 1, At, B1); PG8_BAR; PG8_SCHED;
            PG8_LDB(B0, 1, 0); PG8_LDB(B1, 1, 1); PG8_SCHED; PG8_LDA(At, 1, 0); PG8_STAGE(PG8_SA(0, 1), a2 + hstep, voffA);
            PG8_WAIT_V(8); PG8_WAIT_L(0); PG8_BAR; PG8_MMA(0, 0, At, B0); PG8_MMA(0, 1, At, B1); PG8_BAR; PG8_SCHED;
            PG8_LDA(At, 1, 1); PG8_STAGE(PG8_SB(1, 0), b3, voffB); PG8_STAGE(PG8_SB(1, 1), b3 + hstep, voffB); PG8_STAGE(PG8_SA(1, 0), a3, voffA);
            PG8_WAIT_V(8); PG8_WAIT_L(0); PG8_BAR; PG8_MMA(1, 0, At, B0); PG8_MMA(1, 1, At, B1); PG8_BAR; PG8_SCHED;
            } else {
            PG8_LDB(B0, 0, 0); PG8_SCHED; PG8_LDA(At, 0, 0); PG8_STAGE(PG8_SA(1, 1), a1 + hstep, voffA);
            PG8_WAIT_L(8); PG8_BAR; PG8_WAIT_L(0); PG8_MMA(0, 0, At, B0); PG8_BAR; PG8_SCHED;
            PG8_LDB(B1, 0, 1); PG8_STAGE(PG8_SB(0, 0), b2, voffB);
            PG8_BAR; PG8_WAIT_L(0); PG8_MMA(0, 1, At, B1); PG8_BAR;
            PG8_LDA(At, 0, 1); PG8_STAGE(PG8_SA(0, 0), a2, voffA);
            PG8_BAR; PG8_WAIT_L(0); PG8_MMA(1, 0, At, B0); PG8_BAR; PG8_SCHED;
            PG8_STAGE(PG8_SB(0, 1), b2 + hstep, voffB);
            PG8_WAIT_V(6); PG8_BAR; PG8_MMA(1, 1, At, B1); PG8_BAR;
            PG8_LDB(B0, 1, 0); PG8_SCHED; PG8_LDA(At, 1, 0); PG8_STAGE(PG8_SA(0, 1), a2 + hstep, voffA);
            PG8_WAIT_L(8); PG8_BAR; PG8_WAIT_L(0); PG8_MMA(0, 0, At, B0); PG8_BAR; PG8_SCHED;
            PG8_LDB(B1, 1, 1); PG8_STAGE(PG8_SB(1, 0), b3, voffB);
            PG8_BAR; PG8_WAIT_L(0); PG8_MMA(0, 1, At, B1); PG8_BAR;
            PG8_LDA(At, 1, 1); PG8_STAGE(PG8_SA(1, 0), a3, voffA);
            PG8_BAR; PG8_WAIT_L(0); PG8_MMA(1, 0, At, B0); PG8_BAR; PG8_SCHED;
            PG8_STAGE(PG8_SB(1, 1), b3 + hstep, voffB);
            PG8_WAIT_V(6); PG8_BAR; PG8_MMA(1, 1, At, B1); PG8_BAR;
            }
        }
        if constexpr (ALIGN_EPI) { if (wr == 0) PG8_BAR; }
        if constexpr (!Epi::AFTER_DRAIN) { E(acc, cur, wr, wc, fr, fq, lds + STAGE_BYTES); S.done(cur); }
        if (!has_next) break;
#pragma unroll
        for (int a = 0; a < 2; ++a)
#pragma unroll
            for (int b = 0; b < 2; ++b)
#pragma unroll
                for (int m = 0; m < 4; ++m)
#pragma unroll
                    for (int n = 0; n < 2; ++n) acc[a][b][m][n] = (f32x4){0.f, 0.f, 0.f, 0.f};
        cur = nxt; cA = nA; cB = nB; ++ui;
        if constexpr (ALIGN_EPI) { if (wr == 1) PG8_BAR; }
    }
    PG8_WAIT_V(0);
    if constexpr (!ALIGN_EPI) { if (wr == 0) PG8_BAR; }
    PG8_BAR;
    if constexpr (Epi::AFTER_DRAIN) { E.fused(acc, cur, wr, wc, fr, fq, lds, wid, lane); S.done(cur); }
#undef PG8_SA
#undef PG8_SB
#undef PG8_STAGE
#undef PG8_LDA
#undef PG8_LDB
#undef PG8_MMA
#undef PG8_WAIT_V
#undef PG8_WAIT_L
#undef PG8_BAR
#undef PG8_SCHED
}
}

constexpr int NWAVES = 8, NTHR = 512;
constexpr int NB = 4, SEQ = 4096, DM = 2048, MTOK = NB * SEQ, NLAYER = 4;
constexpr int DFF = 5504, NUP = 2 * DFF;
constexpr int INC = 5028, INP = 5120;
constexpr int DRW = 768, RWC = 2560, PO_POOL = 2560, DPOOL = 512, PO_NSA = 3072;
constexpr int PO_Q = PO_NSA, PO_KC = PO_NSA + 768, PO_VC = PO_KC + 192, PO_KS = PO_VC + 192, PO_VS = PO_KS + 192, PO_KW = PO_VS + 192, PO_VW = PO_KW + 192, PO_GL = PO_VW + 192;
static_assert(PO_GL + 36 == INC, "W_in column map");
constexpr int NCMP = 255, NCMPP = 256;
constexpr float ALPHA = 1.6817928305074290f;
constexpr float LN_EPS = 1e-5f, GN_EPS = 64e-5f;
constexpr int NPH = 1 + 14 * NLAYER;

constexpr size_t MiB = 1u << 20;
constexpr size_t WS_CTL = 0, CTL_ZERO_BYTES = 1 * MiB;
constexpr size_t WS_ROPE = 1 * MiB;
constexpr size_t WS_KC = 2 * MiB, WS_VC = 2 * MiB + 512 * 1024;
constexpr size_t WS_SC = 3 * MiB;
constexpr size_t WS_WUP1 = 8 * MiB, WS_WDN1 = 51 * MiB, WS_WIN = WS_WDN1 + 21 * MiB + 512 * 1024, WS_WOUT = WS_WIN + 20 * MiB, WS_WUP2 = WS_WOUT + 8 * MiB, WS_WDN2 = WS_WUP2 + 43 * MiB;
constexpr size_t WS_XB = 165 * MiB;
static_assert(WS_WDN2 + (size_t)DM * DFF * 2 <= WS_XB, "weights map");
constexpr size_t WS_CAT = 229 * MiB;
constexpr size_t WS_QR = 293 * MiB;
constexpr size_t WS_KS = 317 * MiB, WS_KW = 323 * MiB, WS_VS = 329 * MiB, WS_VW = 335 * MiB;
constexpr size_t WS_P = 341 * MiB;
constexpr size_t WS_H = 661 * MiB;
constexpr size_t WS_Y = 833 * MiB;
constexpr size_t WS_SV = WS_H;
constexpr size_t SV_STRIDE = 48 * MiB;
static_assert(WS_SV + 6 * SV_STRIDE <= WS_Y + 128 * MiB, "scan overlay");
constexpr size_t WS_G = 961 * MiB, WS_YS = 1009 * MiB;
constexpr size_t WS_VST = 1057 * MiB, WS_VWT = 1063 * MiB;
constexpr size_t WS_VCT = 6 * MiB;
constexpr size_t WS_SW = 1069 * MiB;
constexpr size_t WS_W2T = WS_SW, WS_A2T = WS_W2T + 768 * 64 * 2, WS_G2T = WS_A2T + 768 * 64 * 2, WS_PWT = WS_G2T + 768 * 128 * 2;
constexpr size_t WS_W1T = WS_PWT + 4 * 128 * 128 * 2, WS_W2CT = WS_W1T + 2 * 256 * 2048 * 2, WS_CBIAS = WS_W2CT + 2 * 64 * 256 * 2;
constexpr size_t WS_SPREC = 1073 * MiB;
constexpr size_t SPREC_BYTES = 15360, WS_YR = WS_SPREC + (size_t)NB * 12 * 256 * SPREC_BYTES + MiB;
static_assert(true, ""); constexpr size_t WS_XL8 = WS_YR;
constexpr int GWN = NUP + INP + NUP;
constexpr size_t WS_AUX = WS_YR + 128 * MiB;
constexpr size_t AUX_ST = 0, AUX_GWBW = AUX_ST + (size_t)12 * MTOK * 2 * 4, AUX_ZERO_BYTES = AUX_GWBW + (size_t)NLAYER * 2 * GWN * 4, AUX_LNGB = (AUX_ZERO_BYTES + 255) & ~(size_t)255;
constexpr size_t WS_END = WS_AUX + AUX_LNGB + (size_t)12 * 2 * DM * 4 + MiB;
static_assert(WS_CBIAS + 2 * 256 * 4 <= WS_END, "small weights map");

constexpr int LDS_SCRATCH = 147456;
constexpr int LDS_BYTES = LDS_SCRATCH + 1024, MISC_OFF = LDS_SCRATCH + 320;

#define GAS __attribute__((address_space(1)))
#define LAS __attribute__((address_space(3)))
typedef unsigned short bf16;
typedef float f32x4 __attribute__((ext_vector_type(4)));
typedef float f32x2 __attribute__((ext_vector_type(2)));
typedef unsigned u32x4 __attribute__((ext_vector_type(4)));
typedef unsigned u32x2 __attribute__((ext_vector_type(2)));
#define LDS_WAIT() asm volatile("s_waitcnt lgkmcnt(0)" ::: "memory")
__device__ __forceinline__ unsigned f2bf(float f) { unsigned u = __builtin_bit_cast(unsigned, f); return (u + 0x7fffu + ((u >> 16) & 1u)) >> 16; }
__device__ __forceinline__ unsigned pk2(float lo, float hi) { return f2bf(lo) | (f2bf(hi) << 16); }
__device__ __forceinline__ float bf2f(unsigned short b) { return __builtin_bit_cast(float, ((unsigned)b) << 16); }
__device__ __forceinline__ float wave_sum(float v) {
#pragma unroll
    for (int o = 1; o < 64; o <<= 1) v += __shfl_xor(v, o);
    return v;
}
__device__ __forceinline__ float wave_max(float v) {
#pragma unroll
    for (int o = 1; o < 64; o <<= 1) v = fmaxf(v, __shfl_xor(v, o));
    return v;
}
__device__ __forceinline__ float sigmoidf_(float x) { return 1.0f / (1.0f + expf(-x)); }
template <int CTRL> __device__ __forceinline__ float dpp_f(float v) { return __builtin_bit_cast(float, __builtin_amdgcn_update_dpp(0, __builtin_bit_cast(int, v), CTRL, 0xF, 0xF, true)); }
__device__ __forceinline__ float row16_sum(float v) {
    v += dpp_f<0xB1>(v); v += dpp_f<0x4E>(v); v += dpp_f<0x141>(v); v += dpp_f<0x140>(v); return v;
}

#define XB_TMO      128
#define XB_XCNT(j)  (256  + 64 * (j))
#define XB_XSUB(j)  (1280 + 64 * (j))
#define XB_XGEN(j)  (2304 + 64 * (j))
#define XB_TOP      3328
#define XB_TOPGEN   3392
#define XCD_BAR_WORDS 3456
#define XB_SPIN_CAP (1u << 18)

__device__ __forceinline__ unsigned xb_ld(unsigned* p)              { return __hip_atomic_load(p, __ATOMIC_RELAXED, __HIP_MEMORY_SCOPE_AGENT); }
__device__ __forceinline__ unsigned xb_add(unsigned* p, unsigned v) { return __hip_atomic_fetch_add(p, v, __ATOMIC_RELAXED, __HIP_MEMORY_SCOPE_AGENT); }
__device__ __forceinline__ unsigned xb_xcc_id() { return (unsigned)__builtin_amdgcn_s_getreg((3 << 11) | 20) & 0xFu; }
#define XB_SPIN(cond, bar) do { unsigned _sp = 0; while (cond) { __builtin_amdgcn_s_sleep(1); \
    if ((++_sp & 255u) == 0u) { if (xb_ld(&(bar)[XB_TMO])) break; if (_sp > XB_SPIN_CAP) { atomicAdd(&(bar)[XB_TMO], 1u); break; } } } } while (0)

struct XcdBarrier {
    unsigned* bar; unsigned x;
    volatile LAS unsigned* st;
};

__device__ __forceinline__ XcdBarrier xcd_barrier_post(unsigned* bar, volatile LAS unsigned* st) {
    XcdBarrier b; b.bar = bar; b.x = xb_xcc_id(); b.st = st;
    if (threadIdx.x == 0) (void)xb_add(&bar[XB_XCNT(b.x)], 1u);
    return b;
}
__device__ __forceinline__ void xcd_barrier_complete(unsigned* bar, unsigned x, unsigned& nloc, unsigned& nx) {
    const unsigned G = gridDim.x * gridDim.y * gridDim.z;
    unsigned sum, cnt, mine, sp = 0u;
    for (;;) {
        sum = 0u; cnt = 0u; mine = 0u;
#pragma unroll
        for (unsigned j = 0; j < 16; ++j) { const unsigned c = xb_ld(&bar[XB_XCNT(j)]); sum += c; cnt += (c > 0u) ? 1u : 0u; mine = (j == x) ? c : mine; }
        if (sum == G) break;
        __builtin_amdgcn_s_sleep(1);
        if ((++sp & 255u) == 0u) { if (xb_ld(&bar[XB_TMO])) break; if (sp > XB_SPIN_CAP) { atomicAdd(&bar[XB_TMO], 1u); break; } }
    }
    nloc = mine > 0u ? mine : 1u; nx = cnt > 0u ? cnt : 1u;
}

__device__ __forceinline__ void xcd_barrier(const XcdBarrier& b) {
    asm volatile("s_waitcnt vmcnt(0)" ::: "memory");
    __syncthreads();
    if (threadIdx.x == 0) {
        unsigned* bar = b.bar;
        __builtin_amdgcn_s_waitcnt(0);
        unsigned nloc = b.st[0], nx = b.st[1];
        if (nloc == 0u) { xcd_barrier_complete(bar, b.x, nloc, nx); b.st[0] = nloc; b.st[1] = nx; }
        const unsigned old = xb_add(&bar[XB_XSUB(b.x)], 1u);
        const unsigned gen = old / nloc;
        if (old + 1u == (gen + 1u) * nloc) {
            __builtin_amdgcn_fence(__ATOMIC_RELEASE, "agent");
            asm volatile("s_waitcnt vmcnt(0)" ::: "memory");
            const unsigned og = xb_add(&bar[XB_TOP], 1u);
            const unsigned tg = og / nx;
            if (og + 1u == (tg + 1u) * nx) xb_add(&bar[XB_TOPGEN], 1u);
            else XB_SPIN(xb_ld(&bar[XB_TOPGEN]) == tg, bar);
            __builtin_amdgcn_fence(__ATOMIC_ACQUIRE, "agent");
            xb_add(&bar[XB_XGEN(b.x)], 1u);
            asm volatile("s_waitcnt vmcnt(0)" ::: "memory");
        } else {
            XB_SPIN(xb_ld(&bar[XB_XGEN(b.x)]) == gen, bar);
            __builtin_amdgcn_fence(__ATOMIC_ACQUIRE, "agent");
            asm volatile("s_waitcnt vmcnt(0)" ::: "memory");
        }
    }
    __syncthreads();
}

struct Args { const float* in[34]; float* out; unsigned char* ws; int ph_lo, ph_hi, rep; };
__device__ __forceinline__ int opaque0() { int z = 0; asm volatile("" : "+s"(z)); return z; }
#define OPQ_S(x) asm volatile("" : "+s"(x))
#define OPQ_SI(x) do { (x) = __builtin_amdgcn_readfirstlane(x); asm volatile("" : "+s"(x)); } while (0)
#define OPQ_V(x) asm volatile("" : "+v"(x))
#define INPTR(a, idx) ((a).in[(idx) + opaque0()])
enum { I_X = 0, I_UP1, I_DN1, I_LN1G, I_LN1B, I_WIN, I_MU, I_W0, I_W2, I_A0, I_A2, I_G2, I_KK, I_KA, I_RK, I_GNG, I_GNB, I_PW, I_PB, I_PS, I_PEK, I_PEV, I_CK1, I_CK2, I_CV1, I_CV2, I_GB, I_WOUT, I_LN2G, I_LN2B, I_UP2, I_DN2, I_LN3G, I_LN3B };

template <bool LN = false> __device__ __forceinline__ void transpose_item(const float* W, int K, int Nsrc, bf16* WT, int dst0, LAS float* scr, int k0, int n0, int lane, const float* lng = nullptr, const float* lnb = nullptr, float* gwp = nullptr) {
    const int c4 = lane & 15, rq = lane >> 4; const int n = n0 + 4 * c4; const bool ok = n < Nsrc;
    const float* wp = W + (size_t)(k0 + rq) * Nsrc + n;
#pragma unroll 8
    for (int i = 0; i < 16; ++i) { const f32x4 v = ok ? *(const f32x4*)(wp + (size_t)(4 * i) * Nsrc) : (f32x4){0.f, 0.f, 0.f, 0.f};
        LAS float* d = scr + (4 * i + rq) * 65 + 4 * c4; d[0] = v.x; d[1] = v.y; d[2] = v.z; d[3] = v.w; }
    const int c = lane & 7;
    f32x4 g0 = {1.f, 1.f, 1.f, 1.f}, g1 = g0, b0 = {0.f, 0.f, 0.f, 0.f}, b1 = b0;
    if constexpr (LN) { g0 = *(const f32x4*)(lng + k0 + 8 * c); g1 = *(const f32x4*)(lng + k0 + 8 * c + 4); b0 = *(const f32x4*)(lnb + k0 + 8 * c); b1 = *(const f32x4*)(lnb + k0 + 8 * c + 4); }
    LDS_WAIT();
    float mg = 0.f, mb = 0.f;
#pragma unroll
    for (int j = 0; j < 8; ++j) { const int nn = (lane >> 3) + 8 * j; const LAS float* s = scr + (8 * c) * 65 + nn;
        float v[8];
#pragma unroll
        for (int q = 0; q < 8; ++q) v[q] = s[q * 65];
        if constexpr (LN) {
            float pb = v[0] * b0.x + v[1] * b0.y + v[2] * b0.z + v[3] * b0.w + v[4] * b1.x + v[5] * b1.y + v[6] * b1.z + v[7] * b1.w;
            v[0] *= g0.x; v[1] *= g0.y; v[2] *= g0.z; v[3] *= g0.w; v[4] *= g1.x; v[5] *= g1.y; v[6] *= g1.z; v[7] *= g1.w;
            float pg = ((v[0] + v[1]) + (v[2] + v[3])) + ((v[4] + v[5]) + (v[6] + v[7]));
            pg += dpp_f<0xB1>(pg); pg += dpp_f<0x4E>(pg); pg += dpp_f<0x141>(pg); pb += dpp_f<0xB1>(pb); pb += dpp_f<0x4E>(pb); pb += dpp_f<0x141>(pb);
            mg = c == j ? pg : mg; mb = c == j ? pb : mb; }
        u32x4 o; o.x = pk2(v[0], v[1]); o.y = pk2(v[2], v[3]); o.z = pk2(v[4], v[5]); o.w = pk2(v[6], v[7]);
        *(u32x4*)(WT + (size_t)(dst0 + nn) * K + k0 + 8 * c) = o; }
    if constexpr (LN) { const int nm = n0 + (lane >> 3) + 8 * c;
        if (nm < Nsrc) {
            __hip_atomic_fetch_add((GAS float*)gwp + nm, __builtin_rintf(mg * 65536.0f) * (1.0f / 65536.0f), __ATOMIC_RELAXED, __HIP_MEMORY_SCOPE_AGENT);
            __hip_atomic_fetch_add((GAS float*)gwp + GWN + nm, __builtin_rintf(mb * 65536.0f) * (1.0f / 65536.0f), __ATOMIC_RELAXED, __HIP_MEMORY_SCOPE_AGENT); } }
    LDS_WAIT();
}
__device__ __forceinline__ int up_dst_row(int n0) { return n0 < DFF ? 256 * (n0 / 128) + (n0 % 128) : 256 * ((n0 - DFF) / 128) + 128 + ((n0 - DFF) % 128); }

__device__ __forceinline__ void phase_wconv(const Args& a, int l, LAS unsigned char* lds, int gw, int NGW, int wave, int lane) {
    OPQ_SI(gw); OPQ_SI(wave); OPQ_V(lane);
    LAS float* scr = (LAS float*)(lds + wave * 16640);
    unsigned char* ws = a.ws + opaque0();
    float* gwl = a.rep ? (float*)(ws + WS_END - MiB) : (float*)(ws + WS_AUX + AUX_GWBW) + (size_t)l * 2 * GWN;
    {
        const int gt = gw * 64 + lane; if (gt < 3 * 2 * (DM / 4)) { const int j = gt / (2 * (DM / 4)), r2 = gt - j * 2 * (DM / 4), isb = r2 / (DM / 4), c4_ = r2 - isb * (DM / 4);
            const float* src = (j == 0 ? (isb ? INPTR(a, I_LN1B) : INPTR(a, I_LN1G)) : j == 1 ? (isb ? INPTR(a, I_LN2B) : INPTR(a, I_LN2G)) : (isb ? INPTR(a, I_LN3B) : INPTR(a, I_LN3G))) + (size_t)l * DM;
            ((f32x4*)(ws + WS_AUX + AUX_LNGB))[((size_t)(3 * l + j) * 2 + isb) * (DM / 4) + c4_] = ((const f32x4*)src)[c4_]; } }
    constexpr int I_UP = (DM / 64) * (NUP / 64), I_DN = (DFF / 64) * (DM / 64), I_IN = (DM / 64) * (INP / 64), I_OUT = (DM / 64) * (DM / 64);
    constexpr int NIT = 2 * I_UP + 2 * I_DN + I_IN + I_OUT + 12 + 12 + 24 + 16 + 256 + 8;
    for (int it = gw; it < NIT; it += NGW) {
        int r = it;
        if (r < 2 * I_UP) { const int which = r / I_UP; r -= which * I_UP; const int nblk = NUP / 64, kb = r / nblk, nb = r % nblk;
            const float* W = a.in[which ? I_UP2 : I_UP1] + (size_t)l * DM * NUP; bf16* WT = (bf16*)(ws + (which ? WS_WUP2 : WS_WUP1));
            const float* lg = which ? INPTR(a, I_LN2G) + (size_t)l * DM : (l > 0 ? INPTR(a, I_LN3G) + (size_t)(l - 1) * DM : nullptr);
            const float* lb = which ? INPTR(a, I_LN2B) + (size_t)l * DM : (l > 0 ? INPTR(a, I_LN3B) + (size_t)(l - 1) * DM : nullptr);
            if (lg) transpose_item<true>(W, DM, NUP, WT, up_dst_row(64 * nb), scr, 64 * kb, 64 * nb, lane, lg, lb, gwl + (which ? NUP + INP : 0)); else transpose_item<false>(W, DM, NUP, WT, up_dst_row(64 * nb), scr, 64 * kb, 64 * nb, lane); continue; }
        r -= 2 * I_UP;
        if (r < 2 * I_DN) { const int which = r / I_DN; r -= which * I_DN; const int nblk = DM / 64, kb = r / nblk, nb = r % nblk;
            const float* W = a.in[which ? I_DN2 : I_DN1] + (size_t)l * DFF * DM; bf16* WT = (bf16*)(ws + (which ? WS_WDN2 : WS_WDN1));
            transpose_item(W, DFF, DM, WT, 64 * nb, scr, 64 * kb, 64 * nb, lane); continue; }
        r -= 2 * I_DN;
        if (r < I_IN) { const int nblk = INP / 64, kb = r / nblk, nb = r % nblk;
            transpose_item<true>(INPTR(a, I_WIN) + (size_t)l * DM * INC, DM, INC, (bf16*)(ws + WS_WIN), 64 * nb, scr, 64 * kb, 64 * nb, lane, INPTR(a, I_LN1G) + (size_t)l * DM, INPTR(a, I_LN1B) + (size_t)l * DM, gwl + NUP); continue; }
        r -= I_IN;
        if (r < I_OUT) { const int nblk = DM / 64, kb = r / nblk, nb = r % nblk;
            transpose_item(INPTR(a, I_WOUT) + (size_t)l * DM * DM, DM, DM, (bf16*)(ws + WS_WOUT), 64 * nb, scr, 64 * kb, 64 * nb, lane); continue; }
        r -= I_OUT;
        if (r < 12) { transpose_item(INPTR(a, I_W2) + (size_t)l * 64 * DRW, 64, DRW, (bf16*)(ws + WS_W2T), 64 * r, scr, 0, 64 * r, lane); continue; } r -= 12;
        if (r < 12) { transpose_item(INPTR(a, I_A2) + (size_t)l * 64 * DRW, 64, DRW, (bf16*)(ws + WS_A2T), 64 * r, scr, 0, 64 * r, lane); continue; } r -= 12;
        if (r < 24) { const int kb = r / 12, nb = r % 12; transpose_item(INPTR(a, I_G2) + (size_t)l * 128 * DRW, 128, DRW, (bf16*)(ws + WS_G2T), 64 * nb, scr, 64 * kb, 64 * nb, lane); continue; } r -= 24;
        if (r < 16) { const int gi = r >> 2, q = r & 3, kb = q >> 1, nb = q & 1; transpose_item(INPTR(a, I_PW) + ((size_t)l * 4 + gi) * 128 * 128, 128, 128, (bf16*)(ws + WS_PWT) + gi * 128 * 128, 64 * nb, scr, 64 * kb, 64 * nb, lane); continue; } r -= 16;
        if (r < 256) { const int ten = r >> 7, q = r & 127, kb = q >> 2, nb = q & 3; transpose_item(INPTR(a, ten ? I_CV1 : I_CK1) + (size_t)l * 2048 * 256, 2048, 256, (bf16*)(ws + WS_W1T) + (size_t)ten * 256 * 2048, 64 * nb, scr, 64 * kb, 64 * nb, lane); continue; } r -= 256;
        { const int ten = r >> 2, kb = r & 3; transpose_item(INPTR(a, ten ? I_CV2 : I_CK2) + (size_t)l * 256 * 64, 256, 64, (bf16*)(ws + WS_W2CT) + (size_t)ten * 64 * 256, 0, scr, 64 * kb, 0, lane); }
    }
}

__device__ __forceinline__ void phase_prologue(const Args& a, int gtid, int NGT) {
    OPQ_V(gtid);
    const f32x4* x4 = (const f32x4*)INPTR(a, I_X); u32x2* xb = (u32x2*)(a.ws + WS_XB);
    int* xl8 = (int*)(a.ws + WS_XL8);
    for (size_t i = gtid; i < (size_t)MTOK * DM / 4; i += NGT) { const f32x4 v = x4[i]; u32x2 o; o.x = pk2(v.x, v.y); o.y = pk2(v.z, v.w); xb[i] = o;
        int w = __builtin_amdgcn_cvt_pk_bf8_f32(v.x - __builtin_bit_cast(float, o.x << 16), v.y - __builtin_bit_cast(float, o.x & 0xffff0000u), 0, false);
        w = __builtin_amdgcn_cvt_pk_bf8_f32(v.z - __builtin_bit_cast(float, o.y << 16), v.w - __builtin_bit_cast(float, o.y & 0xffff0000u), w, true); xl8[i] = w; }
    f32x2* rope = (f32x2*)(a.ws + WS_ROPE);
    for (int i = gtid; i < SEQ * 8; i += NGT) { const int s = i >> 3, k = i & 7;
        const float inv = powf(500000.0f, -(float)k * 0.125f); const float ang = (float)s * inv;
        const double ad = (double)ang; const double q = __builtin_rint(ad * 0.15915494309189535); const double rr = ad - q * 6.283185307179586;
        const float rf = (float)rr; rope[i] = (f32x2){cosf(rf), sinf(rf)}; }
}

__device__ __forceinline__ void phase_ln_final(const bf16* HI, const unsigned char* LO, const float* g, const float* b, float* X, int gw, int NGW, int lane) {
    OPQ_SI(gw); OPQ_V(lane);
    f32x4 gv[8], bv[8];
#pragma unroll
    for (int j = 0; j < 8; ++j) { gv[j] = ((const f32x4*)g)[64 * j + lane]; bv[j] = ((const f32x4*)b)[64 * j + lane]; }
    u32x2 nh[8]; unsigned nl[8];
    { const size_t m0 = (size_t)(gw < MTOK ? gw : 0) * DM;
#pragma unroll
        for (int j = 0; j < 8; ++j) { nh[j] = ((const u32x2*)(HI + m0))[64 * j + lane]; nl[j] = ((const unsigned*)(LO + m0))[64 * j + lane]; } }
    for (int m = gw; m < MTOK; m += NGW) {
        f32x4 v[8]; float s = 0.f;
#pragma unroll
        for (int j = 0; j < 8; ++j) { const f32x2 l0 = __builtin_amdgcn_cvt_pk_f32_bf8((int)nl[j], false), l1 = __builtin_amdgcn_cvt_pk_f32_bf8((int)nl[j], true);
            v[j].x = __builtin_bit_cast(float, nh[j].x << 16) + l0.x; v[j].y = __builtin_bit_cast(float, nh[j].x & 0xffff0000u) + l0.y; v[j].z = __builtin_bit_cast(float, nh[j].y << 16) + l1.x; v[j].w = __builtin_bit_cast(float, nh[j].y & 0xffff0000u) + l1.y; }
        { const size_t mn = (size_t)(m + NGW < MTOK ? m + NGW : m) * DM;
#pragma unroll
            for (int j = 0; j < 8; ++j) { nh[j] = ((const u32x2*)(HI + mn))[64 * j + lane]; nl[j] = ((const unsigned*)(LO + mn))[64 * j + lane]; } }
#pragma unroll
        for (int j = 0; j < 8; ++j) s += (v[j].x + v[j].y) + (v[j].z + v[j].w);
        const float mean = wave_sum(s) * (1.f / DM); float s2 = 0.f;
#pragma unroll
        for (int j = 0; j < 8; ++j) { v[j] = v[j] - mean; s2 += (v[j].x * v[j].x + v[j].y * v[j].y) + (v[j].z * v[j].z + v[j].w * v[j].w); }
        const float rstd = 1.f / sqrtf(wave_sum(s2) * (1.f / DM) + LN_EPS);
        f32x4* xr = (f32x4*)(X + (size_t)m * DM) + lane;
#pragma unroll
        for (int j = 0; j < 8; ++j) xr[64 * j] = v[j] * rstd * gv[j] + bv[j];
    }
}
__device__ __forceinline__ void phase_ln(const float* Y, const float* g, const float* b, float* X, bf16* XB, float* stats, int gw, int NGW, int lane) {
    OPQ_SI(gw); OPQ_V(lane);
    f32x4 gv[8], bv[8];
#pragma unroll
    for (int j = 0; j < 8; ++j) { gv[j] = ((const f32x4*)g)[64 * j + lane]; bv[j] = ((const f32x4*)b)[64 * j + lane]; }
    if (gw < NWAVES) { f32x4* gd = (f32x4*)(stats + 2 * MTOK) + gw * 64 + lane; gd[0] = ((const f32x4*)g)[gw * 64 + lane]; gd[512] = ((const f32x4*)b)[gw * 64 + lane]; }
    f32x4 nx[8];
    { const f32x4* yr0 = (const f32x4*)(Y + (size_t)(gw < MTOK ? gw : 0) * DM) + lane;
#pragma unroll
        for (int j = 0; j < 8; ++j) nx[j] = yr0[64 * j]; }
    for (int m = gw; m < MTOK; m += NGW) {
        f32x4 v[8]; float s = 0.f;
#pragma unroll
        for (int j = 0; j < 8; ++j) v[j] = nx[j];
        { const int mn = m + NGW < MTOK ? m + NGW : m; const f32x4* yrn = (const f32x4*)(Y + (size_t)mn * DM) + lane;
#pragma unroll
            for (int j = 0; j < 8; ++j) nx[j] = yrn[64 * j]; }
#pragma unroll
        for (int j = 0; j < 8; ++j) s += (v[j].x + v[j].y) + (v[j].z + v[j].w);
        const float mean = wave_sum(s) * (1.f / DM); float s2 = 0.f;
#pragma unroll
        for (int j = 0; j < 8; ++j) { v[j] = v[j] - mean; s2 += (v[j].x * v[j].x + v[j].y * v[j].y) + (v[j].z * v[j].z + v[j].w * v[j].w); }
        const float rstd = 1.f / sqrtf(wave_sum(s2) * (1.f / DM) + LN_EPS);
        if (lane == 0) *(f32x2*)(stats + 2 * (size_t)m) = (f32x2){mean, rstd};
        u32x2* xb = (u32x2*)(XB + (size_t)m * DM) + lane;
        if (X) { f32x4* xr = (f32x4*)(X + (size_t)m * DM) + lane;
#pragma unroll
            for (int j = 0; j < 8; ++j) { const f32x4 o = v[j] * rstd * gv[j] + bv[j]; xr[64 * j] = o; } }
#pragma unroll
        for (int j = 0; j < 8; ++j) { const f32x4 o = v[j] * rstd * gv[j] + bv[j]; u32x2 w; w.x = pk2(o.x, o.y); w.y = pk2(o.z, o.w); xb[64 * j] = w; }
    }
}


typedef float f32x16 __attribute__((ext_vector_type(16)));
typedef short bf16x8 __attribute__((ext_vector_type(8)));
#define MFMA32(a, b, c) __builtin_amdgcn_mfma_f32_32x32x16_bf16((a), (b), (c), 0, 0, 0)
#define WSYNC() asm volatile("s_waitcnt lgkmcnt(0)" ::: "memory")
__device__ __forceinline__ void half_swap(float x, float& lo, float& hi) { float a = x, b = x; asm volatile("s_nop 1\n\tv_permlane32_swap_b32 %0, %1" : "+v"(a), "+v"(b)); lo = a; hi = b; }
__device__ __forceinline__ float half_max(float x) { float lo, hi; half_swap(x, lo, hi); return fmaxf(lo, hi); }
__device__ __forceinline__ float half_sum(float x) { float lo, hi; half_swap(x, lo, hi); return lo + hi; }
__device__ __forceinline__ float other_half(float x, int h) { float lo, hi; half_swap(x, lo, hi); return h ? lo : hi; }
__device__ __forceinline__ unsigned cvtpk(float lo, float hi) { unsigned r; asm volatile("v_cvt_pk_bf16_f32 %0, %1, %2" : "=v"(r) : "v"(lo), "v"(hi)); return r; }
__device__ __forceinline__ float half32_sum(float v) { v = row16_sum(v); float a = v, b = v; asm volatile("s_nop 1\n\tv_permlane16_swap_b32 %0, %1" : "+v"(a), "+v"(b)); return a + b; }
__device__ __forceinline__ int vt_pos(int k) { return 16 * ((k >> 2) & 1) + 8 * (k >> 4) + 4 * ((k >> 3) & 1) + (k & 3); }
__device__ __forceinline__ float fexp(float x) { return __builtin_amdgcn_exp2f(x * 1.4426950408889634f); }
__device__ __forceinline__ float fsigmoid(float x) { return __builtin_amdgcn_rcpf(1.0f + __builtin_amdgcn_exp2f(x * -1.4426950408889634f)); }
__device__ __forceinline__ float ftanh(float x) { const float xc = fminf(fmaxf(x, -15.f), 15.f); return 1.0f - 2.0f * __builtin_amdgcn_rcpf(1.0f + __builtin_amdgcn_exp2f(xc * 2.8853900817779268f)); }
__device__ __forceinline__ float fsoftplus(float z) { return z > 20.f ? z : __builtin_amdgcn_logf(1.0f + __builtin_amdgcn_exp2f(z * 1.4426950408889634f)) * 0.6931471805599453f; }

#ifndef REP_MASK
#define REP_MASK 0
#endif
#ifndef M1_PREFETCH
#define M1_PREFETCH 1
#endif
constexpr int XP = 264, ZP = 520, HP = 264;
__device__ __forceinline__ bf16x8 lds_frag(const LAS bf16* p) { return *(const LAS bf16x8*)p; }
__device__ __forceinline__ bf16x8 cvt8(const f32x4 a, const f32x4 b) { u32x4 w; w.x = cvtpk(a.x, a.y); w.y = cvtpk(a.z, a.w); w.z = cvtpk(b.x, b.y); w.w = cvtpk(b.z, b.w); return __builtin_bit_cast(bf16x8, w); }
__device__ __forceinline__ void phase_m1(const Args& a, int l, LAS unsigned char* lds, int bid, int G, int tid, int wave, int lane) {
    OPQ_SI(bid); OPQ_V(tid); OPQ_SI(wave); lane = tid & 63;
    unsigned char* ws = a.ws + opaque0(); const float* P = (const float*)(ws + WS_P);
    const int r = lane & 31, h = lane >> 5;
    const f32x2* rope = (const f32x2*)(ws + WS_ROPE);
    for (int rp1 = 0; rp1 < (((REP_MASK) >> 22) & 1 ? 2 : 1); ++rp1)
    for (int unit = bid; unit < MTOK / 64; unit += G) {
        const int t0 = unit * 64, b = t0 >> 12, s0 = t0 & (SEQ - 1);
        LAS bf16* XL = (LAS bf16*)lds;
        LAS bf16* ZL = (LAS bf16*)(lds + 64 * XP * 2);
        { const float* mu = INPTR(a, I_MU) + (size_t)l * RWC;
#pragma unroll 16
            for (int i = tid; i < 64 * 256; i += NTHR) { const int tt = i >> 8, j = i & 255, col = 2304 + j; const int m = t0 + tt;
                const float pc = P[(size_t)m * INP + col]; const float pp = (s0 + tt) > 0 ? P[(size_t)(m - 1) * INP + col] : 0.f; const float v = pc + (pp - pc) * mu[col];
                const float f = j < 64 ? ftanh(v) : (j < 128 ? v : fsigmoid(v)); XL[tt * XP + j] = (bf16)f2bf(f); }
            {
                const int ch = tid, gi = ch >> 7, win = 2 << gi; const float* pp = P + (size_t)t0 * INP + PO_POOL + ch; float sum = 0.f;
                for (int j = 1; j < win; ++j) if (s0 - j >= 0) sum += pp[-(ptrdiff_t)j * INP];
#pragma unroll 16
                for (int tt = 0; tt < 64; ++tt) { const int s = s0 + tt; const float cur = pp[(size_t)tt * INP]; sum += cur; const int cnt = (s + 1) < win ? (s + 1) : win;
                    ZL[tt * ZP + ch] = (bf16)f2bf(sum / (float)cnt - cur); if (s - win + 1 >= 0) sum -= pp[((ptrdiff_t)tt - win + 1) * INP]; } } }
        __syncthreads();
        {
            const float* mu = INPTR(a, I_MU) + (size_t)l * RWC; const float* w0 = INPTR(a, I_W0) + (size_t)l * DRW; const float* a0 = INPTR(a, I_A0) + (size_t)l * DRW;
            const float* k_k = INPTR(a, I_KK) + (size_t)l * DRW; const float* k_a = INPTR(a, I_KA) + (size_t)l * DRW; const float* r_k = INPTR(a, I_RK) + (size_t)l * DRW;
            const bf16* W2T = (const bf16*)(ws + WS_W2T); const bf16* A2T = (const bf16*)(ws + WS_A2T); const bf16* G2T = (const bf16*)(ws + WS_G2T);
            float* vKK = (float*)(ws + WS_SV); float* vWR = (float*)(ws + WS_SV + SV_STRIDE); float* vW = (float*)(ws + WS_SV + 2 * SV_STRIDE);
            float* vKM = (float*)(ws + WS_SV + 3 * SV_STRIDE); float* vBB = (float*)(ws + WS_SV + 4 * SV_STRIDE); float* vV = (float*)(ws + WS_SV + 5 * SV_STRIDE);
            float* vG = (float*)(ws + WS_G); float* SC = (float*)(ws + WS_SC);
#pragma unroll 1
            for (int jj = 0; jj < 3; ++jj) {
                const int job = wave + 8 * jj, hd = job >> 1, th = job & 1;
                f32x16 aU[2], aA[2];
#pragma unroll
                for (int t = 0; t < 2; ++t)
#pragma unroll
                    for (int i = 0; i < 16; ++i) { aU[t][i] = 0.f; aA[t][i] = 0.f; }
                const LAS bf16* xa = XL + (32 * th + r) * XP + 8 * h;
#pragma unroll
                for (int ks = 0; ks < 4; ++ks) { const bf16x8 xt = lds_frag(xa + 16 * ks), xl = lds_frag(xa + 64 + 16 * ks);
#pragma unroll
                    for (int t = 0; t < 2; ++t) { const int c = hd * 64 + 32 * t + r;
                        aU[t] = MFMA32(xt, *(const bf16x8*)(W2T + (size_t)c * 64 + 16 * ks + 8 * h), aU[t]);
                        aA[t] = MFMA32(xl, *(const bf16x8*)(A2T + (size_t)c * 64 + 16 * ks + 8 * h), aA[t]); } }
                float pmr[2], pmk[2], pmv[2], pw0[2], pa0[2], pkk[2], pka[2], prk[2];
#pragma unroll
                for (int t = 0; t < 2; ++t) { const int c = hd * 64 + 32 * t + r; pmr[t] = mu[c]; pmk[t] = mu[768 + c]; pmv[t] = mu[1536 + c]; pw0[t] = w0[c]; pa0[t] = a0[c]; pkk[t] = k_k[c]; pka[t] = k_a[c]; prk[t] = r_k[c]; }
                const int lo_p = 4 * h * INP + hd * 64 + r, lo_s = 4 * h * DRW + hd * 64 + r;
                float ld[5][12];
#define M1_LOADROW(buf, i) do { int mr_ = t0 + 32 * th + ((i) & 3) + 8 * ((i) >> 2); OPQ_SI(mr_); const bool first_ = (s0 + 32 * th + ((i) & 3) + 8 * ((i) >> 2) + 4 * h) == 0; \
        const float* pc_ = P + (size_t)mr_ * INP; const float* pp_ = pc_ - INP; _Pragma("unroll") for (int t = 0; t < 2; ++t) { const int o = lo_p + 32 * t; \
        buf[6 * t + 0] = pc_[o]; buf[6 * t + 1] = pc_[o + 768]; buf[6 * t + 2] = pc_[o + 1536]; \
        if (((i) & 3) == 0) { buf[6 * t + 3] = first_ ? 0.f : pp_[o]; buf[6 * t + 4] = first_ ? 0.f : pp_[o + 768]; buf[6 * t + 5] = first_ ? 0.f : pp_[o + 1536]; } } } while (0)
#if M1_PREFETCH
                M1_LOADROW(ld[0], 0); M1_LOADROW(ld[1], 1); M1_LOADROW(ld[2], 2);
#else
                M1_LOADROW(ld[0], 0);
#endif
#pragma unroll
                for (int i = 0; i < 16; ++i) {
#if M1_PREFETCH
                    if (i + 3 < 16) M1_LOADROW(ld[(i + 3) % 5], i + 3);
#else
                    if (i > 0) M1_LOADROW(ld[i % 5], i);
#endif
                    int mrow = t0 + 32 * th + (i & 3) + 8 * (i >> 2); OPQ_SI(mrow);
                    float rr[2], kv[2], vv[2], dec[2], av[2], kr[2], km[2];
                    float ss = 0.f, s1 = 0.f, s2 = 0.f, s3 = 0.f;
#pragma unroll
                    for (int t = 0; t < 2; ++t) { const float* L = ld[i % 5] + 6 * t; const float* Lp = (i & 3) == 0 ? L + 3 : ld[(i + 4) % 5] + 6 * t;
                        const float rc = L[0], kc = L[1], vc = L[2], rp = Lp[0], kp = Lp[1], vp = Lp[2];
                        rr[t] = rc + (rp - rc) * pmr[t]; kv[t] = kc + (kp - kc) * pmk[t]; vv[t] = vc + (vp - vc) * pmv[t];
                        const float uu = pw0[t] + aU[t][i]; const float z = -uu; const float sp = fsoftplus(z); dec[t] = fexp(-fexp(-sp - 0.5f));
                        av[t] = fsigmoid(pa0[t] + aA[t][i]);
                        kr[t] = kv[t] * pkk[t]; km[t] = kv[t] * (1.0f + (av[t] - 1.0f) * pka[t]);
                        ss += kr[t] * kr[t]; s1 += kr[t] * av[t] * rr[t]; s2 += km[t] * rr[t]; s3 += rr[t] * km[t] * prk[t]; }
                    ss = half32_sum(ss); s1 = half32_sum(s1); s2 = half32_sum(s2); s3 = half32_sum(s3);
                    const float invn = 1.0f / fmaxf(sqrtf(ss), 1e-12f);
                    const size_t ro = (size_t)mrow * DRW;
#pragma unroll
                    for (int t = 0; t < 2; ++t) { const int o = lo_s + 32 * t; const float kk = kr[t] * invn;
                        (vKK + ro)[o] = kk; (vWR + ro)[o] = dec[t] * rr[t]; (vW + ro)[o] = dec[t]; (vKM + ro)[o] = km[t]; (vBB + ro)[o] = kk * av[t]; (vV + ro)[o] = vv[t]; }
                    if (r == 0) *(f32x4*)(SC + ((size_t)mrow * 12 + hd) * 4 + 4 * h * 48) = (f32x4){s1 * invn, s2, s3, 0.f};
                    asm volatile("" ::: "memory");
                }
#undef M1_LOADROW
                { f32x16 aG[2];
#pragma unroll
                    for (int t = 0; t < 2; ++t)
#pragma unroll
                        for (int i = 0; i < 16; ++i) aG[t][i] = 0.f;
#pragma unroll
                    for (int ks = 0; ks < 8; ++ks) { const bf16x8 xg = lds_frag(xa + 128 + 16 * ks);
#pragma unroll
                        for (int t = 0; t < 2; ++t) { const int c = hd * 64 + 32 * t + r; aG[t] = MFMA32(xg, *(const bf16x8*)(G2T + (size_t)c * 128 + 16 * ks + 8 * h), aG[t]); } }
#pragma unroll
                    for (int i = 0; i < 16; ++i) { int mrow = t0 + 32 * th + (i & 3) + 8 * (i >> 2); OPQ_SI(mrow); float* gp = vG + (size_t)mrow * DRW;
#pragma unroll
                        for (int t = 0; t < 2; ++t) gp[lo_s + 32 * t] = aG[t][i]; } }
            }
        }
        {
            int lane_b = lane; OPQ_V(lane_b); const int r = lane_b & 31, h = lane_b >> 5;
            const int gi = wave >> 1, th = wave & 1; const bf16* PWT = (const bf16*)(ws + WS_PWT) + gi * 128 * 128;
            const float* pb = INPTR(a, I_PB) + (size_t)l * DPOOL + gi * 128; const float* psc = INPTR(a, I_PS) + (size_t)l * DPOOL + gi * 128; bf16* CAT = (bf16*)(ws + WS_CAT);
            f32x16 acc[4];
#pragma unroll
            for (int t = 0; t < 4; ++t)
#pragma unroll
                for (int i = 0; i < 16; ++i) acc[t][i] = 0.f;
            const LAS bf16* za = ZL + (32 * th + r) * ZP + gi * 128 + 8 * h;
#pragma unroll
            for (int ks = 0; ks < 8; ++ks) { const bf16x8 zf = lds_frag(za + 16 * ks);
#pragma unroll
                for (int t = 0; t < 4; ++t) acc[t] = MFMA32(zf, *(const bf16x8*)(PWT + (size_t)(32 * t + r) * 128 + 16 * ks + 8 * h), acc[t]); }
#pragma unroll
            for (int t = 0; t < 4; ++t) { const int d = 32 * t + r; const float bv = pb[d], sv = psc[d];
#pragma unroll
                for (int i = 0; i < 16; ++i) { const int m = t0 + 32 * th + (i & 3) + 8 * (i >> 2) + 4 * h; CAT[(size_t)m * DM + DRW + gi * 128 + d] = (bf16)f2bf((acc[t][i] + bv) * sv); } }
        }
        __syncthreads();
        {
            int tid_c = tid; OPQ_V(tid_c); const int tid = tid_c;
            bf16* QR = (bf16*)(ws + WS_QR); bf16* KS = (bf16*)(ws + WS_KS); bf16* KW = (bf16*)(ws + WS_KW); bf16* VST = (bf16*)(ws + WS_VST); bf16* VWT = (bf16*)(ws + WS_VWT);
            LAS float* T0 = (LAS float*)lds; LAS float* T1 = T0 + 64 * 193;
#pragma unroll 1
            for (int c = tid; c < 1152; c += NTHR) {
                int src; float scale = 1.f; const int d = c & 63; const bool isq = c < 768; const int cc = isq ? c : (c < 960 ? c - 768 : c - 960);
                bf16* dbase;
                if (isq) { src = PO_Q + c; dbase = QR + (size_t)t0 * 768 + c; scale = 0.125f * 1.4426950408889634f; }
                else if (c < 960) { src = PO_KS + cc; dbase = KS + ((size_t)(b * 3 + (cc >> 6)) * SEQ + s0) * 64 + (cc & 63); }
                else { src = PO_KW + cc; dbase = KW + ((size_t)(b * 3 + (cc >> 6)) * SEQ + s0) * 64 + (cc & 63); }
                const int dstep = isq ? 768 : 64; const bool rot = d < 16; const int po = d < 8 ? 8 : -8; const float sg = d < 8 ? -1.f : 1.f;
                const float* pr = P + (size_t)t0 * INP + src; const f32x2* rp = rope + s0 * 8 + (d & 7);
#pragma unroll 1
                for (int t8 = 0; t8 < 64; t8 += 16) { float v[16], pv[16]; f32x2 cs[16];
#pragma unroll
                    for (int e = 0; e < 16; ++e) { v[e] = pr[(size_t)(t8 + e) * INP]; pv[e] = pr[(size_t)(t8 + e) * INP + (rot ? po : 0)]; cs[e] = rp[(t8 + e) * 8]; }
#pragma unroll
                    for (int e = 0; e < 16; ++e) { const float o = rot ? v[e] * cs[e].x + sg * pv[e] * cs[e].y : v[e]; dbase[(size_t)(t8 + e) * dstep] = (bf16)f2bf(o * scale); } } }
            if (tid < 384) { const int c = tid; const float* pr = P + (size_t)t0 * INP + (c < 192 ? PO_VS + c : PO_VW + (c - 192)); LAS float* td = c < 192 ? T0 + c : T1 + (c - 192);
#pragma unroll 1
                for (int t8 = 0; t8 < 64; t8 += 16) { float v[16];
#pragma unroll
                    for (int e = 0; e < 16; ++e) v[e] = pr[(size_t)(t8 + e) * INP];
#pragma unroll
                    for (int e = 0; e < 16; ++e) td[(t8 + e) * 193] = v[e]; } }
            __syncthreads();
            for (int i = tid; i < 384 * 64; i += NTHR) { const int c2 = i >> 6, tok = i & 63; const int which = c2 >= 192, c = which ? c2 - 192 : c2;
                const float v = (which ? T1 : T0)[tok * 193 + c]; const int sk = s0 + tok;
                bf16* dst = (which ? VWT : VST) + (((size_t)(b * 3 + (c >> 6)) * 128 + (sk >> 5)) * 64 + (c & 63)) * 32 + vt_pos(sk & 31); *dst = (bf16)f2bf(v); }
        }
        __syncthreads();
    }
    {
        int lane_d = lane; OPQ_V(lane_d); const int r = lane_d & 31, h = lane_d >> 5;
        LAS bf16* HL = (LAS bf16*)lds;
        bf16* KC = (bf16*)(ws + WS_KC); bf16* VCT = (bf16*)(ws + WS_VCT);
        for (int rp2 = 0; rp2 < (((REP_MASK) >> 23) & 1 ? 2 : 1); ++rp2)
        for (int u = bid; u < 2 * NB * 3 * 8; u += G) {
            const int ten = u / 96, q = u - ten * 96, b = q / 24, q2 = q - b * 24, hh = q2 >> 3, nt = q2 & 7, n0 = 32 * nt;
            const bf16* W1T = (const bf16*)(ws + WS_W1T) + (size_t)ten * 256 * 2048 + (size_t)(32 * wave + r) * 2048 + 8 * h;
            const int tk0 = 16 * (n0 + r);
            const float* pa = P + ((size_t)b * SEQ + tk0) * INP + (ten ? PO_VC : PO_KC) + hh * 64 + 8 * h;
            const float* pep = INPTR(a, ten ? I_PEV : I_PEK) + (size_t)l * 2048 + 8 * h;
            f32x16 acc;
#pragma unroll
            for (int i = 0; i < 16; ++i) acc[i] = 0.f;
            f32x4 xa[2][8]; bf16x8 wb[2][4];
#define CMP_LOAD(sl, ll) do { const bool ok_ = tk0 + (ll) < SEQ; const float* pl_ = pa + (size_t)(ll) * INP; const float* pe_ = pep + 64 * (ll); _Pragma("unroll") for (int ds = 0; ds < 4; ++ds) { \
        xa[sl][2 * ds] = (ok_ ? *(const f32x4*)(pl_ + 16 * ds) : (f32x4){0.f, 0.f, 0.f, 0.f}) + *(const f32x4*)(pe_ + 16 * ds); xa[sl][2 * ds + 1] = (ok_ ? *(const f32x4*)(pl_ + 16 * ds + 4) : (f32x4){0.f, 0.f, 0.f, 0.f}) + *(const f32x4*)(pe_ + 16 * ds + 4); \
        wb[sl][ds] = *(const bf16x8*)(W1T + 64 * (ll) + 16 * ds); } } while (0)
            CMP_LOAD(0, 0);
#pragma unroll 1
            for (int ll = 0; ll < 32; ll += 2) {
                CMP_LOAD(1, ll + 1);
#pragma unroll
                for (int ds = 0; ds < 4; ++ds) acc = MFMA32(cvt8(xa[0][2 * ds], xa[0][2 * ds + 1]), wb[0][ds], acc);
                if (ll + 2 < 32) CMP_LOAD(0, ll + 2);
#pragma unroll
                for (int ds = 0; ds < 4; ++ds) acc = MFMA32(cvt8(xa[1][2 * ds], xa[1][2 * ds + 1]), wb[1][ds], acc);
            }
#undef CMP_LOAD
            {
#pragma unroll
                for (int i = 0; i < 16; ++i) { const float x = acc[i]; const float gl = 0.5f * x * (1.0f + ftanh(0.7978845608028654f * (x + 0.044715f * x * x * x)));
                    HL[((i & 3) + 8 * (i >> 2) + 4 * h) * HP + 32 * wave + r] = (bf16)f2bf(gl); } }
            __syncthreads();
            if (wave < 2) {
                const bf16* W2CT = (const bf16*)(ws + WS_W2CT) + (size_t)ten * 64 * 256 + (size_t)(32 * wave + r) * 256 + 8 * h;
                f32x16 o;
#pragma unroll
                for (int i = 0; i < 16; ++i) o[i] = 0.f;
                const LAS bf16* ha = HL + r * HP + 8 * h;
#pragma unroll
                for (int ks = 0; ks < 16; ++ks) o = MFMA32(lds_frag(ha + 16 * ks), *(const bf16x8*)(W2CT + 16 * ks), o);
                const int d = 32 * wave + r;
#pragma unroll
                for (int i = 0; i < 16; ++i) { const int n = n0 + (i & 3) + 8 * (i >> 2) + 4 * h; float v = o[i];
                    if (ten == 0) { const float other = dpp_f<0x128>(v);
                        if (wave == 0 && r < 16) { const f32x2 cs = rope[((16 * n + 31) & (SEQ - 1)) * 8 + (r & 7)]; v = r < 8 ? v * cs.x - other * cs.y : v * cs.x + other * cs.y; }
                        if (n < NCMP) KC[((size_t)(b * 3 + hh) * NCMPP + n) * 64 + d] = (bf16)f2bf(v); }
                    else if (n < NCMP) VCT[(((size_t)(b * 3 + hh) * 8 + (n >> 5)) * 64 + d) * 32 + vt_pos(n & 31)] = (bf16)f2bf(v); }
            }
            __syncthreads();
        }
    }
}

constexpr int SPX = 72;
__device__ __forceinline__ void phase_scan_prep(const Args& a, LAS unsigned char* lds, int gw, int NGW, int wave, int lane) {
    OPQ_SI(gw); OPQ_SI(wave); OPQ_V(lane);
    unsigned char* ws = a.ws + opaque0();
    LAS unsigned char* wl = lds + wave * 16384;
    LAS bf16* XA = (LAS bf16*)wl; LAS bf16* XR = XA + 16 * SPX; LAS bf16* XB_ = XR + 16 * SPX; LAS bf16* XK = XB_ + 16 * SPX;
    LAS float* GB = (LAS float*)(wl + 4 * 16 * SPX * 2); LAS float* GK = GB + 256; LAS float* HB = GK + 256; LAS float* HK = HB + 256; LAS float* NM = HK + 256;
    const int r = lane & 31, h = lane >> 5;
    const GAS float* vKK = (const GAS float*)(ws + WS_SV); const GAS float* vWR = (const GAS float*)(ws + WS_SV + SV_STRIDE); const GAS float* vW = (const GAS float*)(ws + WS_SV + 2 * SV_STRIDE);
    const GAS float* vKM = (const GAS float*)(ws + WS_SV + 3 * SV_STRIDE); const GAS float* vBB = (const GAS float*)(ws + WS_SV + 4 * SV_STRIDE); const GAS float* vV = (const GAS float*)(ws + WS_SV + 5 * SV_STRIDE);
#pragma unroll 1
    for (int item = gw; item < NB * 12 * 256; item += NGW) {
        const int hd = item >> 8, c = item & 255, b = hd / 12, hh = hd - b * 12;
        const size_t o0 = ((size_t)b * SEQ + 16 * c) * DRW + hh * 64 + lane;
        GAS unsigned char* rec = (GAS unsigned char*)(ws + WS_SPREC) + (size_t)item * SPREC_BYTES;
        float al[16], rh[16], be[16], ka[16], vv[16]; float g = 1.f;
#pragma unroll
        for (int t = 0; t < 16; ++t) { const size_t o = o0 + (size_t)t * DRW; const float w = vW[o], kk = vKK[o], bb = vBB[o], km = vKM[o], wr = vWR[o]; vv[t] = vV[o];
            al[t] = g * kk; rh[t] = g * wr; g *= w; const float ig = 1.0f / g; be[t] = bb * ig; ka[t] = km * ig; }
#pragma unroll
        for (int t = 0; t < 16; ++t) { XA[t * SPX + lane] = (bf16)f2bf(al[t]); XR[t * SPX + lane] = (bf16)f2bf(rh[t]); XB_[t * SPX + lane] = (bf16)f2bf(be[t]); XK[t * SPX + lane] = (bf16)f2bf(ka[t]); }
#pragma unroll
        for (int hp = 0; hp < 2; ++hp) {
            u32x4 wb, wk, wv;
            wb.x = cvtpk(be[4 * hp + 0], be[4 * hp + 1]); wb.y = cvtpk(be[4 * hp + 2], be[4 * hp + 3]); wb.z = cvtpk(be[8 + 4 * hp + 0], be[8 + 4 * hp + 1]); wb.w = cvtpk(be[8 + 4 * hp + 2], be[8 + 4 * hp + 3]);
            wk.x = cvtpk(ka[4 * hp + 0], ka[4 * hp + 1]); wk.y = cvtpk(ka[4 * hp + 2], ka[4 * hp + 3]); wk.z = cvtpk(ka[8 + 4 * hp + 0], ka[8 + 4 * hp + 1]); wk.w = cvtpk(ka[8 + 4 * hp + 2], ka[8 + 4 * hp + 3]);
            wv.x = cvtpk(vv[4 * hp + 0], vv[4 * hp + 1]); wv.y = cvtpk(vv[4 * hp + 2], vv[4 * hp + 3]); wv.z = cvtpk(vv[8 + 4 * hp + 0], vv[8 + 4 * hp + 1]); wv.w = cvtpk(vv[8 + 4 * hp + 2], vv[8 + 4 * hp + 3]);
            *(GAS u32x4*)(rec + 4096 + ((h * 2 + hp) * 32 + r) * 16) = wb; *(GAS u32x4*)(rec + 6144 + ((h * 2 + hp) * 32 + r) * 16) = wk;
            *(GAS u32x4*)(rec + 9216 + h * 3072 + 2048 + (hp * 32 + r) * 16) = wv; }
        *(GAS float*)(rec + 8704 + ((h * 2 + ((r >> 2) & 1)) * 16 + (r & 3) + 4 * (r >> 3)) * 4) = g;
        WSYNC();
        const bool lo16 = r < 16; const bf16x8 zf = {0, 0, 0, 0, 0, 0, 0, 0};
#define SP_GRAM(X1, X2, OUT, INCL) do { f32x16 D; _Pragma("unroll") for (int i = 0; i < 16; ++i) D[i] = 0.f; \
            _Pragma("unroll") for (int ks = 0; ks < 4; ++ks) { const bf16x8 fa = lo16 ? *(const LAS bf16x8*)(X1 + r * SPX + 16 * ks + 8 * h) : zf, fb = lo16 ? *(const LAS bf16x8*)(X2 + r * SPX + 16 * ks + 8 * h) : zf; D = MFMA32(fa, fb, D); } \
            if (lo16) { _Pragma("unroll") for (int i = 0; i < 8; ++i) { const int t = (i & 3) + 8 * (i >> 2) + 4 * h; OUT[t * 16 + r] = (INCL ? r <= t : r < t) ? D[i] : 0.f; } } } while (0)
        SP_GRAM(XA, XB_, GB, false); SP_GRAM(XA, XK, GK, false); SP_GRAM(XR, XB_, HB, true); SP_GRAM(XR, XK, HK, true);
#undef SP_GRAM
        WSYNC();
        { const int cc = lane & 15; float n[16];
#pragma unroll
            for (int t = 0; t < 16; ++t) { float acc = t == cc ? 1.f : 0.f;
#pragma unroll
                for (int s2 = 0; s2 < t; ++s2) acc -= GB[t * 16 + s2] * n[s2];
                n[t] = acc; }
            if (lane < 16) {
#pragma unroll
                for (int t = 0; t < 16; ++t) NM[t * 16 + cc] = n[t]; } }
        if (lo16) { u32x4 w_; const LAS float* hr = HB + r * 16 + 4 * h;
            w_.x = cvtpk(hr[0], hr[1]); w_.y = cvtpk(hr[2], hr[3]); w_.z = cvtpk(hr[8], hr[9]); w_.w = cvtpk(hr[10], hr[11]); *(GAS u32x4*)(rec + 8192 + (h * 16 + r) * 16) = w_; }
        WSYNC();
        { float ap[16];
#pragma unroll
            for (int t = 0; t < 16; ++t) { float acc = 0.f;
#pragma unroll
                for (int s2 = 0; s2 <= t; ++s2) acc = fmaf(NM[t * 16 + s2], al[s2], acc);
                ap[t] = acc; }
#pragma unroll
            for (int t = 0; t < 16; ++t) XA[t * SPX + lane] = (bf16)f2bf(ap[t]); }
        WSYNC();
        if (lo16) {
#pragma unroll
            for (int ks = 0; ks < 4; ++ks) { const LAS bf16* pa = XA + r * SPX + 16 * ks + 4 * h; const LAS bf16* pr = XR + r * SPX + 16 * ks + 4 * h;
                const u32x2 a0 = *(const LAS u32x2*)pa, a1 = *(const LAS u32x2*)(pa + 8), r0 = *(const LAS u32x2*)pr, r1 = *(const LAS u32x2*)(pr + 8);
                *(GAS u32x4*)(rec + ((ks * 2 + h) * 16 + r) * 16) = (u32x4){a0.x, a0.y, a1.x, a1.y}; *(GAS u32x4*)(rec + 2048 + ((ks * 2 + h) * 16 + r) * 16) = (u32x4){r0.x, r0.y, r1.x, r1.y}; } }
        { float wq[16], p1[16], yk[16];
#pragma unroll
            for (int t = 0; t < 16; ++t) { float acc = 0.f, acy = 0.f;
#pragma unroll
                for (int s2 = 0; s2 <= t; ++s2) { if (s2 < t) acc = fmaf(GK[t * 16 + s2], vv[s2], acc); acy = fmaf(HK[t * 16 + s2], vv[s2], acy); }
                wq[t] = acc; yk[t] = acy; }
#pragma unroll
            for (int t = 0; t < 16; ++t) { float acc = 0.f;
#pragma unroll
                for (int s2 = 0; s2 <= t; ++s2) acc = fmaf(NM[t * 16 + s2], wq[s2], acc);
                p1[t] = acc; }
            GAS unsigned char* rv = rec + 9216 + h * 3072;
#pragma unroll
            for (int hq = 0; hq < 2; ++hq) { u32x4 wp, wy;
                wp.x = cvtpk(p1[4 * hq + 0], p1[4 * hq + 1]); wp.y = cvtpk(p1[4 * hq + 2], p1[4 * hq + 3]); wp.z = cvtpk(p1[8 + 4 * hq + 0], p1[8 + 4 * hq + 1]); wp.w = cvtpk(p1[8 + 4 * hq + 2], p1[8 + 4 * hq + 3]);
                wy.x = cvtpk(yk[4 * hq + 0], yk[4 * hq + 1]); wy.y = cvtpk(yk[4 * hq + 2], yk[4 * hq + 3]); wy.z = cvtpk(yk[8 + 4 * hq + 0], yk[8 + 4 * hq + 1]); wy.w = cvtpk(yk[8 + 4 * hq + 2], yk[8 + 4 * hq + 3]);
                *(GAS u32x4*)(rv + (hq * 32 + r) * 16) = wp; *(GAS u32x4*)(rv + 1024 + (hq * 32 + r) * 16) = wy; } }
        WSYNC();
    }
}
__device__ __forceinline__ void scan_seq(const Args& a, LAS unsigned char* lds, int grp, int lane) {
    OPQ_SI(grp); OPQ_V(lane);
    __builtin_amdgcn_s_setprio(3);
    unsigned char* ws = a.ws + opaque0();
    const int hd = grp % 48, vt = grp / 48, b = hd / 12, hh = hd - b * 12;
    const int r = lane & 31, h = lane >> 5; const bool lo16 = r < 16;
    LAS unsigned char* RS = lds + 16384;
    const GAS unsigned char* recs = (const GAS unsigned char*)(ws + WS_SPREC) + (size_t)hd * 256 * SPREC_BYTES;
    GAS float* yp = (GAS float*)(ws + WS_YS) + (size_t)b * SEQ * DRW + hh * 64 + 32 * vt + r;
    const bf16x8 zf = {0, 0, 0, 0, 0, 0, 0, 0};
    f32x16 T0, T1;
#pragma unroll
    for (int i = 0; i < 16; ++i) { T0[i] = 0.f; T1[i] = 0.f; }
#define SQ_DMA(slot, ck) do { const GAS unsigned char* rp_ = recs + (size_t)(ck) * SPREC_BYTES + lane * 16; LAS unsigned char* ls_ = RS + (slot) * 12288; \
        _Pragma("unroll") for (int q = 0; q < 9; ++q) __builtin_amdgcn_global_load_lds((const unsigned*)(rp_ + 1024 * q), (LAS unsigned*)(ls_ + 1024 * q), 16, 0, 0); \
        _Pragma("unroll") for (int q = 0; q < 3; ++q) __builtin_amdgcn_global_load_lds((const unsigned*)(rp_ + 9216 + 3072 * vt + 1024 * q), (LAS unsigned*)(ls_ + 9216 + 1024 * q), 16, 0, 0); } while (0)
    SQ_DMA(0, 0); SQ_DMA(1, 1);
#pragma unroll 1
    for (int ck = 0; ck < 256; ++ck) {
        const LAS unsigned char* L = RS + (ck & 1) * 12288;
        if (ck == 0) asm volatile("s_waitcnt vmcnt(12)" ::: "memory"); else if (ck + 1 < 256) asm volatile("s_waitcnt vmcnt(20)" ::: "memory"); else asm volatile("s_waitcnt vmcnt(0)" ::: "memory");
        bf16x8 tb[4];
#pragma unroll
        for (int s2 = 0; s2 < 2; ++s2) { u32x4 w0, w1;
            w0.x = cvtpk(T0[8 * s2], T0[8 * s2 + 1]); w0.y = cvtpk(T0[8 * s2 + 2], T0[8 * s2 + 3]); w0.z = cvtpk(T0[8 * s2 + 4], T0[8 * s2 + 5]); w0.w = cvtpk(T0[8 * s2 + 6], T0[8 * s2 + 7]);
            w1.x = cvtpk(T1[8 * s2], T1[8 * s2 + 1]); w1.y = cvtpk(T1[8 * s2 + 2], T1[8 * s2 + 3]); w1.z = cvtpk(T1[8 * s2 + 4], T1[8 * s2 + 5]); w1.w = cvtpk(T1[8 * s2 + 6], T1[8 * s2 + 7]);
            tb[s2] = __builtin_bit_cast(bf16x8, w0); tb[2 + s2] = __builtin_bit_cast(bf16x8, w1); }
        f32x16 aU, aY;
#pragma unroll
        for (int i = 0; i < 16; ++i) { aU[i] = 0.f; aY[i] = 0.f; }
        { const u32x4 yk = *(const LAS u32x4*)(L + 9216 + 1024 + lane * 16);
            aY[0] = __builtin_bit_cast(float, yk.x << 16); aY[1] = __builtin_bit_cast(float, yk.x & 0xffff0000u); aY[2] = __builtin_bit_cast(float, yk.y << 16); aY[3] = __builtin_bit_cast(float, yk.y & 0xffff0000u);
            aY[4] = __builtin_bit_cast(float, yk.z << 16); aY[5] = __builtin_bit_cast(float, yk.z & 0xffff0000u); aY[6] = __builtin_bit_cast(float, yk.w << 16); aY[7] = __builtin_bit_cast(float, yk.w & 0xffff0000u); }
#pragma unroll
        for (int ks = 0; ks < 4; ++ks) { const bf16x8 fa = lo16 ? *(const LAS bf16x8*)(L + ((ks * 2 + h) * 16 + r) * 16) : zf, fr = lo16 ? *(const LAS bf16x8*)(L + 2048 + ((ks * 2 + h) * 16 + r) * 16) : zf;
            aU = MFMA32(fa, tb[ks], aU); aY = MFMA32(fr, tb[ks], aY); }
        bf16x8 ub;
        { const u32x4 p1 = *(const LAS u32x4*)(L + 9216 + lane * 16); float u[8];
            u[0] = -aU[0] - __builtin_bit_cast(float, p1.x << 16); u[1] = -aU[1] - __builtin_bit_cast(float, p1.x & 0xffff0000u); u[2] = -aU[2] - __builtin_bit_cast(float, p1.y << 16); u[3] = -aU[3] - __builtin_bit_cast(float, p1.y & 0xffff0000u);
            u[4] = -aU[4] - __builtin_bit_cast(float, p1.z << 16); u[5] = -aU[5] - __builtin_bit_cast(float, p1.z & 0xffff0000u); u[6] = -aU[6] - __builtin_bit_cast(float, p1.w << 16); u[7] = -aU[7] - __builtin_bit_cast(float, p1.w & 0xffff0000u);
            u32x4 w_; w_.x = cvtpk(u[0], u[1]); w_.y = cvtpk(u[2], u[3]); w_.z = cvtpk(u[4], u[5]); w_.w = cvtpk(u[6], u[7]); ub = __builtin_bit_cast(bf16x8, w_); }
        { const bf16x8 fh = lo16 ? *(const LAS bf16x8*)(L + 8192 + (h * 16 + r) * 16) : zf; aY = MFMA32(fh, ub, aY); }
        { const bf16x8 fv = *(const LAS bf16x8*)(L + 9216 + 2048 + lane * 16);
            const bf16x8 b0 = *(const LAS bf16x8*)(L + 4096 + lane * 16), b1 = *(const LAS bf16x8*)(L + 4096 + 1024 + lane * 16), k0 = *(const LAS bf16x8*)(L + 6144 + lane * 16), k1 = *(const LAS bf16x8*)(L + 6144 + 1024 + lane * 16);
            T0 = MFMA32(b0, ub, T0); T1 = MFMA32(b1, ub, T1); T0 = MFMA32(k0, fv, T0); T1 = MFMA32(k1, fv, T1);
#pragma unroll
            for (int q = 0; q < 4; ++q) { const f32x4 g0 = *(const LAS f32x4*)(L + 8704 + (h * 16 + 4 * q) * 4), g1 = *(const LAS f32x4*)(L + 8704 + ((2 + h) * 16 + 4 * q) * 4);
                T0[4 * q] *= g0.x; T0[4 * q + 1] *= g0.y; T0[4 * q + 2] *= g0.z; T0[4 * q + 3] *= g0.w; T1[4 * q] *= g1.x; T1[4 * q + 1] *= g1.y; T1[4 * q + 2] *= g1.z; T1[4 * q + 3] *= g1.w; } }
#pragma unroll
        for (int i = 0; i < 8; ++i) yp[((size_t)ck * 16 + (i & 3) + 8 * (i >> 2) + 4 * h) * DRW] = aY[i];
        asm volatile("s_waitcnt lgkmcnt(0)" ::: "memory");
        if (ck + 2 < 256) SQ_DMA(ck & 1, ck + 2);
    }
#undef SQ_DMA
    asm volatile("s_waitcnt vmcnt(0)" ::: "memory");
    __builtin_amdgcn_s_setprio(0);
}

template <bool WITH_V> __device__ __forceinline__ void dma_tile(LAS unsigned char* RW, const bf16* Kb, int key0, unsigned koff, const bf16* Vt, unsigned voff) {
    const char* kp = (const char*)(Kb + (size_t)key0 * 64) + koff;
#pragma unroll
    for (int q = 0; q < 4; ++q) __builtin_amdgcn_global_load_lds((const unsigned*)(kp + 1024 * q), (LAS unsigned*)(RW + q * 1024), 16, 0, 0);
    if (WITH_V) { const char* vp = (const char*)(Vt + (size_t)(key0 >> 5) * 2048) + voff;
#pragma unroll
        for (int q = 0; q < 4; ++q) __builtin_amdgcn_global_load_lds((const unsigned*)(vp + 1024 * q), (LAS unsigned*)(RW + (4 + q) * 1024), 16, 0, 0); }
}
template <bool WITH_V> __device__ __forceinline__ void read_tile(const LAS unsigned char* RW, unsigned krd, unsigned vrd, bf16x8 (&kf)[4], bf16x8 (&vf)[2][2], bool younger) {
    if (younger) { if (WITH_V) asm volatile("s_waitcnt vmcnt(8)" ::: "memory"); else asm volatile("s_waitcnt vmcnt(4)" ::: "memory"); } else asm volatile("s_waitcnt vmcnt(0)" ::: "memory");
    const int rk = (krd >> 7) & 7, hh = krd & 1;
#pragma unroll
    for (int ks = 0; ks < 4; ++ks) kf[ks] = *(const LAS bf16x8*)(RW + (krd & ~1u) + (((2 * ks + hh) ^ rk) << 4));
    if (WITH_V) {
#pragma unroll
        for (int q = 0; q < 4; ++q) { const int dt = q >> 1, s = q & 1; const unsigned row = (vrd >> 6) + 32 * dt; vf[dt][s] = *(const LAS bf16x8*)(RW + 4096 + row * 64 + ((((2 * hh + s)) ^ ((row >> 2) & 3)) << 4)); } }
    asm volatile("s_waitcnt lgkmcnt(0)" ::: "memory");
}
__device__ __forceinline__ f32x16 qk_tile(const bf16x8 (&kf)[4], const bf16x8 (&qf)[4]) {
    f32x16 S;
#pragma unroll
    for (int i = 0; i < 16; ++i) S[i] = 0.f;
#pragma unroll
    for (int ks = 0; ks < 4; ++ks) S = MFMA32(kf[ks], qf[ks], S);
    return S;
}
__device__ __forceinline__ void pv_tile(const float (&p)[16], const bf16x8 (&vf)[2][2], f32x16 (&O)[2]) {
#pragma unroll
    for (int s = 0; s < 2; ++s) { u32x4 w; w.x = cvtpk(p[8 * s], p[8 * s + 1]); w.y = cvtpk(p[8 * s + 2], p[8 * s + 3]); w.z = cvtpk(p[8 * s + 4], p[8 * s + 5]); w.w = cvtpk(p[8 * s + 6], p[8 * s + 7]);
        const bf16x8 pf = __builtin_bit_cast(bf16x8, w);
#pragma unroll
        for (int dt = 0; dt < 2; ++dt) O[dt] = MFMA32(vf[dt][s], pf, O[dt]); }
}
__device__ __forceinline__ void att_rest(f32x16& S, const bf16x8 (&vf)[2][2], int key0, int h, bool masked, int klo, int khi, bool colsel, float& m, float& l, f32x16 (&O)[2]) {
    if (masked) { const int kb = key0 + 4 * h;
#pragma unroll
        for (int i = 0; i < 16; ++i) { const int key = kb + (i & 3) + 8 * (i >> 2); S[i] = (key <= khi && key >= klo) ? S[i] : -INFINITY; } }
    float tmax = fmaxf(fmaxf(fmaxf(S[0], S[1]), fmaxf(S[2], S[3])), fmaxf(fmaxf(S[4], S[5]), fmaxf(S[6], S[7])));
    tmax = fmaxf(tmax, fmaxf(fmaxf(fmaxf(S[8], S[9]), fmaxf(S[10], S[11])), fmaxf(fmaxf(S[12], S[13]), fmaxf(S[14], S[15]))));
    tmax = half_max(tmax); tmax = colsel ? tmax : -INFINITY;
    if (__builtin_amdgcn_ballot_w64(tmax > m + 8.0f) != 0ull) {
        const float mn = fmaxf(m, tmax); const float ms = mn == -INFINITY ? 0.f : mn; const float alpha = __builtin_amdgcn_exp2f(m - ms);
        l *= alpha; m = mn;
#pragma unroll
        for (int dt = 0; dt < 2; ++dt)
#pragma unroll
            for (int i = 0; i < 16; ++i) O[dt][i] *= alpha;
    }
    float msx = m == -INFINITY ? 0.f : m; msx = colsel ? msx : INFINITY;
    float p[16]; float ps = 0.f;
#pragma unroll
    for (int i = 0; i < 16; ++i) { p[i] = __builtin_amdgcn_exp2f(S[i] - msx); ps += p[i]; }
    l += half_sum(ps);
    pv_tile(p, vf, O);
}
constexpr int NSA_RING0 = 16384;
static_assert(NSA_RING0 + 8 * 16384 <= LDS_SCRATCH, "attention LDS map");
__device__ __forceinline__ void phase_nsa(const Args& a, int qi, int l, LAS unsigned char* lds, int slot, int lane) {
    OPQ_SI(slot); OPQ_V(lane);
    unsigned char* ws = a.ws + opaque0();
    LAS float* impl = (LAS float*)(lds + slot * 2048);
    LAS unsigned char* RW = lds + NSA_RING0 + slot * 16384;
    const bf16* QR = (const bf16*)(ws + WS_QR); const float* P = (const float*)(ws + WS_P); const float* gate_b = INPTR(a, I_GB) + (size_t)l * 36; bf16* CAT = (bf16*)(ws + WS_CAT);
    unsigned* qctr = (unsigned*)(ws + WS_CTL) + 8192 + 64 * qi;
    const int r = lane & 31, h = lane >> 5, g = r & 3, ql = r >> 2;
    const unsigned koff = (unsigned)((lane >> 3) * 128 + (((lane & 7) ^ ((lane >> 3) & 7)) << 4)), voff = (unsigned)((lane >> 2) * 64 + (((lane & 3) ^ (((lane >> 2) >> 2) & 3)) << 4));
    const unsigned krd = (unsigned)(r * 128) | (unsigned)h, vrd = (unsigned)(r * 64);
    const int myx = (int)(xb_xcc_id() & 7u); int qsel = 0;
    for (;;) {
        int item = 0, qx = 0;
        for (;;) { qx = (myx + qsel) & 7; if (lane == 0) item = (int)atomicAdd(qctr + 8 * qx, 1u); item = __builtin_amdgcn_readfirstlane(item); if (item < 96 * 8 || qsel >= 7) break; ++qsel; }
        if (item >= 96 * 8) break;
        const int up = item >> 3, wave = item & 7, k3 = up / 3, e3 = up - 3 * k3;
        const int bk = e3 < 2 ? qx : 8 + (qx >> 1); const int qt = e3 == 0 ? 63 - 2 * k3 : (e3 == 1 ? 62 - 2 * k3 : 62 - 2 * k3 + (qx & 1));
        const int b = bk / 3, kvh = bk - b * 3;
        const int tile0 = qt * 64, cur = qt; const int qp = tile0 + 8 * wave + ql; const size_t mq = (size_t)b * SEQ + qp; const int head = kvh * 4 + g;
        bf16x8 qf[4];
#pragma unroll
        for (int ks = 0; ks < 4; ++ks) qf[ks] = *(const bf16x8*)(QR + mq * 768 + head * 64 + 16 * ks + 8 * h);
        float g0, g1, g2;
        { const float* gl = P + mq * INP + PO_GL + head * 3; const float* gb = gate_b + head * 3; g0 = sigmoidf_(gl[0] + gb[0]); g1 = sigmoidf_(gl[1] + gb[1]); g2 = sigmoidf_(gl[2] + gb[2]); }
        f32x16 out[2], O[2]; bf16x8 kf[4]; bf16x8 vf[2][2];
#pragma unroll
        for (int dt = 0; dt < 2; ++dt)
#pragma unroll
            for (int i = 0; i < 16; ++i) out[dt][i] = 0.f;
        unsigned long long mymask = (2ull << cur) - 1ull, umask = mymask;
        const int qpw = tile0 + 8 * wave + 7;
        {
            const bf16* Kb = (const bf16*)(ws + WS_KC) + (size_t)(b * 3 + kvh) * NCMPP * 64; const bf16* Vt = (const bf16*)(ws + WS_VCT) + (size_t)(b * 3 + kvh) * 8 * 2048;
            const int nvw = qpw >= 31 ? ((qpw - 31) >> 4) + 1 : 0; const int nvq = qp >= 31 ? ((qp - 31) >> 4) + 1 : 0; const int ntile = (nvw + 31) >> 5;
            const bool need_imp = cur >= 16;
            if (ntile > 0) {
                float m = -INFINITY, ls = 0.f;
                dma_tile<false>(RW, Kb, 0, koff, Vt, voff);
#pragma unroll 1
                for (int kt = 0; kt < ntile; ++kt) { read_tile<false>(RW, krd, vrd, kf, vf, false); if (kt + 1 < ntile) dma_tile<false>(RW, Kb, 32 * (kt + 1), koff, Vt, voff); else dma_tile<true>(RW, Kb, 0, koff, Vt, voff);
                    const f32x16 S = qk_tile(kf, qf);
                    float tmax = -INFINITY; float sv[16];
#pragma unroll
                    for (int i = 0; i < 16; ++i) { const int n = 32 * kt + (i & 3) + 8 * (i >> 2) + 4 * h; sv[i] = n < nvq ? S[i] : -INFINITY; tmax = fmaxf(tmax, sv[i]); }
                    tmax = half_max(tmax); const float mn = fmaxf(m, tmax); const float ms = mn == -INFINITY ? 0.f : mn; float ps = 0.f;
#pragma unroll
                    for (int i = 0; i < 16; ++i) ps += __builtin_amdgcn_exp2f(sv[i] - ms);
                    ls = ls * __builtin_amdgcn_exp2f(m - ms) + half_sum(ps); m = mn; }
                const float ms = m == -INFINITY ? 0.f : m; const float inv = 1.0f / fmaxf(ls, 1.17549435e-38f);
                float carry = 0.f;
#pragma unroll
                for (int dt = 0; dt < 2; ++dt)
#pragma unroll
                    for (int i = 0; i < 16; ++i) O[dt][i] = 0.f;
                if (need_imp) {
#pragma unroll
                    for (int i = 0; i < 8; ++i) impl[i * 64 + lane] = 0.f;
                    WSYNC(); }
#pragma unroll 1
                for (int kt = 0; kt < ntile; ++kt) {
                    read_tile<true>(RW, krd, vrd, kf, vf, false); if (kt + 1 < ntile) dma_tile<true>(RW, Kb, 32 * (kt + 1), koff, Vt, voff);
                    const f32x16 S = qk_tile(kf, qf);
                    float p[16];
#pragma unroll
                    for (int i = 0; i < 16; ++i) { const int n = 32 * kt + (i & 3) + 8 * (i >> 2) + 4 * h; p[i] = n < nvq ? __builtin_amdgcn_exp2f(S[i] - ms) * inv : 0.f; }
                    if (need_imp) {
                        float val[4];
#pragma unroll
                        for (int t = 0; t < 4; ++t) { const float sp = 0.5f * p[4 * t + 3]; const float base = (p[4 * t] + p[4 * t + 1]) + (p[4 * t + 2] + sp); const float rv = other_half(sp, h);
                            val[t] = base + (h ? rv : carry); carry = h ? 0.f : rv; }
#pragma unroll
                        for (int t = 0; t < 4; ++t) { float v = val[t]; v += dpp_f<0xB1>(v); v += dpp_f<0x4E>(v); if (g == 0) impl[ql * 64 + 8 * kt + 2 * t + h] = v; }
                    }
                    pv_tile(p, vf, O);
                }
#pragma unroll
                for (int dt = 0; dt < 2; ++dt)
#pragma unroll
                    for (int i = 0; i < 16; ++i) out[dt][i] = O[dt][i] * g0;
                if (need_imp) {
                    WSYNC();
#pragma unroll 1
                    for (int q = 0; q < 8; ++q) { const float v = impl[q * 64 + lane]; const bool forced = lane == 0 || lane == cur || lane == cur - 1; impl[q * 64 + lane] = lane > cur ? -INFINITY : (forced ? 1e9f : v); }
                    WSYNC();
                    umask = 0ull;
#pragma unroll 1
                    for (int q = 0; q < 8; ++q) { const float sc = impl[q * 64 + lane]; int rank = 0;
#pragma unroll 4
                        for (int i4 = 0; i4 < 16; ++i4) { const f32x4 o = *(const LAS f32x4*)(impl + q * 64 + 4 * i4);
                            rank += (o.x > sc || (o.x == sc && 4 * i4 + 0 < lane)) ? 1 : 0; rank += (o.y > sc || (o.y == sc && 4 * i4 + 1 < lane)) ? 1 : 0;
                            rank += (o.z > sc || (o.z == sc && 4 * i4 + 2 < lane)) ? 1 : 0; rank += (o.w > sc || (o.w == sc && 4 * i4 + 3 < lane)) ? 1 : 0; }
                        const unsigned long long mk = __ballot(lane <= cur && rank < 16);
                        umask |= mk; if (ql == q) mymask = mk; }
                    WSYNC();
                }
            }
        }
        {
            const bf16* Kb = (const bf16*)(ws + WS_KS) + (size_t)(b * 3 + kvh) * SEQ * 64; const bf16* Vt = (const bf16*)(ws + WS_VST) + (size_t)(b * 3 + kvh) * 128 * 2048;
            float m = -INFINITY, ls = 0.f;
#pragma unroll
            for (int dt = 0; dt < 2; ++dt)
#pragma unroll
                for (int i = 0; i < 16; ++i) O[dt][i] = 0.f;
            unsigned long long um = umask; int hf = 0;
#define SEL_NEXT(have, jb, key0) do { have = um != 0ull; if (have) { jb = __builtin_ctzll(um); key0 = 64 * jb + 32 * hf; if (hf == 0 && 64 * jb + 32 <= qpw) hf = 1; else { hf = 0; um &= um - 1ull; } } } while (0)
            bool h0, h1; int j0 = 0, k0 = 0, j1 = 0, k1 = 0, sl = 0;
            SEL_NEXT(h0, j0, k0); if (h0) dma_tile<true>(RW, Kb, k0, koff, Vt, voff);
            SEL_NEXT(h1, j1, k1); if (h1) dma_tile<true>(RW + 8192, Kb, k1, koff, Vt, voff);
#pragma unroll 1
            while (h0) {
                read_tile<true>(RW + sl * 8192, krd, vrd, kf, vf, h1);
                bool h2; int j2 = 0, k2 = 0; SEL_NEXT(h2, j2, k2); if (h2) dma_tile<true>(RW + sl * 8192, Kb, k2, koff, Vt, voff);
                f32x16 S = qk_tile(kf, qf);
                att_rest(S, vf, k0, h, j0 == cur, -0x7fffffff, qp, (mymask >> j0) & 1ull, m, ls, O);
                h0 = h1; j0 = j1; k0 = k1; h1 = h2; j1 = j2; k1 = k2; sl ^= 1;
            }
#undef SEL_NEXT
            const float sc = g1 / fmaxf(ls, 1.17549435e-38f);
#pragma unroll
            for (int dt = 0; dt < 2; ++dt)
#pragma unroll
                for (int i = 0; i < 16; ++i) out[dt][i] += O[dt][i] * sc;
        }
        {
            const bf16* Kb = (const bf16*)(ws + WS_KW) + (size_t)(b * 3 + kvh) * SEQ * 64; const bf16* Vt = (const bf16*)(ws + WS_VWT) + (size_t)(b * 3 + kvh) * 128 * 2048;
            float m = -INFINITY, ls = 0.f;
#pragma unroll
            for (int dt = 0; dt < 2; ++dt)
#pragma unroll
                for (int i = 0; i < 16; ++i) O[dt][i] = 0.f;
            const int q0w = tile0 + 8 * wave; const int lo = q0w - 511 > 0 ? q0w - 511 : 0;
            const int tEnd = (q0w + 7) >> 5; int t = lo >> 5;
            dma_tile<true>(RW, Kb, 32 * t, koff, Vt, voff); if (t + 1 <= tEnd) dma_tile<true>(RW + 8192, Kb, 32 * (t + 1), koff, Vt, voff);
            int sl = 0;
#pragma unroll 1
            for (; t <= tEnd; ++t) {
                read_tile<true>(RW + sl * 8192, krd, vrd, kf, vf, t + 1 <= tEnd);
                if (t + 2 <= tEnd) dma_tile<true>(RW + sl * 8192, Kb, 32 * (t + 2), koff, Vt, voff);
                f32x16 S = qk_tile(kf, qf);
                att_rest(S, vf, 32 * t, h, !(32 * t >= q0w + 7 - 511 && 32 * t + 31 <= q0w), qp - 511, qp, true, m, ls, O);
                sl ^= 1;
            }
            const float sc = g2 / fmaxf(ls, 1.17549435e-38f);
            bf16* op = CAT + mq * DM + DRW + DPOOL + head * 64 + 4 * h;
#pragma unroll
            for (int dt = 0; dt < 2; ++dt)
#pragma unroll
                for (int t2 = 0; t2 < 4; ++t2) { u32x2 w; w.x = cvtpk(out[dt][4 * t2] + O[dt][4 * t2] * sc, out[dt][4 * t2 + 1] + O[dt][4 * t2 + 1] * sc); w.y = cvtpk(out[dt][4 * t2 + 2] + O[dt][4 * t2 + 2] * sc, out[dt][4 * t2 + 3] + O[dt][4 * t2 + 3] * sc);
                    *(u32x2*)(op + 32 * dt + 8 * t2) = w; }
        }
    }
}

__device__ __forceinline__ void phase_rwkv_out(const Args& a, int l, int gw, int NGW, int lane) {
    OPQ_SI(gw); OPQ_V(lane);
    unsigned char* ws = a.ws + opaque0(); const float* YS = (const float*)(ws + WS_YS); const float* vV = (const float*)(ws + WS_SV + 5 * SV_STRIDE); const float* vG = (const float*)(ws + WS_G); const float* SC = (const float*)(ws + WS_SC);
    const float* gng = INPTR(a, I_GNG) + (size_t)l * DRW; const float* gnb = INPTR(a, I_GNB) + (size_t)l * DRW; bf16* CAT = (bf16*)(ws + WS_CAT);
    for (int id0 = gw * 4; id0 < MTOK * 12; id0 += NGW * 4) {
        float y[4], vv[4], gg[4], bc[4]; int cc[4], mm[4]; size_t oo[4];
#pragma unroll
        for (int e = 0; e < 4; ++e) { const int id = id0 + e, m = id / 12, h = id - m * 12; cc[e] = h * 64 + lane; mm[e] = m; oo[e] = (size_t)m * DRW + cc[e]; y[e] = YS[oo[e]]; vv[e] = vV[oo[e]]; gg[e] = vG[oo[e]]; bc[e] = SC[((size_t)m * 12 + h) * 4 + 2]; }
#pragma unroll
        for (int e = 0; e < 4; ++e) { const float mean = wave_sum(y[e]) * (1.f / 64.f); const float d = y[e] - mean; const float var = wave_sum(d * d) * (1.f / 64.f);
            const float yn = d * (1.f / sqrtf(var + GN_EPS)) * gng[cc[e]] + gnb[cc[e]];
            CAT[(size_t)mm[e] * DM + cc[e]] = (bf16)f2bf((yn + bc[e] * vv[e]) * gg[e]); } }
}

#ifndef PROBE_MODE
#define PROBE_MODE 0
#endif
template <int PHMASK> __global__ void __launch_bounds__(NTHR, 2) fwd(Args args) {
    extern __shared__ __attribute__((aligned(16))) unsigned char lds_raw[];
    LAS unsigned char* lds = (LAS unsigned char*)lds_raw;
    const int tid = threadIdx.x, lane = tid & 63, wave = __builtin_amdgcn_readfirstlane(tid >> 6);
#define LANE lane
#define TID tid
    const int G = gridDim.x, bid = blockIdx.x; const int gw = bid * NWAVES + wave, NGW = G * NWAVES;
    unsigned char* ws = args.ws;
    for (int u = TID; u < (LDS_BYTES - LDS_SCRATCH) / 4; u += NTHR) ((LAS unsigned*)(lds + LDS_SCRATCH))[u] = 0u;
    __syncthreads();
    const int lo = args.ph_lo, hi = args.ph_hi;
    XcdBarrier bar; bar.bar = (unsigned*)(ws + WS_CTL) + 4096; bar.x = 0; bar.st = nullptr;
    if (hi - lo > 1) bar = xcd_barrier_post((unsigned*)(ws + WS_CTL) + 4096, (volatile LAS unsigned*)(lds + MISC_OFF) + 8);
#define IN(k) (lo <= (k) && (k) < hi)
#define PHEN(j) (((PHMASK) >> (j)) & 1)

#define SEAM(k) do { if ((k) + 1 < hi) xcd_barrier(bar); } while (0)
    bf16* XB = (bf16*)(ws + WS_XB); bf16* Hb = (bf16*)(ws + WS_H); float* Y = (float*)(ws + WS_YR); const float* AUX = (const float*)(ws + WS_AUX); float* Pm = (float*)(ws + WS_P); bf16* CAT = (bf16*)(ws + WS_CAT);

    if (PHEN(0) && IN(0)) { phase_prologue(args, bid * NTHR + TID, G * NTHR); SEAM(0); }
    for (int l = 0; l < NLAYER; ++l) {
        const int pb = 1 + 14 * l;
        for (int rep = 0; rep < (((REP_MASK) >> 1) & 1 ? 2 : 1); ++rep) if (PHEN(1) && IN(pb + 0)) { phase_wconv(args, l, lds, gw, NGW, wave, LANE); SEAM(pb + 0); }
        for (int rep = 0; rep < (((REP_MASK) >> 2) & 1 ? 2 : 1); ++rep) if (PHEN(2) && IN(pb + 1)) {
            pg8::Gemm g{XB, (const bf16*)(ws + WS_WUP1), MTOK, NUP, DM}; pg8::StaticOrder S; S.init(MTOK, NUP, G, bid); pg8::EpiSwiGLU E{Hb, DFF, AUX, 3 * l - 1, l * 2 * GWN};
            pg8::gemm_phase<pg8::EpiSwiGLU, pg8::StaticOrder, true, true>(lds, g, S, E); SEAM(pb + 1); }
        for (int rep = 0; rep < (((REP_MASK) >> 3) & 1 ? 2 : 1); ++rep) if (PHEN(3) && IN(pb + 2)) {
            pg8::Gemm g{Hb, (const bf16*)(ws + WS_WDN1), MTOK, DM, DFF}; pg8::StaticOrder S; S.init(MTOK, DM, G, bid); pg8::EpiResid E{args.rep ? (float*)(ws + WS_P + 128 * MiB) : Y, args.rep ? (bf16*)(ws + WS_P) : XB, args.rep ? ws + WS_P + 64 * MiB : (unsigned char*)Y, DM, ALPHA, 0.5f, 3 * l - 1, 3 * l};
            pg8::gemm_phase<pg8::EpiResid, pg8::StaticOrder, true, true>(lds, g, S, E); SEAM(pb + 2); }
        for (int rep = 0; rep < (((REP_MASK) >> 5) & 1 ? 2 : 1); ++rep) if (PHEN(5) && IN(pb + 4)) {
            pg8::Gemm g{XB, (const bf16*)(ws + WS_WIN), MTOK, INP, DM}; pg8::StaticOrder S; S.init(MTOK, INP, G, bid); pg8::EpiF32 E{Pm, INP, AUX, 3 * l, l * 2 * GWN + NUP};
            pg8::gemm_phase<pg8::EpiF32, pg8::StaticOrder, true, true>(lds, g, S, E); SEAM(pb + 4); }
        for (int rep = 0; rep < (((REP_MASK) >> 6) & 1 ? 2 : 1); ++rep) if (PHEN(6) && IN(pb + 5)) { phase_m1(args, l, lds, bid, G, TID, wave, LANE); SEAM(pb + 5); }
        for (int rep = 0; rep < (((REP_MASK) >> 7) & 1 ? 2 : 1); ++rep) if (PHEN(7) && IN(pb + 6)) { phase_scan_prep(args, lds, gw, NGW, wave, LANE); SEAM(pb + 6); }
        for (int rep = 0; rep < (((REP_MASK) >> 8) & 1 ? 2 : 1); ++rep) if (PHEN(8) && IN(pb + 7)) { for (int r2 = 0; r2 < (((REP_MASK) >> 20) & 1 ? 2 : 1); ++r2) { if (bid < 96 && wave == 0) scan_seq(args, lds, bid, LANE); } for (int r3 = 0; r3 < (((REP_MASK) >> 21) & 1 ? 2 : 1); ++r3) if (!(bid < 96 && wave == 1)) phase_nsa(args, l + 4 * rep + 8 * r3, l, lds, wave, LANE); SEAM(pb + 7); }
        for (int rep = 0; rep < (((REP_MASK) >> 9) & 1 ? 2 : 1); ++rep) if (PHEN(9) && IN(pb + 8)) { phase_rwkv_out(args, l, gw, NGW, LANE); SEAM(pb + 8); }
        for (int rep = 0; rep < (((REP_MASK) >> 10) & 1 ? 2 : 1); ++rep) if (PHEN(10) && IN(pb + 9)) {
            pg8::Gemm g{CAT, (const bf16*)(ws + WS_WOUT), MTOK, DM, DM}; pg8::StaticOrder S; S.init(MTOK, DM, G, bid); pg8::EpiResid E{Y, XB, (unsigned char*)Y, DM, ALPHA, 1.0f, 3 * l, 3 * l + 1};
            pg8::gemm_phase<pg8::EpiResid, pg8::StaticOrder, true, true>(lds, g, S, E); SEAM(pb + 9); }
        for (int rep = 0; rep < (((REP_MASK) >> 12) & 1 ? 2 : 1); ++rep) if (PHEN(12) && IN(pb + 11)) {
            pg8::Gemm g{XB, (const bf16*)(ws + WS_WUP2), MTOK, NUP, DM}; pg8::StaticOrder S; S.init(MTOK, NUP, G, bid); pg8::EpiSwiGLU E{Hb, DFF, AUX, 3 * l + 1, l * 2 * GWN + NUP + INP};
            pg8::gemm_phase<pg8::EpiSwiGLU, pg8::StaticOrder, true, true>(lds, g, S, E); SEAM(pb + 11); }
        for (int rep = 0; rep < (((REP_MASK) >> 13) & 1 ? 2 : 1); ++rep) if (PHEN(13) && IN(pb + 12)) {
            pg8::Gemm g{Hb, (const bf16*)(ws + WS_WDN2), MTOK, DM, DFF}; pg8::StaticOrder S; S.init(MTOK, DM, G, bid); pg8::EpiResid E{Y, XB, (unsigned char*)Y, DM, ALPHA, 0.5f, 3 * l + 1, 3 * l + 2};
            pg8::gemm_phase<pg8::EpiResid, pg8::StaticOrder, true, true>(lds, g, S, E); SEAM(pb + 12); }
        for (int rep = 0; rep < (((REP_MASK) >> 14) & 1 ? 2 : 1); ++rep) if (l == NLAYER - 1 && PHEN(14) && IN(pb + 13)) { phase_ln_final(XB, (const unsigned char*)Y, INPTR(args, I_LN3G) + (size_t)l * DM, INPTR(args, I_LN3B) + (size_t)l * DM, args.out, gw, NGW, LANE); SEAM(pb + 13); }
    }
#undef IN
#undef SEAM
}

#ifndef ONE_MASK
#define ONE_MASK 0xFFFFF
#endif
#ifndef MK_ONE_LAUNCH
#define MK_ONE_LAUNCH 1
#endif
typedef void (*kern_t)(Args);
extern "C" void kernel_launch(void* const* d_in, const int* in_sizes, int n_in, void* d_out, int out_size, void* d_ws, size_t ws_size, hipStream_t stream) {
    static int grid = 0;
#if MK_ONE_LAUNCH
    static const kern_t kerns[1] = {fwd<ONE_MASK>};
    constexpr int NK = 1;
#else
    static const kern_t kerns[15] = {fwd<1 << 0>, fwd<1 << 1>, fwd<1 << 2>, fwd<1 << 3>, fwd<1 << 4>, fwd<1 << 5>, fwd<1 << 6>, fwd<1 << 7>, fwd<1 << 8>, fwd<1 << 9>, fwd<1 << 10>, fwd<1 << 11>, fwd<1 << 12>, fwd<1 << 13>, fwd<1 << 14>};
    constexpr int NK = 15;
#endif
    if (grid == 0) {
        if (n_in != 34 || out_size != MTOK * DM || ws_size < WS_END) { fprintf(stderr, "kernel_launch: unexpected shapes (n_in %d, out %d, ws %zu; need ws >= %zu)\n", n_in, out_size, ws_size, (size_t)WS_END); grid = -1; return; }
        int dev = 0, cus = 0;
        if (hipGetDevice(&dev) != hipSuccess || hipDeviceGetAttribute(&cus, hipDeviceAttributeMultiprocessorCount, dev) != hipSuccess) { grid = -1; return; }
        for (int i = 0; i < NK; ++i) if (hipFuncSetAttribute((const void*)kerns[i], hipFuncAttributeMaxDynamicSharedMemorySize, LDS_BYTES) != hipSuccess) { fprintf(stderr, "kernel_launch: hipFuncSetAttribute failed\n"); grid = -1; return; }
        int per_cu = 0;
        if (hipOccupancyMaxActiveBlocksPerMultiprocessor(&per_cu, (const void*)kerns[0], NTHR, LDS_BYTES) != hipSuccess || per_cu < 1) fprintf(stderr, "kernel_launch: occupancy query says %d blocks per CU\n", per_cu);
        (void)hipGetLastError();
        grid = cus;
    }
    if (grid < 0) return;
    (void)hipMemsetAsync((char*)d_ws + WS_CTL, 0, CTL_ZERO_BYTES, stream);
    (void)hipMemsetAsync((char*)d_ws + WS_AUX, 0, AUX_ZERO_BYTES, stream);
    Args a{};
    for (int i = 0; i < 34; ++i) a.in[i] = (const float*)d_in[i];
    a.out = (float*)d_out; a.ws = (unsigned char*)d_ws;
#if MK_ONE_LAUNCH
    a.ph_lo = 0; a.ph_hi = NPH;
    hipLaunchKernelGGL(kerns[0], dim3(grid), dim3(NTHR), LDS_BYTES, stream, a);
#else
#ifndef HOST_REP
#define HOST_REP 0
#endif
    for (int k = 0; k < NPH; ++k) { a.ph_lo = k; a.ph_hi = k + 1; const int j = k == 0 ? 0 : (k - 1) % 14 + 1;
        for (int rep = 0; rep < (((HOST_REP) >> j) & 1 ? 2 : 1); ++rep) {
            if (rep && j == 8) (void)hipMemsetAsync((char*)d_ws + WS_CTL + (8192 + 64 * ((k - 1) / 14)) * 4, 0, 256, stream);
            a.rep = rep; hipLaunchKernelGGL(kerns[j], dim3(grid), dim3(NTHR), LDS_BYTES, stream, a); } }
#endif
}
```

```cpp
#include <hip/hip_runtime.h>
#include <cstdio>
#include <cstdint>
__device__ __forceinline__ int lane_now() { unsigned m = ~0u; asm volatile("" : "+s"(m)); return (int)__builtin_amdgcn_mbcnt_hi(m, __builtin_amdgcn_mbcnt_lo(m, 0u)); }
namespace pg8 {
#define PG8_LAS __attribute__((address_space(3)))
typedef unsigned short bf16_t;
typedef short bf16x8 __attribute__((ext_vector_type(8)));
typedef float f32x4 __attribute__((ext_vector_type(4)));
typedef unsigned u32x4 __attribute__((ext_vector_type(4)));
constexpr int BM = 256, BK = 64, HALF = 128, HTB = HALF * BK * 2  , STAGE_BYTES = 8 * HTB, NXCD = 8, WGM = 8;

__host__ __device__ __forceinline__ int lds_byte(int r, int c) { const int st = (r >> 4) * 2 + (c >> 5), rr = r & 15, cc = c & 31, ob = rr * 64 + cc * 2; return st * 1024 + (ob ^ (((ob >> 9) & 1) << 5)); }
__host__ __device__ __forceinline__ void stage_rc(int b, int& R, int& C) { const int st = b / 1024, sb = b % 1024, swz = sb ^ (((sb >> 9) & 1) << 5); R = (st >> 1) * 16 + swz / 64; C = (st & 1) * 32 + (swz % 64) / 2; }
__host__ __device__ __forceinline__ int perm32(int rho) { const int n = rho >> 4, i = rho & 15; return 8 * (i >> 2) + 4 * n + (i & 3); }

struct Unit { int pm, pn; };
struct Gemm { const bf16_t* A; const bf16_t* Bt; int M, N, K; };

struct StaticOrder {
    int nM, nN, nwg, G, c;
    __host__ __device__ void init(int M, int N, int G_, int c_) { nM = M / BM; nN = N / BM; nwg = nM * nN; G = G_; c = c_; }
    __host__ __device__ bool next(int i, Unit& u) const {
        const long L = (long)i * G + c; if (L >= nwg) return false;
        int wgid = (int)L; { const int q = nwg / NXCD, r = nwg % NXCD, xcd = wgid % NXCD, off = wgid / NXCD; wgid = (xcd < r ? xcd * (q + 1) : r * (q + 1) + (xcd - r) * q) + off; }
        const int nig = WGM * nN, gid = wgid / nig, fm = gid * WGM, gsz = (nM - fm) < WGM ? (nM - fm) : WGM;
        u.pm = fm + ((wgid % nig) % gsz); u.pn = (wgid % nig) / gsz; return true;
    }
    __device__ __forceinline__ void a_ready(const Unit&) const {}
    __device__ __forceinline__ void done(const Unit&) const {}
};

__device__ __forceinline__ unsigned cvt_pk_bf16(float lo, float hi) { unsigned r; asm volatile("v_cvt_pk_bf16_f32 %0, %1, %2" : "=v"(r) : "v"(lo), "v"(hi)); return r; }
typedef float f32x2 __attribute__((ext_vector_type(2)));
constexpr int A_MT = 16384, A_DM = 2048, A_GWBW = 12 * A_MT * 2, A_GWN = 27136, A_LNGB = A_GWBW + 4 * 2 * A_GWN;
#define PG8_GAS __attribute__((address_space(1)))
__device__ __forceinline__ float quad16_sum(float x) { float a = x, b = x; asm volatile("s_nop 1\n\tv_permlane16_swap_b32 %0, %1" : "+v"(a), "+v"(b)); float y = a + b, c = y, d = y; asm volatile("s_nop 1\n\tv_permlane32_swap_b32 %0, %1" : "+v"(c), "+v"(d)); return c + d; }
template <class T> __device__ __forceinline__ PG8_GAS T* uni_ptr(T* p) { const unsigned long long v = (unsigned long long)p; const unsigned lo = __builtin_amdgcn_readfirstlane((unsigned)v), hi = __builtin_amdgcn_readfirstlane((unsigned)(v >> 32)); return (PG8_GAS T*)(((unsigned long long)hi << 32) | lo); }
__device__ __forceinline__ f32x2 ln_stats(const float* aux, int q, int row) { const f32x2 s = *(const f32x2*)(aux + ((size_t)q * A_MT + row) * 2); const float mean = s.x * (1.0f / A_DM);
    const float var = s.y * (1.0f / A_DM) - mean * mean; return (f32x2){mean, 1.0f / sqrtf(var + 1e-5f)}; }
struct EpiSwiGLU {
    static constexpr bool PERM = true, AFTER_DRAIN = false, PREFETCH = true;
    bf16_t* H; int ldh; const float* aux; int q, gwo;
    __device__ __forceinline__ void prefetch(const Unit& u, PG8_LAS unsigned char* xl, int wid, int lane) const {
        const int w = wid & 3, qq = q < 0 ? 0 : q; const PG8_GAS float* au = uni_ptr(aux);
        const PG8_GAS float* src = w < 2 ? au + ((size_t)qq * A_MT + u.pm * BM) * 2 + (w * 64 + lane) * 4
                                         : au + A_GWBW + gwo + (w == 3 ? A_GWN : 0) + (lane >= 32 ? 5504 : 0) + u.pn * HALF + (lane & 31) * 4;
        __builtin_amdgcn_global_load_lds((const unsigned*)src, (PG8_LAS unsigned*)(xl + wid * 1024), 16, 0, 0);
    }
    __device__ __forceinline__ void operator()(const f32x4 (&acc)[2][2][4][2], const Unit& u, int wr, int wc, int fr, int fq, PG8_LAS unsigned char* xl) const {
        const int row0 = u.pm * BM + wr * 64 + fr, col0 = u.pn * HALF + wc * 32 + 8 * fq;
        f32x4 ga[2], gb[2], ba[2], bb[2]; f32x2 sr[8];
#pragma unroll
        for (int n = 0; n < 2; ++n) { ga[n] = (f32x4){0.f, 0.f, 0.f, 0.f}; gb[n] = ga[n]; ba[n] = ga[n]; bb[n] = ga[n]; }
#pragma unroll
        for (int k = 0; k < 8; ++k) sr[k] = (f32x2){0.f, (float)A_DM * (1.0f - 1e-5f)};
        if (q >= 0) { const PG8_LAS float* cv = (const PG8_LAS float*)(xl + 2048) + wc * 32 + 8 * fq; const PG8_LAS float* rs = (const PG8_LAS float*)xl + (wr * 64 + fr) * 2;
#pragma unroll
            for (int n = 0; n < 2; ++n) { ga[n] = *(const PG8_LAS f32x4*)(cv + 4 * n); gb[n] = *(const PG8_LAS f32x4*)(cv + 128 + 4 * n); ba[n] = *(const PG8_LAS f32x4*)(cv + 256 + 4 * n); bb[n] = *(const PG8_LAS f32x4*)(cv + 384 + 4 * n); }
#pragma unroll
            for (int k = 0; k < 8; ++k) sr[k] = *(const PG8_LAS f32x2*)(rs + ((k >> 2) * HALF + (k & 3) * 16) * 2);
        }
        asm volatile("" ::: "memory");
#pragma unroll
        for (int ai = 0; ai < 2; ++ai)
#pragma unroll
            for (int m = 0; m < 4; ++m) { const int row = row0 + ai * HALF + m * 16; bf16_t* rowp = H + (size_t)row * ldh + col0;
                const float mean = sr[ai * 4 + m].x * (1.0f / A_DM), rstd = 1.0f / sqrtf(sr[ai * 4 + m].y * (1.0f / A_DM) - mean * mean + 1e-5f);
                float hv[8];
#pragma unroll
                for (int n = 0; n < 2; ++n) {
#pragma unroll
                    for (int i = 0; i < 4; ++i) { const float a = (acc[ai][0][m][n][i] - mean * ga[n][i]) * rstd + ba[n][i], b = (acc[ai][1][m][n][i] - mean * gb[n][i]) * rstd + bb[n][i];
                        const float e = __builtin_amdgcn_exp2f(a * -1.44269504089f); hv[n * 4 + i] = a * __builtin_amdgcn_rcpf(1.0f + e) * b; } }
                u32x4 w; w.x = cvt_pk_bf16(hv[0], hv[1]); w.y = cvt_pk_bf16(hv[2], hv[3]); w.z = cvt_pk_bf16(hv[4], hv[5]); w.w = cvt_pk_bf16(hv[6], hv[7]);
                *(u32x4*)rowp = w; asm volatile("" ::: "memory"); }
    }
};
struct EpiResid {
    static constexpr bool PERM = true, AFTER_DRAIN = false, PREFETCH = false;
    float* Y; bf16_t* YB; unsigned char* L8; int ldc; float alpha, s; int qp, qn;
    __device__ __forceinline__ void operator()(const f32x4 (&acc)[2][2][4][2], const Unit& u, int wr, int wc, int fr, int fq, PG8_LAS unsigned char* xl) const {
        const int urow0 = __builtin_amdgcn_readfirstlane(u.pm * BM + wr * 64), ucol0 = __builtin_amdgcn_readfirstlane(u.pn * BM + wc * 32); const unsigned lob = (unsigned)(fr * ldc + 8 * fq) * 4u;
        float al_ = alpha, sc_ = s; asm volatile("" : "+s"(al_), "+s"(sc_));
        PG8_GAS float* Yu = uni_ptr(Y); PG8_GAS bf16_t* YBu = uni_ptr(YB); PG8_GAS unsigned char* L8u = uni_ptr(L8);
        PG8_GAS float* aux = Yu + (size_t)A_MT * A_DM; const PG8_GAS float* lng = aux + A_LNGB + (size_t)(qp < 0 ? 0 : qp) * 2 * A_DM + ucol0 + 8 * fq; const PG8_GAS float* lnb = lng + A_DM;
        PG8_LAS float* wl = (PG8_LAS float*)(xl + (wr * 4 + wc) * 2048); float t1[2] = {0.f, 0.f}, t2[2] = {0.f, 0.f};
#pragma unroll
        for (int e = 0; e < 2; ++e) { const int k = 2 * fq + e, j = 16 * k + fr; f32x2 st = {0.f, 1.f};
            if (qp >= 0) { const f32x2 sr = *(const PG8_GAS f32x2*)(aux + ((size_t)qp * A_MT + urow0 + (k >> 2) * HALF + (k & 3) * 16 + fr) * 2); const float mean = sr.x * (1.0f / A_DM);
                st.x = mean; st.y = 1.0f / sqrtf(sr.y * (1.0f / A_DM) - mean * mean + 1e-5f); }
            *(PG8_LAS f32x2*)(wl + 2 * j) = st; }
        asm volatile("s_waitcnt lgkmcnt(0)" ::: "memory");
        typedef unsigned u32x2_ __attribute__((ext_vector_type(2)));
#pragma unroll
        for (int c = 0; c < 4; ++c) { const int ai = c >> 1, bj = c & 1;
            f32x4 gv[2], bv[2];
#pragma unroll
            for (int n = 0; n < 2; ++n) { gv[n] = (f32x4){1.f, 1.f, 1.f, 1.f}; bv[n] = (f32x4){0.f, 0.f, 0.f, 0.f}; }
            u32x4 xb[4]; u32x2_ xl8[4];
            if (qp >= 0) {
#pragma unroll
                for (int n = 0; n < 2; ++n) { gv[n] = *(const PG8_GAS f32x4*)(lng + bj * HALF + n * 4); bv[n] = *(const PG8_GAS f32x4*)(lnb + bj * HALF + n * 4); } }
#pragma unroll
            for (int m = 0; m < 4; ++m) { int ur = urow0 + ai * HALF + m * 16; ur = __builtin_amdgcn_readfirstlane(ur); asm volatile("" : "+s"(ur));
                const size_t eo = (size_t)ur * ldc + ucol0 + bj * HALF; xb[m] = *(const PG8_GAS u32x4*)((const PG8_GAS char*)(YBu + eo) + (lob >> 1)); xl8[m] = *(const PG8_GAS u32x2_*)(L8u + eo + (lob >> 2)); }
            asm volatile("" ::: "memory");
#pragma unroll
            for (int m = 0; m < 4; ++m) { int ur = urow0 + ai * HALF + m * 16; ur = __builtin_amdgcn_readfirstlane(ur); asm volatile("" : "+s"(ur)); const size_t uoff = (size_t)ur * ldc + ucol0 + bj * HALF;
                const int j = 16 * (ai * 4 + m) + fr; const f32x2 st = *(const PG8_LAS f32x2*)(wl + 2 * j); float p1 = 0.f, p2 = 0.f; u32x4 wb; u32x2_ wl8;
#pragma unroll
                for (int n = 0; n < 2; ++n) {
                    f32x4 xr; { const unsigned w0 = n ? xb[m].z : xb[m].x, w1 = n ? xb[m].w : xb[m].y; const int lw = (int)(n ? xl8[m].y : xl8[m].x); const f32x2 l0 = __builtin_amdgcn_cvt_pk_f32_bf8(lw, false), l1 = __builtin_amdgcn_cvt_pk_f32_bf8(lw, true);
                        xr.x = __builtin_bit_cast(float, w0 << 16) + l0.x; xr.y = __builtin_bit_cast(float, w0 & 0xffff0000u) + l0.y; xr.z = __builtin_bit_cast(float, w1 << 16) + l1.x; xr.w = __builtin_bit_cast(float, w1 & 0xffff0000u) + l1.y; }
                    const f32x4 x = (xr - st.x) * st.y * gv[n] + bv[n];
                    const f32x4 y = x * al_ + acc[ai][bj][m][n] * sc_;
                    const unsigned h0 = cvt_pk_bf16(y.x, y.y), h1 = cvt_pk_bf16(y.z, y.w);
                    int l8 = __builtin_amdgcn_cvt_pk_bf8_f32(y.x - __builtin_bit_cast(float, h0 << 16), y.y - __builtin_bit_cast(float, h0 & 0xffff0000u), 0, false);
                    l8 = __builtin_amdgcn_cvt_pk_bf8_f32(y.z - __builtin_bit_cast(float, h1 << 16), y.w - __builtin_bit_cast(float, h1 & 0xffff0000u), l8, true);
                    if (n == 0) { wb.x = h0; wb.y = h1; wl8.x = (unsigned)l8; } else { wb.z = h0; wb.w = h1; wl8.y = (unsigned)l8; }
                    p1 += (y.x + y.y) + (y.z + y.w); p2 += (y.x * y.x + y.y * y.y) + (y.z * y.z + y.w * y.w); }
                *(PG8_GAS u32x4*)((PG8_GAS char*)(YBu + uoff) + (lob >> 1)) = wb; *(PG8_GAS u32x2_*)(L8u + uoff + (lob >> 2)) = wl8;
                p1 = quad16_sum(p1); p2 = quad16_sum(p2); const bool mine = fq == ((ai * 4 + m) >> 1);
                t1[m & 1] += mine ? p1 : 0.f; t2[m & 1] += mine ? p2 : 0.f; }
            asm volatile("" ::: "memory"); }
#pragma unroll
        for (int e = 0; e < 2; ++e) { const int k = 2 * fq + e;
            PG8_GAS float* sp = aux + ((size_t)qn * A_MT + urow0 + (k >> 2) * HALF + (k & 3) * 16 + fr) * 2;
            __hip_atomic_fetch_add(sp, __builtin_rintf(t1[e] * 1024.0f) * (1.0f / 1024.0f), __ATOMIC_RELAXED, __HIP_MEMORY_SCOPE_AGENT); __hip_atomic_fetch_add(sp + 1, __builtin_rintf(t2[e] * 64.0f) * (1.0f / 64.0f), __ATOMIC_RELAXED, __HIP_MEMORY_SCOPE_AGENT); }
        asm volatile("s_waitcnt lgkmcnt(0)" ::: "memory");
    }
};
struct EpiF32 {
    static constexpr bool PERM = false, AFTER_DRAIN = false, PREFETCH = true;
    float* C; int ldc; const float* aux; int q, gwo;
    __device__ __forceinline__ void prefetch(const Unit& u, PG8_LAS unsigned char* xl, int wid, int lane) const {
        const int w = wid & 3; const PG8_GAS float* au = uni_ptr(aux);
        const PG8_GAS float* src = w < 2 ? au + ((size_t)q * A_MT + u.pm * BM) * 2 + (w * 64 + lane) * 4 : au + A_GWBW + gwo + (w == 3 ? A_GWN : 0) + u.pn * BM + lane * 4;
        __builtin_amdgcn_global_load_lds((const unsigned*)src, (PG8_LAS unsigned*)(xl + wid * 1024), 16, 0, 0);
    }
    __device__ __forceinline__ void operator()(const f32x4 (&acc)[2][2][4][2], const Unit& u, int wr, int wc, int fr, int fq, PG8_LAS unsigned char* xl) const {
        const int row0 = u.pm * BM + wr * 64 + fr, col0 = u.pn * BM + wc * 32 + 4 * fq;
        const PG8_LAS float* cv = (const PG8_LAS float*)(xl + 2048) + wc * 32 + 4 * fq; const PG8_LAS float* rs = (const PG8_LAS float*)xl + (wr * 64 + fr) * 2;
        f32x4 g4[2][2], b4[2][2]; f32x2 sr[8];
#pragma unroll
        for (int bj = 0; bj < 2; ++bj)
#pragma unroll
            for (int n = 0; n < 2; ++n) { g4[bj][n] = *(const PG8_LAS f32x4*)(cv + bj * HALF + n * 16); b4[bj][n] = *(const PG8_LAS f32x4*)(cv + 256 + bj * HALF + n * 16); }
#pragma unroll
        for (int k = 0; k < 8; ++k) sr[k] = *(const PG8_LAS f32x2*)(rs + ((k >> 2) * HALF + (k & 3) * 16) * 2);
        asm volatile("" ::: "memory");
#pragma unroll
        for (int ai = 0; ai < 2; ++ai)
#pragma unroll
            for (int m = 0; m < 4; ++m) { const int row = row0 + ai * HALF + m * 16; float* rowp = C + (size_t)row * ldc + col0;
                const float mean = sr[ai * 4 + m].x * (1.0f / A_DM), rstd = 1.0f / sqrtf(sr[ai * 4 + m].y * (1.0f / A_DM) - mean * mean + 1e-5f);
#pragma unroll
                for (int bj = 0; bj < 2; ++bj)
#pragma unroll
                    for (int n = 0; n < 2; ++n) *(f32x4*)(rowp + bj * HALF + n * 16) = (acc[ai][bj][m][n] - g4[bj][n] * mean) * rstd + b4[bj][n];
                asm volatile("" ::: "memory"); }
    }
};

template <class Epi, class Sched, bool ALIGN_EPI = false, bool SP2 = false>
__device__ __forceinline__ void gemm_phase(PG8_LAS unsigned char* lds, const Gemm g, const Sched& S, const Epi& E) {
    int tid_ = threadIdx.x; asm volatile("" : "+v"(tid_));
    const int tid = tid_, wid = __builtin_amdgcn_readfirstlane(tid >> 6), lane = tid & 63, wr = wid >> 2, wc = wid & 3, fr = lane & 15, fq = lane >> 4;
    const int K = g.K, nt = K / BK;
    unsigned voffA[2], voffB[2];
#pragma unroll
    for (int i = 0; i < 2; ++i) { int R, C; stage_rc(tid * 16 + i * 8192, R, C); const int Rb = Epi::PERM ? ((R & ~31) + perm32(R & 31)) : R;
        voffA[i] = (unsigned)(R * K + C) * 2u; voffB[i] = (unsigned)(Rb * K + C) * 2u; }
    const size_t kstep = (size_t)(BK * 2);
    const size_t hstep = (size_t)HALF * K * 2;
    const size_t tstep = 2 * hstep;
    const unsigned ldsw = (unsigned)wid * 1024u;
    const int aoff = lds_byte(wr * 64 + fr, fq * 8), boff = lds_byte(wc * 32 + fr, fq * 8);
#define PG8_SA(b, h) (((b) * 2 + (h)) * HTB)
#define PG8_SB(b, h) ((4 + (b) * 2 + (h)) * HTB)
#define PG8_STAGE(bufoff, gbase, voff) do { _Pragma("unroll") for (int _i = 0; _i < 2; ++_i) \
        __builtin_amdgcn_global_load_lds((const unsigned*)((const char*)(gbase) + (voff)[_i]), (PG8_LAS unsigned*)(lds + (bufoff) + ldsw + _i * 8192), 16, 0, 0); } while (0)
#define PG8_LDA(dst, b, h) do { _Pragma("unroll") for (int m = 0; m < 4; ++m) _Pragma("unroll") for (int k = 0; k < 2; ++k) dst[m][k] = *(const PG8_LAS bf16x8*)(lds + PG8_SA(b, h) + aoff + m * 2048 + k * 1024); } while (0)
#define PG8_LDB(dst, b, h) do { _Pragma("unroll") for (int n = 0; n < 2; ++n) _Pragma("unroll") for (int k = 0; k < 2; ++k) dst[n][k] = *(const PG8_LAS bf16x8*)(lds + PG8_SB(b, h) + boff + n * 2048 + k * 1024); } while (0)
#define PG8_MMA(ai, bj, At, Bt) do { __builtin_amdgcn_s_setprio(1); _Pragma("unroll") for (int m = 0; m < 4; ++m) _Pragma("unroll") for (int n = 0; n < 2; ++n) _Pragma("unroll") for (int k = 0; k < 2; ++k) \
        acc[ai][bj][m][n] = __builtin_amdgcn_mfma_f32_16x16x32_bf16(Bt[n][k], At[m][k], acc[ai][bj][m][n], 0, 0, 0); __builtin_amdgcn_s_setprio(0); } while (0)
#define PG8_WAIT_V(n) asm volatile("s_waitcnt vmcnt(" #n ")" ::: "memory")
#define PG8_WAIT_L(n) asm volatile("s_waitcnt lgkmcnt(" #n ")" ::: "memory")
#define PG8_BAR __builtin_amdgcn_s_barrier()
#define PG8_SCHED __builtin_amdgcn_sched_barrier(0)
    Unit cur, nxt; int ui = 0;
    if (!S.next(0, cur)) return;
    f32x4 acc[2][2][4][2];
#pragma unroll
    for (int a = 0; a < 2; ++a)
#pragma unroll
        for (int b = 0; b < 2; ++b)
#pragma unroll
            for (int m = 0; m < 4; ++m)
#pragma unroll
                for (int n = 0; n < 2; ++n) acc[a][b][m][n] = (f32x4){0.f, 0.f, 0.f, 0.f};
    bf16x8 At[4][2], B0[2][2], B1[2][2];
    const char* cA = (const char*)g.A + (size_t)cur.pm * tstep; const char* cB = (const char*)g.Bt + (size_t)cur.pn * tstep;
    S.a_ready(cur);
    if constexpr (SP2) {
        PG8_STAGE(PG8_SB(0, 0), cB, voffB); PG8_STAGE(PG8_SB(0, 1), cB + hstep, voffB); PG8_STAGE(PG8_SA(0, 0), cA, voffA); PG8_STAGE(PG8_SA(0, 1), cA + hstep, voffA);
        if (wr == 1) PG8_BAR;
        PG8_WAIT_V(2); PG8_BAR;
        PG8_STAGE(PG8_SB(1, 0), cB + kstep, voffB); PG8_STAGE(PG8_SA(1, 0), cA + kstep, voffA); PG8_STAGE(PG8_SB(1, 1), cB + hstep + kstep, voffB);
        PG8_WAIT_V(6); PG8_BAR;
    } else {
        PG8_STAGE(PG8_SB(0, 0), cB, voffB); PG8_STAGE(PG8_SA(0, 0), cA, voffA); PG8_STAGE(PG8_SB(0, 1), cB + hstep, voffB); PG8_STAGE(PG8_SA(0, 1), cA + hstep, voffA);
        if (wr == 1) PG8_BAR;
        PG8_WAIT_V(4); PG8_BAR;
        PG8_STAGE(PG8_SB(1, 0), cB + kstep, voffB); PG8_STAGE(PG8_SA(1, 0), cA + kstep, voffA); PG8_STAGE(PG8_SB(1, 1), cB + hstep + kstep, voffB);
        PG8_WAIT_V(6); PG8_BAR;
    }
    for (;;) {
        const bool has_next = S.next(ui + 1, nxt);
        const char* nA = has_next ? (const char*)g.A + (size_t)nxt.pm * tstep : cA; const char* nB = has_next ? (const char*)g.Bt + (size_t)nxt.pn * tstep : cB;
        for (int t = 0; t < nt; t += 2) {
            const bool last = (t == nt - 2);
            const char* a1 = cA + (size_t)(t + 1) * kstep;
            const char* a2 = last ? nA : cA + (size_t)(t + 2) * kstep; const char* b2 = last ? nB : cB + (size_t)(t + 2) * kstep;
            const char* a3 = a2 + kstep; const char* b3 = b2 + kstep;
            if (last && has_next) S.a_ready(nxt);
            if constexpr (Epi::PREFETCH) { if (last) E.prefetch(cur, lds + STAGE_BYTES, wid, lane); }
            if constexpr (SP2) {
            PG8_LDB(B0, 0, 0); PG8_LDB(B1, 0, 1); PG8_SCHED; PG8_LDA(At, 0, 0); PG8_STAGE(PG8_SA(1, 1), a1 + hstep, voffA);
            PG8_WAIT_V(8); PG8_WAIT_L(0); PG8_BAR; PG8_MMA(0, 0, At, B0); PG8_MMA(0, 1, At, B1); PG8_BAR; PG8_SCHED;
            PG8_LDA(At, 0, 1); PG8_STAGE(PG8_SB(0, 0), b2, voffB); PG8_STAGE(PG8_SB(0, 1), b2 + hstep, voffB); PG8_STAGE(PG8_SA(0, 0), a2, voffA);
            PG8_WAIT_V(8); PG8_WAIT_L(0); PG8_BAR; PG8_MMA(1, 0, At, B0); PG8_MMA(1, 1, At, B1); PG8_BAR; PG8_SCHED;
            PG8_LDB(B0, 1, 0); PG8_LDB(B1, 1, 1); PG8_SCHED; PG8_LDA(At, 1, 0); PG8_STAGE(PG8_SA(0, 1), a2 + hstep, voffA);
            PG8_WAIT_V(8); PG8_WAIT_L(0); PG8_BAR; PG8_MMA(0, 0, At, B0); PG8_MMA(0, 1, At, B1); PG8_BAR; PG8_SCHED;
            PG8_LDA(At, 1, 1); PG8_STAGE(PG8_SB(1, 0), b3, voffB); PG8_STAGE(PG8_SB(1, 1), b3 + hstep, voffB); PG8_STAGE(PG8_SA(1, 0), a3, voffA);
            PG8_WAIT_V(8); PG8_WAIT_L(0); PG8_BAR; PG8_MMA(1, 0, At, B0); PG8_MMA(1, 1, At, B1); PG8_BAR; PG8_SCHED;
            } else {
            PG8_LDB(B0, 0, 0); PG8_SCHED; PG8_LDA(At, 0, 0); PG8_STAGE(PG8_SA(1, 1), a1 + hstep, voffA);
            PG8_WAIT_L(8); PG8_BAR; PG8_WAIT_L(0); PG8_MMA(0, 0, At, B0); PG8_BAR; PG8_SCHED;
            PG8_LDB(B1, 0, 1); PG8_STAGE(PG8_SB(0, 0), b2, voffB);
            PG8_BAR; PG8_WAIT_L(0); PG8_MMA(0, 1, At, B1); PG8_BAR;
            PG8_LDA(At, 0, 1); PG8_STAGE(PG8_SA(0, 0), a2, voffA);
            PG8_BAR; PG8_WAIT_L(0); PG8_MMA(1, 0, At, B0); PG8_BAR; PG8_SCHED;
            PG8_STAGE(PG8_SB(0, 1), b2 + hstep, voffB);
            PG8_WAIT_V(6); PG8_BAR; PG8_MMA(1, 1, At, B1); PG8_BAR;
            PG8_LDB(B0, 1, 0); PG8_SCHED; PG8_LDA(At, 1, 0); PG8_STAGE(PG8_SA(0, 1), a2 + hstep, voffA);
            PG8_WAIT_L(8); PG8_BAR; PG8_WAIT_L(0); PG8_MMA(0, 0, At, B0); PG8_BAR; PG8_SCHED;
            PG8_LDB(B1, 1, 1); PG8_STAGE(PG8_SB(1, 0), b3, voffB);
            PG8_BAR; PG8_WAIT_L(0); PG8_MMA(0, 1, At, B1); PG8_BAR;
            PG8_LDA(At, 1, 1); PG8_STAGE(PG8_SA(1, 0), a3, voffA);
            PG8_BAR; PG8_WAIT_L(0); PG8_MMA(1, 0, At, B0); PG8_BAR; PG8_SCHED;
            PG8_STAGE(PG8_SB(1, 1), b3 + hstep, voffB);
            PG8_WAIT_V(6); PG8_BAR; PG8_MMA(1, 1, At, B1); PG8_BAR;
            }
        }
        if constexpr (ALIGN_EPI) { if (wr == 0) PG8_BAR; }
        if constexpr (!Epi::AFTER_DRAIN) { E(acc, cur, wr, wc, fr, fq, lds + STAGE_BYTES); S.done(cur); }
        if (!has_next) break;
#pragma unroll
        for (int a = 0; a < 2; ++a)
#pragma unroll
            for (int b = 0; b < 2; ++b)
#pragma unroll
                for (int m = 0; m < 4; ++m)
#pragma unroll
                    for (int n = 0; n < 2; ++n) acc[a][b][m][n] = (f32x4){0.f, 0.f, 0.f, 0.f};
        cur = nxt; cA = nA; cB = nB; ++ui;
        if constexpr (ALIGN_EPI) { if (wr == 1) PG8_BAR; }
    }
    PG8_WAIT_V(0);
    if constexpr (!ALIGN_EPI) { if (wr == 0) PG8_BAR; }
    PG8_BAR;
    if constexpr (Epi::AFTER_DRAIN) { E.fused(acc, cur, wr, wc, fr, fq, lds, wid, lane); S.done(cur); }
#undef PG8_SA
#undef PG8_SB
#undef PG8_STAGE
#undef PG8_LDA
#undef PG8_LDB
#undef PG8_MMA
#undef PG8_WAIT_V
#undef PG8_WAIT_L
#undef PG8_BAR
#undef PG8_SCHED
}
}

constexpr int NWAVES = 8, NTHR = 512;
constexpr int NB = 4, SEQ = 4096, DM = 2048, MTOK = NB * SEQ, NLAYER = 4;
constexpr int DFF = 5504, NUP = 2 * DFF;
constexpr int INC = 5028, INP = 5120;
constexpr int DRW = 768, RWC = 2560, PO_POOL = 2560, DPOOL = 512, PO_NSA = 3072;
constexpr int PO_Q = PO_NSA, PO_KC = PO_NSA + 768, PO_VC = PO_KC + 192, PO_KS = PO_VC + 192, PO_VS = PO_KS + 192, PO_KW = PO_VS + 192, PO_VW = PO_KW + 192, PO_GL = PO_VW + 192;
static_assert(PO_GL + 36 == INC, "W_in column map");
constexpr int NCMP = 255, NCMPP = 256;
constexpr float ALPHA = 1.6817928305074290f;
constexpr float LN_EPS = 1e-5f, GN_EPS = 64e-5f;
constexpr int NPH = 1 + 14 * NLAYER;

constexpr size_t MiB = 1u << 20;
constexpr size_t WS_CTL = 0, CTL_ZERO_BYTES = 1 * MiB;
constexpr size_t WS_ROPE = 1 * MiB;
constexpr size_t WS_KC = 2 * MiB, WS_VC = 2 * MiB + 512 * 1024;
constexpr size_t WS_SC = 3 * MiB;
constexpr size_t WS_WUP1 = 8 * MiB, WS_WDN1 = 51 * MiB, WS_WIN = WS_WDN1 + 21 * MiB + 512 * 1024, WS_WOUT = WS_WIN + 20 * MiB, WS_WUP2 = WS_WOUT + 8 * MiB, WS_WDN2 = WS_WUP2 + 43 * MiB;
constexpr size_t WS_XB = 165 * MiB;
static_assert(WS_WDN2 + (size_t)DM * DFF * 2 <= WS_XB, "weights map");
constexpr size_t WS_CAT = 229 * MiB;
constexpr size_t WS_QR = 293 * MiB;
constexpr size_t WS_KS = 317 * MiB, WS_KW = 323 * MiB, WS_VS = 329 * MiB, WS_VW = 335 * MiB;
constexpr size_t WS_P = 341 * MiB;
constexpr size_t WS_H = 661 * MiB;
constexpr size_t WS_Y = 833 * MiB;
constexpr size_t WS_SV = WS_H;
constexpr size_t SV_STRIDE = 48 * MiB;
static_assert(WS_SV + 6 * SV_STRIDE <= WS_Y + 128 * MiB, "scan overlay");
constexpr size_t WS_G = 961 * MiB, WS_YS = 1009 * MiB;
constexpr size_t WS_VST = 1057 * MiB, WS_VWT = 1063 * MiB;
constexpr size_t WS_VCT = 6 * MiB;
constexpr size_t WS_SW = 1069 * MiB;
constexpr size_t WS_W2T = WS_SW, WS_A2T = WS_W2T + 768 * 64 * 2, WS_G2T = WS_A2T + 768 * 64 * 2, WS_PWT = WS_G2T + 768 * 128 * 2;
constexpr size_t WS_W1T = WS_PWT + 4 * 128 * 128 * 2, WS_W2CT = WS_W1T + 2 * 256 * 2048 * 2, WS_CBIAS = WS_W2CT + 2 * 64 * 256 * 2;
constexpr size_t WS_SPREC = 1073 * MiB;
constexpr size_t SPREC_BYTES = 15360, WS_YR = WS_SPREC + (size_t)NB * 12 * 256 * SPREC_BYTES + MiB;
static_assert(true, ""); constexpr size_t WS_XL8 = WS_YR;
constexpr int GWN = NUP + INP + NUP;
constexpr size_t WS_AUX = WS_YR + 128 * MiB;
constexpr size_t AUX_ST = 0, AUX_GWBW = AUX_ST + (size_t)12 * MTOK * 2 * 4, AUX_ZERO_BYTES = AUX_GWBW + (size_t)NLAYER * 2 * GWN * 4, AUX_LNGB = (AUX_ZERO_BYTES + 255) & ~(size_t)255;
constexpr size_t WS_END = WS_AUX + AUX_LNGB + (size_t)12 * 2 * DM * 4 + MiB;
static_assert(WS_CBIAS + 2 * 256 * 4 <= WS_END, "small weights map");

constexpr int LDS_SCRATCH = 147456;
constexpr int LDS_BYTES = LDS_SCRATCH + 1024, MISC_OFF = LDS_SCRATCH + 320;

#define GAS __attribute__((address_space(1)))
#define LAS __attribute__((address_space(3)))
typedef unsigned short bf16;
typedef float f32x4 __attribute__((ext_vector_type(4)));
typedef float f32x2 __attribute__((ext_vector_type(2)));
typedef unsigned u32x4 __attribute__((ext_vector_type(4)));
typedef unsigned u32x2 __attribute__((ext_vector_type(2)));
#define LDS_WAIT() asm volatile("s_waitcnt lgkmcnt(0)" ::: "memory")
__device__ __forceinline__ unsigned f2bf(float f) { unsigned u = __builtin_bit_cast(unsigned, f); return (u + 0x7fffu + ((u >> 16) & 1u)) >> 16; }
__device__ __forceinline__ unsigned pk2(float lo, float hi) { return f2bf(lo) | (f2bf(hi) << 16); }
__device__ __forceinline__ float bf2f(unsigned short b) { return __builtin_bit_cast(float, ((unsigned)b) << 16); }
__device__ __forceinline__ float wave_sum(float v) {
#pragma unroll
    for (int o = 1; o < 64; o <<= 1) v += __shfl_xor(v, o);
    return v;
}
__device__ __forceinline__ float wave_max(float v) {
#pragma unroll
    for (int o = 1; o < 64; o <<= 1) v = fmaxf(v, __shfl_xor(v, o));
    return v;
}
__device__ __forceinline__ float sigmoidf_(float x) { return 1.0f / (1.0f + expf(-x)); }
template <int CTRL> __device__ __forceinline__ float dpp_f(float v) { return __builtin_bit_cast(float, __builtin_amdgcn_update_dpp(0, __builtin_bit_cast(int, v), CTRL, 0xF, 0xF, true)); }
__device__ __forceinline__ float row16_sum(float v) {
    v += dpp_f<0xB1>(v); v += dpp_f<0x4E>(v); v += dpp_f<0x141>(v); v += dpp_f<0x140>(v); return v;
}

#define XB_TMO      128
#define XB_XCNT(j)  (256  + 64 * (j))
#define XB_XSUB(j)  (1280 + 64 * (j))
#define XB_XGEN(j)  (2304 + 64 * (j))
#define XB_TOP      3328
#define XB_TOPGEN   3392
#define XCD_BAR_WORDS 3456
#define XB_SPIN_CAP (1u << 18)

__device__ __forceinline__ unsigned xb_ld(unsigned* p)              { return __hip_atomic_load(p, __ATOMIC_RELAXED, __HIP_MEMORY_SCOPE_AGENT); }
__device__ __forceinline__ unsigned xb_add(unsigned* p, unsigned v) { return __hip_atomic_fetch_add(p, v, __ATOMIC_RELAXED, __HIP_MEMORY_SCOPE_AGENT); }
__device__ __forceinline__ unsigned xb_xcc_id() { return (unsigned)__builtin_amdgcn_s_getreg((3 << 11) | 20) & 0xFu; }
#define XB_SPIN(cond, bar) do { unsigned _sp = 0; while (cond) { __builtin_amdgcn_s_sleep(1); \
    if ((++_sp & 255u) == 0u) { if (xb_ld(&(bar)[XB_TMO])) break; if (_sp > XB_SPIN_CAP) { atomicAdd(&(bar)[XB_TMO], 1u); break; } } } } while (0)

struct XcdBarrier {
    unsigned* bar; unsigned x;
    volatile LAS unsigned* st;
};

__device__ __forceinline__ XcdBarrier xcd_barrier_post(unsigned* bar, volatile LAS unsigned* st) {
    XcdBarrier b; b.bar = bar; b.x = xb_xcc_id(); b.st = st;
    if (threadIdx.x == 0) (void)xb_add(&bar[XB_XCNT(b.x)], 1u);
    return b;
}
__device__ __forceinline__ void xcd_barrier_complete(unsigned* bar, unsigned x, unsigned& nloc, unsigned& nx) {
    const unsigned G = gridDim.x * gridDim.y * gridDim.z;
    unsigned sum, cnt, mine, sp = 0u;
    for (;;) {
        sum = 0u; cnt = 0u; mine = 0u;
#pragma unroll
        for (unsigned j = 0; j < 16; ++j) { const unsigned c = xb_ld(&bar[XB_XCNT(j)]); sum += c; cnt += (c > 0u) ? 1u : 0u; mine = (j == x) ? c : mine; }
        if (sum == G) break;
        __builtin_amdgcn_s_sleep(1);
        if ((++sp & 255u) == 0u) { if (xb_ld(&bar[XB_TMO])) break; if (sp > XB_SPIN_CAP) { atomicAdd(&bar[XB_TMO], 1u); break; } }
    }
    nloc = mine > 0u ? mine : 1u; nx = cnt > 0u ? cnt : 1u;
}

__device__ __forceinline__ void xcd_barrier(const XcdBarrier& b) {
    asm volatile("s_waitcnt vmcnt(0)" ::: "memory");
    __syncthreads();
    if (threadIdx.x == 0) {
        unsigned* bar = b.bar;
        __builtin_amdgcn_s_waitcnt(0);
        unsigned nloc = b.st[0], nx = b.st[1];
        if (nloc == 0u) { xcd_barrier_complete(bar, b.x, nloc, nx); b.st[0] = nloc; b.st[1] = nx; }
        const unsigned old = xb_add(&bar[XB_XSUB(b.x)], 1u);
        const unsigned gen = old / nloc;
        if (old + 1u == (gen + 1u) * nloc) {
            __builtin_amdgcn_fence(__ATOMIC_RELEASE, "agent");
            asm volatile("s_waitcnt vmcnt(0)" ::: "memory");
            const unsigned og = xb_add(&bar[XB_TOP], 1u);
            const unsigned tg = og / nx;
            if (og + 1u == (tg + 1u) * nx) xb_add(&bar[XB_TOPGEN], 1u);
            else XB_SPIN(xb_ld(&bar[XB_TOPGEN]) == tg, bar);
            __builtin_amdgcn_fence(__ATOMIC_ACQUIRE, "agent");
            xb_add(&bar[XB_XGEN(b.x)], 1u);
            asm volatile("s_waitcnt vmcnt(0)" ::: "memory");
        } else {
            XB_SPIN(xb_ld(&bar[XB_XGEN(b.x)]) == gen, bar);
            __builtin_amdgcn_fence(__ATOMIC_ACQUIRE, "agent");
            asm volatile("s_waitcnt vmcnt(0)" ::: "memory");
        }
    }
    __syncthreads();
}

struct Args { const float* in[34]; float* out; unsigned char* ws; int ph_lo, ph_hi, rep; };
__device__ __forceinline__ int opaque0() { int z = 0; asm volatile("" : "+s"(z)); return z; }
#define OPQ_S(x) asm volatile("" : "+s"(x))
#define OPQ_SI(x) do { (x) = __builtin_amdgcn_readfirstlane(x); asm volatile("" : "+s"(x)); } while (0)
#define OPQ_V(x) asm volatile("" : "+v"(x))
#define INPTR(a, idx) ((a).in[(idx) + opaque0()])
enum { I_X = 0, I_UP1, I_DN1, I_LN1G, I_LN1B, I_WIN, I_MU, I_W0, I_W2, I_A0, I_A2, I_G2, I_KK, I_KA, I_RK, I_GNG, I_GNB, I_PW, I_PB, I_PS, I_PEK, I_PEV, I_CK1, I_CK2, I_CV1, I_CV2, I_GB, I_WOUT, I_LN2G, I_LN2B, I_UP2, I_DN2, I_LN3G, I_LN3B };

template <bool LN = false> __device__ __forceinline__ void transpose_item(const float* W, int K, int Nsrc, bf16* WT, int dst0, LAS float* scr, int k0, int n0, int lane, const float* lng = nullptr, const float* lnb = nullptr, float* gwp = nullptr) {
    const int c4 = lane & 15, rq = lane >> 4; const int n = n0 + 4 * c4; const bool ok = n < Nsrc;
    const float* wp = W + (size_t)(k0 + rq) * Nsrc + n;
#pragma unroll 8
    for (int i = 0; i < 16; ++i) { const f32x4 v = ok ? __builtin_nontemporal_load((const f32x4*)(wp + (size_t)(4 * i) * Nsrc)) : (f32x4){0.f, 0.f, 0.f, 0.f};
        LAS float* d = scr + (4 * i + rq) * 65 + 4 * c4; d[0] = v.x; d[1] = v.y; d[2] = v.z; d[3] = v.w; }
    const int c = lane & 7;
    f32x4 g0 = {1.f, 1.f, 1.f, 1.f}, g1 = g0, b0 = {0.f, 0.f, 0.f, 0.f}, b1 = b0;
    if constexpr (LN) { g0 = *(const f32x4*)(lng + k0 + 8 * c); g1 = *(const f32x4*)(lng + k0 + 8 * c + 4); b0 = *(const f32x4*)(lnb + k0 + 8 * c); b1 = *(const f32x4*)(lnb + k0 + 8 * c + 4); }
    LDS_WAIT();
    float mg = 0.f, mb = 0.f;
#pragma unroll
    for (int j = 0; j < 8; ++j) { const int nn = (lane >> 3) + 8 * j; const LAS float* s = scr + (8 * c) * 65 + nn;
        float v[8];
#pragma unroll
        for (int q = 0; q < 8; ++q) v[q] = s[q * 65];
        if constexpr (LN) {
            float pb = v[0] * b0.x + v[1] * b0.y + v[2] * b0.z + v[3] * b0.w + v[4] * b1.x + v[5] * b1.y + v[6] * b1.z + v[7] * b1.w;
            v[0] *= g0.x; v[1] *= g0.y; v[2] *= g0.z; v[3] *= g0.w; v[4] *= g1.x; v[5] *= g1.y; v[6] *= g1.z; v[7] *= g1.w;
            float pg = ((v[0] + v[1]) + (v[2] + v[3])) + ((v[4] + v[5]) + (v[6] + v[7]));
            pg += dpp_f<0xB1>(pg); pg += dpp_f<0x4E>(pg); pg += dpp_f<0x141>(pg); pb += dpp_f<0xB1>(pb); pb += dpp_f<0x4E>(pb); pb += dpp_f<0x141>(pb);
            mg = c == j ? pg : mg; mb = c == j ? pb : mb; }
        u32x4 o; o.x = pk2(v[0], v[1]); o.y = pk2(v[2], v[3]); o.z = pk2(v[4], v[5]); o.w = pk2(v[6], v[7]);
        *(u32x4*)(WT + (size_t)(dst0 + nn) * K + k0 + 8 * c) = o; }
    if constexpr (LN) { const int nm = n0 + (lane >> 3) + 8 * c;
        if (nm < Nsrc) {
            __hip_atomic_fetch_add((GAS float*)gwp + nm, __builtin_rintf(mg * 65536.0f) * (1.0f / 65536.0f), __ATOMIC_RELAXED, __HIP_MEMORY_SCOPE_AGENT);
            __hip_atomic_fetch_add((GAS float*)gwp + GWN + nm, __builtin_rintf(mb * 65536.0f) * (1.0f / 65536.0f), __ATOMIC_RELAXED, __HIP_MEMORY_SCOPE_AGENT); } }
    LDS_WAIT();
}
__device__ __forceinline__ int up_dst_row(int n0) { return n0 < DFF ? 256 * (n0 / 128) + (n0 % 128) : 256 * ((n0 - DFF) / 128) + 128 + ((n0 - DFF) % 128); }

__device__ __forceinline__ void phase_wconv(const Args& a, int l, LAS unsigned char* lds, int gw, int NGW, int wave, int lane) {
    OPQ_SI(gw); OPQ_SI(wave); OPQ_V(lane);
    LAS float* scr = (LAS float*)(lds + wave * 16640);
    unsigned char* ws = a.ws + opaque0();
    float* gwl = a.rep ? (float*)(ws + WS_END - MiB) : (float*)(ws + WS_AUX + AUX_GWBW) + (size_t)l * 2 * GWN;
    {
        const int gt = gw * 64 + lane; if (gt < 3 * 2 * (DM / 4)) { const int j = gt / (2 * (DM / 4)), r2 = gt - j * 2 * (DM / 4), isb = r2 / (DM / 4), c4_ = r2 - isb * (DM / 4);
            const float* src = (j == 0 ? (isb ? INPTR(a, I_LN1B) : INPTR(a, I_LN1G)) : j == 1 ? (isb ? INPTR(a, I_LN2B) : INPTR(a, I_LN2G)) : (isb ? INPTR(a, I_LN3B) : INPTR(a, I_LN3G))) + (size_t)l * DM;
            ((f32x4*)(ws + WS_AUX + AUX_LNGB))[((size_t)(3 * l + j) * 2 + isb) * (DM / 4) + c4_] = ((const f32x4*)src)[c4_]; } }
    constexpr int I_UP = (DM / 64) * (NUP / 64), I_DN = (DFF / 64) * (DM / 64), I_IN = (DM / 64) * (INP / 64), I_OUT = (DM / 64) * (DM / 64);
    constexpr int NIT = 2 * I_UP + 2 * I_DN + I_IN + I_OUT + 12 + 12 + 24 + 16 + 256 + 8;
    for (int it = gw; it < NIT; it += NGW) {
        int r = it;
        if (r < 2 * I_UP) { const int which = r / I_UP; r -= which * I_UP; const int nblk = NUP / 64, kb = r / nblk, nb = r % nblk;
            const float* W = a.in[which ? I_UP2 : I_UP1] + (size_t)l * DM * NUP; bf16* WT = (bf16*)(ws + (which ? WS_WUP2 : WS_WUP1));
            const float* lg = which ? INPTR(a, I_LN2G) + (size_t)l * DM : (l > 0 ? INPTR(a, I_LN3G) + (size_t)(l - 1) * DM : nullptr);
            const float* lb = which ? INPTR(a, I_LN2B) + (size_t)l * DM : (l > 0 ? INPTR(a, I_LN3B) + (size_t)(l - 1) * DM : nullptr);
            if (lg) transpose_item<true>(W, DM, NUP, WT, up_dst_row(64 * nb), scr, 64 * kb, 64 * nb, lane, lg, lb, gwl + (which ? NUP + INP : 0)); else transpose_item<false>(W, DM, NUP, WT, up_dst_row(64 * nb), scr, 64 * kb, 64 * nb, lane); continue; }
        r -= 2 * I_UP;
        if (r < 2 * I_DN) { const int which = r / I_DN; r -= which * I_DN; const int nblk = DM / 64, kb = r / nblk, nb = r % nblk;
            const float* W = a.in[which ? I_DN2 : I_DN1] + (size_t)l * DFF * DM; bf16* WT = (bf16*)(ws + (which ? WS_WDN2 : WS_WDN1));
            transpose_item(W, DFF, DM, WT, 64 * nb, scr, 64 * kb, 64 * nb, lane); continue; }
        r -= 2 * I_DN;
        if (r < I_IN) { const int nblk = INP / 64, kb = r / nblk, nb = r % nblk;
            transpose_item<true>(INPTR(a, I_WIN) + (size_t)l * DM * INC, DM, INC, (bf16*)(ws + WS_WIN), 64 * nb, scr, 64 * kb, 64 * nb, lane, INPTR(a, I_LN1G) + (size_t)l * DM, INPTR(a, I_LN1B) + (size_t)l * DM, gwl + NUP); continue; }
        r -= I_IN;
        if (r < I_OUT) { const int nblk = DM / 64, kb = r / nblk, nb = r % nblk;
            transpose_item(INPTR(a, I_WOUT) + (size_t)l * DM * DM, DM, DM, (bf16*)(ws + WS_WOUT), 64 * nb, scr, 64 * kb, 64 * nb, lane); continue; }
        r -= I_OUT;
        if (r < 12) { transpose_item(INPTR(a, I_W2) + (size_t)l * 64 * DRW, 64, DRW, (bf16*)(ws + WS_W2T), 64 * r, scr, 0, 64 * r, lane); continue; } r -= 12;
        if (r < 12) { transpose_item(INPTR(a, I_A2) + (size_t)l * 64 * DRW, 64, DRW, (bf16*)(ws + WS_A2T), 64 * r, scr, 0, 64 * r, lane); continue; } r -= 12;
        if (r < 24) { const int kb = r / 12, nb = r % 12; transpose_item(INPTR(a, I_G2) + (size_t)l * 128 * DRW, 128, DRW, (bf16*)(ws + WS_G2T), 64 * nb, scr, 64 * kb, 64 * nb, lane); continue; } r -= 24;
        if (r < 16) { const int gi = r >> 2, q = r & 3, kb = q >> 1, nb = q & 1; transpose_item(INPTR(a, I_PW) + ((size_t)l * 4 + gi) * 128 * 128, 128, 128, (bf16*)(ws + WS_PWT) + gi * 128 * 128, 64 * nb, scr, 64 * kb, 64 * nb, lane); continue; } r -= 16;
        if (r < 256) { const int ten = r >> 7, q = r & 127, kb = q >> 2, nb = q & 3; transpose_item(INPTR(a, ten ? I_CV1 : I_CK1) + (size_t)l * 2048 * 256, 2048, 256, (bf16*)(ws + WS_W1T) + (size_t)ten * 256 * 2048, 64 * nb, scr, 64 * kb, 64 * nb, lane); continue; } r -= 256;
        { const int ten = r >> 2, kb = r & 3; transpose_item(INPTR(a, ten ? I_CV2 : I_CK2) + (size_t)l * 256 * 64, 256, 64, (bf16*)(ws + WS_W2CT) + (size_t)ten * 64 * 256, 0, scr, 64 * kb, 0, lane); }
    }
}

__device__ __forceinline__ void phase_prologue(const Args& a, int gtid, int NGT) {
    OPQ_V(gtid);
    const f32x4* x4 = (const f32x4*)INPTR(a, I_X); u32x2* xb = (u32x2*)(a.ws + WS_XB);
    int* xl8 = (int*)(a.ws + WS_XL8);
    for (size_t i = gtid; i < (size_t)MTOK * DM / 4; i += NGT) { const f32x4 v = x4[i]; u32x2 o; o.x = pk2(v.x, v.y); o.y = pk2(v.z, v.w); xb[i] = o;
        int w = __builtin_amdgcn_cvt_pk_bf8_f32(v.x - __builtin_bit_cast(float, o.x << 16), v.y - __builtin_bit_cast(float, o.x & 0xffff0000u), 0, false);
        w = __builtin_amdgcn_cvt_pk_bf8_f32(v.z - __builtin_bit_cast(float, o.y << 16), v.w - __builtin_bit_cast(float, o.y & 0xffff0000u), w, true); xl8[i] = w; }
    f32x2* rope = (f32x2*)(a.ws + WS_ROPE);
    for (int i = gtid; i < SEQ * 8; i += NGT) { const int s = i >> 3, k = i & 7;
        const float inv = powf(500000.0f, -(float)k * 0.125f); const float ang = (float)s * inv;
        const double ad = (double)ang; const double q = __builtin_rint(ad * 0.15915494309189535); const double rr = ad - q * 6.283185307179586;
        const float rf = (float)rr; rope[i] = (f32x2){cosf(rf), sinf(rf)}; }
}

__device__ __forceinline__ void phase_ln_final(const bf16* HI, const unsigned char* LO, const float* g, const float* b, float* X, int gw, int NGW, int lane) {
    OPQ_SI(gw); OPQ_V(lane);
    f32x4 gv[8], bv[8];
#pragma unroll
    for (int j = 0; j < 8; ++j) { gv[j] = ((const f32x4*)g)[64 * j + lane]; bv[j] = ((const f32x4*)b)[64 * j + lane]; }
    u32x2 nh[8]; unsigned nl[8];
    { const size_t m0 = (size_t)(gw < MTOK ? gw : 0) * DM;
#pragma unroll
        for (int j = 0; j < 8; ++j) { nh[j] = ((const u32x2*)(HI + m0))[64 * j + lane]; nl[j] = ((const unsigned*)(LO + m0))[64 * j + lane]; } }
    for (int m = gw; m < MTOK; m += NGW) {
        f32x4 v[8]; float s = 0.f;
#pragma unroll
        for (int j = 0; j < 8; ++j) { const f32x2 l0 = __builtin_amdgcn_cvt_pk_f32_bf8((int)nl[j], false), l1 = __builtin_amdgcn_cvt_pk_f32_bf8((int)nl[j], true);
            v[j].x = __builtin_bit_cast(float, nh[j].x << 16) + l0.x; v[j].y = __builtin_bit_cast(float, nh[j].x & 0xffff0000u) + l0.y; v[j].z = __builtin_bit_cast(float, nh[j].y << 16) + l1.x; v[j].w = __builtin_bit_cast(float, nh[j].y & 0xffff0000u) + l1.y; }
        { const size_t mn = (size_t)(m + NGW < MTOK ? m + NGW : m) * DM;
#pragma unroll
            for (int j = 0; j < 8; ++j) { nh[j] = ((const u32x2*)(HI + mn))[64 * j + lane]; nl[j] = ((const unsigned*)(LO + mn))[64 * j + lane]; } }
#pragma unroll
        for (int j = 0; j < 8; ++j) s += (v[j].x + v[j].y) + (v[j].z + v[j].w);
        const float mean = wave_sum(s) * (1.f / DM); float s2 = 0.f;
#pragma unroll
        for (int j = 0; j < 8; ++j) { v[j] = v[j] - mean; s2 += (v[j].x * v[j].x + v[j].y * v[j].y) + (v[j].z * v[j].z + v[j].w * v[j].w); }
        const float rstd = 1.f / sqrtf(wave_sum(s2) * (1.f / DM) + LN_EPS);
        f32x4* xr = (f32x4*)(X + (size_t)m * DM) + lane;
#pragma unroll
        for (int j = 0; j < 8; ++j) xr[64 * j] = v[j] * rstd * gv[j] + bv[j];
    }
}
__device__ __forceinline__ void phase_ln(const float* Y, const float* g, const float* b, float* X, bf16* XB, float* stats, int gw, int NGW, int lane) {
    OPQ_SI(gw); OPQ_V(lane);
    f32x4 gv[8], bv[8];
#pragma unroll
    for (int j = 0; j < 8; ++j) { gv[j] = ((const f32x4*)g)[64 * j + lane]; bv[j] = ((const f32x4*)b)[64 * j + lane]; }
    if (gw < NWAVES) { f32x4* gd = (f32x4*)(stats + 2 * MTOK) + gw * 64 + lane; gd[0] = ((const f32x4*)g)[gw * 64 + lane]; gd[512] = ((const f32x4*)b)[gw * 64 + lane]; }
    f32x4 nx[8];
    { const f32x4* yr0 = (const f32x4*)(Y + (size_t)(gw < MTOK ? gw : 0) * DM) + lane;
#pragma unroll
        for (int j = 0; j < 8; ++j) nx[j] = yr0[64 * j]; }
    for (int m = gw; m < MTOK; m += NGW) {
        f32x4 v[8]; float s = 0.f;
#pragma unroll
        for (int j = 0; j < 8; ++j) v[j] = nx[j];
        { const int mn = m + NGW < MTOK ? m + NGW : m; const f32x4* yrn = (const f32x4*)(Y + (size_t)mn * DM) + lane;
#pragma unroll
            for (int j = 0; j < 8; ++j) nx[j] = yrn[64 * j]; }
#pragma unroll
        for (int j = 0; j < 8; ++j) s += (v[j].x + v[j].y) + (v[j].z + v[j].w);
        const float mean = wave_sum(s) * (1.f / DM); float s2 = 0.f;
#pragma unroll
        for (int j = 0; j < 8; ++j) { v[j] = v[j] - mean; s2 += (v[j].x * v[j].x + v[j].y * v[j].y) + (v[j].z * v[j].z + v[j].w * v[j].w); }
        const float rstd = 1.f / sqrtf(wave_sum(s2) * (1.f / DM) + LN_EPS);
        if (lane == 0) *(f32x2*)(stats + 2 * (size_t)m) = (f32x2){mean, rstd};
        u32x2* xb = (u32x2*)(XB + (size_t)m * DM) + lane;
        if (X) { f32x4* xr = (f32x4*)(X + (size_t)m * DM) + lane;
#pragma unroll
            for (int j = 0; j < 8; ++j) { const f32x4 o = v[j] * rstd * gv[j] + bv[j]; xr[64 * j] = o; } }
#pragma unroll
        for (int j = 0; j < 8; ++j) { const f32x4 o = v[j] * rstd * gv[j] + bv[j]; u32x2 w; w.x = pk2(o.x, o.y); w.y = pk2(o.z, o.w); xb[64 * j] = w; }
    }
}


typedef float f32x16 __attribute__((ext_vector_type(16)));
typedef short bf16x8 __attribute__((ext_vector_type(8)));
#define MFMA32(a, b, c) __builtin_amdgcn_mfma_f32_32x32x16_bf16((a), (b), (c), 0, 0, 0)
#define WSYNC() asm volatile("s_waitcnt lgkmcnt(0)" ::: "memory")
__device__ __forceinline__ void half_swap(float x, float& lo, float& hi) { float a = x, b = x; asm volatile("s_nop 1\n\tv_permlane32_swap_b32 %0, %1" : "+v"(a), "+v"(b)); lo = a; hi = b; }
__device__ __forceinline__ float half_max(float x) { float lo, hi; half_swap(x, lo, hi); return fmaxf(lo, hi); }
__device__ __forceinline__ float half_sum(float x) { float lo, hi; half_swap(x, lo, hi); return lo + hi; }
__device__ __forceinline__ float other_half(float x, int h) { float lo, hi; half_swap(x, lo, hi); return h ? lo : hi; }
__device__ __forceinline__ unsigned cvtpk(float lo, float hi) { unsigned r; asm volatile("v_cvt_pk_bf16_f32 %0, %1, %2" : "=v"(r) : "v"(lo), "v"(hi)); return r; }
__device__ __forceinline__ float half32_sum(float v) { v = row16_sum(v); float a = v, b = v; asm volatile("s_nop 1\n\tv_permlane16_swap_b32 %0, %1" : "+v"(a), "+v"(b)); return a + b; }
__device__ __forceinline__ int vt_pos(int k) { return 16 * ((k >> 2) & 1) + 8 * (k >> 4) + 4 * ((k >> 3) & 1) + (k & 3); }
__device__ __forceinline__ float fexp(float x) { return __builtin_amdgcn_exp2f(x * 1.4426950408889634f); }
__device__ __forceinline__ float fsigmoid(float x) { return __builtin_amdgcn_rcpf(1.0f + __builtin_amdgcn_exp2f(x * -1.4426950408889634f)); }
__device__ __forceinline__ float ftanh(float x) { const float xc = fminf(fmaxf(x, -15.f), 15.f); return 1.0f - 2.0f * __builtin_amdgcn_rcpf(1.0f + __builtin_amdgcn_exp2f(xc * 2.8853900817779268f)); }
__device__ __forceinline__ float fsoftplus(float z) { return z > 20.f ? z : __builtin_amdgcn_logf(1.0f + __builtin_amdgcn_exp2f(z * 1.4426950408889634f)) * 0.6931471805599453f; }

#ifndef REP_MASK
#define REP_MASK 0
#endif
#ifndef M1_PREFETCH
#define M1_PREFETCH 1
#endif
constexpr int XP = 264, ZP = 520, HP = 264;
__device__ __forceinline__ bf16x8 lds_frag(const LAS bf16* p) { return *(const LAS bf16x8*)p; }
__device__ __forceinline__ bf16x8 cvt8(const f32x4 a, const f32x4 b) { u32x4 w; w.x = cvtpk(a.x, a.y); w.y = cvtpk(a.z, a.w); w.z = cvtpk(b.x, b.y); w.w = cvtpk(b.z, b.w); return __builtin_bit_cast(bf16x8, w); }
__device__ __forceinline__ void phase_m1(const Args& a, int l, LAS unsigned char* lds, int bid, int G, int tid, int wave, int lane) {
    OPQ_SI(bid); OPQ_V(tid); OPQ_SI(wave); lane = tid & 63;
    unsigned char* ws = a.ws + opaque0(); const float* P = (const float*)(ws + WS_P);
    const int r = lane & 31, h = lane >> 5;
    const f32x2* rope = (const f32x2*)(ws + WS_ROPE);
    for (int rp1 = 0; rp1 < (((REP_MASK) >> 22) & 1 ? 2 : 1); ++rp1)
    for (int unit = bid; unit < MTOK / 64; unit += G) {
        const int t0 = unit * 64, b = t0 >> 12, s0 = t0 & (SEQ - 1);
        LAS bf16* XL = (LAS bf16*)lds;
        LAS bf16* ZL = (LAS bf16*)(lds + 64 * XP * 2);
        { const float* mu = INPTR(a, I_MU) + (size_t)l * RWC;
#pragma unroll 16
            for (int i = tid; i < 64 * 256; i += NTHR) { const int tt = i >> 8, j = i & 255, col = 2304 + j; const int m = t0 + tt;
                const float pc = P[(size_t)m * INP + col]; const float pp = (s0 + tt) > 0 ? P[(size_t)(m - 1) * INP + col] : 0.f; const float v = pc + (pp - pc) * mu[col];
                const float f = j < 64 ? ftanh(v) : (j < 128 ? v : fsigmoid(v)); XL[tt * XP + j] = (bf16)f2bf(f); }
            {
                const int ch = tid, gi = ch >> 7, win = 2 << gi; const float* pp = P + (size_t)t0 * INP + PO_POOL + ch; float sum = 0.f;
                for (int j = 1; j < win; ++j) if (s0 - j >= 0) sum += pp[-(ptrdiff_t)j * INP];
#pragma unroll 16
                for (int tt = 0; tt < 64; ++tt) { const int s = s0 + tt; const float cur = pp[(size_t)tt * INP]; sum += cur; const int cnt = (s + 1) < win ? (s + 1) : win;
                    ZL[tt * ZP + ch] = (bf16)f2bf(sum / (float)cnt - cur); if (s - win + 1 >= 0) sum -= pp[((ptrdiff_t)tt - win + 1) * INP]; } } }
        __syncthreads();
        {
            const float* mu = INPTR(a, I_MU) + (size_t)l * RWC; const float* w0 = INPTR(a, I_W0) + (size_t)l * DRW; const float* a0 = INPTR(a, I_A0) + (size_t)l * DRW;
            const float* k_k = INPTR(a, I_KK) + (size_t)l * DRW; const float* k_a = INPTR(a, I_KA) + (size_t)l * DRW; const float* r_k = INPTR(a, I_RK) + (size_t)l * DRW;
            const bf16* W2T = (const bf16*)(ws + WS_W2T); const bf16* A2T = (const bf16*)(ws + WS_A2T); const bf16* G2T = (const bf16*)(ws + WS_G2T);
            float* vKK = (float*)(ws + WS_SV); float* vWR = (float*)(ws + WS_SV + SV_STRIDE); float* vW = (float*)(ws + WS_SV + 2 * SV_STRIDE);
            float* vKM = (float*)(ws + WS_SV + 3 * SV_STRIDE); float* vBB = (float*)(ws + WS_SV + 4 * SV_STRIDE); float* vV = (float*)(ws + WS_SV + 5 * SV_STRIDE);
            float* vG = (float*)(ws + WS_G); float* SC = (float*)(ws + WS_SC);
#pragma unroll 1
            for (int jj = 0; jj < 3; ++jj) {
                const int job = wave + 8 * jj, hd = job >> 1, th = job & 1;
                f32x16 aU[2], aA[2];
#pragma unroll
                for (int t = 0; t < 2; ++t)
#pragma unroll
                    for (int i = 0; i < 16; ++i) { aU[t][i] = 0.f; aA[t][i] = 0.f; }
                const LAS bf16* xa = XL + (32 * th + r) * XP + 8 * h;
#pragma unroll
                for (int ks = 0; ks < 4; ++ks) { const bf16x8 xt = lds_frag(xa + 16 * ks), xl = lds_frag(xa + 64 + 16 * ks);
#pragma unroll
                    for (int t = 0; t < 2; ++t) { const int c = hd * 64 + 32 * t + r;
                        aU[t] = MFMA32(xt, *(const bf16x8*)(W2T + (size_t)c * 64 + 16 * ks + 8 * h), aU[t]);
                        aA[t] = MFMA32(xl, *(const bf16x8*)(A2T + (size_t)c * 64 + 16 * ks + 8 * h), aA[t]); } }
                float pmr[2], pmk[2], pmv[2], pw0[2], pa0[2], pkk[2], pka[2], prk[2];
#pragma unroll
                for (int t = 0; t < 2; ++t) { const int c = hd * 64 + 32 * t + r; pmr[t] = mu[c]; pmk[t] = mu[768 + c]; pmv[t] = mu[1536 + c]; pw0[t] = w0[c]; pa0[t] = a0[c]; pkk[t] = k_k[c]; pka[t] = k_a[c]; prk[t] = r_k[c]; }
                const int lo_p = 4 * h * INP + hd * 64 + r, lo_s = 4 * h * DRW + hd * 64 + r;
                float ld[5][12];
#define M1_LOADROW(buf, i) do { int mr_ = t0 + 32 * th + ((i) & 3) + 8 * ((i) >> 2); OPQ_SI(mr_); const bool first_ = (s0 + 32 * th + ((i) & 3) + 8 * ((i) >> 2) + 4 * h) == 0; \
        const float* pc_ = P + (size_t)mr_ * INP; const float* pp_ = pc_ - INP; _Pragma("unroll") for (int t = 0; t < 2; ++t) { const int o = lo_p + 32 * t; \
        buf[6 * t + 0] = __builtin_nontemporal_load(pc_ + o); buf[6 * t + 1] = __builtin_nontemporal_load(pc_ + o + 768); buf[6 * t + 2] = __builtin_nontemporal_load(pc_ + o + 1536); \
        if (((i) & 3) == 0) { buf[6 * t + 3] = first_ ? 0.f : pp_[o]; buf[6 * t + 4] = first_ ? 0.f : pp_[o + 768]; buf[6 * t + 5] = first_ ? 0.f : pp_[o + 1536]; } } } while (0)
#if M1_PREFETCH
                M1_LOADROW(ld[0], 0); M1_LOADROW(ld[1], 1); M1_LOADROW(ld[2], 2);
#else
                M1_LOADROW(ld[0], 0);
#endif
#pragma unroll
                for (int i = 0; i < 16; ++i) {
#if M1_PREFETCH
                    if (i + 3 < 16) M1_LOADROW(ld[(i + 3) % 5], i + 3);
#else
                    if (i > 0) M1_LOADROW(ld[i % 5], i);
#endif
                    int mrow = t0 + 32 * th + (i & 3) + 8 * (i >> 2); OPQ_SI(mrow);
                    float rr[2], kv[2], vv[2], dec[2], av[2], kr[2], km[2];
                    float ss = 0.f, s1 = 0.f, s2 = 0.f, s3 = 0.f;
#pragma unroll
                    for (int t = 0; t < 2; ++t) { const float* L = ld[i % 5] + 6 * t; const float* Lp = (i & 3) == 0 ? L + 3 : ld[(i + 4) % 5] + 6 * t;
                        const float rc = L[0], kc = L[1], vc = L[2], rp = Lp[0], kp = Lp[1], vp = Lp[2];
                        rr[t] = rc + (rp - rc) * pmr[t]; kv[t] = kc + (kp - kc) * pmk[t]; vv[t] = vc + (vp - vc) * pmv[t];
                        const float uu = pw0[t] + aU[t][i]; const float z = -uu; const float sp = fsoftplus(z); dec[t] = fexp(-fexp(-sp - 0.5f));
                        av[t] = fsigmoid(pa0[t] + aA[t][i]);
                        kr[t] = kv[t] * pkk[t]; km[t] = kv[t] * (1.0f + (av[t] - 1.0f) * pka[t]);
                        ss += kr[t] * kr[t]; s1 += kr[t] * av[t] * rr[t]; s2 += km[t] * rr[t]; s3 += rr[t] * km[t] * prk[t]; }
                    ss = half32_sum(ss); s1 = half32_sum(s1); s2 = half32_sum(s2); s3 = half32_sum(s3);
                    const float invn = 1.0f / fmaxf(sqrtf(ss), 1e-12f);
                    const size_t ro = (size_t)mrow * DRW;
#pragma unroll
                    for (int t = 0; t < 2; ++t) { const int o = lo_s + 32 * t; const float kk = kr[t] * invn;
                        (vKK + ro)[o] = kk; (vWR + ro)[o] = dec[t] * rr[t]; (vW + ro)[o] = dec[t]; (vKM + ro)[o] = km[t]; (vBB + ro)[o] = kk * av[t]; (vV + ro)[o] = vv[t]; }
                    if (r == 0) *(f32x4*)(SC + ((size_t)mrow * 12 + hd) * 4 + 4 * h * 48) = (f32x4){s1 * invn, s2, s3, 0.f};
                    asm volatile("" ::: "memory");
                }
#undef M1_LOADROW
                { f32x16 aG[2];
#pragma unroll
                    for (int t = 0; t < 2; ++t)
#pragma unroll
                        for (int i = 0; i < 16; ++i) aG[t][i] = 0.f;
#pragma unroll
                    for (int ks = 0; ks < 8; ++ks) { const bf16x8 xg = lds_frag(xa + 128 + 16 * ks);
#pragma unroll
                        for (int t = 0; t < 2; ++t) { const int c = hd * 64 + 32 * t + r; aG[t] = MFMA32(xg, *(const bf16x8*)(G2T + (size_t)c * 128 + 16 * ks + 8 * h), aG[t]); } }
#pragma unroll
                    for (int i = 0; i < 16; ++i) { int mrow = t0 + 32 * th + (i & 3) + 8 * (i >> 2); OPQ_SI(mrow); float* gp = vG + (size_t)mrow * DRW;
#pragma unroll
                        for (int t = 0; t < 2; ++t) gp[lo_s + 32 * t] = aG[t][i]; } }
            }
        }
        {
            int lane_b = lane; OPQ_V(lane_b); const int r = lane_b & 31, h = lane_b >> 5;
            const int gi = wave >> 1, th = wave & 1; const bf16* PWT = (const bf16*)(ws + WS_PWT) + gi * 128 * 128;
            const float* pb = INPTR(a, I_PB) + (size_t)l * DPOOL + gi * 128; const float* psc = INPTR(a, I_PS) + (size_t)l * DPOOL + gi * 128; bf16* CAT = (bf16*)(ws + WS_CAT);
            f32x16 acc[4];
#pragma unroll
            for (int t = 0; t < 4; ++t)
#pragma unroll
                for (int i = 0; i < 16; ++i) acc[t][i] = 0.f;
            const LAS bf16* za = ZL + (32 * th + r) * ZP + gi * 128 + 8 * h;
#pragma unroll
            for (int ks = 0; ks < 8; ++ks) { const bf16x8 zf = lds_frag(za + 16 * ks);
#pragma unroll
                for (int t = 0; t < 4; ++t) acc[t] = MFMA32(zf, *(const bf16x8*)(PWT + (size_t)(32 * t + r) * 128 + 16 * ks + 8 * h), acc[t]); }
#pragma unroll
            for (int t = 0; t < 4; ++t) { const int d = 32 * t + r; const float bv = pb[d], sv = psc[d];
#pragma unroll
                for (int i = 0; i < 16; ++i) { const int m = t0 + 32 * th + (i & 3) + 8 * (i >> 2) + 4 * h; CAT[(size_t)m * DM + DRW + gi * 128 + d] = (bf16)f2bf((acc[t][i] + bv) * sv); } }
        }
        __syncthreads();
        {
            int tid_c = tid; OPQ_V(tid_c); const int tid = tid_c;
            bf16* QR = (bf16*)(ws + WS_QR); bf16* KS = (bf16*)(ws + WS_KS); bf16* KW = (bf16*)(ws + WS_KW); bf16* VST = (bf16*)(ws + WS_VST); bf16* VWT = (bf16*)(ws + WS_VWT);
            LAS float* T0 = (LAS float*)lds; LAS float* T1 = T0 + 64 * 193;
#pragma unroll 1
            for (int c = tid; c < 1152; c += NTHR) {
                int src; float scale = 1.f; const int d = c & 63; const bool isq = c < 768; const int cc = isq ? c : (c < 960 ? c - 768 : c - 960);
                bf16* dbase;
                if (isq) { src = PO_Q + c; dbase = QR + (size_t)t0 * 768 + c; scale = 0.125f * 1.4426950408889634f; }
                else if (c < 960) { src = PO_KS + cc; dbase = KS + ((size_t)(b * 3 + (cc >> 6)) * SEQ + s0) * 64 + (cc & 63); }
                else { src = PO_KW + cc; dbase = KW + ((size_t)(b * 3 + (cc >> 6)) * SEQ + s0) * 64 + (cc & 63); }
                const int dstep = isq ? 768 : 64; const bool rot = d < 16; const int po = d < 8 ? 8 : -8; const float sg = d < 8 ? -1.f : 1.f;
                const float* pr = P + (size_t)t0 * INP + src; const f32x2* rp = rope + s0 * 8 + (d & 7);
#pragma unroll 1
                for (int t8 = 0; t8 < 64; t8 += 16) { float v[16], pv[16]; f32x2 cs[16];
#pragma unroll
                    for (int e = 0; e < 16; ++e) { v[e] = pr[(size_t)(t8 + e) * INP]; pv[e] = pr[(size_t)(t8 + e) * INP + (rot ? po : 0)]; cs[e] = rp[(t8 + e) * 8]; }
#pragma unroll
                    for (int e = 0; e < 16; ++e) { const float o = rot ? v[e] * cs[e].x + sg * pv[e] * cs[e].y : v[e]; dbase[(size_t)(t8 + e) * dstep] = (bf16)f2bf(o * scale); } } }
            if (tid < 384) { const int c = tid; const float* pr = P + (size_t)t0 * INP + (c < 192 ? PO_VS + c : PO_VW + (c - 192)); LAS float* td = c < 192 ? T0 + c : T1 + (c - 192);
#pragma unroll 1
                for (int t8 = 0; t8 < 64; t8 += 16) { float v[16];
#pragma unroll
                    for (int e = 0; e < 16; ++e) v[e] = pr[(size_t)(t8 + e) * INP];
#pragma unroll
                    for (int e = 0; e < 16; ++e) td[(t8 + e) * 193] = v[e]; } }
            __syncthreads();
            for (int i = tid; i < 384 * 64; i += NTHR) { const int c2 = i >> 6, tok = i & 63; const int which = c2 >= 192, c = which ? c2 - 192 : c2;
                const float v = (which ? T1 : T0)[tok * 193 + c]; const int sk = s0 + tok;
                bf16* dst = (which ? VWT : VST) + (((size_t)(b * 3 + (c >> 6)) * 128 + (sk >> 5)) * 64 + (c & 63)) * 32 + vt_pos(sk & 31); *dst = (bf16)f2bf(v); }
        }
        __syncthreads();
    }
    {
        int lane_d = lane; OPQ_V(lane_d); const int r = lane_d & 31, h = lane_d >> 5;
        LAS bf16* HL = (LAS bf16*)lds;
        bf16* KC = (bf16*)(ws + WS_KC); bf16* VCT = (bf16*)(ws + WS_VCT);
        for (int rp2 = 0; rp2 < (((REP_MASK) >> 23) & 1 ? 2 : 1); ++rp2)
        for (int u = bid; u < 2 * NB * 3 * 8; u += G) {
            const int ten = u / 96, q = u - ten * 96, b = q / 24, q2 = q - b * 24, hh = q2 >> 3, nt = q2 & 7, n0 = 32 * nt;
            const bf16* W1T = (const bf16*)(ws + WS_W1T) + (size_t)ten * 256 * 2048 + (size_t)(32 * wave + r) * 2048 + 8 * h;
            const int tk0 = 16 * (n0 + r);
            const float* pa = P + ((size_t)b * SEQ + tk0) * INP + (ten ? PO_VC : PO_KC) + hh * 64 + 8 * h;
            const float* pep = INPTR(a, ten ? I_PEV : I_PEK) + (size_t)l * 2048 + 8 * h;
            f32x16 acc;
#pragma unroll
            for (int i = 0; i < 16; ++i) acc[i] = 0.f;
            f32x4 xa[2][8]; bf16x8 wb[2][4];
#define CMP_LOAD(sl, ll) do { const bool ok_ = tk0 + (ll) < SEQ; const float* pl_ = pa + (size_t)(ll) * INP; const float* pe_ = pep + 64 * (ll); _Pragma("unroll") for (int ds = 0; ds < 4; ++ds) { \
        xa[sl][2 * ds] = (ok_ ? *(const f32x4*)(pl_ + 16 * ds) : (f32x4){0.f, 0.f, 0.f, 0.f}) + *(const f32x4*)(pe_ + 16 * ds); xa[sl][2 * ds + 1] = (ok_ ? *(const f32x4*)(pl_ + 16 * ds + 4) : (f32x4){0.f, 0.f, 0.f, 0.f}) + *(const f32x4*)(pe_ + 16 * ds + 4); \
        wb[sl][ds] = *(const bf16x8*)(W1T + 64 * (ll) + 16 * ds); } } while (0)
            CMP_LOAD(0, 0);
#pragma unroll 1
            for (int ll = 0; ll < 32; ll += 2) {
                CMP_LOAD(1, ll + 1);
#pragma unroll
                for (int ds = 0; ds < 4; ++ds) acc = MFMA32(cvt8(xa[0][2 * ds], xa[0][2 * ds + 1]), wb[0][ds], acc);
                if (ll + 2 < 32) CMP_LOAD(0, ll + 2);
#pragma unroll
                for (int ds = 0; ds < 4; ++ds) acc = MFMA32(cvt8(xa[1][2 * ds], xa[1][2 * ds + 1]), wb[1][ds], acc);
            }
#undef CMP_LOAD
            {
#pragma unroll
                for (int i = 0; i < 16; ++i) { const float x = acc[i]; const float gl = 0.5f * x * (1.0f + ftanh(0.7978845608028654f * (x + 0.044715f * x * x * x)));
                    HL[((i & 3) + 8 * (i >> 2) + 4 * h) * HP + 32 * wave + r] = (bf16)f2bf(gl); } }
            __syncthreads();
            if (wave < 2) {
                const bf16* W2CT = (const bf16*)(ws + WS_W2CT) + (size_t)ten * 64 * 256 + (size_t)(32 * wave + r) * 256 + 8 * h;
                f32x16 o;
#pragma unroll
                for (int i = 0; i < 16; ++i) o[i] = 0.f;
                const LAS bf16* ha = HL + r * HP + 8 * h;
#pragma unroll
                for (int ks = 0; ks < 16; ++ks) o = MFMA32(lds_frag(ha + 16 * ks), *(const bf16x8*)(W2CT + 16 * ks), o);
                const int d = 32 * wave + r;
#pragma unroll
                for (int i = 0; i < 16; ++i) { const int n = n0 + (i & 3) + 8 * (i >> 2) + 4 * h; float v = o[i];
                    if (ten == 0) { const float other = dpp_f<0x128>(v);
                        if (wave == 0 && r < 16) { const f32x2 cs = rope[((16 * n + 31) & (SEQ - 1)) * 8 + (r & 7)]; v = r < 8 ? v * cs.x - other * cs.y : v * cs.x + other * cs.y; }
                        if (n < NCMP) KC[((size_t)(b * 3 + hh) * NCMPP + n) * 64 + d] = (bf16)f2bf(v); }
                    else if (n < NCMP) VCT[(((size_t)(b * 3 + hh) * 8 + (n >> 5)) * 64 + d) * 32 + vt_pos(n & 31)] = (bf16)f2bf(v); }
            }
            __syncthreads();
        }
    }
}

constexpr int SPX = 72;
__device__ __forceinline__ void phase_scan_prep(const Args& a, LAS unsigned char* lds, int gw, int NGW, int wave, int lane) {
    OPQ_SI(gw); OPQ_SI(wave); OPQ_V(lane);
    unsigned char* ws = a.ws + opaque0();
    LAS unsigned char* wl = lds + wave * 16384;
    LAS bf16* XA = (LAS bf16*)wl; LAS bf16* XR = XA + 16 * SPX; LAS bf16* XB_ = XR + 16 * SPX; LAS bf16* XK = XB_ + 16 * SPX;
    LAS float* GB = (LAS float*)(wl + 4 * 16 * SPX * 2); LAS float* GK = GB + 256; LAS float* HB = GK + 256; LAS float* HK = HB + 256; LAS float* NM = HK + 256;
    const int r = lane & 31, h = lane >> 5;
    const GAS float* vKK = (const GAS float*)(ws + WS_SV); const GAS float* vWR = (const GAS float*)(ws + WS_SV + SV_STRIDE); const GAS float* vW = (const GAS float*)(ws + WS_SV + 2 * SV_STRIDE);
    const GAS float* vKM = (const GAS float*)(ws + WS_SV + 3 * SV_STRIDE); const GAS float* vBB = (const GAS float*)(ws + WS_SV + 4 * SV_STRIDE); const GAS float* vV = (const GAS float*)(ws + WS_SV + 5 * SV_STRIDE);
#pragma unroll 1
    for (int item = gw; item < NB * 12 * 256; item += NGW) {
        const int hd = item >> 8, c = item & 255, b = hd / 12, hh = hd - b * 12;
        const size_t o0 = ((size_t)b * SEQ + 16 * c) * DRW + hh * 64 + lane;
        GAS unsigned char* rec = (GAS unsigned char*)(ws + WS_SPREC) + (size_t)item * SPREC_BYTES;
        float al[16], rh[16], be[16], ka[16], vv[16]; float g = 1.f;
#pragma unroll
        for (int t = 0; t < 16; ++t) { const size_t o = o0 + (size_t)t * DRW; const float w = vW[o], kk = vKK[o], bb = vBB[o], km = vKM[o], wr = vWR[o]; vv[t] = vV[o];
            al[t] = g * kk; rh[t] = g * wr; g *= w; const float ig = 1.0f / g; be[t] = bb * ig; ka[t] = km * ig; }
#pragma unroll
        for (int t = 0; t < 16; ++t) { XA[t * SPX + lane] = (bf16)f2bf(al[t]); XR[t * SPX + lane] = (bf16)f2bf(rh[t]); XB_[t * SPX + lane] = (bf16)f2bf(be[t]); XK[t * SPX + lane] = (bf16)f2bf(ka[t]); }
#pragma unroll
        for (int hp = 0; hp < 2; ++hp) {
            u32x4 wb, wk, wv;
            wb.x = cvtpk(be[4 * hp + 0], be[4 * hp + 1]); wb.y = cvtpk(be[4 * hp + 2], be[4 * hp + 3]); wb.z = cvtpk(be[8 + 4 * hp + 0], be[8 + 4 * hp + 1]); wb.w = cvtpk(be[8 + 4 * hp + 2], be[8 + 4 * hp + 3]);
            wk.x = cvtpk(ka[4 * hp + 0], ka[4 * hp + 1]); wk.y = cvtpk(ka[4 * hp + 2], ka[4 * hp + 3]); wk.z = cvtpk(ka[8 + 4 * hp + 0], ka[8 + 4 * hp + 1]); wk.w = cvtpk(ka[8 + 4 * hp + 2], ka[8 + 4 * hp + 3]);
            wv.x = cvtpk(vv[4 * hp + 0], vv[4 * hp + 1]); wv.y = cvtpk(vv[4 * hp + 2], vv[4 * hp + 3]); wv.z = cvtpk(vv[8 + 4 * hp + 0], vv[8 + 4 * hp + 1]); wv.w = cvtpk(vv[8 + 4 * hp + 2], vv[8 + 4 * hp + 3]);
            *(GAS u32x4*)(rec + 4096 + ((h * 2 + hp) * 32 + r) * 16) = wb; *(GAS u32x4*)(rec + 6144 + ((h * 2 + hp) * 32 + r) * 16) = wk;
            *(GAS u32x4*)(rec + 9216 + h * 3072 + 2048 + (hp * 32 + r) * 16) = wv; }
        *(GAS float*)(rec + 8704 + ((h * 2 + ((r >> 2) & 1)) * 16 + (r & 3) + 4 * (r >> 3)) * 4) = g;
        WSYNC();
        const bool lo16 = r < 16; const bf16x8 zf = {0, 0, 0, 0, 0, 0, 0, 0};
#define SP_GRAM(X1, X2, OUT, INCL) do { f32x16 D; _Pragma("unroll") for (int i = 0; i < 16; ++i) D[i] = 0.f; \
            _Pragma("unroll") for (int ks = 0; ks < 4; ++ks) { const bf16x8 fa = lo16 ? *(const LAS bf16x8*)(X1 + r * SPX + 16 * ks + 8 * h) : zf, fb = lo16 ? *(const LAS bf16x8*)(X2 + r * SPX + 16 * ks + 8 * h) : zf; D = MFMA32(fa, fb, D); } \
            if (lo16) { _Pragma("unroll") for (int i = 0; i < 8; ++i) { const int t = (i & 3) + 8 * (i >> 2) + 4 * h; OUT[t * 16 + r] = (INCL ? r <= t : r < t) ? D[i] : 0.f; } } } while (0)
        SP_GRAM(XA, XB_, GB, false); SP_GRAM(XA, XK, GK, false); SP_GRAM(XR, XB_, HB, true); SP_GRAM(XR, XK, HK, true);
#undef SP_GRAM
        WSYNC();
        { const int cc = lane & 15; float n[16];
#pragma unroll
            for (int t = 0; t < 16; ++t) { float acc = t == cc ? 1.f : 0.f;
#pragma unroll
                for (int s2 = 0; s2 < t; ++s2) acc -= GB[t * 16 + s2] * n[s2];
                n[t] = acc; }
            if (lane < 16) {
#pragma unroll
                for (int t = 0; t < 16; ++t) NM[t * 16 + cc] = n[t]; } }
        if (lo16) { u32x4 w_; const LAS float* hr = HB + r * 16 + 4 * h;
            w_.x = cvtpk(hr[0], hr[1]); w_.y = cvtpk(hr[2], hr[3]); w_.z = cvtpk(hr[8], hr[9]); w_.w = cvtpk(hr[10], hr[11]); *(GAS u32x4*)(rec + 8192 + (h * 16 + r) * 16) = w_; }
        WSYNC();
        { float ap[16];
#pragma unroll
            for (int t = 0; t < 16; ++t) { float acc = 0.f;
#pragma unroll
                for (int s2 = 0; s2 <= t; ++s2) acc = fmaf(NM[t * 16 + s2], al[s2], acc);
                ap[t] = acc; }
#pragma unroll
            for (int t = 0; t < 16; ++t) XA[t * SPX + lane] = (bf16)f2bf(ap[t]); }
        WSYNC();
        if (lo16) {
#pragma unroll
            for (int ks = 0; ks < 4; ++ks) { const LAS bf16* pa = XA + r * SPX + 16 * ks + 4 * h; const LAS bf16* pr = XR + r * SPX + 16 * ks + 4 * h;
                const u32x2 a0 = *(const LAS u32x2*)pa, a1 = *(const LAS u32x2*)(pa + 8), r0 = *(const LAS u32x2*)pr, r1 = *(const LAS u32x2*)(pr + 8);
                *(GAS u32x4*)(rec + ((ks * 2 + h) * 16 + r) * 16) = (u32x4){a0.x, a0.y, a1.x, a1.y}; *(GAS u32x4*)(rec + 2048 + ((ks * 2 + h) * 16 + r) * 16) = (u32x4){r0.x, r0.y, r1.x, r1.y}; } }
        { float wq[16], p1[16], yk[16];
#pragma unroll
            for (int t = 0; t < 16; ++t) { float acc = 0.f, acy = 0.f;
#pragma unroll
                for (int s2 = 0; s2 <= t; ++s2) { if (s2 < t) acc = fmaf(GK[t * 16 + s2], vv[s2], acc); acy = fmaf(HK[t * 16 + s2], vv[s2], acy); }
                wq[t] = acc; yk[t] = acy; }
#pragma unroll
            for (int t = 0; t < 16; ++t) { float acc = 0.f;
#pragma unroll
                for (int s2 = 0; s2 <= t; ++s2) acc = fmaf(NM[t * 16 + s2], wq[s2], acc);
                p1[t] = acc; }
            GAS unsigned char* rv = rec + 9216 + h * 3072;
#pragma unroll
            for (int hq = 0; hq < 2; ++hq) { u32x4 wp, wy;
                wp.x = cvtpk(p1[4 * hq + 0], p1[4 * hq + 1]); wp.y = cvtpk(p1[4 * hq + 2], p1[4 * hq + 3]); wp.z = cvtpk(p1[8 + 4 * hq + 0], p1[8 + 4 * hq + 1]); wp.w = cvtpk(p1[8 + 4 * hq + 2], p1[8 + 4 * hq + 3]);
                wy.x = cvtpk(yk[4 * hq + 0], yk[4 * hq + 1]); wy.y = cvtpk(yk[4 * hq + 2], yk[4 * hq + 3]); wy.z = cvtpk(yk[8 + 4 * hq + 0], yk[8 + 4 * hq + 1]); wy.w = cvtpk(yk[8 + 4 * hq + 2], yk[8 + 4 * hq + 3]);
                *(GAS u32x4*)(rv + (hq * 32 + r) * 16) = wp; *(GAS u32x4*)(rv + 1024 + (hq * 32 + r) * 16) = wy; } }
        WSYNC();
    }
}
__device__ __forceinline__ void scan_seq(const Args& a, LAS unsigned char* lds, int grp, int lane) {
    OPQ_SI(grp); OPQ_V(lane);
    __builtin_amdgcn_s_setprio(3);
    unsigned char* ws = a.ws + opaque0();
    const int hd = grp % 48, vt = grp / 48, b = hd / 12, hh = hd - b * 12;
    const int r = lane & 31, h = lane >> 5; const bool lo16 = r < 16;
    LAS unsigned char* RS = lds + 16384;
    const GAS unsigned char* recs = (const GAS unsigned char*)(ws + WS_SPREC) + (size_t)hd * 256 * SPREC_BYTES;
    GAS float* yp = (GAS float*)(ws + WS_YS) + (size_t)b * SEQ * DRW + hh * 64 + 32 * vt + r;
    const bf16x8 zf = {0, 0, 0, 0, 0, 0, 0, 0};
    f32x16 T0, T1;
#pragma unroll
    for (int i = 0; i < 16; ++i) { T0[i] = 0.f; T1[i] = 0.f; }
#define SQ_DMA(slot, ck) do { const GAS unsigned char* rp_ = recs + (size_t)(ck) * SPREC_BYTES + lane * 16; LAS unsigned char* ls_ = RS + (slot) * 12288; \
        _Pragma("unroll") for (int q = 0; q < 9; ++q) __builtin_amdgcn_global_load_lds((const unsigned*)(rp_ + 1024 * q), (LAS unsigned*)(ls_ + 1024 * q), 16, 0, 0); \
        _Pragma("unroll") for (int q = 0; q < 3; ++q) __builtin_amdgcn_global_load_lds((const unsigned*)(rp_ + 9216 + 3072 * vt + 1024 * q), (LAS unsigned*)(ls_ + 9216 + 1024 * q), 16, 0, 0); } while (0)
    SQ_DMA(0, 0); SQ_DMA(1, 1);
#pragma unroll 1
    for (int ck = 0; ck < 256; ++ck) {
        const LAS unsigned char* L = RS + (ck & 1) * 12288;
        if (ck == 0) asm volatile("s_waitcnt vmcnt(12)" ::: "memory"); else if (ck + 1 < 256) asm volatile("s_waitcnt vmcnt(20)" ::: "memory"); else asm volatile("s_waitcnt vmcnt(0)" ::: "memory");
        bf16x8 tb[4];
#pragma unroll
        for (int s2 = 0; s2 < 2; ++s2) { u32x4 w0, w1;
            w0.x = cvtpk(T0[8 * s2], T0[8 * s2 + 1]); w0.y = cvtpk(T0[8 * s2 + 2], T0[8 * s2 + 3]); w0.z = cvtpk(T0[8 * s2 + 4], T0[8 * s2 + 5]); w0.w = cvtpk(T0[8 * s2 + 6], T0[8 * s2 + 7]);
            w1.x = cvtpk(T1[8 * s2], T1[8 * s2 + 1]); w1.y = cvtpk(T1[8 * s2 + 2], T1[8 * s2 + 3]); w1.z = cvtpk(T1[8 * s2 + 4], T1[8 * s2 + 5]); w1.w = cvtpk(T1[8 * s2 + 6], T1[8 * s2 + 7]);
            tb[s2] = __builtin_bit_cast(bf16x8, w0); tb[2 + s2] = __builtin_bit_cast(bf16x8, w1); }
        f32x16 aU, aY;
#pragma unroll
        for (int i = 0; i < 16; ++i) { aU[i] = 0.f; aY[i] = 0.f; }
        { const u32x4 yk = *(const LAS u32x4*)(L + 9216 + 1024 + lane * 16);
            aY[0] = __builtin_bit_cast(float, yk.x << 16); aY[1] = __builtin_bit_cast(float, yk.x & 0xffff0000u); aY[2] = __builtin_bit_cast(float, yk.y << 16); aY[3] = __builtin_bit_cast(float, yk.y & 0xffff0000u);
            aY[4] = __builtin_bit_cast(float, yk.z << 16); aY[5] = __builtin_bit_cast(float, yk.z & 0xffff0000u); aY[6] = __builtin_bit_cast(float, yk.w << 16); aY[7] = __builtin_bit_cast(float, yk.w & 0xffff0000u); }
#pragma unroll
        for (int ks = 0; ks < 4; ++ks) { const bf16x8 fa = lo16 ? *(const LAS bf16x8*)(L + ((ks * 2 + h) * 16 + r) * 16) : zf, fr = lo16 ? *(const LAS bf16x8*)(L + 2048 + ((ks * 2 + h) * 16 + r) * 16) : zf;
            aU = MFMA32(fa, tb[ks], aU); aY = MFMA32(fr, tb[ks], aY); }
        bf16x8 ub;
        { const u32x4 p1 = *(const LAS u32x4*)(L + 9216 + lane * 16); float u[8];
            u[0] = -aU[0] - __builtin_bit_cast(float, p1.x << 16); u[1] = -aU[1] - __builtin_bit_cast(float, p1.x & 0xffff0000u); u[2] = -aU[2] - __builtin_bit_cast(float, p1.y << 16); u[3] = -aU[3] - __builtin_bit_cast(float, p1.y & 0xffff0000u);
            u[4] = -aU[4] - __builtin_bit_cast(float, p1.z << 16); u[5] = -aU[5] - __builtin_bit_cast(float, p1.z & 0xffff0000u); u[6] = -aU[6] - __builtin_bit_cast(float, p1.w << 16); u[7] = -aU[7] - __builtin_bit_cast(float, p1.w & 0xffff0000u);
            u32x4 w_; w_.x = cvtpk(u[0], u[1]); w_.y = cvtpk(u[2], u[3]); w_.z = cvtpk(u[4], u[5]); w_.w = cvtpk(u[6], u[7]); ub = __builtin_bit_cast(bf16x8, w_); }
        { const bf16x8 fh = lo16 ? *(const LAS bf16x8*)(L + 8192 + (h * 16 + r) * 16) : zf; aY = MFMA32(fh, ub, aY); }
        { const bf16x8 fv = *(const LAS bf16x8*)(L + 9216 + 2048 + lane * 16);
            const bf16x8 b0 = *(const LAS bf16x8*)(L + 4096 + lane * 16), b1 = *(const LAS bf16x8*)(L + 4096 + 1024 + lane * 16), k0 = *(const LAS bf16x8*)(L + 6144 + lane * 16), k1 = *(const LAS bf16x8*)(L + 6144 + 1024 + lane * 16);
            T0 = MFMA32(b0, ub, T0); T1 = MFMA32(b1, ub, T1); T0 = MFMA32(k0, fv, T0); T1 = MFMA32(k1, fv, T1);
#pragma unroll
            for (int q = 0; q < 4; ++q) { const f32x4 g0 = *(const LAS f32x4*)(L + 8704 + (h * 16 + 4 * q) * 4), g1 = *(const LAS f32x4*)(L + 8704 + ((2 + h) * 16 + 4 * q) * 4);
                T0[4 * q] *= g0.x; T0[4 * q + 1] *= g0.y; T0[4 * q + 2] *= g0.z; T0[4 * q + 3] *= g0.w; T1[4 * q] *= g1.x; T1[4 * q + 1] *= g1.y; T1[4 * q + 2] *= g1.z; T1[4 * q + 3] *= g1.w; } }
#pragma unroll
        for (int i = 0; i < 8; ++i) yp[((size_t)ck * 16 + (i & 3) + 8 * (i >> 2) + 4 * h) * DRW] = aY[i];
        asm volatile("s_waitcnt lgkmcnt(0)" ::: "memory");
        if (ck + 2 < 256) SQ_DMA(ck & 1, ck + 2);
    }
#undef SQ_DMA
    asm volatile("s_waitcnt vmcnt(0)" ::: "memory");
    __builtin_amdgcn_s_setprio(0);
}

template <bool WITH_V> __device__ __forceinline__ void dma_tile(LAS unsigned char* RW, const bf16* Kb, int key0, unsigned koff, const bf16* Vt, unsigned voff) {
    const char* kp = (const char*)(Kb + (size_t)key0 * 64) + koff;
#pragma unroll
    for (int q = 0; q < 4; ++q) __builtin_amdgcn_global_load_lds((const unsigned*)(kp + 1024 * q), (LAS unsigned*)(RW + q * 1024), 16, 0, 0);
    if (WITH_V) { const char* vp = (const char*)(Vt + (size_t)(key0 >> 5) * 2048) + voff;
#pragma unroll
        for (int q = 0; q < 4; ++q) __builtin_amdgcn_global_load_lds((const unsigned*)(vp + 1024 * q), (LAS unsigned*)(RW + (4 + q) * 1024), 16, 0, 0); }
}
template <bool WITH_V> __device__ __forceinline__ void read_tile(const LAS unsigned char* RW, unsigned krd, unsigned vrd, bf16x8 (&kf)[4], bf16x8 (&vf)[2][2], bool younger) {
    if (younger) { if (WITH_V) asm volatile("s_waitcnt vmcnt(8)" ::: "memory"); else asm volatile("s_waitcnt vmcnt(4)" ::: "memory"); } else asm volatile("s_waitcnt vmcnt(0)" ::: "memory");
    const int rk = (krd >> 7) & 7, hh = krd & 1;
#pragma unroll
    for (int ks = 0; ks < 4; ++ks) kf[ks] = *(const LAS bf16x8*)(RW + (krd & ~1u) + (((2 * ks + hh) ^ rk) << 4));
    if (WITH_V) {
#pragma unroll
        for (int q = 0; q < 4; ++q) { const int dt = q >> 1, s = q & 1; const unsigned row = (vrd >> 6) + 32 * dt; vf[dt][s] = *(const LAS bf16x8*)(RW + 4096 + row * 64 + ((((2 * hh + s)) ^ ((row >> 2) & 3)) << 4)); } }
    asm volatile("s_waitcnt lgkmcnt(0)" ::: "memory");
}
__device__ __forceinline__ f32x16 qk_tile(const bf16x8 (&kf)[4], const bf16x8 (&qf)[4]) {
    f32x16 S;
#pragma unroll
    for (int i = 0; i < 16; ++i) S[i] = 0.f;
#pragma unroll
    for (int ks = 0; ks < 4; ++ks) S = MFMA32(kf[ks], qf[ks], S);
    return S;
}
__device__ __forceinline__ void pv_tile(const float (&p)[16], const bf16x8 (&vf)[2][2], f32x16 (&O)[2]) {
#pragma unroll
    for (int s = 0; s < 2; ++s) { u32x4 w; w.x = cvtpk(p[8 * s], p[8 * s + 1]); w.y = cvtpk(p[8 * s + 2], p[8 * s + 3]); w.z = cvtpk(p[8 * s + 4], p[8 * s + 5]); w.w = cvtpk(p[8 * s + 6], p[8 * s + 7]);
        const bf16x8 pf = __builtin_bit_cast(bf16x8, w);
#pragma unroll
        for (int dt = 0; dt < 2; ++dt) O[dt] = MFMA32(vf[dt][s], pf, O[dt]); }
}
__device__ __forceinline__ void att_rest(f32x16& S, const bf16x8 (&vf)[2][2], int key0, int h, bool masked, int klo, int khi, bool colsel, float& m, float& l, f32x16 (&O)[2]) {
    if (masked) { const int kb = key0 + 4 * h;
#pragma unroll
        for (int i = 0; i < 16; ++i) { const int key = kb + (i & 3) + 8 * (i >> 2); S[i] = (key <= khi && key >= klo) ? S[i] : -INFINITY; } }
    float tmax = fmaxf(fmaxf(fmaxf(S[0], S[1]), fmaxf(S[2], S[3])), fmaxf(fmaxf(S[4], S[5]), fmaxf(S[6], S[7])));
    tmax = fmaxf(tmax, fmaxf(fmaxf(fmaxf(S[8], S[9]), fmaxf(S[10], S[11])), fmaxf(fmaxf(S[12], S[13]), fmaxf(S[14], S[15]))));
    tmax = half_max(tmax); tmax = colsel ? tmax : -INFINITY;
    if (__builtin_amdgcn_ballot_w64(tmax > m + 8.0f) != 0ull) {
        const float mn = fmaxf(m, tmax); const float ms = mn == -INFINITY ? 0.f : mn; const float alpha = __builtin_amdgcn_exp2f(m - ms);
        l *= alpha; m = mn;
#pragma unroll
        for (int dt = 0; dt < 2; ++dt)
#pragma unroll
            for (int i = 0; i < 16; ++i) O[dt][i] *= alpha;
    }
    float msx = m == -INFINITY ? 0.f : m; msx = colsel ? msx : INFINITY;
    float p[16]; float ps = 0.f;
#pragma unroll
    for (int i = 0; i < 16; ++i) { p[i] = __builtin_amdgcn_exp2f(S[i] - msx); ps += p[i]; }
    l += half_sum(ps);
    pv_tile(p, vf, O);
}
constexpr int NSA_RING0 = 16384;
static_assert(NSA_RING0 + 8 * 16384 <= LDS_SCRATCH, "attention LDS map");
__device__ __forceinline__ void phase_nsa(const Args& a, int qi, int l, LAS unsigned char* lds, int slot, int lane) {
    OPQ_SI(slot); OPQ_V(lane);
    unsigned char* ws = a.ws + opaque0();
    LAS float* impl = (LAS float*)(lds + slot * 2048);
    LAS unsigned char* RW = lds + NSA_RING0 + slot * 16384;
    const bf16* QR = (const bf16*)(ws + WS_QR); const float* P = (const float*)(ws + WS_P); const float* gate_b = INPTR(a, I_GB) + (size_t)l * 36; bf16* CAT = (bf16*)(ws + WS_CAT);
    unsigned* qctr = (unsigned*)(ws + WS_CTL) + 8192 + 64 * qi;
    const int r = lane & 31, h = lane >> 5, g = r & 3, ql = r >> 2;
    const unsigned koff = (unsigned)((lane >> 3) * 128 + (((lane & 7) ^ ((lane >> 3) & 7)) << 4)), voff = (unsigned)((lane >> 2) * 64 + (((lane & 3) ^ (((lane >> 2) >> 2) & 3)) << 4));
    const unsigned krd = (unsigned)(r * 128) | (unsigned)h, vrd = (unsigned)(r * 64);
    const int myx = (int)(xb_xcc_id() & 7u); int qsel = 0;
    for (;;) {
        int item = 0, qx = 0;
        for (;;) { qx = (myx + qsel) & 7; if (lane == 0) item = (int)atomicAdd(qctr + 8 * qx, 1u); item = __builtin_amdgcn_readfirstlane(item); if (item < 96 * 8 || qsel >= 7) break; ++qsel; }
        if (item >= 96 * 8) break;
        const int up = item >> 3, wave = item & 7, k3 = up / 3, e3 = up - 3 * k3;
        const int bk = e3 < 2 ? qx : 8 + (qx >> 1); const int qt = e3 == 0 ? 63 - 2 * k3 : (e3 == 1 ? 62 - 2 * k3 : 62 - 2 * k3 + (qx & 1));
        const int b = bk / 3, kvh = bk - b * 3;
        const int tile0 = qt * 64, cur = qt; const int qp = tile0 + 8 * wave + ql; const size_t mq = (size_t)b * SEQ + qp; const int head = kvh * 4 + g;
        bf16x8 qf[4];
#pragma unroll
        for (int ks = 0; ks < 4; ++ks) qf[ks] = *(const bf16x8*)(QR + mq * 768 + head * 64 + 16 * ks + 8 * h);
        float g0, g1, g2;
        { const float* gl = P + mq * INP + PO_GL + head * 3; const float* gb = gate_b + head * 3; g0 = sigmoidf_(gl[0] + gb[0]); g1 = sigmoidf_(gl[1] + gb[1]); g2 = sigmoidf_(gl[2] + gb[2]); }
        f32x16 out[2], O[2]; bf16x8 kf[4]; bf16x8 vf[2][2];
#pragma unroll
        for (int dt = 0; dt < 2; ++dt)
#pragma unroll
            for (int i = 0; i < 16; ++i) out[dt][i] = 0.f;
        unsigned long long mymask = (2ull << cur) - 1ull, umask = mymask;
        const int qpw = tile0 + 8 * wave + 7;
        {
            const bf16* Kb = (const bf16*)(ws + WS_KC) + (size_t)(b * 3 + kvh) * NCMPP * 64; const bf16* Vt = (const bf16*)(ws + WS_VCT) + (size_t)(b * 3 + kvh) * 8 * 2048;
            const int nvw = qpw >= 31 ? ((qpw - 31) >> 4) + 1 : 0; const int nvq = qp >= 31 ? ((qp - 31) >> 4) + 1 : 0; const int ntile = (nvw + 31) >> 5;
            const bool need_imp = cur >= 16;
            if (ntile > 0) {
                float m = -INFINITY, ls = 0.f;
                dma_tile<false>(RW, Kb, 0, koff, Vt, voff);
#pragma unroll 1
                for (int kt = 0; kt < ntile; ++kt) { read_tile<false>(RW, krd, vrd, kf, vf, false); if (kt + 1 < ntile) dma_tile<false>(RW, Kb, 32 * (kt + 1), koff, Vt, voff); else dma_tile<true>(RW, Kb, 0, koff, Vt, voff);
                    const f32x16 S = qk_tile(kf, qf);
                    float tmax = -INFINITY; float sv[16];
#pragma unroll
                    for (int i = 0; i < 16; ++i) { const int n = 32 * kt + (i & 3) + 8 * (i >> 2) + 4 * h; sv[i] = n < nvq ? S[i] : -INFINITY; tmax = fmaxf(tmax, sv[i]); }
                    tmax = half_max(tmax); const float mn = fmaxf(m, tmax); const float ms = mn == -INFINITY ? 0.f : mn; float ps = 0.f;
#pragma unroll
                    for (int i = 0; i < 16; ++i) ps += __builtin_amdgcn_exp2f(sv[i] - ms);
                    ls = ls * __builtin_amdgcn_exp2f(m - ms) + half_sum(ps); m = mn; }
                const float ms = m == -INFINITY ? 0.f : m; const float inv = 1.0f / fmaxf(ls, 1.17549435e-38f);
                float carry = 0.f;
#pragma unroll
                for (int dt = 0; dt < 2; ++dt)
#pragma unroll
                    for (int i = 0; i < 16; ++i) O[dt][i] = 0.f;
                if (need_imp) {
#pragma unroll
                    for (int i = 0; i < 8; ++i) impl[i * 64 + lane] = 0.f;
                    WSYNC(); }
#pragma unroll 1
                for (int kt = 0; kt < ntile; ++kt) {
                    read_tile<true>(RW, krd, vrd, kf, vf, false); if (kt + 1 < ntile) dma_tile<true>(RW, Kb, 32 * (kt + 1), koff, Vt, voff);
                    const f32x16 S = qk_tile(kf, qf);
                    float p[16];
#pragma unroll
                    for (int i = 0; i < 16; ++i) { const int n = 32 * kt + (i & 3) + 8 * (i >> 2) + 4 * h; p[i] = n < nvq ? __builtin_amdgcn_exp2f(S[i] - ms) * inv : 0.f; }
                    if (need_imp) {
                        float val[4];
#pragma unroll
                        for (int t = 0; t < 4; ++t) { const float sp = 0.5f * p[4 * t + 3]; const float base = (p[4 * t] + p[4 * t + 1]) + (p[4 * t + 2] + sp); const float rv = other_half(sp, h);
                            val[t] = base + (h ? rv : carry); carry = h ? 0.f : rv; }
#pragma unroll
                        for (int t = 0; t < 4; ++t) { float v = val[t]; v += dpp_f<0xB1>(v); v += dpp_f<0x4E>(v); if (g == 0) impl[ql * 64 + 8 * kt + 2 * t + h] = v; }
                    }
                    pv_tile(p, vf, O);
                }
#pragma unroll
                for (int dt = 0; dt < 2; ++dt)
#pragma unroll
                    for (int i = 0; i < 16; ++i) out[dt][i] = O[dt][i] * g0;
                if (need_imp) {
                    WSYNC();
#pragma unroll 1
                    for (int q = 0; q < 8; ++q) { const float v = impl[q * 64 + lane]; const bool forced = lane == 0 || lane == cur || lane == cur - 1; impl[q * 64 + lane] = lane > cur ? -INFINITY : (forced ? 1e9f : v); }
                    WSYNC();
                    umask = 0ull;
#pragma unroll 1
                    for (int q = 0; q < 8; ++q) { const float sc = impl[q * 64 + lane]; int rank = 0;
#pragma unroll 4
                        for (int i4 = 0; i4 < 16; ++i4) { const f32x4 o = *(const LAS f32x4*)(impl + q * 64 + 4 * i4);
                            rank += (o.x > sc || (o.x == sc && 4 * i4 + 0 < lane)) ? 1 : 0; rank += (o.y > sc || (o.y == sc && 4 * i4 + 1 < lane)) ? 1 : 0;
                            rank += (o.z > sc || (o.z == sc && 4 * i4 + 2 < lane)) ? 1 : 0; rank += (o.w > sc || (o.w == sc && 4 * i4 + 3 < lane)) ? 1 : 0; }
                        const unsigned long long mk = __ballot(lane <= cur && rank < 16);
                        umask |= mk; if (ql == q) mymask = mk; }
                    WSYNC();
                }
            }
        }
        {
            const bf16* Kb = (const bf16*)(ws + WS_KS) + (size_t)(b * 3 + kvh) * SEQ * 64; const bf16* Vt = (const bf16*)(ws + WS_VST) + (size_t)(b * 3 + kvh) * 128 * 2048;
            float m = -INFINITY, ls = 0.f;
#pragma unroll
            for (int dt = 0; dt < 2; ++dt)
#pragma unroll
                for (int i = 0; i < 16; ++i) O[dt][i] = 0.f;
            unsigned long long um = umask; int hf = 0;
#define SEL_NEXT(have, jb, key0) do { have = um != 0ull; if (have) { jb = __builtin_ctzll(um); key0 = 64 * jb + 32 * hf; if (hf == 0 && 64 * jb + 32 <= qpw) hf = 1; else { hf = 0; um &= um - 1ull; } } } while (0)
            bool h0, h1; int j0 = 0, k0 = 0, j1 = 0, k1 = 0, sl = 0;
            SEL_NEXT(h0, j0, k0); if (h0) dma_tile<true>(RW, Kb, k0, koff, Vt, voff);
            SEL_NEXT(h1, j1, k1); if (h1) dma_tile<true>(RW + 8192, Kb, k1, koff, Vt, voff);
#pragma unroll 1
            while (h0) {
                read_tile<true>(RW + sl * 8192, krd, vrd, kf, vf, h1);
                bool h2; int j2 = 0, k2 = 0; SEL_NEXT(h2, j2, k2); if (h2) dma_tile<true>(RW + sl * 8192, Kb, k2, koff, Vt, voff);
                f32x16 S = qk_tile(kf, qf);
                att_rest(S, vf, k0, h, j0 == cur, -0x7fffffff, qp, (mymask >> j0) & 1ull, m, ls, O);
                h0 = h1; j0 = j1; k0 = k1; h1 = h2; j1 = j2; k1 = k2; sl ^= 1;
            }
#undef SEL_NEXT
            const float sc = g1 / fmaxf(ls, 1.17549435e-38f);
#pragma unroll
            for (int dt = 0; dt < 2; ++dt)
#pragma unroll
                for (int i = 0; i < 16; ++i) out[dt][i] += O[dt][i] * sc;
        }
        {
            const bf16* Kb = (const bf16*)(ws + WS_KW) + (size_t)(b * 3 + kvh) * SEQ * 64; const bf16* Vt = (const bf16*)(ws + WS_VWT) + (size_t)(b * 3 + kvh) * 128 * 2048;
            float m = -INFINITY, ls = 0.f;
#pragma unroll
            for (int dt = 0; dt < 2; ++dt)
#pragma unroll
                for (int i = 0; i < 16; ++i) O[dt][i] = 0.f;
            const int q0w = tile0 + 8 * wave; const int lo = q0w - 511 > 0 ? q0w - 511 : 0;
            const int tEnd = (q0w + 7) >> 5; int t = lo >> 5;
            dma_tile<true>(RW, Kb, 32 * t, koff, Vt, voff); if (t + 1 <= tEnd) dma_tile<true>(RW + 8192, Kb, 32 * (t + 1), koff, Vt, voff);
            int sl = 0;
#pragma unroll 1
            for (; t <= tEnd; ++t) {
                read_tile<true>(RW + sl * 8192, krd, vrd, kf, vf, t + 1 <= tEnd);
                if (t + 2 <= tEnd) dma_tile<true>(RW + sl * 8192, Kb, 32 * (t + 2), koff, Vt, voff);
                f32x16 S = qk_tile(kf, qf);
                att_rest(S, vf, 32 * t, h, !(32 * t >= q0w + 7 - 511 && 32 * t + 31 <= q0w), qp - 511, qp, true, m, ls, O);
                sl ^= 1;
            }
            const float sc = g2 / fmaxf(ls, 1.17549435e-38f);
            bf16* op = CAT + mq * DM + DRW + DPOOL + head * 64 + 4 * h;
#pragma unroll
            for (int dt = 0; dt < 2; ++dt)
#pragma unroll
                for (int t2 = 0; t2 < 4; ++t2) { u32x2 w; w.x = cvtpk(out[dt][4 * t2] + O[dt][4 * t2] * sc, out[dt][4 * t2 + 1] + O[dt][4 * t2 + 1] * sc); w.y = cvtpk(out[dt][4 * t2 + 2] + O[dt][4 * t2 + 2] * sc, out[dt][4 * t2 + 3] + O[dt][4 * t2 + 3] * sc);
                    *(u32x2*)(op + 32 * dt + 8 * t2) = w; }
        }
    }
}

__device__ __forceinline__ void phase_rwkv_out(const Args& a, int l, int gw, int NGW, int lane) {
    OPQ_SI(gw); OPQ_V(lane);
    unsigned char* ws = a.ws + opaque0(); const float* YS = (const float*)(ws + WS_YS); const float* vV = (const float*)(ws + WS_SV + 5 * SV_STRIDE); const float* vG = (const float*)(ws + WS_G); const float* SC = (const float*)(ws + WS_SC);
    const float* gng = INPTR(a, I_GNG) + (size_t)l * DRW; const float* gnb = INPTR(a, I_GNB) + (size_t)l * DRW; bf16* CAT = (bf16*)(ws + WS_CAT);
    for (int id0 = gw * 4; id0 < MTOK * 12; id0 += NGW * 4) {
        float y[4], vv[4], gg[4], bc[4]; int cc[4], mm[4]; size_t oo[4];
#pragma unroll
        for (int e = 0; e < 4; ++e) { const int id = id0 + e, m = id / 12, h = id - m * 12; cc[e] = h * 64 + lane; mm[e] = m; oo[e] = (size_t)m * DRW + cc[e]; y[e] = YS[oo[e]]; vv[e] = vV[oo[e]]; gg[e] = vG[oo[e]]; bc[e] = SC[((size_t)m * 12 + h) * 4 + 2]; }
#pragma unroll
        for (int e = 0; e < 4; ++e) { const float mean = wave_sum(y[e]) * (1.f / 64.f); const float d = y[e] - mean; const float var = wave_sum(d * d) * (1.f / 64.f);
            const float yn = d * (1.f / sqrtf(var + GN_EPS)) * gng[cc[e]] + gnb[cc[e]];
            CAT[(size_t)mm[e] * DM + cc[e]] = (bf16)f2bf((yn + bc[e] * vv[e]) * gg[e]); } }
}

#ifndef PROBE_MODE
#define PROBE_MODE 0
#endif
template <int PHMASK> __global__ void __launch_bounds__(NTHR, 2) fwd(Args args) {
    extern __shared__ __attribute__((aligned(16))) unsigned char lds_raw[];
    LAS unsigned char* lds = (LAS unsigned char*)lds_raw;
    const int tid = threadIdx.x, lane = tid & 63, wave = __builtin_amdgcn_readfirstlane(tid >> 6);
#define LANE lane
#define TID tid
    const int G = gridDim.x, bid = blockIdx.x; const int gw = bid * NWAVES + wave, NGW = G * NWAVES;
    unsigned char* ws = args.ws;
    for (int u = TID; u < (LDS_BYTES - LDS_SCRATCH) / 4; u += NTHR) ((LAS unsigned*)(lds + LDS_SCRATCH))[u] = 0u;
    __syncthreads();
    const int lo = args.ph_lo, hi = args.ph_hi;
    XcdBarrier bar; bar.bar = (unsigned*)(ws + WS_CTL) + 4096; bar.x = 0; bar.st = nullptr;
    if (hi - lo > 1) bar = xcd_barrier_post((unsigned*)(ws + WS_CTL) + 4096, (volatile LAS unsigned*)(lds + MISC_OFF) + 8);
#define IN(k) (lo <= (k) && (k) < hi)
#define PHEN(j) (((PHMASK) >> (j)) & 1)

#define SEAM(k) do { if ((k) + 1 < hi) xcd_barrier(bar); } while (0)
    bf16* XB = (bf16*)(ws + WS_XB); bf16* Hb = (bf16*)(ws + WS_H); float* Y = (float*)(ws + WS_YR); const float* AUX = (const float*)(ws + WS_AUX); float* Pm = (float*)(ws + WS_P); bf16* CAT = (bf16*)(ws + WS_CAT);

    if (PHEN(0) && IN(0)) { phase_prologue(args, bid * NTHR + TID, G * NTHR); SEAM(0); }
    for (int l = 0; l < NLAYER; ++l) {
        const int pb = 1 + 14 * l;
        for (int rep = 0; rep < (((REP_MASK) >> 1) & 1 ? 2 : 1); ++rep) if (PHEN(1) && IN(pb + 0)) { phase_wconv(args, l, lds, gw, NGW, wave, LANE); SEAM(pb + 0); }
        for (int rep = 0; rep < (((REP_MASK) >> 2) & 1 ? 2 : 1); ++rep) if (PHEN(2) && IN(pb + 1)) {
            pg8::Gemm g{XB, (const bf16*)(ws + WS_WUP1), MTOK, NUP, DM}; pg8::StaticOrder S; S.init(MTOK, NUP, G, bid); pg8::EpiSwiGLU E{Hb, DFF, AUX, 3 * l - 1, l * 2 * GWN};
            pg8::gemm_phase<pg8::EpiSwiGLU, pg8::StaticOrder, true, true>(lds, g, S, E); SEAM(pb + 1); }
        for (int rep = 0; rep < (((REP_MASK) >> 3) & 1 ? 2 : 1); ++rep) if (PHEN(3) && IN(pb + 2)) {
            pg8::Gemm g{Hb, (const bf16*)(ws + WS_WDN1), MTOK, DM, DFF}; pg8::StaticOrder S; S.init(MTOK, DM, G, bid); pg8::EpiResid E{args.rep ? (float*)(ws + WS_P + 128 * MiB) : Y, args.rep ? (bf16*)(ws + WS_P) : XB, args.rep ? ws + WS_P + 64 * MiB : (unsigned char*)Y, DM, ALPHA, 0.5f, 3 * l - 1, 3 * l};
            pg8::gemm_phase<pg8::EpiResid, pg8::StaticOrder, true, true>(lds, g, S, E); SEAM(pb + 2); }
        for (int rep = 0; rep < (((REP_MASK) >> 5) & 1 ? 2 : 1); ++rep) if (PHEN(5) && IN(pb + 4)) {
            pg8::Gemm g{XB, (const bf16*)(ws + WS_WIN), MTOK, INP, DM}; pg8::StaticOrder S; S.init(MTOK, INP, G, bid); pg8::EpiF32 E{Pm, INP, AUX, 3 * l, l * 2 * GWN + NUP};
            pg8::gemm_phase<pg8::EpiF32, pg8::StaticOrder, true, true>(lds, g, S, E); SEAM(pb + 4); }
        for (int rep = 0; rep < (((REP_MASK) >> 6) & 1 ? 2 : 1); ++rep) if (PHEN(6) && IN(pb + 5)) { phase_m1(args, l, lds, bid, G, TID, wave, LANE); SEAM(pb + 5); }
        for (int rep = 0; rep < (((REP_MASK) >> 7) & 1 ? 2 : 1); ++rep) if (PHEN(7) && IN(pb + 6)) { phase_scan_prep(args, lds, gw, NGW, wave, LANE); SEAM(pb + 6); }
        for (int rep = 0; rep < (((REP_MASK) >> 8) & 1 ? 2 : 1); ++rep) if (PHEN(8) && IN(pb + 7)) { for (int r2 = 0; r2 < (((REP_MASK) >> 20) & 1 ? 2 : 1); ++r2) { if (bid < 96 && wave == 0) scan_seq(args, lds, bid, LANE); } for (int r3 = 0; r3 < (((REP_MASK) >> 21) & 1 ? 2 : 1); ++r3) if (!(bid < 96 && wave == 1)) phase_nsa(args, l + 4 * rep + 8 * r3, l, lds, wave, LANE); SEAM(pb + 7); }
        for (int rep = 0; rep < (((REP_MASK) >> 9) & 1 ? 2 : 1); ++rep) if (PHEN(9) && IN(pb + 8)) { phase_rwkv_out(args, l, gw, NGW, LANE); SEAM(pb + 8); }
        for (int rep = 0; rep < (((REP_MASK) >> 10) & 1 ? 2 : 1); ++rep) if (PHEN(10) && IN(pb + 9)) {
            pg8::Gemm g{CAT, (const bf16*)(ws + WS_WOUT), MTOK, DM, DM}; pg8::StaticOrder S; S.init(MTOK, DM, G, bid); pg8::EpiResid E{Y, XB, (unsigned char*)Y, DM, ALPHA, 1.0f, 3 * l, 3 * l + 1};
            pg8::gemm_phase<pg8::EpiResid, pg8::StaticOrder, true, true>(lds, g, S, E); SEAM(pb + 9); }
        for (int rep = 0; rep < (((REP_MASK) >> 12) & 1 ? 2 : 1); ++rep) if (PHEN(12) && IN(pb + 11)) {
            pg8::Gemm g{XB, (const bf16*)(ws + WS_WUP2), MTOK, NUP, DM}; pg8::StaticOrder S; S.init(MTOK, NUP, G, bid); pg8::EpiSwiGLU E{Hb, DFF, AUX, 3 * l + 1, l * 2 * GWN + NUP + INP};
            pg8::gemm_phase<pg8::EpiSwiGLU, pg8::StaticOrder, true, true>(lds, g, S, E); SEAM(pb + 11); }
        for (int rep = 0; rep < (((REP_MASK) >> 13) & 1 ? 2 : 1); ++rep) if (PHEN(13) && IN(pb + 12)) {
            pg8::Gemm g{Hb, (const bf16*)(ws + WS_WDN2), MTOK, DM, DFF}; pg8::StaticOrder S; S.init(MTOK, DM, G, bid); pg8::EpiResid E{Y, XB, (unsigned char*)Y, DM, ALPHA, 0.5f, 3 * l + 1, 3 * l + 2};
            pg8::gemm_phase<pg8::EpiResid, pg8::StaticOrder, true, true>(lds, g, S, E); SEAM(pb + 12); }
        for (int rep = 0; rep < (((REP_MASK) >> 14) & 1 ? 2 : 1); ++rep) if (l == NLAYER - 1 && PHEN(14) && IN(pb + 13)) { phase_ln_final(XB, (const unsigned char*)Y, INPTR(args, I_LN3G) + (size_t)l * DM, INPTR(args, I_LN3B) + (size_t)l * DM, args.out, gw, NGW, LANE); SEAM(pb + 13); }
    }
#undef IN
#undef SEAM
}

#ifndef ONE_MASK
#define ONE_MASK 0xFFFFF
#endif
#ifndef MK_ONE_LAUNCH
#define MK_ONE_LAUNCH 1
#endif
typedef void (*kern_t)(Args);
extern "C" void kernel_launch(void* const* d_in, const int* in_sizes, int n_in, void* d_out, int out_size, void* d_ws, size_t ws_size, hipStream_t stream) {
    static int grid = 0;
#if MK_ONE_LAUNCH
    static const kern_t kerns[1] = {fwd<ONE_MASK>};
    constexpr int NK = 1;
#else
    static const kern_t kerns[15] = {fwd<1 << 0>, fwd<1 << 1>, fwd<1 << 2>, fwd<1 << 3>, fwd<1 << 4>, fwd<1 << 5>, fwd<1 << 6>, fwd<1 << 7>, fwd<1 << 8>, fwd<1 << 9>, fwd<1 << 10>, fwd<1 << 11>, fwd<1 << 12>, fwd<1 << 13>, fwd<1 << 14>};
    constexpr int NK = 15;
#endif
    if (grid == 0) {
        if (n_in != 34 || out_size != MTOK * DM || ws_size < WS_END) { fprintf(stderr, "kernel_launch: unexpected shapes (n_in %d, out %d, ws %zu; need ws >= %zu)\n", n_in, out_size, ws_size, (size_t)WS_END); grid = -1; return; }
        int dev = 0, cus = 0;
        if (hipGetDevice(&dev) != hipSuccess || hipDeviceGetAttribute(&cus, hipDeviceAttributeMultiprocessorCount, dev) != hipSuccess) { grid = -1; return; }
        for (int i = 0; i < NK; ++i) if (hipFuncSetAttribute((const void*)kerns[i], hipFuncAttributeMaxDynamicSharedMemorySize, LDS_BYTES) != hipSuccess) { fprintf(stderr, "kernel_launch: hipFuncSetAttribute failed\n"); grid = -1; return; }
        int per_cu = 0;
        if (hipOccupancyMaxActiveBlocksPerMultiprocessor(&per_cu, (const void*)kerns[0], NTHR, LDS_BYTES) != hipSuccess || per_cu < 1) fprintf(stderr, "kernel_launch: occupancy query says %d blocks per CU\n", per_cu);
        (void)hipGetLastError();
        grid = cus;
    }
    if (grid < 0) return;
    (void)hipMemsetAsync((char*)d_ws + WS_CTL, 0, CTL_ZERO_BYTES, stream);
    (void)hipMemsetAsync((char*)d_ws + WS_AUX, 0, AUX_ZERO_BYTES, stream);
    Args a{};
    for (int i = 0; i < 34; ++i) a.in[i] = (const float*)d_in[i];
    a.out = (float*)d_out; a.ws = (unsigned char*)d_ws;
#if MK_ONE_LAUNCH
    a.ph_lo = 0; a.ph_hi = NPH;
    hipLaunchKernelGGL(kerns[0], dim3(grid), dim3(NTHR), LDS_BYTES, stream, a);
#else
#ifndef HOST_REP
#define HOST_REP 0
#endif
    for (int k = 0; k < NPH; ++k) { a.ph_lo = k; a.ph_hi = k + 1; const int j = k == 0 ? 0 : (k - 1) % 14 + 1;
        for (int rep = 0; rep < (((HOST_REP) >> j) & 1 ? 2 : 1); ++rep) {
            if (rep && j == 8) (void)hipMemsetAsync((char*)d_ws + WS_CTL + (8192 + 64 * ((k - 1) / 14)) * 4, 0, 256, stream);
            a.rep = rep; hipLaunchKernelGGL(kerns[j], dim3(grid), dim3(NTHR), LDS_BYTES, stream, a); } }
#endif
}
```

```cpp
#include <hip/hip_runtime.h>
#include <cstdio>
#include <cstdint>
__device__ __forceinline__ int lane_now() { unsigned m = ~0u; asm volatile("" : "+s"(m)); return (int)__builtin_amdgcn_mbcnt_hi(m, __builtin_amdgcn_mbcnt_lo(m, 0u)); }
namespace pg8 {
#define PG8_LAS __attribute__((address_space(3)))
typedef unsigned short bf16_t;
typedef short bf16x8 __attribute__((ext_vector_type(8)));
typedef float f32x4 __attribute__((ext_vector_type(4)));
typedef unsigned u32x4 __attribute__((ext_vector_type(4)));
constexpr int BM = 256, BK = 64, HALF = 128, HTB = HALF * BK * 2  , STAGE_BYTES = 8 * HTB, NXCD = 8, WGM = 8;

__host__ __device__ __forceinline__ int lds_byte(int r, int c) { const int st = (r >> 4) * 2 + (c >> 5), rr = r & 15, cc = c & 31, ob = rr * 64 + cc * 2; return st * 1024 + (ob ^ (((ob >> 9) & 1) << 5)); }
__host__ __device__ __forceinline__ void stage_rc(int b, int& R, int& C) { const int st = b / 1024, sb = b % 1024, swz = sb ^ (((sb >> 9) & 1) << 5); R = (st >> 1) * 16 + swz / 64; C = (st & 1) * 32 + (swz % 64) / 2; }
__host__ __device__ __forceinline__ int perm32(int rho) { const int n = rho >> 4, i = rho & 15; return 8 * (i >> 2) + 4 * n + (i & 3); }

struct Unit { int pm, pn; };
struct Gemm { const bf16_t* A; const bf16_t* Bt; int M, N, K; };

struct StaticOrder {
    int nM, nN, nwg, G, c;
    __host__ __device__ void init(int M, int N, int G_, int c_) { nM = M / BM; nN = N / BM; nwg = nM * nN; G = G_; c = c_; }
    __host__ __device__ bool next(int i, Unit& u) const {
        const long L = (long)i * G + c; if (L >= nwg) return false;
        int wgid = (int)L; { const int q = nwg / NXCD, r = nwg % NXCD, xcd = wgid % NXCD, off = wgid / NXCD; wgid = (xcd < r ? xcd * (q + 1) : r * (q + 1) + (xcd - r) * q) + off; }
        const int nig = WGM * nN, gid = wgid / nig, fm = gid * WGM, gsz = (nM - fm) < WGM ? (nM - fm) : WGM;
        u.pm = fm + ((wgid % nig) % gsz); u.pn = (wgid % nig) / gsz; return true;
    }
    __device__ __forceinline__ void a_ready(const Unit&) const {}
    __device__ __forceinline__ void done(const Unit&) const {}
};

__device__ __forceinline__ unsigned cvt_pk_bf16(float lo, float hi) { unsigned r; asm volatile("v_cvt_pk_bf16_f32 %0, %1, %2" : "=v"(r) : "v"(lo), "v"(hi)); return r; }
typedef float f32x2 __attribute__((ext_vector_type(2)));
constexpr int A_MT = 16384, A_DM = 2048, A_GWBW = 12 * A_MT * 2, A_GWN = 27136, A_LNGB = A_GWBW + 4 * 2 * A_GWN;
#define PG8_GAS __attribute__((address_space(1)))
__device__ __forceinline__ float quad16_sum(float x) { float a = x, b = x; asm volatile("s_nop 1\n\tv_permlane16_swap_b32 %0, %1" : "+v"(a), "+v"(b)); float y = a + b, c = y, d = y; asm volatile("s_nop 1\n\tv_permlane32_swap_b32 %0, %1" : "+v"(c), "+v"(d)); return c + d; }
template <class T> __device__ __forceinline__ PG8_GAS T* uni_ptr(T* p) { const unsigned long long v = (unsigned long long)p; const unsigned lo = __builtin_amdgcn_readfirstlane((unsigned)v), hi = __builtin_amdgcn_readfirstlane((unsigned)(v >> 32)); return (PG8_GAS T*)(((unsigned long long)hi << 32) | lo); }
__device__ __forceinline__ f32x2 ln_stats(const float* aux, int q, int row) { const f32x2 s = *(const f32x2*)(aux + ((size_t)q * A_MT + row) * 2); const float mean = s.x * (1.0f / A_DM);
    const float var = s.y * (1.0f / A_DM) - mean * mean; return (f32x2){mean, 1.0f / sqrtf(var + 1e-5f)}; }
struct EpiSwiGLU {
    static constexpr bool PERM = true, AFTER_DRAIN = false, PREFETCH = true;
    bf16_t* H; int ldh; const float* aux; int q, gwo;
    __device__ __forceinline__ void prefetch(const Unit& u, PG8_LAS unsigned char* xl, int wid, int lane) const {
        const int w = wid & 3, qq = q < 0 ? 0 : q; const PG8_GAS float* au = uni_ptr(aux);
        const PG8_GAS float* src = w < 2 ? au + ((size_t)qq * A_MT + u.pm * BM) * 2 + (w * 64 + lane) * 4
                                         : au + A_GWBW + gwo + (w == 3 ? A_GWN : 0) + (lane >= 32 ? 5504 : 0) + u.pn * HALF + (lane & 31) * 4;
        __builtin_amdgcn_global_load_lds((const unsigned*)src, (PG8_LAS unsigned*)(xl + wid * 1024), 16, 0, 0);
    }
    __device__ __forceinline__ void operator()(const f32x4 (&acc)[2][2][4][2], const Unit& u, int wr, int wc, int fr, int fq, PG8_LAS unsigned char* xl) const {
        const int row0 = u.pm * BM + wr * 64 + fr, col0 = u.pn * HALF + wc * 32 + 8 * fq;
        f32x4 ga[2], gb[2], ba[2], bb[2]; f32x2 sr[8];
#pragma unroll
        for (int n = 0; n < 2; ++n) { ga[n] = (f32x4){0.f, 0.f, 0.f, 0.f}; gb[n] = ga[n]; ba[n] = ga[n]; bb[n] = ga[n]; }
#pragma unroll
        for (int k = 0; k < 8; ++k) sr[k] = (f32x2){0.f, (float)A_DM * (1.0f - 1e-5f)};
        if (q >= 0) { const PG8_LAS float* cv = (const PG8_LAS float*)(xl + 2048) + wc * 32 + 8 * fq; const PG8_LAS float* rs = (const PG8_LAS float*)xl + (wr * 64 + fr) * 2;
#pragma unroll
            for (int n = 0; n < 2; ++n) { ga[n] = *(const PG8_LAS f32x4*)(cv + 4 * n); gb[n] = *(const PG8_LAS f32x4*)(cv + 128 + 4 * n); ba[n] = *(const PG8_LAS f32x4*)(cv + 256 + 4 * n); bb[n] = *(const PG8_LAS f32x4*)(cv + 384 + 4 * n); }
#pragma unroll
            for (int k = 0; k < 8; ++k) sr[k] = *(const PG8_LAS f32x2*)(rs + ((k >> 2) * HALF + (k & 3) * 16) * 2);
        }
        asm volatile("" ::: "memory");
#pragma unroll
        for (int ai = 0; ai < 2; ++ai)
#pragma unroll
            for (int m = 0; m < 4; ++m) { const int row = row0 + ai * HALF + m * 16; bf16_t* rowp = H + (size_t)row * ldh + col0;
                const float mean = sr[ai * 4 + m].x * (1.0f / A_DM), rstd = 1.0f / sqrtf(sr[ai * 4 + m].y * (1.0f / A_DM) - mean * mean + 1e-5f);
                float hv[8];
#pragma unroll
                for (int n = 0; n < 2; ++n) {
#pragma unroll
                    for (int i = 0; i < 4; ++i) { const float a = (acc[ai][0][m][n][i] - mean * ga[n][i]) * rstd + ba[n][i], b = (acc[ai][1][m][n][i] - mean * gb[n][i]) * rstd + bb[n][i];
                        const float e = __builtin_amdgcn_exp2f(a * -1.44269504089f); hv[n * 4 + i] = a * __builtin_amdgcn_rcpf(1.0f + e) * b; } }
                u32x4 w; w.x = cvt_pk_bf16(hv[0], hv[1]); w.y = cvt_pk_bf16(hv[2], hv[3]); w.z = cvt_pk_bf16(hv[4], hv[5]); w.w = cvt_pk_bf16(hv[6], hv[7]);
                *(u32x4*)rowp = w; asm volatile("" ::: "memory"); }
    }
};
struct EpiResid {
    static constexpr bool PERM = true, AFTER_DRAIN = false, PREFETCH = false;
    float* Y; bf16_t* YB; unsigned char* L8; int ldc; float alpha, s; int qp, qn;
    __device__ __forceinline__ void operator()(const f32x4 (&acc)[2][2][4][2], const Unit& u, int wr, int wc, int fr, int fq, PG8_LAS unsigned char* xl) const {
        const int urow0 = __builtin_amdgcn_readfirstlane(u.pm * BM + wr * 64), ucol0 = __builtin_amdgcn_readfirstlane(u.pn * BM + wc * 32); const unsigned lob = (unsigned)(fr * ldc + 8 * fq) * 4u;
        float al_ = alpha, sc_ = s; asm volatile("" : "+s"(al_), "+s"(sc_));
        PG8_GAS float* Yu = uni_ptr(Y); PG8_GAS bf16_t* YBu = uni_ptr(YB); PG8_GAS unsigned char* L8u = uni_ptr(L8);
        PG8_GAS float* aux = Yu + (size_t)A_MT * A_DM; const PG8_GAS float* lng = aux + A_LNGB + (size_t)(qp < 0 ? 0 : qp) * 2 * A_DM + ucol0 + 8 * fq; const PG8_GAS float* lnb = lng + A_DM;
        PG8_LAS float* wl = (PG8_LAS float*)(xl + (wr * 4 + wc) * 2048); float t1[2] = {0.f, 0.f}, t2[2] = {0.f, 0.f};
#pragma unroll
        for (int e = 0; e < 2; ++e) { const int k = 2 * fq + e, j = 16 * k + fr; f32x2 st = {0.f, 1.f};
            if (qp >= 0) { const f32x2 sr = *(const PG8_GAS f32x2*)(aux + ((size_t)qp * A_MT + urow0 + (k >> 2) * HALF + (k & 3) * 16 + fr) * 2); const float mean = sr.x * (1.0f / A_DM);
                st.x = mean; st.y = 1.0f / sqrtf(sr.y * (1.0f / A_DM) - mean * mean + 1e-5f); }
            *(PG8_LAS f32x2*)(wl + 2 * j) = st; }
        asm volatile("s_waitcnt lgkmcnt(0)" ::: "memory");
        typedef unsigned u32x2_ __attribute__((ext_vector_type(2)));
#pragma unroll
        for (int c = 0; c < 4; ++c) { const int ai = c >> 1, bj = c & 1;
            f32x4 gv[2], bv[2];
#pragma unroll
            for (int n = 0; n < 2; ++n) { gv[n] = (f32x4){1.f, 1.f, 1.f, 1.f}; bv[n] = (f32x4){0.f, 0.f, 0.f, 0.f}; }
            u32x4 xb[4]; u32x2_ xl8[4];
            if (qp >= 0) {
#pragma unroll
                for (int n = 0; n < 2; ++n) { gv[n] = *(const PG8_GAS f32x4*)(lng + bj * HALF + n * 4); bv[n] = *(const PG8_GAS f32x4*)(lnb + bj * HALF + n * 4); } }
#pragma unroll
            for (int m = 0; m < 4; ++m) { int ur = urow0 + ai * HALF + m * 16; ur = __builtin_amdgcn_readfirstlane(ur); asm volatile("" : "+s"(ur));
                const size_t eo = (size_t)ur * ldc + ucol0 + bj * HALF; xb[m] = *(const PG8_GAS u32x4*)((const PG8_GAS char*)(YBu + eo) + (lob >> 1)); xl8[m] = *(const PG8_GAS u32x2_*)(L8u + eo + (lob >> 2)); }
            asm volatile("" ::: "memory");
#pragma unroll
            for (int m = 0; m < 4; ++m) { int ur = urow0 + ai * HALF + m * 16; ur = __builtin_amdgcn_readfirstlane(ur); asm volatile("" : "+s"(ur)); const size_t uoff = (size_t)ur * ldc + ucol0 + bj * HALF;
                const int j = 16 * (ai * 4 + m) + fr; const f32x2 st = *(const PG8_LAS f32x2*)(wl + 2 * j); float p1 = 0.f, p2 = 0.f; u32x4 wb; u32x2_ wl8;
#pragma unroll
                for (int n = 0; n < 2; ++n) {
                    f32x4 xr; { const unsigned w0 = n ? xb[m].z : xb[m].x, w1 = n ? xb[m].w : xb[m].y; const int lw = (int)(n ? xl8[m].y : xl8[m].x); const f32x2 l0 = __builtin_amdgcn_cvt_pk_f32_bf8(lw, false), l1 = __builtin_amdgcn_cvt_pk_f32_bf8(lw, true);
                        xr.x = __builtin_bit_cast(float, w0 << 16) + l0.x; xr.y = __builtin_bit_cast(float, w0 & 0xffff0000u) + l0.y; xr.z = __builtin_bit_cast(float, w1 << 16) + l1.x; xr.w = __builtin_bit_cast(float, w1 & 0xffff0000u) + l1.y; }
                    const f32x4 x = (xr - st.x) * st.y * gv[n] + bv[n];
                    const f32x4 y = x * al_ + acc[ai][bj][m][n] * sc_;
                    const unsigned h0 = cvt_pk_bf16(y.x, y.y), h1 = cvt_pk_bf16(y.z, y.w);
                    int l8 = __builtin_amdgcn_cvt_pk_bf8_f32(y.x - __builtin_bit_cast(float, h0 << 16), y.y - __builtin_bit_cast(float, h0 & 0xffff0000u), 0, false);
                    l8 = __builtin_amdgcn_cvt_pk_bf8_f32(y.z - __builtin_bit_cast(float, h1 << 16), y.w - __builtin_bit_cast(float, h1 & 0xffff0000u), l8, true);
                    if (n == 0) { wb.x = h0; wb.y = h1; wl8.x = (unsigned)l8; } else { wb.z = h0; wb.w = h1; wl8.y = (unsigned)l8; }
                    p1 += (y.x + y.y) + (y.z + y.w); p2 += (y.x * y.x + y.y * y.y) + (y.z * y.z + y.w * y.w); }
                *(PG8_GAS u32x4*)((PG8_GAS char*)(YBu + uoff) + (lob >> 1)) = wb; *(PG8_GAS u32x2_*)(L8u + uoff + (lob >> 2)) = wl8;
                p1 = quad16_sum(p1); p2 = quad16_sum(p2); const bool mine = fq == ((ai * 4 + m) >> 1);
                t1[m & 1] += mine ? p1 : 0.f; t2[m & 1] += mine ? p2 : 0.f; }
            asm volatile("" ::: "memory"); }
#pragma unroll
        for (int e = 0; e < 2; ++e) { const int k = 2 * fq + e;
            PG8_GAS float* sp = aux + ((size_t)qn * A_MT + urow0 + (k >> 2) * HALF + (k & 3) * 16 + fr) * 2;
            __hip_atomic_fetch_add(sp, __builtin_rintf(t1[e] * 1024.0f) * (1.0f / 1024.0f), __ATOMIC_RELAXED, __HIP_MEMORY_SCOPE_AGENT); __hip_atomic_fetch_add(sp + 1, __builtin_rintf(t2[e] * 64.0f) * (1.0f / 64.0f), __ATOMIC_RELAXED, __HIP_MEMORY_SCOPE_AGENT); }
        asm volatile("s_waitcnt lgkmcnt(0)" ::: "memory");
    }
};
struct EpiF32 {
    static constexpr bool PERM = false, AFTER_DRAIN = false, PREFETCH = true;
    float* C; int ldc; const float* aux; int q, gwo;
    __device__ __forceinline__ void prefetch(const Unit& u, PG8_LAS unsigned char* xl, int wid, int lane) const {
        const int w = wid & 3; const PG8_GAS float* au = uni_ptr(aux);
        const PG8_GAS float* src = w < 2 ? au + ((size_t)q * A_MT + u.pm * BM) * 2 + (w * 64 + lane) * 4 : au + A_GWBW + gwo + (w == 3 ? A_GWN : 0) + u.pn * BM + lane * 4;
        __builtin_amdgcn_global_load_lds((const unsigned*)src, (PG8_LAS unsigned*)(xl + wid * 1024), 16, 0, 0);
    }
    __device__ __forceinline__ void operator()(const f32x4 (&acc)[2][2][4][2], const Unit& u, int wr, int wc, int fr, int fq, PG8_LAS unsigned char* xl) const {
        const int row0 = u.pm * BM + wr * 64 + fr, col0 = u.pn * BM + wc * 32 + 4 * fq;
        const PG8_LAS float* cv = (const PG8_LAS float*)(xl + 2048) + wc * 32 + 4 * fq; const PG8_LAS float* rs = (const PG8_LAS float*)xl + (wr * 64 + fr) * 2;
        f32x4 g4[2][2], b4[2][2]; f32x2 sr[8];
#pragma unroll
        for (int bj = 0; bj < 2; ++bj)
#pragma unroll
            for (int n = 0; n < 2; ++n) { g4[bj][n] = *(const PG8_LAS f32x4*)(cv + bj * HALF + n * 16); b4[bj][n] = *(const PG8_LAS f32x4*)(cv + 256 + bj * HALF + n * 16); }
#pragma unroll
        for (int k = 0; k < 8; ++k) sr[k] = *(const PG8_LAS f32x2*)(rs + ((k >> 2) * HALF + (k & 3) * 16) * 2);
        asm volatile("" ::: "memory");
#pragma unroll
        for (int ai = 0; ai < 2; ++ai)
#pragma unroll
            for (int m = 0; m < 4; ++m) { const int row = row0 + ai * HALF + m * 16; float* rowp = C + (size_t)row * ldc + col0;
                const float mean = sr[ai * 4 + m].x * (1.0f / A_DM), rstd = 1.0f / sqrtf(sr[ai * 4 + m].y * (1.0f / A_DM) - mean * mean + 1e-5f);
#pragma unroll
                for (int bj = 0; bj < 2; ++bj)
#pragma unroll
                    for (int n = 0; n < 2; ++n) *(f32x4*)(rowp + bj * HALF + n * 16) = (acc[ai][bj][m][n] - g4[bj][n] * mean) * rstd + b4[bj][n];
                asm volatile("" ::: "memory"); }
    }
};

template <class Epi, class Sched, bool ALIGN_EPI = false, bool SP2 = false>
__device__ __forceinline__ void gemm_phase(PG8_LAS unsigned char* lds, const Gemm g, const Sched& S, const Epi& E, int wave_u) {
    int tid_ = wave_u * 64 + lane_now(); asm volatile("" : "+v"(tid_));
    const int tid = tid_, wid = __builtin_amdgcn_readfirstlane(tid >> 6), lane = tid & 63, wr = wid >> 2, wc = wid & 3, fr = lane & 15, fq = lane >> 4;
    const int K = g.K, nt = K / BK;
    unsigned voffA[2], voffB[2];
#pragma unroll
    for (int i = 0; i < 2; ++i) { int R, C; stage_rc(tid * 16 + i * 8192, R, C); const int Rb = Epi::PERM ? ((R & ~31) + perm32(R & 31)) : R;
        voffA[i] = (unsigned)(R * K + C) * 2u; voffB[i] = (unsigned)(Rb * K + C) * 2u; }
    const size_t kstep = (size_t)(BK * 2);
    const size_t hstep = (size_t)HALF * K * 2;
    const size_t tstep = 2 * hstep;
    const unsigned ldsw = (unsigned)wid * 1024u;
    const int aoff = lds_byte(wr * 64 + fr, fq * 8), boff = lds_byte(wc * 32 + fr, fq * 8);
#define PG8_SA(b, h) (((b) * 2 + (h)) * HTB)
#define PG8_SB(b, h) ((4 + (b) * 2 + (h)) * HTB)
#define PG8_STAGE(bufoff, gbase, voff) do { _Pragma("unroll") for (int _i = 0; _i < 2; ++_i) \
        __builtin_amdgcn_global_load_lds((const unsigned*)((const char*)(gbase) + (voff)[_i]), (PG8_LAS unsigned*)(lds + (bufoff) + ldsw + _i * 8192), 16, 0, 0); } while (0)
#define PG8_LDA(dst, b, h) do { _Pragma("unroll") for (int m = 0; m < 4; ++m) _Pragma("unroll") for (int k = 0; k < 2; ++k) dst[m][k] = *(const PG8_LAS bf16x8*)(lds + PG8_SA(b, h) + aoff + m * 2048 + k * 1024); } while (0)
#define PG8_LDB(dst, b, h) do { _Pragma("unroll") for (int n = 0; n < 2; ++n) _Pragma("unroll") for (int k = 0; k < 2; ++k) dst[n][k] = *(const PG8_LAS bf16x8*)(lds + PG8_SB(b, h) + boff + n * 2048 + k * 1024); } while (0)
#define PG8_MMA(ai, bj, At, Bt) do { __builtin_amdgcn_s_setprio(1); _Pragma("unroll") for (int m = 0; m < 4; ++m) _Pragma("unroll") for (int n = 0; n < 2; ++n) _Pragma("unroll") for (int k = 0; k < 2; ++k) \
        acc[ai][bj][m][n] = __builtin_amdgcn_mfma_f32_16x16x32_bf16(Bt[n][k], At[m][k], acc[ai][bj][m][n], 0, 0, 0); __builtin_amdgcn_s_setprio(0); } while (0)
#define PG8_WAIT_V(n) asm volatile("s_waitcnt vmcnt(" #n ")" ::: "memory")
#define PG8_WAIT_L(n) asm volatile("s_waitcnt lgkmcnt(" #n ")" ::: "memory")
#define PG8_BAR __builtin_amdgcn_s_barrier()
#define PG8_SCHED __builtin_amdgcn_sched_barrier(0)
    Unit cur, nxt; int ui = 0;
    if (!S.next(0, cur)) return;
    f32x4 acc[2][2][4][2];
#pragma unroll
    for (int a = 0; a < 2; ++a)
#pragma unroll
        for (int b = 0; b < 2; ++b)
#pragma unroll
            for (int m = 0; m < 4; ++m)
#pragma unroll
                for (int n = 0; n < 2; ++n) acc[a][b][m][n] = (f32x4){0.f, 0.f, 0.f, 0.f};
    bf16x8 At[4][2], B0[2][2], B1[2][2];
    const char* cA = (const char*)g.A + (size_t)cur.pm * tstep; const char* cB = (const char*)g.Bt + (size_t)cur.pn * tstep;
    S.a_ready(cur);
    if constexpr (SP2) {
        PG8_STAGE(PG8_SB(0, 0), cB, voffB); PG8_STAGE(PG8_SB(0, 1), cB + hstep, voffB); PG8_STAGE(PG8_SA(0, 0), cA, voffA); PG8_STAGE(PG8_SA(0, 1), cA + hstep, voffA);
        if (wr == 1) PG8_BAR;
        PG8_WAIT_V(2); PG8_BAR;
        PG8_STAGE(PG8_SB(1, 0), cB + kstep, voffB); PG8_STAGE(PG8_SA(1, 0), cA + kstep, voffA); PG8_STAGE(PG8_SB(1, 1), cB + hstep + kstep, voffB);
        PG8_WAIT_V(6); PG8_BAR;
    } else {
        PG8_STAGE(PG8_SB(0, 0), cB, voffB); PG8_STAGE(PG8_SA(0, 0), cA, voffA); PG8_STAGE(PG8_SB(0, 1), cB + hstep, voffB); PG8_STAGE(PG8_SA(0, 1), cA + hstep, voffA);
        if (wr == 1) PG8_BAR;
        PG8_WAIT_V(4); PG8_BAR;
        PG8_STAGE(PG8_SB(1, 0), cB + kstep, voffB); PG8_STAGE(PG8_SA(1, 0), cA + kstep, voffA); PG8_STAGE(PG8_SB(1, 1), cB + hstep + kstep, voffB);
        PG8_WAIT_V(6); PG8_BAR;
    }
    for (;;) {
        const bool has_next = S.next(ui + 1, nxt);
        const char* nA = has_next ? (const char*)g.A + (size_t)nxt.pm * tstep : cA; const char* nB = has_next ? (const char*)g.Bt + (size_t)nxt.pn * tstep : cB;
        for (int t = 0; t < nt; t += 2) {
            const bool last = (t == nt - 2);
            const char* a1 = cA + (size_t)(t + 1) * kstep;
            const char* a2 = last ? nA : cA + (size_t)(t + 2) * kstep; const char* b2 = last ? nB : cB + (size_t)(t + 2) * kstep;
            const char* a3 = a2 + kstep; const char* b3 = b2 + kstep;
            if (last && has_next) S.a_ready(nxt);
            if constexpr (Epi::PREFETCH) { if (last) E.prefetch(cur, lds + STAGE_BYTES, wid, lane); }
            if constexpr (SP2) {
            PG8_LDB(B0, 0, 0); PG8_LDB(B1, 0, 1); PG8_SCHED; PG8_LDA(At, 0, 0); PG8_STAGE(PG8_SA(1, 1), a1 + hstep, voffA);
            PG8_WAIT_V(8); PG8_WAIT_L(0); PG8_BAR; PG8_MMA(0, 0, At, B0); PG8_MMA(0, 1, At, B1); PG8_BAR; PG8_SCHED;
            PG8_LDA(At, 0, 1); PG8_STAGE(PG8_SB(0, 0), b2, voffB); PG8_STAGE(PG8_SB(0, 1), b2 + hstep, voffB); PG8_STAGE(PG8_SA(0, 0), a2, voffA);
            PG8_WAIT_V(8); PG8_WAIT_L(0); PG8_BAR; PG8_MMA(1, 0, At, B0); PG8_MMA(1, 1, At, B1); PG8_BAR; PG8_SCHED;
            PG8_LDB(B0, 1, 0); PG8_LDB(B1, 1, 1); PG8_SCHED; PG8_LDA(At, 1, 0); PG8_STAGE(PG8_SA(0, 1), a2 + hstep, voffA);
            PG8_WAIT_V(8); PG8_WAIT_L(0); PG8_BAR; PG8_MMA(0, 0, At, B0); PG8_MMA(0, 1, At, B1); PG8_BAR; PG8_SCHED;
            PG8_LDA(At, 1, 1); PG8_STAGE(PG8_SB(1, 0), b3, voffB); PG8_STAGE(PG8_SB(1, 1), b3 + hstep, voffB); PG8_STAGE(PG8_SA(1, 0), a3, voffA);
            PG8_WAIT_V(8); PG8_WAIT_L(0); PG8_BAR; PG8_MMA(1, 0, At, B0); PG8_MMA(1, 1, At, B1); PG8_BAR; PG8_SCHED;
            } else {
            PG8_LDB(B0, 0, 0); PG8_SCHED; PG8_LDA(At, 0, 0); PG8_STAGE(PG8_SA(1, 1), a1 + hstep, voffA);
            PG8_WAIT_L(8); PG8_BAR; PG8_WAIT_L(0); PG8_MMA(0, 0, At, B0); PG8_BAR; PG8_SCHED;
            PG8_LDB(B1, 0, 1); PG8_STAGE(PG8_SB(0, 0), b2, voffB);
            PG8_BAR; PG8_WAIT_L(0); PG8_MMA(0, 1, At, B1); PG8_BAR;
            PG8_LDA(At, 0, 1); PG8_STAGE(PG8_SA(0, 0), a2, voffA);
            PG8_BAR; PG8_WAIT_L(0); PG8_MMA(1, 0, At, B0); PG8_BAR; PG8_SCHED;
            PG8_STAGE(PG8_SB(0, 1), b2 + hstep, voffB);
            PG8_WAIT_V(6); PG8_BAR; PG8_MMA(1, 1, At, B1); PG8_BAR;
            PG8_LDB(B0, 1, 0); PG8_SCHED; PG8_LDA(At, 1, 0); PG8_STAGE(PG8_SA(0, 1), a2 + hstep, voffA);
            PG8_WAIT_L(8); PG8_BAR; PG8_WAIT_L(0); PG8_MMA(0, 0, At, B0); PG8_BAR; PG8_SCHED;
            PG8_LDB(B1, 1, 1); PG8_STAGE(PG8_SB(1, 0), b3, voffB);
            PG8_BAR; PG8_WAIT_L(0); PG8_MMA(0, 1, At, B1); PG8_BAR;
            PG8_LDA(At, 1, 1); PG8_STAGE(PG8_SA(1, 0), a3, voffA);
            PG8_BAR; PG8_WAIT_L(0); PG8_MMA(1, 0, At, B0); PG8_BAR; PG8_SCHED;
            PG8_STAGE(PG8_SB(1, 1), b3 + hstep, voffB);
            PG8_WAIT_V(6); PG8_BAR; PG8_MMA(1, 1, At, B1); PG8_BAR;
            }
        }
        if constexpr (ALIGN_EPI) { if (wr == 0) PG8_BAR; }
        if constexpr (!Epi::AFTER_DRAIN) { E(acc, cur, wr, wc, fr, fq, lds + STAGE_BYTES); S.done(cur); }
        if (!has_next) break;
#pragma unroll
        for (int a = 0; a < 2; ++a)
#pragma unroll
            for (int b = 0; b < 2; ++b)
#pragma unroll
                for (int m = 0; m < 4; ++m)
#pragma unroll
                    for (int n = 0; n < 2; ++n) acc[a][b][m][n] = (f32x4){0.f, 0.f, 0.f, 0.f};
        cur = nxt; cA = nA; cB = nB; ++ui;
        if constexpr (ALIGN_EPI) { if (wr == 1) PG8_BAR; }
    }
    PG8_WAIT_V(0);
    if constexpr (!ALIGN_EPI) { if (wr == 0) PG8_BAR; }
    PG8_BAR;
    if constexpr (Epi::AFTER_DRAIN) { E.fused(acc, cur, wr, wc, fr, fq, lds, wid, lane); S.done(cur); }
#undef PG8_SA
#undef PG8_SB
#undef PG8_STAGE
#undef PG8_LDA
#undef PG8_LDB
#undef PG8_MMA
#undef PG8_WAIT_V
#undef PG8_WAIT_L
#undef PG8_BAR
#undef PG8_SCHED
}
}

constexpr int NWAVES = 8, NTHR = 512;
constexpr int NB = 4, SEQ = 4096, DM = 2048, MTOK = NB * SEQ, NLAYER = 4;
constexpr int DFF = 5504, NUP = 2 * DFF;
constexpr int INC = 5028, INP = 5120;
constexpr int DRW = 768, RWC = 2560, PO_POOL = 2560, DPOOL = 512, PO_NSA = 3072;
constexpr int PO_Q = PO_NSA, PO_KC = PO_NSA + 768, PO_VC = PO_KC + 192, PO_KS = PO_VC + 192, PO_VS = PO_KS + 192, PO_KW = PO_VS + 192, PO_VW = PO_KW + 192, PO_GL = PO_VW + 192;
static_assert(PO_GL + 36 == INC, "W_in column map");
constexpr int NCMP = 255, NCMPP = 256;
constexpr float ALPHA = 1.6817928305074290f;
constexpr float LN_EPS = 1e-5f, GN_EPS = 64e-5f;
constexpr int NPH = 1 + 14 * NLAYER;

constexpr size_t MiB = 1u << 20;
constexpr size_t WS_CTL = 0, CTL_ZERO_BYTES = 1 * MiB;
constexpr size_t WS_ROPE = 1 * MiB;
constexpr size_t WS_KC = 2 * MiB, WS_VC = 2 * MiB + 512 * 1024;
constexpr size_t WS_SC = 3 * MiB;
constexpr size_t WS_WUP1 = 8 * MiB, WS_WDN1 = 51 * MiB, WS_WIN = WS_WDN1 + 21 * MiB + 512 * 1024, WS_WOUT = WS_WIN + 20 * MiB, WS_WUP2 = WS_WOUT + 8 * MiB, WS_WDN2 = WS_WUP2 + 43 * MiB;
constexpr size_t WS_XB = 165 * MiB;
static_assert(WS_WDN2 + (size_t)DM * DFF * 2 <= WS_XB, "weights map");
constexpr size_t WS_CAT = 229 * MiB;
constexpr size_t WS_QR = 293 * MiB;
constexpr size_t WS_KS = 317 * MiB, WS_KW = 323 * MiB, WS_VS = 329 * MiB, WS_VW = 335 * MiB;
constexpr size_t WS_P = 341 * MiB;
constexpr size_t WS_H = 661 * MiB;
constexpr size_t WS_Y = 833 * MiB;
constexpr size_t WS_SV = WS_H;
constexpr size_t SV_STRIDE = 48 * MiB;
static_assert(WS_SV + 6 * SV_STRIDE <= WS_Y + 128 * MiB, "scan overlay");
constexpr size_t WS_G = 961 * MiB, WS_YS = 1009 * MiB;
constexpr size_t WS_VST = 1057 * MiB, WS_VWT = 1063 * MiB;
constexpr size_t WS_VCT = 6 * MiB;
constexpr size_t WS_SW = 1069 * MiB;
constexpr size_t WS_W2T = WS_SW, WS_A2T = WS_W2T + 768 * 64 * 2, WS_G2T = WS_A2T + 768 * 64 * 2, WS_PWT = WS_G2T + 768 * 128 * 2;
constexpr size_t WS_W1T = WS_PWT + 4 * 128 * 128 * 2, WS_W2CT = WS_W1T + 2 * 256 * 2048 * 2, WS_CBIAS = WS_W2CT + 2 * 64 * 256 * 2;
constexpr size_t WS_SPREC = 1073 * MiB;
constexpr size_t SPREC_BYTES = 15360, WS_YR = WS_SPREC + (size_t)NB * 12 * 256 * SPREC_BYTES + MiB;
static_assert(true, ""); constexpr size_t WS_XL8 = WS_YR;
constexpr int GWN = NUP + INP + NUP;
constexpr size_t WS_AUX = WS_YR + 128 * MiB;
constexpr size_t AUX_ST = 0, AUX_GWBW = AUX_ST + (size_t)12 * MTOK * 2 * 4, AUX_ZERO_BYTES = AUX_GWBW + (size_t)NLAYER * 2 * GWN * 4, AUX_LNGB = (AUX_ZERO_BYTES + 255) & ~(size_t)255;
constexpr size_t WS_END = WS_AUX + AUX_LNGB + (size_t)12 * 2 * DM * 4 + MiB;
static_assert(WS_CBIAS + 2 * 256 * 4 <= WS_END, "small weights map");

constexpr int LDS_SCRATCH = 147456;
constexpr int LDS_BYTES = LDS_SCRATCH + 1024, MISC_OFF = LDS_SCRATCH + 320;

#define GAS __attribute__((address_space(1)))
#define LAS __attribute__((address_space(3)))
typedef unsigned short bf16;
typedef float f32x4 __attribute__((ext_vector_type(4)));
typedef float f32x2 __attribute__((ext_vector_type(2)));
typedef unsigned u32x4 __attribute__((ext_vector_type(4)));
typedef unsigned u32x2 __attribute__((ext_vector_type(2)));
#define LDS_WAIT() asm volatile("s_waitcnt lgkmcnt(0)" ::: "memory")
__device__ __forceinline__ unsigned f2bf(float f) { unsigned u = __builtin_bit_cast(unsigned, f); return (u + 0x7fffu + ((u >> 16) & 1u)) >> 16; }
__device__ __forceinline__ unsigned pk2(float lo, float hi) { return f2bf(lo) | (f2bf(hi) << 16); }
__device__ __forceinline__ float bf2f(unsigned short b) { return __builtin_bit_cast(float, ((unsigned)b) << 16); }
__device__ __forceinline__ float wave_sum(float v) {
#pragma unroll
    for (int o = 1; o < 64; o <<= 1) v += __shfl_xor(v, o);
    return v;
}
__device__ __forceinline__ float wave_max(float v) {
#pragma unroll
    for (int o = 1; o < 64; o <<= 1) v = fmaxf(v, __shfl_xor(v, o));
    return v;
}
__device__ __forceinline__ float sigmoidf_(float x) { return 1.0f / (1.0f + expf(-x)); }
template <int CTRL> __device__ __forceinline__ float dpp_f(float v) { return __builtin_bit_cast(float, __builtin_amdgcn_update_dpp(0, __builtin_bit_cast(int, v), CTRL, 0xF, 0xF, true)); }
__device__ __forceinline__ float row16_sum(float v) {
    v += dpp_f<0xB1>(v); v += dpp_f<0x4E>(v); v += dpp_f<0x141>(v); v += dpp_f<0x140>(v); return v;
}

#define XB_TMO      128
#define XB_XCNT(j)  (256  + 64 * (j))
#define XB_XSUB(j)  (1280 + 64 * (j))
#define XB_XGEN(j)  (2304 + 64 * (j))
#define XB_TOP      3328
#define XB_TOPGEN   3392
#define XCD_BAR_WORDS 3456
#define XB_SPIN_CAP (1u << 18)

__device__ __forceinline__ unsigned xb_ld(unsigned* p)              { return __hip_atomic_load(p, __ATOMIC_RELAXED, __HIP_MEMORY_SCOPE_AGENT); }
__device__ __forceinline__ unsigned xb_add(unsigned* p, unsigned v) { return __hip_atomic_fetch_add(p, v, __ATOMIC_RELAXED, __HIP_MEMORY_SCOPE_AGENT); }
__device__ __forceinline__ unsigned xb_xcc_id() { return (unsigned)__builtin_amdgcn_s_getreg((3 << 11) | 20) & 0xFu; }
#define XB_SPIN(cond, bar) do { unsigned _sp = 0; while (cond) { __builtin_amdgcn_s_sleep(1); \
    if ((++_sp & 255u) == 0u) { if (xb_ld(&(bar)[XB_TMO])) break; if (_sp > XB_SPIN_CAP) { atomicAdd(&(bar)[XB_TMO], 1u); break; } } } } while (0)

struct XcdBarrier {
    unsigned* bar; unsigned x; int w;
    volatile LAS unsigned* st;
};

__device__ __forceinline__ XcdBarrier xcd_barrier_post(unsigned* bar, volatile LAS unsigned* st, int w) {
    XcdBarrier b; b.bar = bar; b.x = xb_xcc_id(); b.st = st; b.w = w;
    if (w == 0 && lane_now() == 0) (void)xb_add(&bar[XB_XCNT(b.x)], 1u);
    return b;
}
__device__ __forceinline__ void xcd_barrier_complete(unsigned* bar, unsigned x, unsigned& nloc, unsigned& nx) {
    const unsigned G = gridDim.x * gridDim.y * gridDim.z;
    unsigned sum, cnt, mine, sp = 0u;
    for (;;) {
        sum = 0u; cnt = 0u; mine = 0u;
#pragma unroll
        for (unsigned j = 0; j < 16; ++j) { const unsigned c = xb_ld(&bar[XB_XCNT(j)]); sum += c; cnt += (c > 0u) ? 1u : 0u; mine = (j == x) ? c : mine; }
        if (sum == G) break;
        __builtin_amdgcn_s_sleep(1);
        if ((++sp & 255u) == 0u) { if (xb_ld(&bar[XB_TMO])) break; if (sp > XB_SPIN_CAP) { atomicAdd(&bar[XB_TMO], 1u); break; } }
    }
    nloc = mine > 0u ? mine : 1u; nx = cnt > 0u ? cnt : 1u;
}

__device__ __forceinline__ void xcd_barrier(const XcdBarrier& b) {
    asm volatile("s_waitcnt vmcnt(0)" ::: "memory");
    __syncthreads();
    if (b.w == 0 && lane_now() == 0) {
        unsigned* bar = b.bar;
        __builtin_amdgcn_s_waitcnt(0);
        unsigned nloc = b.st[0], nx = b.st[1];
        if (nloc == 0u) { xcd_barrier_complete(bar, b.x, nloc, nx); b.st[0] = nloc; b.st[1] = nx; }
        const unsigned old = xb_add(&bar[XB_XSUB(b.x)], 1u);
        const unsigned gen = old / nloc;
        if (old + 1u == (gen + 1u) * nloc) {
            __builtin_amdgcn_fence(__ATOMIC_RELEASE, "agent");
            asm volatile("s_waitcnt vmcnt(0)" ::: "memory");
            const unsigned og = xb_add(&bar[XB_TOP], 1u);
            const unsigned tg = og / nx;
            if (og + 1u == (tg + 1u) * nx) xb_add(&bar[XB_TOPGEN], 1u);
            else XB_SPIN(xb_ld(&bar[XB_TOPGEN]) == tg, bar);
            __builtin_amdgcn_fence(__ATOMIC_ACQUIRE, "agent");
            xb_add(&bar[XB_XGEN(b.x)], 1u);
            asm volatile("s_waitcnt vmcnt(0)" ::: "memory");
        } else {
            XB_SPIN(xb_ld(&bar[XB_XGEN(b.x)]) == gen, bar);
            __builtin_amdgcn_fence(__ATOMIC_ACQUIRE, "agent");
            asm volatile("s_waitcnt vmcnt(0)" ::: "memory");
        }
    }
    __syncthreads();
}

struct Args { const float* in[34]; float* out; unsigned char* ws; int ph_lo, ph_hi, rep; };
__device__ __forceinline__ int opaque0() { int z = 0; asm volatile("" : "+s"(z)); return z; }
#define OPQ_S(x) asm volatile("" : "+s"(x))
#define OPQ_SI(x) do { (x) = __builtin_amdgcn_readfirstlane(x); asm volatile("" : "+s"(x)); } while (0)
#define OPQ_V(x) asm volatile("" : "+v"(x))
#define INPTR(a, idx) ((a).in[(idx) + opaque0()])
enum { I_X = 0, I_UP1, I_DN1, I_LN1G, I_LN1B, I_WIN, I_MU, I_W0, I_W2, I_A0, I_A2, I_G2, I_KK, I_KA, I_RK, I_GNG, I_GNB, I_PW, I_PB, I_PS, I_PEK, I_PEV, I_CK1, I_CK2, I_CV1, I_CV2, I_GB, I_WOUT, I_LN2G, I_LN2B, I_UP2, I_DN2, I_LN3G, I_LN3B };

template <bool LN = false> __device__ __forceinline__ void transpose_item(const float* W, int K, int Nsrc, bf16* WT, int dst0, LAS float* scr, int k0, int n0, int lane, const float* lng = nullptr, const float* lnb = nullptr, float* gwp = nullptr) {
    const int c4 = lane & 15, rq = lane >> 4; const int n = n0 + 4 * c4; const bool ok = n < Nsrc;
    const float* wp = W + (size_t)(k0 + rq) * Nsrc + n;
#pragma unroll 8
    for (int i = 0; i < 16; ++i) { const f32x4 v = ok ? __builtin_nontemporal_load((const f32x4*)(wp + (size_t)(4 * i) * Nsrc)) : (f32x4){0.f, 0.f, 0.f, 0.f};
        LAS float* d = scr + (4 * i + rq) * 65 + 4 * c4; d[0] = v.x; d[1] = v.y; d[2] = v.z; d[3] = v.w; }
    const int c = lane & 7;
    f32x4 g0 = {1.f, 1.f, 1.f, 1.f}, g1 = g0, b0 = {0.f, 0.f, 0.f, 0.f}, b1 = b0;
    if constexpr (LN) { g0 = *(const f32x4*)(lng + k0 + 8 * c); g1 = *(const f32x4*)(lng + k0 + 8 * c + 4); b0 = *(const f32x4*)(lnb + k0 + 8 * c); b1 = *(const f32x4*)(lnb + k0 + 8 * c + 4); }
    LDS_WAIT();
    float mg = 0.f, mb = 0.f;
#pragma unroll
    for (int j = 0; j < 8; ++j) { const int nn = (lane >> 3) + 8 * j; const LAS float* s = scr + (8 * c) * 65 + nn;
        float v[8];
#pragma unroll
        for (int q = 0; q < 8; ++q) v[q] = s[q * 65];
        if constexpr (LN) {
            float pb = v[0] * b0.x + v[1] * b0.y + v[2] * b0.z + v[3] * b0.w + v[4] * b1.x + v[5] * b1.y + v[6] * b1.z + v[7] * b1.w;
            v[0] *= g0.x; v[1] *= g0.y; v[2] *= g0.z; v[3] *= g0.w; v[4] *= g1.x; v[5] *= g1.y; v[6] *= g1.z; v[7] *= g1.w;
            float pg = ((v[0] + v[1]) + (v[2] + v[3])) + ((v[4] + v[5]) + (v[6] + v[7]));
            pg += dpp_f<0xB1>(pg); pg += dpp_f<0x4E>(pg); pg += dpp_f<0x141>(pg); pb += dpp_f<0xB1>(pb); pb += dpp_f<0x4E>(pb); pb += dpp_f<0x141>(pb);
            mg = c == j ? pg : mg; mb = c == j ? pb : mb; }
        u32x4 o; o.x = pk2(v[0], v[1]); o.y = pk2(v[2], v[3]); o.z = pk2(v[4], v[5]); o.w = pk2(v[6], v[7]);
        *(u32x4*)(WT + (size_t)(dst0 + nn) * K + k0 + 8 * c) = o; }
    if constexpr (LN) { const int nm = n0 + (lane >> 3) + 8 * c;
        if (nm < Nsrc) {
            __hip_atomic_fetch_add((GAS float*)gwp + nm, __builtin_rintf(mg * 65536.0f) * (1.0f / 65536.0f), __ATOMIC_RELAXED, __HIP_MEMORY_SCOPE_AGENT);
            __hip_atomic_fetch_add((GAS float*)gwp + GWN + nm, __builtin_rintf(mb * 65536.0f) * (1.0f / 65536.0f), __ATOMIC_RELAXED, __HIP_MEMORY_SCOPE_AGENT); } }
    LDS_WAIT();
}
__device__ __forceinline__ int up_dst_row(int n0) { return n0 < DFF ? 256 * (n0 / 128) + (n0 % 128) : 256 * ((n0 - DFF) / 128) + 128 + ((n0 - DFF) % 128); }

__device__ __forceinline__ void phase_wconv(const Args& a, int l, LAS unsigned char* lds, int gw, int NGW, int wave, int lane) {
    OPQ_SI(gw); OPQ_SI(wave); OPQ_V(lane);
    LAS float* scr = (LAS float*)(lds + wave * 16640);
    unsigned char* ws = a.ws + opaque0();
    float* gwl = a.rep ? (float*)(ws + WS_END - MiB) : (float*)(ws + WS_AUX + AUX_GWBW) + (size_t)l * 2 * GWN;
    {
        const int gt = gw * 64 + lane; if (gt < 3 * 2 * (DM / 4)) { const int j = gt / (2 * (DM / 4)), r2 = gt - j * 2 * (DM / 4), isb = r2 / (DM / 4), c4_ = r2 - isb * (DM / 4);
            const float* src = (j == 0 ? (isb ? INPTR(a, I_LN1B) : INPTR(a, I_LN1G)) : j == 1 ? (isb ? INPTR(a, I_LN2B) : INPTR(a, I_LN2G)) : (isb ? INPTR(a, I_LN3B) : INPTR(a, I_LN3G))) + (size_t)l * DM;
            ((f32x4*)(ws + WS_AUX + AUX_LNGB))[((size_t)(3 * l + j) * 2 + isb) * (DM / 4) + c4_] = ((const f32x4*)src)[c4_]; } }
    constexpr int I_UP = (DM / 64) * (NUP / 64), I_DN = (DFF / 64) * (DM / 64), I_IN = (DM / 64) * (INP / 64), I_OUT = (DM / 64) * (DM / 64);
    constexpr int NIT = 2 * I_UP + 2 * I_DN + I_IN + I_OUT + 12 + 12 + 24 + 16 + 256 + 8;
    for (int it = gw; it < NIT; it += NGW) {
        int r = it;
        if (r < 2 * I_UP) { const int which = r / I_UP; r -= which * I_UP; const int nblk = NUP / 64, kb = r / nblk, nb = r % nblk;
            const float* W = a.in[which ? I_UP2 : I_UP1] + (size_t)l * DM * NUP; bf16* WT = (bf16*)(ws + (which ? WS_WUP2 : WS_WUP1));
            const float* lg = which ? INPTR(a, I_LN2G) + (size_t)l * DM : (l > 0 ? INPTR(a, I_LN3G) + (size_t)(l - 1) * DM : nullptr);
            const float* lb = which ? INPTR(a, I_LN2B) + (size_t)l * DM : (l > 0 ? INPTR(a, I_LN3B) + (size_t)(l - 1) * DM : nullptr);
            if (lg) transpose_item<true>(W, DM, NUP, WT, up_dst_row(64 * nb), scr, 64 * kb, 64 * nb, lane, lg, lb, gwl + (which ? NUP + INP : 0)); else transpose_item<false>(W, DM, NUP, WT, up_dst_row(64 * nb), scr, 64 * kb, 64 * nb, lane); continue; }
        r -= 2 * I_UP;
        if (r < 2 * I_DN) { const int which = r / I_DN; r -= which * I_DN; const int nblk = DM / 64, kb = r / nblk, nb = r % nblk;
            const float* W = a.in[which ? I_DN2 : I_DN1] + (size_t)l * DFF * DM; bf16* WT = (bf16*)(ws + (which ? WS_WDN2 : WS_WDN1));
            transpose_item(W, DFF, DM, WT, 64 * nb, scr, 64 * kb, 64 * nb, lane); continue; }
        r -= 2 * I_DN;
        if (r < I_IN) { const int nblk = INP / 64, kb = r / nblk, nb = r % nblk;
            transpose_item<true>(INPTR(a, I_WIN) + (size_t)l * DM * INC, DM, INC, (bf16*)(ws + WS_WIN), 64 * nb, scr, 64 * kb, 64 * nb, lane, INPTR(a, I_LN1G) + (size_t)l * DM, INPTR(a, I_LN1B) + (size_t)l * DM, gwl + NUP); continue; }
        r -= I_IN;
        if (r < I_OUT) { const int nblk = DM / 64, kb = r / nblk, nb = r % nblk;
            transpose_item(INPTR(a, I_WOUT) + (size_t)l * DM * DM, DM, DM, (bf16*)(ws + WS_WOUT), 64 * nb, scr, 64 * kb, 64 * nb, lane); continue; }
        r -= I_OUT;
        if (r < 12) { transpose_item(INPTR(a, I_W2) + (size_t)l * 64 * DRW, 64, DRW, (bf16*)(ws + WS_W2T), 64 * r, scr, 0, 64 * r, lane); continue; } r -= 12;
        if (r < 12) { transpose_item(INPTR(a, I_A2) + (size_t)l * 64 * DRW, 64, DRW, (bf16*)(ws + WS_A2T), 64 * r, scr, 0, 64 * r, lane); continue; } r -= 12;
        if (r < 24) { const int kb = r / 12, nb = r % 12; transpose_item(INPTR(a, I_G2) + (size_t)l * 128 * DRW, 128, DRW, (bf16*)(ws + WS_G2T), 64 * nb, scr, 64 * kb, 64 * nb, lane); continue; } r -= 24;
        if (r < 16) { const int gi = r >> 2, q = r & 3, kb = q >> 1, nb = q & 1; transpose_item(INPTR(a, I_PW) + ((size_t)l * 4 + gi) * 128 * 128, 128, 128, (bf16*)(ws + WS_PWT) + gi * 128 * 128, 64 * nb, scr, 64 * kb, 64 * nb, lane); continue; } r -= 16;
        if (r < 256) { const int ten = r >> 7, q = r & 127, kb = q >> 2, nb = q & 3; transpose_item(INPTR(a, ten ? I_CV1 : I_CK1) + (size_t)l * 2048 * 256, 2048, 256, (bf16*)(ws + WS_W1T) + (size_t)ten * 256 * 2048, 64 * nb, scr, 64 * kb, 64 * nb, lane); continue; } r -= 256;
        { const int ten = r >> 2, kb = r & 3; transpose_item(INPTR(a, ten ? I_CV2 : I_CK2) + (size_t)l * 256 * 64, 256, 64, (bf16*)(ws + WS_W2CT) + (size_t)ten * 64 * 256, 0, scr, 64 * kb, 0, lane); }
    }
}

__device__ __forceinline__ void phase_prologue(const Args& a, int gtid, int NGT) {
    OPQ_V(gtid);
    const f32x4* x4 = (const f32x4*)INPTR(a, I_X); u32x2* xb = (u32x2*)(a.ws + WS_XB);
    int* xl8 = (int*)(a.ws + WS_XL8);
    for (size_t i = gtid; i < (size_t)MTOK * DM / 4; i += NGT) { const f32x4 v = x4[i]; u32x2 o; o.x = pk2(v.x, v.y); o.y = pk2(v.z, v.w); xb[i] = o;
        int w = __builtin_amdgcn_cvt_pk_bf8_f32(v.x - __builtin_bit_cast(float, o.x << 16), v.y - __builtin_bit_cast(float, o.x & 0xffff0000u), 0, false);
        w = __builtin_amdgcn_cvt_pk_bf8_f32(v.z - __builtin_bit_cast(float, o.y << 16), v.w - __builtin_bit_cast(float, o.y & 0xffff0000u), w, true); xl8[i] = w; }
    f32x2* rope = (f32x2*)(a.ws + WS_ROPE);
    for (int i = gtid; i < SEQ * 8; i += NGT) { const int s = i >> 3, k = i & 7;
        const float inv = powf(500000.0f, -(float)k * 0.125f); const float ang = (float)s * inv;
        const double ad = (double)ang; const double q = __builtin_rint(ad * 0.15915494309189535); const double rr = ad - q * 6.283185307179586;
        const float rf = (float)rr; rope[i] = (f32x2){cosf(rf), sinf(rf)}; }
}

__device__ __forceinline__ void phase_ln_final(const bf16* HI, const unsigned char* LO, const float* g, const float* b, float* X, int gw, int NGW, int lane) {
    OPQ_SI(gw); OPQ_V(lane);
    f32x4 gv[8], bv[8];
#pragma unroll
    for (int j = 0; j < 8; ++j) { gv[j] = ((const f32x4*)g)[64 * j + lane]; bv[j] = ((const f32x4*)b)[64 * j + lane]; }
    u32x2 nh[8]; unsigned nl[8];
    { const size_t m0 = (size_t)(gw < MTOK ? gw : 0) * DM;
#pragma unroll
        for (int j = 0; j < 8; ++j) { nh[j] = ((const u32x2*)(HI + m0))[64 * j + lane]; nl[j] = ((const unsigned*)(LO + m0))[64 * j + lane]; } }
    for (int m = gw; m < MTOK; m += NGW) {
        f32x4 v[8]; float s = 0.f;
#pragma unroll
        for (int j = 0; j < 8; ++j) { const f32x2 l0 = __builtin_amdgcn_cvt_pk_f32_bf8((int)nl[j], false), l1 = __builtin_amdgcn_cvt_pk_f32_bf8((int)nl[j], true);
            v[j].x = __builtin_bit_cast(float, nh[j].x << 16) + l0.x; v[j].y = __builtin_bit_cast(float, nh[j].x & 0xffff0000u) + l0.y; v[j].z = __builtin_bit_cast(float, nh[j].y << 16) + l1.x; v[j].w = __builtin_bit_cast(float, nh[j].y & 0xffff0000u) + l1.y; }
        { const size_t mn = (size_t)(m + NGW < MTOK ? m + NGW : m) * DM;
#pragma unroll
            for (int j = 0; j < 8; ++j) { nh[j] = ((const u32x2*)(HI + mn))[64 * j + lane]; nl[j] = ((const unsigned*)(LO + mn))[64 * j + lane]; } }
#pragma unroll
        for (int j = 0; j < 8; ++j) s += (v[j].x + v[j].y) + (v[j].z + v[j].w);
        const float mean = wave_sum(s) * (1.f / DM); float s2 = 0.f;
#pragma unroll
        for (int j = 0; j < 8; ++j) { v[j] = v[j] - mean; s2 += (v[j].x * v[j].x + v[j].y * v[j].y) + (v[j].z * v[j].z + v[j].w * v[j].w); }
        const float rstd = 1.f / sqrtf(wave_sum(s2) * (1.f / DM) + LN_EPS);
        f32x4* xr = (f32x4*)(X + (size_t)m * DM) + lane;
#pragma unroll
        for (int j = 0; j < 8; ++j) xr[64 * j] = v[j] * rstd * gv[j] + bv[j];
    }
}
__device__ __forceinline__ void phase_ln(const float* Y, const float* g, const float* b, float* X, bf16* XB, float* stats, int gw, int NGW, int lane) {
    OPQ_SI(gw); OPQ_V(lane);
    f32x4 gv[8], bv[8];
#pragma unroll
    for (int j = 0; j < 8; ++j) { gv[j] = ((const f32x4*)g)[64 * j + lane]; bv[j] = ((const f32x4*)b)[64 * j + lane]; }
    if (gw < NWAVES) { f32x4* gd = (f32x4*)(stats + 2 * MTOK) + gw * 64 + lane; gd[0] = ((const f32x4*)g)[gw * 64 + lane]; gd[512] = ((const f32x4*)b)[gw * 64 + lane]; }
    f32x4 nx[8];
    { const f32x4* yr0 = (const f32x4*)(Y + (size_t)(gw < MTOK ? gw : 0) * DM) + lane;
#pragma unroll
        for (int j = 0; j < 8; ++j) nx[j] = yr0[64 * j]; }
    for (int m = gw; m < MTOK; m += NGW) {
        f32x4 v[8]; float s = 0.f;
#pragma unroll
        for (int j = 0; j < 8; ++j) v[j] = nx[j];
        { const int mn = m + NGW < MTOK ? m + NGW : m; const f32x4* yrn = (const f32x4*)(Y + (size_t)mn * DM) + lane;
#pragma unroll
            for (int j = 0; j < 8; ++j) nx[j] = yrn[64 * j]; }
#pragma unroll
        for (int j = 0; j < 8; ++j) s += (v[j].x + v[j].y) + (v[j].z + v[j].w);
        const float mean = wave_sum(s) * (1.f / DM); float s2 = 0.f;
#pragma unroll
        for (int j = 0; j < 8; ++j) { v[j] = v[j] - mean; s2 += (v[j].x * v[j].x + v[j].y * v[j].y) + (v[j].z * v[j].z + v[j].w * v[j].w); }
        const float rstd = 1.f / sqrtf(wave_sum(s2) * (1.f / DM) + LN_EPS);
        if (lane == 0) *(f32x2*)(stats + 2 * (size_t)m) = (f32x2){mean, rstd};
        u32x2* xb = (u32x2*)(XB + (size_t)m * DM) + lane;
        if (X) { f32x4* xr = (f32x4*)(X + (size_t)m * DM) + lane;
#pragma unroll
            for (int j = 0; j < 8; ++j) { const f32x4 o = v[j] * rstd * gv[j] + bv[j]; xr[64 * j] = o; } }
#pragma unroll
        for (int j = 0; j < 8; ++j) { const f32x4 o = v[j] * rstd * gv[j] + bv[j]; u32x2 w; w.x = pk2(o.x, o.y); w.y = pk2(o.z, o.w); xb[64 * j] = w; }
    }
}


typedef float f32x16 __attribute__((ext_vector_type(16)));
typedef short bf16x8 __attribute__((ext_vector_type(8)));
#define MFMA32(a, b, c) __builtin_amdgcn_mfma_f32_32x32x16_bf16((a), (b), (c), 0, 0, 0)
#define WSYNC() asm volatile("s_waitcnt lgkmcnt(0)" ::: "memory")
__device__ __forceinline__ void half_swap(float x, float& lo, float& hi) { float a = x, b = x; asm volatile("s_nop 1\n\tv_permlane32_swap_b32 %0, %1" : "+v"(a), "+v"(b)); lo = a; hi = b; }
__device__ __forceinline__ float half_max(float x) { float lo, hi; half_swap(x, lo, hi); return fmaxf(lo, hi); }
__device__ __forceinline__ float half_sum(float x) { float lo, hi; half_swap(x, lo, hi); return lo + hi; }
__device__ __forceinline__ float other_half(float x, int h) { float lo, hi; half_swap(x, lo, hi); return h ? lo : hi; }
__device__ __forceinline__ unsigned cvtpk(float lo, float hi) { unsigned r; asm volatile("v_cvt_pk_bf16_f32 %0, %1, %2" : "=v"(r) : "v"(lo), "v"(hi)); return r; }
__device__ __forceinline__ float half32_sum(float v) { v = row16_sum(v); float a = v, b = v; asm volatile("s_nop 1\n\tv_permlane16_swap_b32 %0, %1" : "+v"(a), "+v"(b)); return a + b; }
__device__ __forceinline__ int vt_pos(int k) { return 16 * ((k >> 2) & 1) + 8 * (k >> 4) + 4 * ((k >> 3) & 1) + (k & 3); }
__device__ __forceinline__ float fexp(float x) { return __builtin_amdgcn_exp2f(x * 1.4426950408889634f); }
__device__ __forceinline__ float fsigmoid(float x) { return __builtin_amdgcn_rcpf(1.0f + __builtin_amdgcn_exp2f(x * -1.4426950408889634f)); }
__device__ __forceinline__ float ftanh(float x) { const float xc = fminf(fmaxf(x, -15.f), 15.f); return 1.0f - 2.0f * __builtin_amdgcn_rcpf(1.0f + __builtin_amdgcn_exp2f(xc * 2.8853900817779268f)); }
__device__ __forceinline__ float fsoftplus(float z) { return z > 20.f ? z : __builtin_amdgcn_logf(1.0f + __builtin_amdgcn_exp2f(z * 1.4426950408889634f)) * 0.6931471805599453f; }

#ifndef REP_MASK
#define REP_MASK 0
#endif
#ifndef M1_PREFETCH
#define M1_PREFETCH 1
#endif
constexpr int XP = 264, ZP = 520, HP = 264;
__device__ __forceinline__ bf16x8 lds_frag(const LAS bf16* p) { return *(const LAS bf16x8*)p; }
__device__ __forceinline__ bf16x8 cvt8(const f32x4 a, const f32x4 b) { u32x4 w; w.x = cvtpk(a.x, a.y); w.y = cvtpk(a.z, a.w); w.z = cvtpk(b.x, b.y); w.w = cvtpk(b.z, b.w); return __builtin_bit_cast(bf16x8, w); }
__device__ __forceinline__ void phase_m1(const Args& a, int l, LAS unsigned char* lds, int bid, int G, int tid, int wave, int lane) {
    OPQ_SI(bid); OPQ_V(tid); OPQ_SI(wave); lane = tid & 63;
    unsigned char* ws = a.ws + opaque0(); const float* P = (const float*)(ws + WS_P);
    const int r = lane & 31, h = lane >> 5;
    const f32x2* rope = (const f32x2*)(ws + WS_ROPE);
    for (int rp1 = 0; rp1 < (((REP_MASK) >> 22) & 1 ? 2 : 1); ++rp1)
    for (int unit = bid; unit < MTOK / 64; unit += G) {
        const int t0 = unit * 64, b = t0 >> 12, s0 = t0 & (SEQ - 1);
        LAS bf16* XL = (LAS bf16*)lds;
        LAS bf16* ZL = (LAS bf16*)(lds + 64 * XP * 2);
        { const float* mu = INPTR(a, I_MU) + (size_t)l * RWC;
#pragma unroll 8
            for (int i = tid; i < 64 * 64; i += NTHR) { const int tt = i >> 6, j = 4 * (i & 63), col = 2304 + j; const int m = t0 + tt;
                const f32x4 pc = *(const f32x4*)(P + (size_t)m * INP + col); const f32x4 pp = (s0 + tt) > 0 ? *(const f32x4*)(P + (size_t)(m - 1) * INP + col) : (f32x4){0.f, 0.f, 0.f, 0.f}; const f32x4 v = pc + (pp - pc) * *(const f32x4*)(mu + col);
                float f[4];
#pragma unroll
                for (int e = 0; e < 4; ++e) f[e] = j < 64 ? ftanh(v[e]) : (j < 128 ? v[e] : fsigmoid(v[e]));
                u32x2 w; w.x = cvtpk(f[0], f[1]); w.y = cvtpk(f[2], f[3]); *(LAS u32x2*)(XL + tt * XP + j) = w; }
            {
                const int ch = tid, gi = ch >> 7, win = 2 << gi; const float* pp = P + (size_t)t0 * INP + PO_POOL + ch; float sum = 0.f;
                for (int j = 1; j < win; ++j) if (s0 - j >= 0) sum += pp[-(ptrdiff_t)j * INP];
#pragma unroll 16
                for (int tt = 0; tt < 64; ++tt) { const int s = s0 + tt; const float cur = pp[(size_t)tt * INP]; sum += cur; const int cnt = (s + 1) < win ? (s + 1) : win;
                    ZL[tt * ZP + ch] = (bf16)f2bf(sum / (float)cnt - cur); if (s - win + 1 >= 0) sum -= pp[((ptrdiff_t)tt - win + 1) * INP]; } } }
        __syncthreads();
        {
            const float* mu = INPTR(a, I_MU) + (size_t)l * RWC; const float* w0 = INPTR(a, I_W0) + (size_t)l * DRW; const float* a0 = INPTR(a, I_A0) + (size_t)l * DRW;
            const float* k_k = INPTR(a, I_KK) + (size_t)l * DRW; const float* k_a = INPTR(a, I_KA) + (size_t)l * DRW; const float* r_k = INPTR(a, I_RK) + (size_t)l * DRW;
            const bf16* W2T = (const bf16*)(ws + WS_W2T); const bf16* A2T = (const bf16*)(ws + WS_A2T); const bf16* G2T = (const bf16*)(ws + WS_G2T);
            float* vKK = (float*)(ws + WS_SV); float* vWR = (float*)(ws + WS_SV + SV_STRIDE); float* vW = (float*)(ws + WS_SV + 2 * SV_STRIDE);
            float* vKM = (float*)(ws + WS_SV + 3 * SV_STRIDE); float* vBB = (float*)(ws + WS_SV + 4 * SV_STRIDE); float* vV = (float*)(ws + WS_SV + 5 * SV_STRIDE);
            float* vG = (float*)(ws + WS_G); float* SC = (float*)(ws + WS_SC);
#pragma unroll 1
            for (int jj = 0; jj < 3; ++jj) {
                const int job = wave + 8 * jj, hd = job >> 1, th = job & 1;
                f32x16 aU[2], aA[2];
#pragma unroll
                for (int t = 0; t < 2; ++t)
#pragma unroll
                    for (int i = 0; i < 16; ++i) { aU[t][i] = 0.f; aA[t][i] = 0.f; }
                const LAS bf16* xa = XL + (32 * th + r) * XP + 8 * h;
#pragma unroll
                for (int ks = 0; ks < 4; ++ks) { const bf16x8 xt = lds_frag(xa + 16 * ks), xl = lds_frag(xa + 64 + 16 * ks);
#pragma unroll
                    for (int t = 0; t < 2; ++t) { const int c = hd * 64 + 2 * r + t;
                        aU[t] = MFMA32(xt, *(const bf16x8*)(W2T + (size_t)c * 64 + 16 * ks + 8 * h), aU[t]);
                        aA[t] = MFMA32(xl, *(const bf16x8*)(A2T + (size_t)c * 64 + 16 * ks + 8 * h), aA[t]); } }
                float pmr[2], pmk[2], pmv[2], pw0[2], pa0[2], pkk[2], pka[2], prk[2];
#pragma unroll
                for (int t = 0; t < 2; ++t) { const int c = hd * 64 + 2 * r + t; pmr[t] = mu[c]; pmk[t] = mu[768 + c]; pmv[t] = mu[1536 + c]; pw0[t] = w0[c]; pa0[t] = a0[c]; pkk[t] = k_k[c]; pka[t] = k_a[c]; prk[t] = r_k[c]; }
                const int lo_p = 4 * h * INP + hd * 64 + 2 * r, lo_s = 4 * h * DRW + hd * 64 + 2 * r;
                float ld[5][12];
#define M1_LOADROW(buf, i) do { int mr_ = t0 + 32 * th + ((i) & 3) + 8 * ((i) >> 2); OPQ_SI(mr_); const bool first_ = (s0 + 32 * th + ((i) & 3) + 8 * ((i) >> 2) + 4 * h) == 0; \
        const float* pc_ = P + (size_t)mr_ * INP + lo_p; const float* pp_ = pc_ - INP; _Pragma("unroll") for (int j = 0; j < 3; ++j) { const f32x2 v_ = __builtin_nontemporal_load((const f32x2*)(pc_ + 768 * j)); buf[j] = v_.x; buf[6 + j] = v_.y; \
        if (((i) & 3) == 0) { const f32x2 q_ = first_ ? (f32x2){0.f, 0.f} : *(const f32x2*)(pp_ + 768 * j); buf[3 + j] = q_.x; buf[9 + j] = q_.y; } } } while (0)
#if M1_PREFETCH
                M1_LOADROW(ld[0], 0); M1_LOADROW(ld[1], 1); M1_LOADROW(ld[2], 2);
#else
                M1_LOADROW(ld[0], 0);
#endif
#pragma unroll
                for (int i = 0; i < 16; ++i) {
#if M1_PREFETCH
                    if (i + 3 < 16) M1_LOADROW(ld[(i + 3) % 5], i + 3);
#else
                    if (i > 0) M1_LOADROW(ld[i % 5], i);
#endif
                    int mrow = t0 + 32 * th + (i & 3) + 8 * (i >> 2); OPQ_SI(mrow);
                    float rr[2], kv[2], vv[2], dec[2], av[2], kr[2], km[2];
                    float ss = 0.f, s1 = 0.f, s2 = 0.f, s3 = 0.f;
#pragma unroll
                    for (int t = 0; t < 2; ++t) { const float* L = ld[i % 5] + 6 * t; const float* Lp = (i & 3) == 0 ? L + 3 : ld[(i + 4) % 5] + 6 * t;
                        const float rc = L[0], kc = L[1], vc = L[2], rp = Lp[0], kp = Lp[1], vp = Lp[2];
                        rr[t] = rc + (rp - rc) * pmr[t]; kv[t] = kc + (kp - kc) * pmk[t]; vv[t] = vc + (vp - vc) * pmv[t];
                        const float uu = pw0[t] + aU[t][i]; const float z = -uu; const float sp = fsoftplus(z); dec[t] = fexp(-fexp(-sp - 0.5f));
                        av[t] = fsigmoid(pa0[t] + aA[t][i]);
                        kr[t] = kv[t] * pkk[t]; km[t] = kv[t] * (1.0f + (av[t] - 1.0f) * pka[t]);
                        ss += kr[t] * kr[t]; s1 += kr[t] * av[t] * rr[t]; s2 += km[t] * rr[t]; s3 += rr[t] * km[t] * prk[t]; }
                    ss = half32_sum(ss); s1 = half32_sum(s1); s2 = half32_sum(s2); s3 = half32_sum(s3);
                    const float invn = 1.0f / fmaxf(sqrtf(ss), 1e-12f);
                    const size_t ro = (size_t)mrow * DRW;
                    { const float kk0 = kr[0] * invn, kk1 = kr[1] * invn; const size_t so = ro + lo_s;
                        *(f32x2*)(vKK + so) = (f32x2){kk0, kk1}; *(f32x2*)(vWR + so) = (f32x2){dec[0] * rr[0], dec[1] * rr[1]}; *(f32x2*)(vW + so) = (f32x2){dec[0], dec[1]};
                        *(f32x2*)(vKM + so) = (f32x2){km[0], km[1]}; *(f32x2*)(vBB + so) = (f32x2){kk0 * av[0], kk1 * av[1]}; *(f32x2*)(vV + so) = (f32x2){vv[0], vv[1]}; }
                    if (r == 0) *(f32x4*)(SC + ((size_t)mrow * 12 + hd) * 4 + 4 * h * 48) = (f32x4){s1 * invn, s2, s3, 0.f};
                    asm volatile("" ::: "memory");
                }
#undef M1_LOADROW
                { f32x16 aG[2];
#pragma unroll
                    for (int t = 0; t < 2; ++t)
#pragma unroll
                        for (int i = 0; i < 16; ++i) aG[t][i] = 0.f;
#pragma unroll
                    for (int ks = 0; ks < 8; ++ks) { const bf16x8 xg = lds_frag(xa + 128 + 16 * ks);
#pragma unroll
                        for (int t = 0; t < 2; ++t) { const int c = hd * 64 + 2 * r + t; aG[t] = MFMA32(xg, *(const bf16x8*)(G2T + (size_t)c * 128 + 16 * ks + 8 * h), aG[t]); } }
#pragma unroll
                    for (int i = 0; i < 16; ++i) { int mrow = t0 + 32 * th + (i & 3) + 8 * (i >> 2); OPQ_SI(mrow); *(f32x2*)(vG + (size_t)mrow * DRW + lo_s) = (f32x2){aG[0][i], aG[1][i]}; } }
            }
        }
        {
            int lane_b = lane; OPQ_V(lane_b); const int r = lane_b & 31, h = lane_b >> 5;
            const int gi = wave >> 1, th = wave & 1; const bf16* PWT = (const bf16*)(ws + WS_PWT) + gi * 128 * 128;
            const float* pb = INPTR(a, I_PB) + (size_t)l * DPOOL + gi * 128; const float* psc = INPTR(a, I_PS) + (size_t)l * DPOOL + gi * 128; bf16* CAT = (bf16*)(ws + WS_CAT);
            f32x16 acc[4];
#pragma unroll
            for (int t = 0; t < 4; ++t)
#pragma unroll
                for (int i = 0; i < 16; ++i) acc[t][i] = 0.f;
            const LAS bf16* za = ZL + (32 * th + r) * ZP + gi * 128 + 8 * h;
#pragma unroll
            for (int ks = 0; ks < 8; ++ks) { const bf16x8 zf = lds_frag(za + 16 * ks);
#pragma unroll
                for (int t = 0; t < 4; ++t) acc[t] = MFMA32(zf, *(const bf16x8*)(PWT + (size_t)(4 * r + t) * 128 + 16 * ks + 8 * h), acc[t]); }
            { const f32x4 bv = *(const f32x4*)(pb + 4 * r), sv = *(const f32x4*)(psc + 4 * r);
#pragma unroll
                for (int i = 0; i < 16; ++i) { const int m = t0 + 32 * th + (i & 3) + 8 * (i >> 2) + 4 * h; u32x2 w; w.x = cvtpk((acc[0][i] + bv.x) * sv.x, (acc[1][i] + bv.y) * sv.y); w.y = cvtpk((acc[2][i] + bv.z) * sv.z, (acc[3][i] + bv.w) * sv.w);
                    *(u32x2*)(CAT + (size_t)m * DM + DRW + gi * 128 + 4 * r) = w; } }
        }
        __syncthreads();
        {
            int tid_c = tid; OPQ_V(tid_c); const int tid = tid_c;
            bf16* QR = (bf16*)(ws + WS_QR); bf16* KS = (bf16*)(ws + WS_KS); bf16* KW = (bf16*)(ws + WS_KW); bf16* VST = (bf16*)(ws + WS_VST); bf16* VWT = (bf16*)(ws + WS_VWT);
            LAS float* T0 = (LAS float*)lds; LAS float* T1 = T0 + 64 * 193;
#pragma unroll 1
            for (int c = tid; c < 1152; c += NTHR) {
                int src; float scale = 1.f; const int d = c & 63; const bool isq = c < 768; const int cc = isq ? c : (c < 960 ? c - 768 : c - 960);
                bf16* dbase;
                if (isq) { src = PO_Q + c; dbase = QR + (size_t)t0 * 768 + c; scale = 0.125f * 1.4426950408889634f; }
                else if (c < 960) { src = PO_KS + cc; dbase = KS + ((size_t)(b * 3 + (cc >> 6)) * SEQ + s0) * 64 + (cc & 63); }
                else { src = PO_KW + cc; dbase = KW + ((size_t)(b * 3 + (cc >> 6)) * SEQ + s0) * 64 + (cc & 63); }
                const int dstep = isq ? 768 : 64; const bool rot = d < 16; const int po = d < 8 ? 8 : -8; const float sg = d < 8 ? -1.f : 1.f;
                const float* pr = P + (size_t)t0 * INP + src; const f32x2* rp = rope + s0 * 8 + (d & 7);
#pragma unroll 1
                for (int t8 = 0; t8 < 64; t8 += 16) { float v[16], pv[16]; f32x2 cs[16];
#pragma unroll
                    for (int e = 0; e < 16; ++e) { v[e] = pr[(size_t)(t8 + e) * INP]; pv[e] = pr[(size_t)(t8 + e) * INP + (rot ? po : 0)]; cs[e] = rp[(t8 + e) * 8]; }
#pragma unroll
                    for (int e = 0; e < 16; ++e) { const float o = rot ? v[e] * cs[e].x + sg * pv[e] * cs[e].y : v[e]; dbase[(size_t)(t8 + e) * dstep] = (bf16)f2bf(o * scale); } } }
            if (tid < 384) { const int c = tid; const float* pr = P + (size_t)t0 * INP + (c < 192 ? PO_VS + c : PO_VW + (c - 192)); LAS float* td = c < 192 ? T0 + c : T1 + (c - 192);
#pragma unroll 1
                for (int t8 = 0; t8 < 64; t8 += 16) { float v[16];
#pragma unroll
                    for (int e = 0; e < 16; ++e) v[e] = pr[(size_t)(t8 + e) * INP];
#pragma unroll
                    for (int e = 0; e < 16; ++e) td[(t8 + e) * 193] = v[e]; } }
            __syncthreads();
            for (int i = tid; i < 384 * 64; i += NTHR) { const int c2 = i >> 6, tok = i & 63; const int which = c2 >= 192, c = which ? c2 - 192 : c2;
                const float v = (which ? T1 : T0)[tok * 193 + c]; const int sk = s0 + tok;
                bf16* dst = (which ? VWT : VST) + (((size_t)(b * 3 + (c >> 6)) * 128 + (sk >> 5)) * 64 + (c & 63)) * 32 + vt_pos(sk & 31); *dst = (bf16)f2bf(v); }
        }
        __syncthreads();
    }
    {
        int lane_d = lane; OPQ_V(lane_d); const int r = lane_d & 31, h = lane_d >> 5;
        LAS bf16* HL = (LAS bf16*)lds;
        bf16* KC = (bf16*)(ws + WS_KC); bf16* VCT = (bf16*)(ws + WS_VCT);
        for (int rp2 = 0; rp2 < (((REP_MASK) >> 23) & 1 ? 2 : 1); ++rp2)
        for (int u = bid; u < 2 * NB * 3 * 8; u += G) {
            const int ten = u / 96, q = u - ten * 96, b = q / 24, q2 = q - b * 24, hh = q2 >> 3, nt = q2 & 7, n0 = 32 * nt;
            const int cg = wave & 3, kh = wave >> 2;
            const bf16* W1T = (const bf16*)(ws + WS_W1T) + (size_t)ten * 256 * 2048 + (size_t)(64 * cg + r) * 2048 + 8 * h;
            const int tk0 = 16 * (n0 + r);
            const float* pa = P + ((size_t)b * SEQ + tk0) * INP + (ten ? PO_VC : PO_KC) + hh * 64 + 8 * h;
            LAS float* PEL = (LAS float*)(lds + 24576);
            ((LAS f32x4*)PEL)[tid] = ((const f32x4*)(INPTR(a, ten ? I_PEV : I_PEK) + (size_t)l * 2048))[tid]; __syncthreads();
            const LAS float* pep = PEL + 8 * h;
            f32x16 acc[2];
#pragma unroll
            for (int t = 0; t < 2; ++t)
#pragma unroll
                for (int i = 0; i < 16; ++i) acc[t][i] = 0.f;
            f32x4 xa[2][8]; bf16x8 wb[2][4];
#define CMP_LOAD(sl, ll) do { const bool ok_ = tk0 + (ll) < SEQ; const float* pl_ = pa + (size_t)(ll) * INP; _Pragma("unroll") for (int ds = 0; ds < 4; ++ds) { \
        xa[sl][2 * ds] = ok_ ? *(const f32x4*)(pl_ + 16 * ds) : (f32x4){0.f, 0.f, 0.f, 0.f}; xa[sl][2 * ds + 1] = ok_ ? *(const f32x4*)(pl_ + 16 * ds + 4) : (f32x4){0.f, 0.f, 0.f, 0.f}; \
        } } while (0)
#define CMP_LOADW(ll) do { _Pragma("unroll") for (int ds = 0; ds < 4; ++ds) { wb[0][ds] = *(const bf16x8*)(W1T + 64 * (ll) + 16 * ds); wb[1][ds] = *(const bf16x8*)(W1T + 32 * 2048 + 64 * (ll) + 16 * ds); } } while (0)
#define CMP_MMA(sl, ll) do { const LAS float* pe_ = pep + 64 * (ll); _Pragma("unroll") for (int ds = 0; ds < 4; ++ds) { const bf16x8 af = cvt8(xa[sl][2 * ds] + *(const LAS f32x4*)(pe_ + 16 * ds), xa[sl][2 * ds + 1] + *(const LAS f32x4*)(pe_ + 16 * ds + 4)); acc[0] = MFMA32(af, wb[0][ds], acc[0]); acc[1] = MFMA32(af, wb[1][ds], acc[1]); } } while (0)
            const int l0 = 16 * kh;
            CMP_LOAD(0, l0);
#pragma unroll 1
            for (int ll = l0; ll < l0 + 16; ll += 2) {
                CMP_LOADW(ll); CMP_LOAD(1, ll + 1);
                CMP_MMA(0, ll);
                CMP_LOADW(ll + 1); if (ll + 2 < l0 + 16) CMP_LOAD(0, ll + 2);
                CMP_MMA(1, ll + 1);
            }
#undef CMP_LOADW
#undef CMP_LOAD
#undef CMP_MMA
            { LAS float* PL = (LAS float*)(lds + 32768);
                if (kh == 1) {
#pragma unroll
                    for (int t = 0; t < 2; ++t)
#pragma unroll
                        for (int i = 0; i < 16; ++i) PL[((i & 3) + 8 * (i >> 2) + 4 * h) * 256 + 64 * cg + 32 * t + r] = acc[t][i]; }
                __syncthreads();
                if (kh == 0) {
#pragma unroll
                    for (int t = 0; t < 2; ++t)
#pragma unroll
                        for (int i = 0; i < 16; ++i) { const int row = (i & 3) + 8 * (i >> 2) + 4 * h, col = 64 * cg + 32 * t + r; const float x = acc[t][i] + PL[row * 256 + col];
                            const float gl = 0.5f * x * (1.0f + ftanh(0.7978845608028654f * (x + 0.044715f * x * x * x))); HL[row * HP + col] = (bf16)f2bf(gl); } } }
            __syncthreads();
            if (wave < 2) {
                const bf16* W2CT = (const bf16*)(ws + WS_W2CT) + (size_t)ten * 64 * 256 + (size_t)(32 * wave + r) * 256 + 8 * h;
                f32x16 o;
#pragma unroll
                for (int i = 0; i < 16; ++i) o[i] = 0.f;
                const LAS bf16* ha = HL + r * HP + 8 * h;
#pragma unroll
                for (int ks = 0; ks < 16; ++ks) o = MFMA32(lds_frag(ha + 16 * ks), *(const bf16x8*)(W2CT + 16 * ks), o);
                const int d = 32 * wave + r;
#pragma unroll
                for (int i = 0; i < 16; ++i) { const int n = n0 + (i & 3) + 8 * (i >> 2) + 4 * h; float v = o[i];
                    if (ten == 0) { const float other = dpp_f<0x128>(v);
                        if (wave == 0 && r < 16) { const f32x2 cs = rope[((16 * n + 31) & (SEQ - 1)) * 8 + (r & 7)]; v = r < 8 ? v * cs.x - other * cs.y : v * cs.x + other * cs.y; }
                        if (n < NCMP) KC[((size_t)(b * 3 + hh) * NCMPP + n) * 64 + d] = (bf16)f2bf(v); }
                    else if (n < NCMP) VCT[(((size_t)(b * 3 + hh) * 8 + (n >> 5)) * 64 + d) * 32 + vt_pos(n & 31)] = (bf16)f2bf(v); }
            }
            __syncthreads();
        }
    }
}

constexpr int SPX = 72;
__device__ __forceinline__ void phase_scan_prep(const Args& a, LAS unsigned char* lds, int gw, int NGW, int wave, int lane) {
    OPQ_SI(gw); OPQ_SI(wave); OPQ_V(lane);
    unsigned char* ws = a.ws + opaque0();
    LAS unsigned char* wl = lds + wave * 16384;
    LAS bf16* XA = (LAS bf16*)wl; LAS bf16* XR = XA + 16 * SPX; LAS bf16* XB_ = XR + 16 * SPX; LAS bf16* XK = XB_ + 16 * SPX;
    LAS float* GB = (LAS float*)(wl + 4 * 16 * SPX * 2); LAS float* GK = GB + 256; LAS float* HB = GK + 256; LAS float* HK = HB + 256; LAS float* NM = HK + 256;
    const int r = lane & 31, h = lane >> 5;
    const GAS float* vKK = (const GAS float*)(ws + WS_SV); const GAS float* vWR = (const GAS float*)(ws + WS_SV + SV_STRIDE); const GAS float* vW = (const GAS float*)(ws + WS_SV + 2 * SV_STRIDE);
    const GAS float* vKM = (const GAS float*)(ws + WS_SV + 3 * SV_STRIDE); const GAS float* vBB = (const GAS float*)(ws + WS_SV + 4 * SV_STRIDE); const GAS float* vV = (const GAS float*)(ws + WS_SV + 5 * SV_STRIDE);
#pragma unroll 1
    for (int item = gw; item < NB * 12 * 256; item += NGW) {
        const int hd = item >> 8, c = item & 255, b = hd / 12, hh = hd - b * 12;
        const size_t o0 = ((size_t)b * SEQ + 16 * c) * DRW + hh * 64 + lane;
        GAS unsigned char* rec = (GAS unsigned char*)(ws + WS_SPREC) + (size_t)item * SPREC_BYTES;
        float al[16], rh[16], be[16], ka[16], vv[16]; float g = 1.f;
#pragma unroll
        for (int t = 0; t < 16; ++t) { const size_t o = o0 + (size_t)t * DRW; const float w = vW[o], kk = vKK[o], bb = vBB[o], km = vKM[o], wr = vWR[o]; vv[t] = vV[o];
            al[t] = g * kk; rh[t] = g * wr; g *= w; const float ig = 1.0f / g; be[t] = bb * ig; ka[t] = km * ig; }
#pragma unroll
        for (int t = 0; t < 16; ++t) { XA[t * SPX + lane] = (bf16)f2bf(al[t]); XR[t * SPX + lane] = (bf16)f2bf(rh[t]); XB_[t * SPX + lane] = (bf16)f2bf(be[t]); XK[t * SPX + lane] = (bf16)f2bf(ka[t]); }
#pragma unroll
        for (int hp = 0; hp < 2; ++hp) {
            u32x4 wb, wk, wv;
            wb.x = cvtpk(be[4 * hp + 0], be[4 * hp + 1]); wb.y = cvtpk(be[4 * hp + 2], be[4 * hp + 3]); wb.z = cvtpk(be[8 + 4 * hp + 0], be[8 + 4 * hp + 1]); wb.w = cvtpk(be[8 + 4 * hp + 2], be[8 + 4 * hp + 3]);
            wk.x = cvtpk(ka[4 * hp + 0], ka[4 * hp + 1]); wk.y = cvtpk(ka[4 * hp + 2], ka[4 * hp + 3]); wk.z = cvtpk(ka[8 + 4 * hp + 0], ka[8 + 4 * hp + 1]); wk.w = cvtpk(ka[8 + 4 * hp + 2], ka[8 + 4 * hp + 3]);
            wv.x = cvtpk(vv[4 * hp + 0], vv[4 * hp + 1]); wv.y = cvtpk(vv[4 * hp + 2], vv[4 * hp + 3]); wv.z = cvtpk(vv[8 + 4 * hp + 0], vv[8 + 4 * hp + 1]); wv.w = cvtpk(vv[8 + 4 * hp + 2], vv[8 + 4 * hp + 3]);
            *(GAS u32x4*)(rec + 4096 + ((h * 2 + hp) * 32 + r) * 16) = wb; *(GAS u32x4*)(rec + 6144 + ((h * 2 + hp) * 32 + r) * 16) = wk;
            *(GAS u32x4*)(rec + 9216 + h * 3072 + 2048 + (hp * 32 + r) * 16) = wv; }
        *(GAS float*)(rec + 8704 + ((h * 2 + ((r >> 2) & 1)) * 16 + (r & 3) + 4 * (r >> 3)) * 4) = g;
        WSYNC();
        const bool lo16 = r < 16; const bf16x8 zf = {0, 0, 0, 0, 0, 0, 0, 0};
#define SP_GRAM(X1, X2, OUT, INCL) do { f32x16 D; _Pragma("unroll") for (int i = 0; i < 16; ++i) D[i] = 0.f; \
            _Pragma("unroll") for (int ks = 0; ks < 4; ++ks) { const bf16x8 fa = lo16 ? *(const LAS bf16x8*)(X1 + r * SPX + 16 * ks + 8 * h) : zf, fb = lo16 ? *(const LAS bf16x8*)(X2 + r * SPX + 16 * ks + 8 * h) : zf; D = MFMA32(fa, fb, D); } \
            if (lo16) { _Pragma("unroll") for (int i = 0; i < 8; ++i) { const int t = (i & 3) + 8 * (i >> 2) + 4 * h; OUT[t * 16 + r] = (INCL ? r <= t : r < t) ? D[i] : 0.f; } } } while (0)
        SP_GRAM(XA, XB_, GB, false); SP_GRAM(XA, XK, GK, false); SP_GRAM(XR, XB_, HB, true); SP_GRAM(XR, XK, HK, true);
#undef SP_GRAM
        WSYNC();
        { const int cc = lane & 15; float n[16];
#pragma unroll
            for (int t = 0; t < 16; ++t) { float acc = t == cc ? 1.f : 0.f;
#pragma unroll
                for (int s2 = 0; s2 < t; ++s2) acc -= GB[t * 16 + s2] * n[s2];
                n[t] = acc; }
            if (lane < 16) {
#pragma unroll
                for (int t = 0; t < 16; ++t) NM[t * 16 + cc] = n[t]; } }
        if (lo16) { u32x4 w_; const LAS float* hr = HB + r * 16 + 4 * h;
            w_.x = cvtpk(hr[0], hr[1]); w_.y = cvtpk(hr[2], hr[3]); w_.z = cvtpk(hr[8], hr[9]); w_.w = cvtpk(hr[10], hr[11]); *(GAS u32x4*)(rec + 8192 + (h * 16 + r) * 16) = w_; }
        WSYNC();
        { float ap[16];
#pragma unroll
            for (int t = 0; t < 16; ++t) { float acc = 0.f;
#pragma unroll
                for (int s2 = 0; s2 <= t; ++s2) acc = fmaf(NM[t * 16 + s2], al[s2], acc);
                ap[t] = acc; }
#pragma unroll
            for (int t = 0; t < 16; ++t) XA[t * SPX + lane] = (bf16)f2bf(ap[t]); }
        WSYNC();
        if (lo16) {
#pragma unroll
            for (int ks = 0; ks < 4; ++ks) { const LAS bf16* pa = XA + r * SPX + 16 * ks + 4 * h; const LAS bf16* pr = XR + r * SPX + 16 * ks + 4 * h;
                const u32x2 a0 = *(const LAS u32x2*)pa, a1 = *(const LAS u32x2*)(pa + 8), r0 = *(const LAS u32x2*)pr, r1 = *(const LAS u32x2*)(pr + 8);
                *(GAS u32x4*)(rec + ((ks * 2 + h) * 16 + r) * 16) = (u32x4){a0.x, a0.y, a1.x, a1.y}; *(GAS u32x4*)(rec + 2048 + ((ks * 2 + h) * 16 + r) * 16) = (u32x4){r0.x, r0.y, r1.x, r1.y}; } }
        { float wq[16], p1[16], yk[16];
#pragma unroll
            for (int t = 0; t < 16; ++t) { float acc = 0.f, acy = 0.f;
#pragma unroll
                for (int s2 = 0; s2 <= t; ++s2) { if (s2 < t) acc = fmaf(GK[t * 16 + s2], vv[s2], acc); acy = fmaf(HK[t * 16 + s2], vv[s2], acy); }
                wq[t] = acc; yk[t] = acy; }
#pragma unroll
            for (int t = 0; t < 16; ++t) { float acc = 0.f;
#pragma unroll
                for (int s2 = 0; s2 <= t; ++s2) acc = fmaf(NM[t * 16 + s2], wq[s2], acc);
                p1[t] = acc; }
            GAS unsigned char* rv = rec + 9216 + h * 3072;
#pragma unroll
            for (int hq = 0; hq < 2; ++hq) { u32x4 wp, wy;
                wp.x = cvtpk(p1[4 * hq + 0], p1[4 * hq + 1]); wp.y = cvtpk(p1[4 * hq + 2], p1[4 * hq + 3]); wp.z = cvtpk(p1[8 + 4 * hq + 0], p1[8 + 4 * hq + 1]); wp.w = cvtpk(p1[8 + 4 * hq + 2], p1[8 + 4 * hq + 3]);
                wy.x = cvtpk(yk[4 * hq + 0], yk[4 * hq + 1]); wy.y = cvtpk(yk[4 * hq + 2], yk[4 * hq + 3]); wy.z = cvtpk(yk[8 + 4 * hq + 0], yk[8 + 4 * hq + 1]); wy.w = cvtpk(yk[8 + 4 * hq + 2], yk[8 + 4 * hq + 3]);
                *(GAS u32x4*)(rv + (hq * 32 + r) * 16) = wp; *(GAS u32x4*)(rv + 1024 + (hq * 32 + r) * 16) = wy; } }
        WSYNC();
    }
}
__device__ __forceinline__ void scan_seq(const Args& a, LAS unsigned char* lds, int grp, int lane) {
    OPQ_SI(grp); OPQ_V(lane);
    __builtin_amdgcn_s_setprio(3);
    unsigned char* ws = a.ws + opaque0();
    const int hd = grp % 48, vt = grp / 48, b = hd / 12, hh = hd - b * 12;
    const int r = lane & 31, h = lane >> 5; const bool lo16 = r < 16;
    LAS unsigned char* RS = lds + 16384;
    const GAS unsigned char* recs = (const GAS unsigned char*)(ws + WS_SPREC) + (size_t)hd * 256 * SPREC_BYTES;
    GAS float* yp = (GAS float*)(ws + WS_YS) + (size_t)b * SEQ * DRW + hh * 64 + 32 * vt + r;
    const bf16x8 zf = {0, 0, 0, 0, 0, 0, 0, 0};
    f32x16 T0, T1;
#pragma unroll
    for (int i = 0; i < 16; ++i) { T0[i] = 0.f; T1[i] = 0.f; }
#define SQ_DMA(slot, ck) do { const GAS unsigned char* rp_ = recs + (size_t)(ck) * SPREC_BYTES + lane * 16; LAS unsigned char* ls_ = RS + (slot) * 12288; \
        _Pragma("unroll") for (int q = 0; q < 9; ++q) __builtin_amdgcn_global_load_lds((const unsigned*)(rp_ + 1024 * q), (LAS unsigned*)(ls_ + 1024 * q), 16, 0, 0); \
        _Pragma("unroll") for (int q = 0; q < 3; ++q) __builtin_amdgcn_global_load_lds((const unsigned*)(rp_ + 9216 + 3072 * vt + 1024 * q), (LAS unsigned*)(ls_ + 9216 + 1024 * q), 16, 0, 0); } while (0)
    SQ_DMA(0, 0); SQ_DMA(1, 1);
#pragma unroll 1
    for (int ck = 0; ck < 256; ++ck) {
        const LAS unsigned char* L = RS + (ck & 1) * 12288;
        if (ck == 0) asm volatile("s_waitcnt vmcnt(12)" ::: "memory"); else if (ck + 1 < 256) asm volatile("s_waitcnt vmcnt(20)" ::: "memory"); else asm volatile("s_waitcnt vmcnt(0)" ::: "memory");
        bf16x8 tb[4];
#pragma unroll
        for (int s2 = 0; s2 < 2; ++s2) { u32x4 w0, w1;
            w0.x = cvtpk(T0[8 * s2], T0[8 * s2 + 1]); w0.y = cvtpk(T0[8 * s2 + 2], T0[8 * s2 + 3]); w0.z = cvtpk(T0[8 * s2 + 4], T0[8 * s2 + 5]); w0.w = cvtpk(T0[8 * s2 + 6], T0[8 * s2 + 7]);
            w1.x = cvtpk(T1[8 * s2], T1[8 * s2 + 1]); w1.y = cvtpk(T1[8 * s2 + 2], T1[8 * s2 + 3]); w1.z = cvtpk(T1[8 * s2 + 4], T1[8 * s2 + 5]); w1.w = cvtpk(T1[8 * s2 + 6], T1[8 * s2 + 7]);
            tb[s2] = __builtin_bit_cast(bf16x8, w0); tb[2 + s2] = __builtin_bit_cast(bf16x8, w1); }
        f32x16 aU, aY;
#pragma unroll
        for (int i = 0; i < 16; ++i) { aU[i] = 0.f; aY[i] = 0.f; }
        { const u32x4 yk = *(const LAS u32x4*)(L + 9216 + 1024 + lane * 16);
            aY[0] = __builtin_bit_cast(float, yk.x << 16); aY[1] = __builtin_bit_cast(float, yk.x & 0xffff0000u); aY[2] = __builtin_bit_cast(float, yk.y << 16); aY[3] = __builtin_bit_cast(float, yk.y & 0xffff0000u);
            aY[4] = __builtin_bit_cast(float, yk.z << 16); aY[5] = __builtin_bit_cast(float, yk.z & 0xffff0000u); aY[6] = __builtin_bit_cast(float, yk.w << 16); aY[7] = __builtin_bit_cast(float, yk.w & 0xffff0000u); }
#pragma unroll
        for (int ks = 0; ks < 4; ++ks) { const bf16x8 fa = lo16 ? *(const LAS bf16x8*)(L + ((ks * 2 + h) * 16 + r) * 16) : zf, fr = lo16 ? *(const LAS bf16x8*)(L + 2048 + ((ks * 2 + h) * 16 + r) * 16) : zf;
            aU = MFMA32(fa, tb[ks], aU); aY = MFMA32(fr, tb[ks], aY); }
        bf16x8 ub;
        { const u32x4 p1 = *(const LAS u32x4*)(L + 9216 + lane * 16); float u[8];
            u[0] = -aU[0] - __builtin_bit_cast(float, p1.x << 16); u[1] = -aU[1] - __builtin_bit_cast(float, p1.x & 0xffff0000u); u[2] = -aU[2] - __builtin_bit_cast(float, p1.y << 16); u[3] = -aU[3] - __builtin_bit_cast(float, p1.y & 0xffff0000u);
            u[4] = -aU[4] - __builtin_bit_cast(float, p1.z << 16); u[5] = -aU[5] - __builtin_bit_cast(float, p1.z & 0xffff0000u); u[6] = -aU[6] - __builtin_bit_cast(float, p1.w << 16); u[7] = -aU[7] - __builtin_bit_cast(float, p1.w & 0xffff0000u);
            u32x4 w_; w_.x = cvtpk(u[0], u[1]); w_.y = cvtpk(u[2], u[3]); w_.z = cvtpk(u[4], u[5]); w_.w = cvtpk(u[6], u[7]); ub = __builtin_bit_cast(bf16x8, w_); }
        { const bf16x8 fh = lo16 ? *(const LAS bf16x8*)(L + 8192 + (h * 16 + r) * 16) : zf; aY = MFMA32(fh, ub, aY); }
        { const bf16x8 fv = *(const LAS bf16x8*)(L + 9216 + 2048 + lane * 16);
            const bf16x8 b0 = *(const LAS bf16x8*)(L + 4096 + lane * 16), b1 = *(const LAS bf16x8*)(L + 4096 + 1024 + lane * 16), k0 = *(const LAS bf16x8*)(L + 6144 + lane * 16), k1 = *(const LAS bf16x8*)(L + 6144 + 1024 + lane * 16);
            T0 = MFMA32(b0, ub, T0); T1 = MFMA32(b1, ub, T1); T0 = MFMA32(k0, fv, T0); T1 = MFMA32(k1, fv, T1);
#pragma unroll
            for (int q = 0; q < 4; ++q) { const f32x4 g0 = *(const LAS f32x4*)(L + 8704 + (h * 16 + 4 * q) * 4), g1 = *(const LAS f32x4*)(L + 8704 + ((2 + h) * 16 + 4 * q) * 4);
                T0[4 * q] *= g0.x; T0[4 * q + 1] *= g0.y; T0[4 * q + 2] *= g0.z; T0[4 * q + 3] *= g0.w; T1[4 * q] *= g1.x; T1[4 * q + 1] *= g1.y; T1[4 * q + 2] *= g1.z; T1[4 * q + 3] *= g1.w; } }
#pragma unroll
        for (int i = 0; i < 8; ++i) yp[((size_t)ck * 16 + (i & 3) + 8 * (i >> 2) + 4 * h) * DRW] = aY[i];
        asm volatile("s_waitcnt lgkmcnt(0)" ::: "memory");
        if (ck + 2 < 256) SQ_DMA(ck & 1, ck + 2);
    }
#undef SQ_DMA
    asm volatile("s_waitcnt vmcnt(0)" ::: "memory");
    __builtin_amdgcn_s_setprio(0);
}

template <bool WITH_V> __device__ __forceinline__ void dma_tile(LAS unsigned char* RW, const bf16* Kb, int key0, unsigned koff, const bf16* Vt, unsigned voff) {
    const char* kp = (const char*)(Kb + (size_t)key0 * 64) + koff;
#pragma unroll
    for (int q = 0; q < 4; ++q) __builtin_amdgcn_global_load_lds((const unsigned*)(kp + 1024 * q), (LAS unsigned*)(RW + q * 1024), 16, 0, 0);
    if (WITH_V) { const char* vp = (const char*)(Vt + (size_t)(key0 >> 5) * 2048) + voff;
#pragma unroll
        for (int q = 0; q < 4; ++q) __builtin_amdgcn_global_load_lds((const unsigned*)(vp + 1024 * q), (LAS unsigned*)(RW + (4 + q) * 1024), 16, 0, 0); }
}
template <bool WITH_V> __device__ __forceinline__ void read_tile(const LAS unsigned char* RW, unsigned krd, unsigned vrd, bf16x8 (&kf)[4], bf16x8 (&vf)[2][2], bool younger) {
    if (younger) { if (WITH_V) asm volatile("s_waitcnt vmcnt(8)" ::: "memory"); else asm volatile("s_waitcnt vmcnt(4)" ::: "memory"); } else asm volatile("s_waitcnt vmcnt(0)" ::: "memory");
    const int rk = (krd >> 7) & 7, hh = krd & 1;
#pragma unroll
    for (int ks = 0; ks < 4; ++ks) kf[ks] = *(const LAS bf16x8*)(RW + (krd & ~1u) + (((2 * ks + hh) ^ rk) << 4));
    if (WITH_V) {
#pragma unroll
        for (int q = 0; q < 4; ++q) { const int dt = q >> 1, s = q & 1; const unsigned row = (vrd >> 6) + 32 * dt; vf[dt][s] = *(const LAS bf16x8*)(RW + 4096 + row * 64 + ((((2 * hh + s)) ^ ((row >> 2) & 3)) << 4)); } }
    asm volatile("s_waitcnt lgkmcnt(0)" ::: "memory");
}
__device__ __forceinline__ f32x16 qk_tile(const bf16x8 (&kf)[4], const bf16x8 (&qf)[4]) {
    f32x16 S;
#pragma unroll
    for (int i = 0; i < 16; ++i) S[i] = 0.f;
#pragma unroll
    for (int ks = 0; ks < 4; ++ks) S = MFMA32(kf[ks], qf[ks], S);
    return S;
}
__device__ __forceinline__ void pv_tile(const float (&p)[16], const bf16x8 (&vf)[2][2], f32x16 (&O)[2]) {
#pragma unroll
    for (int s = 0; s < 2; ++s) { u32x4 w; w.x = cvtpk(p[8 * s], p[8 * s + 1]); w.y = cvtpk(p[8 * s + 2], p[8 * s + 3]); w.z = cvtpk(p[8 * s + 4], p[8 * s + 5]); w.w = cvtpk(p[8 * s + 6], p[8 * s + 7]);
        const bf16x8 pf = __builtin_bit_cast(bf16x8, w);
#pragma unroll
        for (int dt = 0; dt < 2; ++dt) O[dt] = MFMA32(vf[dt][s], pf, O[dt]); }
}
__device__ __forceinline__ void att_rest(f32x16& S, const bf16x8 (&vf)[2][2], int key0, int h, bool masked, int klo, int khi, bool colsel, float& m, float& l, f32x16 (&O)[2]) {
    if (masked) { const int kb = key0 + 4 * h;
#pragma unroll
        for (int i = 0; i < 16; ++i) { const int key = kb + (i & 3) + 8 * (i >> 2); S[i] = (key <= khi && key >= klo) ? S[i] : -INFINITY; } }
    float tmax = fmaxf(fmaxf(fmaxf(S[0], S[1]), fmaxf(S[2], S[3])), fmaxf(fmaxf(S[4], S[5]), fmaxf(S[6], S[7])));
    tmax = fmaxf(tmax, fmaxf(fmaxf(fmaxf(S[8], S[9]), fmaxf(S[10], S[11])), fmaxf(fmaxf(S[12], S[13]), fmaxf(S[14], S[15]))));
    tmax = half_max(tmax); tmax = colsel ? tmax : -INFINITY;
    if (__builtin_amdgcn_ballot_w64(tmax > m + 8.0f) != 0ull) {
        const float mn = fmaxf(m, tmax); const float ms = mn == -INFINITY ? 0.f : mn; const float alpha = __builtin_amdgcn_exp2f(m - ms);
        l *= alpha; m = mn;
#pragma unroll
        for (int dt = 0; dt < 2; ++dt)
#pragma unroll
            for (int i = 0; i < 16; ++i) O[dt][i] *= alpha;
    }
    float msx = m == -INFINITY ? 0.f : m; msx = colsel ? msx : INFINITY;
    float p[16]; float ps = 0.f;
#pragma unroll
    for (int i = 0; i < 16; ++i) { p[i] = __builtin_amdgcn_exp2f(S[i] - msx); ps += p[i]; }
    l += half_sum(ps);
    pv_tile(p, vf, O);
}
constexpr int NSA_RING0 = 16384;
static_assert(NSA_RING0 + 8 * 16384 <= LDS_SCRATCH, "attention LDS map");
__device__ __forceinline__ void phase_nsa(const Args& a, int qi, int l, LAS unsigned char* lds, int slot, int lane) {
    OPQ_SI(slot); OPQ_V(lane);
    unsigned char* ws = a.ws + opaque0();
    LAS float* impl = (LAS float*)(lds + slot * 2048);
    LAS unsigned char* RW = lds + NSA_RING0 + slot * 16384;
    const bf16* QR = (const bf16*)(ws + WS_QR); const float* P = (const float*)(ws + WS_P); const float* gate_b = INPTR(a, I_GB) + (size_t)l * 36; bf16* CAT = (bf16*)(ws + WS_CAT);
    unsigned* qctr = (unsigned*)(ws + WS_CTL) + 8192 + 64 * qi;
    const int r = lane & 31, h = lane >> 5, g = r & 3, ql = r >> 2;
    const unsigned koff = (unsigned)((lane >> 3) * 128 + (((lane & 7) ^ ((lane >> 3) & 7)) << 4)), voff = (unsigned)((lane >> 2) * 64 + (((lane & 3) ^ (((lane >> 2) >> 2) & 3)) << 4));
    const unsigned krd = (unsigned)(r * 128) | (unsigned)h, vrd = (unsigned)(r * 64);
    const int myx = (int)(xb_xcc_id() & 7u); int qsel = 0;
    for (;;) {
        int item = 0, qx = 0;
        for (;;) { qx = (myx + qsel) & 7; if (lane == 0) item = (int)atomicAdd(qctr + 8 * qx, 1u); item = __builtin_amdgcn_readfirstlane(item); if (item < 96 * 8 || qsel >= 7) break; ++qsel; }
        if (item >= 96 * 8) break;
        const int up = item >> 3, wave = item & 7, k3 = up / 3, e3 = up - 3 * k3;
        const int bk = e3 < 2 ? qx : 8 + (qx >> 1); const int qt = e3 == 0 ? 63 - 2 * k3 : (e3 == 1 ? 62 - 2 * k3 : 62 - 2 * k3 + (qx & 1));
        const int b = bk / 3, kvh = bk - b * 3;
        const int tile0 = qt * 64, cur = qt; const int qp = tile0 + 8 * wave + ql; const size_t mq = (size_t)b * SEQ + qp; const int head = kvh * 4 + g;
        bf16x8 qf[4];
#pragma unroll
        for (int ks = 0; ks < 4; ++ks) qf[ks] = *(const bf16x8*)(QR + mq * 768 + head * 64 + 16 * ks + 8 * h);
        float g0, g1, g2;
        { const float* gl = P + mq * INP + PO_GL + head * 3; const float* gb = gate_b + head * 3; g0 = sigmoidf_(gl[0] + gb[0]); g1 = sigmoidf_(gl[1] + gb[1]); g2 = sigmoidf_(gl[2] + gb[2]); }
        f32x16 out[2], O[2]; bf16x8 kf[4]; bf16x8 vf[2][2];
#pragma unroll
        for (int dt = 0; dt < 2; ++dt)
#pragma unroll
            for (int i = 0; i < 16; ++i) out[dt][i] = 0.f;
        unsigned long long mymask = (2ull << cur) - 1ull, umask = mymask;
        const int qpw = tile0 + 8 * wave + 7;
        {
            const bf16* Kb = (const bf16*)(ws + WS_KC) + (size_t)(b * 3 + kvh) * NCMPP * 64; const bf16* Vt = (const bf16*)(ws + WS_VCT) + (size_t)(b * 3 + kvh) * 8 * 2048;
            const int nvw = qpw >= 31 ? ((qpw - 31) >> 4) + 1 : 0; const int nvq = qp >= 31 ? ((qp - 31) >> 4) + 1 : 0; const int ntile = (nvw + 31) >> 5;
            const bool need_imp = cur >= 16;
            if (ntile > 0) {
                float m = -INFINITY, ls = 0.f;
                dma_tile<false>(RW, Kb, 0, koff, Vt, voff);
#pragma unroll 1
                for (int kt = 0; kt < ntile; ++kt) { read_tile<false>(RW, krd, vrd, kf, vf, false); if (kt + 1 < ntile) dma_tile<false>(RW, Kb, 32 * (kt + 1), koff, Vt, voff); else dma_tile<true>(RW, Kb, 0, koff, Vt, voff);
                    const f32x16 S = qk_tile(kf, qf);
                    float tmax = -INFINITY; float sv[16];
#pragma unroll
                    for (int i = 0; i < 16; ++i) { const int n = 32 * kt + (i & 3) + 8 * (i >> 2) + 4 * h; sv[i] = n < nvq ? S[i] : -INFINITY; tmax = fmaxf(tmax, sv[i]); }
                    tmax = half_max(tmax); const float mn = fmaxf(m, tmax); const float ms = mn == -INFINITY ? 0.f : mn; float ps = 0.f;
#pragma unroll
                    for (int i = 0; i < 16; ++i) ps += __builtin_amdgcn_exp2f(sv[i] - ms);
                    ls = ls * __builtin_amdgcn_exp2f(m - ms) + half_sum(ps); m = mn; }
                const float ms = m == -INFINITY ? 0.f : m; const float inv = 1.0f / fmaxf(ls, 1.17549435e-38f);
                float carry = 0.f;
#pragma unroll
                for (int dt = 0; dt < 2; ++dt)
#pragma unroll
                    for (int i = 0; i < 16; ++i) O[dt][i] = 0.f;
                if (need_imp) {
#pragma unroll
                    for (int i = 0; i < 8; ++i) impl[i * 64 + lane] = 0.f;
                    WSYNC(); }
#pragma unroll 1
                for (int kt = 0; kt < ntile; ++kt) {
                    read_tile<true>(RW, krd, vrd, kf, vf, false); if (kt + 1 < ntile) dma_tile<true>(RW, Kb, 32 * (kt + 1), koff, Vt, voff);
                    const f32x16 S = qk_tile(kf, qf);
                    float p[16];
#pragma unroll
                    for (int i = 0; i < 16; ++i) { const int n = 32 * kt + (i & 3) + 8 * (i >> 2) + 4 * h; p[i] = n < nvq ? __builtin_amdgcn_exp2f(S[i] - ms) * inv : 0.f; }
                    if (need_imp) {
                        float val[4];
#pragma unroll
                        for (int t = 0; t < 4; ++t) { const float sp = 0.5f * p[4 * t + 3]; const float base = (p[4 * t] + p[4 * t + 1]) + (p[4 * t + 2] + sp); const float rv = other_half(sp, h);
                            val[t] = base + (h ? rv : carry); carry = h ? 0.f : rv; }
#pragma unroll
                        for (int t = 0; t < 4; ++t) { float v = val[t]; v += dpp_f<0xB1>(v); v += dpp_f<0x4E>(v); if (g == 0) impl[ql * 64 + 8 * kt + 2 * t + h] = v; }
                    }
                    pv_tile(p, vf, O);
                }
#pragma unroll
                for (int dt = 0; dt < 2; ++dt)
#pragma unroll
                    for (int i = 0; i < 16; ++i) out[dt][i] = O[dt][i] * g0;
                if (need_imp) {
                    WSYNC();
#pragma unroll 1
                    for (int q = 0; q < 8; ++q) { const float v = impl[q * 64 + lane]; const bool forced = lane == 0 || lane == cur || lane == cur - 1; impl[q * 64 + lane] = lane > cur ? -INFINITY : (forced ? 1e9f : v); }
                    WSYNC();
                    umask = 0ull;
#pragma unroll 1
                    for (int q = 0; q < 8; ++q) { const float sc = impl[q * 64 + lane]; int rank = 0;
#pragma unroll 4
                        for (int i4 = 0; i4 < 16; ++i4) { const f32x4 o = *(const LAS f32x4*)(impl + q * 64 + 4 * i4);
                            rank += (o.x > sc || (o.x == sc && 4 * i4 + 0 < lane)) ? 1 : 0; rank += (o.y > sc || (o.y == sc && 4 * i4 + 1 < lane)) ? 1 : 0;
                            rank += (o.z > sc || (o.z == sc && 4 * i4 + 2 < lane)) ? 1 : 0; rank += (o.w > sc || (o.w == sc && 4 * i4 + 3 < lane)) ? 1 : 0; }
                        const unsigned long long mk = __ballot(lane <= cur && rank < 16);
                        umask |= mk; if (ql == q) mymask = mk; }
                    WSYNC();
                }
            }
        }
        {
            const bf16* Kb = (const bf16*)(ws + WS_KS) + (size_t)(b * 3 + kvh) * SEQ * 64; const bf16* Vt = (const bf16*)(ws + WS_VST) + (size_t)(b * 3 + kvh) * 128 * 2048;
            float m = -INFINITY, ls = 0.f;
#pragma unroll
            for (int dt = 0; dt < 2; ++dt)
#pragma unroll
                for (int i = 0; i < 16; ++i) O[dt][i] = 0.f;
            unsigned long long um = umask; int hf = 0;
#define SEL_NEXT(have, jb, key0) do { have = um != 0ull; if (have) { jb = __builtin_ctzll(um); key0 = 64 * jb + 32 * hf; if (hf == 0 && 64 * jb + 32 <= qpw) hf = 1; else { hf = 0; um &= um - 1ull; } } } while (0)
            bool h0, h1; int j0 = 0, k0 = 0, j1 = 0, k1 = 0, sl = 0;
            SEL_NEXT(h0, j0, k0); if (h0) dma_tile<true>(RW, Kb, k0, koff, Vt, voff);
            SEL_NEXT(h1, j1, k1); if (h1) dma_tile<true>(RW + 8192, Kb, k1, koff, Vt, voff);
#pragma unroll 1
            while (h0) {
                read_tile<true>(RW + sl * 8192, krd, vrd, kf, vf, h1);
                bool h2; int j2 = 0, k2 = 0; SEL_NEXT(h2, j2, k2); if (h2) dma_tile<true>(RW + sl * 8192, Kb, k2, koff, Vt, voff);
                f32x16 S = qk_tile(kf, qf);
                att_rest(S, vf, k0, h, j0 == cur, -0x7fffffff, qp, (mymask >> j0) & 1ull, m, ls, O);
                h0 = h1; j0 = j1; k0 = k1; h1 = h2; j1 = j2; k1 = k2; sl ^= 1;
            }
#undef SEL_NEXT
            const float sc = g1 / fmaxf(ls, 1.17549435e-38f);
#pragma unroll
            for (int dt = 0; dt < 2; ++dt)
#pragma unroll
                for (int i = 0; i < 16; ++i) out[dt][i] += O[dt][i] * sc;
        }
        {
            const bf16* Kb = (const bf16*)(ws + WS_KW) + (size_t)(b * 3 + kvh) * SEQ * 64; const bf16* Vt = (const bf16*)(ws + WS_VWT) + (size_t)(b * 3 + kvh) * 128 * 2048;
            float m = -INFINITY, ls = 0.f;
#pragma unroll
            for (int dt = 0; dt < 2; ++dt)
#pragma unroll
                for (int i = 0; i < 16; ++i) O[dt][i] = 0.f;
            const int q0w = tile0 + 8 * wave; const int lo = q0w - 511 > 0 ? q0w - 511 : 0;
            const int tEnd = (q0w + 7) >> 5; int t = lo >> 5;
            dma_tile<true>(RW, Kb, 32 * t, koff, Vt, voff); if (t + 1 <= tEnd) dma_tile<true>(RW + 8192, Kb, 32 * (t + 1), koff, Vt, voff);
            int sl = 0;
#pragma unroll 1
            for (; t <= tEnd; ++t) {
                read_tile<true>(RW + sl * 8192, krd, vrd, kf, vf, t + 1 <= tEnd);
                if (t + 2 <= tEnd) dma_tile<true>(RW + sl * 8192, Kb, 32 * (t + 2), koff, Vt, voff);
                f32x16 S = qk_tile(kf, qf);
                att_rest(S, vf, 32 * t, h, !(32 * t >= q0w + 7 - 511 && 32 * t + 31 <= q0w), qp - 511, qp, true, m, ls, O);
                sl ^= 1;
            }
            const float sc = g2 / fmaxf(ls, 1.17549435e-38f);
            bf16* op = CAT + mq * DM + DRW + DPOOL + head * 64 + 4 * h;
#pragma unroll
            for (int dt = 0; dt < 2; ++dt)
#pragma unroll
                for (int t2 = 0; t2 < 4; ++t2) { u32x2 w; w.x = cvtpk(out[dt][4 * t2] + O[dt][4 * t2] * sc, out[dt][4 * t2 + 1] + O[dt][4 * t2 + 1] * sc); w.y = cvtpk(out[dt][4 * t2 + 2] + O[dt][4 * t2 + 2] * sc, out[dt][4 * t2 + 3] + O[dt][4 * t2 + 3] * sc);
                    *(u32x2*)(op + 32 * dt + 8 * t2) = w; }
        }
    }
}

__device__ __forceinline__ void phase_rwkv_out(const Args& a, int l, int gw, int NGW, int lane) {
    OPQ_SI(gw); OPQ_V(lane);
    unsigned char* ws = a.ws + opaque0(); const float* YS = (const float*)(ws + WS_YS); const float* vV = (const float*)(ws + WS_SV + 5 * SV_STRIDE); const float* vG = (const float*)(ws + WS_G); const float* SC = (const float*)(ws + WS_SC);
    const float* gng = INPTR(a, I_GNG) + (size_t)l * DRW; const float* gnb = INPTR(a, I_GNB) + (size_t)l * DRW; bf16* CAT = (bf16*)(ws + WS_CAT);
    for (int id0 = gw * 4; id0 < MTOK * 12; id0 += NGW * 4) {
        float y[4], vv[4], gg[4], bc[4]; int cc[4], mm[4]; size_t oo[4];
#pragma unroll
        for (int e = 0; e < 4; ++e) { const int id = id0 + e, m = id / 12, h = id - m * 12; cc[e] = h * 64 + lane; mm[e] = m; oo[e] = (size_t)m * DRW + cc[e]; y[e] = YS[oo[e]]; vv[e] = vV[oo[e]]; gg[e] = vG[oo[e]]; bc[e] = SC[((size_t)m * 12 + h) * 4 + 2]; }
#pragma unroll
        for (int e = 0; e < 4; ++e) { const float mean = wave_sum(y[e]) * (1.f / 64.f); const float d = y[e] - mean; const float var = wave_sum(d * d) * (1.f / 64.f);
            const float yn = d * (1.f / sqrtf(var + GN_EPS)) * gng[cc[e]] + gnb[cc[e]];
            CAT[(size_t)mm[e] * DM + cc[e]] = (bf16)f2bf((yn + bc[e] * vv[e]) * gg[e]); } }
}

#ifndef PROBE_MODE
#define PROBE_MODE 0
#endif
template <int PHMASK> __global__ void __launch_bounds__(NTHR, 2) fwd(Args args) {
    extern __shared__ __attribute__((aligned(16))) unsigned char lds_raw[];
    LAS unsigned char* lds = (LAS unsigned char*)lds_raw;
    const int wave = __builtin_amdgcn_readfirstlane((int)threadIdx.x >> 6);
#define LANE lane_now()
#define TID (wave * 64 + lane_now())
    const int G = gridDim.x, bid = blockIdx.x; const int gw = bid * NWAVES + wave, NGW = G * NWAVES;
    unsigned char* ws = args.ws;
    for (int u = TID; u < (LDS_BYTES - LDS_SCRATCH) / 4; u += NTHR) ((LAS unsigned*)(lds + LDS_SCRATCH))[u] = 0u;
    __syncthreads();
    const int lo = args.ph_lo, hi = args.ph_hi;
    XcdBarrier bar; bar.bar = (unsigned*)(ws + WS_CTL) + 4096; bar.x = 0; bar.st = nullptr; bar.w = wave;
    if (hi - lo > 1) bar = xcd_barrier_post((unsigned*)(ws + WS_CTL) + 4096, (volatile LAS unsigned*)(lds + MISC_OFF) + 8, wave);
#define IN(k) (lo <= (k) && (k) < hi)
#define PHEN(j) (((PHMASK) >> (j)) & 1)

#define SEAM(k) do { if ((k) + 1 < hi) xcd_barrier(bar); } while (0)
    bf16* XB = (bf16*)(ws + WS_XB); bf16* Hb = (bf16*)(ws + WS_H); float* Y = (float*)(ws + WS_YR); const float* AUX = (const float*)(ws + WS_AUX); float* Pm = (float*)(ws + WS_P); bf16* CAT = (bf16*)(ws + WS_CAT);

    if (PHEN(0) && IN(0)) { phase_prologue(args, bid * NTHR + TID, G * NTHR); SEAM(0); }
    for (int l = 0; l < NLAYER; ++l) {
        const int pb = 1 + 14 * l;
        for (int rep = 0; rep < (((REP_MASK) >> 1) & 1 ? 2 : 1); ++rep) if (PHEN(1) && IN(pb + 0)) { phase_wconv(args, l, lds, gw, NGW, wave, LANE); SEAM(pb + 0); }
        for (int rep = 0; rep < (((REP_MASK) >> 2) & 1 ? 2 : 1); ++rep) if (PHEN(2) && IN(pb + 1)) {
            pg8::Gemm g{XB, (const bf16*)(ws + WS_WUP1), MTOK, NUP, DM}; pg8::StaticOrder S; S.init(MTOK, NUP, G, bid); pg8::EpiSwiGLU E{Hb, DFF, AUX, 3 * l - 1, l * 2 * GWN};
            pg8::gemm_phase<pg8::EpiSwiGLU, pg8::StaticOrder, true, true>(lds, g, S, E, wave); SEAM(pb + 1); }
        for (int rep = 0; rep < (((REP_MASK) >> 3) & 1 ? 2 : 1); ++rep) if (PHEN(3) && IN(pb + 2)) {
            pg8::Gemm g{Hb, (const bf16*)(ws + WS_WDN1), MTOK, DM, DFF}; pg8::StaticOrder S; S.init(MTOK, DM, G, bid); pg8::EpiResid E{args.rep ? (float*)(ws + WS_P + 128 * MiB) : Y, args.rep ? (bf16*)(ws + WS_P) : XB, args.rep ? ws + WS_P + 64 * MiB : (unsigned char*)Y, DM, ALPHA, 0.5f, 3 * l - 1, 3 * l};
            pg8::gemm_phase<pg8::EpiResid, pg8::StaticOrder, true, true>(lds, g, S, E, wave); SEAM(pb + 2); }
        for (int rep = 0; rep < (((REP_MASK) >> 5) & 1 ? 2 : 1); ++rep) if (PHEN(5) && IN(pb + 4)) {
            pg8::Gemm g{XB, (const bf16*)(ws + WS_WIN), MTOK, INP, DM}; pg8::StaticOrder S; S.init(MTOK, INP, G, bid); pg8::EpiF32 E{Pm, INP, AUX, 3 * l, l * 2 * GWN + NUP};
            pg8::gemm_phase<pg8::EpiF32, pg8::StaticOrder, true, true>(lds, g, S, E, wave); SEAM(pb + 4); }
        for (int rep = 0; rep < (((REP_MASK) >> 6) & 1 ? 2 : 1); ++rep) if (PHEN(6) && IN(pb + 5)) { phase_m1(args, l, lds, bid, G, TID, wave, LANE); SEAM(pb + 5); }
        for (int rep = 0; rep < (((REP_MASK) >> 7) & 1 ? 2 : 1); ++rep) if (PHEN(7) && IN(pb + 6)) { phase_scan_prep(args, lds, gw, NGW, wave, LANE); SEAM(pb + 6); }
        for (int rep = 0; rep < (((REP_MASK) >> 8) & 1 ? 2 : 1); ++rep) if (PHEN(8) && IN(pb + 7)) { for (int r2 = 0; r2 < (((REP_MASK) >> 20) & 1 ? 2 : 1); ++r2) { if (bid < 96 && wave == 0) scan_seq(args, lds, bid, LANE); } for (int r3 = 0; r3 < (((REP_MASK) >> 21) & 1 ? 2 : 1); ++r3) if (!(bid < 96 && wave == 1)) phase_nsa(args, l + 4 * rep + 8 * r3, l, lds, wave, LANE); SEAM(pb + 7); }
        for (int rep = 0; rep < (((REP_MASK) >> 9) & 1 ? 2 : 1); ++rep) if (PHEN(9) && IN(pb + 8)) { phase_rwkv_out(args, l, gw, NGW, LANE); SEAM(pb + 8); }
        for (int rep = 0; rep < (((REP_MASK) >> 10) & 1 ? 2 : 1); ++rep) if (PHEN(10) && IN(pb + 9)) {
            pg8::Gemm g{CAT, (const bf16*)(ws + WS_WOUT), MTOK, DM, DM}; pg8::StaticOrder S; S.init(MTOK, DM, G, bid); pg8::EpiResid E{Y, XB, (unsigned char*)Y, DM, ALPHA, 1.0f, 3 * l, 3 * l + 1};
            pg8::gemm_phase<pg8::EpiResid, pg8::StaticOrder, true, true>(lds, g, S, E, wave); SEAM(pb + 9); }
        for (int rep = 0; rep < (((REP_MASK) >> 12) & 1 ? 2 : 1); ++rep) if (PHEN(12) && IN(pb + 11)) {
            pg8::Gemm g{XB, (const bf16*)(ws + WS_WUP2), MTOK, NUP, DM}; pg8::StaticOrder S; S.init(MTOK, NUP, G, bid); pg8::EpiSwiGLU E{Hb, DFF, AUX, 3 * l + 1, l * 2 * GWN + NUP + INP};
            pg8::gemm_phase<pg8::EpiSwiGLU, pg8::StaticOrder, true, true>(lds, g, S, E, wave); SEAM(pb + 11); }
        for (int rep = 0; rep < (((REP_MASK) >> 13) & 1 ? 2 : 1); ++rep) if (PHEN(13) && IN(pb + 12)) {
            pg8::Gemm g{Hb, (const bf16*)(ws + WS_WDN2), MTOK, DM, DFF}; pg8::StaticOrder S; S.init(MTOK, DM, G, bid); pg8::EpiResid E{Y, XB, (unsigned char*)Y, DM, ALPHA, 0.5f, 3 * l + 1, 3 * l + 2};
            pg8::gemm_phase<pg8::EpiResid, pg8::StaticOrder, true, true>(lds, g, S, E, wave); SEAM(pb + 12); }
        for (int rep = 0; rep < (((REP_MASK) >> 14) & 1 ? 2 : 1); ++rep) if (l == NLAYER - 1 && PHEN(14) && IN(pb + 13)) { phase_ln_final(XB, (const unsigned char*)Y, INPTR(args, I_LN3G) + (size_t)l * DM, INPTR(args, I_LN3B) + (size_t)l * DM, args.out, gw, NGW, LANE); SEAM(pb + 13); }
    }
#undef IN
#undef SEAM
}

#ifndef ONE_MASK
#define ONE_MASK 0xFFFFF
#endif
#ifndef MK_ONE_LAUNCH
#define MK_ONE_LAUNCH 1
#endif
typedef void (*kern_t)(Args);
extern "C" void kernel_launch(void* const* d_in, const int* in_sizes, int n_in, void* d_out, int out_size, void* d_ws, size_t ws_size, hipStream_t stream) {
    static int grid = 0;
#if MK_ONE_LAUNCH
    static const kern_t kerns[1] = {fwd<ONE_MASK>};
    constexpr int NK = 1;
#else
    static const kern_t kerns[15] = {fwd<1 << 0>, fwd<1 << 1>, fwd<1 << 2>, fwd<1 << 3>, fwd<1 << 4>, fwd<1 << 5>, fwd<1 << 6>, fwd<1 << 7>, fwd<1 << 8>, fwd<1 << 9>, fwd<1 << 10>, fwd<1 << 11>, fwd<1 << 12>, fwd<1 << 13>, fwd<1 << 14>};
    constexpr int NK = 15;
#endif
    if (grid == 0) {
        if (n_in != 34 || out_size != MTOK * DM || ws_size < WS_END) { fprintf(stderr, "kernel_launch: unexpected shapes (n_in %d, out %d, ws %zu; need ws >= %zu)\n", n_in, out_size, ws_size, (size_t)WS_END); grid = -1; return; }
        int dev = 0, cus = 0;
        if (hipGetDevice(&dev) != hipSuccess || hipDeviceGetAttribute(&cus, hipDeviceAttributeMultiprocessorCount, dev) != hipSuccess) { grid = -1; return; }
        for (int i = 0; i < NK; ++i) if (hipFuncSetAttribute((const void*)kerns[i], hipFuncAttributeMaxDynamicSharedMemorySize, LDS_BYTES) != hipSuccess) { fprintf(stderr, "kernel_launch: hipFuncSetAttribute failed\n"); grid = -1; return; }
        int per_cu = 0;
        if (hipOccupancyMaxActiveBlocksPerMultiprocessor(&per_cu, (const void*)kerns[0], NTHR, LDS_BYTES) != hipSuccess || per_cu < 1) fprintf(stderr, "kernel_launch: occupancy query says %d blocks per CU\n", per_cu);
        (void)hipGetLastError();
        grid = cus;
    }
    if (grid < 0) return;
    (void)hipMemsetAsync((char*)d_ws + WS_CTL, 0, CTL_ZERO_BYTES, stream);
    (void)hipMemsetAsync((char*)d_ws + WS_AUX, 0, AUX_ZERO_BYTES, stream);
    Args a{};
    for (int i = 0; i < 34; ++i) a.in[i] = (const float*)d_in[i];
    a.out = (float*)d_out; a.ws = (unsigned char*)d_ws;
#if MK_ONE_LAUNCH
    a.ph_lo = 0; a.ph_hi = NPH;
    hipLaunchKernelGGL(kerns[0], dim3(grid), dim3(NTHR), LDS_BYTES, stream, a);
#else
#ifndef HOST_REP
#define HOST_REP 0
#endif
    for (int k = 0; k < NPH; ++k) { a.ph_lo = k; a.ph_hi = k + 1; const int j = k == 0 ? 0 : (k - 1) % 14 + 1;
        for (int rep = 0; rep < (((HOST_REP) >> j) & 1 ? 2 : 1); ++rep) {
            if (rep && j == 8) (void)hipMemsetAsync((char*)d_ws + WS_CTL + (8192 + 64 * ((k - 1) / 14)) * 4, 0, 256, stream);
            a.rep = rep; hipLaunchKernelGGL(kerns[j], dim3(grid), dim3(NTHR), LDS_BYTES, stream, a); } }
#endif
}
```
